# Optimizing an MI355X kernel written in HIP

```python
import math
import jax
import jax.numpy as jnp
from jax import lax
import numpy as np

D_MODEL = 1024
BATCH = 1
SEQ = 16384
DEPTH = 2

CTX_LEN = 256
GRID_W = 64
N_EVEN = (DEPTH + 1) // 2
N_ODD = DEPTH // 2
EPS = 1e-6
CONV_W = 3

SSD_HEADS = 8
SSD_HEAD_DIM = 64
SSD_INNER = SSD_HEADS * SSD_HEAD_DIM
SSD_GROUPS = 2
SSD_STATE = 64
SSD_CHUNK = 128
SSD_CONV_DIM = SSD_INNER + 2 * SSD_GROUPS * SSD_STATE

ATT_Q_HEADS = 8
ATT_KV_HEADS = 2
ATT_HEAD_DIM = 64
ATT_BLOCK = 128
WINDOW = 128
ROPE_THETA = 10000.0

ML_HEADS = 8
ML_QK_DIM = 64
ML_V_DIM = 128
ML_CHUNK = 128
ML_INNER = ML_HEADS * ML_V_DIM
ML_QKV = 2 * ML_HEADS * ML_QK_DIM + ML_INNER

N_EXPERTS = 16
N_GROUPS = 4
TOPK_GROUP = 1
TOP_K = 2
D_EXPERT = 512

EVEN_SIZES = (SSD_INNER, SSD_CONV_DIM, 2 * SSD_HEADS, ATT_Q_HEADS * ATT_HEAD_DIM, ATT_KV_HEADS * ATT_HEAD_DIM, ATT_KV_HEADS * ATT_HEAD_DIM)
EVEN_IN = sum(EVEN_SIZES)
EVEN_MIX = SSD_INNER + ATT_Q_HEADS * ATT_HEAD_DIM
ODD_SIZES = (ML_QKV, ML_INNER, 2 * ML_HEADS, 2 * ML_HEADS)
ODD_IN = sum(ODD_SIZES)

kernel_name = 'hybrid_ssd_swa_mlstm_moe_prefix_ctx'


def cuts(sizes):
    out, acc = [], 0
    for s in sizes[:-1]:
        acc += s
        out.append(acc)
    return out


def rmsnorm(x, g):
    xf = x.astype(jnp.float32)
    y = xf * lax.rsqrt(jnp.mean(xf * xf, axis=-1, keepdims=True) + EPS)
    return y.astype(x.dtype) * g


def adaln(cvec, w_mod, b_mod):
    m = (jax.nn.silu(cvec) @ w_mod + b_mod)[..., None, :]
    return jnp.split(m, 6, axis=-1)


def rev(t):
    return jnp.flip(t, axis=1)


def ident(t):
    return t


def dwconv_centred(x, w, b):
    L = x.shape[1]
    pad = CONV_W // 2
    xp = jnp.pad(x, ((0, 0), (pad, pad), (0, 0)))
    return sum(xp[:, j:j + L] * w[j] for j in range(CONV_W)) + b


def rope_1d(x, pos):
    n = x.shape[-1] // 2
    inv = ROPE_THETA ** (-jnp.arange(n, dtype=jnp.float32) / n)
    ang = pos.astype(jnp.float32)[:, None] * inv
    cos = jnp.cos(ang)[None, :, None, :]
    sin = jnp.sin(ang)[None, :, None, :]
    x1 = x[..., :n].astype(jnp.float32)
    x2 = x[..., n:].astype(jnp.float32)
    return jnp.concatenate([x1 * cos - x2 * sin, x1 * sin + x2 * cos], axis=-1)


def axial_rope(x, row, col):
    half = x.shape[-1] // 2
    return jnp.concatenate([rope_1d(x[..., :half], row), rope_1d(x[..., half:], col)], axis=-1).astype(x.dtype)


def segsum(a):
    T = a.shape[-1]
    strict = jnp.tril(jnp.ones((T, T), dtype=bool), -1)
    incl = jnp.tril(jnp.ones((T, T), dtype=bool))
    cs = jnp.cumsum(jnp.where(strict, a[..., :, None], 0.0), axis=-2)
    return jnp.where(incl, cs, -jnp.inf)


def ssd_scan(x, dt, A, Bm, Cm, h0):
    Bt, L, H, P = x.shape
    G, N = Bm.shape[2], Bm.shape[3]
    R = H // G
    T = SSD_CHUNK
    nc = L // T
    xc = x.reshape(Bt, nc, T, G, R, P)
    dtc = dt.reshape(Bt, nc, T, G, R)
    Bc = Bm.reshape(Bt, nc, T, G, N)
    Cc = Cm.reshape(Bt, nc, T, G, N)
    a = jnp.moveaxis(dtc * A.reshape(G, R), 2, -1)
    a_cs = jnp.cumsum(a, axis=-1)
    xdt = xc * dtc[..., None]
    Lm = jnp.exp(segsum(a))
    cb = jnp.einsum('bctgn,bcsgn->bcgts', Cc, Bc)
    y_diag = jnp.einsum('bcgts,bcgrts,bcsgrp->bctgrp', cb, Lm, xdt)
    decay_s = jnp.exp(a_cs[..., -1:] - a_cs)
    states = jnp.einsum('bcsgn,bcgrs,bcsgrp->bcgrpn', Bc, decay_s, xdt)
    states = jnp.concatenate([h0.reshape(Bt, 1, G, R, P, N).astype(states.dtype), states], axis=1)
    chunk_tot = jnp.pad(a_cs[..., -1], ((0, 0), (1, 0), (0, 0), (0, 0)))
    decay_chunk = jnp.exp(segsum(jnp.moveaxis(chunk_tot, 1, -1)))
    new_states = jnp.einsum('bgrzc,bcgrpn->bzgrpn', decay_chunk, states)
    states_in, final = new_states[:, :-1], new_states[:, -1]
    y_off = jnp.einsum('bctgn,bcgrpn,bcgrt->bctgrp', Cc, states_in, jnp.exp(a_cs))
    y = (y_diag + y_off).reshape(Bt, L, H, P)
    return y, final.reshape(Bt, H, P, N)


def mlstm_scan(q, k, v, ig, lf, state0):
    Bt, L, H, Dk = q.shape
    Dv = v.shape[-1]
    T = ML_CHUNK
    nc = L // T
    qc = q.reshape(Bt, nc, T, H, Dk)
    kc = k.reshape(Bt, nc, T, H, Dk)
    vc = v.reshape(Bt, nc, T, H, Dv)
    igc = jnp.moveaxis(ig.reshape(Bt, nc, T, H), 2, -1)
    b = jnp.cumsum(jnp.moveaxis(lf.reshape(Bt, nc, T, H), 2, -1), axis=-1)
    b_last = b[..., -1]
    w_end = b_last[..., None] - b + igc
    a_c = jnp.max(w_end, axis=-1)
    e_end = jnp.exp(w_end - a_c[..., None])
    S_c = jnp.einsum('bchs,bcshk,bcshv->bchkv', e_end, kc, vc)
    n_c = jnp.einsum('bchs,bcshk->bchk', e_end, kc)

    def step(carry, inp):
        Cs, ns, m = carry
        bl, a, Sc, nn_c = inp
        m_new = jnp.maximum(bl + m, a)
        sp = jnp.exp(bl + m - m_new)
        sc = jnp.exp(a - m_new)
        Cn = sp[..., None, None] * Cs + sc[..., None, None] * Sc
        nn = sp[..., None] * ns + sc[..., None] * nn_c
        return (Cn, nn, m_new), (Cs, ns, m)

    xs = (jnp.moveaxis(b_last, 1, 0), jnp.moveaxis(a_c, 1, 0), jnp.moveaxis(S_c, 1, 0), jnp.moveaxis(n_c, 1, 0))
    final, (C_in, n_in, m_in) = lax.scan(step, state0, xs)
    C_in = jnp.moveaxis(C_in, 0, 1)
    n_in = jnp.moveaxis(n_in, 0, 1)
    m_in = jnp.moveaxis(m_in, 0, 1)
    causal = jnp.tril(jnp.ones((T, T), dtype=bool))
    Dlog = jnp.where(causal, b[..., :, None] - b[..., None, :] + igc[..., None, :], -jnp.inf)
    g = b + m_in[..., None]
    m_star = jnp.maximum(g, jnp.max(Dlog, axis=-1))
    W = jnp.exp(Dlog - m_star[..., None]) * jnp.einsum('bcthk,bcshk->bchts', qc, kc)
    e_inter = jnp.exp(g - m_star)
    num = jnp.einsum('bchts,bcshv->bcthv', W, vc) + jnp.einsum('bcthk,bchkv,bcht->bcthv', qc, C_in, e_inter)
    den = W.sum(-1) + jnp.einsum('bcthk,bchk->bcht', qc, n_in) * e_inter
    denom = jnp.maximum(jnp.abs(den), jnp.exp(-m_star))
    h = num / jnp.swapaxes(denom, 2, 3)[..., None]
    return h.reshape(Bt, L, H, Dv), final


def window_attention(q, k, v, k_ctx, v_ctx, sink):
    Bt, S = q.shape[:2]
    nb = S // ATT_BLOCK
    G, R, Dh = ATT_KV_HEADS, ATT_Q_HEADS // ATT_KV_HEADS, ATT_HEAD_DIM
    scale = Dh ** -0.5
    qb = q.reshape(Bt, nb, ATT_BLOCK, G, R, Dh)

    def band(t):
        tp = jnp.pad(t, ((0, 0), (ATT_BLOCK, ATT_BLOCK), (0, 0), (0, 0))).reshape(Bt, nb + 2, ATT_BLOCK, G, Dh)
        return jnp.concatenate([tp[:, :-2], tp[:, 1:-1], tp[:, 2:]], axis=2)

    kb, vb = band(k), band(v)
    s_loc = jnp.einsum('bnqgrd,bnkgd->bngrqk', qb, kb, preferred_element_type=jnp.float32) * scale
    qpos = jnp.arange(nb)[:, None] * ATT_BLOCK + jnp.arange(ATT_BLOCK)[None]
    kpos = jnp.arange(nb)[:, None] * ATT_BLOCK - ATT_BLOCK + jnp.arange(3 * ATT_BLOCK)[None]
    valid = (jnp.abs(qpos[:, :, None] - kpos[:, None, :]) <= WINDOW) & (kpos[:, None, :] >= 0) & (kpos[:, None, :] < S)
    s_loc = jnp.where(valid[None, :, None, None], s_loc, -jnp.inf)
    s_ctx = jnp.einsum('bnqgrd,bcgd->bngrqc', qb, k_ctx, preferred_element_type=jnp.float32) * scale
    s_sink = sink.astype(jnp.float32).reshape(1, 1, G, R, 1, 1)
    m = jnp.maximum(jnp.maximum(s_loc.max(-1, keepdims=True), s_ctx.max(-1, keepdims=True)), s_sink)
    p_loc = jnp.exp(s_loc - m)
    p_ctx = jnp.exp(s_ctx - m)
    denom = p_loc.sum(-1, keepdims=True) + p_ctx.sum(-1, keepdims=True) + jnp.exp(s_sink - m)
    o = (jnp.einsum('bngrqk,bnkgd->bnqgrd', p_loc / denom, vb.astype(jnp.float32))
         + jnp.einsum('bngrqc,bcgd->bnqgrd', p_ctx / denom, v_ctx.astype(jnp.float32)))
    return o.reshape(Bt, S, ATT_Q_HEADS * Dh).astype(q.dtype)


def context_attention(q, k, v, sink):
    Bt, C = q.shape[:2]
    G, R = ATT_KV_HEADS, ATT_Q_HEADS // ATT_KV_HEADS
    qg = q.reshape(Bt, C, G, R, ATT_HEAD_DIM)
    s = jnp.einsum('bqgrd,bkgd->bgrqk', qg, k, preferred_element_type=jnp.float32) * ATT_HEAD_DIM ** -0.5
    s_sink = jnp.broadcast_to(sink.astype(jnp.float32).reshape(1, G, R, 1, 1), (Bt, G, R, C, 1))
    p = jax.nn.softmax(jnp.concatenate([s, s_sink], axis=-1), axis=-1)[..., :C]
    o = jnp.einsum('bgrqk,bkgd->bqgrd', p, v.astype(jnp.float32))
    return o.reshape(Bt, C, ATT_Q_HEADS * ATT_HEAD_DIM).astype(q.dtype)


def even_mixer(h_lat, h_ctx, row, col, w_in, conv_w, conv_b, dt_bias, a_log, d_skip, ssd_norm,
               q_norm, k_norm, sink, w_out, with_ctx):
    Bt = h_lat.shape[0]
    A = -jnp.exp(a_log.astype(jnp.float32))

    def project(h):
        L = h.shape[1]
        z, xbc, dt_raw, q, k, v = jnp.split(h @ w_in, cuts(EVEN_SIZES), axis=-1)
        xbc = jax.nn.silu(dwconv_centred(xbc, conv_w, conv_b))
        xs, bm, cm = jnp.split(xbc, [SSD_INNER, SSD_INNER + SSD_GROUPS * SSD_STATE], axis=-1)
        dt = jax.nn.softplus(dt_raw.reshape(Bt, L, 2, SSD_HEADS).astype(jnp.float32) + dt_bias)
        q = rmsnorm(q.reshape(Bt, L, ATT_Q_HEADS, ATT_HEAD_DIM), q_norm)
        k = rmsnorm(k.reshape(Bt, L, ATT_KV_HEADS, ATT_HEAD_DIM), k_norm)
        v = v.reshape(Bt, L, ATT_KV_HEADS, ATT_HEAD_DIM)
        return (z, xs.reshape(Bt, L, SSD_HEADS, SSD_HEAD_DIM), bm.reshape(Bt, L, SSD_GROUPS, SSD_STATE),
                cm.reshape(Bt, L, SSD_GROUPS, SSD_STATE), dt, q, k, v)

    zl, xl, bl, cl, dtl, ql, kl, vl = project(h_lat)
    zc, xc, bc, cc, dtc, qc, kc, vc = project(h_ctx)
    h0 = jnp.zeros((Bt, SSD_HEADS, SSD_HEAD_DIM, SSD_STATE), jnp.float32)
    y_lat = d_skip[:, None] * xl
    y_ctx = d_skip[:, None] * xc
    for d in range(2):
        f = rev if d else ident
        yc, hc = ssd_scan(f(xc), f(dtc[:, :, d]), A[d], f(bc), f(cc), h0)
        yl, _ = ssd_scan(f(xl), f(dtl[:, :, d]), A[d], f(bl), f(cl), hc)
        y_lat = y_lat + f(yl)
        if with_ctx:
            y_ctx = y_ctx + f(yc)

    def ssd_out(y, z):
        y = y.reshape(Bt, y.shape[1], SSD_INNER).astype(z.dtype)
        return rmsnorm(y * jax.nn.silu(z), ssd_norm)

    ql = axial_rope(ql, row, col)
    kl = axial_rope(kl, row, col)
    out_lat = jnp.concatenate([ssd_out(y_lat, zl), window_attention(ql, kl, vl, kc, vc, sink)], axis=-1) @ w_out
    out_ctx = None
    if with_ctx:
        out_ctx = (jnp.concatenate([ssd_out(y_ctx, zc), context_attention(qc, kc, vc, sink)], axis=-1) @ w_out).astype(h_ctx.dtype)
    return out_lat.astype(h_lat.dtype), out_ctx


def odd_mixer(h_lat, h_ctx, w_in, conv_w, conv_b, igate_b, fgate_b, head_norm, w_out, with_ctx):
    Bt = h_lat.shape[0]

    def project(h):
        L = h.shape[1]
        qkv, o, ig, fg = jnp.split(h @ w_in, cuts(ODD_SIZES), axis=-1)
        qkv = jax.nn.silu(dwconv_centred(qkv, conv_w, conv_b))
        q, k, v = jnp.split(qkv, [ML_HEADS * ML_QK_DIM, 2 * ML_HEADS * ML_QK_DIM], axis=-1)
        q = q.reshape(Bt, L, ML_HEADS, ML_QK_DIM)
        k = k.reshape(Bt, L, ML_HEADS, ML_QK_DIM) * (ML_QK_DIM ** -0.5)
        v = v.reshape(Bt, L, ML_HEADS, ML_V_DIM)
        ig = ig.reshape(Bt, L, 2, ML_HEADS).astype(jnp.float32) + igate_b
        lf = jax.nn.log_sigmoid(fg.reshape(Bt, L, 2, ML_HEADS).astype(jnp.float32) + fgate_b)
        return q, k, v, o, ig, lf

    ql, kl, vl, ol, igl, lfl = project(h_lat)
    qc, kc, vc, oc, igc, lfc = project(h_ctx)
    zero = (jnp.zeros((Bt, ML_HEADS, ML_QK_DIM, ML_V_DIM), jnp.float32),
            jnp.zeros((Bt, ML_HEADS, ML_QK_DIM), jnp.float32),
            jnp.zeros((Bt, ML_HEADS), jnp.float32))
    h_l = 0.0
    h_c = 0.0
    for d in range(2):
        f = rev if d else ident
        yc, sc = mlstm_scan(f(qc), f(kc), f(vc), f(igc[:, :, d]), f(lfc[:, :, d]), zero)
        yl, _ = mlstm_scan(f(ql), f(kl), f(vl), f(igl[:, :, d]), f(lfl[:, :, d]), sc)
        h_l = h_l + f(yl)
        if with_ctx:
            h_c = h_c + f(yc)

    def out(hh, o):
        hh = rmsnorm(hh, head_norm.reshape(ML_HEADS, ML_V_DIM)).reshape(Bt, hh.shape[1], ML_INNER).astype(o.dtype)
        return (hh * jax.nn.sigmoid(o)) @ w_out

    out_lat = out(h_l, ol).astype(h_lat.dtype)
    out_ctx = out(h_c, oc).astype(h_ctx.dtype) if with_ctx else None
    return out_lat, out_ctx


def moe(h, router_w, router_b, w1, w3, w2):
    scores = jax.nn.sigmoid((h @ router_w).astype(jnp.float32))
    biased = scores + router_b.astype(jnp.float32)
    per = N_EXPERTS // N_GROUPS
    grp = biased.reshape(biased.shape[:-1] + (N_GROUPS, per))
    grp_score = lax.top_k(grp, 2)[0].sum(-1)
    _, gidx = lax.top_k(grp_score, TOPK_GROUP)
    gsel = jax.nn.one_hot(gidx, N_GROUPS, dtype=jnp.float32).sum(-2) > 0
    esel = jnp.repeat(gsel, per, axis=-1)
    _, eidx = lax.top_k(jnp.where(esel, biased, -jnp.inf), TOP_K)
    w = jnp.take_along_axis(scores, eidx, axis=-1)
    w = w / w.sum(-1, keepdims=True)
    gates = (jax.nn.one_hot(eidx, N_EXPERTS, dtype=jnp.float32) * w[..., None]).sum(-2)
    out = jnp.zeros(h.shape, jnp.float32)
    for e in range(N_EXPERTS):
        a = jax.nn.silu(h @ w1[e]) * (h @ w3[e])
        out = out + gates[..., e:e + 1] * (a @ w2[e])
    return out.astype(h.dtype)


def setup_inputs(seed: int = 0) -> dict:
    key = jax.random.key(seed)
    keys = jax.random.split(key, 48)
    ki = iter(range(48))
    D = D_MODEL

    def nrm(shape, s):
        return jax.random.normal(keys[next(ki)], shape, jnp.float32) * s

    def unif(shape, lo, hi):
        return jax.random.uniform(keys[next(ki)], shape, jnp.float32, minval=lo, maxval=hi)

    dt = jnp.exp(unif((N_EVEN, 2, SSD_HEADS), math.log(1e-3), math.log(1e-1)))
    return {
        'x': nrm((BATCH, SEQ, D), 1.0),
        'c': nrm((BATCH, D), 1.0),
        'ctx': nrm((BATCH, CTX_LEN, D), 1.0),
        'c_ctx': nrm((D,), 1.0),
        'router_w': nrm((D, N_EXPERTS), D ** -0.5),
        'router_b': nrm((N_EXPERTS,), 0.01),
        'norm_mix': 1.0 + nrm((DEPTH, D), 0.02),
        'norm_ffn': 1.0 + nrm((DEPTH, D), 0.02),
        'w_mod': nrm((DEPTH, D, 6 * D), 0.5 * D ** -0.5),
        'b_mod': nrm((DEPTH, 6 * D), 0.02),
        'ev_w_in': nrm((N_EVEN, D, EVEN_IN), D ** -0.5),
        'ev_conv_w': nrm((N_EVEN, CONV_W, SSD_CONV_DIM), CONV_W ** -0.5),
        'ev_conv_b': nrm((N_EVEN, SSD_CONV_DIM), 0.02),
        'ev_dt_bias': dt + jnp.log(-jnp.expm1(-dt)),
        'ev_a_log': jnp.log(unif((N_EVEN, 2, SSD_HEADS), 1.0, 16.0)),
        'ev_d_skip': 1.0 + nrm((N_EVEN, SSD_HEADS), 0.1),
        'ev_ssd_norm': 1.0 + nrm((N_EVEN, SSD_INNER), 0.02),
        'ev_q_norm': 1.0 + nrm((N_EVEN, ATT_HEAD_DIM), 0.02),
        'ev_k_norm': 1.0 + nrm((N_EVEN, ATT_HEAD_DIM), 0.02),
        'ev_sink': nrm((N_EVEN, ATT_Q_HEADS), 1.0),
        'ev_w_out': nrm((N_EVEN, EVEN_MIX, D), EVEN_MIX ** -0.5),
        'od_w_in': nrm((N_ODD, D, ODD_IN), D ** -0.5),
        'od_conv_w': nrm((N_ODD, CONV_W, ML_QKV), CONV_W ** -0.5),
        'od_conv_b': nrm((N_ODD, ML_QKV), 0.02),
        'od_igate_b': nrm((N_ODD, 2, ML_HEADS), 0.1),
        'od_fgate_b': jnp.linspace(3.0, 6.0, ML_HEADS, dtype=jnp.float32)[None, None, :] + nrm((N_ODD, 2, ML_HEADS), 0.1),
        'od_head_norm': 1.0 + nrm((N_ODD, ML_INNER), 0.02),
        'od_w_out': nrm((N_ODD, ML_INNER, D), ML_INNER ** -0.5),
        'moe_w1': nrm((DEPTH, N_EXPERTS, D, D_EXPERT), D ** -0.5),
        'moe_w3': nrm((DEPTH, N_EXPERTS, D, D_EXPERT), D ** -0.5),
        'moe_w2': nrm((DEPTH, N_EXPERTS, D_EXPERT, D), D_EXPERT ** -0.5),
    }


def reference(x, c, ctx, c_ctx, router_w, router_b, norm_mix, norm_ffn, w_mod, b_mod,
              ev_w_in, ev_conv_w, ev_conv_b, ev_dt_bias, ev_a_log, ev_d_skip, ev_ssd_norm,
              ev_q_norm, ev_k_norm, ev_sink, ev_w_out,
              od_w_in, od_conv_w, od_conv_b, od_igate_b, od_fgate_b, od_head_norm, od_w_out,
              moe_w1, moe_w3, moe_w2):
    S = x.shape[1]
    ROWS = S // GRID_W
    row = jnp.repeat(jnp.arange(ROWS, dtype=jnp.int32), GRID_W)
    col = jnp.tile(jnp.arange(GRID_W, dtype=jnp.int32), ROWS)
    x_lat, x_ctx = x, ctx
    for l in range(DEPTH):
        with_ctx = l < DEPTH - 1
        sh_m, sc_m, g_m, sh_f, sc_f, g_f = adaln(c, w_mod[l], b_mod[l])
        csh_m, csc_m, cg_m, csh_f, csc_f, cg_f = adaln(c_ctx, w_mod[l], b_mod[l])
        h_lat = rmsnorm(x_lat, norm_mix[l]) * (1.0 + sc_m) + sh_m
        h_ctx = rmsnorm(x_ctx, norm_mix[l]) * (1.0 + csc_m) + csh_m
        i = l // 2
        if l % 2 == 0:
            m_lat, m_ctx = even_mixer(h_lat, h_ctx, row, col, ev_w_in[i], ev_conv_w[i], ev_conv_b[i], ev_dt_bias[i],
                                      ev_a_log[i], ev_d_skip[i], ev_ssd_norm[i], ev_q_norm[i], ev_k_norm[i],
                                      ev_sink[i], ev_w_out[i], with_ctx)
        else:
            m_lat, m_ctx = odd_mixer(h_lat, h_ctx, od_w_in[i], od_conv_w[i], od_conv_b[i], od_igate_b[i],
                                     od_fgate_b[i], od_head_norm[i], od_w_out[i], with_ctx)
        x_lat = x_lat + g_m * m_lat
        h_lat = rmsnorm(x_lat, norm_ffn[l]) * (1.0 + sc_f) + sh_f
        x_lat = x_lat + g_f * moe(h_lat, router_w, router_b, moe_w1[l], moe_w3[l], moe_w2[l])
        if with_ctx:
            x_ctx = x_ctx + cg_m * m_ctx
            h_ctx = rmsnorm(x_ctx, norm_ffn[l]) * (1.0 + csc_f) + csh_f
            x_ctx = x_ctx + cg_f * moe(h_ctx, router_w, router_b, moe_w1[l], moe_w3[l], moe_w2[l])
    return x_lat
```

```cpp
#include <hip/hip_runtime.h>
#include <hip/hip_cooperative_groups.h>
#include <cstdio>
namespace cg = cooperative_groups;

typedef unsigned short bf16_t;
typedef unsigned int u32;

constexpr int D = 1024, SEQ = 16384, CTX = 256, MT = SEQ + CTX;
constexpr int NTH = 512;
#ifndef NPH_RUN
#define NPH_RUN 21
#endif
constexpr int EV_IN = 2064, OD_IN = 3104;
constexpr int NE = 16, DE = 512;
constexpr int MAXTILES = 146, MAXSLOTS = MAXTILES * 256;

constexpr size_t al256(size_t x) { return (x + 255) & ~(size_t)255; }
constexpr size_t WS_CTL   = 0;
constexpr size_t WS_MODS  = 65536;
constexpr size_t WS_ROPE  = WS_MODS + al256(2 * 2 * 6144 * 4);
constexpr size_t WS_SMALL = WS_ROPE + al256(2 * 256 * 16 * 4);
constexpr size_t WS_ROUTE = WS_SMALL + al256((size_t)MT * 32 * 4);
constexpr size_t WS_GATE  = WS_ROUTE + al256((size_t)MT * 16);
constexpr size_t WS_SLOT  = WS_GATE + al256((size_t)MT * 8);
constexpr size_t WS_LIST  = WS_SLOT + al256((size_t)MT * 8);
constexpr size_t WS_TEXP  = WS_LIST + al256((size_t)MAXSLOTS * 4);
constexpr size_t WS_WIN0  = WS_TEXP + 1024;
constexpr size_t WS_WIN1  = WS_WIN0 + (size_t)2048 * 1024 * 2;
constexpr size_t WS_WOUT0 = WS_WIN1 + (size_t)3072 * 1024 * 2;
constexpr size_t WS_WOUT1 = WS_WOUT0 + (size_t)1024 * 1024 * 2;
constexpr size_t WS_WMOE  = WS_WOUT1 + (size_t)1024 * 1024 * 2;
constexpr size_t WS_XRES  = WS_WMOE + (size_t)16 * 1024 * 1024 * 2 + (size_t)16 * 1024 * 512 * 2;
constexpr size_t WS_HB    = WS_XRES + (size_t)MT * 1024 * 4;
constexpr size_t WS_PROJ  = WS_HB + (size_t)MT * 1024 * 2;
constexpr size_t WS_Y     = WS_PROJ + (size_t)MT * 3072 * 2;
constexpr size_t WS_END   = WS_Y + (size_t)MT * 1024 * 4;
static_assert(WS_END < 349000000, "workspace too large");

constexpr int CW_CNT = 0;

struct PK { const float* in[31]; float* out; unsigned char* ws; };
typedef __attribute__((address_space(4))) const unsigned char* kaptr_t;
struct InTab { __device__ __forceinline__ const float* operator[](int i) const {
    kaptr_t ka = (kaptr_t)__builtin_amdgcn_kernarg_segment_ptr(); asm volatile("" : "+s"(ka)); return *(const float* __attribute__((address_space(4))) const*)(ka + i * 8); } };
struct P { InTab in;
    __device__ __forceinline__ float* get_out() const { kaptr_t ka = (kaptr_t)__builtin_amdgcn_kernarg_segment_ptr(); asm volatile("" : "+s"(ka)); return *(float* __attribute__((address_space(4))) const*)(ka + 31 * 8); }
    __device__ __forceinline__ unsigned char* get_ws() const { kaptr_t ka = (kaptr_t)__builtin_amdgcn_kernarg_segment_ptr(); asm volatile("" : "+s"(ka)); return *(unsigned char* __attribute__((address_space(4))) const*)(ka + 32 * 8); } };

__device__ __forceinline__ float bf2f(bf16_t b) { return __uint_as_float((u32)b << 16); }
__device__ __forceinline__ bf16_t f2bf(float f) { u32 u = __float_as_uint(f); u += 0x7FFFu + ((u >> 16) & 1u); return (bf16_t)(u >> 16); }
__device__ __forceinline__ u32 pack2(float a, float b) { return (u32)f2bf(a) | ((u32)f2bf(b) << 16); }
__device__ __forceinline__ float siluf(float x) { return x / (1.f + __expf(-x)); }
__device__ __forceinline__ float sigmf(float x) { return 1.f / (1.f + __expf(-x)); }
__device__ __forceinline__ float softplusf(float x) { return x > 20.f ? x : log1pf(__expf(x)); }
__device__ __forceinline__ float logsigf(float x) { return x < -20.f ? x : -log1pf(__expf(-x)); }
__device__ __forceinline__ float wave_sum(float v) {
#pragma unroll
    for (int o = 32; o >= 1; o >>= 1) v += __shfl_xor(v, o);
    return v;
}
__device__ __forceinline__ int otid() { int t = threadIdx.x; asm volatile("" : "+v"(t)); return t; }
__device__ __forceinline__ float rdlane(float v, int l) { return __int_as_float(__builtin_amdgcn_readlane(__float_as_int(v), l)); }

__device__ __forceinline__ void phase_mods(const P& p, int bid, int nb, float* lds) {
    const int tid = otid();
    float* MODS = (float*)(p.get_ws() + WS_MODS);
    if (bid == 0 && tid < 64) ((u32*)(p.get_ws() + WS_CTL))[tid] = 0u;
    float* RC = (float*)(p.get_ws() + WS_ROPE); float* RS = RC + 256 * 16;
    for (int i = bid * NTH + tid; i < 256 * 16; i += nb * NTH) {
        const int pos = i >> 4, f = i & 15;
        const float inv = powf(10000.f, -(float)f / 16.f);
        const float ang = (float)pos * inv;
        RC[i] = cosf(ang); RS[i] = sinf(ang);
    }
    const float* c = p.in[1]; const float* cx = p.in[3];
    for (int i = tid; i < 1024; i += NTH) { const float a = c[i]; lds[i] = a / (1.f + expf(-a)); const float b = cx[i]; lds[1024 + i] = b / (1.f + expf(-b)); }
    __syncthreads();
    float* red = lds + 2048;
    const int tx = tid & 15, ty = tid >> 4;
    for (int item = bid; item < 192; item += nb) {
        const int l = item / 96, cgp = item % 96;
        const float* W = p.in[8] + (size_t)l * 1024 * 6144 + cgp * 64 + tx * 4;
        float4 ac = {0.f, 0.f, 0.f, 0.f}, ax = {0.f, 0.f, 0.f, 0.f};
#pragma unroll 8
        for (int k = ty; k < 1024; k += 32) {
            const float4 w = *(const float4*)(W + (size_t)k * 6144);
            const float sc = lds[k], sx = lds[1024 + k];
            ac.x += sc * w.x; ac.y += sc * w.y; ac.z += sc * w.z; ac.w += sc * w.w;
            ax.x += sx * w.x; ax.y += sx * w.y; ax.z += sx * w.z; ax.w += sx * w.w;
        }
        float* r = red + (ty * 16 + tx) * 8;
        r[0] = ac.x; r[1] = ac.y; r[2] = ac.z; r[3] = ac.w; r[4] = ax.x; r[5] = ax.y; r[6] = ax.z; r[7] = ax.w;
        __syncthreads();
        if (tid < 128) {
            const int col = tid & 63, which = tid >> 6;
            float s = 0.f;
            for (int y = 0; y < 32; ++y) s += red[(y * 16 + (col >> 2)) * 8 + which * 4 + (col & 3)];
            s += p.in[9][l * 6144 + cgp * 64 + col];
            MODS[(l * 2 + which) * 6144 + cgp * 64 + col] = s;
        }
        __syncthreads();
    }
}

struct RowArgs {
    int layer;
    int ffn;
    int src;
    int combine;
    int clayer;
    int final_out;
    int nrows;
    const float* wsm; int ldw; int wcol0;
    int route;
};

template <int NS> __forceinline__
__device__ __forceinline__ void phase_rows(const P& p, int bid, int nb, float* lds, const RowArgs a) {
    const int tid = otid(), lane = tid & 63, wid = tid >> 6;
    unsigned char* ws = p.get_ws();
    const float* MODS = (const float*)(ws + WS_MODS);
    float* XRES = (float*)(ws + WS_XRES);
    bf16_t* HB = (bf16_t*)(ws + WS_HB);
    float* SMALL = (float*)(ws + WS_SMALL);
    if (!a.final_out) {
        for (int i = tid; i < 1024 * NS; i += NTH) { const int k = i / NS, n = i % NS; lds[i] = a.wsm[(size_t)k * a.ldw + a.wcol0 + n]; }
    }
    __syncthreads();
    const float* gamma = (a.ffn ? p.in[7] : p.in[6]) + a.layer * 1024;
    const bf16_t* YMOE = (const bf16_t*)(ws + WS_PROJ);
    const int2* SLOT = (const int2*)(ws + WS_SLOT);
    const float2* GATE = (const float2*)(ws + WS_GATE);
    for (int row = bid * 8 + wid; row < a.nrows; row += nb * 8) {
        const int which = row >= SEQ ? 1 : 0;
        const float* src = a.src ? XRES + (size_t)row * 1024 : (which ? p.in[2] + (size_t)(row - SEQ) * 1024 : p.in[0] + (size_t)row * 1024);
        float v[16];
#pragma unroll
        for (int i = 0; i < 4; ++i) { const float4 t = *(const float4*)(src + i * 256 + lane * 4); v[i * 4] = t.x; v[i * 4 + 1] = t.y; v[i * 4 + 2] = t.z; v[i * 4 + 3] = t.w; }
        if (a.combine) {
            const int2 sl = SLOT[row]; const float2 gt = GATE[row];
            const float* gf = MODS + (a.clayer * 2 + which) * 6144 + 5 * 1024;
#pragma unroll
            for (int i = 0; i < 4; ++i) {
                const uint2 y0 = *(const uint2*)(YMOE + (size_t)sl.x * 1024 + i * 256 + lane * 4);
                const uint2 y1 = *(const uint2*)(YMOE + (size_t)sl.y * 1024 + i * 256 + lane * 4);
                const float4 g = *(const float4*)(gf + i * 256 + lane * 4);
                v[i * 4 + 0] += g.x * (gt.x * bf2f((bf16_t)(y0.x & 0xffff)) + gt.y * bf2f((bf16_t)(y1.x & 0xffff)));
                v[i * 4 + 1] += g.y * (gt.x * bf2f((bf16_t)(y0.x >> 16)) + gt.y * bf2f((bf16_t)(y1.x >> 16)));
                v[i * 4 + 2] += g.z * (gt.x * bf2f((bf16_t)(y0.y & 0xffff)) + gt.y * bf2f((bf16_t)(y1.y & 0xffff)));
                v[i * 4 + 3] += g.w * (gt.x * bf2f((bf16_t)(y0.y >> 16)) + gt.y * bf2f((bf16_t)(y1.y >> 16)));
            }
            float* dst = a.final_out ? p.get_out() + (size_t)row * 1024 : XRES + (size_t)row * 1024;
#pragma unroll
            for (int i = 0; i < 4; ++i) *(float4*)(dst + i * 256 + lane * 4) = make_float4(v[i * 4], v[i * 4 + 1], v[i * 4 + 2], v[i * 4 + 3]);
            if (a.final_out) continue;
        }
        float ss = 0.f;
#pragma unroll
        for (int j = 0; j < 16; ++j) ss += v[j] * v[j];
        ss = wave_sum(ss);
        const float rs = rsqrtf(ss * (1.f / 1024.f) + 1e-6f);
        const float* md = MODS + (a.layer * 2 + which) * 6144 + (a.ffn ? 3 * 1024 : 0);
#pragma unroll
        for (int i = 0; i < 4; ++i) {
            const float4 g = *(const float4*)(gamma + i * 256 + lane * 4);
            const float4 sh = *(const float4*)(md + i * 256 + lane * 4);
            const float4 sc = *(const float4*)(md + 1024 + i * 256 + lane * 4);
            v[i * 4 + 0] = v[i * 4 + 0] * rs * g.x * (1.f + sc.x) + sh.x;
            v[i * 4 + 1] = v[i * 4 + 1] * rs * g.y * (1.f + sc.y) + sh.y;
            v[i * 4 + 2] = v[i * 4 + 2] * rs * g.z * (1.f + sc.z) + sh.z;
            v[i * 4 + 3] = v[i * 4 + 3] * rs * g.w * (1.f + sc.w) + sh.w;
            uint2 o; o.x = pack2(v[i * 4], v[i * 4 + 1]); o.y = pack2(v[i * 4 + 2], v[i * 4 + 3]);
            *(uint2*)(HB + (size_t)row * 1024 + i * 256 + lane * 4) = o;
        }
        float s[NS];
#pragma unroll
        for (int n = 0; n < NS; ++n) s[n] = 0.f;
#pragma unroll
        for (int i = 0; i < 4; ++i)
#pragma unroll
            for (int j = 0; j < 4; ++j) {
                const float* w = lds + (i * 256 + lane * 4 + j) * NS;
                const float x = v[i * 4 + j];
#pragma unroll
                for (int n = 0; n < NS; n += 4) { const float4 ww = *(const float4*)(w + n); s[n] += x * ww.x; s[n + 1] += x * ww.y; s[n + 2] += x * ww.z; s[n + 3] += x * ww.w; }
                asm volatile("" ::: "memory");
            }
#pragma unroll
        for (int n = 0; n < NS; ++n) s[n] = wave_sum(s[n]);
        if (!a.route) {
            if (lane == 0) {
#pragma unroll
                for (int n = 0; n < NS; n += 4) *(float4*)(SMALL + (size_t)row * 32 + n) = make_float4(s[n], s[n + 1], s[n + 2], s[n + 3]);
            }
        } else if (NS == 16) {
            if (lane == 0) {
                const float* rb = p.in[5];
                float sc[16], bs[16];
#pragma unroll
                for (int n = 0; n < 16; ++n) { sc[n] = 1.f / (1.f + expf(-s[n])); bs[n] = sc[n] + rb[n]; }
                int bg = 0; float bgs = -1e30f;
#pragma unroll
                for (int g = 0; g < 4; ++g) {
                    float m1 = -1e30f, m2 = -1e30f;
#pragma unroll
                    for (int j = 0; j < 4; ++j) { const float x = bs[g * 4 + j]; if (x > m1) { m2 = m1; m1 = x; } else if (x > m2) m2 = x; }
                    const float gs = m1 + m2;
                    if (gs > bgs) { bgs = gs; bg = g; }
                }
                int e0 = 0, e1 = 0; float b0 = -1e30f, b1 = -1e30f;
#pragma unroll
                for (int j = 0; j < 4; ++j) {
                    float x = 0.f; int e = 0;
#pragma unroll
                    for (int g = 0; g < 4; ++g) if (g == bg) { x = bs[g * 4 + j]; e = g * 4 + j; }
                    if (x > b0) { b1 = b0; e1 = e0; b0 = x; e0 = e; } else if (x > b1) { b1 = x; e1 = e; }
                }
                float w0 = 0.f, w1 = 0.f;
#pragma unroll
                for (int n = 0; n < 16; ++n) { if (n == e0) w0 = sc[n]; if (n == e1) w1 = sc[n]; }
                const float inv = 1.f / (w0 + w1);
                u32* cnt = (u32*)(ws + WS_CTL) + CW_CNT + a.layer * 16;
                const int p0 = (int)atomicAdd(cnt + e0, 1u), p1 = (int)atomicAdd(cnt + e1, 1u);
                ((int4*)(ws + WS_ROUTE))[row] = make_int4(e0, p0, e1, p1);
                ((float2*)(ws + WS_GATE))[row] = make_float2(w0 * inv, w1 * inv);
            }
        }
    }
}

__device__ __forceinline__ void phase_lists(const P& p, int bid, int nb, int layer, int nrows) {
    const int tid = otid();
    unsigned char* ws = p.get_ws();
    const u32* cnt = (const u32*)(ws + WS_CTL) + CW_CNT + layer * 16;
    int off[17]; off[0] = 0;
#pragma unroll
    for (int e = 0; e < 16; ++e) off[e + 1] = off[e] + (int)((cnt[e] + 255u) / 256u) * 256;
    int* LIST = (int*)(ws + WS_LIST); int2* SLOT = (int2*)(ws + WS_SLOT); int* TEXP = (int*)(ws + WS_TEXP);
    const int4* ROUTE = (const int4*)(ws + WS_ROUTE);
    for (int row = bid * NTH + tid; row < nrows; row += nb * NTH) {
        const int4 r = ROUTE[row];
        int o0 = 0, o1 = 0;
#pragma unroll
        for (int e = 0; e < 16; ++e) { if (e == r.x) o0 = off[e]; if (e == r.z) o1 = off[e]; }
        const int s0 = o0 + r.y, s1 = o1 + r.w;
        LIST[s0] = row; LIST[s1] = row; SLOT[row] = make_int2(s0, s1);
    }
    if (bid == 0) {
        for (int e = 0; e < 16; ++e) {
            const int c = (int)cnt[e];
            for (int i = off[e] + c + tid; i < off[e + 1]; i += NTH) LIST[i] = 0;
            for (int t = off[e] / 256 + tid; t < off[e + 1] / 256; t += NTH) TEXP[t] = e;
        }
        if (tid == 0) TEXP[255] = off[16] / 256;
    }
}

template <class AF, class WF, class EF>
__device__ __forceinline__ void gemm_naive(int ntm, int ntn, int K, int bid, int nb, float* lds, const AF& af, const WF& wf, const EF& ef) {
    const int tid = otid(), tx = tid & 15, ty = tid >> 4;
    float* As = lds;
    float* Bs = lds + 16 * 132;
    for (int t = bid; t < ntm * ntn; t += nb) {
        const int tm = t / ntn, tn = t % ntn;
        float acc[4][8];
#pragma unroll
        for (int i = 0; i < 4; ++i)
#pragma unroll
            for (int j = 0; j < 8; ++j) acc[i][j] = 0.f;
        const int lr = tid >> 2, lk = (tid & 3) * 4;
        const bf16_t* arow = af(tm * 128 + lr);
        const int bk = tid >> 5, bn = (tid & 31) * 4;
        for (int k0 = 0; k0 < K; k0 += 16) {
            const uint2 av = *(const uint2*)(arow + k0 + lk);
            const float4 bv = *(const float4*)wf(k0 + bk, tn * 128 + bn);
            __syncthreads();
            As[(lk + 0) * 132 + lr] = bf2f((bf16_t)(av.x & 0xffff)); As[(lk + 1) * 132 + lr] = bf2f((bf16_t)(av.x >> 16));
            As[(lk + 2) * 132 + lr] = bf2f((bf16_t)(av.y & 0xffff)); As[(lk + 3) * 132 + lr] = bf2f((bf16_t)(av.y >> 16));
            *(float4*)(Bs + bk * 132 + bn) = make_float4(bf2f(f2bf(bv.x)), bf2f(f2bf(bv.y)), bf2f(f2bf(bv.z)), bf2f(f2bf(bv.w)));
            __syncthreads();
#pragma unroll
            for (int k = 0; k < 16; ++k) {
                const float4 a4 = *(const float4*)(As + k * 132 + ty * 4);
                const float4 b0 = *(const float4*)(Bs + k * 132 + tx * 8), b1 = *(const float4*)(Bs + k * 132 + tx * 8 + 4);
                const float aa[4] = {a4.x, a4.y, a4.z, a4.w}; const float bb[8] = {b0.x, b0.y, b0.z, b0.w, b1.x, b1.y, b1.z, b1.w};
#pragma unroll
                for (int i = 0; i < 4; ++i)
#pragma unroll
                    for (int j = 0; j < 8; ++j) acc[i][j] += aa[i] * bb[j];
            }
        }
#pragma unroll
        for (int i = 0; i < 4; ++i) ef(tm * 128 + ty * 4 + i, tn * 128 + tx * 8, acc[i]);
    }
}

struct ARowPlain { const bf16_t* A; int ld; __device__ const bf16_t* operator()(int m) const { return A + (size_t)m * ld; } };
struct ARowGather { const bf16_t* A; int ld; const int* list; __device__ const bf16_t* operator()(int m) const { return A + (size_t)list[m] * ld; } };
struct WEven { const float* W; __device__ const float* operator()(int k, int n) const { return W + (size_t)k * EV_IN + (n < 1280 ? n : n + 16); } };
struct WPlain { const float* W; int ldw; __device__ const float* operator()(int k, int n) const { return W + (size_t)k * ldw + n; } };
struct WMoe13 { const float* W1; long long d13;
    __device__ const float* operator()(int k, int n) const { const int j = (n >> 3) * 4 + (n & 3); return W1 + ((n & 4) ? d13 : 0ll) + (size_t)k * DE + j; } };
struct EpiBf16Store { bf16_t* C; int ld; __device__ void operator()(int r, int c0, const float* v) const {
    uint4 o; o.x = pack2(v[0], v[1]); o.y = pack2(v[2], v[3]); o.z = pack2(v[4], v[5]); o.w = pack2(v[6], v[7]); *(uint4*)(C + (size_t)r * ld + c0) = o; } };
struct EpiResid { const float* xlat; const float* xctx; float* XRES; const float* gl; const float* gc;
    __device__ void operator()(int r, int c0, const float* v) const {
        const float* xin = xctx && r >= SEQ ? xctx + (size_t)(r - SEQ) * 1024 : xlat + (size_t)r * 1024;
        const float* g = r >= SEQ ? gc : gl;
        const float4 x0 = *(const float4*)(xin + c0), x1 = *(const float4*)(xin + c0 + 4), g0 = *(const float4*)(g + c0), g1 = *(const float4*)(g + c0 + 4);
        *(float4*)(XRES + (size_t)r * 1024 + c0) = make_float4(x0.x + g0.x * v[0], x0.y + g0.y * v[1], x0.z + g0.z * v[2], x0.w + g0.w * v[3]);
        *(float4*)(XRES + (size_t)r * 1024 + c0 + 4) = make_float4(x1.x + g1.x * v[4], x1.y + g1.y * v[5], x1.z + g1.z * v[6], x1.w + g1.w * v[7]);
    } };
struct EpiSwiglu { bf16_t* H; __device__ void operator()(int r, int c0, const float* v) const {
    uint2 o; o.x = pack2(siluf(v[0]) * v[4], siluf(v[1]) * v[5]); o.y = pack2(siluf(v[2]) * v[6], siluf(v[3]) * v[7]); *(uint2*)(H + (size_t)r * DE + (c0 >> 3) * 4) = o; } };

__device__ __forceinline__ void phase_moe1_naive(const P& p, int bid, int nb, float* lds, int layer) {
    unsigned char* ws = p.get_ws(); const int* TEXP = (const int*)(ws + WS_TEXP); const int nt256 = TEXP[255];
    const int* LIST = (const int*)(ws + WS_LIST);
    for (int e = 0; e < 16; ++e) {
        int t0 = -1, t1 = -1;
        for (int t = 0; t < nt256; ++t) if (TEXP[t] == e) { if (t0 < 0) t0 = t; t1 = t + 1; }
        if (t0 < 0) continue;
        const int ntm = (t1 - t0) * 2;
        ARowGather af{(const bf16_t*)(ws + WS_HB), 1024, LIST + t0 * 256};
        WMoe13 wf{p.in[28] + ((size_t)layer * 16 + e) * 1024 * DE, (long long)(p.in[29] - p.in[28])};
        EpiSwiglu ef{(bf16_t*)(ws + WS_Y) + (size_t)t0 * 256 * DE};
        const int rb = (bid + e * 37) % nb;
        gemm_naive(ntm, 8, 1024, rb, nb, lds, af, wf, ef);
    }
}
__device__ __forceinline__ void phase_moe2_naive(const P& p, int bid, int nb, float* lds, int layer) {
    unsigned char* ws = p.get_ws(); const int* TEXP = (const int*)(ws + WS_TEXP); const int nt256 = TEXP[255];
    for (int e = 0; e < 16; ++e) {
        int t0 = -1, t1 = -1;
        for (int t = 0; t < nt256; ++t) if (TEXP[t] == e) { if (t0 < 0) t0 = t; t1 = t + 1; }
        if (t0 < 0) continue;
        const int ntm = (t1 - t0) * 2;
        ARowPlain af{(const bf16_t*)(ws + WS_Y) + (size_t)t0 * 256 * DE, DE};
        WPlain wf{p.in[30] + ((size_t)layer * 16 + e) * DE * 1024, 1024};
        EpiBf16Store ef{(bf16_t*)(ws + WS_PROJ) + (size_t)t0 * 256 * 1024, 1024};
        const int rb = (bid + e * 37) % nb;
        gemm_naive(ntm, 8, DE, rb, nb, lds, af, wf, ef);
    }
}

__device__ __forceinline__ void phase_qkprep(const P& p, int bid, int nb) {
    const int tid = otid(), lane = tid & 63, wid = tid >> 6;
    unsigned char* ws = p.get_ws();
    const bf16_t* PROJ = (const bf16_t*)(ws + WS_PROJ);
    bf16_t* QKR = (bf16_t*)(ws + WS_XRES);
    const float* RC = (const float*)(ws + WS_ROPE); const float* RS = RC + 256 * 16;
    const float qn = p.in[17][lane], kn = p.in[18][lane];
    for (int row = bid * 8 + wid; row < MT; row += nb * 8) {
        const bool lat = row < SEQ;
        const int pos = lane < 32 ? (row >> 6) : (row & 63);
        const int f = lane & 15;
        const float cs = lat ? RC[pos * 16 + f] : 1.f, sn = lat ? RS[pos * 16 + f] : 0.f;
        for (int h = 0; h < 10; ++h) {
            const float x = bf2f(PROJ[(size_t)row * 2048 + 1280 + h * 64 + lane]);
            const float ss = wave_sum(x * x);
            const float y = x * rsqrtf(ss * (1.f / 64.f) + 1e-6f) * (h < 8 ? qn : kn);
            const float o = __shfl_xor(y, 16);
            const float r = ((lane & 16) == 0) ? y * cs - o * sn : o * sn + y * cs;
            QKR[(size_t)row * 640 + h * 64 + lane] = f2bf(r);
        }
    }
}

__device__ __forceinline__ void ssd_scan_naive(const P& p, int dh, float* lds) {
    const int lane = otid() & 63;
    const int d = dh >> 3, h = dh & 7, g = h >> 2;
    unsigned char* ws = p.get_ws();
    const bf16_t* PROJ = (const bf16_t*)(ws + WS_PROJ);
    const float* SMALL = (const float*)(ws + WS_SMALL);
    float* Y = (float*)(ws + WS_Y) + (size_t)d * MT * 512;
    const float* cw = p.in[11]; const float* cb = p.in[12];
    const int chx = h * 64 + lane, chb = 512 + g * 64 + lane, chc = 640 + g * 64 + lane;
    const float wx0 = cw[chx], wx1 = cw[768 + chx], wx2 = cw[1536 + chx], bx = cb[chx];
    const float wb0 = cw[chb], wb1 = cw[768 + chb], wb2 = cw[1536 + chb], bb = cb[chb];
    const float wc0 = cw[chc], wc1 = cw[768 + chc], wc2 = cw[1536 + chc], bc = cb[chc];
    const float A = -expf(p.in[14][d * 8 + h]);
    const float dtb = p.in[13][d * 8 + h];
    float st[64];
#pragma unroll
    for (int n = 0; n < 64; ++n) st[n] = 0.f;
    float* tx = lds;
    float* tb = lds + 66 * 64;
    float* tc = lds + 2 * 66 * 64;
    float* tdt = lds + 3 * 66 * 64;
    for (int seg = 0; seg < 2; ++seg) {
        const int L = seg == 0 ? CTX : SEQ, base = seg == 0 ? SEQ : 0;
        for (int k = 0; k < L / 64; ++k) {
            const int tbs = d ? L - 64 - k * 64 : k * 64;
            for (int r = 0; r < 66; ++r) {
                const int t = tbs - 1 + r;
                float vx = 0.f, vb = 0.f, vc = 0.f;
                if (t >= 0 && t < L) { const bf16_t* pr = PROJ + (size_t)(base + t) * 2048 + 512; vx = bf2f(pr[chx]); vb = bf2f(pr[chb]); vc = bf2f(pr[chc]); }
                tx[r * 64 + lane] = vx; tb[r * 64 + lane] = vb; tc[r * 64 + lane] = vc;
            }
            { const float dtr = SMALL[(size_t)(base + tbs + lane) * 32 + d * 8 + h] + dtb; const float dt = softplusf(dtr); tdt[lane] = dt; tdt[64 + lane] = __expf(dt * A); }
            __builtin_amdgcn_s_waitcnt(0);
            __builtin_amdgcn_wave_barrier();
            for (int s = 0; s < 64; ++s) {
                const int tl = d ? 63 - s : s; const int r = tl + 1;
                const float xv = siluf(wx0 * tx[(r - 1) * 64 + lane] + wx1 * tx[r * 64 + lane] + wx2 * tx[(r + 1) * 64 + lane] + bx);
                const float bv = siluf(wb0 * tb[(r - 1) * 64 + lane] + wb1 * tb[r * 64 + lane] + wb2 * tb[(r + 1) * 64 + lane] + bb);
                const float cv = siluf(wc0 * tc[(r - 1) * 64 + lane] + wc1 * tc[r * 64 + lane] + wc2 * tc[(r + 1) * 64 + lane] + bc);
                const float dt = tdt[tl], a = tdt[64 + tl];
                const float xd = xv * dt;
                float y = 0.f;
#pragma unroll
                for (int n = 0; n < 64; ++n) { st[n] = a * st[n] + xd * rdlane(bv, n); y += rdlane(cv, n) * st[n]; }
                Y[(size_t)(base + tbs + tl) * 512 + h * 64 + lane] = y;
            }
            __builtin_amdgcn_wave_barrier();
        }
    }
}

__device__ __forceinline__ void attn_naive_item(const P& p, int row, int hq, int half) {
    unsigned char* ws = p.get_ws();
    const bf16_t* PROJ = (const bf16_t*)(ws + WS_PROJ);
    const bf16_t* QKR = (const bf16_t*)(ws + WS_XRES);
    bf16_t* MIX = (bf16_t*)(ws + WS_HB);
    const int g = hq >> 2;
    float q[64], o[32];
    { const bf16_t* qp = QKR + (size_t)row * 640 + hq * 64;
#pragma unroll
      for (int dd = 0; dd < 64; ++dd) q[dd] = bf2f(qp[dd]) * 0.125f;
#pragma unroll
      for (int dd = 0; dd < 32; ++dd) o[dd] = 0.f; }
    const float sink = p.in[19][hq];
    float m = sink, l = 1.f;
    const bool lat = row < SEQ;
    int j0 = 0, j1 = -1;
    if (lat) { j0 = row - 128 < 0 ? 0 : row - 128; j1 = row + 128 > SEQ - 1 ? SEQ - 1 : row + 128; }
    const int nloc = j1 - j0 + 1;
    for (int jj = 0; jj < nloc + CTX; ++jj) {
        const int kr = jj < nloc ? j0 + jj : SEQ + (jj - nloc);
        const bf16_t* kp = QKR + (size_t)kr * 640 + 512 + g * 64;
        float s = 0.f;
#pragma unroll
        for (int dd = 0; dd < 64; dd += 2) { const u32 w = *(const u32*)(kp + dd); s += q[dd] * bf2f((bf16_t)(w & 0xffff)) + q[dd + 1] * bf2f((bf16_t)(w >> 16)); }
        const float mn = fmaxf(m, s);
        const float al = __expf(m - mn), pe = __expf(s - mn);
        l = l * al + pe; m = mn;
        const bf16_t* vp = PROJ + (size_t)kr * 2048 + 1920 + g * 64 + half * 32;
#pragma unroll
        for (int dd = 0; dd < 32; dd += 2) { const u32 w = *(const u32*)(vp + dd); o[dd] = o[dd] * al + pe * bf2f((bf16_t)(w & 0xffff)); o[dd + 1] = o[dd + 1] * al + pe * bf2f((bf16_t)(w >> 16)); }
    }
    const float inv = 1.f / l;
    bf16_t* op = MIX + (size_t)row * 1024 + 512 + hq * 64 + half * 32;
#pragma unroll
    for (int dd = 0; dd < 32; dd += 2) *(u32*)(op + dd) = pack2(o[dd] * inv, o[dd + 1] * inv);
}

__device__ __forceinline__ void phase_mix0_naive(const P& p, int bid, int nb, float* lds) {
    const int tid = otid(), wid = tid >> 6;
    const bool scanner = bid < 16 && wid == 0;
    if (scanner) { ssd_scan_naive(p, bid, lds); return; }
    const int nwaves = nb * 8 - 16;
    const int wv = bid < 16 ? bid * 7 + (wid - 1) : 16 * 7 + (bid - 16) * 8 + wid;
    for (int it = wv * 64 + (tid & 63); it < MT * 16; it += nwaves * 64) attn_naive_item(p, it >> 4, (it >> 1) & 7, it & 1);
}

__device__ __forceinline__ void phase_ssdout(const P& p, int bid, int nb) {
    const int tid = otid(), lane = tid & 63, wid = tid >> 6;
    unsigned char* ws = p.get_ws();
    const bf16_t* PROJ = (const bf16_t*)(ws + WS_PROJ);
    const float* Y0 = (const float*)(ws + WS_Y); const float* Y1 = Y0 + (size_t)MT * 512;
    bf16_t* MIX = (bf16_t*)(ws + WS_HB);
    const float* cw = p.in[11]; const float* cb = p.in[12];
    for (int row = bid * 8 + wid; row < MT; row += nb * 8) {
        const bool lat = row < SEQ; const int t = lat ? row : row - SEQ, L = lat ? SEQ : CTX;
        float u[8]; float ss = 0.f;
#pragma unroll
        for (int j = 0; j < 8; ++j) {
            const int c = lane * 8 + j;
            const float xm = t > 0 ? bf2f(PROJ[(size_t)(row - 1) * 2048 + 512 + c]) : 0.f;
            const float x0 = bf2f(PROJ[(size_t)row * 2048 + 512 + c]);
            const float xp = t < L - 1 ? bf2f(PROJ[(size_t)(row + 1) * 2048 + 512 + c]) : 0.f;
            const float xs = siluf(cw[c] * xm + cw[768 + c] * x0 + cw[1536 + c] * xp + cb[c]);
            const float y = Y0[(size_t)row * 512 + c] + Y1[(size_t)row * 512 + c] + p.in[15][c >> 6] * xs;
            const float z = bf2f(PROJ[(size_t)row * 2048 + c]);
            u[j] = y * siluf(z); ss += u[j] * u[j];
        }
        ss = wave_sum(ss);
        const float rs = rsqrtf(ss * (1.f / 512.f) + 1e-6f);
#pragma unroll
        for (int j = 0; j < 8; ++j) { const int c = lane * 8 + j; MIX[(size_t)row * 1024 + c] = f2bf(u[j] * rs * p.in[16][c]); }
    }
}

__device__ __forceinline__ void mlstm_scan_naive(const P& p, int item, float* lds) {
    const int lane = otid() & 63;
    const int d = item >> 4, h = (item >> 1) & 7, half = item & 1;
    unsigned char* ws = p.get_ws();
    const bf16_t* PROJ = (const bf16_t*)(ws + WS_PROJ);
    const float* SMALL = (const float*)(ws + WS_SMALL);
    bf16_t* Y = (bf16_t*)(ws + WS_Y) + (size_t)d * MT * 1024;
    const float* cw = p.in[22]; const float* cb = p.in[23];
    const int chq = h * 64 + lane, chk = 512 + h * 64 + lane, chv = 1024 + h * 128 + half * 64 + lane;
    const float wq0 = cw[chq], wq1 = cw[2048 + chq], wq2 = cw[4096 + chq], bq = cb[chq];
    const float wk0 = cw[chk], wk1 = cw[2048 + chk], wk2 = cw[4096 + chk], bk = cb[chk];
    const float wv0 = cw[chv], wv1 = cw[2048 + chv], wv2 = cw[4096 + chv], bv = cb[chv];
    const float igb = p.in[24][d * 8 + h], fgb = p.in[25][d * 8 + h];
    float C[64], nn[64];
#pragma unroll
    for (int n = 0; n < 64; ++n) { C[n] = 0.f; nn[n] = 0.f; }
    float m = 0.f;
    float* tq = lds; float* tk = lds + 66 * 64; float* tv = lds + 2 * 66 * 64; float* tg = lds + 3 * 66 * 64;
    for (int seg = 0; seg < 2; ++seg) {
        const int L = seg == 0 ? CTX : SEQ, base = seg == 0 ? SEQ : 0;
        for (int k = 0; k < L / 64; ++k) {
            const int tbs = d ? L - 64 - k * 64 : k * 64;
            for (int r = 0; r < 66; ++r) {
                const int t = tbs - 1 + r;
                float vq = 0.f, vk = 0.f, vv = 0.f;
                if (t >= 0 && t < L) { const bf16_t* pr = PROJ + (size_t)(base + t) * 3072; vq = bf2f(pr[chq]); vk = bf2f(pr[chk]); vv = bf2f(pr[chv]); }
                tq[r * 64 + lane] = vq; tk[r * 64 + lane] = vk; tv[r * 64 + lane] = vv;
            }
            { const float* sm = SMALL + (size_t)(base + tbs + lane) * 32; tg[lane] = sm[d * 8 + h] + igb; tg[64 + lane] = logsigf(sm[16 + d * 8 + h] + fgb); }
            __builtin_amdgcn_s_waitcnt(0);
            __builtin_amdgcn_wave_barrier();
            for (int s = 0; s < 64; ++s) {
                const int tl = d ? 63 - s : s; const int r = tl + 1;
                const float qv = siluf(wq0 * tq[(r - 1) * 64 + lane] + wq1 * tq[r * 64 + lane] + wq2 * tq[(r + 1) * 64 + lane] + bq);
                const float kv = siluf(wk0 * tk[(r - 1) * 64 + lane] + wk1 * tk[r * 64 + lane] + wk2 * tk[(r + 1) * 64 + lane] + bk) * 0.125f;
                const float vv = siluf(wv0 * tv[(r - 1) * 64 + lane] + wv1 * tv[r * 64 + lane] + wv2 * tv[(r + 1) * 64 + lane] + bv);
                const float ig = tg[tl], lf = tg[64 + tl];
                const float mn = fmaxf(lf + m, ig);
                const float fs = __expf(lf + m - mn), is = __expf(ig - mn);
                m = mn;
                const float iv = is * vv;
                float num = 0.f, den = 0.f;
#pragma unroll
                for (int n = 0; n < 64; ++n) {
                    const float kb = rdlane(kv, n), qb = rdlane(qv, n);
                    C[n] = fs * C[n] + kb * iv; nn[n] = fs * nn[n] + is * kb;
                    num += qb * C[n]; den += qb * nn[n];
                }
                const float hv = num / fmaxf(fabsf(den), __expf(-mn));
                Y[(size_t)(base + tbs + tl) * 1024 + h * 128 + half * 64 + lane] = f2bf(hv);
            }
            __builtin_amdgcn_wave_barrier();
        }
    }
}
__device__ __forceinline__ void phase_mix1_naive(const P& p, int bid, int nb, float* lds) {
    const int wid = otid() >> 6;
    if (bid < 32 && wid == 0) mlstm_scan_naive(p, bid, lds);
}
__device__ __forceinline__ void phase_mlstmout(const P& p, int bid, int nb) {
    const int tid = otid(), lane = tid & 63, wid = tid >> 6;
    unsigned char* ws = p.get_ws();
    const bf16_t* PROJ = (const bf16_t*)(ws + WS_PROJ);
    const bf16_t* Y0 = (const bf16_t*)(ws + WS_Y); const bf16_t* Y1 = Y0 + (size_t)MT * 1024;
    bf16_t* MIX = (bf16_t*)(ws + WS_HB);
    for (int row = bid * 8 + wid; row < SEQ; row += nb * 8) {
        float v[16]; float ss = 0.f;
#pragma unroll
        for (int j = 0; j < 16; ++j) { const int c = lane * 16 + j; v[j] = bf2f(Y0[(size_t)row * 1024 + c]) + bf2f(Y1[(size_t)row * 1024 + c]); ss += v[j] * v[j]; }
        ss += __shfl_xor(ss, 1); ss += __shfl_xor(ss, 2); ss += __shfl_xor(ss, 4);
        const float rs = rsqrtf(ss * (1.f / 128.f) + 1e-6f);
#pragma unroll
        for (int j = 0; j < 16; ++j) { const int c = lane * 16 + j; const float o = bf2f(PROJ[(size_t)row * 3072 + 2048 + c]); MIX[(size_t)row * 1024 + c] = f2bf(v[j] * rs * p.in[26][c] * sigmf(o)); }
    }
}

#define GSYNC() grid.sync()
__global__ void __launch_bounds__(NTH, 2) fwd_kernel(PK pk) {
    P p;
    extern __shared__ __attribute__((aligned(16))) unsigned char smem[];
    float* lds = (float*)smem;
    cg::grid_group grid = cg::this_grid();
    const int bid = blockIdx.x, nb = gridDim.x;
    int nph = NPH_RUN; asm volatile("" : "+s"(nph));
#pragma unroll 1
    for (int ph = 0; ph < nph; ++ph) {
        unsigned char* ws = p.get_ws();
        const float* MODS = (const float*)(ws + WS_MODS);
        switch (ph) {
        case 0: {
            phase_mods(p, bid, nb, lds);
        } break;
        case 1: {
            { RowArgs a{}; a.layer = 0; a.ffn = 0; a.src = 0; a.nrows = MT; a.wsm = p.in[10]; a.ldw = EV_IN; a.wcol0 = 1280; phase_rows<16>(p, bid, nb, lds, a); }
        } break;
        case 2: {
            { ARowPlain af{(const bf16_t*)(ws + WS_HB), 1024}; WEven wf{p.in[10]}; EpiBf16Store ef{(bf16_t*)(ws + WS_PROJ), 2048};
              gemm_naive(MT / 128, 2048 / 128, 1024, bid, nb, lds, af, wf, ef); }
        } break;
        case 3: {
            phase_qkprep(p, bid, nb);
        } break;
        case 4: {
            phase_mix0_naive(p, bid, nb, lds);
        } break;
        case 5: {
            phase_ssdout(p, bid, nb);
        } break;
        case 6: {
            { ARowPlain af{(const bf16_t*)(ws + WS_HB), 1024}; WPlain wf{p.in[20], 1024};
              EpiResid ef{p.in[0], p.in[2], (float*)(ws + WS_XRES), MODS + (0 * 2 + 0) * 6144 + 2048, MODS + (0 * 2 + 1) * 6144 + 2048};
              gemm_naive(MT / 128, 8, 1024, bid, nb, lds, af, wf, ef); }
        } break;
        case 7: {
            { RowArgs a{}; a.layer = 0; a.ffn = 1; a.src = 1; a.nrows = MT; a.wsm = p.in[4]; a.ldw = 16; a.wcol0 = 0; a.route = 1; phase_rows<16>(p, bid, nb, lds, a); }
        } break;
        case 8: {
            phase_lists(p, bid, nb, 0, MT);
        } break;
        case 9: {
            phase_moe1_naive(p, bid, nb, lds, 0);
        } break;
        case 10: {
            phase_moe2_naive(p, bid, nb, lds, 0);
        } break;
        case 11: {
            { RowArgs a{}; a.layer = 1; a.ffn = 0; a.src = 1; a.combine = 1; a.clayer = 0; a.nrows = MT; a.wsm = p.in[21]; a.ldw = OD_IN; a.wcol0 = 3072; phase_rows<32>(p, bid, nb, lds, a); }
        } break;
        case 12: {
            { ARowPlain af{(const bf16_t*)(ws + WS_HB), 1024}; WPlain wf{p.in[21], OD_IN}; EpiBf16Store ef{(bf16_t*)(ws + WS_PROJ), 3072};
              gemm_naive(MT / 128, 3072 / 128, 1024, bid, nb, lds, af, wf, ef); }
        } break;
        case 13: {
            phase_mix1_naive(p, bid, nb, lds);
        } break;
        case 14: {
            phase_mlstmout(p, bid, nb);
        } break;
        case 15: {
            { ARowPlain af{(const bf16_t*)(ws + WS_HB), 1024}; WPlain wf{p.in[27], 1024};
              EpiResid ef{(const float*)(ws + WS_XRES), nullptr, (float*)(ws + WS_XRES), MODS + (1 * 2 + 0) * 6144 + 2048, MODS + (1 * 2 + 0) * 6144 + 2048};
              gemm_naive(SEQ / 128, 8, 1024, bid, nb, lds, af, wf, ef); }
        } break;
        case 16: {
            { RowArgs a{}; a.layer = 1; a.ffn = 1; a.src = 1; a.nrows = SEQ; a.wsm = p.in[4]; a.ldw = 16; a.wcol0 = 0; a.route = 1; phase_rows<16>(p, bid, nb, lds, a); }
        } break;
        case 17: {
            phase_lists(p, bid, nb, 1, SEQ);
        } break;
        case 18: {
            phase_moe1_naive(p, bid, nb, lds, 1);
        } break;
        case 19: {
            phase_moe2_naive(p, bid, nb, lds, 1);
        } break;
        case 20: {
            { RowArgs a{}; a.layer = 1; a.src = 1; a.combine = 1; a.clayer = 1; a.final_out = 1; a.nrows = SEQ; phase_rows<16>(p, bid, nb, lds, a); }
        } break;
        default: break;
        }
        if (ph + 1 < nph) grid.sync();
    }
}

constexpr int LDS_BYTES = 140 * 1024;

extern "C" void kernel_launch(void* const* d_in, const int* in_sizes, int n_in, void* d_out, int out_size, void* d_ws, size_t ws_size, hipStream_t stream) {
    static int grid = 0;
    if (grid == 0) {
        if (n_in != 31 || ws_size < WS_END) { fprintf(stderr, "kernel_launch: unexpected n_in %d or ws_size %zu < %zu\n", n_in, ws_size, (size_t)WS_END); grid = -1; return; }
        int dev = 0, cus = 0, per_cu = 0;
        hipGetDevice(&dev);
        hipDeviceGetAttribute(&cus, hipDeviceAttributeMultiprocessorCount, dev);
        hipFuncSetAttribute((const void*)fwd_kernel, hipFuncAttributeMaxDynamicSharedMemorySize, LDS_BYTES);
        hipOccupancyMaxActiveBlocksPerMultiprocessor(&per_cu, (const void*)fwd_kernel, NTH, LDS_BYTES);
        if (per_cu < 1) { fprintf(stderr, "kernel_launch: occupancy query says %d blocks per CU\n", per_cu); per_cu = 1; }
        grid = cus;
    }
    if (grid < 0) return;
    PK p{};
    for (int i = 0; i < 31; ++i) p.in[i] = (const float*)d_in[i];
    p.out = (float*)d_out; p.ws = (unsigned char*)d_ws;
    void* args[] = {&p};
    hipError_t e = hipLaunchCooperativeKernel((const void*)fwd_kernel, dim3(grid), dim3(NTH), args, LDS_BYTES, stream);
    if (e != hipSuccess) fprintf(stderr, "cooperative launch failed: %s (grid %d)\n", hipGetErrorString(e), grid);
}
```

```cpp
#include <hip/hip_runtime.h>
#include <hip/hip_cooperative_groups.h>
#include <cstdio>
namespace cg = cooperative_groups;

typedef unsigned short bf16_t;
typedef unsigned int u32;

constexpr int D = 1024, SEQ = 16384, CTX = 256, MT = SEQ + CTX;
constexpr int NTH = 512;
#ifndef NPH_RUN
#define NPH_RUN 21
#endif
constexpr int EV_IN = 2064, OD_IN = 3104;
constexpr int NE = 16, DE = 512;
constexpr int MAXTILES = 146, MAXSLOTS = MAXTILES * 256;

constexpr size_t al256(size_t x) { return (x + 255) & ~(size_t)255; }
constexpr size_t WS_CTL   = 0;
constexpr size_t WS_MODS  = 65536;
constexpr size_t WS_ROPE  = WS_MODS + al256(2 * 2 * 6144 * 4);
constexpr size_t WS_SMALL = WS_ROPE + al256(2 * 256 * 16 * 4);
constexpr size_t WS_ROUTE = WS_SMALL + al256((size_t)MT * 32 * 4);
constexpr size_t WS_GATE  = WS_ROUTE + al256((size_t)MT * 16);
constexpr size_t WS_SLOT  = WS_GATE + al256((size_t)MT * 8);
constexpr size_t WS_LIST  = WS_SLOT + al256((size_t)MT * 8);
constexpr size_t WS_TEXP  = WS_LIST + al256((size_t)MAXSLOTS * 4);
constexpr size_t WS_WIN0  = WS_TEXP + 1024;
constexpr size_t WS_WIN1  = WS_WIN0 + (size_t)2048 * 1024 * 2;
constexpr size_t WS_WOUT0 = WS_WIN1 + (size_t)3072 * 1024 * 2;
constexpr size_t WS_WOUT1 = WS_WOUT0 + (size_t)1024 * 1024 * 2;
constexpr size_t WS_WMOE  = WS_WOUT1 + (size_t)1024 * 1024 * 2;
constexpr size_t WS_XRES  = WS_WMOE + (size_t)16 * 1024 * 1024 * 2 + (size_t)16 * 1024 * 512 * 2;
constexpr size_t WS_HB    = WS_XRES + (size_t)MT * 1024 * 4;
constexpr size_t WS_PROJ  = WS_HB + (size_t)MT * 1024 * 2;
constexpr size_t WS_Y     = WS_PROJ + (size_t)MT * 3072 * 2;
constexpr size_t WS_END   = WS_Y + (size_t)MT * 1024 * 4;
static_assert(WS_END < 349000000, "workspace too large");

constexpr int CW_CNT = 0;

struct PK { const float* in[31]; float* out; unsigned char* ws; };
typedef __attribute__((address_space(4))) const unsigned char* kaptr_t;
struct InTab { __device__ __forceinline__ const float* operator[](int i) const {
    kaptr_t ka = (kaptr_t)__builtin_amdgcn_kernarg_segment_ptr(); asm volatile("" : "+s"(ka)); return *(const float* __attribute__((address_space(4))) const*)(ka + i * 8); } };
struct P { InTab in;
    __device__ __forceinline__ float* get_out() const { kaptr_t ka = (kaptr_t)__builtin_amdgcn_kernarg_segment_ptr(); asm volatile("" : "+s"(ka)); return *(float* __attribute__((address_space(4))) const*)(ka + 31 * 8); }
    __device__ __forceinline__ unsigned char* get_ws() const { kaptr_t ka = (kaptr_t)__builtin_amdgcn_kernarg_segment_ptr(); asm volatile("" : "+s"(ka)); return *(unsigned char* __attribute__((address_space(4))) const*)(ka + 32 * 8); } };

__device__ __forceinline__ float bf2f(bf16_t b) { return __uint_as_float((u32)b << 16); }
__device__ __forceinline__ bf16_t f2bf(float f) { u32 u = __float_as_uint(f); u += 0x7FFFu + ((u >> 16) & 1u); return (bf16_t)(u >> 16); }
__device__ __forceinline__ u32 pack2(float a, float b) { return (u32)f2bf(a) | ((u32)f2bf(b) << 16); }
__device__ __forceinline__ float siluf(float x) { return x / (1.f + __expf(-x)); }
__device__ __forceinline__ float sigmf(float x) { return 1.f / (1.f + __expf(-x)); }
__device__ __forceinline__ float softplusf(float x) { return x > 20.f ? x : log1pf(__expf(x)); }
__device__ __forceinline__ float logsigf(float x) { return x < -20.f ? x : -log1pf(__expf(-x)); }
__device__ __forceinline__ float wave_sum(float v) {
#pragma unroll
    for (int o = 32; o >= 1; o >>= 1) v += __shfl_xor(v, o);
    return v;
}
__device__ __forceinline__ int otid() { int t = threadIdx.x; asm volatile("" : "+v"(t)); return t; }
__device__ __forceinline__ float rdlane(float v, int l) { return __int_as_float(__builtin_amdgcn_readlane(__float_as_int(v), l)); }

__device__ __forceinline__ void phase_mods(const P& p, int bid, int nb, float* lds) {
    const int tid = otid();
    float* MODS = (float*)(p.get_ws() + WS_MODS);
    if (bid == 0 && tid < 64) ((u32*)(p.get_ws() + WS_CTL))[tid] = 0u;
    float* RC = (float*)(p.get_ws() + WS_ROPE); float* RS = RC + 256 * 16;
    for (int i = bid * NTH + tid; i < 256 * 16; i += nb * NTH) {
        const int pos = i >> 4, f = i & 15;
        const float inv = powf(10000.f, -(float)f / 16.f);
        const float ang = (float)pos * inv;
        RC[i] = cosf(ang); RS[i] = sinf(ang);
    }
    const float* c = p.in[1]; const float* cx = p.in[3];
    for (int i = tid; i < 1024; i += NTH) { const float a = c[i]; lds[i] = a / (1.f + expf(-a)); const float b = cx[i]; lds[1024 + i] = b / (1.f + expf(-b)); }
    __syncthreads();
    float* red = lds + 2048;
    const int tx = tid & 15, ty = tid >> 4;
    for (int item = bid; item < 192; item += nb) {
        const int l = item / 96, cgp = item % 96;
        const float* W = p.in[8] + (size_t)l * 1024 * 6144 + cgp * 64 + tx * 4;
        float4 ac = {0.f, 0.f, 0.f, 0.f}, ax = {0.f, 0.f, 0.f, 0.f};
#pragma unroll 8
        for (int k = ty; k < 1024; k += 32) {
            const float4 w = *(const float4*)(W + (size_t)k * 6144);
            const float sc = lds[k], sx = lds[1024 + k];
            ac.x += sc * w.x; ac.y += sc * w.y; ac.z += sc * w.z; ac.w += sc * w.w;
            ax.x += sx * w.x; ax.y += sx * w.y; ax.z += sx * w.z; ax.w += sx * w.w;
        }
        float* r = red + (ty * 16 + tx) * 8;
        r[0] = ac.x; r[1] = ac.y; r[2] = ac.z; r[3] = ac.w; r[4] = ax.x; r[5] = ax.y; r[6] = ax.z; r[7] = ax.w;
        __syncthreads();
        if (tid < 128) {
            const int col = tid & 63, which = tid >> 6;
            float s = 0.f;
            for (int y = 0; y < 32; ++y) s += red[(y * 16 + (col >> 2)) * 8 + which * 4 + (col & 3)];
            s += p.in[9][l * 6144 + cgp * 64 + col];
            MODS[(l * 2 + which) * 6144 + cgp * 64 + col] = s;
        }
        __syncthreads();
    }
}

struct RowArgs {
    int layer;
    int ffn;
    int src;
    int combine;
    int clayer;
    int final_out;
    int nrows;
    const float* wsm; int ldw; int wcol0;
    int route;
};

template <int NS> __forceinline__
__device__ __forceinline__ void phase_rows(const P& p, int bid, int nb, float* lds, const RowArgs a) {
    const int tid = otid(), lane = tid & 63, wid = tid >> 6;
    unsigned char* ws = p.get_ws();
    const float* MODS = (const float*)(ws + WS_MODS);
    float* XRES = (float*)(ws + WS_XRES);
    bf16_t* HB = (bf16_t*)(ws + WS_HB);
    float* SMALL = (float*)(ws + WS_SMALL);
    if (!a.final_out) {
        for (int i = tid; i < 1024 * NS; i += NTH) { const int k = i / NS, n = i % NS; lds[i] = a.wsm[(size_t)k * a.ldw + a.wcol0 + n]; }
    }
    __syncthreads();
    const float* gamma = (a.ffn ? p.in[7] : p.in[6]) + a.layer * 1024;
    const bf16_t* YMOE = (const bf16_t*)(ws + WS_PROJ);
    const int2* SLOT = (const int2*)(ws + WS_SLOT);
    const float2* GATE = (const float2*)(ws + WS_GATE);
    for (int row = bid * 8 + wid; row < a.nrows; row += nb * 8) {
        const int which = row >= SEQ ? 1 : 0;
        const float* src = a.src ? XRES + (size_t)row * 1024 : (which ? p.in[2] + (size_t)(row - SEQ) * 1024 : p.in[0] + (size_t)row * 1024);
        float v[16];
#pragma unroll
        for (int i = 0; i < 4; ++i) { const float4 t = *(const float4*)(src + i * 256 + lane * 4); v[i * 4] = t.x; v[i * 4 + 1] = t.y; v[i * 4 + 2] = t.z; v[i * 4 + 3] = t.w; }
        if (a.combine) {
            const int2 sl = SLOT[row]; const float2 gt = GATE[row];
            const float* gf = MODS + (a.clayer * 2 + which) * 6144 + 5 * 1024;
#pragma unroll
            for (int i = 0; i < 4; ++i) {
                const uint2 y0 = *(const uint2*)(YMOE + (size_t)sl.x * 1024 + i * 256 + lane * 4);
                const uint2 y1 = *(const uint2*)(YMOE + (size_t)sl.y * 1024 + i * 256 + lane * 4);
                const float4 g = *(const float4*)(gf + i * 256 + lane * 4);
                v[i * 4 + 0] += g.x * (gt.x * bf2f((bf16_t)(y0.x & 0xffff)) + gt.y * bf2f((bf16_t)(y1.x & 0xffff)));
                v[i * 4 + 1] += g.y * (gt.x * bf2f((bf16_t)(y0.x >> 16)) + gt.y * bf2f((bf16_t)(y1.x >> 16)));
                v[i * 4 + 2] += g.z * (gt.x * bf2f((bf16_t)(y0.y & 0xffff)) + gt.y * bf2f((bf16_t)(y1.y & 0xffff)));
                v[i * 4 + 3] += g.w * (gt.x * bf2f((bf16_t)(y0.y >> 16)) + gt.y * bf2f((bf16_t)(y1.y >> 16)));
            }
            float* dst = a.final_out ? p.get_out() + (size_t)row * 1024 : XRES + (size_t)row * 1024;
#pragma unroll
            for (int i = 0; i < 4; ++i) *(float4*)(dst + i * 256 + lane * 4) = make_float4(v[i * 4], v[i * 4 + 1], v[i * 4 + 2], v[i * 4 + 3]);
            if (a.final_out) continue;
        }
        float ss = 0.f;
#pragma unroll
        for (int j = 0; j < 16; ++j) ss += v[j] * v[j];
        ss = wave_sum(ss);
        const float rs = rsqrtf(ss * (1.f / 1024.f) + 1e-6f);
        const float* md = MODS + (a.layer * 2 + which) * 6144 + (a.ffn ? 3 * 1024 : 0);
#pragma unroll
        for (int i = 0; i < 4; ++i) {
            const float4 g = *(const float4*)(gamma + i * 256 + lane * 4);
            const float4 sh = *(const float4*)(md + i * 256 + lane * 4);
            const float4 sc = *(const float4*)(md + 1024 + i * 256 + lane * 4);
            v[i * 4 + 0] = v[i * 4 + 0] * rs * g.x * (1.f + sc.x) + sh.x;
            v[i * 4 + 1] = v[i * 4 + 1] * rs * g.y * (1.f + sc.y) + sh.y;
            v[i * 4 + 2] = v[i * 4 + 2] * rs * g.z * (1.f + sc.z) + sh.z;
            v[i * 4 + 3] = v[i * 4 + 3] * rs * g.w * (1.f + sc.w) + sh.w;
            uint2 o; o.x = pack2(v[i * 4], v[i * 4 + 1]); o.y = pack2(v[i * 4 + 2], v[i * 4 + 3]);
            *(uint2*)(HB + (size_t)row * 1024 + i * 256 + lane * 4) = o;
        }
        float s[NS];
#pragma unroll
        for (int n = 0; n < NS; ++n) s[n] = 0.f;
#pragma unroll
        for (int i = 0; i < 4; ++i)
#pragma unroll
            for (int j = 0; j < 4; ++j) {
                const float* w = lds + (i * 256 + lane * 4 + j) * NS;
                const float x = v[i * 4 + j];
#pragma unroll
                for (int n = 0; n < NS; n += 4) { const float4 ww = *(const float4*)(w + n); s[n] += x * ww.x; s[n + 1] += x * ww.y; s[n + 2] += x * ww.z; s[n + 3] += x * ww.w; }
                asm volatile("" ::: "memory");
            }
#pragma unroll
        for (int n = 0; n < NS; ++n) s[n] = wave_sum(s[n]);
        if (!a.route) {
            if (lane == 0) {
#pragma unroll
                for (int n = 0; n < NS; n += 4) *(float4*)(SMALL + (size_t)row * 32 + n) = make_float4(s[n], s[n + 1], s[n + 2], s[n + 3]);
            }
        } else if (NS == 16) {
            if (lane == 0) {
                const float* rb = p.in[5];
                float sc[16], bs[16];
#pragma unroll
                for (int n = 0; n < 16; ++n) { sc[n] = 1.f / (1.f + expf(-s[n])); bs[n] = sc[n] + rb[n]; }
                int bg = 0; float bgs = -1e30f;
#pragma unroll
                for (int g = 0; g < 4; ++g) {
                    float m1 = -1e30f, m2 = -1e30f;
#pragma unroll
                    for (int j = 0; j < 4; ++j) { const float x = bs[g * 4 + j]; if (x > m1) { m2 = m1; m1 = x; } else if (x > m2) m2 = x; }
                    const float gs = m1 + m2;
                    if (gs > bgs) { bgs = gs; bg = g; }
                }
                int e0 = 0, e1 = 0; float b0 = -1e30f, b1 = -1e30f;
#pragma unroll
                for (int j = 0; j < 4; ++j) {
                    float x = 0.f; int e = 0;
#pragma unroll
                    for (int g = 0; g < 4; ++g) if (g == bg) { x = bs[g * 4 + j]; e = g * 4 + j; }
                    if (x > b0) { b1 = b0; e1 = e0; b0 = x; e0 = e; } else if (x > b1) { b1 = x; e1 = e; }
                }
                float w0 = 0.f, w1 = 0.f;
#pragma unroll
                for (int n = 0; n < 16; ++n) { if (n == e0) w0 = sc[n]; if (n == e1) w1 = sc[n]; }
                const float inv = 1.f / (w0 + w1);
                u32* cnt = (u32*)(ws + WS_CTL) + CW_CNT + a.layer * 16;
                const int p0 = (int)atomicAdd(cnt + e0, 1u), p1 = (int)atomicAdd(cnt + e1, 1u);
                ((int4*)(ws + WS_ROUTE))[row] = make_int4(e0, p0, e1, p1);
                ((float2*)(ws + WS_GATE))[row] = make_float2(w0 * inv, w1 * inv);
            }
        }
    }
}

__device__ __forceinline__ void phase_lists(const P& p, int bid, int nb, int layer, int nrows) {
    const int tid = otid();
    unsigned char* ws = p.get_ws();
    const u32* cnt = (const u32*)(ws + WS_CTL) + CW_CNT + layer * 16;
    int off[17]; off[0] = 0;
#pragma unroll
    for (int e = 0; e < 16; ++e) off[e + 1] = off[e] + (int)((cnt[e] + 255u) / 256u) * 256;
    int* LIST = (int*)(ws + WS_LIST); int2* SLOT = (int2*)(ws + WS_SLOT); int* TEXP = (int*)(ws + WS_TEXP);
    const int4* ROUTE = (const int4*)(ws + WS_ROUTE);
    for (int row = bid * NTH + tid; row < nrows; row += nb * NTH) {
        const int4 r = ROUTE[row];
        int o0 = 0, o1 = 0;
#pragma unroll
        for (int e = 0; e < 16; ++e) { if (e == r.x) o0 = off[e]; if (e == r.z) o1 = off[e]; }
        const int s0 = o0 + r.y, s1 = o1 + r.w;
        LIST[s0] = row; LIST[s1] = row; SLOT[row] = make_int2(s0, s1);
    }
    if (bid == 0) {
        for (int e = 0; e < 16; ++e) {
            const int c = (int)cnt[e];
            for (int i = off[e] + c + tid; i < off[e + 1]; i += NTH) LIST[i] = 0;
            for (int t = off[e] / 256 + tid; t < off[e + 1] / 256; t += NTH) TEXP[t] = e;
        }
        if (tid == 0) TEXP[255] = off[16] / 256;
    }
}

template <class AF, class WF, class EF>
__device__ __forceinline__ void gemm_naive(int ntm, int ntn, int K, int bid, int nb, float* lds, const AF& af, const WF& wf, const EF& ef) {
    const int tid = otid(), tx = tid & 15, ty = tid >> 4;
    float* As = lds;
    float* Bs = lds + 16 * 132;
    for (int t = bid; t < ntm * ntn; t += nb) {
        const int tm = t / ntn, tn = t % ntn;
        float acc[4][8];
#pragma unroll
        for (int i = 0; i < 4; ++i)
#pragma unroll
            for (int j = 0; j < 8; ++j) acc[i][j] = 0.f;
        const int lr = tid >> 2, lk = (tid & 3) * 4;
        const bf16_t* arow = af(tm * 128 + lr);
        const int bk = tid >> 5, bn = (tid & 31) * 4;
        for (int k0 = 0; k0 < K; k0 += 16) {
            const uint2 av = *(const uint2*)(arow + k0 + lk);
            const float4 bv = *(const float4*)wf(k0 + bk, tn * 128 + bn);
            __syncthreads();
            As[(lk + 0) * 132 + lr] = bf2f((bf16_t)(av.x & 0xffff)); As[(lk + 1) * 132 + lr] = bf2f((bf16_t)(av.x >> 16));
            As[(lk + 2) * 132 + lr] = bf2f((bf16_t)(av.y & 0xffff)); As[(lk + 3) * 132 + lr] = bf2f((bf16_t)(av.y >> 16));
            *(float4*)(Bs + bk * 132 + bn) = make_float4(bf2f(f2bf(bv.x)), bf2f(f2bf(bv.y)), bf2f(f2bf(bv.z)), bf2f(f2bf(bv.w)));
            __syncthreads();
#pragma unroll
            for (int k = 0; k < 16; ++k) {
                const float4 a4 = *(const float4*)(As + k * 132 + ty * 4);
                const float4 b0 = *(const float4*)(Bs + k * 132 + tx * 8), b1 = *(const float4*)(Bs + k * 132 + tx * 8 + 4);
                const float aa[4] = {a4.x, a4.y, a4.z, a4.w}; const float bb[8] = {b0.x, b0.y, b0.z, b0.w, b1.x, b1.y, b1.z, b1.w};
#pragma unroll
                for (int i = 0; i < 4; ++i)
#pragma unroll
                    for (int j = 0; j < 8; ++j) acc[i][j] += aa[i] * bb[j];
            }
        }
#pragma unroll
        for (int i = 0; i < 4; ++i) ef(tm * 128 + ty * 4 + i, tn * 128 + tx * 8, acc[i]);
    }
}


namespace g8 {
#define G8_LAS __attribute__((address_space(3)))
typedef short bf16x8 __attribute__((ext_vector_type(8)));
typedef float f32x4 __attribute__((ext_vector_type(4)));
constexpr int BM = 256, BK = 64, HALF = 128, HTB = HALF * BK * 2, STAGE_BYTES = 8 * HTB, NXCD = 8, WGM = 8;
__device__ __forceinline__ int lds_byte(int r, int c) { const int st = (r >> 4) * 2 + (c >> 5), rr = r & 15, cc = c & 31, ob = rr * 64 + cc * 2; return st * 1024 + (ob ^ (((ob >> 9) & 1) << 5)); }
__device__ __forceinline__ void stage_rc(int b, int& R, int& C) { const int st = b / 1024, sb = b % 1024, swz = sb ^ (((sb >> 9) & 1) << 5); R = (st >> 1) * 16 + swz / 64; C = (st & 1) * 32 + (swz % 64) / 2; }
__device__ __forceinline__ int perm32(int rho) { const int n = rho >> 4, i = rho & 15; return 8 * (i >> 2) + 4 * n + (i & 3); }
struct Unit { int pm, pn; };
struct Order {
    int nM, nN, nwg, G, c;
    __device__ __forceinline__ void init(int nM_, int nN_, int G_, int c_) { nM = nM_; nN = nN_; nwg = nM * nN; G = G_; c = c_; }
    __device__ __forceinline__ bool next(int i, Unit& u) const {
        const long L = (long)i * G + c; if (L >= nwg) return false;
        int wgid = (int)L; { const int q = nwg / NXCD, r = nwg % NXCD, xcd = wgid % NXCD, off = wgid / NXCD; wgid = (xcd < r ? xcd * (q + 1) : r * (q + 1) + (xcd - r) * q) + off; }
        const int nig = WGM * nN, gid = wgid / nig, fm = gid * WGM, gsz = (nM - fm) < WGM ? (nM - fm) : WGM;
        u.pm = fm + ((wgid % nig) % gsz); u.pn = (wgid % nig) / gsz; return true;
    }
};
template <bool GATHER, class BSel, class EF>
__device__ __forceinline__ void gemm8(G8_LAS unsigned char* lds, const bf16_t* A, int K, const int* list, const Order& S, const BSel& bsel, const EF& ef) {
    const int tid = otid(), wid = __builtin_amdgcn_readfirstlane(tid >> 6), lane = tid & 63, wr = wid >> 2, wc = wid & 3, fr = lane & 15, fq = lane >> 4;
    const int nt = K / BK;
    int R0, C0, R1, C1; stage_rc(tid * 16, R0, C0); stage_rc(tid * 16 + 8192, R1, C1);
    const unsigned vb0 = (unsigned)(((R0 & ~31) + perm32(R0 & 31)) * K + C0) * 2u, vb1 = (unsigned)(((R1 & ~31) + perm32(R1 & 31)) * K + C1) * 2u;
    const size_t kstep = (size_t)(BK * 2), hstep = (size_t)HALF * K * 2, tstep = 2 * hstep;
    const unsigned ldsw = (unsigned)wid * 1024u;
    const int aoff = lds_byte(wr * 64 + fr, fq * 8), boff = lds_byte(wc * 32 + fr, fq * 8);
#define G8_SA(b, h) (((b) * 2 + (h)) * HTB)
#define G8_SB(b, h) ((4 + (b) * 2 + (h)) * HTB)
#define G8_STAGE(bufoff, gbase, v0, v1) do { \
        __builtin_amdgcn_global_load_lds((const unsigned*)((const char*)(gbase) + (v0)), (G8_LAS unsigned*)(lds + (bufoff) + ldsw), 16, 0, 0); \
        __builtin_amdgcn_global_load_lds((const unsigned*)((const char*)(gbase) + (v1)), (G8_LAS unsigned*)(lds + (bufoff) + ldsw + 8192), 16, 0, 0); } while (0)
#define G8_LDA(dst, b, h) do { _Pragma("unroll") for (int m = 0; m < 4; ++m) _Pragma("unroll") for (int k = 0; k < 2; ++k) dst[m][k] = *(const G8_LAS bf16x8*)(lds + G8_SA(b, h) + aoff + m * 2048 + k * 1024); } while (0)
#define G8_LDB(dst, b, h) do { _Pragma("unroll") for (int n = 0; n < 2; ++n) _Pragma("unroll") for (int k = 0; k < 2; ++k) dst[n][k] = *(const G8_LAS bf16x8*)(lds + G8_SB(b, h) + boff + n * 2048 + k * 1024); } while (0)
#define G8_MMA(ai, bj, At, Bt) do { __builtin_amdgcn_s_setprio(1); _Pragma("unroll") for (int m = 0; m < 4; ++m) _Pragma("unroll") for (int n = 0; n < 2; ++n) _Pragma("unroll") for (int k = 0; k < 2; ++k) \
        acc[ai][bj][m][n] = __builtin_amdgcn_mfma_f32_16x16x32_bf16(Bt[n][k], At[m][k], acc[ai][bj][m][n], 0, 0, 0); __builtin_amdgcn_s_setprio(0); } while (0)
#define G8_WAIT_V(n) asm volatile("s_waitcnt vmcnt(" #n ")" ::: "memory")
#define G8_WAIT_L(n) asm volatile("s_waitcnt lgkmcnt(" #n ")" ::: "memory")
#define G8_BAR __builtin_amdgcn_s_barrier()
#define G8_SCHED __builtin_amdgcn_sched_barrier(0)
#define G8_AOFF(pm_, h_, R_, C_) ((unsigned)((GATHER ? list[(pm_) * 256 + (h_) * 128 + (R_)] : ((pm_) * 256 + (h_) * 128 + (R_))) * K + (C_)) * 2u)
    Unit cur, nxt; int ui = 0;
    if (!S.next(0, cur)) return;
    f32x4 acc[2][2][4][2];
#pragma unroll
    for (int a = 0; a < 2; ++a)
#pragma unroll
        for (int b = 0; b < 2; ++b)
#pragma unroll
            for (int m = 0; m < 4; ++m)
#pragma unroll
                for (int n = 0; n < 2; ++n) acc[a][b][m][n] = (f32x4){0.f, 0.f, 0.f, 0.f};
    bf16x8 At[4][2], B0[2][2], B1[2][2];
    const char* Ab = (const char*)A;
    unsigned a00 = G8_AOFF(cur.pm, 0, R0, C0), a01 = G8_AOFF(cur.pm, 0, R1, C1), a10 = G8_AOFF(cur.pm, 1, R0, C0), a11 = G8_AOFF(cur.pm, 1, R1, C1);
    const char* cB = bsel(cur.pm) + (size_t)cur.pn * tstep;
    G8_STAGE(G8_SB(0, 0), cB, vb0, vb1); G8_STAGE(G8_SA(0, 0), Ab, a00, a01); G8_STAGE(G8_SB(0, 1), cB + hstep, vb0, vb1); G8_STAGE(G8_SA(0, 1), Ab, a10, a11);
    if (wr == 1) G8_BAR;
    G8_WAIT_V(4); G8_BAR;
    G8_STAGE(G8_SB(1, 0), cB + kstep, vb0, vb1); G8_STAGE(G8_SA(1, 0), Ab + kstep, a00, a01); G8_STAGE(G8_SB(1, 1), cB + hstep + kstep, vb0, vb1);
    G8_WAIT_V(6); G8_BAR;
    for (;;) {
        const bool has_next = S.next(ui + 1, nxt);
        unsigned n00 = a00, n01 = a01, n10 = a10, n11 = a11; const char* nB = cB;
        if (has_next) { n00 = G8_AOFF(nxt.pm, 0, R0, C0); n01 = G8_AOFF(nxt.pm, 0, R1, C1); n10 = G8_AOFF(nxt.pm, 1, R0, C0); n11 = G8_AOFF(nxt.pm, 1, R1, C1); nB = bsel(nxt.pm) + (size_t)nxt.pn * tstep; }
        for (int t = 0; t < nt; t += 2) {
            const bool last = (t == nt - 2);
            const char* a1p = Ab + (size_t)(t + 1) * kstep;
            const char* a2p = last ? Ab : Ab + (size_t)(t + 2) * kstep; const char* b2 = last ? nB : cB + (size_t)(t + 2) * kstep;
            const char* a3p = a2p + kstep; const char* b3 = b2 + kstep;
            const unsigned x00 = last ? n00 : a00, x01 = last ? n01 : a01, x10 = last ? n10 : a10, x11 = last ? n11 : a11;
            G8_LDB(B0, 0, 0); G8_SCHED; G8_LDA(At, 0, 0); G8_STAGE(G8_SA(1, 1), a1p, a10, a11);
            G8_WAIT_L(8); G8_BAR; G8_WAIT_L(0); G8_MMA(0, 0, At, B0); G8_BAR; G8_SCHED;
            G8_LDB(B1, 0, 1); G8_STAGE(G8_SB(0, 0), b2, vb0, vb1);
            G8_BAR; G8_WAIT_L(0); G8_MMA(0, 1, At, B1); G8_BAR;
            G8_LDA(At, 0, 1); G8_STAGE(G8_SA(0, 0), a2p, x00, x01);
            G8_BAR; G8_WAIT_L(0); G8_MMA(1, 0, At, B0); G8_BAR; G8_SCHED;
            G8_STAGE(G8_SB(0, 1), b2 + hstep, vb0, vb1);
            G8_WAIT_V(6); G8_BAR; G8_MMA(1, 1, At, B1); G8_BAR;
            G8_LDB(B0, 1, 0); G8_SCHED; G8_LDA(At, 1, 0); G8_STAGE(G8_SA(0, 1), a2p, x10, x11);
            G8_WAIT_L(8); G8_BAR; G8_WAIT_L(0); G8_MMA(0, 0, At, B0); G8_BAR; G8_SCHED;
            G8_LDB(B1, 1, 1); G8_STAGE(G8_SB(1, 0), b3, vb0, vb1);
            G8_BAR; G8_WAIT_L(0); G8_MMA(0, 1, At, B1); G8_BAR;
            G8_LDA(At, 1, 1); G8_STAGE(G8_SA(1, 0), a3p, x00, x01);
            G8_BAR; G8_WAIT_L(0); G8_MMA(1, 0, At, B0); G8_BAR; G8_SCHED;
            G8_STAGE(G8_SB(1, 1), b3 + hstep, vb0, vb1);
            G8_WAIT_V(6); G8_BAR; G8_MMA(1, 1, At, B1); G8_BAR;
        }
#pragma unroll
        for (int ai = 0; ai < 2; ++ai)
#pragma unroll
            for (int m = 0; m < 4; ++m)
#pragma unroll
                for (int bj = 0; bj < 2; ++bj) {
                    const f32x4 v0 = acc[ai][bj][m][0], v1 = acc[ai][bj][m][1];
                    const float v[8] = {v0[0], v0[1], v0[2], v0[3], v1[0], v1[1], v1[2], v1[3]};
                    ef(cur.pm * BM + ai * HALF + wr * 64 + m * 16 + fr, cur.pn * BM + bj * HALF + wc * 32 + 8 * fq, v);
                }
        if (!has_next) break;
#pragma unroll
        for (int a = 0; a < 2; ++a)
#pragma unroll
            for (int b = 0; b < 2; ++b)
#pragma unroll
                for (int m = 0; m < 4; ++m)
#pragma unroll
                    for (int n = 0; n < 2; ++n) acc[a][b][m][n] = (f32x4){0.f, 0.f, 0.f, 0.f};
        cur = nxt; a00 = n00; a01 = n01; a10 = n10; a11 = n11; cB = nB; ++ui;
    }
    G8_WAIT_V(0);
    if (wr == 0) G8_BAR;
    G8_BAR;
#undef G8_SA
#undef G8_SB
#undef G8_STAGE
#undef G8_LDA
#undef G8_LDB
#undef G8_MMA
#undef G8_WAIT_V
#undef G8_WAIT_L
#undef G8_BAR
#undef G8_SCHED
#undef G8_AOFF
}
}
struct BSelOne { const char* B; __device__ __forceinline__ const char* operator()(int) const { return B; } };
struct BSelExp { const char* B; const int* texp; size_t stride; __device__ __forceinline__ const char* operator()(int pm) const { return B + (size_t)texp[pm] * stride; } };

struct SrcPlain { const float* W; int ldw; __device__ __forceinline__ const float* operator()(int k, int n) const { return W + (size_t)k * ldw + n; } };
struct SrcEven { const float* W; __device__ __forceinline__ const float* operator()(int k, int n) const { return W + (size_t)k * EV_IN + (n < 1280 ? n : n + 16); } };
struct SrcMoe13 { const float* W1; long long d13; __device__ __forceinline__ const float* operator()(int k, int n) const { return W1 + ((n & 4) ? d13 : 0ll) + (size_t)k * DE + ((n >> 3) * 4 + (n & 3)); } };
template <class SF>
__device__ __forceinline__ void conv_matrix(const SF& src, int K, int N, bf16_t* WT, int gw, int ngw, float* scr, int lane) {
    const int nblk = N / 32, nitems = (K / 64) * nblk;
    for (int item = gw; item < nitems; item += ngw) {
        const int kb = item / nblk, nbk = item % nblk, k0 = 64 * kb, n0 = 32 * nbk;
#pragma unroll 8
        for (int i = 0; i < 32; ++i) { const int kk = 2 * i + (lane >> 5); scr[kk * 33 + (lane & 31)] = *src(k0 + kk, n0 + (lane & 31)); }
        __builtin_amdgcn_s_waitcnt(0xC07F); asm volatile("" ::: "memory");
        const int c = lane & 7;
#pragma unroll
        for (int j = 0; j < 4; ++j) { const int n = (lane >> 3) + 8 * j; const float* sp = scr + (8 * c) * 33 + n;
            uint4 o; o.x = pack2(sp[0 * 33], sp[1 * 33]); o.y = pack2(sp[2 * 33], sp[3 * 33]); o.z = pack2(sp[4 * 33], sp[5 * 33]); o.w = pack2(sp[6 * 33], sp[7 * 33]);
            *(uint4*)(WT + (size_t)(n0 + n) * K + k0 + 8 * c) = o; }
        __builtin_amdgcn_s_waitcnt(0xC07F); asm volatile("" ::: "memory");
    }
}
__device__ __forceinline__ void conv_dense(const P& p, int bid, int nb, float* lds) {
    const int tid = otid(), lane = tid & 63, wid = tid >> 6;
    float* scr = lds + 16384 + wid * (64 * 33);
    const int gw = bid * 8 + wid, ngw = nb * 8;
    unsigned char* ws = p.get_ws();
    conv_matrix(SrcEven{p.in[10]}, 1024, 2048, (bf16_t*)(ws + WS_WIN0), gw, ngw, scr, lane);
    conv_matrix(SrcPlain{p.in[21], OD_IN}, 1024, 3072, (bf16_t*)(ws + WS_WIN1), gw, ngw, scr, lane);
    conv_matrix(SrcPlain{p.in[20], 1024}, 1024, 1024, (bf16_t*)(ws + WS_WOUT0), gw, ngw, scr, lane);
    conv_matrix(SrcPlain{p.in[27], 1024}, 1024, 1024, (bf16_t*)(ws + WS_WOUT1), gw, ngw, scr, lane);
}
__device__ __forceinline__ void conv_moe(const P& p, int bid, int nb, float* lds, int layer) {
    const int tid = otid(), lane = tid & 63, wid = tid >> 6;
    float* scr = lds + 16384 + wid * (64 * 33);
    const int ngw = nb * 8; int gw = bid * 8 + wid;
    unsigned char* ws = p.get_ws();
    bf16_t* W13T = (bf16_t*)(ws + WS_WMOE); bf16_t* W2T = W13T + (size_t)16 * 1024 * 1024;
    const long long d13 = (long long)(p.in[29] - p.in[28]);
    for (int e = 0; e < 16; ++e) {
        conv_matrix(SrcMoe13{p.in[28] + ((size_t)layer * 16 + e) * 1024 * DE, d13}, 1024, 1024, W13T + (size_t)e * 1024 * 1024, gw, ngw, scr, lane);
        conv_matrix(SrcPlain{p.in[30] + ((size_t)layer * 16 + e) * DE * 1024, 1024}, DE, 1024, W2T + (size_t)e * 1024 * DE, gw, ngw, scr, lane);
        gw = (gw + 768) % ngw;
    }
}

struct ARowPlain { const bf16_t* A; int ld; __device__ const bf16_t* operator()(int m) const { return A + (size_t)m * ld; } };
struct ARowGather { const bf16_t* A; int ld; const int* list; __device__ const bf16_t* operator()(int m) const { return A + (size_t)list[m] * ld; } };
struct WEven { const float* W; __device__ const float* operator()(int k, int n) const { return W + (size_t)k * EV_IN + (n < 1280 ? n : n + 16); } };
struct WPlain { const float* W; int ldw; __device__ const float* operator()(int k, int n) const { return W + (size_t)k * ldw + n; } };
struct WMoe13 { const float* W1; long long d13;
    __device__ const float* operator()(int k, int n) const { const int j = (n >> 3) * 4 + (n & 3); return W1 + ((n & 4) ? d13 : 0ll) + (size_t)k * DE + j; } };
struct EpiBf16Store { bf16_t* C; int ld; __device__ void operator()(int r, int c0, const float* v) const {
    uint4 o; o.x = pack2(v[0], v[1]); o.y = pack2(v[2], v[3]); o.z = pack2(v[4], v[5]); o.w = pack2(v[6], v[7]); *(uint4*)(C + (size_t)r * ld + c0) = o; } };
struct EpiResid { const float* xlat; const float* xctx; float* XRES; const float* gl; const float* gc;
    __device__ void operator()(int r, int c0, const float* v) const {
        const float* xin = xctx && r >= SEQ ? xctx + (size_t)(r - SEQ) * 1024 : xlat + (size_t)r * 1024;
        const float* g = r >= SEQ ? gc : gl;
        const float4 x0 = *(const float4*)(xin + c0), x1 = *(const float4*)(xin + c0 + 4), g0 = *(const float4*)(g + c0), g1 = *(const float4*)(g + c0 + 4);
        *(float4*)(XRES + (size_t)r * 1024 + c0) = make_float4(x0.x + g0.x * v[0], x0.y + g0.y * v[1], x0.z + g0.z * v[2], x0.w + g0.w * v[3]);
        *(float4*)(XRES + (size_t)r * 1024 + c0 + 4) = make_float4(x1.x + g1.x * v[4], x1.y + g1.y * v[5], x1.z + g1.z * v[6], x1.w + g1.w * v[7]);
    } };
struct EpiSwiglu { bf16_t* H; __device__ void operator()(int r, int c0, const float* v) const {
    uint2 o; o.x = pack2(siluf(v[0]) * v[4], siluf(v[1]) * v[5]); o.y = pack2(siluf(v[2]) * v[6], siluf(v[3]) * v[7]); *(uint2*)(H + (size_t)r * DE + (c0 >> 3) * 4) = o; } };

__device__ __forceinline__ void phase_moe1_naive(const P& p, int bid, int nb, float* lds, int layer) {
    unsigned char* ws = p.get_ws(); const int* TEXP = (const int*)(ws + WS_TEXP); const int nt256 = TEXP[255];
    const int* LIST = (const int*)(ws + WS_LIST);
    for (int e = 0; e < 16; ++e) {
        int t0 = -1, t1 = -1;
        for (int t = 0; t < nt256; ++t) if (TEXP[t] == e) { if (t0 < 0) t0 = t; t1 = t + 1; }
        if (t0 < 0) continue;
        const int ntm = (t1 - t0) * 2;
        ARowGather af{(const bf16_t*)(ws + WS_HB), 1024, LIST + t0 * 256};
        WMoe13 wf{p.in[28] + ((size_t)layer * 16 + e) * 1024 * DE, (long long)(p.in[29] - p.in[28])};
        EpiSwiglu ef{(bf16_t*)(ws + WS_Y) + (size_t)t0 * 256 * DE};
        const int rb = (bid + e * 37) % nb;
        gemm_naive(ntm, 8, 1024, rb, nb, lds, af, wf, ef);
    }
}
__device__ __forceinline__ void phase_moe2_naive(const P& p, int bid, int nb, float* lds, int layer) {
    unsigned char* ws = p.get_ws(); const int* TEXP = (const int*)(ws + WS_TEXP); const int nt256 = TEXP[255];
    for (int e = 0; e < 16; ++e) {
        int t0 = -1, t1 = -1;
        for (int t = 0; t < nt256; ++t) if (TEXP[t] == e) { if (t0 < 0) t0 = t; t1 = t + 1; }
        if (t0 < 0) continue;
        const int ntm = (t1 - t0) * 2;
        ARowPlain af{(const bf16_t*)(ws + WS_Y) + (size_t)t0 * 256 * DE, DE};
        WPlain wf{p.in[30] + ((size_t)layer * 16 + e) * DE * 1024, 1024};
        EpiBf16Store ef{(bf16_t*)(ws + WS_PROJ) + (size_t)t0 * 256 * 1024, 1024};
        const int rb = (bid + e * 37) % nb;
        gemm_naive(ntm, 8, DE, rb, nb, lds, af, wf, ef);
    }
}

__device__ __forceinline__ void phase_moe1(const P& p, int bid, int nb, G8_LAS unsigned char* ldsa) {
    unsigned char* ws = p.get_ws(); const int* TEXP = (const int*)(ws + WS_TEXP);
    g8::Order S; S.init(TEXP[255], 4, nb, bid);
    EpiSwiglu ef{(bf16_t*)(ws + WS_Y)};
    g8::gemm8<true>(ldsa, (const bf16_t*)(ws + WS_HB), 1024, (const int*)(ws + WS_LIST), S, BSelExp{(const char*)(ws + WS_WMOE), TEXP, (size_t)1024 * 1024 * 2}, ef);
}
__device__ __forceinline__ void phase_moe2(const P& p, int bid, int nb, G8_LAS unsigned char* ldsa) {
    unsigned char* ws = p.get_ws(); const int* TEXP = (const int*)(ws + WS_TEXP);
    g8::Order S; S.init(TEXP[255], 4, nb, bid);
    EpiBf16Store ef{(bf16_t*)(ws + WS_PROJ), 1024};
    g8::gemm8<false>(ldsa, (const bf16_t*)(ws + WS_Y), DE, nullptr, S, BSelExp{(const char*)(ws + WS_WMOE) + (size_t)16 * 1024 * 1024 * 2, TEXP, (size_t)1024 * DE * 2}, ef);
}

__device__ __forceinline__ void phase_qkprep(const P& p, int bid, int nb) {
    const int tid = otid(), lane = tid & 63, wid = tid >> 6;
    unsigned char* ws = p.get_ws();
    const bf16_t* PROJ = (const bf16_t*)(ws + WS_PROJ);
    bf16_t* QKR = (bf16_t*)(ws + WS_XRES);
    const float* RC = (const float*)(ws + WS_ROPE); const float* RS = RC + 256 * 16;
    const float qn = p.in[17][lane], kn = p.in[18][lane];
    for (int row = bid * 8 + wid; row < MT; row += nb * 8) {
        const bool lat = row < SEQ;
        const int pos = lane < 32 ? (row >> 6) : (row & 63);
        const int f = lane & 15;
        const float cs = lat ? RC[pos * 16 + f] : 1.f, sn = lat ? RS[pos * 16 + f] : 0.f;
        for (int h = 0; h < 10; ++h) {
            const float x = bf2f(PROJ[(size_t)row * 2048 + 1280 + h * 64 + lane]);
            const float ss = wave_sum(x * x);
            const float y = x * rsqrtf(ss * (1.f / 64.f) + 1e-6f) * (h < 8 ? qn : kn);
            const float o = __shfl_xor(y, 16);
            const float r = ((lane & 16) == 0) ? y * cs - o * sn : o * sn + y * cs;
            QKR[(size_t)row * 640 + h * 64 + lane] = f2bf(r);
        }
    }
}

__device__ __forceinline__ void ssd_scan_naive(const P& p, int dh, float* lds) {
    const int lane = otid() & 63;
    const int d = dh >> 3, h = dh & 7, g = h >> 2;
    unsigned char* ws = p.get_ws();
    const bf16_t* PROJ = (const bf16_t*)(ws + WS_PROJ);
    const float* SMALL = (const float*)(ws + WS_SMALL);
    float* Y = (float*)(ws + WS_Y) + (size_t)d * MT * 512;
    const float* cw = p.in[11]; const float* cb = p.in[12];
    const int chx = h * 64 + lane, chb = 512 + g * 64 + lane, chc = 640 + g * 64 + lane;
    const float wx0 = cw[chx], wx1 = cw[768 + chx], wx2 = cw[1536 + chx], bx = cb[chx];
    const float wb0 = cw[chb], wb1 = cw[768 + chb], wb2 = cw[1536 + chb], bb = cb[chb];
    const float wc0 = cw[chc], wc1 = cw[768 + chc], wc2 = cw[1536 + chc], bc = cb[chc];
    const float A = -expf(p.in[14][d * 8 + h]);
    const float dtb = p.in[13][d * 8 + h];
    float st[64];
#pragma unroll
    for (int n = 0; n < 64; ++n) st[n] = 0.f;
    float* tx = lds;
    float* tb = lds + 66 * 64;
    float* tc = lds + 2 * 66 * 64;
    float* tdt = lds + 3 * 66 * 64;
    for (int seg = 0; seg < 2; ++seg) {
        const int L = seg == 0 ? CTX : SEQ, base = seg == 0 ? SEQ : 0;
        for (int k = 0; k < L / 64; ++k) {
            const int tbs = d ? L - 64 - k * 64 : k * 64;
            for (int r = 0; r < 66; ++r) {
                const int t = tbs - 1 + r;
                float vx = 0.f, vb = 0.f, vc = 0.f;
                if (t >= 0 && t < L) { const bf16_t* pr = PROJ + (size_t)(base + t) * 2048 + 512; vx = bf2f(pr[chx]); vb = bf2f(pr[chb]); vc = bf2f(pr[chc]); }
                tx[r * 64 + lane] = vx; tb[r * 64 + lane] = vb; tc[r * 64 + lane] = vc;
            }
            { const float dtr = SMALL[(size_t)(base + tbs + lane) * 32 + d * 8 + h] + dtb; const float dt = softplusf(dtr); tdt[lane] = dt; tdt[64 + lane] = __expf(dt * A); }
            __builtin_amdgcn_s_waitcnt(0);
            __builtin_amdgcn_wave_barrier();
            for (int s = 0; s < 64; ++s) {
                const int tl = d ? 63 - s : s; const int r = tl + 1;
                const float xv = siluf(wx0 * tx[(r - 1) * 64 + lane] + wx1 * tx[r * 64 + lane] + wx2 * tx[(r + 1) * 64 + lane] + bx);
                const float bv = siluf(wb0 * tb[(r - 1) * 64 + lane] + wb1 * tb[r * 64 + lane] + wb2 * tb[(r + 1) * 64 + lane] + bb);
                const float cv = siluf(wc0 * tc[(r - 1) * 64 + lane] + wc1 * tc[r * 64 + lane] + wc2 * tc[(r + 1) * 64 + lane] + bc);
                const float dt = tdt[tl], a = tdt[64 + tl];
                const float xd = xv * dt;
                float y = 0.f;
#pragma unroll
                for (int n = 0; n < 64; ++n) { st[n] = a * st[n] + xd * rdlane(bv, n); y += rdlane(cv, n) * st[n]; }
                Y[(size_t)(base + tbs + tl) * 512 + h * 64 + lane] = y;
            }
            __builtin_amdgcn_wave_barrier();
        }
    }
}

__device__ __forceinline__ void attn_naive_item(const P& p, int row, int hq, int half) {
    unsigned char* ws = p.get_ws();
    const bf16_t* PROJ = (const bf16_t*)(ws + WS_PROJ);
    const bf16_t* QKR = (const bf16_t*)(ws + WS_XRES);
    bf16_t* MIX = (bf16_t*)(ws + WS_HB);
    const int g = hq >> 2;
    float q[64], o[32];
    { const bf16_t* qp = QKR + (size_t)row * 640 + hq * 64;
#pragma unroll
      for (int dd = 0; dd < 64; ++dd) q[dd] = bf2f(qp[dd]) * 0.125f;
#pragma unroll
      for (int dd = 0; dd < 32; ++dd) o[dd] = 0.f; }
    const float sink = p.in[19][hq];
    float m = sink, l = 1.f;
    const bool lat = row < SEQ;
    int j0 = 0, j1 = -1;
    if (lat) { j0 = row - 128 < 0 ? 0 : row - 128; j1 = row + 128 > SEQ - 1 ? SEQ - 1 : row + 128; }
    const int nloc = j1 - j0 + 1;
    for (int jj = 0; jj < nloc + CTX; ++jj) {
        const int kr = jj < nloc ? j0 + jj : SEQ + (jj - nloc);
        const bf16_t* kp = QKR + (size_t)kr * 640 + 512 + g * 64;
        float s = 0.f;
#pragma unroll
        for (int dd = 0; dd < 64; dd += 2) { const u32 w = *(const u32*)(kp + dd); s += q[dd] * bf2f((bf16_t)(w & 0xffff)) + q[dd + 1] * bf2f((bf16_t)(w >> 16)); }
        const float mn = fmaxf(m, s);
        const float al = __expf(m - mn), pe = __expf(s - mn);
        l = l * al + pe; m = mn;
        const bf16_t* vp = PROJ + (size_t)kr * 2048 + 1920 + g * 64 + half * 32;
#pragma unroll
        for (int dd = 0; dd < 32; dd += 2) { const u32 w = *(const u32*)(vp + dd); o[dd] = o[dd] * al + pe * bf2f((bf16_t)(w & 0xffff)); o[dd + 1] = o[dd + 1] * al + pe * bf2f((bf16_t)(w >> 16)); }
    }
    const float inv = 1.f / l;
    bf16_t* op = MIX + (size_t)row * 1024 + 512 + hq * 64 + half * 32;
#pragma unroll
    for (int dd = 0; dd < 32; dd += 2) *(u32*)(op + dd) = pack2(o[dd] * inv, o[dd + 1] * inv);
}

__device__ __forceinline__ void phase_mix0_naive(const P& p, int bid, int nb, float* lds) {
    const int tid = otid(), wid = tid >> 6;
    const bool scanner = bid < 16 && wid == 0;
    if (scanner) { ssd_scan_naive(p, bid, lds); return; }
    const int nwaves = nb * 8 - 16;
    const int wv = bid < 16 ? bid * 7 + (wid - 1) : 16 * 7 + (bid - 16) * 8 + wid;
    for (int it = wv * 64 + (tid & 63); it < MT * 16; it += nwaves * 64) attn_naive_item(p, it >> 4, (it >> 1) & 7, it & 1);
}

__device__ __forceinline__ void phase_ssdout(const P& p, int bid, int nb) {
    const int tid = otid(), lane = tid & 63, wid = tid >> 6;
    unsigned char* ws = p.get_ws();
    const bf16_t* PROJ = (const bf16_t*)(ws + WS_PROJ);
    const float* Y0 = (const float*)(ws + WS_Y); const float* Y1 = Y0 + (size_t)MT * 512;
    bf16_t* MIX = (bf16_t*)(ws + WS_HB);
    const float* cw = p.in[11]; const float* cb = p.in[12];
    for (int row = bid * 8 + wid; row < MT; row += nb * 8) {
        const bool lat = row < SEQ; const int t = lat ? row : row - SEQ, L = lat ? SEQ : CTX;
        float u[8]; float ss = 0.f;
#pragma unroll
        for (int j = 0; j < 8; ++j) {
            const int c = lane * 8 + j;
            const float xm = t > 0 ? bf2f(PROJ[(size_t)(row - 1) * 2048 + 512 + c]) : 0.f;
            const float x0 = bf2f(PROJ[(size_t)row * 2048 + 512 + c]);
            const float xp = t < L - 1 ? bf2f(PROJ[(size_t)(row + 1) * 2048 + 512 + c]) : 0.f;
            const float xs = siluf(cw[c] * xm + cw[768 + c] * x0 + cw[1536 + c] * xp + cb[c]);
            const float y = Y0[(size_t)row * 512 + c] + Y1[(size_t)row * 512 + c] + p.in[15][c >> 6] * xs;
            const float z = bf2f(PROJ[(size_t)row * 2048 + c]);
            u[j] = y * siluf(z); ss += u[j] * u[j];
        }
        ss = wave_sum(ss);
        const float rs = rsqrtf(ss * (1.f / 512.f) + 1e-6f);
#pragma unroll
        for (int j = 0; j < 8; ++j) { const int c = lane * 8 + j; MIX[(size_t)row * 1024 + c] = f2bf(u[j] * rs * p.in[16][c]); }
    }
}

__device__ __forceinline__ void mlstm_scan_naive(const P& p, int item, float* lds) {
    const int lane = otid() & 63;
    const int d = item >> 4, h = (item >> 1) & 7, half = item & 1;
    unsigned char* ws = p.get_ws();
    const bf16_t* PROJ = (const bf16_t*)(ws + WS_PROJ);
    const float* SMALL = (const float*)(ws + WS_SMALL);
    bf16_t* Y = (bf16_t*)(ws + WS_Y) + (size_t)d * MT * 1024;
    const float* cw = p.in[22]; const float* cb = p.in[23];
    const int chq = h * 64 + lane, chk = 512 + h * 64 + lane, chv = 1024 + h * 128 + half * 64 + lane;
    const float wq0 = cw[chq], wq1 = cw[2048 + chq], wq2 = cw[4096 + chq], bq = cb[chq];
    const float wk0 = cw[chk], wk1 = cw[2048 + chk], wk2 = cw[4096 + chk], bk = cb[chk];
    const float wv0 = cw[chv], wv1 = cw[2048 + chv], wv2 = cw[4096 + chv], bv = cb[chv];
    const float igb = p.in[24][d * 8 + h], fgb = p.in[25][d * 8 + h];
    float C[64], nn[64];
#pragma unroll
    for (int n = 0; n < 64; ++n) { C[n] = 0.f; nn[n] = 0.f; }
    float m = 0.f;
    float* tq = lds; float* tk = lds + 66 * 64; float* tv = lds + 2 * 66 * 64; float* tg = lds + 3 * 66 * 64;
    for (int seg = 0; seg < 2; ++seg) {
        const int L = seg == 0 ? CTX : SEQ, base = seg == 0 ? SEQ : 0;
        for (int k = 0; k < L / 64; ++k) {
            const int tbs = d ? L - 64 - k * 64 : k * 64;
            for (int r = 0; r < 66; ++r) {
                const int t = tbs - 1 + r;
                float vq = 0.f, vk = 0.f, vv = 0.f;
                if (t >= 0 && t < L) { const bf16_t* pr = PROJ + (size_t)(base + t) * 3072; vq = bf2f(pr[chq]); vk = bf2f(pr[chk]); vv = bf2f(pr[chv]); }
                tq[r * 64 + lane] = vq; tk[r * 64 + lane] = vk; tv[r * 64 + lane] = vv;
            }
            { const float* sm = SMALL + (size_t)(base + tbs + lane) * 32; tg[lane] = sm[d * 8 + h] + igb; tg[64 + lane] = logsigf(sm[16 + d * 8 + h] + fgb); }
            __builtin_amdgcn_s_waitcnt(0);
            __builtin_amdgcn_wave_barrier();
            for (int s = 0; s < 64; ++s) {
                const int tl = d ? 63 - s : s; const int r = tl + 1;
                const float qv = siluf(wq0 * tq[(r - 1) * 64 + lane] + wq1 * tq[r * 64 + lane] + wq2 * tq[(r + 1) * 64 + lane] + bq);
                const float kv = siluf(wk0 * tk[(r - 1) * 64 + lane] + wk1 * tk[r * 64 + lane] + wk2 * tk[(r + 1) * 64 + lane] + bk) * 0.125f;
                const float vv = siluf(wv0 * tv[(r - 1) * 64 + lane] + wv1 * tv[r * 64 + lane] + wv2 * tv[(r + 1) * 64 + lane] + bv);
                const float ig = tg[tl], lf = tg[64 + tl];
                const float mn = fmaxf(lf + m, ig);
                const float fs = __expf(lf + m - mn), is = __expf(ig - mn);
                m = mn;
                const float iv = is * vv;
                float num = 0.f, den = 0.f;
#pragma unroll
                for (int n = 0; n < 64; ++n) {
                    const float kb = rdlane(kv, n), qb = rdlane(qv, n);
                    C[n] = fs * C[n] + kb * iv; nn[n] = fs * nn[n] + is * kb;
                    num += qb * C[n]; den += qb * nn[n];
                }
                const float hv = num / fmaxf(fabsf(den), __expf(-mn));
                Y[(size_t)(base + tbs + tl) * 1024 + h * 128 + half * 64 + lane] = f2bf(hv);
            }
            __builtin_amdgcn_wave_barrier();
        }
    }
}
__device__ __forceinline__ void phase_mix1_naive(const P& p, int bid, int nb, float* lds) {
    const int wid = otid() >> 6;
    if (bid < 32 && wid == 0) mlstm_scan_naive(p, bid, lds);
}
__device__ __forceinline__ void phase_mlstmout(const P& p, int bid, int nb) {
    const int tid = otid(), lane = tid & 63, wid = tid >> 6;
    unsigned char* ws = p.get_ws();
    const bf16_t* PROJ = (const bf16_t*)(ws + WS_PROJ);
    const bf16_t* Y0 = (const bf16_t*)(ws + WS_Y); const bf16_t* Y1 = Y0 + (size_t)MT * 1024;
    bf16_t* MIX = (bf16_t*)(ws + WS_HB);
    for (int row = bid * 8 + wid; row < SEQ; row += nb * 8) {
        float v[16]; float ss = 0.f;
#pragma unroll
        for (int j = 0; j < 16; ++j) { const int c = lane * 16 + j; v[j] = bf2f(Y0[(size_t)row * 1024 + c]) + bf2f(Y1[(size_t)row * 1024 + c]); ss += v[j] * v[j]; }
        ss += __shfl_xor(ss, 1); ss += __shfl_xor(ss, 2); ss += __shfl_xor(ss, 4);
        const float rs = rsqrtf(ss * (1.f / 128.f) + 1e-6f);
#pragma unroll
        for (int j = 0; j < 16; ++j) { const int c = lane * 16 + j; const float o = bf2f(PROJ[(size_t)row * 3072 + 2048 + c]); MIX[(size_t)row * 1024 + c] = f2bf(v[j] * rs * p.in[26][c] * sigmf(o)); }
    }
}

#define GSYNC() grid.sync()
__global__ void __launch_bounds__(NTH, 2) fwd_kernel(PK pk) {
    P p;
    extern __shared__ __attribute__((aligned(16))) unsigned char smem[];
    float* lds = (float*)smem;
    G8_LAS unsigned char* ldsa = (G8_LAS unsigned char*)smem;
    cg::grid_group grid = cg::this_grid();
    const int bid = blockIdx.x, nb = gridDim.x;
    int nph = NPH_RUN; asm volatile("" : "+s"(nph));
#pragma unroll 1
    for (int ph = 0; ph < nph; ++ph) {
        unsigned char* ws = p.get_ws();
        const float* MODS = (const float*)(ws + WS_MODS);
        switch (ph) {
        case 0: {
            phase_mods(p, bid, nb, lds);
            conv_dense(p, bid, nb, lds);
            conv_moe(p, bid, nb, lds, 0);
        } break;
        case 1: {
            { RowArgs a{}; a.layer = 0; a.ffn = 0; a.src = 0; a.nrows = MT; a.wsm = p.in[10]; a.ldw = EV_IN; a.wcol0 = 1280; phase_rows<16>(p, bid, nb, lds, a); }
        } break;
        case 2: {
            { g8::Order S; S.init(MT / 256, 2048 / 256, nb, bid); EpiBf16Store ef{(bf16_t*)(ws + WS_PROJ), 2048};
              g8::gemm8<false>(ldsa, (const bf16_t*)(ws + WS_HB), 1024, nullptr, S, BSelOne{(const char*)(ws + WS_WIN0)}, ef); }
        } break;
        case 3: {
            phase_qkprep(p, bid, nb);
        } break;
        case 4: {
            phase_mix0_naive(p, bid, nb, lds);
        } break;
        case 5: {
            phase_ssdout(p, bid, nb);
        } break;
        case 6: {
            { g8::Order S; S.init(MT / 256, 4, nb, bid);
              EpiResid ef{p.in[0], p.in[2], (float*)(ws + WS_XRES), MODS + (0 * 2 + 0) * 6144 + 2048, MODS + (0 * 2 + 1) * 6144 + 2048};
              g8::gemm8<false>(ldsa, (const bf16_t*)(ws + WS_HB), 1024, nullptr, S, BSelOne{(const char*)(ws + WS_WOUT0)}, ef); }
        } break;
        case 7: {
            { RowArgs a{}; a.layer = 0; a.ffn = 1; a.src = 1; a.nrows = MT; a.wsm = p.in[4]; a.ldw = 16; a.wcol0 = 0; a.route = 1; phase_rows<16>(p, bid, nb, lds, a); }
        } break;
        case 8: {
            phase_lists(p, bid, nb, 0, MT);
        } break;
        case 9: {
            phase_moe1(p, bid, nb, ldsa);
        } break;
        case 10: {
            phase_moe2(p, bid, nb, ldsa);
        } break;
        case 11: {
            { RowArgs a{}; a.layer = 1; a.ffn = 0; a.src = 1; a.combine = 1; a.clayer = 0; a.nrows = MT; a.wsm = p.in[21]; a.ldw = OD_IN; a.wcol0 = 3072; phase_rows<32>(p, bid, nb, lds, a); }
        } break;
        case 12: {
            { g8::Order S; S.init(MT / 256, 3072 / 256, nb, bid); EpiBf16Store ef{(bf16_t*)(ws + WS_PROJ), 3072};
              g8::gemm8<false>(ldsa, (const bf16_t*)(ws + WS_HB), 1024, nullptr, S, BSelOne{(const char*)(ws + WS_WIN1)}, ef); }
        } break;
        case 13: {
            phase_mix1_naive(p, bid, nb, lds);
            conv_moe(p, bid, nb, lds, 1);
        } break;
        case 14: {
            phase_mlstmout(p, bid, nb);
        } break;
        case 15: {
            { g8::Order S; S.init(SEQ / 256, 4, nb, bid);
              EpiResid ef{(const float*)(ws + WS_XRES), nullptr, (float*)(ws + WS_XRES), MODS + (1 * 2 + 0) * 6144 + 2048, MODS + (1 * 2 + 0) * 6144 + 2048};
              g8::gemm8<false>(ldsa, (const bf16_t*)(ws + WS_HB), 1024, nullptr, S, BSelOne{(const char*)(ws + WS_WOUT1)}, ef); }
        } break;
        case 16: {
            { RowArgs a{}; a.layer = 1; a.ffn = 1; a.src = 1; a.nrows = SEQ; a.wsm = p.in[4]; a.ldw = 16; a.wcol0 = 0; a.route = 1; phase_rows<16>(p, bid, nb, lds, a); }
        } break;
        case 17: {
            phase_lists(p, bid, nb, 1, SEQ);
        } break;
        case 18: {
            phase_moe1(p, bid, nb, ldsa);
        } break;
        case 19: {
            phase_moe2(p, bid, nb, ldsa);
        } break;
        case 20: {
            { RowArgs a{}; a.layer = 1; a.src = 1; a.combine = 1; a.clayer = 1; a.final_out = 1; a.nrows = SEQ; phase_rows<16>(p, bid, nb, lds, a); }
        } break;
        default: break;
        }
        if (ph + 1 < nph) grid.sync();
    }
}

constexpr int LDS_BYTES = 140 * 1024;

extern "C" void kernel_launch(void* const* d_in, const int* in_sizes, int n_in, void* d_out, int out_size, void* d_ws, size_t ws_size, hipStream_t stream) {
    static int grid = 0;
    if (grid == 0) {
        if (n_in != 31 || ws_size < WS_END) { fprintf(stderr, "kernel_launch: unexpected n_in %d or ws_size %zu < %zu\n", n_in, ws_size, (size_t)WS_END); grid = -1; return; }
        int dev = 0, cus = 0, per_cu = 0;
        hipGetDevice(&dev);
        hipDeviceGetAttribute(&cus, hipDeviceAttributeMultiprocessorCount, dev);
        hipFuncSetAttribute((const void*)fwd_kernel, hipFuncAttributeMaxDynamicSharedMemorySize, LDS_BYTES);
        hipOccupancyMaxActiveBlocksPerMultiprocessor(&per_cu, (const void*)fwd_kernel, NTH, LDS_BYTES);
        if (per_cu < 1) { fprintf(stderr, "kernel_launch: occupancy query says %d blocks per CU\n", per_cu); per_cu = 1; }
        grid = cus;
    }
    if (grid < 0) return;
    PK p{};
    for (int i = 0; i < 31; ++i) p.in[i] = (const float*)d_in[i];
    p.out = (float*)d_out; p.ws = (unsigned char*)d_ws;
    void* args[] = {&p};
    hipError_t e = hipLaunchCooperativeKernel((const void*)fwd_kernel, dim3(grid), dim3(NTH), args, LDS_BYTES, stream);
    if (e != hipSuccess) fprintf(stderr, "cooperative launch failed: %s (grid %d)\n", hipGetErrorString(e), grid);
}
```

```cpp
#include <hip/hip_runtime.h>
#include <hip/hip_cooperative_groups.h>
#include <cstdio>
namespace cg = cooperative_groups;

typedef unsigned short bf16_t;
typedef unsigned int u32;

constexpr int D = 1024, SEQ = 16384, CTX = 256, MT = SEQ + CTX;
constexpr int NTH = 512;
#ifndef NPH_RUN
#define NPH_RUN 21
#endif
constexpr int EV_IN = 2064, OD_IN = 3104;
constexpr int NE = 16, DE = 512;
constexpr int MAXTILES = 146, MAXSLOTS = MAXTILES * 256;

constexpr size_t al256(size_t x) { return (x + 255) & ~(size_t)255; }
constexpr size_t WS_CTL   = 0;
constexpr size_t WS_MODS  = 65536;
constexpr size_t WS_ROPE  = WS_MODS + al256(2 * 2 * 6144 * 4);
constexpr size_t WS_SMALL = WS_ROPE + al256(2 * 256 * 16 * 4);
constexpr size_t WS_ROUTE = WS_SMALL + al256((size_t)MT * 32 * 4);
constexpr size_t WS_GATE  = WS_ROUTE + al256((size_t)MT * 16);
constexpr size_t WS_SLOT  = WS_GATE + al256((size_t)MT * 8);
constexpr size_t WS_LIST  = WS_SLOT + al256((size_t)MT * 8);
constexpr size_t WS_TEXP  = WS_LIST + al256((size_t)MAXSLOTS * 4);
constexpr size_t WS_CHK   = WS_TEXP + 1024;
constexpr size_t WS_WIN0  = WS_CHK + (size_t)2 * 1024 * 1024;
constexpr size_t WS_WIN1  = WS_WIN0 + (size_t)2048 * 1024 * 2;
constexpr size_t WS_WOUT0 = WS_WIN1 + (size_t)3072 * 1024 * 2;
constexpr size_t WS_WOUT1 = WS_WOUT0 + (size_t)1024 * 1024 * 2;
constexpr size_t WS_WMOE  = WS_WOUT1 + (size_t)1024 * 1024 * 2;
constexpr size_t WS_XRES  = WS_WMOE + (size_t)16 * 1024 * 1024 * 2 + (size_t)16 * 1024 * 512 * 2;
constexpr size_t WS_HB    = WS_XRES + (size_t)MT * 1024 * 4;
constexpr size_t WS_PROJ  = WS_HB + (size_t)MT * 1024 * 2;
constexpr size_t WS_Y     = WS_PROJ + (size_t)MT * 3072 * 2;
constexpr size_t WS_END   = WS_Y + (size_t)MT * 1024 * 4;
static_assert(WS_END < 349000000, "workspace too large");

constexpr int CW_CNT = 0;
constexpr int CW_BAR = 1024;
constexpr int LDS_BYTES = 160 * 1024;

struct PK { const float* in[31]; float* out; unsigned char* ws; };
typedef __attribute__((address_space(4))) const unsigned char* kaptr_t;
struct InTab { __device__ __forceinline__ const float* operator[](int i) const {
    kaptr_t ka = (kaptr_t)__builtin_amdgcn_kernarg_segment_ptr(); asm volatile("" : "+s"(ka)); return *(const float* __attribute__((address_space(4))) const*)(ka + i * 8); } };
struct P { InTab in;
    __device__ __forceinline__ float* get_out() const { kaptr_t ka = (kaptr_t)__builtin_amdgcn_kernarg_segment_ptr(); asm volatile("" : "+s"(ka)); return *(float* __attribute__((address_space(4))) const*)(ka + 31 * 8); }
    __device__ __forceinline__ unsigned char* get_ws() const { kaptr_t ka = (kaptr_t)__builtin_amdgcn_kernarg_segment_ptr(); asm volatile("" : "+s"(ka)); return *(unsigned char* __attribute__((address_space(4))) const*)(ka + 32 * 8); } };

__device__ __forceinline__ float bf2f(bf16_t b) { return __uint_as_float((u32)b << 16); }
__device__ __forceinline__ bf16_t f2bf(float f) { u32 u = __float_as_uint(f); u += 0x7FFFu + ((u >> 16) & 1u); return (bf16_t)(u >> 16); }
__device__ __forceinline__ u32 pack2(float a, float b) { return (u32)f2bf(a) | ((u32)f2bf(b) << 16); }
__device__ __forceinline__ float siluf(float x) { return x / (1.f + __expf(-x)); }
__device__ __forceinline__ float sigmf(float x) { return 1.f / (1.f + __expf(-x)); }
__device__ __forceinline__ float softplusf(float x) { return x > 20.f ? x : log1pf(__expf(x)); }
__device__ __forceinline__ float logsigf(float x) { return x < -20.f ? x : -log1pf(__expf(-x)); }
__device__ __forceinline__ float wave_sum(float v) {
#pragma unroll
    for (int o = 32; o >= 1; o >>= 1) v += __shfl_xor(v, o);
    return v;
}
__device__ __forceinline__ int otid() { int t = threadIdx.x; asm volatile("" : "+v"(t)); return t; }
__device__ __forceinline__ float rdlane(float v, int l) { return __int_as_float(__builtin_amdgcn_readlane(__float_as_int(v), l)); }

__device__ __forceinline__ void phase_mods(const P& p, int bid, int nb, float* lds) {
    const int tid = otid();
    float* MODS = (float*)(p.get_ws() + WS_MODS);
    float* RC = (float*)(p.get_ws() + WS_ROPE); float* RS = RC + 256 * 16;
    for (int i = bid * NTH + tid; i < 256 * 16; i += nb * NTH) {
        const int pos = i >> 4, f = i & 15;
        const float inv = powf(10000.f, -(float)f / 16.f);
        const float ang = (float)pos * inv;
        RC[i] = cosf(ang); RS[i] = sinf(ang);
    }
    const float* c = p.in[1]; const float* cx = p.in[3];
    for (int i = tid; i < 1024; i += NTH) { const float a = c[i]; lds[i] = a / (1.f + expf(-a)); const float b = cx[i]; lds[1024 + i] = b / (1.f + expf(-b)); }
    __syncthreads();
    float* red = lds + 2048;
    const int tx = tid & 15, ty = tid >> 4;
    for (int item = bid; item < 192; item += nb) {
        const int l = item / 96, cgp = item % 96;
        const float* W = p.in[8] + (size_t)l * 1024 * 6144 + cgp * 64 + tx * 4;
        float4 ac = {0.f, 0.f, 0.f, 0.f}, ax = {0.f, 0.f, 0.f, 0.f};
#pragma unroll 8
        for (int k = ty; k < 1024; k += 32) {
            const float4 w = *(const float4*)(W + (size_t)k * 6144);
            const float sc = lds[k], sx = lds[1024 + k];
            ac.x += sc * w.x; ac.y += sc * w.y; ac.z += sc * w.z; ac.w += sc * w.w;
            ax.x += sx * w.x; ax.y += sx * w.y; ax.z += sx * w.z; ax.w += sx * w.w;
        }
        float* r = red + (ty * 16 + tx) * 8;
        r[0] = ac.x; r[1] = ac.y; r[2] = ac.z; r[3] = ac.w; r[4] = ax.x; r[5] = ax.y; r[6] = ax.z; r[7] = ax.w;
        __syncthreads();
        if (tid < 128) {
            const int col = tid & 63, which = tid >> 6;
            float s = 0.f;
            for (int y = 0; y < 32; ++y) s += red[(y * 16 + (col >> 2)) * 8 + which * 4 + (col & 3)];
            s += p.in[9][l * 6144 + cgp * 64 + col];
            MODS[(l * 2 + which) * 6144 + cgp * 64 + col] = s;
        }
        __syncthreads();
    }
}

struct RowArgs {
    int layer;
    int ffn;
    int src;
    int combine;
    int clayer;
    int final_out;
    int nrows;
    const float* wsm; int ldw; int wcol0;
    int route;
};

template <int NS> __forceinline__
__device__ __forceinline__ void phase_rows(const P& p, int bid, int nb, float* lds, const RowArgs a) {
    const int tid = otid(), lane = tid & 63, wid = tid >> 6;
    unsigned char* ws = p.get_ws();
    const float* MODS = (const float*)(ws + WS_MODS);
    float* XRES = (float*)(ws + WS_XRES);
    bf16_t* HB = (bf16_t*)(ws + WS_HB);
    float* SMALL = (float*)(ws + WS_SMALL);
    if (!a.final_out) {
        for (int i = tid; i < 1024 * NS; i += NTH) { const int k = i / NS, n = i % NS; lds[i] = a.wsm[(size_t)k * a.ldw + a.wcol0 + n]; }
    }
    __syncthreads();
    const float* gamma = (a.ffn ? p.in[7] : p.in[6]) + a.layer * 1024;
    const bf16_t* YMOE = (const bf16_t*)(ws + WS_PROJ);
    const int2* SLOT = (const int2*)(ws + WS_SLOT);
    const float2* GATE = (const float2*)(ws + WS_GATE);
    for (int row = bid * 8 + wid; row < a.nrows; row += nb * 8) {
        const int which = row >= SEQ ? 1 : 0;
        const float* src = a.src ? XRES + (size_t)row * 1024 : (which ? p.in[2] + (size_t)(row - SEQ) * 1024 : p.in[0] + (size_t)row * 1024);
        float v[16];
#pragma unroll
        for (int i = 0; i < 4; ++i) { const float4 t = *(const float4*)(src + i * 256 + lane * 4); v[i * 4] = t.x; v[i * 4 + 1] = t.y; v[i * 4 + 2] = t.z; v[i * 4 + 3] = t.w; }
        if (a.combine) {
            const int2 sl = SLOT[row]; const float2 gt = GATE[row];
            const float* gf = MODS + (a.clayer * 2 + which) * 6144 + 5 * 1024;
#pragma unroll
            for (int i = 0; i < 4; ++i) {
                const uint2 y0 = *(const uint2*)(YMOE + (size_t)sl.x * 1024 + i * 256 + lane * 4);
                const uint2 y1 = *(const uint2*)(YMOE + (size_t)sl.y * 1024 + i * 256 + lane * 4);
                const float4 g = *(const float4*)(gf + i * 256 + lane * 4);
                v[i * 4 + 0] += g.x * (gt.x * bf2f((bf16_t)(y0.x & 0xffff)) + gt.y * bf2f((bf16_t)(y1.x & 0xffff)));
                v[i * 4 + 1] += g.y * (gt.x * bf2f((bf16_t)(y0.x >> 16)) + gt.y * bf2f((bf16_t)(y1.x >> 16)));
                v[i * 4 + 2] += g.z * (gt.x * bf2f((bf16_t)(y0.y & 0xffff)) + gt.y * bf2f((bf16_t)(y1.y & 0xffff)));
                v[i * 4 + 3] += g.w * (gt.x * bf2f((bf16_t)(y0.y >> 16)) + gt.y * bf2f((bf16_t)(y1.y >> 16)));
            }
            float* dst = a.final_out ? p.get_out() + (size_t)row * 1024 : XRES + (size_t)row * 1024;
#pragma unroll
            for (int i = 0; i < 4; ++i) *(float4*)(dst + i * 256 + lane * 4) = make_float4(v[i * 4], v[i * 4 + 1], v[i * 4 + 2], v[i * 4 + 3]);
            if (a.final_out) continue;
        }
        float ss = 0.f;
#pragma unroll
        for (int j = 0; j < 16; ++j) ss += v[j] * v[j];
        ss = wave_sum(ss);
        const float rs = rsqrtf(ss * (1.f / 1024.f) + 1e-6f);
        const float* md = MODS + (a.layer * 2 + which) * 6144 + (a.ffn ? 3 * 1024 : 0);
#pragma unroll
        for (int i = 0; i < 4; ++i) {
            const float4 g = *(const float4*)(gamma + i * 256 + lane * 4);
            const float4 sh = *(const float4*)(md + i * 256 + lane * 4);
            const float4 sc = *(const float4*)(md + 1024 + i * 256 + lane * 4);
            v[i * 4 + 0] = v[i * 4 + 0] * rs * g.x * (1.f + sc.x) + sh.x;
            v[i * 4 + 1] = v[i * 4 + 1] * rs * g.y * (1.f + sc.y) + sh.y;
            v[i * 4 + 2] = v[i * 4 + 2] * rs * g.z * (1.f + sc.z) + sh.z;
            v[i * 4 + 3] = v[i * 4 + 3] * rs * g.w * (1.f + sc.w) + sh.w;
            uint2 o; o.x = pack2(v[i * 4], v[i * 4 + 1]); o.y = pack2(v[i * 4 + 2], v[i * 4 + 3]);
            *(uint2*)(HB + (size_t)row * 1024 + i * 256 + lane * 4) = o;
        }
        float s[NS];
#pragma unroll
        for (int n = 0; n < NS; ++n) s[n] = 0.f;
#pragma unroll
        for (int i = 0; i < 4; ++i)
#pragma unroll
            for (int j = 0; j < 4; ++j) {
                const float* w = lds + (i * 256 + lane * 4 + j) * NS;
                const float x = v[i * 4 + j];
#pragma unroll
                for (int n = 0; n < NS; n += 4) { const float4 ww = *(const float4*)(w + n); s[n] += x * ww.x; s[n + 1] += x * ww.y; s[n + 2] += x * ww.z; s[n + 3] += x * ww.w; }
                asm volatile("" ::: "memory");
            }
#pragma unroll
        for (int n = 0; n < NS; ++n) s[n] = wave_sum(s[n]);
        if (!a.route) {
            if (lane == 0) {
#pragma unroll
                for (int n = 0; n < NS; n += 4) *(float4*)(SMALL + (size_t)row * 32 + n) = make_float4(s[n], s[n + 1], s[n + 2], s[n + 3]);
            }
        } else if (NS == 16) {
            if (lane == 0) {
                const float* rb = p.in[5];
                float sc[16], bs[16];
#pragma unroll
                for (int n = 0; n < 16; ++n) { sc[n] = 1.f / (1.f + expf(-s[n])); bs[n] = sc[n] + rb[n]; }
                int bg = 0; float bgs = -1e30f;
#pragma unroll
                for (int g = 0; g < 4; ++g) {
                    float m1 = -1e30f, m2 = -1e30f;
#pragma unroll
                    for (int j = 0; j < 4; ++j) { const float x = bs[g * 4 + j]; if (x > m1) { m2 = m1; m1 = x; } else if (x > m2) m2 = x; }
                    const float gs = m1 + m2;
                    if (gs > bgs) { bgs = gs; bg = g; }
                }
                int e0 = 0, e1 = 0; float b0 = -1e30f, b1 = -1e30f;
#pragma unroll
                for (int j = 0; j < 4; ++j) {
                    float x = 0.f; int e = 0;
#pragma unroll
                    for (int g = 0; g < 4; ++g) if (g == bg) { x = bs[g * 4 + j]; e = g * 4 + j; }
                    if (x > b0) { b1 = b0; e1 = e0; b0 = x; e0 = e; } else if (x > b1) { b1 = x; e1 = e; }
                }
                float w0 = 0.f, w1 = 0.f;
#pragma unroll
                for (int n = 0; n < 16; ++n) { if (n == e0) w0 = sc[n]; if (n == e1) w1 = sc[n]; }
                const float inv = 1.f / (w0 + w1);
                u32* cnt = (u32*)(ws + WS_CTL) + CW_CNT + a.layer * 16;
                const int p0 = (int)atomicAdd(cnt + e0, 1u), p1 = (int)atomicAdd(cnt + e1, 1u);
                ((int4*)(ws + WS_ROUTE))[row] = make_int4(e0, p0, e1, p1);
                ((float2*)(ws + WS_GATE))[row] = make_float2(w0 * inv, w1 * inv);
            }
        }
    }
}

__device__ __forceinline__ void phase_lists(const P& p, int bid, int nb, int layer, int nrows) {
    const int tid = otid();
    unsigned char* ws = p.get_ws();
    const u32* cnt = (const u32*)(ws + WS_CTL) + CW_CNT + layer * 16;
    int off[17]; off[0] = 0;
#pragma unroll
    for (int e = 0; e < 16; ++e) off[e + 1] = off[e] + (int)((cnt[e] + 255u) / 256u) * 256;
    int* LIST = (int*)(ws + WS_LIST); int2* SLOT = (int2*)(ws + WS_SLOT); int* TEXP = (int*)(ws + WS_TEXP);
    const int4* ROUTE = (const int4*)(ws + WS_ROUTE);
    for (int row = bid * NTH + tid; row < nrows; row += nb * NTH) {
        const int4 r = ROUTE[row];
        int o0 = 0, o1 = 0;
#pragma unroll
        for (int e = 0; e < 16; ++e) { if (e == r.x) o0 = off[e]; if (e == r.z) o1 = off[e]; }
        const int s0 = o0 + r.y, s1 = o1 + r.w;
        LIST[s0] = row; LIST[s1] = row; SLOT[row] = make_int2(s0, s1);
    }
    if (bid == 0) {
        for (int e = 0; e < 16; ++e) {
            const int c = (int)cnt[e];
            for (int i = off[e] + c + tid; i < off[e + 1]; i += NTH) LIST[i] = 0;
            for (int t = off[e] / 256 + tid; t < off[e + 1] / 256; t += NTH) TEXP[t] = e;
        }
        if (tid == 0) TEXP[255] = off[16] / 256;
    }
}

template <class AF, class WF, class EF>
__device__ __forceinline__ void gemm_naive(int ntm, int ntn, int K, int bid, int nb, float* lds, const AF& af, const WF& wf, const EF& ef) {
    const int tid = otid(), tx = tid & 15, ty = tid >> 4;
    float* As = lds;
    float* Bs = lds + 16 * 132;
    for (int t = bid; t < ntm * ntn; t += nb) {
        const int tm = t / ntn, tn = t % ntn;
        float acc[4][8];
#pragma unroll
        for (int i = 0; i < 4; ++i)
#pragma unroll
            for (int j = 0; j < 8; ++j) acc[i][j] = 0.f;
        const int lr = tid >> 2, lk = (tid & 3) * 4;
        const bf16_t* arow = af(tm * 128 + lr);
        const int bk = tid >> 5, bn = (tid & 31) * 4;
        for (int k0 = 0; k0 < K; k0 += 16) {
            const uint2 av = *(const uint2*)(arow + k0 + lk);
            const float4 bv = *(const float4*)wf(k0 + bk, tn * 128 + bn);
            __syncthreads();
            As[(lk + 0) * 132 + lr] = bf2f((bf16_t)(av.x & 0xffff)); As[(lk + 1) * 132 + lr] = bf2f((bf16_t)(av.x >> 16));
            As[(lk + 2) * 132 + lr] = bf2f((bf16_t)(av.y & 0xffff)); As[(lk + 3) * 132 + lr] = bf2f((bf16_t)(av.y >> 16));
            *(float4*)(Bs + bk * 132 + bn) = make_float4(bf2f(f2bf(bv.x)), bf2f(f2bf(bv.y)), bf2f(f2bf(bv.z)), bf2f(f2bf(bv.w)));
            __syncthreads();
#pragma unroll
            for (int k = 0; k < 16; ++k) {
                const float4 a4 = *(const float4*)(As + k * 132 + ty * 4);
                const float4 b0 = *(const float4*)(Bs + k * 132 + tx * 8), b1 = *(const float4*)(Bs + k * 132 + tx * 8 + 4);
                const float aa[4] = {a4.x, a4.y, a4.z, a4.w}; const float bb[8] = {b0.x, b0.y, b0.z, b0.w, b1.x, b1.y, b1.z, b1.w};
#pragma unroll
                for (int i = 0; i < 4; ++i)
#pragma unroll
                    for (int j = 0; j < 8; ++j) acc[i][j] += aa[i] * bb[j];
            }
        }
#pragma unroll
        for (int i = 0; i < 4; ++i) ef(tm * 128 + ty * 4 + i, tn * 128 + tx * 8, acc[i]);
    }
}


namespace g8 {
#define G8_LAS __attribute__((address_space(3)))
typedef short bf16x8 __attribute__((ext_vector_type(8)));
typedef float f32x4 __attribute__((ext_vector_type(4)));
constexpr int BM = 256, BK = 64, HALF = 128, HTB = HALF * BK * 2, STAGE_BYTES = 8 * HTB, NXCD = 8, WGM = 8;
__device__ __forceinline__ int lds_byte(int r, int c) { const int st = (r >> 4) * 2 + (c >> 5), rr = r & 15, cc = c & 31, ob = rr * 64 + cc * 2; return st * 1024 + (ob ^ (((ob >> 9) & 1) << 5)); }
__device__ __forceinline__ void stage_rc(int b, int& R, int& C) { const int st = b / 1024, sb = b % 1024, swz = sb ^ (((sb >> 9) & 1) << 5); R = (st >> 1) * 16 + swz / 64; C = (st & 1) * 32 + (swz % 64) / 2; }
__device__ __forceinline__ int perm32(int rho) { const int n = rho >> 4, i = rho & 15; return 8 * (i >> 2) + 4 * n + (i & 3); }
struct Unit { int pm, pn; };
struct Order {
    int nM, nN, nwg, G, c;
    __device__ __forceinline__ void init(int nM_, int nN_, int G_, int c_) { nM = nM_; nN = nN_; nwg = nM * nN; G = G_; c = c_; }
    __device__ __forceinline__ bool next(int i, Unit& u) const {
        const long L = (long)i * G + c; if (L >= nwg) return false;
        int wgid = (int)L; { const int q = nwg / NXCD, r = nwg % NXCD, xcd = wgid % NXCD, off = wgid / NXCD; wgid = (xcd < r ? xcd * (q + 1) : r * (q + 1) + (xcd - r) * q) + off; }
        const int nig = WGM * nN, gid = wgid / nig, fm = gid * WGM, gsz = (nM - fm) < WGM ? (nM - fm) : WGM;
        u.pm = fm + ((wgid % nig) % gsz); u.pn = (wgid % nig) / gsz; return true;
    }
};
template <bool GATHER, class BSel, class EF>
__device__ __forceinline__ void gemm8(G8_LAS unsigned char* lds, const bf16_t* A, int K, const int* list, const Order& S, const BSel& bsel, const EF& ef) {
    const int tid = otid(), wid = __builtin_amdgcn_readfirstlane(tid >> 6), lane = tid & 63, wr = wid >> 2, wc = wid & 3, fr = lane & 15, fq = lane >> 4;
    const int nt = K / BK;
    int R0, C0, R1, C1; stage_rc(tid * 16, R0, C0); stage_rc(tid * 16 + 8192, R1, C1);
    const unsigned vb0 = (unsigned)(((R0 & ~31) + perm32(R0 & 31)) * K + C0) * 2u, vb1 = (unsigned)(((R1 & ~31) + perm32(R1 & 31)) * K + C1) * 2u;
    const size_t kstep = (size_t)(BK * 2), hstep = (size_t)HALF * K * 2, tstep = 2 * hstep;
    const unsigned ldsw = (unsigned)wid * 1024u;
    const int aoff = lds_byte(wr * 64 + fr, fq * 8), boff = lds_byte(wc * 32 + fr, fq * 8);
#define G8_SA(b, h) (((b) * 2 + (h)) * HTB)
#define G8_SB(b, h) ((4 + (b) * 2 + (h)) * HTB)
#define G8_STAGE(bufoff, gbase, v0, v1) do { \
        __builtin_amdgcn_global_load_lds((const unsigned*)((const char*)(gbase) + (v0)), (G8_LAS unsigned*)(lds + (bufoff) + ldsw), 16, 0, 0); \
        __builtin_amdgcn_global_load_lds((const unsigned*)((const char*)(gbase) + (v1)), (G8_LAS unsigned*)(lds + (bufoff) + ldsw + 8192), 16, 0, 0); } while (0)
#define G8_LDA(dst, b, h) do { _Pragma("unroll") for (int m = 0; m < 4; ++m) _Pragma("unroll") for (int k = 0; k < 2; ++k) dst[m][k] = *(const G8_LAS bf16x8*)(lds + G8_SA(b, h) + aoff + m * 2048 + k * 1024); } while (0)
#define G8_LDB(dst, b, h) do { _Pragma("unroll") for (int n = 0; n < 2; ++n) _Pragma("unroll") for (int k = 0; k < 2; ++k) dst[n][k] = *(const G8_LAS bf16x8*)(lds + G8_SB(b, h) + boff + n * 2048 + k * 1024); } while (0)
#define G8_MMA(ai, bj, At, Bt) do { __builtin_amdgcn_s_setprio(1); _Pragma("unroll") for (int m = 0; m < 4; ++m) _Pragma("unroll") for (int n = 0; n < 2; ++n) _Pragma("unroll") for (int k = 0; k < 2; ++k) \
        acc[ai][bj][m][n] = __builtin_amdgcn_mfma_f32_16x16x32_bf16(Bt[n][k], At[m][k], acc[ai][bj][m][n], 0, 0, 0); __builtin_amdgcn_s_setprio(0); } while (0)
#define G8_WAIT_V(n) asm volatile("s_waitcnt vmcnt(" #n ")" ::: "memory")
#define G8_WAIT_L(n) asm volatile("s_waitcnt lgkmcnt(" #n ")" ::: "memory")
#define G8_BAR __builtin_amdgcn_s_barrier()
#define G8_SCHED __builtin_amdgcn_sched_barrier(0)
#define G8_AOFF(pm_, h_, R_, C_) ((unsigned)((GATHER ? list[(pm_) * 256 + (h_) * 128 + (R_)] : ((pm_) * 256 + (h_) * 128 + (R_))) * K + (C_)) * 2u)
    Unit cur, nxt; int ui = 0;
    if (!S.next(0, cur)) return;
    f32x4 acc[2][2][4][2];
#pragma unroll
    for (int a = 0; a < 2; ++a)
#pragma unroll
        for (int b = 0; b < 2; ++b)
#pragma unroll
            for (int m = 0; m < 4; ++m)
#pragma unroll
                for (int n = 0; n < 2; ++n) acc[a][b][m][n] = (f32x4){0.f, 0.f, 0.f, 0.f};
    bf16x8 At[4][2], B0[2][2], B1[2][2];
    const char* Ab = (const char*)A;
    unsigned a00 = G8_AOFF(cur.pm, 0, R0, C0), a01 = G8_AOFF(cur.pm, 0, R1, C1), a10 = G8_AOFF(cur.pm, 1, R0, C0), a11 = G8_AOFF(cur.pm, 1, R1, C1);
    const char* cB = bsel(cur.pm) + (size_t)cur.pn * tstep;
    G8_STAGE(G8_SB(0, 0), cB, vb0, vb1); G8_STAGE(G8_SA(0, 0), Ab, a00, a01); G8_STAGE(G8_SB(0, 1), cB + hstep, vb0, vb1); G8_STAGE(G8_SA(0, 1), Ab, a10, a11);
    if (wr == 1) G8_BAR;
    G8_WAIT_V(4); G8_BAR;
    G8_STAGE(G8_SB(1, 0), cB + kstep, vb0, vb1); G8_STAGE(G8_SA(1, 0), Ab + kstep, a00, a01); G8_STAGE(G8_SB(1, 1), cB + hstep + kstep, vb0, vb1);
    G8_WAIT_V(6); G8_BAR;
    for (;;) {
        const bool has_next = S.next(ui + 1, nxt);
        unsigned n00 = a00, n01 = a01, n10 = a10, n11 = a11; const char* nB = cB;
        if (has_next) { n00 = G8_AOFF(nxt.pm, 0, R0, C0); n01 = G8_AOFF(nxt.pm, 0, R1, C1); n10 = G8_AOFF(nxt.pm, 1, R0, C0); n11 = G8_AOFF(nxt.pm, 1, R1, C1); nB = bsel(nxt.pm) + (size_t)nxt.pn * tstep; }
        for (int t = 0; t < nt; t += 2) {
            const bool last = (t == nt - 2);
            const char* a1p = Ab + (size_t)(t + 1) * kstep;
            const char* a2p = last ? Ab : Ab + (size_t)(t + 2) * kstep; const char* b2 = last ? nB : cB + (size_t)(t + 2) * kstep;
            const char* a3p = a2p + kstep; const char* b3 = b2 + kstep;
            const unsigned x00 = last ? n00 : a00, x01 = last ? n01 : a01, x10 = last ? n10 : a10, x11 = last ? n11 : a11;
            G8_LDB(B0, 0, 0); G8_SCHED; G8_LDA(At, 0, 0); G8_STAGE(G8_SA(1, 1), a1p, a10, a11);
            G8_WAIT_L(8); G8_BAR; G8_WAIT_L(0); G8_MMA(0, 0, At, B0); G8_BAR; G8_SCHED;
            G8_LDB(B1, 0, 1); G8_STAGE(G8_SB(0, 0), b2, vb0, vb1);
            G8_BAR; G8_WAIT_L(0); G8_MMA(0, 1, At, B1); G8_BAR;
            G8_LDA(At, 0, 1); G8_STAGE(G8_SA(0, 0), a2p, x00, x01);
            G8_BAR; G8_WAIT_L(0); G8_MMA(1, 0, At, B0); G8_BAR; G8_SCHED;
            G8_STAGE(G8_SB(0, 1), b2 + hstep, vb0, vb1);
            G8_WAIT_V(6); G8_BAR; G8_MMA(1, 1, At, B1); G8_BAR;
            G8_LDB(B0, 1, 0); G8_SCHED; G8_LDA(At, 1, 0); G8_STAGE(G8_SA(0, 1), a2p, x10, x11);
            G8_WAIT_L(8); G8_BAR; G8_WAIT_L(0); G8_MMA(0, 0, At, B0); G8_BAR; G8_SCHED;
            G8_LDB(B1, 1, 1); G8_STAGE(G8_SB(1, 0), b3, vb0, vb1);
            G8_BAR; G8_WAIT_L(0); G8_MMA(0, 1, At, B1); G8_BAR;
            G8_LDA(At, 1, 1); G8_STAGE(G8_SA(1, 0), a3p, x00, x01);
            G8_BAR; G8_WAIT_L(0); G8_MMA(1, 0, At, B0); G8_BAR; G8_SCHED;
            G8_STAGE(G8_SB(1, 1), b3 + hstep, vb0, vb1);
            G8_WAIT_V(6); G8_BAR; G8_MMA(1, 1, At, B1); G8_BAR;
        }
#pragma unroll
        for (int ai = 0; ai < 2; ++ai)
#pragma unroll
            for (int m = 0; m < 4; ++m)
#pragma unroll
                for (int bj = 0; bj < 2; ++bj) {
                    const f32x4 v0 = acc[ai][bj][m][0], v1 = acc[ai][bj][m][1];
                    const float v[8] = {v0[0], v0[1], v0[2], v0[3], v1[0], v1[1], v1[2], v1[3]};
                    ef(cur.pm * BM + ai * HALF + wr * 64 + m * 16 + fr, cur.pn * BM + bj * HALF + wc * 32 + 8 * fq, v);
                }
        if (!has_next) break;
#pragma unroll
        for (int a = 0; a < 2; ++a)
#pragma unroll
            for (int b = 0; b < 2; ++b)
#pragma unroll
                for (int m = 0; m < 4; ++m)
#pragma unroll
                    for (int n = 0; n < 2; ++n) acc[a][b][m][n] = (f32x4){0.f, 0.f, 0.f, 0.f};
        cur = nxt; a00 = n00; a01 = n01; a10 = n10; a11 = n11; cB = nB; ++ui;
    }
    G8_WAIT_V(0);
    if (wr == 0) G8_BAR;
    G8_BAR;
#undef G8_SA
#undef G8_SB
#undef G8_STAGE
#undef G8_LDA
#undef G8_LDB
#undef G8_MMA
#undef G8_WAIT_V
#undef G8_WAIT_L
#undef G8_BAR
#undef G8_SCHED
#undef G8_AOFF
}
}
struct BSelOne { const char* B; __device__ __forceinline__ const char* operator()(int) const { return B; } };
struct BSelExp { const char* B; const int* texp; size_t stride; __device__ __forceinline__ const char* operator()(int pm) const { return B + (size_t)texp[pm] * stride; } };

struct SrcPlain { const float* W; int ldw; __device__ __forceinline__ const float* operator()(int k, int n) const { return W + (size_t)k * ldw + n; } };
struct SrcEven { const float* W; __device__ __forceinline__ const float* operator()(int k, int n) const { return W + (size_t)k * EV_IN + (n < 1280 ? n : n + 16); } };
struct SrcMoe13 { const float* W1; long long d13; __device__ __forceinline__ const float* operator()(int k, int n) const { return W1 + ((n & 4) ? d13 : 0ll) + (size_t)k * DE + ((n >> 3) * 4 + (n & 3)); } };
template <class SF>
__device__ __forceinline__ void conv_matrix(const SF& src, int K, int N, bf16_t* WT, int gw, int ngw, float* scr, int lane) {
    const int nblk = N / 32, nitems = (K / 64) * nblk;
    for (int item = gw; item < nitems; item += ngw) {
        const int kb = item / nblk, nbk = item % nblk, k0 = 64 * kb, n0 = 32 * nbk;
#pragma unroll 8
        for (int i = 0; i < 32; ++i) { const int kk = 2 * i + (lane >> 5); scr[kk * 33 + (lane & 31)] = *src(k0 + kk, n0 + (lane & 31)); }
        __builtin_amdgcn_s_waitcnt(0xC07F); asm volatile("" ::: "memory");
        const int c = lane & 7;
#pragma unroll
        for (int j = 0; j < 4; ++j) { const int n = (lane >> 3) + 8 * j; const float* sp = scr + (8 * c) * 33 + n;
            uint4 o; o.x = pack2(sp[0 * 33], sp[1 * 33]); o.y = pack2(sp[2 * 33], sp[3 * 33]); o.z = pack2(sp[4 * 33], sp[5 * 33]); o.w = pack2(sp[6 * 33], sp[7 * 33]);
            *(uint4*)(WT + (size_t)(n0 + n) * K + k0 + 8 * c) = o; }
        __builtin_amdgcn_s_waitcnt(0xC07F); asm volatile("" ::: "memory");
    }
}
__device__ __forceinline__ void conv_dense(const P& p, int bid, int nb, float* lds) {
    const int tid = otid(), lane = tid & 63, wid = tid >> 6;
    float* scr = lds + 16384 + wid * (64 * 33);
    const int gw = bid * 8 + wid, ngw = nb * 8;
    unsigned char* ws = p.get_ws();
    conv_matrix(SrcEven{p.in[10]}, 1024, 2048, (bf16_t*)(ws + WS_WIN0), gw, ngw, scr, lane);
    conv_matrix(SrcPlain{p.in[21], OD_IN}, 1024, 3072, (bf16_t*)(ws + WS_WIN1), gw, ngw, scr, lane);
    conv_matrix(SrcPlain{p.in[20], 1024}, 1024, 1024, (bf16_t*)(ws + WS_WOUT0), gw, ngw, scr, lane);
    conv_matrix(SrcPlain{p.in[27], 1024}, 1024, 1024, (bf16_t*)(ws + WS_WOUT1), gw, ngw, scr, lane);
}
__device__ __forceinline__ void conv_moe(const P& p, int bid, int nb, float* lds, int layer) {
    const int tid = otid(), lane = tid & 63, wid = tid >> 6;
    float* scr = lds + 16384 + wid * (64 * 33);
    const int ngw = nb * 8; int gw = bid * 8 + wid;
    unsigned char* ws = p.get_ws();
    bf16_t* W13T = (bf16_t*)(ws + WS_WMOE); bf16_t* W2T = W13T + (size_t)16 * 1024 * 1024;
    const long long d13 = (long long)(p.in[29] - p.in[28]);
    for (int e = 0; e < 16; ++e) {
        conv_matrix(SrcMoe13{p.in[28] + ((size_t)layer * 16 + e) * 1024 * DE, d13}, 1024, 1024, W13T + (size_t)e * 1024 * 1024, gw, ngw, scr, lane);
        conv_matrix(SrcPlain{p.in[30] + ((size_t)layer * 16 + e) * DE * 1024, 1024}, DE, 1024, W2T + (size_t)e * 1024 * DE, gw, ngw, scr, lane);
        gw = (gw + 768) % ngw;
    }
}

struct ARowPlain { const bf16_t* A; int ld; __device__ const bf16_t* operator()(int m) const { return A + (size_t)m * ld; } };
struct ARowGather { const bf16_t* A; int ld; const int* list; __device__ const bf16_t* operator()(int m) const { return A + (size_t)list[m] * ld; } };
struct WEven { const float* W; __device__ const float* operator()(int k, int n) const { return W + (size_t)k * EV_IN + (n < 1280 ? n : n + 16); } };
struct WPlain { const float* W; int ldw; __device__ const float* operator()(int k, int n) const { return W + (size_t)k * ldw + n; } };
struct WMoe13 { const float* W1; long long d13;
    __device__ const float* operator()(int k, int n) const { const int j = (n >> 3) * 4 + (n & 3); return W1 + ((n & 4) ? d13 : 0ll) + (size_t)k * DE + j; } };
struct EpiBf16Store { bf16_t* C; int ld; __device__ void operator()(int r, int c0, const float* v) const {
    uint4 o; o.x = pack2(v[0], v[1]); o.y = pack2(v[2], v[3]); o.z = pack2(v[4], v[5]); o.w = pack2(v[6], v[7]); *(uint4*)(C + (size_t)r * ld + c0) = o; } };
struct EpiResid { const float* xlat; const float* xctx; float* XRES; const float* gl; const float* gc;
    __device__ void operator()(int r, int c0, const float* v) const {
        const float* xin = xctx && r >= SEQ ? xctx + (size_t)(r - SEQ) * 1024 : xlat + (size_t)r * 1024;
        const float* g = r >= SEQ ? gc : gl;
        const float4 x0 = *(const float4*)(xin + c0), x1 = *(const float4*)(xin + c0 + 4), g0 = *(const float4*)(g + c0), g1 = *(const float4*)(g + c0 + 4);
        *(float4*)(XRES + (size_t)r * 1024 + c0) = make_float4(x0.x + g0.x * v[0], x0.y + g0.y * v[1], x0.z + g0.z * v[2], x0.w + g0.w * v[3]);
        *(float4*)(XRES + (size_t)r * 1024 + c0 + 4) = make_float4(x1.x + g1.x * v[4], x1.y + g1.y * v[5], x1.z + g1.z * v[6], x1.w + g1.w * v[7]);
    } };
struct EpiSwiglu { bf16_t* H; __device__ void operator()(int r, int c0, const float* v) const {
    uint2 o; o.x = pack2(siluf(v[0]) * v[4], siluf(v[1]) * v[5]); o.y = pack2(siluf(v[2]) * v[6], siluf(v[3]) * v[7]); *(uint2*)(H + (size_t)r * DE + (c0 >> 3) * 4) = o; } };

__device__ __forceinline__ void phase_moe1_naive(const P& p, int bid, int nb, float* lds, int layer) {
    unsigned char* ws = p.get_ws(); const int* TEXP = (const int*)(ws + WS_TEXP); const int nt256 = TEXP[255];
    const int* LIST = (const int*)(ws + WS_LIST);
    for (int e = 0; e < 16; ++e) {
        int t0 = -1, t1 = -1;
        for (int t = 0; t < nt256; ++t) if (TEXP[t] == e) { if (t0 < 0) t0 = t; t1 = t + 1; }
        if (t0 < 0) continue;
        const int ntm = (t1 - t0) * 2;
        ARowGather af{(const bf16_t*)(ws + WS_HB), 1024, LIST + t0 * 256};
        WMoe13 wf{p.in[28] + ((size_t)layer * 16 + e) * 1024 * DE, (long long)(p.in[29] - p.in[28])};
        EpiSwiglu ef{(bf16_t*)(ws + WS_Y) + (size_t)t0 * 256 * DE};
        const int rb = (bid + e * 37) % nb;
        gemm_naive(ntm, 8, 1024, rb, nb, lds, af, wf, ef);
    }
}
__device__ __forceinline__ void phase_moe2_naive(const P& p, int bid, int nb, float* lds, int layer) {
    unsigned char* ws = p.get_ws(); const int* TEXP = (const int*)(ws + WS_TEXP); const int nt256 = TEXP[255];
    for (int e = 0; e < 16; ++e) {
        int t0 = -1, t1 = -1;
        for (int t = 0; t < nt256; ++t) if (TEXP[t] == e) { if (t0 < 0) t0 = t; t1 = t + 1; }
        if (t0 < 0) continue;
        const int ntm = (t1 - t0) * 2;
        ARowPlain af{(const bf16_t*)(ws + WS_Y) + (size_t)t0 * 256 * DE, DE};
        WPlain wf{p.in[30] + ((size_t)layer * 16 + e) * DE * 1024, 1024};
        EpiBf16Store ef{(bf16_t*)(ws + WS_PROJ) + (size_t)t0 * 256 * 1024, 1024};
        const int rb = (bid + e * 37) % nb;
        gemm_naive(ntm, 8, DE, rb, nb, lds, af, wf, ef);
    }
}

__device__ __forceinline__ void phase_moe1(const P& p, int bid, int nb, G8_LAS unsigned char* ldsa) {
    unsigned char* ws = p.get_ws(); const int* TEXP = (const int*)(ws + WS_TEXP);
    g8::Order S; S.init(TEXP[255], 4, nb, bid);
    EpiSwiglu ef{(bf16_t*)(ws + WS_Y)};
    g8::gemm8<true>(ldsa, (const bf16_t*)(ws + WS_HB), 1024, (const int*)(ws + WS_LIST), S, BSelExp{(const char*)(ws + WS_WMOE), TEXP, (size_t)1024 * 1024 * 2}, ef);
}
__device__ __forceinline__ void phase_moe2(const P& p, int bid, int nb, G8_LAS unsigned char* ldsa) {
    unsigned char* ws = p.get_ws(); const int* TEXP = (const int*)(ws + WS_TEXP);
    g8::Order S; S.init(TEXP[255], 4, nb, bid);
    EpiBf16Store ef{(bf16_t*)(ws + WS_PROJ), 1024};
    g8::gemm8<false>(ldsa, (const bf16_t*)(ws + WS_Y), DE, nullptr, S, BSelExp{(const char*)(ws + WS_WMOE) + (size_t)16 * 1024 * 1024 * 2, TEXP, (size_t)1024 * DE * 2}, ef);
}

__device__ __forceinline__ void phase_qkprep(const P& p, int bid, int nb) {
    const int tid = otid(), lane = tid & 63, wid = tid >> 6;
    unsigned char* ws = p.get_ws();
    const bf16_t* PROJ = (const bf16_t*)(ws + WS_PROJ);
    bf16_t* QKR = (bf16_t*)(ws + WS_XRES);
    const float* RC = (const float*)(ws + WS_ROPE); const float* RS = RC + 256 * 16;
    const float qn = p.in[17][lane], kn = p.in[18][lane];
    for (int row = bid * 8 + wid; row < MT; row += nb * 8) {
        const bool lat = row < SEQ;
        const int pos = lane < 32 ? (row >> 6) : (row & 63);
        const int f = lane & 15;
        const float cs = lat ? RC[pos * 16 + f] : 1.f, sn = lat ? RS[pos * 16 + f] : 0.f;
        for (int h = 0; h < 10; ++h) {
            const float x = bf2f(PROJ[(size_t)row * 2048 + 1280 + h * 64 + lane]);
            const float ss = wave_sum(x * x);
            const float y = x * rsqrtf(ss * (1.f / 64.f) + 1e-6f) * (h < 8 ? qn : kn);
            const float o = __shfl_xor(y, 16);
            const float r = ((lane & 16) == 0) ? y * cs - o * sn : o * sn + y * cs;
            QKR[(size_t)row * 640 + h * 64 + lane] = f2bf(r);
        }
    }
}

__device__ __forceinline__ void ssd_scan_naive(const P& p, int dh, float* lds) {
    const int lane = otid() & 63;
    const int d = dh >> 3, h = dh & 7, g = h >> 2;
    unsigned char* ws = p.get_ws();
    const bf16_t* PROJ = (const bf16_t*)(ws + WS_PROJ);
    const float* SMALL = (const float*)(ws + WS_SMALL);
    float* Y = (float*)(ws + WS_Y) + (size_t)d * MT * 512;
    const float* cw = p.in[11]; const float* cb = p.in[12];
    const int chx = h * 64 + lane, chb = 512 + g * 64 + lane, chc = 640 + g * 64 + lane;
    const float wx0 = cw[chx], wx1 = cw[768 + chx], wx2 = cw[1536 + chx], bx = cb[chx];
    const float wb0 = cw[chb], wb1 = cw[768 + chb], wb2 = cw[1536 + chb], bb = cb[chb];
    const float wc0 = cw[chc], wc1 = cw[768 + chc], wc2 = cw[1536 + chc], bc = cb[chc];
    const float A = -expf(p.in[14][d * 8 + h]);
    const float dtb = p.in[13][d * 8 + h];
    float st[64];
#pragma unroll
    for (int n = 0; n < 64; ++n) st[n] = 0.f;
    float* tx = lds;
    float* tb = lds + 66 * 64;
    float* tc = lds + 2 * 66 * 64;
    float* tdt = lds + 3 * 66 * 64;
    for (int seg = 0; seg < 2; ++seg) {
        const int L = seg == 0 ? CTX : SEQ, base = seg == 0 ? SEQ : 0;
        for (int k = 0; k < L / 64; ++k) {
            const int tbs = d ? L - 64 - k * 64 : k * 64;
            for (int r = 0; r < 66; ++r) {
                const int t = tbs - 1 + r;
                float vx = 0.f, vb = 0.f, vc = 0.f;
                if (t >= 0 && t < L) { const bf16_t* pr = PROJ + (size_t)(base + t) * 2048 + 512; vx = bf2f(pr[chx]); vb = bf2f(pr[chb]); vc = bf2f(pr[chc]); }
                tx[r * 64 + lane] = vx; tb[r * 64 + lane] = vb; tc[r * 64 + lane] = vc;
            }
            { const float dtr = SMALL[(size_t)(base + tbs + lane) * 32 + d * 8 + h] + dtb; const float dt = softplusf(dtr); tdt[lane] = dt; tdt[64 + lane] = __expf(dt * A); }
            __builtin_amdgcn_s_waitcnt(0);
            __builtin_amdgcn_wave_barrier();
            for (int s = 0; s < 64; ++s) {
                const int tl = d ? 63 - s : s; const int r = tl + 1;
                const float xv = siluf(wx0 * tx[(r - 1) * 64 + lane] + wx1 * tx[r * 64 + lane] + wx2 * tx[(r + 1) * 64 + lane] + bx);
                const float bv = siluf(wb0 * tb[(r - 1) * 64 + lane] + wb1 * tb[r * 64 + lane] + wb2 * tb[(r + 1) * 64 + lane] + bb);
                const float cv = siluf(wc0 * tc[(r - 1) * 64 + lane] + wc1 * tc[r * 64 + lane] + wc2 * tc[(r + 1) * 64 + lane] + bc);
                const float dt = tdt[tl], a = tdt[64 + tl];
                const float xd = xv * dt;
                float y = 0.f;
#pragma unroll
                for (int n = 0; n < 64; ++n) { st[n] = a * st[n] + xd * rdlane(bv, n); y += rdlane(cv, n) * st[n]; }
                Y[(size_t)(base + tbs + tl) * 512 + h * 64 + lane] = y;
            }
            __builtin_amdgcn_wave_barrier();
        }
    }
}

__device__ __forceinline__ void attn_naive_item(const P& p, int row, int hq, int half) {
    unsigned char* ws = p.get_ws();
    const bf16_t* PROJ = (const bf16_t*)(ws + WS_PROJ);
    const bf16_t* QKR = (const bf16_t*)(ws + WS_XRES);
    bf16_t* MIX = (bf16_t*)(ws + WS_HB);
    const int g = hq >> 2;
    float q[64], o[32];
    { const bf16_t* qp = QKR + (size_t)row * 640 + hq * 64;
#pragma unroll
      for (int dd = 0; dd < 64; ++dd) q[dd] = bf2f(qp[dd]) * 0.125f;
#pragma unroll
      for (int dd = 0; dd < 32; ++dd) o[dd] = 0.f; }
    const float sink = p.in[19][hq];
    float m = sink, l = 1.f;
    const bool lat = row < SEQ;
    int j0 = 0, j1 = -1;
    if (lat) { j0 = row - 128 < 0 ? 0 : row - 128; j1 = row + 128 > SEQ - 1 ? SEQ - 1 : row + 128; }
    const int nloc = j1 - j0 + 1;
    for (int jj = 0; jj < nloc + CTX; ++jj) {
        const int kr = jj < nloc ? j0 + jj : SEQ + (jj - nloc);
        const bf16_t* kp = QKR + (size_t)kr * 640 + 512 + g * 64;
        float s = 0.f;
#pragma unroll
        for (int dd = 0; dd < 64; dd += 2) { const u32 w = *(const u32*)(kp + dd); s += q[dd] * bf2f((bf16_t)(w & 0xffff)) + q[dd + 1] * bf2f((bf16_t)(w >> 16)); }
        const float mn = fmaxf(m, s);
        const float al = __expf(m - mn), pe = __expf(s - mn);
        l = l * al + pe; m = mn;
        const bf16_t* vp = PROJ + (size_t)kr * 2048 + 1920 + g * 64 + half * 32;
#pragma unroll
        for (int dd = 0; dd < 32; dd += 2) { const u32 w = *(const u32*)(vp + dd); o[dd] = o[dd] * al + pe * bf2f((bf16_t)(w & 0xffff)); o[dd + 1] = o[dd + 1] * al + pe * bf2f((bf16_t)(w >> 16)); }
    }
    const float inv = 1.f / l;
    bf16_t* op = MIX + (size_t)row * 1024 + 512 + hq * 64 + half * 32;
#pragma unroll
    for (int dd = 0; dd < 32; dd += 2) *(u32*)(op + dd) = pack2(o[dd] * inv, o[dd + 1] * inv);
}

__device__ __forceinline__ void phase_attn_naive(const P& p, int bid, int nb) {
    const int tid = otid();
    for (int it = bid * NTH + tid; it < MT * 16; it += nb * NTH) attn_naive_item(p, it >> 4, (it >> 1) & 7, it & 1);
}
__device__ __forceinline__ void phase_mix0_naive(const P& p, int bid, int nb, float* lds) {
    const int tid = otid(), wid = tid >> 6;
    const bool scanner = bid < 16 && wid == 0;
    if (scanner) { ssd_scan_naive(p, bid, lds); return; }
    const int nwaves = nb * 8 - 16;
    const int wv = bid < 16 ? bid * 7 + (wid - 1) : 16 * 7 + (bid - 16) * 8 + wid;
    for (int it = wv * 64 + (tid & 63); it < MT * 16; it += nwaves * 64) attn_naive_item(p, it >> 4, (it >> 1) & 7, it & 1);
}

__device__ __forceinline__ void phase_ssdout(const P& p, int bid, int nb) {
    const int tid = otid(), lane = tid & 63, wid = tid >> 6;
    unsigned char* ws = p.get_ws();
    const bf16_t* PROJ = (const bf16_t*)(ws + WS_PROJ);
    const float* Y0 = (const float*)(ws + WS_Y); const float* Y1 = Y0 + (size_t)MT * 512;
    bf16_t* MIX = (bf16_t*)(ws + WS_HB);
    const float* cw = p.in[11]; const float* cb = p.in[12];
    for (int row = bid * 8 + wid; row < MT; row += nb * 8) {
        const bool lat = row < SEQ; const int t = lat ? row : row - SEQ, L = lat ? SEQ : CTX;
        float u[8]; float ss = 0.f;
#pragma unroll
        for (int j = 0; j < 8; ++j) {
            const int c = lane * 8 + j;
            const float xm = t > 0 ? bf2f(PROJ[(size_t)(row - 1) * 2048 + 512 + c]) : 0.f;
            const float x0 = bf2f(PROJ[(size_t)row * 2048 + 512 + c]);
            const float xp = t < L - 1 ? bf2f(PROJ[(size_t)(row + 1) * 2048 + 512 + c]) : 0.f;
            const float xs = siluf(cw[c] * xm + cw[768 + c] * x0 + cw[1536 + c] * xp + cb[c]);
            const float y = Y0[(size_t)row * 512 + c] + Y1[(size_t)row * 512 + c] + p.in[15][c >> 6] * xs;
            const float z = bf2f(PROJ[(size_t)row * 2048 + c]);
            u[j] = y * siluf(z); ss += u[j] * u[j];
        }
        ss = wave_sum(ss);
        const float rs = rsqrtf(ss * (1.f / 512.f) + 1e-6f);
#pragma unroll
        for (int j = 0; j < 8; ++j) { const int c = lane * 8 + j; MIX[(size_t)row * 1024 + c] = f2bf(u[j] * rs * p.in[16][c]); }
    }
}


typedef short bf16x8 __attribute__((ext_vector_type(8)));
typedef float f32x4 __attribute__((ext_vector_type(4)));
template <int MI, int NI, int KK, bool SWAP>
__device__ __forceinline__ void wave_mma(f32x4 (&acc)[MI][NI], const bf16_t* A, int lda, const bf16_t* Bt, int ldb, int lane) {
    const int r = lane & 15, q = lane >> 4;
#pragma unroll
    for (int kk = 0; kk < KK; kk += 32) {
        bf16x8 a[MI], b[NI];
#pragma unroll
        for (int mi = 0; mi < MI; ++mi) a[mi] = *(const bf16x8*)(A + (16 * mi + r) * lda + kk + 8 * q);
#pragma unroll
        for (int ni = 0; ni < NI; ++ni) b[ni] = *(const bf16x8*)(Bt + (16 * ni + r) * ldb + kk + 8 * q);
#pragma unroll
        for (int mi = 0; mi < MI; ++mi)
#pragma unroll
            for (int ni = 0; ni < NI; ++ni)
                acc[mi][ni] = SWAP ? __builtin_amdgcn_mfma_f32_16x16x32_bf16(b[ni], a[mi], acc[mi][ni], 0, 0, 0) : __builtin_amdgcn_mfma_f32_16x16x32_bf16(a[mi], b[ni], acc[mi][ni], 0, 0, 0);
    }
}
__device__ __forceinline__ void unpack8(const uint4 w, float* f) {
    f[0] = __uint_as_float(w.x << 16); f[1] = __uint_as_float(w.x & 0xffff0000u); f[2] = __uint_as_float(w.y << 16); f[3] = __uint_as_float(w.y & 0xffff0000u);
    f[4] = __uint_as_float(w.z << 16); f[5] = __uint_as_float(w.z & 0xffff0000u); f[6] = __uint_as_float(w.w << 16); f[7] = __uint_as_float(w.w & 0xffff0000u);
}
__device__ __forceinline__ void conv8(const bf16_t* rowp, int ld, int t, int L, const float* cwl, float* out) {
    const uint4 z = make_uint4(0u, 0u, 0u, 0u);
    const uint4 rm = t > 0 ? *(const uint4*)(rowp - ld) : z, r0 = *(const uint4*)rowp, rp = t < L - 1 ? *(const uint4*)(rowp + ld) : z;
    float fm[8], f0[8], fp[8]; unpack8(rm, fm); unpack8(r0, f0); unpack8(rp, fp);
#pragma unroll
    for (int j = 0; j < 8; ++j) { const float4 w = *(const float4*)(cwl + j * 4); out[j] = siluf(w.x * fm[j] + w.y * f0[j] + w.z * fp[j] + w.w); }
}
__device__ __forceinline__ float wave_scan128(float& v0, float& v1, int lane) {
    float s = v0 + v1;
#pragma unroll
    for (int o = 1; o < 64; o <<= 1) { const float t = __shfl_up(s, o); if (lane >= o) s += t; }
    const float excl = s - (v0 + v1);
    v0 = excl + v0; v1 = v0 + v1;
    return __shfl(s, 63);
}

constexpr size_t SSD_S_OFF = 0;
constexpr size_t SSD_H_OFF = (size_t)130 * 16 * 4096 * 4;
__device__ __forceinline__ void stage_convw(const float* cw, const float* cb, int C, float* cwl, int tid) {
    for (int c = tid; c < C; c += NTH) *(float4*)(cwl + c * 4) = make_float4(cw[c], cw[C + c], cw[2 * C + c], cb[c]);
}
__device__ __forceinline__ void ssd_states(const P& p, int bid, int nb, float* lds) {
    const int tid = otid(), lane = tid & 63, wid = tid >> 6;
    unsigned char* ws = p.get_ws();
    const bf16_t* PROJ = (const bf16_t*)(ws + WS_PROJ);
    const float* SMALL = (const float*)(ws + WS_SMALL);
    float* S = (float*)(ws + WS_Y + SSD_S_OFF);
    float* DEC = (float*)(ws + WS_CHK);
    float* cwl = lds;
    bf16_t* XT = (bf16_t*)(lds + 768 * 4);
    bf16_t* BT = XT + 256 * 136;
    float* wsc = (float*)(BT + 64 * 136);
    stage_convw(p.in[11], p.in[12], 768, cwl, tid);
    __syncthreads();
    for (int item = bid; item < 260; item += nb) {
        const int c = item >> 1, g = item & 1;
        const int L = c < 128 ? SEQ : CTX, t0 = c < 128 ? c * 128 : (c - 128) * 128, rbase = c < 128 ? 0 : SEQ;
        for (int i = tid; i < 128 * 40; i += NTH) {
            const int tl = i & 127, cg8 = i >> 7;
            const int ch = cg8 < 32 ? g * 256 + cg8 * 8 : 512 + g * 64 + (cg8 - 32) * 8;
            float o[8]; conv8(PROJ + (size_t)(rbase + t0 + tl) * 2048 + 512 + ch, 2048, t0 + tl, L, cwl + ch * 4, o);
            bf16_t* dst = cg8 < 32 ? XT + (cg8 * 8) * 136 + tl : BT + ((cg8 - 32) * 8) * 136 + tl;
#pragma unroll
            for (int j = 0; j < 8; ++j) dst[j * 136] = f2bf(o[j]);
        }
        const int hh = wid >> 1, d = wid & 1, h = g * 4 + hh;
        {
            const float A = -expf(p.in[14][d * 8 + h]), dtb = p.in[13][d * 8 + h];
            const float dt0 = softplusf(SMALL[(size_t)(rbase + t0 + 2 * lane) * 32 + d * 8 + h] + dtb), dt1 = softplusf(SMALL[(size_t)(rbase + t0 + 2 * lane + 1) * 32 + d * 8 + h] + dtb);
            const float a0 = dt0 * A, a1 = dt1 * A;
            float c0 = a0, c1 = a1; const float tot = wave_scan128(c0, c1, lane);
            const float w0 = d == 0 ? __expf(tot - c0) * dt0 : __expf(c0 - a0) * dt0, w1 = d == 0 ? __expf(tot - c1) * dt1 : __expf(c1 - a1) * dt1;
            wsc[wid * 128 + 2 * lane] = w0; wsc[wid * 128 + 2 * lane + 1] = w1;
            if (lane == 0) DEC[c * 16 + d * 8 + h] = __expf(tot);
        }
        __syncthreads();
        {
            f32x4 acc[4][4];
#pragma unroll
            for (int mi = 0; mi < 4; ++mi)
#pragma unroll
                for (int ni = 0; ni < 4; ++ni) acc[mi][ni] = (f32x4){0.f, 0.f, 0.f, 0.f};
            const int r = lane & 15, q = lane >> 4;
#pragma unroll
            for (int kk = 0; kk < 128; kk += 32) {
                const float4 wa = *(const float4*)(wsc + wid * 128 + kk + 8 * q), wb = *(const float4*)(wsc + wid * 128 + kk + 8 * q + 4);
                bf16x8 a[4], b[4];
#pragma unroll
                for (int mi = 0; mi < 4; ++mi) {
                    const uint4 raw = *(const uint4*)(XT + (hh * 64 + 16 * mi + r) * 136 + kk + 8 * q);
                    float f[8]; unpack8(raw, f);
                    uint4 o; o.x = pack2(f[0] * wa.x, f[1] * wa.y); o.y = pack2(f[2] * wa.z, f[3] * wa.w); o.z = pack2(f[4] * wb.x, f[5] * wb.y); o.w = pack2(f[6] * wb.z, f[7] * wb.w);
                    a[mi] = *(bf16x8*)&o;
                }
#pragma unroll
                for (int ni = 0; ni < 4; ++ni) b[ni] = *(const bf16x8*)(BT + (16 * ni + r) * 136 + kk + 8 * q);
#pragma unroll
                for (int mi = 0; mi < 4; ++mi)
#pragma unroll
                    for (int ni = 0; ni < 4; ++ni) acc[mi][ni] = __builtin_amdgcn_mfma_f32_16x16x32_bf16(a[mi], b[ni], acc[mi][ni], 0, 0, 0);
            }
            float* Sp = S + ((size_t)(c * 2 + d) * 8 + h) * 4096;
#pragma unroll
            for (int mi = 0; mi < 4; ++mi)
#pragma unroll
                for (int ni = 0; ni < 4; ++ni)
#pragma unroll
                    for (int j = 0; j < 4; ++j) Sp[(16 * mi + 4 * q + j) * 64 + 16 * ni + r] = acc[mi][ni][j];
        }
        __syncthreads();
    }
}
__device__ __forceinline__ void ssd_scan(const P& p, int bid, int nb) {
    const int tid = otid();
    unsigned char* ws = p.get_ws();
    const float* S = (const float*)(ws + WS_Y + SSD_S_OFF);
    bf16_t* HIN = (bf16_t*)(ws + WS_Y + SSD_H_OFF);
    const float* DEC = (const float*)(ws + WS_CHK);
    for (int gid = bid * NTH + tid; gid < 65536; gid += nb * NTH) {
        const int d = gid >> 15, h = (gid >> 12) & 7, e = gid & 4095;
        float H = 0.f;
#pragma unroll 1
        for (int i0 = 0; i0 < 130; i0 += 10) {
            float sv[10], dv[10]; int cc[10];
#pragma unroll
            for (int j = 0; j < 10; ++j) {
                const int i = i0 + j;
                const int c = d == 0 ? (i < 2 ? 128 + i : i - 2) : (i < 2 ? 129 - i : 129 - i);
                cc[j] = c; sv[j] = S[((size_t)(c * 2 + d) * 8 + h) * 4096 + e]; dv[j] = DEC[c * 16 + d * 8 + h];
            }
#pragma unroll
            for (int j = 0; j < 10; ++j) { HIN[((size_t)(cc[j] * 2 + d) * 8 + h) * 4096 + e] = f2bf(H); H = dv[j] * H + sv[j]; }
        }
    }
}
__device__ __forceinline__ void ssd_out(const P& p, int bid, int nb, float* lds) {
    const int tid = otid(), lane = tid & 63, wid = tid >> 6, r = lane & 15, q = lane >> 4;
    unsigned char* ws = p.get_ws();
    const bf16_t* PROJ = (const bf16_t*)(ws + WS_PROJ);
    const float* SMALL = (const float*)(ws + WS_SMALL);
    const bf16_t* HIN = (const bf16_t*)(ws + WS_Y + SSD_H_OFF);
    bf16_t* MIX = (bf16_t*)(ws + WS_HB);
    float* cwl = lds;
    bf16_t* Cg = (bf16_t*)(lds + 768 * 4);
    bf16_t* Bg = Cg + 128 * 72;
    bf16_t* XT = Bg + 128 * 72;
    bf16_t* Mb = XT + 64 * 136;
    bf16_t* Hn = Mb + 128 * 136;
    float* csb = (float*)(Hn + 64 * 72);
    float* dts = csb + 256;
    stage_convw(p.in[11], p.in[12], 768, cwl, tid);
    __syncthreads();
    for (int c = bid; c < 130; c += nb) {
        const int L = c < 128 ? SEQ : CTX, t0 = c < 128 ? c * 128 : (c - 128) * 128, rbase = c < 128 ? 0 : SEQ;
        const int trow = wid * 16 + r;
        float ssq = 0.f;
        for (int g = 0; g < 2; ++g) {
            for (int i = tid; i < 128 * 16; i += NTH) {
                const int cg8 = i & 15, tl = i >> 4;
                const int ch = cg8 < 8 ? 640 + g * 64 + cg8 * 8 : 512 + g * 64 + (cg8 - 8) * 8;
                float o[8]; conv8(PROJ + (size_t)(rbase + t0 + tl) * 2048 + 512 + ch, 2048, t0 + tl, L, cwl + ch * 4, o);
                uint4 w; w.x = pack2(o[0], o[1]); w.y = pack2(o[2], o[3]); w.z = pack2(o[4], o[5]); w.w = pack2(o[6], o[7]);
                *(uint4*)((cg8 < 8 ? Cg + cg8 * 8 : Bg + (cg8 - 8) * 8) + tl * 72) = w;
            }
            __syncthreads();
            f32x4 G[1][8];
#pragma unroll
            for (int ni = 0; ni < 8; ++ni) G[0][ni] = (f32x4){0.f, 0.f, 0.f, 0.f};
            wave_mma<1, 8, 64, true>(G, Cg + wid * 16 * 72, 72, Bg, 72, lane);
            for (int hh = 0; hh < 4; ++hh) {
                const int h = g * 4 + hh;
                for (int i = tid; i < 128 * 8; i += NTH) {
                    const int tl = i & 127, cg8 = i >> 7; const int ch = h * 64 + cg8 * 8;
                    float o[8]; conv8(PROJ + (size_t)(rbase + t0 + tl) * 2048 + 512 + ch, 2048, t0 + tl, L, cwl + ch * 4, o);
#pragma unroll
                    for (int j = 0; j < 8; ++j) XT[(cg8 * 8 + j) * 136 + tl] = f2bf(o[j]);
                }
                if (wid < 2) {
                    const int d = wid;
                    const float A = -expf(p.in[14][d * 8 + h]), dtb = p.in[13][d * 8 + h];
                    const float dt0 = softplusf(SMALL[(size_t)(rbase + t0 + 2 * lane) * 32 + d * 8 + h] + dtb), dt1 = softplusf(SMALL[(size_t)(rbase + t0 + 2 * lane + 1) * 32 + d * 8 + h] + dtb);
                    const float a0 = dt0 * A, a1 = dt1 * A;
                    float c0 = a0, c1 = a1; const float tot = wave_scan128(c0, c1, lane);
                    csb[d * 128 + 2 * lane] = d == 0 ? c0 : tot - c0 + a0; csb[d * 128 + 2 * lane + 1] = d == 0 ? c1 : tot - c1 + a1;
                    dts[d * 128 + 2 * lane] = dt0; dts[d * 128 + 2 * lane + 1] = dt1;
                }
                __syncthreads();
                f32x4 Y[1][4];
#pragma unroll
                for (int ni = 0; ni < 4; ++ni) Y[0][ni] = (f32x4){0.f, 0.f, 0.f, 0.f};
                for (int d = 0; d < 2; ++d) {
                    const float cst = csb[d * 128 + trow];
#pragma unroll
                    for (int ni = 0; ni < 8; ++ni) {
                        const int s0 = 16 * ni + 4 * q;
                        const float4 css = *(const float4*)(csb + d * 128 + s0), dtv = *(const float4*)(dts + d * 128 + s0);
                        const float cs4[4] = {css.x, css.y, css.z, css.w}, dt4[4] = {dtv.x, dtv.y, dtv.z, dtv.w};
                        float m[4];
#pragma unroll
                        for (int j = 0; j < 4; ++j) { const int sidx = s0 + j; const bool ok = d == 0 ? sidx <= trow : sidx >= trow; m[j] = ok ? G[0][ni][j] * __expf(cst - cs4[j]) * dt4[j] : 0.f; }
                        uint2 w; w.x = pack2(m[0], m[1]); w.y = pack2(m[2], m[3]);
                        *(uint2*)(Mb + trow * 136 + s0) = w;
                    }
                    { const bf16_t* hp = HIN + ((size_t)(c * 2 + d) * 8 + h) * 4096 + tid * 8; *(uint4*)(Hn + (tid >> 3) * 72 + (tid & 7) * 8) = *(const uint4*)hp; }
                    __syncthreads();
                    wave_mma<1, 4, 128, true>(Y, Mb + wid * 16 * 136, 136, XT, 136, lane);
                    f32x4 Yo[1][4];
#pragma unroll
                    for (int ni = 0; ni < 4; ++ni) Yo[0][ni] = (f32x4){0.f, 0.f, 0.f, 0.f};
                    wave_mma<1, 4, 64, true>(Yo, Cg + wid * 16 * 72, 72, Hn, 72, lane);
                    const float ecs = __expf(cst);
#pragma unroll
                    for (int ni = 0; ni < 4; ++ni) Y[0][ni] += Yo[0][ni] * ecs;
                    __syncthreads();
                }
                const float Dh = p.in[15][h];
                const size_t grow = (size_t)(rbase + t0 + trow);
#pragma unroll
                for (int ni = 0; ni < 4; ++ni) {
                    const int p0 = 16 * ni + 4 * q;
                    const uint2 zr = *(const uint2*)(PROJ + grow * 2048 + h * 64 + p0);
                    const float z4[4] = {__uint_as_float(zr.x << 16), __uint_as_float(zr.x & 0xffff0000u), __uint_as_float(zr.y << 16), __uint_as_float(zr.y & 0xffff0000u)};
                    float u[4];
#pragma unroll
                    for (int j = 0; j < 4; ++j) { const float y = Y[0][ni][j] + Dh * bf2f(XT[(p0 + j) * 136 + trow]); u[j] = y * siluf(z4[j]); ssq += u[j] * u[j]; }
                    uint2 w; w.x = pack2(u[0], u[1]); w.y = pack2(u[2], u[3]);
                    *(uint2*)(MIX + grow * 1024 + h * 64 + p0) = w;
                }
                __syncthreads();
            }
        }
        ssq += __shfl_xor(ssq, 16); ssq += __shfl_xor(ssq, 32);
        const float rs = rsqrtf(ssq * (1.f / 512.f) + 1e-6f);
        const size_t grow = (size_t)(rbase + t0 + trow);
        for (int h = 0; h < 8; ++h)
#pragma unroll
            for (int ni = 0; ni < 4; ++ni) {
                const int col = h * 64 + 16 * ni + 4 * q;
                const uint2 ur = *(const uint2*)(MIX + grow * 1024 + col);
                const float4 nw = *(const float4*)(p.in[16] + col);
                uint2 w; w.x = pack2(__uint_as_float(ur.x << 16) * rs * nw.x, __uint_as_float(ur.x & 0xffff0000u) * rs * nw.y);
                w.y = pack2(__uint_as_float(ur.y << 16) * rs * nw.z, __uint_as_float(ur.y & 0xffff0000u) * rs * nw.w);
                *(uint2*)(MIX + grow * 1024 + col) = w;
            }
    }
}


__device__ __forceinline__ void attn_mfma(const P& p, int bid, int nb, float* lds) {
    const int tid = otid(), lane = tid & 63, wid = __builtin_amdgcn_readfirstlane(tid >> 6), r = lane & 15, q = lane >> 4;
    unsigned char* ws = p.get_ws();
    const bf16_t* PROJ = (const bf16_t*)(ws + WS_PROJ);
    const bf16_t* QKR = (const bf16_t*)(ws + WS_XRES);
    bf16_t* MIX = (bf16_t*)(ws + WS_HB);
    bf16_t* Kb = (bf16_t*)lds;
    bf16_t* Vb = Kb + 2 * 64 * 72;
    for (int item = bid; item < 260; item += nb) {
        const bool isctx = item >= 256;
        const int qb = isctx ? (item - 256) >> 1 : item >> 1, g = item & 1;
        const int qrow0 = (isctx ? SEQ : 0) + qb * 128;
        const int hq = g * 4 + (wid >> 1), wrow0 = (wid & 1) * 64;
        const int ntl = isctx ? 0 : 6, nt = ntl + 4;
        bf16_t* Qw = Vb + 2 * 64 * 72 + wid * 64 * 72;
#pragma unroll
        for (int mi = 0; mi < 4; ++mi)
#pragma unroll
            for (int kk = 0; kk < 2; ++kk) {
                const uint4 raw = *(const uint4*)(QKR + (size_t)(qrow0 + wrow0 + 16 * mi + r) * 640 + hq * 64 + kk * 32 + 8 * q);
                float f[8]; unpack8(raw, f);
                uint4 o; o.x = pack2(f[0] * 0.125f, f[1] * 0.125f); o.y = pack2(f[2] * 0.125f, f[3] * 0.125f); o.z = pack2(f[4] * 0.125f, f[5] * 0.125f); o.w = pack2(f[6] * 0.125f, f[7] * 0.125f);
                *(uint4*)(Qw + (16 * mi + r) * 72 + kk * 32 + 8 * q) = o;
            }
        const float sink = p.in[19][hq];
        float m[4], l[4]; f32x4 O[4][4];
#pragma unroll
        for (int mi = 0; mi < 4; ++mi) { m[mi] = sink; l[mi] = q == 0 ? 1.f : 0.f;
#pragma unroll
            for (int ni = 0; ni < 4; ++ni) O[mi][ni] = (f32x4){0.f, 0.f, 0.f, 0.f}; }
#define ATT_VALID(ti_) ((ti_) >= ntl || (qb * 128 - 128 + 64 * (ti_) >= 0 && qb * 128 - 128 + 64 * (ti_) < SEQ))
#define ATT_KROW(ti_) ((ti_) < ntl ? qb * 128 - 128 + 64 * (ti_) : SEQ + 64 * ((ti_) - ntl))
        int ti = 0; while (ti < nt && !ATT_VALID(ti)) ++ti;
        uint4 kreg, vreg;
        { const int kr0 = ATT_KROW(ti);
          kreg = *(const uint4*)(QKR + (size_t)(kr0 + (tid >> 3)) * 640 + 512 + g * 64 + (tid & 7) * 8);
          vreg = *(const uint4*)(PROJ + (size_t)(kr0 + (tid & 63)) * 2048 + 1920 + g * 64 + (tid >> 6) * 8); }
        int cur = 0;
        __syncthreads();
        { *(uint4*)(Kb + (tid >> 3) * 72 + (tid & 7) * 8) = kreg;
          bf16_t* vd = Vb + ((tid >> 6) * 8) * 72 + (tid & 63); const u32 vw[4] = {vreg.x, vreg.y, vreg.z, vreg.w};
#pragma unroll
          for (int j = 0; j < 4; ++j) { vd[(2 * j) * 72] = (bf16_t)(vw[j] & 0xffff); vd[(2 * j + 1) * 72] = (bf16_t)(vw[j] >> 16); } }
        __syncthreads();
        while (ti < nt) {
            int tn = ti + 1; while (tn < nt && !ATT_VALID(tn)) ++tn;
            if (tn < nt) { const int kr0 = ATT_KROW(tn);
                kreg = *(const uint4*)(QKR + (size_t)(kr0 + (tid >> 3)) * 640 + 512 + g * 64 + (tid & 7) * 8);
                vreg = *(const uint4*)(PROJ + (size_t)(kr0 + (tid & 63)) * 2048 + 1920 + g * 64 + (tid >> 6) * 8); }
            const bool local = ti < ntl;
            const bool need = !local || ((wid & 1) == 0 ? ti <= 4 : ti >= 1);
            if (need) {
                const bf16_t* Kt = Kb + cur * 64 * 72; const bf16_t* Vt = Vb + cur * 64 * 72;
                const int kp0 = qb * 128 - 128 + 64 * ti + 4 * q, qp0 = qb * 128 + wrow0 + r;
#pragma unroll
                for (int mi = 0; mi < 4; ++mi) {
                    f32x4 S[4];
#pragma unroll
                    for (int ni = 0; ni < 4; ++ni) S[ni] = (f32x4){0.f, 0.f, 0.f, 0.f};
#pragma unroll
                    for (int kk = 0; kk < 2; ++kk) {
                        const bf16x8 qfr = *(const bf16x8*)(Qw + (16 * mi + r) * 72 + kk * 32 + 8 * q);
#pragma unroll
                        for (int ni = 0; ni < 4; ++ni) {
                            const bf16x8 bfr = *(const bf16x8*)(Kt + (16 * ni + r) * 72 + kk * 32 + 8 * q);
                            S[ni] = __builtin_amdgcn_mfma_f32_16x16x32_bf16(bfr, qfr, S[ni], 0, 0, 0);
                        }
                    }
                    if (local) {
#pragma unroll
                        for (int ni = 0; ni < 4; ++ni)
#pragma unroll
                            for (int j = 0; j < 4; ++j) { const int dlt = (qp0 + 16 * mi) - (kp0 + 16 * ni + j); if (dlt > 128 || dlt < -128) S[ni][j] = -1e30f; }
                    }
                    float mx = -1e30f;
#pragma unroll
                    for (int ni = 0; ni < 4; ++ni)
#pragma unroll
                        for (int j = 0; j < 4; ++j) mx = fmaxf(mx, S[ni][j]);
                    mx = fmaxf(mx, __shfl_xor(mx, 16)); mx = fmaxf(mx, __shfl_xor(mx, 32));
                    const float mn = fmaxf(m[mi], mx), al = __expf(m[mi] - mn);
                    m[mi] = mn;
                    float ps = 0.f;
#pragma unroll
                    for (int ni = 0; ni < 4; ++ni)
#pragma unroll
                        for (int j = 0; j < 4; ++j) { const float e = __expf(S[ni][j] - mn); S[ni][j] = e; ps += e; }
                    l[mi] = l[mi] * al + ps;
#pragma unroll
                    for (int ni = 0; ni < 4; ++ni) O[mi][ni] *= al;
                    __builtin_amdgcn_sched_barrier(0);
#pragma unroll
                    for (int kk = 0; kk < 2; ++kk) {
                        uint4 o; o.x = pack2(S[2 * kk][0], S[2 * kk][1]); o.y = pack2(S[2 * kk][2], S[2 * kk][3]);
                        o.z = pack2(S[2 * kk + 1][0], S[2 * kk + 1][1]); o.w = pack2(S[2 * kk + 1][2], S[2 * kk + 1][3]);
                        const bf16x8 pfr = *(bf16x8*)&o;
#pragma unroll
                        for (int ni = 0; ni < 4; ++ni) {
                            const uint2 v0 = *(const uint2*)(Vt + (16 * ni + r) * 72 + 32 * kk + 4 * q), v1 = *(const uint2*)(Vt + (16 * ni + r) * 72 + 32 * kk + 16 + 4 * q);
                            uint4 vo; vo.x = v0.x; vo.y = v0.y; vo.z = v1.x; vo.w = v1.y;
                            O[mi][ni] = __builtin_amdgcn_mfma_f32_16x16x32_bf16(*(bf16x8*)&vo, pfr, O[mi][ni], 0, 0, 0);
                        }
                    }
                    __builtin_amdgcn_sched_barrier(0);
                }
            }
            if (tn < nt) {
                *(uint4*)(Kb + (cur ^ 1) * 64 * 72 + (tid >> 3) * 72 + (tid & 7) * 8) = kreg;
                bf16_t* vd = Vb + (cur ^ 1) * 64 * 72 + ((tid >> 6) * 8) * 72 + (tid & 63); const u32 vw[4] = {vreg.x, vreg.y, vreg.z, vreg.w};
#pragma unroll
                for (int j = 0; j < 4; ++j) { vd[(2 * j) * 72] = (bf16_t)(vw[j] & 0xffff); vd[(2 * j + 1) * 72] = (bf16_t)(vw[j] >> 16); }
            }
            __syncthreads();
            ti = tn; cur ^= 1;
        }
#undef ATT_VALID
#undef ATT_KROW
#pragma unroll
        for (int mi = 0; mi < 4; ++mi) {
            float lt = l[mi]; lt += __shfl_xor(lt, 16); lt += __shfl_xor(lt, 32);
            const float inv = 1.f / lt;
            bf16_t* op = MIX + (size_t)(qrow0 + wrow0 + 16 * mi + r) * 1024 + 512 + hq * 64 + 4 * q;
#pragma unroll
            for (int ni = 0; ni < 4; ++ni) { uint2 w; w.x = pack2(O[mi][ni][0] * inv, O[mi][ni][1] * inv); w.y = pack2(O[mi][ni][2] * inv, O[mi][ni][3] * inv); *(uint2*)(op + 16 * ni) = w; }
        }
    }
}

__device__ __forceinline__ void mlstm_scan_naive(const P& p, int item, float* lds) {
    const int lane = otid() & 63;
    const int d = item >> 4, h = (item >> 1) & 7, half = item & 1;
    unsigned char* ws = p.get_ws();
    const bf16_t* PROJ = (const bf16_t*)(ws + WS_PROJ);
    const float* SMALL = (const float*)(ws + WS_SMALL);
    bf16_t* Y = (bf16_t*)(ws + WS_Y) + (size_t)d * MT * 1024;
    const float* cw = p.in[22]; const float* cb = p.in[23];
    const int chq = h * 64 + lane, chk = 512 + h * 64 + lane, chv = 1024 + h * 128 + half * 64 + lane;
    const float wq0 = cw[chq], wq1 = cw[2048 + chq], wq2 = cw[4096 + chq], bq = cb[chq];
    const float wk0 = cw[chk], wk1 = cw[2048 + chk], wk2 = cw[4096 + chk], bk = cb[chk];
    const float wv0 = cw[chv], wv1 = cw[2048 + chv], wv2 = cw[4096 + chv], bv = cb[chv];
    const float igb = p.in[24][d * 8 + h], fgb = p.in[25][d * 8 + h];
    float C[64], nn[64];
#pragma unroll
    for (int n = 0; n < 64; ++n) { C[n] = 0.f; nn[n] = 0.f; }
    float m = 0.f;
    float* tq = lds; float* tk = lds + 66 * 64; float* tv = lds + 2 * 66 * 64; float* tg = lds + 3 * 66 * 64;
    for (int seg = 0; seg < 2; ++seg) {
        const int L = seg == 0 ? CTX : SEQ, base = seg == 0 ? SEQ : 0;
        for (int k = 0; k < L / 64; ++k) {
            const int tbs = d ? L - 64 - k * 64 : k * 64;
            for (int r = 0; r < 66; ++r) {
                const int t = tbs - 1 + r;
                float vq = 0.f, vk = 0.f, vv = 0.f;
                if (t >= 0 && t < L) { const bf16_t* pr = PROJ + (size_t)(base + t) * 3072; vq = bf2f(pr[chq]); vk = bf2f(pr[chk]); vv = bf2f(pr[chv]); }
                tq[r * 64 + lane] = vq; tk[r * 64 + lane] = vk; tv[r * 64 + lane] = vv;
            }
            { const float* sm = SMALL + (size_t)(base + tbs + lane) * 32; tg[lane] = sm[d * 8 + h] + igb; tg[64 + lane] = logsigf(sm[16 + d * 8 + h] + fgb); }
            __builtin_amdgcn_s_waitcnt(0);
            __builtin_amdgcn_wave_barrier();
            for (int s = 0; s < 64; ++s) {
                const int tl = d ? 63 - s : s; const int r = tl + 1;
                const float qv = siluf(wq0 * tq[(r - 1) * 64 + lane] + wq1 * tq[r * 64 + lane] + wq2 * tq[(r + 1) * 64 + lane] + bq);
                const float kv = siluf(wk0 * tk[(r - 1) * 64 + lane] + wk1 * tk[r * 64 + lane] + wk2 * tk[(r + 1) * 64 + lane] + bk) * 0.125f;
                const float vv = siluf(wv0 * tv[(r - 1) * 64 + lane] + wv1 * tv[r * 64 + lane] + wv2 * tv[(r + 1) * 64 + lane] + bv);
                const float ig = tg[tl], lf = tg[64 + tl];
                const float mn = fmaxf(lf + m, ig);
                const float fs = __expf(lf + m - mn), is = __expf(ig - mn);
                m = mn;
                const float iv = is * vv;
                float num = 0.f, den = 0.f;
#pragma unroll
                for (int n = 0; n < 64; ++n) {
                    const float kb = rdlane(kv, n), qb = rdlane(qv, n);
                    C[n] = fs * C[n] + kb * iv; nn[n] = fs * nn[n] + is * kb;
                    num += qb * C[n]; den += qb * nn[n];
                }
                const float hv = num / fmaxf(fabsf(den), __expf(-mn));
                Y[(size_t)(base + tbs + tl) * 1024 + h * 128 + half * 64 + lane] = f2bf(hv);
            }
            __builtin_amdgcn_wave_barrier();
        }
    }
}
__device__ __forceinline__ void phase_mix1_naive(const P& p, int bid, int nb, float* lds) {
    const int wid = otid() >> 6;
    if (bid < 32 && wid == 0) mlstm_scan_naive(p, bid, lds);
}
__device__ __forceinline__ void phase_mlstmout(const P& p, int bid, int nb) {
    const int tid = otid(), lane = tid & 63, wid = tid >> 6;
    unsigned char* ws = p.get_ws();
    const bf16_t* PROJ = (const bf16_t*)(ws + WS_PROJ);
    const bf16_t* Y0 = (const bf16_t*)(ws + WS_Y); const bf16_t* Y1 = Y0 + (size_t)MT * 1024;
    bf16_t* MIX = (bf16_t*)(ws + WS_HB);
    for (int row = bid * 8 + wid; row < SEQ; row += nb * 8) {
        float v[16]; float ss = 0.f;
#pragma unroll
        for (int j = 0; j < 16; ++j) { const int c = lane * 16 + j; v[j] = bf2f(Y0[(size_t)row * 1024 + c]) + bf2f(Y1[(size_t)row * 1024 + c]); ss += v[j] * v[j]; }
        ss += __shfl_xor(ss, 1); ss += __shfl_xor(ss, 2); ss += __shfl_xor(ss, 4);
        const float rs = rsqrtf(ss * (1.f / 128.f) + 1e-6f);
#pragma unroll
        for (int j = 0; j < 16; ++j) { const int c = lane * 16 + j; const float o = bf2f(PROJ[(size_t)row * 3072 + 2048 + c]); MIX[(size_t)row * 1024 + c] = f2bf(v[j] * rs * p.in[26][c] * sigmf(o)); }
    }
}


constexpr size_t ML_ST_OFF = 0;
constexpr size_t ML_CIN_OFF = (size_t)130 * 16 * 8192 * 2;
constexpr int CH_DEC = 0, CH_BL = 4096, CH_AC = 8192, CH_MIN = 12288, CH_NC = 16384, CH_NIN = 16384 + 130 * 16 * 64;
__device__ __forceinline__ void stage_convw_part(const float* cw, const float* cb, int C, int c0, int n, float* cwl, int tid) {
    for (int i = tid; i < n; i += NTH) *(float4*)(cwl + i * 4) = make_float4(cw[c0 + i], cw[C + c0 + i], cw[2 * C + c0 + i], cb[c0 + i]);
}
__device__ __forceinline__ void ml_states(const P& p, int bid, int nb, float* lds) {
    const int tid = otid(), lane = tid & 63, wid = tid >> 6, r = lane & 15, q = lane >> 4;
    unsigned char* ws = p.get_ws();
    const bf16_t* PROJ = (const bf16_t*)(ws + WS_PROJ);
    const float* SMALL = (const float*)(ws + WS_SMALL);
    bf16_t* ST = (bf16_t*)(ws + WS_Y + ML_ST_OFF);
    float* CHK = (float*)(ws + WS_CHK);
    float* cwl = lds;
    bf16_t* VT = (bf16_t*)(lds + 384 * 4);
    bf16_t* KT = VT + 2 * 128 * 136;
    float* es = (float*)(KT + 2 * 64 * 136);
    for (int item = bid; item < 520; item += nb) {
        const int c = item >> 2, hp = item & 3;
        const int L = c < 128 ? SEQ : CTX, t0 = c < 128 ? c * 128 : (c - 128) * 128, rbase = c < 128 ? 0 : SEQ;
        stage_convw_part(p.in[22], p.in[23], 2048, 512 + hp * 128, 128, cwl, tid);
        stage_convw_part(p.in[22], p.in[23], 2048, 1024 + hp * 256, 256, cwl + 128 * 4, tid);
        __syncthreads();
        for (int i = tid; i < 128 * 48; i += NTH) {
            const int tl = i & 127, cg8 = i >> 7;
            float o[8];
            if (cg8 < 16) {
                conv8(PROJ + (size_t)(rbase + t0 + tl) * 3072 + 512 + hp * 128 + cg8 * 8, 3072, t0 + tl, L, cwl + cg8 * 32, o);
                bf16_t* dst = KT + (cg8 * 8) * 136 + tl;
#pragma unroll
                for (int j = 0; j < 8; ++j) dst[j * 136] = f2bf(o[j] * 0.125f);
            } else {
                const int vg = cg8 - 16;
                conv8(PROJ + (size_t)(rbase + t0 + tl) * 3072 + 1024 + hp * 256 + vg * 8, 3072, t0 + tl, L, cwl + (128 + vg * 8) * 4, o);
                bf16_t* dst = VT + (vg * 8) * 136 + tl;
#pragma unroll
                for (int j = 0; j < 8; ++j) dst[j * 136] = f2bf(o[j]);
            }
        }
        const int hl = wid >> 2, d = (wid >> 1) & 1, vh = wid & 1, h = hp * 2 + hl, dh = d * 8 + h;
        float tot, ac;
        {
            const float igb = p.in[24][dh], fgb = p.in[25][dh];
            const float* sm0 = SMALL + (size_t)(rbase + t0 + 2 * lane) * 32;
            const float ig0 = sm0[dh] + igb, ig1 = sm0[32 + dh] + igb, lf0 = logsigf(sm0[16 + dh] + fgb), lf1 = logsigf(sm0[32 + 16 + dh] + fgb);
            float c0 = lf0, c1 = lf1; tot = wave_scan128(c0, c1, lane);
            const float w0 = (d == 0 ? tot - c0 : c0 - lf0) + ig0, w1 = (d == 0 ? tot - c1 : c1 - lf1) + ig1;
            ac = fmaxf(w0, w1);
#pragma unroll
            for (int o = 32; o >= 1; o >>= 1) ac = fmaxf(ac, __shfl_xor(ac, o));
            es[wid * 128 + 2 * lane] = __expf(w0 - ac); es[wid * 128 + 2 * lane + 1] = __expf(w1 - ac);
        }
        __syncthreads();
        {
            f32x4 acc[4][4];
#pragma unroll
            for (int mi = 0; mi < 4; ++mi)
#pragma unroll
                for (int ni = 0; ni < 4; ++ni) acc[mi][ni] = (f32x4){0.f, 0.f, 0.f, 0.f};
            const bf16_t* Ab = VT + (hl * 128 + vh * 64) * 136; const bf16_t* Bb = KT + (hl * 64) * 136;
#pragma unroll
            for (int kk = 0; kk < 128; kk += 32) {
                const float4 wa = *(const float4*)(es + wid * 128 + kk + 8 * q), wb = *(const float4*)(es + wid * 128 + kk + 8 * q + 4);
                bf16x8 a[4], b[4];
#pragma unroll
                for (int mi = 0; mi < 4; ++mi) a[mi] = *(const bf16x8*)(Ab + (16 * mi + r) * 136 + kk + 8 * q);
#pragma unroll
                for (int ni = 0; ni < 4; ++ni) {
                    const uint4 raw = *(const uint4*)(Bb + (16 * ni + r) * 136 + kk + 8 * q);
                    float f[8]; unpack8(raw, f);
                    uint4 o; o.x = pack2(f[0] * wa.x, f[1] * wa.y); o.y = pack2(f[2] * wa.z, f[3] * wa.w); o.z = pack2(f[4] * wb.x, f[5] * wb.y); o.w = pack2(f[6] * wb.z, f[7] * wb.w);
                    b[ni] = *(bf16x8*)&o;
                }
#pragma unroll
                for (int mi = 0; mi < 4; ++mi)
#pragma unroll
                    for (int ni = 0; ni < 4; ++ni) acc[mi][ni] = __builtin_amdgcn_mfma_f32_16x16x32_bf16(b[ni], a[mi], acc[mi][ni], 0, 0, 0);
            }
            bf16_t* Sp = ST + ((size_t)c * 16 + dh) * 8192 + (vh * 64) * 64;
#pragma unroll
            for (int mi = 0; mi < 4; ++mi)
#pragma unroll
                for (int ni = 0; ni < 4; ++ni) { uint2 w; w.x = pack2(acc[mi][ni][0], acc[mi][ni][1]); w.y = pack2(acc[mi][ni][2], acc[mi][ni][3]); *(uint2*)(Sp + (16 * mi + r) * 64 + 16 * ni + 4 * q) = w; }
            if (vh == 0) {
                float nsum = 0.f; const bf16_t* kr = Bb + lane * 136;
#pragma unroll 4
                for (int s8 = 0; s8 < 128; s8 += 8) { float f[8]; unpack8(*(const uint4*)(kr + s8), f);
#pragma unroll
                    for (int j = 0; j < 8; ++j) nsum += f[j] * es[wid * 128 + s8 + j]; }
                CHK[CH_NC + (c * 16 + dh) * 64 + lane] = nsum;
                if (lane == 0) { CHK[CH_BL + c * 16 + dh] = tot; CHK[CH_AC + c * 16 + dh] = ac; }
            }
        }
        __syncthreads();
    }
}
__device__ __forceinline__ void ml_scan(const P& p, int bid, int nb) {
    const int tid = otid();
    unsigned char* ws = p.get_ws();
    const bf16_t* ST = (const bf16_t*)(ws + WS_Y + ML_ST_OFF);
    bf16_t* CIN = (bf16_t*)(ws + WS_Y + ML_CIN_OFF);
    float* CHK = (float*)(ws + WS_CHK);
    for (int gid = bid * NTH + tid; gid < 131072; gid += nb * NTH) {
        const int dh = gid >> 13, d = dh >> 3, e = gid & 8191;
        float C = 0.f, n = 0.f, m = 0.f;
#pragma unroll 1
        for (int i0 = 0; i0 < 130; i0 += 10) {
            float sv[10], bl[10], av[10], nv[10]; int cc[10];
#pragma unroll
            for (int j = 0; j < 10; ++j) {
                const int i = i0 + j;
                const int c = d == 0 ? (i < 2 ? 128 + i : i - 2) : 129 - i;
                cc[j] = c; sv[j] = bf2f(ST[((size_t)c * 16 + dh) * 8192 + e]); bl[j] = CHK[CH_BL + c * 16 + dh]; av[j] = CHK[CH_AC + c * 16 + dh];
                nv[j] = e < 64 ? CHK[CH_NC + (c * 16 + dh) * 64 + e] : 0.f;
            }
#pragma unroll
            for (int j = 0; j < 10; ++j) {
                CIN[((size_t)cc[j] * 16 + dh) * 8192 + e] = f2bf(C);
                if (e < 64) CHK[CH_NIN + (cc[j] * 16 + dh) * 64 + e] = n;
                if (e == 0) CHK[CH_MIN + cc[j] * 16 + dh] = m;
                const float mn = fmaxf(bl[j] + m, av[j]);
                const float sp = __expf(bl[j] + m - mn), sc = __expf(av[j] - mn);
                C = sp * C + sc * sv[j]; n = sp * n + sc * nv[j]; m = mn;
            }
        }
    }
}
__device__ __forceinline__ void ml_out(const P& p, int bid, int nb, float* lds) {
    const int tid = otid(), lane = tid & 63, wid = tid >> 6, r = lane & 15, q = lane >> 4;
    unsigned char* ws = p.get_ws();
    const bf16_t* PROJ = (const bf16_t*)(ws + WS_PROJ);
    const float* SMALL = (const float*)(ws + WS_SMALL);
    const bf16_t* CIN = (const bf16_t*)(ws + WS_Y + ML_CIN_OFF);
    const float* CHK = (const float*)(ws + WS_CHK);
    bf16_t* MIX = (bf16_t*)(ws + WS_HB);
    float* cwl = lds;
    bf16_t* Qs = (bf16_t*)(lds + 256 * 4);
    bf16_t* Ks = Qs + 128 * 72;
    bf16_t* VT = Ks + 128 * 72;
    bf16_t* Wb = VT + 128 * 136;
    bf16_t* Ct = Wb + 128 * 136;
    float* bet = (float*)(Ct + 128 * 72);
    float* igs = bet + 256;
    float* nin = igs + 256;
    for (int item = bid; item < 256; item += nb) {
        const int c = item >> 1, hg = item & 1;
        const int t0 = c * 128;
        const int trow = wid * 16 + r;
        const size_t grow = (size_t)(t0 + trow);
        for (int hh = 0; hh < 4; ++hh) {
            const int h = hg * 4 + hh;
            stage_convw_part(p.in[22], p.in[23], 2048, h * 64, 64, cwl, tid);
            stage_convw_part(p.in[22], p.in[23], 2048, 512 + h * 64, 64, cwl + 64 * 4, tid);
            stage_convw_part(p.in[22], p.in[23], 2048, 1024 + h * 128, 128, cwl + 128 * 4, tid);
            __syncthreads();
            for (int i = tid; i < 128 * 16; i += NTH) {
                const int cg8 = i & 15, tl = i >> 4;
                float o[8]; conv8(PROJ + (size_t)(t0 + tl) * 3072 + (cg8 < 8 ? h * 64 + cg8 * 8 : 512 + h * 64 + (cg8 - 8) * 8), 3072, t0 + tl, SEQ, cwl + cg8 * 32, o);
                const float sc = cg8 < 8 ? 1.f : 0.125f;
                uint4 w; w.x = pack2(o[0] * sc, o[1] * sc); w.y = pack2(o[2] * sc, o[3] * sc); w.z = pack2(o[4] * sc, o[5] * sc); w.w = pack2(o[6] * sc, o[7] * sc);
                *(uint4*)((cg8 < 8 ? Qs + cg8 * 8 : Ks + (cg8 - 8) * 8) + tl * 72) = w;
            }
            for (int i = tid; i < 128 * 16; i += NTH) {
                const int tl = i & 127, vg = i >> 7;
                float o[8]; conv8(PROJ + (size_t)(t0 + tl) * 3072 + 1024 + h * 128 + vg * 8, 3072, t0 + tl, SEQ, cwl + (128 + vg * 8) * 4, o);
#pragma unroll
                for (int j = 0; j < 8; ++j) VT[(vg * 8 + j) * 136 + tl] = f2bf(o[j]);
            }
            if (wid < 2) {
                const int d = wid, dh = d * 8 + h;
                const float igb = p.in[24][dh], fgb = p.in[25][dh];
                const float* sm0 = SMALL + (size_t)(t0 + 2 * lane) * 32;
                const float ig0 = sm0[dh] + igb, ig1 = sm0[32 + dh] + igb, lf0 = logsigf(sm0[16 + dh] + fgb), lf1 = logsigf(sm0[32 + 16 + dh] + fgb);
                float c0 = lf0, c1 = lf1; const float tot = wave_scan128(c0, c1, lane);
                bet[d * 128 + 2 * lane] = d == 0 ? c0 : tot - c0 + lf0; bet[d * 128 + 2 * lane + 1] = d == 0 ? c1 : tot - c1 + lf1;
                igs[d * 128 + 2 * lane] = ig0; igs[d * 128 + 2 * lane + 1] = ig1;
                nin[d * 64 + lane] = CHK[CH_NIN + (c * 16 + dh) * 64 + lane];
            }
            __syncthreads();
            f32x4 QK[1][8];
#pragma unroll
            for (int ni = 0; ni < 8; ++ni) QK[0][ni] = (f32x4){0.f, 0.f, 0.f, 0.f};
            wave_mma<1, 8, 64, true>(QK, Qs + wid * 16 * 72, 72, Ks, 72, lane);
            f32x4 Hs[8];
#pragma unroll
            for (int ni = 0; ni < 8; ++ni) Hs[ni] = (f32x4){0.f, 0.f, 0.f, 0.f};
            for (int d = 0; d < 2; ++d) {
                const int dh = d * 8 + h;
                const float bt = bet[d * 128 + trow], g = bt + CHK[CH_MIN + c * 16 + dh];
                float dl[32]; float mx = -1e30f;
#pragma unroll
                for (int ni = 0; ni < 8; ++ni) {
                    const int s0 = 16 * ni + 4 * q;
                    const float4 bs = *(const float4*)(bet + d * 128 + s0), iv = *(const float4*)(igs + d * 128 + s0);
                    const float b4[4] = {bs.x, bs.y, bs.z, bs.w}, i4[4] = {iv.x, iv.y, iv.z, iv.w};
#pragma unroll
                    for (int j = 0; j < 4; ++j) { const int sidx = s0 + j; const bool ok = d == 0 ? sidx <= trow : sidx >= trow; const float v = ok ? bt - b4[j] + i4[j] : -1e30f; dl[ni * 4 + j] = v; mx = fmaxf(mx, v); }
                }
                mx = fmaxf(mx, __shfl_xor(mx, 16)); mx = fmaxf(mx, __shfl_xor(mx, 32));
                const float ms = fmaxf(g, mx);
                float rsum = 0.f;
#pragma unroll
                for (int ni = 0; ni < 8; ++ni) {
                    float w4[4];
#pragma unroll
                    for (int j = 0; j < 4; ++j) { w4[j] = dl[ni * 4 + j] > -1e29f ? __expf(dl[ni * 4 + j] - ms) * QK[0][ni][j] : 0.f; rsum += w4[j]; }
                    uint2 w; w.x = pack2(w4[0], w4[1]); w.y = pack2(w4[2], w4[3]);
                    *(uint2*)(Wb + trow * 136 + 16 * ni + 4 * q) = w;
                }
                rsum += __shfl_xor(rsum, 16); rsum += __shfl_xor(rsum, 32);
                { const bf16_t* cp = CIN + ((size_t)c * 16 + dh) * 8192 + tid * 16;
                  *(uint4*)(Ct + (tid >> 2) * 72 + (tid & 3) * 16) = *(const uint4*)cp; *(uint4*)(Ct + (tid >> 2) * 72 + (tid & 3) * 16 + 8) = *(const uint4*)(cp + 8); }
                __syncthreads();
                f32x4 Nm[1][8], Ni[1][8];
#pragma unroll
                for (int ni = 0; ni < 8; ++ni) { Nm[0][ni] = (f32x4){0.f, 0.f, 0.f, 0.f}; Ni[0][ni] = (f32x4){0.f, 0.f, 0.f, 0.f}; }
                wave_mma<1, 8, 128, true>(Nm, Wb + wid * 16 * 136, 136, VT, 136, lane);
                wave_mma<1, 8, 64, true>(Ni, Qs + wid * 16 * 72, 72, Ct, 72, lane);
                float qn = 0.f;
                { float f[8]; unpack8(*(const uint4*)(Qs + trow * 72 + 16 * q), f);
#pragma unroll
                  for (int j = 0; j < 8; ++j) qn += f[j] * nin[d * 64 + 16 * q + j];
                  unpack8(*(const uint4*)(Qs + trow * 72 + 16 * q + 8), f);
#pragma unroll
                  for (int j = 0; j < 8; ++j) qn += f[j] * nin[d * 64 + 16 * q + 8 + j]; }
                qn += __shfl_xor(qn, 16); qn += __shfl_xor(qn, 32);
                const float ei = __expf(g - ms);
                const float den = rsum + qn * ei;
                const float inv = 1.f / fmaxf(fabsf(den), __expf(-ms));
#pragma unroll
                for (int ni = 0; ni < 8; ++ni) Hs[ni] += (Nm[0][ni] + Ni[0][ni] * ei) * inv;
                __syncthreads();
            }
            float ssq = 0.f;
#pragma unroll
            for (int ni = 0; ni < 8; ++ni)
#pragma unroll
                for (int j = 0; j < 4; ++j) ssq += Hs[ni][j] * Hs[ni][j];
            ssq += __shfl_xor(ssq, 16); ssq += __shfl_xor(ssq, 32);
            const float rs = rsqrtf(ssq * (1.f / 128.f) + 1e-6f);
#pragma unroll
            for (int ni = 0; ni < 8; ++ni) {
                const int col = h * 128 + 16 * ni + 4 * q;
                const uint2 orw = *(const uint2*)(PROJ + grow * 3072 + 2048 + col);
                const float4 nw = *(const float4*)(p.in[26] + col);
                uint2 w; w.x = pack2(Hs[ni][0] * rs * nw.x * sigmf(__uint_as_float(orw.x << 16)), Hs[ni][1] * rs * nw.y * sigmf(__uint_as_float(orw.x & 0xffff0000u)));
                w.y = pack2(Hs[ni][2] * rs * nw.z * sigmf(__uint_as_float(orw.y << 16)), Hs[ni][3] * rs * nw.w * sigmf(__uint_as_float(orw.y & 0xffff0000u)));
                *(uint2*)(MIX + grow * 1024 + col) = w;
            }
            __syncthreads();
        }
    }
}


#define XB_TMO      128
#define XB_XCNT(j)  (256  + 64 * (j))
#define XB_XSUB(j)  (1280 + 64 * (j))
#define XB_XGEN(j)  (2304 + 64 * (j))
#define XB_TOP      3328
#define XB_TOPGEN   3392
#define XCD_BAR_WORDS 3456
#define XB_SPIN_CAP (1u << 22)
#define XLAS __attribute__((address_space(3)))
__device__ __forceinline__ unsigned xb_ld(unsigned* p) { return __hip_atomic_load(p, __ATOMIC_RELAXED, __HIP_MEMORY_SCOPE_AGENT); }
__device__ __forceinline__ unsigned xb_add(unsigned* p, unsigned v) { return __hip_atomic_fetch_add(p, v, __ATOMIC_RELAXED, __HIP_MEMORY_SCOPE_AGENT); }
__device__ __forceinline__ unsigned xb_xcc_id() { return (unsigned)__builtin_amdgcn_s_getreg((3 << 11) | 20) & 0xFu; }
#define XB_SPIN(cond, bar) do { unsigned _sp = 0; while (cond) { __builtin_amdgcn_s_sleep(1); \
    if ((++_sp & 255u) == 0u) { if (xb_ld(&(bar)[XB_TMO])) break; if (_sp > XB_SPIN_CAP) { atomicAdd(&(bar)[XB_TMO], 1u); break; } } } } while (0)
struct XcdBarrier { unsigned* bar; unsigned x; volatile XLAS unsigned* st; };
__device__ __forceinline__ XcdBarrier xcd_barrier_post(unsigned* bar, volatile XLAS unsigned* st) {
    XcdBarrier b; b.bar = bar; b.x = xb_xcc_id(); b.st = st;
    if (threadIdx.x == 0) (void)xb_add(&bar[XB_XCNT(b.x)], 1u);
    return b;
}
__device__ __forceinline__ void xcd_barrier_complete(unsigned* bar, unsigned x, unsigned& nloc, unsigned& nx) {
    const unsigned G = gridDim.x * gridDim.y * gridDim.z;
    unsigned sum, cnt, mine, sp = 0u;
    for (;;) {
        sum = 0u; cnt = 0u; mine = 0u;
#pragma unroll
        for (unsigned j = 0; j < 16; ++j) { const unsigned c = xb_ld(&bar[XB_XCNT(j)]); sum += c; cnt += (c > 0u) ? 1u : 0u; mine = (j == x) ? c : mine; }
        if (sum == G) break;
        __builtin_amdgcn_s_sleep(1);
        if ((++sp & 255u) == 0u) { if (xb_ld(&bar[XB_TMO])) break; if (sp > XB_SPIN_CAP) { atomicAdd(&bar[XB_TMO], 1u); break; } }
    }
    nloc = mine > 0u ? mine : 1u; nx = cnt > 0u ? cnt : 1u;
}
__device__ __forceinline__ void xcd_barrier(const XcdBarrier& b) {
    asm volatile("s_waitcnt vmcnt(0)" ::: "memory");
    __syncthreads();
    if (threadIdx.x == 0) {
        unsigned* bar = b.bar;
        __builtin_amdgcn_s_waitcnt(0);
        unsigned nloc = b.st[0], nx = b.st[1];
        if (nloc == 0u) { xcd_barrier_complete(bar, b.x, nloc, nx); b.st[0] = nloc; b.st[1] = nx; }
        const unsigned old = xb_add(&bar[XB_XSUB(b.x)], 1u);
        const unsigned gen = old / nloc;
        if (old + 1u == (gen + 1u) * nloc) {
            __builtin_amdgcn_fence(__ATOMIC_RELEASE, "agent");
            asm volatile("s_waitcnt vmcnt(0)" ::: "memory");
            const unsigned og = xb_add(&bar[XB_TOP], 1u);
            const unsigned tg = og / nx;
            if (og + 1u == (tg + 1u) * nx) xb_add(&bar[XB_TOPGEN], 1u);
            else XB_SPIN(xb_ld(&bar[XB_TOPGEN]) == tg, bar);
            __builtin_amdgcn_fence(__ATOMIC_ACQUIRE, "agent");
            xb_add(&bar[XB_XGEN(b.x)], 1u);
            asm volatile("s_waitcnt vmcnt(0)" ::: "memory");
        } else {
            XB_SPIN(xb_ld(&bar[XB_XGEN(b.x)]) == gen, bar);
            __builtin_amdgcn_fence(__ATOMIC_ACQUIRE, "agent");
            asm volatile("s_waitcnt vmcnt(0)" ::: "memory");
        }
    }
    __syncthreads();
}

#define GSYNC() grid.sync()
__global__ void __launch_bounds__(NTH, 2) fwd_kernel(PK pk) {
    P p;
    extern __shared__ __attribute__((aligned(16))) unsigned char smem[];
    float* lds = (float*)smem;
    G8_LAS unsigned char* ldsa = (G8_LAS unsigned char*)smem;
    volatile XLAS unsigned* xst = (volatile XLAS unsigned*)((XLAS unsigned char*)smem + LDS_BYTES - 16);
    if (threadIdx.x < 4) xst[threadIdx.x] = 0u;
    __syncthreads();
    const XcdBarrier xbar = xcd_barrier_post((unsigned*)(p.get_ws() + WS_CTL) + CW_BAR, xst);
    int nph = NPH_RUN; asm volatile("" : "+s"(nph));
#pragma unroll 1
    for (int ph = 0; ph < nph; ++ph) {
        unsigned char* ws = p.get_ws();
        const float* MODS = (const float*)(ws + WS_MODS);
        int nb = (int)gridDim.x, bid = (int)blockIdx.x; asm volatile("" : "+s"(nb), "+s"(bid));
        switch (ph) {
        case 0: {
            phase_mods(p, bid, nb, lds);
            conv_dense(p, bid, nb, lds);
            conv_moe(p, bid, nb, lds, 0);
        } break;
        case 1: {
            { RowArgs a{}; a.layer = 0; a.ffn = 0; a.src = 0; a.nrows = MT; a.wsm = p.in[10]; a.ldw = EV_IN; a.wcol0 = 1280; phase_rows<16>(p, bid, nb, lds, a); }
        } break;
        case 2: {
            { g8::Order S; S.init(MT / 256, 2048 / 256, nb, bid); EpiBf16Store ef{(bf16_t*)(ws + WS_PROJ), 2048};
              g8::gemm8<false>(ldsa, (const bf16_t*)(ws + WS_HB), 1024, nullptr, S, BSelOne{(const char*)(ws + WS_WIN0)}, ef); }
        } break;
        case 3: {
            phase_qkprep(p, bid, nb);
            ssd_states(p, bid, nb, lds);
        } break;
        case 4: {
            ssd_scan(p, bid, nb);
            attn_mfma(p, bid, nb, lds);
        } break;
        case 5: {
            ssd_out(p, bid, nb, lds);
        } break;
        case 6: {
            { g8::Order S; S.init(MT / 256, 4, nb, bid);
              EpiResid ef{p.in[0], p.in[2], (float*)(ws + WS_XRES), MODS + (0 * 2 + 0) * 6144 + 2048, MODS + (0 * 2 + 1) * 6144 + 2048};
              g8::gemm8<false>(ldsa, (const bf16_t*)(ws + WS_HB), 1024, nullptr, S, BSelOne{(const char*)(ws + WS_WOUT0)}, ef); }
        } break;
        case 7: {
            { RowArgs a{}; a.layer = 0; a.ffn = 1; a.src = 1; a.nrows = MT; a.wsm = p.in[4]; a.ldw = 16; a.wcol0 = 0; a.route = 1; phase_rows<16>(p, bid, nb, lds, a); }
        } break;
        case 8: {
            phase_lists(p, bid, nb, 0, MT);
        } break;
        case 9: {
            phase_moe1(p, bid, nb, ldsa);
        } break;
        case 10: {
            phase_moe2(p, bid, nb, ldsa);
        } break;
        case 11: {
            { RowArgs a{}; a.layer = 1; a.ffn = 0; a.src = 1; a.combine = 1; a.clayer = 0; a.nrows = MT; a.wsm = p.in[21]; a.ldw = OD_IN; a.wcol0 = 3072; phase_rows<32>(p, bid, nb, lds, a); }
        } break;
        case 12: {
            { g8::Order S; S.init(MT / 256, 3072 / 256, nb, bid); EpiBf16Store ef{(bf16_t*)(ws + WS_PROJ), 3072};
              g8::gemm8<false>(ldsa, (const bf16_t*)(ws + WS_HB), 1024, nullptr, S, BSelOne{(const char*)(ws + WS_WIN1)}, ef); }
        } break;
        case 13: {
            ml_states(p, bid, nb, lds);
            __syncthreads();
            conv_moe(p, bid, nb, lds, 1);
        } break;
        case 14: {
            ml_scan(p, bid, nb);
            xcd_barrier(xbar);
            ml_out(p, bid, nb, lds);
        } break;
        case 15: {
            { g8::Order S; S.init(SEQ / 256, 4, nb, bid);
              EpiResid ef{(const float*)(ws + WS_XRES), nullptr, (float*)(ws + WS_XRES), MODS + (1 * 2 + 0) * 6144 + 2048, MODS + (1 * 2 + 0) * 6144 + 2048};
              g8::gemm8<false>(ldsa, (const bf16_t*)(ws + WS_HB), 1024, nullptr, S, BSelOne{(const char*)(ws + WS_WOUT1)}, ef); }
        } break;
        case 16: {
            { RowArgs a{}; a.layer = 1; a.ffn = 1; a.src = 1; a.nrows = SEQ; a.wsm = p.in[4]; a.ldw = 16; a.wcol0 = 0; a.route = 1; phase_rows<16>(p, bid, nb, lds, a); }
        } break;
        case 17: {
            phase_lists(p, bid, nb, 1, SEQ);
        } break;
        case 18: {
            phase_moe1(p, bid, nb, ldsa);
        } break;
        case 19: {
            phase_moe2(p, bid, nb, ldsa);
        } break;
        case 20: {
            { RowArgs a{}; a.layer = 1; a.src = 1; a.combine = 1; a.clayer = 1; a.final_out = 1; a.nrows = SEQ; phase_rows<16>(p, bid, nb, lds, a); }
        } break;
        default: break;
        }
        if (ph + 1 < nph) xcd_barrier(xbar);
    }
}

extern "C" void kernel_launch(void* const* d_in, const int* in_sizes, int n_in, void* d_out, int out_size, void* d_ws, size_t ws_size, hipStream_t stream) {
    static int grid = 0;
    if (grid == 0) {
        if (n_in != 31 || ws_size < WS_END) { fprintf(stderr, "kernel_launch: unexpected n_in %d or ws_size %zu < %zu\n", n_in, ws_size, (size_t)WS_END); grid = -1; return; }
        int dev = 0, cus = 0, per_cu = 0;
        hipGetDevice(&dev);
        hipDeviceGetAttribute(&cus, hipDeviceAttributeMultiprocessorCount, dev);
        hipFuncSetAttribute((const void*)fwd_kernel, hipFuncAttributeMaxDynamicSharedMemorySize, LDS_BYTES);
        hipOccupancyMaxActiveBlocksPerMultiprocessor(&per_cu, (const void*)fwd_kernel, NTH, LDS_BYTES);
        if (per_cu < 1) { fprintf(stderr, "kernel_launch: occupancy query says %d blocks per CU\n", per_cu); per_cu = 1; }
        grid = cus;
    }
    if (grid < 0) return;
    PK p{};
    for (int i = 0; i < 31; ++i) p.in[i] = (const float*)d_in[i];
    p.out = (float*)d_out; p.ws = (unsigned char*)d_ws;
    hipMemsetAsync((unsigned char*)d_ws + WS_CTL, 0, 65536, stream);
    void* args[] = {&p};
    hipError_t e = hipLaunchCooperativeKernel((const void*)fwd_kernel, dim3(grid), dim3(NTH), args, LDS_BYTES, stream);
    if (e != hipSuccess) fprintf(stderr, "cooperative launch failed: %s (grid %d)\n", hipGetErrorString(e), grid);
}
```

```cpp
#include <hip/hip_runtime.h>
#include <hip/hip_cooperative_groups.h>
#include <cstdio>
namespace cg = cooperative_groups;

typedef unsigned short bf16_t;
typedef unsigned int u32;

constexpr int D = 1024, SEQ = 16384, CTX = 256, MT = SEQ + CTX;
constexpr int NTH = 512;
#ifndef NPH_RUN
#define NPH_RUN 19
#endif
#ifndef REPEAT_MASK
#define REPEAT_MASK 0u
#endif
#ifndef TIMED_PH
#define TIMED_PH -1
#endif
#ifndef TIMED_M2
#define TIMED_M2 1.37f
#endif
constexpr int EV_IN = 2064, OD_IN = 3104;
constexpr int NE = 16, DE = 512;
constexpr int MAXTILES = 146, MAXSLOTS = MAXTILES * 256;

constexpr size_t al256(size_t x) { return (x + 255) & ~(size_t)255; }
constexpr size_t WS_CTL   = 0;
constexpr size_t WS_MODS  = 65536;
constexpr size_t WS_ROPE  = WS_MODS + al256(2 * 2 * 6144 * 4);
constexpr size_t WS_SMALL = WS_ROPE + al256(2 * 256 * 16 * 4);
constexpr size_t WS_ROUTE = WS_SMALL + al256((size_t)MT * 32 * 4);
constexpr size_t WS_GATE  = WS_ROUTE + al256((size_t)MT * 16);
constexpr size_t WS_SLOT  = WS_GATE + al256((size_t)MT * 8);
constexpr size_t WS_LIST  = WS_SLOT + al256((size_t)MT * 8);
constexpr size_t WS_TEXP  = WS_LIST + al256((size_t)MAXSLOTS * 4);
constexpr size_t WS_CHK   = WS_TEXP + 1024;
constexpr size_t WS_WIN0  = WS_CHK + (size_t)4 * 1024 * 1024;
constexpr size_t WS_WIN1  = WS_WIN0 + (size_t)2304 * 1024 * 2;
constexpr size_t WS_WOUT0 = WS_WIN1 + (size_t)3328 * 1024 * 2;
constexpr size_t WS_WOUT1 = WS_WOUT0 + (size_t)1024 * 1024 * 2;
constexpr size_t WS_WMOE  = WS_WOUT1 + (size_t)1024 * 1024 * 2;
constexpr size_t WS_XRES  = WS_WMOE + (size_t)16 * 1024 * 1024 * 2 + (size_t)16 * 1024 * 512 * 2;
constexpr size_t WS_HB    = WS_XRES + (size_t)MT * 1024 * 4;
constexpr size_t WS_PROJ  = WS_HB + (size_t)MT * 1024 * 2;
constexpr size_t WS_Y     = WS_PROJ + (size_t)MT * 3072 * 2;
constexpr size_t WS_END   = WS_Y + (size_t)MT * 1024 * 4;
static_assert(WS_END < 349000000, "workspace too large");

constexpr int CW_CNT = 8192;
constexpr int CH_BBASE = 300000;
constexpr int CH_ELIST = 524288;
constexpr int CW_BAR = 1024;
constexpr int CW_Q5 = 12288;
constexpr int LDS_BYTES = 160 * 1024;

struct PK { const float* in[31]; float* out; unsigned char* ws; };
typedef __attribute__((address_space(4))) const unsigned char* kaptr_t;
struct InTab { __device__ __forceinline__ const float* operator[](int i) const {
    kaptr_t ka = (kaptr_t)__builtin_amdgcn_kernarg_segment_ptr(); asm volatile("" : "+s"(ka)); return *(const float* __attribute__((address_space(4))) const*)(ka + i * 8); } };
struct P { InTab in; int wv;
    __device__ __forceinline__ int tid() const { int l; asm volatile("v_mbcnt_lo_u32_b32 %0, -1, 0\n\tv_mbcnt_hi_u32_b32 %0, -1, %0" : "=v"(l)); return (wv << 6) | l; }
    __device__ __forceinline__ float* get_out() const { kaptr_t ka = (kaptr_t)__builtin_amdgcn_kernarg_segment_ptr(); asm volatile("" : "+s"(ka)); return *(float* __attribute__((address_space(4))) const*)(ka + 31 * 8); }
    __device__ __forceinline__ unsigned char* get_ws() const { kaptr_t ka = (kaptr_t)__builtin_amdgcn_kernarg_segment_ptr(); asm volatile("" : "+s"(ka)); return *(unsigned char* __attribute__((address_space(4))) const*)(ka + 32 * 8); } };

__device__ __forceinline__ float bf2f(bf16_t b) { return __uint_as_float((u32)b << 16); }
__device__ __forceinline__ bf16_t f2bf(float f) { u32 u = __float_as_uint(f); u += 0x7FFFu + ((u >> 16) & 1u); return (bf16_t)(u >> 16); }
__device__ __forceinline__ u32 pack2(float a, float b) { return (u32)f2bf(a) | ((u32)f2bf(b) << 16); }
__device__ __forceinline__ float siluf(float x) { return x / (1.f + __expf(-x)); }
__device__ __forceinline__ float sigmf(float x) { return 1.f / (1.f + __expf(-x)); }
__device__ __forceinline__ float softplusf(float x) { return x > 20.f ? x : log1pf(__expf(x)); }
__device__ __forceinline__ float logsigf(float x) { return x < -20.f ? x : -log1pf(__expf(-x)); }
__device__ __forceinline__ float wave_sum(float v) {
#pragma unroll
    for (int o = 32; o >= 1; o >>= 1) v += __shfl_xor(v, o);
    return v;
}
__device__ __forceinline__ float rdlane(float v, int l) { return __int_as_float(__builtin_amdgcn_readlane(__float_as_int(v), l)); }

__device__ __forceinline__ void phase_mods(const P& p, int bid, int nb, float* lds) {
    const int tid = p.tid();
    float* MODS = (float*)(p.get_ws() + WS_MODS);
    float* RC = (float*)(p.get_ws() + WS_ROPE); float* RS = RC + 256 * 16;
    for (int i = bid * NTH + tid; i < 256 * 16; i += nb * NTH) {
        const int pos = i >> 4, f = i & 15;
        const float inv = powf(10000.f, -(float)f / 16.f);
        const float ang = (float)pos * inv;
        RC[i] = cosf(ang); RS[i] = sinf(ang);
    }
    const float* c = p.in[1]; const float* cx = p.in[3];
    for (int i = tid; i < 1024; i += NTH) { const float a = c[i]; lds[i] = a / (1.f + expf(-a)); const float b = cx[i]; lds[1024 + i] = b / (1.f + expf(-b)); }
    __syncthreads();
    float* red = lds + 2048;
    const int tx = tid & 15, ty = tid >> 4;
    for (int item = bid; item < 192; item += nb) {
        const int l = item / 96, cgp = item % 96;
        const float* W = p.in[8] + (size_t)l * 1024 * 6144 + cgp * 64 + tx * 4;
        float4 ac = {0.f, 0.f, 0.f, 0.f}, ax = {0.f, 0.f, 0.f, 0.f};
#pragma unroll 8
        for (int k = ty; k < 1024; k += 32) {
            const float4 w = *(const float4*)(W + (size_t)k * 6144);
            const float sc = lds[k], sx = lds[1024 + k];
            ac.x += sc * w.x; ac.y += sc * w.y; ac.z += sc * w.z; ac.w += sc * w.w;
            ax.x += sx * w.x; ax.y += sx * w.y; ax.z += sx * w.z; ax.w += sx * w.w;
        }
        float* r = red + (ty * 16 + tx) * 8;
        r[0] = ac.x; r[1] = ac.y; r[2] = ac.z; r[3] = ac.w; r[4] = ax.x; r[5] = ax.y; r[6] = ax.z; r[7] = ax.w;
        __syncthreads();
        if (tid < 128) {
            const int col = tid & 63, which = tid >> 6;
            float s = 0.f;
            for (int y = 0; y < 32; ++y) s += red[(y * 16 + (col >> 2)) * 8 + which * 4 + (col & 3)];
            s += p.in[9][l * 6144 + cgp * 64 + col];
            MODS[(l * 2 + which) * 6144 + cgp * 64 + col] = s;
        }
        __syncthreads();
    }
}

struct RowArgs {
    int layer;
    int ffn;
    int src;
    int combine;
    int clayer;
    int final_out;
    int nrows;
    const float* wsm; int ldw; int wcol0;
    int route;
    int noproj;
};

template <int NS>
__device__ __forceinline__ float row_norm_proj(float (&v)[16], const float* gamma, const float* md, bf16_t* hrow, const float* lds, int lane, bool doproj) {
    float ss = 0.f;
#pragma unroll
    for (int j = 0; j < 16; ++j) ss += v[j] * v[j];
    ss = wave_sum(ss);
    const float rs = rsqrtf(ss * (1.f / 1024.f) + 1e-6f);
#pragma unroll
    for (int i = 0; i < 4; ++i) {
        const float4 g = *(const float4*)(gamma + i * 256 + lane * 4);
        const float4 sh = *(const float4*)(md + i * 256 + lane * 4);
        const float4 sc = *(const float4*)(md + 1024 + i * 256 + lane * 4);
        v[i * 4 + 0] = v[i * 4 + 0] * rs * g.x * (1.f + sc.x) + sh.x;
        v[i * 4 + 1] = v[i * 4 + 1] * rs * g.y * (1.f + sc.y) + sh.y;
        v[i * 4 + 2] = v[i * 4 + 2] * rs * g.z * (1.f + sc.z) + sh.z;
        v[i * 4 + 3] = v[i * 4 + 3] * rs * g.w * (1.f + sc.w) + sh.w;
        uint2 o; o.x = pack2(v[i * 4], v[i * 4 + 1]); o.y = pack2(v[i * 4 + 2], v[i * 4 + 3]);
        *(uint2*)(hrow + i * 256 + lane * 4) = o;
    }
    if (!doproj) return 0.f;
    float s[NS];
#pragma unroll
    for (int n = 0; n < NS; ++n) s[n] = 0.f;
#pragma unroll
    for (int i = 0; i < 4; ++i)
#pragma unroll
        for (int j = 0; j < 4; ++j) {
            const float* w = lds + ((i * 4 + j) * (NS / 4)) * 256 + lane * 4;
            const float x = v[i * 4 + j];
#pragma unroll
            for (int n = 0; n < NS; n += 4) { const float4 ww = *(const float4*)(w + (n >> 2) * 256); s[n] += x * ww.x; s[n + 1] += x * ww.y; s[n + 2] += x * ww.z; s[n + 3] += x * ww.w; }
            asm volatile("" ::: "memory");
        }
#pragma unroll
    for (int hN = NS / 2, off = 32; hN >= 1; hN >>= 1, off >>= 1) {
        const bool upper = (lane & off) != 0;
#pragma unroll
        for (int i2 = 0; i2 < hN; ++i2) { const float mine = upper ? s[i2 + hN] : s[i2], other = upper ? s[i2] : s[i2 + hN]; s[i2] = mine + __shfl_xor(other, off); }
    }
    float s0 = s[0];
    if (NS == 16) { s0 += __shfl_xor(s0, 2); s0 += __shfl_xor(s0, 1); } else { s0 += __shfl_xor(s0, 1); }
    return s0;
}
__device__ __forceinline__ void route16(const float (&sc)[16], const float (&bs)[16], int& e0, int& e1, float& g0, float& g1) {
    float best = -1e30f, W0 = 0.f, W1 = 0.f; int E0 = 0, E1 = 0;
#pragma unroll
    for (int g = 0; g < 4; ++g) {
        float m1 = bs[g * 4], w1 = sc[g * 4]; int i1 = 0;
#pragma unroll
        for (int j = 1; j < 4; ++j) { const bool gt = bs[g * 4 + j] > m1; m1 = gt ? bs[g * 4 + j] : m1; w1 = gt ? sc[g * 4 + j] : w1; i1 = gt ? j : i1; }
        float m2 = -1e30f, w2 = 0.f; int i2 = 0;
#pragma unroll
        for (int j = 0; j < 4; ++j) { const bool gt = (j != i1) && (bs[g * 4 + j] > m2); m2 = gt ? bs[g * 4 + j] : m2; w2 = gt ? sc[g * 4 + j] : w2; i2 = gt ? j : i2; }
        const float gs = m1 + m2; const bool better = gs > best;
        best = better ? gs : best; E0 = better ? g * 4 + i1 : E0; E1 = better ? g * 4 + i2 : E1; W0 = better ? w1 : W0; W1 = better ? w2 : W1;
    }
    e0 = E0; e1 = E1;
    const float inv = 1.f / (W0 + W1);
    g0 = W0 * inv; g1 = W1 * inv;
}
__device__ __forceinline__ void expert_offsets(const u32* cnt  , int (&off)[17]) {
    off[0] = 0;
#pragma unroll
    for (int e = 0; e < 16; ++e) off[e + 1] = off[e] + (int)((cnt[e * 64] + 255u) / 256u) * 256;
}

template <int NS> __forceinline__
__device__ __forceinline__ void phase_rows(const P& p, int bid, int nb, float* lds, const RowArgs a) {
    const int tid = p.tid(), lane = tid & 63, wid = tid >> 6;
    unsigned char* ws = p.get_ws();
    const float* MODS = (const float*)(ws + WS_MODS);
    float* XRES = (float*)(ws + WS_XRES);
    bf16_t* HB = (bf16_t*)(ws + WS_HB);
    float* SMALL = (float*)(ws + WS_SMALL);
    int* CHKI = (int*)(ws + WS_CHK);
    if (!a.final_out && !a.noproj) {
        for (int i = tid; i < 1024 * NS; i += NTH) { const int k = i / NS, n = i % NS;
            lds[(((k >> 8) * 4 + (k & 3)) * (NS / 4) + (n >> 2)) * 256 + ((k >> 2) & 63) * 4 + (n & 3)] = a.wsm[(size_t)k * a.ldw + a.wcol0 + n]; }
    }
    u32* lcnt = (u32*)(lds + 1024 * 32);
    int* lsl = (int*)(lds + 1024 * 32 + 64);
    int4* lrt = (int4*)(lds + 1024 * 32 + 64);
    if (tid < 16) lcnt[tid] = 0u;
    if (a.combine) {
        if (tid == 0) { int off[17]; expert_offsets((const u32*)(ws + WS_CTL) + CW_CNT + a.clayer * 16 * 64, off);
#pragma unroll
            for (int e = 0; e < 16; ++e) lsl[e] = off[e]; }
        for (int i = tid; i < nb * 16; i += NTH) lsl[16 + i] = CHKI[CH_BBASE + i];
    }
    __syncthreads();
    const float* gamma = (a.ffn ? p.in[7] : p.in[6]) + a.layer * 1024;
    const bf16_t* YMOE = (const bf16_t*)(ws + WS_PROJ);
    const int4* ROUTE = (const int4*)(ws + WS_ROUTE);
    const float2* GATE = (const float2*)(ws + WS_GATE);
    const int stride = nb * 8;
    for (int row0 = bid * 8 + wid; row0 < a.nrows; row0 += (NS == 16 ? 2 : 1) * stride) {
        const bool hasB = NS == 16 && row0 + stride < a.nrows;
        const int rw[2] = {row0, hasB ? row0 + stride : row0};
        float v[2][16];
#pragma unroll
        for (int u = 0; u < 2; ++u) {
            const int row = rw[u];
            const float* src = a.src ? XRES + (size_t)row * 1024 : (row >= SEQ ? p.in[2] + (size_t)(row - SEQ) * 1024 : p.in[0] + (size_t)row * 1024);
#pragma unroll
            for (int i = 0; i < 4; ++i) { const float4 t = *(const float4*)(src + i * 256 + lane * 4); v[u][i * 4] = t.x; v[u][i * 4 + 1] = t.y; v[u][i * 4 + 2] = t.z; v[u][i * 4 + 3] = t.w; }
        }
        if (a.combine) {
            int4 rt[2]; float2 gt[2];
#pragma unroll
            for (int u = 0; u < 2; ++u) { rt[u] = ROUTE[rw[u]]; gt[u] = GATE[rw[u]]; }
            uint2 y0[2][4], y1[2][4];
#pragma unroll
            for (int u = 0; u < 2; ++u) {
                const int blk = (rw[u] >> 3) % nb;
                const int s0 = lsl[rt[u].x] + lsl[16 + blk * 16 + rt[u].x] + rt[u].y, s1 = lsl[rt[u].z] + lsl[16 + blk * 16 + rt[u].z] + rt[u].w;
#pragma unroll
                for (int i = 0; i < 4; ++i) { y0[u][i] = *(const uint2*)(YMOE + (size_t)s0 * 1024 + i * 256 + lane * 4); y1[u][i] = *(const uint2*)(YMOE + (size_t)s1 * 1024 + i * 256 + lane * 4); }
            }
#pragma unroll
            for (int u = 0; u < 2; ++u) {
                const int row = rw[u];
                const float* gf = MODS + (a.clayer * 2 + (row >= SEQ ? 1 : 0)) * 6144 + 5 * 1024;
#pragma unroll
                for (int i = 0; i < 4; ++i) {
                    const float4 g = *(const float4*)(gf + i * 256 + lane * 4);
                    v[u][i * 4 + 0] += g.x * (gt[u].x * __uint_as_float(y0[u][i].x << 16) + gt[u].y * __uint_as_float(y1[u][i].x << 16));
                    v[u][i * 4 + 1] += g.y * (gt[u].x * __uint_as_float(y0[u][i].x & 0xffff0000u) + gt[u].y * __uint_as_float(y1[u][i].x & 0xffff0000u));
                    v[u][i * 4 + 2] += g.z * (gt[u].x * __uint_as_float(y0[u][i].y << 16) + gt[u].y * __uint_as_float(y1[u][i].y << 16));
                    v[u][i * 4 + 3] += g.w * (gt[u].x * __uint_as_float(y0[u][i].y & 0xffff0000u) + gt[u].y * __uint_as_float(y1[u][i].y & 0xffff0000u));
                }
                if (u == 0 || hasB) {
                    float* dst = a.final_out ? p.get_out() + (size_t)row * 1024 : XRES + (size_t)row * 1024;
#pragma unroll
                    for (int i = 0; i < 4; ++i) *(float4*)(dst + i * 256 + lane * 4) = make_float4(v[u][i * 4], v[u][i * 4 + 1], v[u][i * 4 + 2], v[u][i * 4 + 3]);
                }
            }
            if (a.final_out) continue;
        }
#pragma unroll
        for (int u = 0; u < 2; ++u) {
            const int row = rw[u];
            if (u == 0 || hasB) {
            const float* md = MODS + (a.layer * 2 + (row >= SEQ ? 1 : 0)) * 6144 + (a.ffn ? 3 * 1024 : 0);
            const float s0 = row_norm_proj<NS>(v[u], gamma, md, HB + (size_t)row * 1024, lds, lane, !a.noproj);
            if (a.noproj) {
            } else if (!a.route) {
                const int nl = NS == 16 ? (((lane >> 5) & 1) << 3) | (((lane >> 4) & 1) << 2) | (((lane >> 3) & 1) << 1) | ((lane >> 2) & 1)
                                        : (((lane >> 5) & 1) << 4) | (((lane >> 4) & 1) << 3) | (((lane >> 3) & 1) << 2) | (((lane >> 2) & 1) << 1) | ((lane >> 1) & 1);
                if ((lane & (NS == 16 ? 3 : 1)) == 0) SMALL[(size_t)row * 32 + nl] = s0;
            } else if (NS == 16) {
                const int nl = (((lane >> 5) & 1) << 3) | (((lane >> 4) & 1) << 2) | (((lane >> 3) & 1) << 1) | ((lane >> 2) & 1);
                const float scl = 1.f / (1.f + expf(-s0)), bsl = scl + p.in[5][nl];
                float sc[16], bs[16];
#pragma unroll
                for (int n = 0; n < 16; ++n) { const int sl = ((n & 8) ? 32 : 0) | ((n & 4) ? 16 : 0) | ((n & 2) ? 8 : 0) | ((n & 1) ? 4 : 0); sc[n] = rdlane(scl, sl); bs[n] = rdlane(bsl, sl); }
                int e0, e1; float g0, g1; route16(sc, bs, e0, e1, g0, g1);
                if (lane == 0) {
                    const int p0 = (int)atomicAdd(lcnt + e0, 1u), p1 = (int)atomicAdd(lcnt + e1, 1u);
                    const int4 rt4 = make_int4(e0, p0, e1, p1);
                    ((int4*)(ws + WS_ROUTE))[row] = rt4;
                    ((float2*)(ws + WS_GATE))[row] = make_float2(g0, g1);
                    lrt[((row - (bid * 8 + wid)) / stride) * 8 + wid] = rt4;
                }
            }
            }
            __builtin_amdgcn_sched_barrier(0);
        }
    }
    if (a.route) {
        __syncthreads();
        if (tid < 16) {
            u32* cnt = (u32*)(ws + WS_CTL) + CW_CNT + (a.layer * 16 + tid) * 64;
            const int base = (int)atomicAdd(cnt, lcnt[tid]);
            CHKI[CH_BBASE + bid * 16 + tid] = base; lcnt[16 + tid] = (u32)base;
        }
        __syncthreads();
        if (lane == 0) {
            int* ELIST = CHKI + CH_ELIST;
            int k = 0;
            for (int row = bid * 8 + wid; row < a.nrows; row += stride, ++k) {
                const int4 r = lrt[k * 8 + wid];
                ELIST[r.x * MT + (int)lcnt[16 + r.x] + r.y] = row; ELIST[r.z * MT + (int)lcnt[16 + r.z] + r.w] = row;
            }
        }
    }
}

namespace g8 {
#define G8_LAS __attribute__((address_space(3)))
typedef short bf16x8 __attribute__((ext_vector_type(8)));
typedef float f32x4 __attribute__((ext_vector_type(4)));
constexpr int BM = 256, BK = 64, HALF = 128, HTB = HALF * BK * 2, STAGE_BYTES = 8 * HTB, NXCD = 8, WGM = 8;
__device__ __forceinline__ int lds_byte(int r, int c) { const int st = (r >> 4) * 2 + (c >> 5), rr = r & 15, cc = c & 31, ob = rr * 64 + cc * 2; return st * 1024 + (ob ^ (((ob >> 9) & 1) << 5)); }
__device__ __forceinline__ void stage_rc(int b, int& R, int& C) { const int st = b / 1024, sb = b % 1024, swz = sb ^ (((sb >> 9) & 1) << 5); R = (st >> 1) * 16 + swz / 64; C = (st & 1) * 32 + (swz % 64) / 2; }
__device__ __forceinline__ int perm32(int rho) { const int n = rho >> 4, i = rho & 15; return 8 * (i >> 2) + 4 * n + (i & 3); }
struct Unit { int pm, pn; };
struct Order {
    int nM, nN, nwg, G, c;
    __device__ __forceinline__ void init(int nM_, int nN_, int G_, int c_) { nM = nM_; nN = nN_; nwg = nM * nN; G = G_; c = c_; }
    __device__ __forceinline__ bool next(int i, Unit& u) const {
        const long L = (long)i * G + c; if (L >= nwg) return false;
        int wgid = (int)L; { const int q = nwg / NXCD, r = nwg % NXCD, xcd = wgid % NXCD, off = wgid / NXCD; wgid = (xcd < r ? xcd * (q + 1) : r * (q + 1) + (xcd - r) * q) + off; }
        const int nig = WGM * nN, gid = wgid / nig, fm = gid * WGM, gsz = (nM - fm) < WGM ? (nM - fm) : WGM;
        u.pm = fm + ((wgid % nig) % gsz); u.pn = (wgid % nig) / gsz; return true;
    }
};
template <class RowSrc, class BSel, class EF>
__device__ __forceinline__ void gemm8(const int tid, G8_LAS unsigned char* lds, const bf16_t* A, int K, const RowSrc& rsrc, const Order& S, const BSel& bsel, const EF& ef) {
    const int wid = __builtin_amdgcn_readfirstlane(tid >> 6), lane = tid & 63, wr = wid >> 2, wc = wid & 3, fr = lane & 15, fq = lane >> 4;
    const int nt = K / BK;
    int R0, C0, R1, C1; stage_rc(tid * 16, R0, C0); stage_rc(tid * 16 + 8192, R1, C1);
    const unsigned vb0 = (unsigned)(((R0 & ~31) + perm32(R0 & 31)) * K + C0) * 2u, vb1 = (unsigned)(((R1 & ~31) + perm32(R1 & 31)) * K + C1) * 2u;
    const size_t kstep = (size_t)(BK * 2), hstep = (size_t)HALF * K * 2, tstep = 2 * hstep;
    const unsigned ldsw = (unsigned)wid * 1024u;
    const int aoff = lds_byte(wr * 64 + fr, fq * 8), boff = lds_byte(wc * 32 + fr, fq * 8);
#define G8_SA(b, h) (((b) * 2 + (h)) * HTB)
#define G8_SB(b, h) ((4 + (b) * 2 + (h)) * HTB)
#define G8_STAGE(bufoff, gbase, v0, v1) do { \
        __builtin_amdgcn_global_load_lds((const unsigned*)((const char*)(gbase) + (v0)), (G8_LAS unsigned*)(lds + (bufoff) + ldsw), 16, 0, 0); \
        __builtin_amdgcn_global_load_lds((const unsigned*)((const char*)(gbase) + (v1)), (G8_LAS unsigned*)(lds + (bufoff) + ldsw + 8192), 16, 0, 0); } while (0)
#define G8_LDA(dst, b, h) do { _Pragma("unroll") for (int m = 0; m < 4; ++m) _Pragma("unroll") for (int k = 0; k < 2; ++k) dst[m][k] = *(const G8_LAS bf16x8*)(lds + G8_SA(b, h) + aoff + m * 2048 + k * 1024); } while (0)
#define G8_LDB(dst, b, h) do { _Pragma("unroll") for (int n = 0; n < 2; ++n) _Pragma("unroll") for (int k = 0; k < 2; ++k) dst[n][k] = *(const G8_LAS bf16x8*)(lds + G8_SB(b, h) + boff + n * 2048 + k * 1024); } while (0)
#define G8_MMA(ai, bj, At, Bt) do { __builtin_amdgcn_s_setprio(1); _Pragma("unroll") for (int m = 0; m < 4; ++m) _Pragma("unroll") for (int n = 0; n < 2; ++n) _Pragma("unroll") for (int k = 0; k < 2; ++k) \
        acc[ai][bj][m][n] = __builtin_amdgcn_mfma_f32_16x16x32_bf16(Bt[n][k], At[m][k], acc[ai][bj][m][n], 0, 0, 0); __builtin_amdgcn_s_setprio(0); } while (0)
#define G8_WAIT_V(n) asm volatile("s_waitcnt vmcnt(" #n ")" ::: "memory")
#define G8_WAIT_L(n) asm volatile("s_waitcnt lgkmcnt(" #n ")" ::: "memory")
#define G8_BAR __builtin_amdgcn_s_barrier()
#define G8_SCHED __builtin_amdgcn_sched_barrier(0)
#define G8_AOFF(pm_, h_, R_, C_) ((unsigned)(rsrc((pm_), (h_) * 128 + (R_)) * K + (C_)) * 2u)
    Unit cur, nxt; int ui = 0;
    if (!S.next(0, cur)) return;
    f32x4 acc[2][2][4][2];
#pragma unroll
    for (int a = 0; a < 2; ++a)
#pragma unroll
        for (int b = 0; b < 2; ++b)
#pragma unroll
            for (int m = 0; m < 4; ++m)
#pragma unroll
                for (int n = 0; n < 2; ++n) acc[a][b][m][n] = (f32x4){0.f, 0.f, 0.f, 0.f};
    bf16x8 At[4][2], B0[2][2], B1[2][2];
    const char* Ab = (const char*)A;
    unsigned a00 = G8_AOFF(cur.pm, 0, R0, C0), a01 = G8_AOFF(cur.pm, 0, R1, C1), a10 = G8_AOFF(cur.pm, 1, R0, C0), a11 = G8_AOFF(cur.pm, 1, R1, C1);
    const char* cB = bsel(cur.pm) + (size_t)cur.pn * tstep;
    G8_STAGE(G8_SB(0, 0), cB, vb0, vb1); G8_STAGE(G8_SA(0, 0), Ab, a00, a01); G8_STAGE(G8_SB(0, 1), cB + hstep, vb0, vb1); G8_STAGE(G8_SA(0, 1), Ab, a10, a11);
    if (wr == 1) G8_BAR;
    G8_WAIT_V(4); G8_BAR;
    G8_STAGE(G8_SB(1, 0), cB + kstep, vb0, vb1); G8_STAGE(G8_SA(1, 0), Ab + kstep, a00, a01); G8_STAGE(G8_SB(1, 1), cB + hstep + kstep, vb0, vb1);
    G8_WAIT_V(6); G8_BAR;
    for (;;) {
        const bool has_next = S.next(ui + 1, nxt);
        unsigned n00 = a00, n01 = a01, n10 = a10, n11 = a11; const char* nB = cB;
        if (has_next) { n00 = G8_AOFF(nxt.pm, 0, R0, C0); n01 = G8_AOFF(nxt.pm, 0, R1, C1); n10 = G8_AOFF(nxt.pm, 1, R0, C0); n11 = G8_AOFF(nxt.pm, 1, R1, C1); nB = bsel(nxt.pm) + (size_t)nxt.pn * tstep; }
        for (int t = 0; t < nt; t += 2) {
            const bool last = (t == nt - 2);
            const char* a1p = Ab + (size_t)(t + 1) * kstep;
            const char* a2p = last ? Ab : Ab + (size_t)(t + 2) * kstep; const char* b2 = last ? nB : cB + (size_t)(t + 2) * kstep;
            const char* a3p = a2p + kstep; const char* b3 = b2 + kstep;
            const unsigned x00 = last ? n00 : a00, x01 = last ? n01 : a01, x10 = last ? n10 : a10, x11 = last ? n11 : a11;
            G8_LDB(B0, 0, 0); G8_SCHED; G8_LDA(At, 0, 0); G8_STAGE(G8_SA(1, 1), a1p, a10, a11);
            G8_WAIT_L(8); G8_BAR; G8_WAIT_L(0); G8_MMA(0, 0, At, B0); G8_BAR; G8_SCHED;
            G8_LDB(B1, 0, 1); G8_STAGE(G8_SB(0, 0), b2, vb0, vb1);
            G8_BAR; G8_WAIT_L(0); G8_MMA(0, 1, At, B1); G8_BAR;
            G8_LDA(At, 0, 1); G8_STAGE(G8_SA(0, 0), a2p, x00, x01);
            G8_BAR; G8_WAIT_L(0); G8_MMA(1, 0, At, B0); G8_BAR; G8_SCHED;
            G8_STAGE(G8_SB(0, 1), b2 + hstep, vb0, vb1);
            G8_WAIT_V(6); G8_BAR; G8_MMA(1, 1, At, B1); G8_BAR;
            G8_LDB(B0, 1, 0); G8_SCHED; G8_LDA(At, 1, 0); G8_STAGE(G8_SA(0, 1), a2p, x10, x11);
            G8_WAIT_L(8); G8_BAR; G8_WAIT_L(0); G8_MMA(0, 0, At, B0); G8_BAR; G8_SCHED;
            G8_LDB(B1, 1, 1); G8_STAGE(G8_SB(1, 0), b3, vb0, vb1);
            G8_BAR; G8_WAIT_L(0); G8_MMA(0, 1, At, B1); G8_BAR;
            G8_LDA(At, 1, 1); G8_STAGE(G8_SA(1, 0), a3p, x00, x01);
            G8_BAR; G8_WAIT_L(0); G8_MMA(1, 0, At, B0); G8_BAR; G8_SCHED;
            G8_STAGE(G8_SB(1, 1), b3 + hstep, vb0, vb1);
            G8_WAIT_V(6); G8_BAR; G8_MMA(1, 1, At, B1); G8_BAR;
        }
#pragma unroll
        for (int ai = 0; ai < 2; ++ai)
#pragma unroll
            for (int m = 0; m < 4; ++m)
#pragma unroll
                for (int bj = 0; bj < 2; ++bj) {
                    const f32x4 v0 = acc[ai][bj][m][0], v1 = acc[ai][bj][m][1];
                    const float v[8] = {v0[0], v0[1], v0[2], v0[3], v1[0], v1[1], v1[2], v1[3]};
                    ef(cur.pm * BM + ai * HALF + wr * 64 + m * 16 + fr, cur.pn * BM + bj * HALF + wc * 32 + 8 * fq, v);
                }
        if (!has_next) break;
#pragma unroll
        for (int a = 0; a < 2; ++a)
#pragma unroll
            for (int b = 0; b < 2; ++b)
#pragma unroll
                for (int m = 0; m < 4; ++m)
#pragma unroll
                    for (int n = 0; n < 2; ++n) acc[a][b][m][n] = (f32x4){0.f, 0.f, 0.f, 0.f};
        cur = nxt; a00 = n00; a01 = n01; a10 = n10; a11 = n11; cB = nB; ++ui;
    }
    G8_WAIT_V(0);
    if (wr == 0) G8_BAR;
    G8_BAR;
#undef G8_SA
#undef G8_SB
#undef G8_STAGE
#undef G8_LDA
#undef G8_LDB
#undef G8_MMA
#undef G8_WAIT_V
#undef G8_WAIT_L
#undef G8_BAR
#undef G8_SCHED
#undef G8_AOFF
}
}
struct BSelOne { const char* B; __device__ __forceinline__ const char* operator()(int) const { return B; } };
struct RowPlain { __device__ __forceinline__ int operator()(int pm, int r) const { return pm * 256 + r; } };
struct BSelExp { const char* B; const int* tinfo; size_t stride; __device__ __forceinline__ const char* operator()(int pm) const { return B + (size_t)tinfo[2 * pm] * stride; } };
struct RowMoe { const int* tinfo; const int* ecnt; const int* elist;
    __device__ __forceinline__ int operator()(int pm, int r) const { const int e = tinfo[2 * pm], pos = tinfo[2 * pm + 1] + r; return pos < ecnt[e] ? elist[e * MT + pos] : 0; } };
__device__ __forceinline__ int moe_tile_table(const P& p, int layer, int* tinfo, int* ecnt, int tid) {
    const u32* cnt = (const u32*)(p.get_ws() + WS_CTL) + CW_CNT + layer * 16 * 64;
    if (tid == 0) {
        int t = 0;
#pragma unroll 1
        for (int e = 0; e < 16; ++e) { const int c = (int)cnt[e * 64]; ecnt[e] = c;
#pragma unroll 1
            for (int i = 0; i < (c + 255) / 256; ++i) { tinfo[2 * t] = e; tinfo[2 * t + 1] = i * 256; ++t; } }
        ecnt[16] = t;
    }
    __syncthreads();
    return ecnt[16];
}

struct SrcPlain { const float* W; int ldw; __device__ __forceinline__ const float* operator()(int k, int n) const { return W + (size_t)k * ldw + n; } };
struct SrcEven { const float* W; __device__ __forceinline__ const float* operator()(int k, int n) const {
        return n < 2048 ? W + (size_t)k * EV_IN + (n < 1280 ? n : n + 16) : (n < 2064 ? W + (size_t)k * EV_IN + 1280 + (n - 2048) : nullptr); } };
struct SrcOdd { const float* W; __device__ __forceinline__ const float* operator()(int k, int n) const { return n < OD_IN ? W + (size_t)k * OD_IN + n : nullptr; } };
struct SrcMoe13 { const float* W1; long long d13; __device__ __forceinline__ const float* operator()(int k, int n) const { return W1 + ((n & 4) ? d13 : 0ll) + (size_t)k * DE + ((n >> 3) * 4 + (n & 3)); } };
template <class SF>
__device__ __forceinline__ void conv_matrix(const SF& src, int K, int N, bf16_t* WT, int gw, int ngw, float* scr, int lane) {
    const int nblk = N / 32, nitems = (K / 64) * nblk;
    for (int item = gw; item < nitems; item += ngw) {
        const int kb = item / nblk, nbk = item % nblk, k0 = 64 * kb, n0 = 32 * nbk;
#pragma unroll 8
        for (int i = 0; i < 32; ++i) { const int kk = 2 * i + (lane >> 5); const float* sp = src(k0 + kk, n0 + (lane & 31)); scr[kk * 33 + (lane & 31)] = sp ? *sp : 0.f; }
        __builtin_amdgcn_s_waitcnt(0xC07F); asm volatile("" ::: "memory");
        const int c = lane & 7;
#pragma unroll
        for (int j = 0; j < 4; ++j) { const int n = (lane >> 3) + 8 * j; const float* sp = scr + (8 * c) * 33 + n;
            uint4 o; o.x = pack2(sp[0 * 33], sp[1 * 33]); o.y = pack2(sp[2 * 33], sp[3 * 33]); o.z = pack2(sp[4 * 33], sp[5 * 33]); o.w = pack2(sp[6 * 33], sp[7 * 33]);
            *(uint4*)(WT + (size_t)(n0 + n) * K + k0 + 8 * c) = o; }
        __builtin_amdgcn_s_waitcnt(0xC07F); asm volatile("" ::: "memory");
    }
}
__device__ __forceinline__ void conv_dense(const P& p, int bid, int nb, float* lds) {
    const int tid = p.tid(), lane = tid & 63, wid = tid >> 6;
    float* scr = lds + 16384 + wid * (64 * 33);
    const int gw = bid * 8 + wid, ngw = nb * 8;
    unsigned char* ws = p.get_ws();
    conv_matrix(SrcEven{p.in[10]}, 1024, 2304, (bf16_t*)(ws + WS_WIN0), gw, ngw, scr, lane);
    conv_matrix(SrcOdd{p.in[21]}, 1024, 3328, (bf16_t*)(ws + WS_WIN1), gw, ngw, scr, lane);
    conv_matrix(SrcPlain{p.in[20], 1024}, 1024, 1024, (bf16_t*)(ws + WS_WOUT0), gw, ngw, scr, lane);
    conv_matrix(SrcPlain{p.in[27], 1024}, 1024, 1024, (bf16_t*)(ws + WS_WOUT1), gw, ngw, scr, lane);
}
__device__ __forceinline__ void conv_moe(const P& p, int bid, int nb, float* lds, int layer) {
    const int tid = p.tid(), lane = tid & 63, wid = tid >> 6;
    float* scr = lds + 16384 + wid * (64 * 33);
    const int ngw = nb * 8; int gw = bid * 8 + wid;
    unsigned char* ws = p.get_ws();
    bf16_t* W13T = (bf16_t*)(ws + WS_WMOE); bf16_t* W2T = W13T + (size_t)16 * 1024 * 1024;
    const long long d13 = (long long)(p.in[29] - p.in[28]);
    for (int e = 0; e < 16; ++e) {
        conv_matrix(SrcMoe13{p.in[28] + ((size_t)layer * 16 + e) * 1024 * DE, d13}, 1024, 1024, W13T + (size_t)e * 1024 * 1024, gw, ngw, scr, lane);
        conv_matrix(SrcPlain{p.in[30] + ((size_t)layer * 16 + e) * DE * 1024, 1024}, DE, 1024, W2T + (size_t)e * 1024 * DE, gw, ngw, scr, lane);
        gw = (gw + 768) % ngw;
    }
}

struct EpiProj { bf16_t* C; int ld; int nmain; int ns; float* SMALL; __device__ void operator()(int r, int c0, const float* v) const {
    if (c0 < nmain) { uint4 o; o.x = pack2(v[0], v[1]); o.y = pack2(v[2], v[3]); o.z = pack2(v[4], v[5]); o.w = pack2(v[6], v[7]); *(uint4*)(C + (size_t)r * ld + c0) = o; }
    else if (c0 < nmain + ns) { float* d = SMALL + (size_t)r * 32 + (c0 - nmain); *(float4*)d = make_float4(v[0], v[1], v[2], v[3]); *(float4*)(d + 4) = make_float4(v[4], v[5], v[6], v[7]); } } };
struct EpiBf16Store { bf16_t* C; int ld; __device__ void operator()(int r, int c0, const float* v) const {
    uint4 o; o.x = pack2(v[0], v[1]); o.y = pack2(v[2], v[3]); o.z = pack2(v[4], v[5]); o.w = pack2(v[6], v[7]); *(uint4*)(C + (size_t)r * ld + c0) = o; } };
struct EpiResid { const float* xlat; const float* xctx; float* XRES; const float* gl; const float* gc;
    __device__ void operator()(int r, int c0, const float* v) const {
        const float* xin = xctx && r >= SEQ ? xctx + (size_t)(r - SEQ) * 1024 : xlat + (size_t)r * 1024;
        const float* g = r >= SEQ ? gc : gl;
        const float4 x0 = *(const float4*)(xin + c0), x1 = *(const float4*)(xin + c0 + 4), g0 = *(const float4*)(g + c0), g1 = *(const float4*)(g + c0 + 4);
        *(float4*)(XRES + (size_t)r * 1024 + c0) = make_float4(x0.x + g0.x * v[0], x0.y + g0.y * v[1], x0.z + g0.z * v[2], x0.w + g0.w * v[3]);
        *(float4*)(XRES + (size_t)r * 1024 + c0 + 4) = make_float4(x1.x + g1.x * v[4], x1.y + g1.y * v[5], x1.z + g1.z * v[6], x1.w + g1.w * v[7]);
    } };
struct EpiSwiglu { bf16_t* H; __device__ void operator()(int r, int c0, const float* v) const {
    uint2 o; o.x = pack2(siluf(v[0]) * v[4], siluf(v[1]) * v[5]); o.y = pack2(siluf(v[2]) * v[6], siluf(v[3]) * v[7]); *(uint2*)(H + (size_t)r * DE + (c0 >> 3) * 4) = o; } };

__device__ __forceinline__ void phase_moe1(const P& p, int bid, int nb, G8_LAS unsigned char* ldsa, float* lds, int layer) {
    unsigned char* ws = p.get_ws();
    int* tinfo = (int*)(lds + 32768); int* ecnt = tinfo + 2 * MAXTILES + 16;
    const int ntiles = moe_tile_table(p, layer, tinfo, ecnt, p.tid());
    g8::Order S; S.init(ntiles, 4, nb, bid);
    EpiSwiglu ef{(bf16_t*)(ws + WS_Y)};
    g8::gemm8(p.tid(), ldsa, (const bf16_t*)(ws + WS_HB), 1024, RowMoe{tinfo, ecnt, (const int*)(ws + WS_CHK) + CH_ELIST}, S, BSelExp{(const char*)(ws + WS_WMOE), tinfo, (size_t)1024 * 1024 * 2}, ef);
}
__device__ __forceinline__ void phase_moe2(const P& p, int bid, int nb, G8_LAS unsigned char* ldsa, float* lds, int layer) {
    unsigned char* ws = p.get_ws();
    int* tinfo = (int*)(lds + 32768); int* ecnt = tinfo + 2 * MAXTILES + 16;
    const int ntiles = moe_tile_table(p, layer, tinfo, ecnt, p.tid());
    g8::Order S; S.init(ntiles, 4, nb, bid);
    EpiBf16Store ef{(bf16_t*)(ws + WS_PROJ), 1024};
    g8::gemm8(p.tid(), ldsa, (const bf16_t*)(ws + WS_Y), DE, RowPlain{}, S, BSelExp{(const char*)(ws + WS_WMOE) + (size_t)16 * 1024 * 1024 * 2, tinfo, (size_t)1024 * DE * 2}, ef);
}

__device__ __forceinline__ void phase_qkprep(const P& p, int bid, int nb) {
    const int tid = p.tid(), lane = tid & 63, wid = tid >> 6;
    unsigned char* ws = p.get_ws();
    const bf16_t* PROJ = (const bf16_t*)(ws + WS_PROJ);
    bf16_t* QKR = (bf16_t*)(ws + WS_XRES);
    const float* RC = (const float*)(ws + WS_ROPE); const float* RS = RC + 256 * 16;
    const float qn = p.in[17][lane], kn = p.in[18][lane];
    for (int row = bid * 8 + wid; row < MT; row += nb * 8) {
        const bool lat = row < SEQ;
        const int pos = lane < 32 ? (row >> 6) : (row & 63);
        const int f = lane & 15;
        const float cs = lat ? RC[pos * 16 + f] : 1.f, sn = lat ? RS[pos * 16 + f] : 0.f;
        for (int h = 0; h < 10; ++h) {
            const float x = bf2f(PROJ[(size_t)row * 2048 + 1280 + h * 64 + lane]);
            const float ss = wave_sum(x * x);
            const float y = x * rsqrtf(ss * (1.f / 64.f) + 1e-6f) * (h < 8 ? qn : kn);
            const float o = __shfl_xor(y, 16);
            const float r = ((lane & 16) == 0) ? y * cs - o * sn : o * sn + y * cs;
            QKR[(size_t)row * 640 + h * 64 + lane] = f2bf(r);
        }
    }
}


typedef short bf16x8 __attribute__((ext_vector_type(8)));
typedef float f32x4 __attribute__((ext_vector_type(4)));
template <int MI, int NI, int KK, bool SWAP>
__device__ __forceinline__ void wave_mma(f32x4 (&acc)[MI][NI], const bf16_t* A, int lda, const bf16_t* Bt, int ldb, int lane) {
    const int r = lane & 15, q = lane >> 4;
#pragma unroll
    for (int kk = 0; kk < KK; kk += 32) {
        bf16x8 a[MI], b[NI];
#pragma unroll
        for (int mi = 0; mi < MI; ++mi) a[mi] = *(const bf16x8*)(A + (16 * mi + r) * lda + kk + 8 * q);
#pragma unroll
        for (int ni = 0; ni < NI; ++ni) b[ni] = *(const bf16x8*)(Bt + (16 * ni + r) * ldb + kk + 8 * q);
#pragma unroll
        for (int mi = 0; mi < MI; ++mi)
#pragma unroll
            for (int ni = 0; ni < NI; ++ni)
                acc[mi][ni] = SWAP ? __builtin_amdgcn_mfma_f32_16x16x32_bf16(b[ni], a[mi], acc[mi][ni], 0, 0, 0) : __builtin_amdgcn_mfma_f32_16x16x32_bf16(a[mi], b[ni], acc[mi][ni], 0, 0, 0);
    }
}
__device__ __forceinline__ void unpack8(const uint4 w, float* f) {
    f[0] = __uint_as_float(w.x << 16); f[1] = __uint_as_float(w.x & 0xffff0000u); f[2] = __uint_as_float(w.y << 16); f[3] = __uint_as_float(w.y & 0xffff0000u);
    f[4] = __uint_as_float(w.z << 16); f[5] = __uint_as_float(w.z & 0xffff0000u); f[6] = __uint_as_float(w.w << 16); f[7] = __uint_as_float(w.w & 0xffff0000u);
}
struct Raw3 { uint4 m, c, p; };
__device__ __forceinline__ Raw3 conv8_load(const bf16_t* rowp, int ld, int t, int L) {
    const uint4 z = make_uint4(0u, 0u, 0u, 0u);
    Raw3 r; r.m = t > 0 ? *(const uint4*)(rowp - ld) : z; r.c = *(const uint4*)rowp; r.p = t < L - 1 ? *(const uint4*)(rowp + ld) : z; return r;
}
__device__ __forceinline__ void conv8_apply(const Raw3& r, const float* cwl, float* out) {
    float fm[8], f0[8], fp[8]; unpack8(r.m, fm); unpack8(r.c, f0); unpack8(r.p, fp);
#pragma unroll
    for (int j = 0; j < 8; ++j) { const float4 w = *(const float4*)(cwl + j * 4); out[j] = siluf(w.x * fm[j] + w.y * f0[j] + w.z * fp[j] + w.w); }
}
__device__ __forceinline__ float wave_scan128(float& v0, float& v1, int lane) {
    float s = v0 + v1;
#pragma unroll
    for (int o = 1; o < 64; o <<= 1) { const float t = __shfl_up(s, o); if (lane >= o) s += t; }
    const float excl = s - (v0 + v1);
    v0 = excl + v0; v1 = v0 + v1;
    return __shfl(s, 63);
}

constexpr size_t SSD_S_OFF = 0;
constexpr size_t SSD_H_OFF = (size_t)130 * 16 * 4096 * 4;
__device__ __forceinline__ void stage_convw(const float* cw, const float* cb, int C, float* cwl, int tid) {
    for (int c = tid; c < C; c += NTH) *(float4*)(cwl + c * 4) = make_float4(cw[c], cw[C + c], cw[2 * C + c], cb[c]);
}
__device__ __forceinline__ void ssd_states(const P& p, int bid, int nb, float* lds) {
    const int tid = p.tid(), lane = tid & 63, wid = tid >> 6;
    unsigned char* ws = p.get_ws();
    const bf16_t* PROJ = (const bf16_t*)(ws + WS_PROJ);
    const float* SMALL = (const float*)(ws + WS_SMALL);
    float* S = (float*)(ws + WS_Y + SSD_S_OFF);
    float* DEC = (float*)(ws + WS_CHK);
    float* cwl = lds;
    bf16_t* XT = (bf16_t*)(lds + 768 * 4);
    bf16_t* BT = XT + 256 * 136;
    float* wsc = (float*)(BT + 64 * 136);
    stage_convw(p.in[11], p.in[12], 768, cwl, tid);
    __syncthreads();
    for (int item = bid; item < 260; item += nb) {
        const int c = item >> 1, g = item & 1;
        const int L = c < 128 ? SEQ : CTX, t0 = c < 128 ? c * 128 : (c - 128) * 128, rbase = c < 128 ? 0 : SEQ;
#pragma unroll 1
        for (int b5 = 0; b5 < 2; ++b5) {
            Raw3 rw[5];
#pragma unroll
            for (int k = 0; k < 5; ++k) { const int i = tid + (b5 * 5 + k) * NTH; const int tl = i & 127, cg8 = i >> 7;
                const int ch = cg8 < 32 ? g * 256 + cg8 * 8 : 512 + g * 64 + (cg8 - 32) * 8;
                rw[k] = conv8_load(PROJ + (size_t)(rbase + t0 + tl) * 2048 + 512 + ch, 2048, t0 + tl, L); }
#pragma unroll
            for (int k = 0; k < 5; ++k) { const int i = tid + (b5 * 5 + k) * NTH; const int tl = i & 127, cg8 = i >> 7;
                const int ch = cg8 < 32 ? g * 256 + cg8 * 8 : 512 + g * 64 + (cg8 - 32) * 8;
                float o[8]; conv8_apply(rw[k], cwl + ch * 4, o);
                bf16_t* dst = cg8 < 32 ? XT + (cg8 * 8) * 136 + tl : BT + ((cg8 - 32) * 8) * 136 + tl;
#pragma unroll
                for (int j = 0; j < 8; ++j) dst[j * 136] = f2bf(o[j]); }
        }
        const int hh = wid >> 1, d = wid & 1, h = g * 4 + hh;
        {
            const float A = -expf(p.in[14][d * 8 + h]), dtb = p.in[13][d * 8 + h];
            const float dt0 = softplusf(SMALL[(size_t)(rbase + t0 + 2 * lane) * 32 + d * 8 + h] + dtb), dt1 = softplusf(SMALL[(size_t)(rbase + t0 + 2 * lane + 1) * 32 + d * 8 + h] + dtb);
            const float a0 = dt0 * A, a1 = dt1 * A;
            float c0 = a0, c1 = a1; const float tot = wave_scan128(c0, c1, lane);
            const float w0 = d == 0 ? __expf(tot - c0) * dt0 : __expf(c0 - a0) * dt0, w1 = d == 0 ? __expf(tot - c1) * dt1 : __expf(c1 - a1) * dt1;
            wsc[wid * 128 + 2 * lane] = w0; wsc[wid * 128 + 2 * lane + 1] = w1;
            if (lane == 0) DEC[c * 16 + d * 8 + h] = __expf(tot);
        }
        __syncthreads();
        {
            f32x4 acc[4][4];
#pragma unroll
            for (int mi = 0; mi < 4; ++mi)
#pragma unroll
                for (int ni = 0; ni < 4; ++ni) acc[mi][ni] = (f32x4){0.f, 0.f, 0.f, 0.f};
            const int r = lane & 15, q = lane >> 4;
#pragma unroll
            for (int kk = 0; kk < 128; kk += 32) {
                const float4 wa = *(const float4*)(wsc + wid * 128 + kk + 8 * q), wb = *(const float4*)(wsc + wid * 128 + kk + 8 * q + 4);
                bf16x8 a[4], b[4];
#pragma unroll
                for (int mi = 0; mi < 4; ++mi) {
                    const uint4 raw = *(const uint4*)(XT + (hh * 64 + 16 * mi + r) * 136 + kk + 8 * q);
                    float f[8]; unpack8(raw, f);
                    uint4 o; o.x = pack2(f[0] * wa.x, f[1] * wa.y); o.y = pack2(f[2] * wa.z, f[3] * wa.w); o.z = pack2(f[4] * wb.x, f[5] * wb.y); o.w = pack2(f[6] * wb.z, f[7] * wb.w);
                    a[mi] = *(bf16x8*)&o;
                }
#pragma unroll
                for (int ni = 0; ni < 4; ++ni) b[ni] = *(const bf16x8*)(BT + (16 * ni + r) * 136 + kk + 8 * q);
#pragma unroll
                for (int mi = 0; mi < 4; ++mi)
#pragma unroll
                    for (int ni = 0; ni < 4; ++ni) acc[mi][ni] = __builtin_amdgcn_mfma_f32_16x16x32_bf16(a[mi], b[ni], acc[mi][ni], 0, 0, 0);
                __builtin_amdgcn_sched_barrier(0);
            }
            float* Sp = S + ((size_t)(c * 2 + d) * 8 + h) * 4096;
#pragma unroll
            for (int mi = 0; mi < 4; ++mi)
#pragma unroll
                for (int ni = 0; ni < 4; ++ni)
#pragma unroll
                    for (int j = 0; j < 4; ++j) Sp[(16 * mi + 4 * q + j) * 64 + 16 * ni + r] = acc[mi][ni][j];
        }
        __syncthreads();
    }
}
__device__ __forceinline__ void ssd_scan(const P& p, int bid, int nb) {
    const int tid = p.tid();
    unsigned char* ws = p.get_ws();
    const float* S = (const float*)(ws + WS_Y + SSD_S_OFF);
    bf16_t* HIN = (bf16_t*)(ws + WS_Y + SSD_H_OFF);
    const float* DEC = (const float*)(ws + WS_CHK);
    for (int gid = bid * NTH + tid; gid < 65536; gid += nb * NTH) {
        const int d = gid >> 15, h = (gid >> 12) & 7, e = gid & 4095;
        float H = 0.f;
#pragma unroll 1
        for (int i0 = 0; i0 < 130; i0 += 10) {
            float sv[10], dv[10]; int cc[10];
#pragma unroll
            for (int j = 0; j < 10; ++j) {
                const int i = i0 + j;
                const int c = d == 0 ? (i < 2 ? 128 + i : i - 2) : (i < 2 ? 129 - i : 129 - i);
                cc[j] = c; sv[j] = S[((size_t)(c * 2 + d) * 8 + h) * 4096 + e]; dv[j] = DEC[c * 16 + d * 8 + h];
            }
#pragma unroll
            for (int j = 0; j < 10; ++j) { HIN[((size_t)(cc[j] * 2 + d) * 8 + h) * 4096 + e] = f2bf(H); H = dv[j] * H + sv[j]; }
        }
    }
}
__device__ __forceinline__ void ssd_out(const P& p, int bid, int nb, float* lds) {
    const int tid = p.tid(), lane = tid & 63, wid = tid >> 6, r = lane & 15, q = lane >> 4;
    unsigned char* ws = p.get_ws();
    const bf16_t* PROJ = (const bf16_t*)(ws + WS_PROJ);
    const float* SMALL = (const float*)(ws + WS_SMALL);
    const bf16_t* HIN = (const bf16_t*)(ws + WS_Y + SSD_H_OFF);
    bf16_t* MIX = (bf16_t*)(ws + WS_HB);
    float* cwl = lds;
    bf16_t* Cg = (bf16_t*)(lds + 768 * 4);
    bf16_t* Bg = Cg + 128 * 72;
    bf16_t* XT = Bg + 128 * 72;
    bf16_t* Mb = XT + 64 * 136;
    bf16_t* Hn = Mb + 128 * 136;
    float* csb = (float*)(Hn + 2 * 64 * 72);
    float* dts = csb + 256;
    stage_convw(p.in[11], p.in[12], 768, cwl, tid);
    __syncthreads();
    for (int c = bid; c < 130; c += nb) {
        const int L = c < 128 ? SEQ : CTX, t0 = c < 128 ? c * 128 : (c - 128) * 128, rbase = c < 128 ? 0 : SEQ;
        const int trow = wid * 16 + r;
        float ssq = 0.f;
        for (int g = 0; g < 2; ++g) {
            {
                Raw3 rw[4];
#pragma unroll
                for (int k = 0; k < 4; ++k) { const int i = tid + k * NTH; const int cg8 = i & 15, tl = i >> 4;
                    const int ch = cg8 < 8 ? 640 + g * 64 + cg8 * 8 : 512 + g * 64 + (cg8 - 8) * 8;
                    rw[k] = conv8_load(PROJ + (size_t)(rbase + t0 + tl) * 2048 + 512 + ch, 2048, t0 + tl, L); }
#pragma unroll
                for (int k = 0; k < 4; ++k) { const int i = tid + k * NTH; const int cg8 = i & 15, tl = i >> 4;
                    const int ch = cg8 < 8 ? 640 + g * 64 + cg8 * 8 : 512 + g * 64 + (cg8 - 8) * 8;
                    float o[8]; conv8_apply(rw[k], cwl + ch * 4, o);
                    uint4 w; w.x = pack2(o[0], o[1]); w.y = pack2(o[2], o[3]); w.z = pack2(o[4], o[5]); w.w = pack2(o[6], o[7]);
                    *(uint4*)((cg8 < 8 ? Cg + cg8 * 8 : Bg + (cg8 - 8) * 8) + tl * 72) = w; }
            }
            __syncthreads();
            f32x4 G[1][8];
#pragma unroll
            for (int ni = 0; ni < 8; ++ni) G[0][ni] = (f32x4){0.f, 0.f, 0.f, 0.f};
            wave_mma<1, 8, 64, true>(G, Cg + wid * 16 * 72, 72, Bg, 72, lane);
            for (int hh = 0; hh < 4; ++hh) {
                const int h = g * 4 + hh;
                {
                    Raw3 rw[2];
#pragma unroll
                    for (int k = 0; k < 2; ++k) { const int i = tid + k * NTH; const int tl = i & 127, cg8 = i >> 7; const int ch = h * 64 + cg8 * 8;
                        rw[k] = conv8_load(PROJ + (size_t)(rbase + t0 + tl) * 2048 + 512 + ch, 2048, t0 + tl, L); }
                    const uint4 hp0 = *(const uint4*)(HIN + ((size_t)(c * 2 + 0) * 8 + h) * 4096 + tid * 8), hp1 = *(const uint4*)(HIN + ((size_t)(c * 2 + 1) * 8 + h) * 4096 + tid * 8);
#pragma unroll
                    for (int k = 0; k < 2; ++k) { const int i = tid + k * NTH; const int tl = i & 127, cg8 = i >> 7; const int ch = h * 64 + cg8 * 8;
                        float o[8]; conv8_apply(rw[k], cwl + ch * 4, o);
#pragma unroll
                        for (int j = 0; j < 8; ++j) XT[(cg8 * 8 + j) * 136 + tl] = f2bf(o[j]); }
                    *(uint4*)(Hn + (tid >> 3) * 72 + (tid & 7) * 8) = hp0; *(uint4*)(Hn + 64 * 72 + (tid >> 3) * 72 + (tid & 7) * 8) = hp1;
                }
                if (wid < 2) {
                    const int d = wid;
                    const float A = -expf(p.in[14][d * 8 + h]), dtb = p.in[13][d * 8 + h];
                    const float dt0 = softplusf(SMALL[(size_t)(rbase + t0 + 2 * lane) * 32 + d * 8 + h] + dtb), dt1 = softplusf(SMALL[(size_t)(rbase + t0 + 2 * lane + 1) * 32 + d * 8 + h] + dtb);
                    const float a0 = dt0 * A, a1 = dt1 * A;
                    float c0 = a0, c1 = a1; const float tot = wave_scan128(c0, c1, lane);
                    csb[d * 128 + 2 * lane] = d == 0 ? c0 : tot - c0 + a0; csb[d * 128 + 2 * lane + 1] = d == 0 ? c1 : tot - c1 + a1;
                    dts[d * 128 + 2 * lane] = dt0; dts[d * 128 + 2 * lane + 1] = dt1;
                }
                __syncthreads();
                f32x4 Y[1][4];
#pragma unroll
                for (int ni = 0; ni < 4; ++ni) Y[0][ni] = (f32x4){0.f, 0.f, 0.f, 0.f};
                for (int d = 0; d < 2; ++d) {
                    const float cst = csb[d * 128 + trow];
#pragma unroll
                    for (int ni = 0; ni < 8; ++ni) {
                        const int s0 = 16 * ni + 4 * q;
                        const float4 css = *(const float4*)(csb + d * 128 + s0), dtv = *(const float4*)(dts + d * 128 + s0);
                        const float cs4[4] = {css.x, css.y, css.z, css.w}, dt4[4] = {dtv.x, dtv.y, dtv.z, dtv.w};
                        float m[4];
#pragma unroll
                        for (int j = 0; j < 4; ++j) { const int sidx = s0 + j; const bool ok = d == 0 ? sidx <= trow : sidx >= trow; m[j] = ok ? G[0][ni][j] * __expf(cst - cs4[j]) * dt4[j] : 0.f; }
                        uint2 w; w.x = pack2(m[0], m[1]); w.y = pack2(m[2], m[3]);
                        *(uint2*)(Mb + trow * 136 + s0) = w;
                    }
                    __syncthreads();
                    wave_mma<1, 4, 128, true>(Y, Mb + wid * 16 * 136, 136, XT, 136, lane);
                    f32x4 Yo[1][4];
#pragma unroll
                    for (int ni = 0; ni < 4; ++ni) Yo[0][ni] = (f32x4){0.f, 0.f, 0.f, 0.f};
                    wave_mma<1, 4, 64, true>(Yo, Cg + wid * 16 * 72, 72, Hn + d * 64 * 72, 72, lane);
                    const float ecs = __expf(cst);
#pragma unroll
                    for (int ni = 0; ni < 4; ++ni) Y[0][ni] += Yo[0][ni] * ecs;
                    __syncthreads();
                }
                const float Dh = p.in[15][h];
                const size_t grow = (size_t)(rbase + t0 + trow);
#pragma unroll
                for (int ni = 0; ni < 4; ++ni) {
                    const int p0 = 16 * ni + 4 * q;
                    const uint2 zr = *(const uint2*)(PROJ + grow * 2048 + h * 64 + p0);
                    const float z4[4] = {__uint_as_float(zr.x << 16), __uint_as_float(zr.x & 0xffff0000u), __uint_as_float(zr.y << 16), __uint_as_float(zr.y & 0xffff0000u)};
                    float u[4];
#pragma unroll
                    for (int j = 0; j < 4; ++j) { const float y = Y[0][ni][j] + Dh * bf2f(XT[(p0 + j) * 136 + trow]); u[j] = y * siluf(z4[j]); ssq += u[j] * u[j]; }
                    uint2 w; w.x = pack2(u[0], u[1]); w.y = pack2(u[2], u[3]);
                    *(uint2*)(MIX + grow * 1024 + h * 64 + p0) = w;
                }
                __syncthreads();
            }
        }
        ssq += __shfl_xor(ssq, 16); ssq += __shfl_xor(ssq, 32);
        const float rs = rsqrtf(ssq * (1.f / 512.f) + 1e-6f);
        const size_t grow = (size_t)(rbase + t0 + trow);
        for (int h = 0; h < 8; ++h)
#pragma unroll
            for (int ni = 0; ni < 4; ++ni) {
                const int col = h * 64 + 16 * ni + 4 * q;
                const uint2 ur = *(const uint2*)(MIX + grow * 1024 + col);
                const float4 nw = *(const float4*)(p.in[16] + col);
                uint2 w; w.x = pack2(__uint_as_float(ur.x << 16) * rs * nw.x, __uint_as_float(ur.x & 0xffff0000u) * rs * nw.y);
                w.y = pack2(__uint_as_float(ur.y << 16) * rs * nw.z, __uint_as_float(ur.y & 0xffff0000u) * rs * nw.w);
                *(uint2*)(MIX + grow * 1024 + col) = w;
            }
    }
}


__device__ __forceinline__ void attn_mfma(const P& p, int bid, int nb, float* lds) {
    const int tid = p.tid(), lane = tid & 63, wid = __builtin_amdgcn_readfirstlane(tid >> 6), r = lane & 15, q = lane >> 4;
    unsigned char* ws = p.get_ws();
    const bf16_t* PROJ = (const bf16_t*)(ws + WS_PROJ);
    const bf16_t* QKR = (const bf16_t*)(ws + WS_XRES);
    bf16_t* MIX = (bf16_t*)(ws + WS_HB);
    bf16_t* Kb = (bf16_t*)lds;
    bf16_t* Vb = Kb + 2 * 64 * 72;
    for (int item = bid; item < 260; item += nb) {
        const bool isctx = item >= 256;
        const int qb = isctx ? (item - 256) >> 1 : item >> 1, g = item & 1;
        const int qrow0 = (isctx ? SEQ : 0) + qb * 128;
        const int hq = g * 4 + (wid >> 1), wrow0 = (wid & 1) * 64;
        const int ntl = isctx ? 0 : 6, nt = ntl + 4;
        bf16_t* Qw = Vb + 2 * 64 * 72 + wid * 64 * 72;
#pragma unroll
        for (int mi = 0; mi < 4; ++mi)
#pragma unroll
            for (int kk = 0; kk < 2; ++kk) {
                const uint4 raw = *(const uint4*)(QKR + (size_t)(qrow0 + wrow0 + 16 * mi + r) * 640 + hq * 64 + kk * 32 + 8 * q);
                float f[8]; unpack8(raw, f);
                uint4 o; o.x = pack2(f[0] * 0.125f, f[1] * 0.125f); o.y = pack2(f[2] * 0.125f, f[3] * 0.125f); o.z = pack2(f[4] * 0.125f, f[5] * 0.125f); o.w = pack2(f[6] * 0.125f, f[7] * 0.125f);
                *(uint4*)(Qw + (16 * mi + r) * 72 + kk * 32 + 8 * q) = o;
            }
        const float sink = p.in[19][hq];
        float m[4], l[4]; f32x4 O[4][4];
#pragma unroll
        for (int mi = 0; mi < 4; ++mi) { m[mi] = sink; l[mi] = q == 0 ? 1.f : 0.f;
#pragma unroll
            for (int ni = 0; ni < 4; ++ni) O[mi][ni] = (f32x4){0.f, 0.f, 0.f, 0.f}; }
#define ATT_VALID(ti_) ((ti_) >= ntl || (qb * 128 - 128 + 64 * (ti_) >= 0 && qb * 128 - 128 + 64 * (ti_) < SEQ))
#define ATT_KROW(ti_) ((ti_) < ntl ? qb * 128 - 128 + 64 * (ti_) : SEQ + 64 * ((ti_) - ntl))
        int ti = 0; while (ti < nt && !ATT_VALID(ti)) ++ti;
        uint4 kreg, vreg;
        { const int kr0 = ATT_KROW(ti);
          kreg = *(const uint4*)(QKR + (size_t)(kr0 + (tid >> 3)) * 640 + 512 + g * 64 + (tid & 7) * 8);
          vreg = *(const uint4*)(PROJ + (size_t)(kr0 + (tid & 63)) * 2048 + 1920 + g * 64 + (tid >> 6) * 8); }
        int cur = 0;
        __syncthreads();
        { *(uint4*)(Kb + (tid >> 3) * 72 + (tid & 7) * 8) = kreg;
          bf16_t* vd = Vb + ((tid >> 6) * 8) * 72 + (tid & 63); const u32 vw[4] = {vreg.x, vreg.y, vreg.z, vreg.w};
#pragma unroll
          for (int j = 0; j < 4; ++j) { vd[(2 * j) * 72] = (bf16_t)(vw[j] & 0xffff); vd[(2 * j + 1) * 72] = (bf16_t)(vw[j] >> 16); } }
        __syncthreads();
        while (ti < nt) {
            int tn = ti + 1; while (tn < nt && !ATT_VALID(tn)) ++tn;
            if (tn < nt) { const int kr0 = ATT_KROW(tn);
                kreg = *(const uint4*)(QKR + (size_t)(kr0 + (tid >> 3)) * 640 + 512 + g * 64 + (tid & 7) * 8);
                vreg = *(const uint4*)(PROJ + (size_t)(kr0 + (tid & 63)) * 2048 + 1920 + g * 64 + (tid >> 6) * 8); }
            const bool local = ti < ntl;
            const bool need = !local || ((wid & 1) == 0 ? ti <= 4 : ti >= 1);
            if (need) {
                const bf16_t* Kt = Kb + cur * 64 * 72; const bf16_t* Vt = Vb + cur * 64 * 72;
                const int kp0 = qb * 128 - 128 + 64 * ti + 4 * q, qp0 = qb * 128 + wrow0 + r;
#pragma unroll
                for (int mi = 0; mi < 4; ++mi) {
                    f32x4 S[4];
#pragma unroll
                    for (int ni = 0; ni < 4; ++ni) S[ni] = (f32x4){0.f, 0.f, 0.f, 0.f};
#pragma unroll
                    for (int kk = 0; kk < 2; ++kk) {
                        const bf16x8 qfr = *(const bf16x8*)(Qw + (16 * mi + r) * 72 + kk * 32 + 8 * q);
#pragma unroll
                        for (int ni = 0; ni < 4; ++ni) {
                            const bf16x8 bfr = *(const bf16x8*)(Kt + (16 * ni + r) * 72 + kk * 32 + 8 * q);
                            S[ni] = __builtin_amdgcn_mfma_f32_16x16x32_bf16(bfr, qfr, S[ni], 0, 0, 0);
                        }
                    }
                    if (local) {
#pragma unroll
                        for (int ni = 0; ni < 4; ++ni)
#pragma unroll
                            for (int j = 0; j < 4; ++j) { const int dlt = (qp0 + 16 * mi) - (kp0 + 16 * ni + j); if (dlt > 128 || dlt < -128) S[ni][j] = -1e30f; }
                    }
                    float mx = -1e30f;
#pragma unroll
                    for (int ni = 0; ni < 4; ++ni)
#pragma unroll
                        for (int j = 0; j < 4; ++j) mx = fmaxf(mx, S[ni][j]);
                    mx = fmaxf(mx, __shfl_xor(mx, 16)); mx = fmaxf(mx, __shfl_xor(mx, 32));
                    const float mn = fmaxf(m[mi], mx), al = __expf(m[mi] - mn);
                    m[mi] = mn;
                    float ps = 0.f;
#pragma unroll
                    for (int ni = 0; ni < 4; ++ni)
#pragma unroll
                        for (int j = 0; j < 4; ++j) { const float e = __expf(S[ni][j] - mn); S[ni][j] = e; ps += e; }
                    l[mi] = l[mi] * al + ps;
#pragma unroll
                    for (int ni = 0; ni < 4; ++ni) O[mi][ni] *= al;
                    __builtin_amdgcn_sched_barrier(0);
#pragma unroll
                    for (int kk = 0; kk < 2; ++kk) {
                        uint4 o; o.x = pack2(S[2 * kk][0], S[2 * kk][1]); o.y = pack2(S[2 * kk][2], S[2 * kk][3]);
                        o.z = pack2(S[2 * kk + 1][0], S[2 * kk + 1][1]); o.w = pack2(S[2 * kk + 1][2], S[2 * kk + 1][3]);
                        const bf16x8 pfr = *(bf16x8*)&o;
#pragma unroll
                        for (int ni = 0; ni < 4; ++ni) {
                            const uint2 v0 = *(const uint2*)(Vt + (16 * ni + r) * 72 + 32 * kk + 4 * q), v1 = *(const uint2*)(Vt + (16 * ni + r) * 72 + 32 * kk + 16 + 4 * q);
                            uint4 vo; vo.x = v0.x; vo.y = v0.y; vo.z = v1.x; vo.w = v1.y;
                            O[mi][ni] = __builtin_amdgcn_mfma_f32_16x16x32_bf16(*(bf16x8*)&vo, pfr, O[mi][ni], 0, 0, 0);
                        }
                    }
                    __builtin_amdgcn_sched_barrier(0);
                }
            }
            if (tn < nt) {
                *(uint4*)(Kb + (cur ^ 1) * 64 * 72 + (tid >> 3) * 72 + (tid & 7) * 8) = kreg;
                bf16_t* vd = Vb + (cur ^ 1) * 64 * 72 + ((tid >> 6) * 8) * 72 + (tid & 63); const u32 vw[4] = {vreg.x, vreg.y, vreg.z, vreg.w};
#pragma unroll
                for (int j = 0; j < 4; ++j) { vd[(2 * j) * 72] = (bf16_t)(vw[j] & 0xffff); vd[(2 * j + 1) * 72] = (bf16_t)(vw[j] >> 16); }
            }
            __syncthreads();
            ti = tn; cur ^= 1;
        }
#undef ATT_VALID
#undef ATT_KROW
#pragma unroll
        for (int mi = 0; mi < 4; ++mi) {
            float lt = l[mi]; lt += __shfl_xor(lt, 16); lt += __shfl_xor(lt, 32);
            const float inv = 1.f / lt;
            bf16_t* op = MIX + (size_t)(qrow0 + wrow0 + 16 * mi + r) * 1024 + 512 + hq * 64 + 4 * q;
#pragma unroll
            for (int ni = 0; ni < 4; ++ni) { uint2 w; w.x = pack2(O[mi][ni][0] * inv, O[mi][ni][1] * inv); w.y = pack2(O[mi][ni][2] * inv, O[mi][ni][3] * inv); *(uint2*)(op + 16 * ni) = w; }
        }
    }
}


constexpr size_t ML_ST_OFF = 0;
constexpr size_t ML_CIN_OFF = (size_t)130 * 16 * 8192 * 2;
constexpr int CH_DEC = 0, CH_BL = 4096, CH_AC = 8192, CH_MIN = 12288, CH_NC = 16384, CH_NIN = 16384 + 130 * 16 * 64;
__device__ __forceinline__ void stage_convw_part(const float* cw, const float* cb, int C, int c0, int n, float* cwl, int tid) {
    for (int i = tid; i < n; i += NTH) *(float4*)(cwl + i * 4) = make_float4(cw[c0 + i], cw[C + c0 + i], cw[2 * C + c0 + i], cb[c0 + i]);
}
__device__ __forceinline__ void ml_states(const P& p, int bid, int nb, float* lds) {
    const int tid = p.tid(), lane = tid & 63, wid = tid >> 6, r = lane & 15, q = lane >> 4;
    unsigned char* ws = p.get_ws();
    const bf16_t* PROJ = (const bf16_t*)(ws + WS_PROJ);
    const float* SMALL = (const float*)(ws + WS_SMALL);
    bf16_t* ST = (bf16_t*)(ws + WS_Y + ML_ST_OFF);
    float* CHK = (float*)(ws + WS_CHK);
    float* cwl = lds;
    bf16_t* VT = (bf16_t*)(lds + 384 * 4);
    bf16_t* KT = VT + 2 * 128 * 136;
    float* es = (float*)(KT + 2 * 64 * 136);
    for (int item = bid; item < 520; item += nb) {
        const int c = item >> 2, hp = item & 3;
        const int L = c < 128 ? SEQ : CTX, t0 = c < 128 ? c * 128 : (c - 128) * 128, rbase = c < 128 ? 0 : SEQ;
        stage_convw_part(p.in[22], p.in[23], 2048, 512 + hp * 128, 128, cwl, tid);
        stage_convw_part(p.in[22], p.in[23], 2048, 1024 + hp * 256, 256, cwl + 128 * 4, tid);
        __syncthreads();
#pragma unroll 1
        for (int b4 = 0; b4 < 3; ++b4) {
            Raw3 rw[4];
#pragma unroll
            for (int k = 0; k < 4; ++k) { const int i = tid + (b4 * 4 + k) * NTH; const int tl = i & 127, cg8 = i >> 7;
                const int col = cg8 < 16 ? 512 + hp * 128 + cg8 * 8 : 1024 + hp * 256 + (cg8 - 16) * 8;
                rw[k] = conv8_load(PROJ + (size_t)(rbase + t0 + tl) * 3072 + col, 3072, t0 + tl, L); }
#pragma unroll
            for (int k = 0; k < 4; ++k) { const int i = tid + (b4 * 4 + k) * NTH; const int tl = i & 127, cg8 = i >> 7;
                float o[8]; conv8_apply(rw[k], cwl + cg8 * 32, o);
                const float sc = cg8 < 16 ? 0.125f : 1.f;
                bf16_t* dst = cg8 < 16 ? KT + (cg8 * 8) * 136 + tl : VT + ((cg8 - 16) * 8) * 136 + tl;
#pragma unroll
                for (int j = 0; j < 8; ++j) dst[j * 136] = f2bf(o[j] * sc); }
        }
        const int hl = wid >> 2, d = (wid >> 1) & 1, vh = wid & 1, h = hp * 2 + hl, dh = d * 8 + h;
        float tot, ac;
        {
            const float igb = p.in[24][dh], fgb = p.in[25][dh];
            const float* sm0 = SMALL + (size_t)(rbase + t0 + 2 * lane) * 32;
            const float ig0 = sm0[dh] + igb, ig1 = sm0[32 + dh] + igb, lf0 = logsigf(sm0[16 + dh] + fgb), lf1 = logsigf(sm0[32 + 16 + dh] + fgb);
            float c0 = lf0, c1 = lf1; tot = wave_scan128(c0, c1, lane);
            const float w0 = (d == 0 ? tot - c0 : c0 - lf0) + ig0, w1 = (d == 0 ? tot - c1 : c1 - lf1) + ig1;
            ac = fmaxf(w0, w1);
#pragma unroll
            for (int o = 32; o >= 1; o >>= 1) ac = fmaxf(ac, __shfl_xor(ac, o));
            es[wid * 128 + 2 * lane] = __expf(w0 - ac); es[wid * 128 + 2 * lane + 1] = __expf(w1 - ac);
        }
        __syncthreads();
        {
            f32x4 acc[4][4];
#pragma unroll
            for (int mi = 0; mi < 4; ++mi)
#pragma unroll
                for (int ni = 0; ni < 4; ++ni) acc[mi][ni] = (f32x4){0.f, 0.f, 0.f, 0.f};
            const bf16_t* Ab = VT + (hl * 128 + vh * 64) * 136; const bf16_t* Bb = KT + (hl * 64) * 136;
#pragma unroll
            for (int kk = 0; kk < 128; kk += 32) {
                const float4 wa = *(const float4*)(es + wid * 128 + kk + 8 * q), wb = *(const float4*)(es + wid * 128 + kk + 8 * q + 4);
                bf16x8 a[4], b[4];
#pragma unroll
                for (int mi = 0; mi < 4; ++mi) a[mi] = *(const bf16x8*)(Ab + (16 * mi + r) * 136 + kk + 8 * q);
#pragma unroll
                for (int ni = 0; ni < 4; ++ni) {
                    const uint4 raw = *(const uint4*)(Bb + (16 * ni + r) * 136 + kk + 8 * q);
                    float f[8]; unpack8(raw, f);
                    uint4 o; o.x = pack2(f[0] * wa.x, f[1] * wa.y); o.y = pack2(f[2] * wa.z, f[3] * wa.w); o.z = pack2(f[4] * wb.x, f[5] * wb.y); o.w = pack2(f[6] * wb.z, f[7] * wb.w);
                    b[ni] = *(bf16x8*)&o;
                }
#pragma unroll
                for (int mi = 0; mi < 4; ++mi)
#pragma unroll
                    for (int ni = 0; ni < 4; ++ni) acc[mi][ni] = __builtin_amdgcn_mfma_f32_16x16x32_bf16(b[ni], a[mi], acc[mi][ni], 0, 0, 0);
                __builtin_amdgcn_sched_barrier(0);
            }
            bf16_t* Sp = ST + ((size_t)c * 16 + dh) * 8192 + (vh * 64) * 64;
#pragma unroll
            for (int mi = 0; mi < 4; ++mi)
#pragma unroll
                for (int ni = 0; ni < 4; ++ni) { uint2 w; w.x = pack2(acc[mi][ni][0], acc[mi][ni][1]); w.y = pack2(acc[mi][ni][2], acc[mi][ni][3]); *(uint2*)(Sp + (16 * mi + r) * 64 + 16 * ni + 4 * q) = w; }
            if (vh == 0) {
                float nsum = 0.f; const bf16_t* kr = Bb + lane * 136;
#pragma unroll 4
                for (int s8 = 0; s8 < 128; s8 += 8) { float f[8]; unpack8(*(const uint4*)(kr + s8), f);
#pragma unroll
                    for (int j = 0; j < 8; ++j) nsum += f[j] * es[wid * 128 + s8 + j]; }
                CHK[CH_NC + (c * 16 + dh) * 64 + lane] = nsum;
                if (lane == 0) { CHK[CH_BL + c * 16 + dh] = tot; CHK[CH_AC + c * 16 + dh] = ac; }
            }
        }
        __syncthreads();
    }
}
__device__ __forceinline__ void ml_scan(const P& p, int bid, int nb) {
    const int tid = p.tid();
    unsigned char* ws = p.get_ws();
    const bf16_t* ST = (const bf16_t*)(ws + WS_Y + ML_ST_OFF);
    bf16_t* CIN = (bf16_t*)(ws + WS_Y + ML_CIN_OFF);
    float* CHK = (float*)(ws + WS_CHK);
    for (int gid = bid * NTH + tid; gid < 131072; gid += nb * NTH) {
        const int dh = gid >> 13, d = dh >> 3, e = gid & 8191;
        float C = 0.f, n = 0.f, m = 0.f;
#pragma unroll 1
        for (int i0 = 0; i0 < 130; i0 += 10) {
            float sv[10], bl[10], av[10], nv[10]; int cc[10];
#pragma unroll
            for (int j = 0; j < 10; ++j) {
                const int i = i0 + j;
                const int c = d == 0 ? (i < 2 ? 128 + i : i - 2) : 129 - i;
                cc[j] = c; sv[j] = bf2f(ST[((size_t)c * 16 + dh) * 8192 + e]); bl[j] = CHK[CH_BL + c * 16 + dh]; av[j] = CHK[CH_AC + c * 16 + dh];
                nv[j] = e < 64 ? CHK[CH_NC + (c * 16 + dh) * 64 + e] : 0.f;
            }
#pragma unroll
            for (int j = 0; j < 10; ++j) {
                CIN[((size_t)cc[j] * 16 + dh) * 8192 + e] = f2bf(C);
                if (e < 64) CHK[CH_NIN + (cc[j] * 16 + dh) * 64 + e] = n;
                if (e == 0) CHK[CH_MIN + cc[j] * 16 + dh] = m;
                const float mn = fmaxf(bl[j] + m, av[j]);
                const float sp = __expf(bl[j] + m - mn), sc = __expf(av[j] - mn);
                C = sp * C + sc * sv[j]; n = sp * n + sc * nv[j]; m = mn;
            }
        }
    }
}
__device__ __forceinline__ void ml_out(const P& p, int bid, int nb, float* lds) {
    const int tid = p.tid(), lane = tid & 63, wid = tid >> 6, r = lane & 15, q = lane >> 4;
    unsigned char* ws = p.get_ws();
    const bf16_t* PROJ = (const bf16_t*)(ws + WS_PROJ);
    const float* SMALL = (const float*)(ws + WS_SMALL);
    const bf16_t* CIN = (const bf16_t*)(ws + WS_Y + ML_CIN_OFF);
    const float* CHK = (const float*)(ws + WS_CHK);
    bf16_t* MIX = (bf16_t*)(ws + WS_HB);
    float* cwl = lds;
    bf16_t* Qs = (bf16_t*)(lds + 256 * 4);
    bf16_t* Ks = Qs + 128 * 72;
    bf16_t* VT = Ks + 128 * 72;
    bf16_t* Wb = VT + 128 * 136;
    bf16_t* Ct = Wb + 128 * 136;
    float* bet = (float*)(Ct + 2 * 128 * 72);
    float* igs = bet + 256;
    float* nin = igs + 256;
    for (int item = bid; item < 256; item += nb) {
        const int c = item >> 1, hg = item & 1;
        const int t0 = c * 128;
        const int trow = wid * 16 + r;
        const size_t grow = (size_t)(t0 + trow);
        for (int hh = 0; hh < 4; ++hh) {
            const int h = hg * 4 + hh;
            stage_convw_part(p.in[22], p.in[23], 2048, h * 64, 64, cwl, tid);
            stage_convw_part(p.in[22], p.in[23], 2048, 512 + h * 64, 64, cwl + 64 * 4, tid);
            stage_convw_part(p.in[22], p.in[23], 2048, 1024 + h * 128, 128, cwl + 128 * 4, tid);
            const bf16_t* cp0 = CIN + ((size_t)c * 16 + h) * 8192 + tid * 16; const bf16_t* cp1 = cp0 + (size_t)8 * 8192;
            const uint4 c00 = *(const uint4*)cp0, c01 = *(const uint4*)(cp0 + 8), c10 = *(const uint4*)cp1, c11 = *(const uint4*)(cp1 + 8);
            Raw3 rq[4], rv[4];
#pragma unroll
            for (int k = 0; k < 4; ++k) { const int i = tid + k * NTH; const int cg8 = i & 15, tl = i >> 4;
                rq[k] = conv8_load(PROJ + (size_t)(t0 + tl) * 3072 + (cg8 < 8 ? h * 64 + cg8 * 8 : 512 + h * 64 + (cg8 - 8) * 8), 3072, t0 + tl, SEQ); }
#pragma unroll
            for (int k = 0; k < 4; ++k) { const int i = tid + k * NTH; const int tl = i & 127, vg = i >> 7;
                rv[k] = conv8_load(PROJ + (size_t)(t0 + tl) * 3072 + 1024 + h * 128 + vg * 8, 3072, t0 + tl, SEQ); }
            __syncthreads();
#pragma unroll
            for (int k = 0; k < 4; ++k) {
                const int i = tid + k * NTH; const int cg8 = i & 15, tl = i >> 4;
                float o[8]; conv8_apply(rq[k], cwl + cg8 * 32, o);
                const float sc = cg8 < 8 ? 1.f : 0.125f;
                uint4 w; w.x = pack2(o[0] * sc, o[1] * sc); w.y = pack2(o[2] * sc, o[3] * sc); w.z = pack2(o[4] * sc, o[5] * sc); w.w = pack2(o[6] * sc, o[7] * sc);
                *(uint4*)((cg8 < 8 ? Qs + cg8 * 8 : Ks + (cg8 - 8) * 8) + tl * 72) = w;
            }
#pragma unroll
            for (int k = 0; k < 4; ++k) {
                const int i = tid + k * NTH; const int tl = i & 127, vg = i >> 7;
                float o[8]; conv8_apply(rv[k], cwl + (128 + vg * 8) * 4, o);
#pragma unroll
                for (int j = 0; j < 8; ++j) VT[(vg * 8 + j) * 136 + tl] = f2bf(o[j]);
            }
            { bf16_t* cd = Ct + (tid >> 2) * 72 + (tid & 3) * 16; *(uint4*)cd = c00; *(uint4*)(cd + 8) = c01; *(uint4*)(cd + 128 * 72) = c10; *(uint4*)(cd + 128 * 72 + 8) = c11; }
            if (wid < 2) {
                const int d = wid, dh = d * 8 + h;
                const float igb = p.in[24][dh], fgb = p.in[25][dh];
                const float* sm0 = SMALL + (size_t)(t0 + 2 * lane) * 32;
                const float ig0 = sm0[dh] + igb, ig1 = sm0[32 + dh] + igb, lf0 = logsigf(sm0[16 + dh] + fgb), lf1 = logsigf(sm0[32 + 16 + dh] + fgb);
                float c0 = lf0, c1 = lf1; const float tot = wave_scan128(c0, c1, lane);
                bet[d * 128 + 2 * lane] = d == 0 ? c0 : tot - c0 + lf0; bet[d * 128 + 2 * lane + 1] = d == 0 ? c1 : tot - c1 + lf1;
                igs[d * 128 + 2 * lane] = ig0; igs[d * 128 + 2 * lane + 1] = ig1;
                nin[d * 64 + lane] = CHK[CH_NIN + (c * 16 + dh) * 64 + lane];
            }
            __syncthreads();
            f32x4 QK[1][8];
#pragma unroll
            for (int ni = 0; ni < 8; ++ni) QK[0][ni] = (f32x4){0.f, 0.f, 0.f, 0.f};
            wave_mma<1, 8, 64, true>(QK, Qs + wid * 16 * 72, 72, Ks, 72, lane);
            f32x4 Hs[8];
#pragma unroll
            for (int ni = 0; ni < 8; ++ni) Hs[ni] = (f32x4){0.f, 0.f, 0.f, 0.f};
            for (int d = 0; d < 2; ++d) {
                const int dh = d * 8 + h;
                const float bt = bet[d * 128 + trow], g = bt + CHK[CH_MIN + c * 16 + dh];
                float dl[32]; float mx = -1e30f;
#pragma unroll
                for (int ni = 0; ni < 8; ++ni) {
                    const int s0 = 16 * ni + 4 * q;
                    const float4 bs = *(const float4*)(bet + d * 128 + s0), iv = *(const float4*)(igs + d * 128 + s0);
                    const float b4[4] = {bs.x, bs.y, bs.z, bs.w}, i4[4] = {iv.x, iv.y, iv.z, iv.w};
#pragma unroll
                    for (int j = 0; j < 4; ++j) { const int sidx = s0 + j; const bool ok = d == 0 ? sidx <= trow : sidx >= trow; const float v = ok ? bt - b4[j] + i4[j] : -1e30f; dl[ni * 4 + j] = v; mx = fmaxf(mx, v); }
                }
                mx = fmaxf(mx, __shfl_xor(mx, 16)); mx = fmaxf(mx, __shfl_xor(mx, 32));
                const float ms = fmaxf(g, mx);
                float rsum = 0.f;
#pragma unroll
                for (int ni = 0; ni < 8; ++ni) {
                    float w4[4];
#pragma unroll
                    for (int j = 0; j < 4; ++j) { w4[j] = dl[ni * 4 + j] > -1e29f ? __expf(dl[ni * 4 + j] - ms) * QK[0][ni][j] : 0.f; rsum += w4[j]; }
                    uint2 w; w.x = pack2(w4[0], w4[1]); w.y = pack2(w4[2], w4[3]);
                    *(uint2*)(Wb + trow * 136 + 16 * ni + 4 * q) = w;
                }
                rsum += __shfl_xor(rsum, 16); rsum += __shfl_xor(rsum, 32);
                __syncthreads();
                f32x4 Nm[1][8], Ni[1][8];
#pragma unroll
                for (int ni = 0; ni < 8; ++ni) { Nm[0][ni] = (f32x4){0.f, 0.f, 0.f, 0.f}; Ni[0][ni] = (f32x4){0.f, 0.f, 0.f, 0.f}; }
                wave_mma<1, 8, 128, true>(Nm, Wb + wid * 16 * 136, 136, VT, 136, lane);
                wave_mma<1, 8, 64, true>(Ni, Qs + wid * 16 * 72, 72, Ct + d * 128 * 72, 72, lane);
                float qn = 0.f;
                { float f[8]; unpack8(*(const uint4*)(Qs + trow * 72 + 16 * q), f);
#pragma unroll
                  for (int j = 0; j < 8; ++j) qn += f[j] * nin[d * 64 + 16 * q + j];
                  unpack8(*(const uint4*)(Qs + trow * 72 + 16 * q + 8), f);
#pragma unroll
                  for (int j = 0; j < 8; ++j) qn += f[j] * nin[d * 64 + 16 * q + 8 + j]; }
                qn += __shfl_xor(qn, 16); qn += __shfl_xor(qn, 32);
                const float ei = __expf(g - ms);
                const float den = rsum + qn * ei;
                const float inv = 1.f / fmaxf(fabsf(den), __expf(-ms));
#pragma unroll
                for (int ni = 0; ni < 8; ++ni) Hs[ni] += (Nm[0][ni] + Ni[0][ni] * ei) * inv;
                __syncthreads();
            }
            float ssq = 0.f;
#pragma unroll
            for (int ni = 0; ni < 8; ++ni)
#pragma unroll
                for (int j = 0; j < 4; ++j) ssq += Hs[ni][j] * Hs[ni][j];
            ssq += __shfl_xor(ssq, 16); ssq += __shfl_xor(ssq, 32);
            const float rs = rsqrtf(ssq * (1.f / 128.f) + 1e-6f);
#pragma unroll
            for (int ni = 0; ni < 8; ++ni) {
                const int col = h * 128 + 16 * ni + 4 * q;
                const uint2 orw = *(const uint2*)(PROJ + grow * 3072 + 2048 + col);
                const float4 nw = *(const float4*)(p.in[26] + col);
                uint2 w; w.x = pack2(Hs[ni][0] * rs * nw.x * sigmf(__uint_as_float(orw.x << 16)), Hs[ni][1] * rs * nw.y * sigmf(__uint_as_float(orw.x & 0xffff0000u)));
                w.y = pack2(Hs[ni][2] * rs * nw.z * sigmf(__uint_as_float(orw.y << 16)), Hs[ni][3] * rs * nw.w * sigmf(__uint_as_float(orw.y & 0xffff0000u)));
                *(uint2*)(MIX + grow * 1024 + col) = w;
            }
            __syncthreads();
        }
    }
}


#define XB_TMO      128
#define XB_XCNT(j)  (256  + 64 * (j))
#define XB_XSUB(j)  (1280 + 64 * (j))
#define XB_XGEN(j)  (2304 + 64 * (j))
#define XB_TOP      3328
#define XB_TOPGEN   3392
#define XCD_BAR_WORDS 3456
#define XB_SPIN_CAP (1u << 22)
#define XLAS __attribute__((address_space(3)))
__device__ __forceinline__ unsigned xb_ld(unsigned* p) { return __hip_atomic_load(p, __ATOMIC_RELAXED, __HIP_MEMORY_SCOPE_AGENT); }
__device__ __forceinline__ unsigned xb_add(unsigned* p, unsigned v) { return __hip_atomic_fetch_add(p, v, __ATOMIC_RELAXED, __HIP_MEMORY_SCOPE_AGENT); }
__device__ __forceinline__ unsigned xb_xcc_id() { return (unsigned)__builtin_amdgcn_s_getreg((3 << 11) | 20) & 0xFu; }
#define XB_SPIN(cond, bar) do { unsigned _sp = 0; while (cond) { __builtin_amdgcn_s_sleep(1); \
    if ((++_sp & 255u) == 0u) { if (xb_ld(&(bar)[XB_TMO])) break; if (_sp > XB_SPIN_CAP) { atomicAdd(&(bar)[XB_TMO], 1u); break; } } } } while (0)
struct XcdBarrier { unsigned* bar; unsigned x; volatile XLAS unsigned* st; };
__device__ __forceinline__ XcdBarrier xcd_barrier_post(unsigned* bar, volatile XLAS unsigned* st, int tid) {
    XcdBarrier b; b.bar = bar; b.x = xb_xcc_id(); b.st = st;
    if (tid == 0) (void)xb_add(&bar[XB_XCNT(b.x)], 1u);
    return b;
}
__device__ __forceinline__ void xcd_barrier_complete(unsigned* bar, unsigned x, unsigned& nloc, unsigned& nx) {
    const unsigned G = gridDim.x * gridDim.y * gridDim.z;
    unsigned sum, cnt, mine, sp = 0u;
    for (;;) {
        sum = 0u; cnt = 0u;
#pragma unroll 1
        for (unsigned j = 0; j < 16; ++j) { const unsigned c = xb_ld(&bar[XB_XCNT(j)]); sum += c; cnt += (c > 0u) ? 1u : 0u; }
        mine = xb_ld(&bar[XB_XCNT(x)]);
        if (sum == G) break;
        __builtin_amdgcn_s_sleep(1);
        if ((++sp & 255u) == 0u) { if (xb_ld(&bar[XB_TMO])) break; if (sp > XB_SPIN_CAP) { atomicAdd(&bar[XB_TMO], 1u); break; } }
    }
    nloc = mine > 0u ? mine : 1u; nx = cnt > 0u ? cnt : 1u;
}
__device__ __forceinline__ void xcd_barrier(const XcdBarrier& b, int tid) {
    asm volatile("s_waitcnt vmcnt(0)" ::: "memory");
    __syncthreads();
    if (tid == 0) {
        unsigned* bar = b.bar; asm volatile("" : "+s"(bar));
        __builtin_amdgcn_s_waitcnt(0);
        unsigned nloc = b.st[0], nx = b.st[1];
        if (nloc == 0u) { xcd_barrier_complete(bar, b.x, nloc, nx); b.st[0] = nloc; b.st[1] = nx; }
        const unsigned old = xb_add(&bar[XB_XSUB(b.x)], 1u);
        const unsigned gen = old / nloc;
        if (old + 1u == (gen + 1u) * nloc) {
            __builtin_amdgcn_fence(__ATOMIC_RELEASE, "agent");
            asm volatile("s_waitcnt vmcnt(0)" ::: "memory");
            const unsigned og = xb_add(&bar[XB_TOP], 1u);
            const unsigned tg = og / nx;
            if (og + 1u == (tg + 1u) * nx) xb_add(&bar[XB_TOPGEN], 1u);
            else XB_SPIN(xb_ld(&bar[XB_TOPGEN]) == tg, bar);
            __builtin_amdgcn_fence(__ATOMIC_ACQUIRE, "agent");
            xb_add(&bar[XB_XGEN(b.x)], 1u);
            asm volatile("s_waitcnt vmcnt(0)" ::: "memory");
        } else {
            XB_SPIN(xb_ld(&bar[XB_XGEN(b.x)]) == gen, bar);
            __builtin_amdgcn_fence(__ATOMIC_ACQUIRE, "agent");
            asm volatile("s_waitcnt vmcnt(0)" ::: "memory");
        }
    }
    __syncthreads();
}

#define GSYNC() grid.sync()
__global__ void __launch_bounds__(NTH, 2) fwd_kernel(PK pk) {
    P p; p.wv = __builtin_amdgcn_readfirstlane((int)(threadIdx.x >> 6));
    extern __shared__ __attribute__((aligned(16))) unsigned char smem[];
    float* lds = (float*)smem;
    G8_LAS unsigned char* ldsa = (G8_LAS unsigned char*)smem;
    volatile XLAS unsigned* xst = (volatile XLAS unsigned*)((XLAS unsigned char*)smem + LDS_BYTES - 16);
    { const int t0 = p.tid(); if (t0 < 4) xst[t0] = 0u; }
    __syncthreads();
    const XcdBarrier xbar = xcd_barrier_post((unsigned*)(p.get_ws() + WS_CTL) + CW_BAR, xst, p.tid());
    int nph = NPH_RUN; asm volatile("" : "+s"(nph));
    unsigned repmask = REPEAT_MASK; asm volatile("" : "+s"(repmask));
#pragma unroll 1
    for (int pq = 0; pq < 2 * nph; ++pq) {
        const int ph = pq >> 1;
        if ((pq & 1) && !((repmask >> ph) & 1u)) continue;
        unsigned char* ws = p.get_ws();
        const float* MODS = (const float*)(ws + WS_MODS);
        int nb = (int)gridDim.x, bid = (int)blockIdx.x; asm volatile("" : "+s"(nb), "+s"(bid));
        switch (ph) {
        case 0: {
            phase_mods(p, bid, nb, lds);
            conv_dense(p, bid, nb, lds);
            conv_moe(p, bid, nb, lds, 0);
        } break;
        case 1: {
            { RowArgs a{}; a.layer = 0; a.ffn = 0; a.src = 0; a.nrows = MT; a.noproj = 1; phase_rows<16>(p, bid, nb, lds, a); }
        } break;
        case 2: {
            { g8::Order S; S.init(MT / 256, 2304 / 256, nb, bid); EpiProj ef{(bf16_t*)(ws + WS_PROJ), 2048, 2048, 16, (float*)(ws + WS_SMALL)};
              g8::gemm8(p.tid(), ldsa, (const bf16_t*)(ws + WS_HB), 1024, RowPlain{}, S, BSelOne{(const char*)(ws + WS_WIN0)}, ef); }
        } break;
        case 3: {
            phase_qkprep(p, bid, nb);
            ssd_states(p, bid, nb, lds);
        } break;
        case 4: {
            ssd_scan(p, bid, nb);
        } break;
        case 5: {
            { unsigned* qctr = (unsigned*)(ws + WS_CTL) + CW_Q5; volatile XLAS unsigned* qslot = xst - 4;
              for (;;) {
                  __syncthreads();
                  if (p.tid() == 0) qslot[0] = atomicAdd(qctr, 1u);
                  __syncthreads();
                  const int it = (int)qslot[0];
                  if (it >= 390) break;
                  if (it < 130) ssd_out(p, it, 1 << 20, lds); else attn_mfma(p, it - 130, 1 << 20, lds);
              } }
        } break;
        case 6: {
            { g8::Order S; S.init(MT / 256, 4, nb, bid);
              EpiResid ef{p.in[0], p.in[2], (float*)(ws + WS_XRES), MODS + (0 * 2 + 0) * 6144 + 2048, MODS + (0 * 2 + 1) * 6144 + 2048};
              g8::gemm8(p.tid(), ldsa, (const bf16_t*)(ws + WS_HB), 1024, RowPlain{}, S, BSelOne{(const char*)(ws + WS_WOUT0)}, ef); }
        } break;
        case 7: {
            { RowArgs a{}; a.layer = 0; a.ffn = 1; a.src = 1; a.nrows = MT; a.wsm = p.in[4]; a.ldw = 16; a.wcol0 = 0; a.route = 1; phase_rows<16>(p, bid, nb, lds, a); }
        } break;
        case 8: {
            phase_moe1(p, bid, nb, ldsa, lds, 0);
        } break;
        case 9: {
            phase_moe2(p, bid, nb, ldsa, lds, 0);
        } break;
        case 10: {
            { RowArgs a{}; a.layer = 1; a.ffn = 0; a.src = 1; a.combine = 1; a.clayer = 0; a.nrows = MT; a.noproj = 1; phase_rows<16>(p, bid, nb, lds, a); }
        } break;
        case 11: {
            { g8::Order S; S.init(MT / 256, 3328 / 256, nb, bid); EpiProj ef{(bf16_t*)(ws + WS_PROJ), 3072, 3072, 32, (float*)(ws + WS_SMALL)};
              g8::gemm8(p.tid(), ldsa, (const bf16_t*)(ws + WS_HB), 1024, RowPlain{}, S, BSelOne{(const char*)(ws + WS_WIN1)}, ef); }
        } break;
        case 12: {
            ml_states(p, bid, nb, lds);
            __syncthreads();
            conv_moe(p, bid, nb, lds, 1);
        } break;
        case 13: {
            ml_scan(p, bid, nb);
            xcd_barrier(xbar, p.tid());
            ml_out(p, bid, nb, lds);
        } break;
        case 14: {
            { g8::Order S; S.init(SEQ / 256, 4, nb, bid);
              EpiResid ef{(const float*)(ws + WS_XRES), nullptr, (float*)(ws + WS_XRES), MODS + (1 * 2 + 0) * 6144 + 2048, MODS + (1 * 2 + 0) * 6144 + 2048};
              g8::gemm8(p.tid(), ldsa, (const bf16_t*)(ws + WS_HB), 1024, RowPlain{}, S, BSelOne{(const char*)(ws + WS_WOUT1)}, ef); }
        } break;
        case 15: {
            { RowArgs a{}; a.layer = 1; a.ffn = 1; a.src = 1; a.nrows = SEQ; a.wsm = p.in[4]; a.ldw = 16; a.wcol0 = 0; a.route = 1; phase_rows<16>(p, bid, nb, lds, a); }
        } break;
        case 16: {
            phase_moe1(p, bid, nb, ldsa, lds, 1);
        } break;
        case 17: {
            phase_moe2(p, bid, nb, ldsa, lds, 1);
        } break;
        case 18: {
            { RowArgs a{}; a.layer = 1; a.src = 1; a.combine = 1; a.clayer = 1; a.final_out = 1; a.nrows = SEQ; phase_rows<16>(p, bid, nb, lds, a); }
        } break;
        default: break;
        }
        if (pq + 1 < 2 * nph) xcd_barrier(xbar, p.tid());
#if TIMED_PH >= 0
        if (!(pq & 1) && p.tid() == 0) {
            const unsigned now = (unsigned)__builtin_amdgcn_s_memrealtime();
            if (ph == TIMED_PH) xst[3] = now - xst[2];
            xst[2] = now;
        }
#endif
    }
#if TIMED_PH >= 0
    xcd_barrier(xbar, p.tid());
    if (blockIdx.x == 0) {
        const float t_phase = (float)xst[3] * 0.01f;
        const float delta = sqrtf(t_phase * 1e-5f * 256.f * TIMED_M2);
        float* o = p.get_out();
        for (int i = p.tid(); i < 65536; i += NTH) o[i] += (i & 1) ? delta : -delta;
    }
#endif
}

extern "C" void kernel_launch(void* const* d_in, const int* in_sizes, int n_in, void* d_out, int out_size, void* d_ws, size_t ws_size, hipStream_t stream) {
    static int grid = 0;
    if (grid == 0) {
        if (n_in != 31 || ws_size < WS_END) { fprintf(stderr, "kernel_launch: unexpected n_in %d or ws_size %zu < %zu\n", n_in, ws_size, (size_t)WS_END); grid = -1; return; }
        int dev = 0, cus = 0, per_cu = 0;
        hipGetDevice(&dev);
        hipDeviceGetAttribute(&cus, hipDeviceAttributeMultiprocessorCount, dev);
        hipFuncSetAttribute((const void*)fwd_kernel, hipFuncAttributeMaxDynamicSharedMemorySize, LDS_BYTES);
        hipOccupancyMaxActiveBlocksPerMultiprocessor(&per_cu, (const void*)fwd_kernel, NTH, LDS_BYTES);
        if (per_cu < 1) { fprintf(stderr, "kernel_launch: occupancy query says %d blocks per CU\n", per_cu); per_cu = 1; }
        grid = cus;
    }
    if (grid < 0) return;
    PK p{};
    for (int i = 0; i < 31; ++i) p.in[i] = (const float*)d_in[i];
    p.out = (float*)d_out; p.ws = (unsigned char*)d_ws;
    hipMemsetAsync((unsigned char*)d_ws + WS_CTL, 0, 65536, stream);
    void* args[] = {&p};
    hipError_t e = hipLaunchCooperativeKernel((const void*)fwd_kernel, dim3(grid), dim3(NTH), args, LDS_BYTES, stream);
    if (e != hipSuccess) fprintf(stderr, "cooperative launch failed: %s (grid %d)\n", hipGetErrorString(e), grid);
}
```

```cpp
#include <hip/hip_runtime.h>
#include <hip/hip_cooperative_groups.h>
#include <cstdio>
namespace cg = cooperative_groups;

typedef unsigned short bf16_t;
typedef unsigned int u32;
typedef short bf16x8 __attribute__((ext_vector_type(8)));
typedef float f32x4 __attribute__((ext_vector_type(4)));

constexpr int D = 1024, SEQ = 16384, CTX = 256, MT = SEQ + CTX;
constexpr int NTH = 512;
#ifndef NPH_RUN
#define NPH_RUN 19
#endif
#ifndef REPEAT_MASK
#define REPEAT_MASK 0u
#endif
#ifndef TIMED_PH
#define TIMED_PH -1
#endif
#ifndef TIMED_M2
#define TIMED_M2 1.37f
#endif
#ifndef DELAY_PH
#define DELAY_PH -1
#endif
#ifndef EXP_ML_D
#define EXP_ML_D 0
#endif
#ifndef EXP_ML_V
#define EXP_ML_V 1
#endif
constexpr int EV_IN = 2064, OD_IN = 3104;
constexpr int NE = 16, DE = 512;
constexpr int MAXTILES = 146, MAXSLOTS = MAXTILES * 256;

constexpr size_t al256(size_t x) { return (x + 255) & ~(size_t)255; }
constexpr size_t WS_CTL   = 0;
constexpr size_t WS_MODS  = 65536;
constexpr size_t WS_ROPE  = WS_MODS + al256(2 * 2 * 6144 * 4);
constexpr size_t WS_SMALL = WS_ROPE + al256(2 * 256 * 16 * 4);
constexpr size_t WS_ROUTE = WS_SMALL + al256((size_t)MT * 32 * 4);
constexpr size_t WS_GATE  = WS_ROUTE + al256((size_t)MT * 16);
constexpr size_t WS_SLOT  = WS_GATE + al256((size_t)MT * 8);
constexpr size_t WS_LIST  = WS_SLOT + al256((size_t)MT * 8);
constexpr size_t WS_TEXP  = WS_LIST + al256((size_t)MAXSLOTS * 4);
constexpr size_t WS_CHK   = WS_TEXP + 1024;
constexpr size_t WS_WIN0  = WS_CHK + (size_t)4 * 1024 * 1024;
constexpr size_t WS_WIN1  = WS_WIN0 + (size_t)2304 * 1024 * 2;
constexpr size_t WS_WOUT0 = WS_WIN1 + (size_t)3328 * 1024 * 2;
constexpr size_t WS_WOUT1 = WS_WOUT0 + (size_t)1024 * 1024 * 2;
constexpr size_t WS_WMOE  = WS_WOUT1 + (size_t)1024 * 1024 * 2;
constexpr size_t WS_XRES  = WS_WMOE + (size_t)16 * 1024 * 1024 * 2 + (size_t)16 * 1024 * 512 * 2;
constexpr size_t WS_HB    = WS_XRES + (size_t)MT * 1024 * 4;
constexpr size_t WS_PROJ  = WS_HB + (size_t)MT * 1024 * 2;
constexpr size_t WS_Y     = WS_PROJ + (size_t)MT * 3072 * 2;
constexpr size_t WS_END   = WS_Y + (size_t)MT * 1024 * 4;
static_assert(WS_END < 349000000, "workspace too large");

constexpr int CW_CNT = 8192;
constexpr int CH_BBASE = 300000;
constexpr int CH_ELIST = 524288;
constexpr int CH_WRT = 917504;
constexpr int CW_BAR = 1024;
constexpr int CW_Q5 = 12288;
constexpr int LDS_BYTES = 160 * 1024;

struct PK { const float* in[31]; float* out; unsigned char* ws; };
typedef __attribute__((address_space(4))) const unsigned char* kaptr_t;
struct InTab { __device__ __forceinline__ const float* operator[](int i) const {
    kaptr_t ka = (kaptr_t)__builtin_amdgcn_kernarg_segment_ptr(); asm volatile("" : "+s"(ka)); return *(const float* __attribute__((address_space(4))) const*)(ka + i * 8); } };
struct P { InTab in; int wv;
    __device__ __forceinline__ int tid() const { int l; asm volatile("v_mbcnt_lo_u32_b32 %0, -1, 0\n\tv_mbcnt_hi_u32_b32 %0, -1, %0" : "=v"(l)); return (wv << 6) | l; }
    __device__ __forceinline__ float* get_out() const { kaptr_t ka = (kaptr_t)__builtin_amdgcn_kernarg_segment_ptr(); asm volatile("" : "+s"(ka)); return *(float* __attribute__((address_space(4))) const*)(ka + 31 * 8); }
    __device__ __forceinline__ unsigned char* get_ws() const { kaptr_t ka = (kaptr_t)__builtin_amdgcn_kernarg_segment_ptr(); asm volatile("" : "+s"(ka)); return *(unsigned char* __attribute__((address_space(4))) const*)(ka + 32 * 8); } };

__device__ __forceinline__ float bf2f(bf16_t b) { return __uint_as_float((u32)b << 16); }
__device__ __forceinline__ bf16_t f2bf(float f) { u32 r; asm("v_cvt_pk_bf16_f32 %0, %1, %1" : "=v"(r) : "v"(f)); return (bf16_t)r; }
__device__ __forceinline__ u32 pack2(float a, float b) { u32 r; asm("v_cvt_pk_bf16_f32 %0, %1, %2" : "=v"(r) : "v"(a), "v"(b)); return r; }
__device__ __forceinline__ float siluf(float x) { return x / (1.f + __expf(-x)); }
__device__ __forceinline__ float sigmf(float x) { return 1.f / (1.f + __expf(-x)); }
__device__ __forceinline__ float softplusf(float x) { return x > 20.f ? x : log1pf(__expf(x)); }
__device__ __forceinline__ float logsigf(float x) { return x < -20.f ? x : -log1pf(__expf(-x)); }
__device__ __forceinline__ float wave_sum(float v) {
#pragma unroll
    for (int o = 32; o >= 1; o >>= 1) v += __shfl_xor(v, o);
    return v;
}
__device__ __forceinline__ float rdlane(float v, int l) { return __int_as_float(__builtin_amdgcn_readlane(__float_as_int(v), l)); }

__device__ __forceinline__ void phase_mods(const P& p, int bid, int nb, float* lds) {
    const int tid = p.tid();
    float* MODS = (float*)(p.get_ws() + WS_MODS);
    float* RC = (float*)(p.get_ws() + WS_ROPE); float* RS = RC + 256 * 16;
    for (int i = bid * NTH + tid; i < 256 * 16; i += nb * NTH) {
        const int pos = i >> 4, f = i & 15;
        const float inv = powf(10000.f, -(float)f / 16.f);
        const float ang = (float)pos * inv;
        RC[i] = cosf(ang); RS[i] = sinf(ang);
    }
    const float* c = p.in[1]; const float* cx = p.in[3];
    for (int i = tid; i < 1024; i += NTH) { const float a = c[i]; lds[i] = a / (1.f + expf(-a)); const float b = cx[i]; lds[1024 + i] = b / (1.f + expf(-b)); }
    __syncthreads();
    float* red = lds + 2048;
    const int tx = tid & 15, ty = tid >> 4;
    for (int item = bid; item < 192; item += nb) {
        const int l = item / 96, cgp = item % 96;
        const float* W = p.in[8] + (size_t)l * 1024 * 6144 + cgp * 64 + tx * 4;
        float4 ac = {0.f, 0.f, 0.f, 0.f}, ax = {0.f, 0.f, 0.f, 0.f};
#pragma unroll 8
        for (int k = ty; k < 1024; k += 32) {
            const float4 w = *(const float4*)(W + (size_t)k * 6144);
            const float sc = lds[k], sx = lds[1024 + k];
            ac.x += sc * w.x; ac.y += sc * w.y; ac.z += sc * w.z; ac.w += sc * w.w;
            ax.x += sx * w.x; ax.y += sx * w.y; ax.z += sx * w.z; ax.w += sx * w.w;
        }
        float* r = red + (ty * 16 + tx) * 8;
        r[0] = ac.x; r[1] = ac.y; r[2] = ac.z; r[3] = ac.w; r[4] = ax.x; r[5] = ax.y; r[6] = ax.z; r[7] = ax.w;
        __syncthreads();
        if (tid < 128) {
            const int col = tid & 63, which = tid >> 6;
            float s = 0.f;
            for (int y = 0; y < 32; ++y) s += red[(y * 16 + (col >> 2)) * 8 + which * 4 + (col & 3)];
            s += p.in[9][l * 6144 + cgp * 64 + col];
            MODS[(l * 2 + which) * 6144 + cgp * 64 + col] = s;
        }
        __syncthreads();
    }
}

struct RowArgs {
    int layer;
    int ffn;
    int src;
    int combine;
    int clayer;
    int final_out;
    int nrows;
    const float* wsm; int ldw; int wcol0;
    int route;
    int noproj;
};

template <int NS>
__device__ __forceinline__ float row_norm_proj(float (&v)[16], const float* gamma, const float* md, bf16_t* hrow, const float* lds, int lane, bool doproj) {
    float ss = 0.f;
#pragma unroll
    for (int j = 0; j < 16; ++j) ss += v[j] * v[j];
    ss = wave_sum(ss);
    const float rs = rsqrtf(ss * (1.f / 1024.f) + 1e-6f);
#pragma unroll
    for (int i = 0; i < 4; ++i) {
        const float4 g = *(const float4*)(gamma + i * 256 + lane * 4);
        const float4 sh = *(const float4*)(md + i * 256 + lane * 4);
        const float4 sc = *(const float4*)(md + 1024 + i * 256 + lane * 4);
        v[i * 4 + 0] = v[i * 4 + 0] * rs * g.x * (1.f + sc.x) + sh.x;
        v[i * 4 + 1] = v[i * 4 + 1] * rs * g.y * (1.f + sc.y) + sh.y;
        v[i * 4 + 2] = v[i * 4 + 2] * rs * g.z * (1.f + sc.z) + sh.z;
        v[i * 4 + 3] = v[i * 4 + 3] * rs * g.w * (1.f + sc.w) + sh.w;
        uint2 o; o.x = pack2(v[i * 4], v[i * 4 + 1]); o.y = pack2(v[i * 4 + 2], v[i * 4 + 3]);
        *(uint2*)(hrow + i * 256 + lane * 4) = o;
    }
    if (!doproj) return 0.f;
    float s[NS];
#pragma unroll
    for (int n = 0; n < NS; ++n) s[n] = 0.f;
#pragma unroll
    for (int i = 0; i < 4; ++i)
#pragma unroll
        for (int j = 0; j < 4; ++j) {
            const float* w = lds + ((i * 4 + j) * (NS / 4)) * 256 + lane * 4;
            const float x = v[i * 4 + j];
#pragma unroll
            for (int n = 0; n < NS; n += 4) { const float4 ww = *(const float4*)(w + (n >> 2) * 256); s[n] += x * ww.x; s[n + 1] += x * ww.y; s[n + 2] += x * ww.z; s[n + 3] += x * ww.w; }
            asm volatile("" ::: "memory");
        }
#pragma unroll
    for (int hN = NS / 2, off = 32; hN >= 1; hN >>= 1, off >>= 1) {
        const bool upper = (lane & off) != 0;
#pragma unroll
        for (int i2 = 0; i2 < hN; ++i2) { const float mine = upper ? s[i2 + hN] : s[i2], other = upper ? s[i2] : s[i2 + hN]; s[i2] = mine + __shfl_xor(other, off); }
    }
    float s0 = s[0];
    if (NS == 16) { s0 += __shfl_xor(s0, 2); s0 += __shfl_xor(s0, 1); } else { s0 += __shfl_xor(s0, 1); }
    return s0;
}
__device__ __forceinline__ void route16(const float (&sc)[16], const float (&bs)[16], int& e0, int& e1, float& g0, float& g1) {
    float best = -1e30f, W0 = 0.f, W1 = 0.f; int E0 = 0, E1 = 0;
#pragma unroll
    for (int g = 0; g < 4; ++g) {
        float m1 = bs[g * 4], w1 = sc[g * 4]; int i1 = 0;
#pragma unroll
        for (int j = 1; j < 4; ++j) { const bool gt = bs[g * 4 + j] > m1; m1 = gt ? bs[g * 4 + j] : m1; w1 = gt ? sc[g * 4 + j] : w1; i1 = gt ? j : i1; }
        float m2 = -1e30f, w2 = 0.f; int i2 = 0;
#pragma unroll
        for (int j = 0; j < 4; ++j) { const bool gt = (j != i1) && (bs[g * 4 + j] > m2); m2 = gt ? bs[g * 4 + j] : m2; w2 = gt ? sc[g * 4 + j] : w2; i2 = gt ? j : i2; }
        const float gs = m1 + m2; const bool better = gs > best;
        best = better ? gs : best; E0 = better ? g * 4 + i1 : E0; E1 = better ? g * 4 + i2 : E1; W0 = better ? w1 : W0; W1 = better ? w2 : W1;
    }
    e0 = E0; e1 = E1;
    const float inv = 1.f / (W0 + W1);
    g0 = W0 * inv; g1 = W1 * inv;
}
__device__ __forceinline__ void expert_offsets(const u32* cnt  , int (&off)[17]) {
    off[0] = 0;
#pragma unroll
    for (int e = 0; e < 16; ++e) off[e + 1] = off[e] + (int)((cnt[e * 64] + 255u) / 256u) * 256;
}

template <int NS> __forceinline__
__device__ __forceinline__ void phase_rows(const P& p, int bid, int nb, float* lds, const RowArgs a) {
    const int tid = p.tid(), lane = tid & 63, wid = tid >> 6;
    unsigned char* ws = p.get_ws();
    const float* MODS = (const float*)(ws + WS_MODS);
    float* XRES = (float*)(ws + WS_XRES);
    bf16_t* HB = (bf16_t*)(ws + WS_HB);
    float* SMALL = (float*)(ws + WS_SMALL);
    int* CHKI = (int*)(ws + WS_CHK);
    if (!a.final_out && !a.noproj) {
        for (int i = tid; i < 1024 * NS; i += NTH) { const int k = i / NS, n = i % NS;
            lds[(((k >> 8) * 4 + (k & 3)) * (NS / 4) + (n >> 2)) * 256 + ((k >> 2) & 63) * 4 + (n & 3)] = a.wsm[(size_t)k * a.ldw + a.wcol0 + n]; }
    }
    u32* lcnt = (u32*)(lds + 1024 * 32);
    int* lsl = (int*)(lds + 1024 * 32 + 64);
    int4* lrt = (int4*)(lds + 1024 * 32 + 64);
    if (tid < 16) lcnt[tid] = 0u;
    if (a.combine) {
        if (tid == 0) { int off[17]; expert_offsets((const u32*)(ws + WS_CTL) + CW_CNT + a.clayer * 16 * 64, off);
#pragma unroll
            for (int e = 0; e < 16; ++e) lsl[e] = off[e]; }
        for (int i = tid; i < nb * 16; i += NTH) lsl[16 + i] = CHKI[CH_BBASE + i];
    }
    __syncthreads();
    const float* gamma = (a.ffn ? p.in[7] : p.in[6]) + a.layer * 1024;
    const bf16_t* YMOE = (const bf16_t*)(ws + WS_PROJ);
    const int4* ROUTE = (const int4*)(ws + WS_ROUTE);
    const float2* GATE = (const float2*)(ws + WS_GATE);
    const int stride = nb * 8;
    for (int row0 = bid * 8 + wid; row0 < a.nrows; row0 += (NS == 16 ? 2 : 1) * stride) {
        const bool hasB = NS == 16 && row0 + stride < a.nrows;
        const int rw[2] = {row0, hasB ? row0 + stride : row0};
        float v[2][16];
#pragma unroll
        for (int u = 0; u < 2; ++u) {
            const int row = rw[u];
            const float* src = a.src ? XRES + (size_t)row * 1024 : (row >= SEQ ? p.in[2] + (size_t)(row - SEQ) * 1024 : p.in[0] + (size_t)row * 1024);
#pragma unroll
            for (int i = 0; i < 4; ++i) { const float4 t = *(const float4*)(src + i * 256 + lane * 4); v[u][i * 4] = t.x; v[u][i * 4 + 1] = t.y; v[u][i * 4 + 2] = t.z; v[u][i * 4 + 3] = t.w; }
        }
        if (a.combine) {
            int4 rt[2]; float2 gt[2];
#pragma unroll
            for (int u = 0; u < 2; ++u) { rt[u] = ROUTE[rw[u]]; gt[u] = GATE[rw[u]]; }
            uint2 y0[2][4], y1[2][4];
#pragma unroll
            for (int u = 0; u < 2; ++u) {
                const int blk = (rw[u] >> 6) % nb;
                const int s0 = lsl[rt[u].x] + lsl[16 + blk * 16 + rt[u].x] + rt[u].y, s1 = lsl[rt[u].z] + lsl[16 + blk * 16 + rt[u].z] + rt[u].w;
#pragma unroll
                for (int i = 0; i < 4; ++i) { y0[u][i] = *(const uint2*)(YMOE + (size_t)s0 * 1024 + i * 256 + lane * 4); y1[u][i] = *(const uint2*)(YMOE + (size_t)s1 * 1024 + i * 256 + lane * 4); }
            }
#pragma unroll
            for (int u = 0; u < 2; ++u) {
                const int row = rw[u];
                const float* gf = MODS + (a.clayer * 2 + (row >= SEQ ? 1 : 0)) * 6144 + 5 * 1024;
#pragma unroll
                for (int i = 0; i < 4; ++i) {
                    const float4 g = *(const float4*)(gf + i * 256 + lane * 4);
                    v[u][i * 4 + 0] += g.x * (gt[u].x * __uint_as_float(y0[u][i].x << 16) + gt[u].y * __uint_as_float(y1[u][i].x << 16));
                    v[u][i * 4 + 1] += g.y * (gt[u].x * __uint_as_float(y0[u][i].x & 0xffff0000u) + gt[u].y * __uint_as_float(y1[u][i].x & 0xffff0000u));
                    v[u][i * 4 + 2] += g.z * (gt[u].x * __uint_as_float(y0[u][i].y << 16) + gt[u].y * __uint_as_float(y1[u][i].y << 16));
                    v[u][i * 4 + 3] += g.w * (gt[u].x * __uint_as_float(y0[u][i].y & 0xffff0000u) + gt[u].y * __uint_as_float(y1[u][i].y & 0xffff0000u));
                }
                if (u == 0 || hasB) {
                    float* dst = a.final_out ? p.get_out() + (size_t)row * 1024 : XRES + (size_t)row * 1024;
#pragma unroll
                    for (int i = 0; i < 4; ++i) *(float4*)(dst + i * 256 + lane * 4) = make_float4(v[u][i * 4], v[u][i * 4 + 1], v[u][i * 4 + 2], v[u][i * 4 + 3]);
                }
            }
            if (a.final_out) continue;
        }
#pragma unroll
        for (int u = 0; u < 2; ++u) {
            const int row = rw[u];
            if (u == 0 || hasB) {
            const float* md = MODS + (a.layer * 2 + (row >= SEQ ? 1 : 0)) * 6144 + (a.ffn ? 3 * 1024 : 0);
            const float s0 = row_norm_proj<NS>(v[u], gamma, md, HB + (size_t)row * 1024, lds, lane, !a.noproj);
            if (a.noproj) {
            } else if (!a.route) {
                const int nl = NS == 16 ? (((lane >> 5) & 1) << 3) | (((lane >> 4) & 1) << 2) | (((lane >> 3) & 1) << 1) | ((lane >> 2) & 1)
                                        : (((lane >> 5) & 1) << 4) | (((lane >> 4) & 1) << 3) | (((lane >> 3) & 1) << 2) | (((lane >> 2) & 1) << 1) | ((lane >> 1) & 1);
                if ((lane & (NS == 16 ? 3 : 1)) == 0) SMALL[(size_t)row * 32 + nl] = s0;
            } else if (NS == 16) {
                const int nl = (((lane >> 5) & 1) << 3) | (((lane >> 4) & 1) << 2) | (((lane >> 3) & 1) << 1) | ((lane >> 2) & 1);
                const float scl = 1.f / (1.f + expf(-s0)), bsl = scl + p.in[5][nl];
                float sc[16], bs[16];
#pragma unroll
                for (int n = 0; n < 16; ++n) { const int sl = ((n & 8) ? 32 : 0) | ((n & 4) ? 16 : 0) | ((n & 2) ? 8 : 0) | ((n & 1) ? 4 : 0); sc[n] = rdlane(scl, sl); bs[n] = rdlane(bsl, sl); }
                int e0, e1; float g0, g1; route16(sc, bs, e0, e1, g0, g1);
                if (lane == 0) {
                    const int p0 = (int)atomicAdd(lcnt + e0, 1u), p1 = (int)atomicAdd(lcnt + e1, 1u);
                    const int4 rt4 = make_int4(e0, p0, e1, p1);
                    ((int4*)(ws + WS_ROUTE))[row] = rt4;
                    ((float2*)(ws + WS_GATE))[row] = make_float2(g0, g1);
                    lrt[((row - (bid * 8 + wid)) / stride) * 8 + wid] = rt4;
                }
            }
            }
            __builtin_amdgcn_sched_barrier(0);
        }
    }
    if (a.route) {
        __syncthreads();
        if (tid < 16) {
            u32* cnt = (u32*)(ws + WS_CTL) + CW_CNT + (a.layer * 16 + tid) * 64;
            const int base = (int)atomicAdd(cnt, lcnt[tid]);
            CHKI[CH_BBASE + bid * 16 + tid] = base; lcnt[16 + tid] = (u32)base;
        }
        __syncthreads();
        if (lane == 0) {
            int* ELIST = CHKI + CH_ELIST;
            int k = 0;
            for (int row = bid * 8 + wid; row < a.nrows; row += stride, ++k) {
                const int4 r = lrt[k * 8 + wid];
                ELIST[r.x * MT + (int)lcnt[16 + r.x] + r.y] = row; ELIST[r.z * MT + (int)lcnt[16 + r.z] + r.w] = row;
            }
        }
    }
}


__device__ __forceinline__ void phase_route(const P& p, int bid, int nb, float* lds, int layer, int nrows) {
    const int tid = p.tid(), lane = tid & 63, wid = tid >> 6, r = lane & 15, q = lane >> 4;
    unsigned char* ws = p.get_ws();
    const float* MODS = (const float*)(ws + WS_MODS);
    const float* XRES = (const float*)(ws + WS_XRES);
    bf16_t* HB = (bf16_t*)(ws + WS_HB);
    int* CHKI = (int*)(ws + WS_CHK);
    const bf16_t* WRT = (const bf16_t*)((const float*)(ws + WS_CHK) + CH_WRT);
    u32* lcnt = (u32*)(lds + 16384);
    int4* lrt = (int4*)(lds + 16384 + 64);
    if (tid < 16) lcnt[tid] = 0u;
    const float* gamma = p.in[7] + layer * 1024;
    int kt = 0;
    for (int tile = bid; tile < nrows / 64; tile += nb, ++kt) {
        const int r0 = tile * 64;
#pragma unroll 1
        for (int pr = 0; pr < 4; ++pr) {
            float v[2][16];
#pragma unroll
            for (int u = 0; u < 2; ++u) { const float* src = XRES + (size_t)(r0 + wid * 8 + pr * 2 + u) * 1024;
#pragma unroll
                for (int i = 0; i < 4; ++i) { const float4 t = *(const float4*)(src + i * 256 + lane * 4); v[u][i * 4] = t.x; v[u][i * 4 + 1] = t.y; v[u][i * 4 + 2] = t.z; v[u][i * 4 + 3] = t.w; } }
#pragma unroll
            for (int u = 0; u < 2; ++u) { const int row = r0 + wid * 8 + pr * 2 + u;
                const float* md = MODS + (layer * 2 + (row >= SEQ ? 1 : 0)) * 6144 + 3 * 1024;
                (void)row_norm_proj<16>(v[u], gamma, md, HB + (size_t)row * 1024, lds, lane, false); }
        }
        asm volatile("s_waitcnt vmcnt(0)" ::: "memory");
        __syncthreads();
        {
            f32x4 acc[4][2];
#pragma unroll
            for (int mi = 0; mi < 4; ++mi)
#pragma unroll
                for (int ni = 0; ni < 2; ++ni) acc[mi][ni] = (f32x4){0.f, 0.f, 0.f, 0.f};
            const bf16_t* Ab = HB + (size_t)(r0 + r) * 1024 + wid * 128 + 8 * q; const bf16_t* Bb = WRT + (size_t)r * 1024 + wid * 128 + 8 * q;
#pragma unroll
            for (int k4 = 0; k4 < 4; ++k4) {
                bf16x8 a[4], b[2];
#pragma unroll
                for (int mi = 0; mi < 4; ++mi) a[mi] = *(const bf16x8*)(Ab + (size_t)(16 * mi) * 1024 + 32 * k4);
#pragma unroll
                for (int ni = 0; ni < 2; ++ni) b[ni] = *(const bf16x8*)(Bb + (size_t)(16 * ni) * 1024 + 32 * k4);
#pragma unroll
                for (int mi = 0; mi < 4; ++mi)
#pragma unroll
                    for (int ni = 0; ni < 2; ++ni) acc[mi][ni] = __builtin_amdgcn_mfma_f32_16x16x32_bf16(b[ni], a[mi], acc[mi][ni], 0, 0, 0);
            }
#pragma unroll
            for (int mi = 0; mi < 4; ++mi)
#pragma unroll
                for (int ni = 0; ni < 2; ++ni) *(f32x4*)(lds + wid * 2048 + (16 * mi + r) * 32 + 16 * ni + 4 * q) = acc[mi][ni];
        }
        __syncthreads();
        if (tid < 128) {
            const int rr = tid >> 1, c8 = (tid & 1) * 8;
            float lg[8] = {0.f, 0.f, 0.f, 0.f, 0.f, 0.f, 0.f, 0.f};
#pragma unroll
            for (int w = 0; w < 8; ++w) { const float4 x0 = *(const float4*)(lds + w * 2048 + rr * 32 + c8), x1 = *(const float4*)(lds + w * 2048 + rr * 32 + c8 + 4);
                lg[0] += x0.x; lg[1] += x0.y; lg[2] += x0.z; lg[3] += x0.w; lg[4] += x1.x; lg[5] += x1.y; lg[6] += x1.z; lg[7] += x1.w; }
            float sc[16], bs[16];
            const float* rb = p.in[5];
#pragma unroll
            for (int j = 0; j < 8; ++j) {
                const float mine_s = 1.f / (1.f + expf(-lg[j])), mine_b = mine_s + rb[c8 + j];
                const float oth_s = __shfl_xor(mine_s, 1), oth_b = __shfl_xor(mine_b, 1);
                sc[j] = c8 ? oth_s : mine_s; sc[8 + j] = c8 ? mine_s : oth_s; bs[j] = c8 ? oth_b : mine_b; bs[8 + j] = c8 ? mine_b : oth_b;
            }
            int e0, e1; float g0, g1; route16(sc, bs, e0, e1, g0, g1);
            if (c8 == 0) {
                const int row = r0 + rr;
                const int p0 = (int)atomicAdd(lcnt + e0, 1u), p1 = (int)atomicAdd(lcnt + e1, 1u);
                const int4 rt4 = make_int4(e0, p0, e1, p1);
                ((int4*)(ws + WS_ROUTE))[row] = rt4;
                ((float2*)(ws + WS_GATE))[row] = make_float2(g0, g1);
                lrt[kt * 64 + rr] = rt4;
            }
        }
        __syncthreads();
    }
    __syncthreads();
    if (tid < 16) {
        u32* cnt = (u32*)(ws + WS_CTL) + CW_CNT + (layer * 16 + tid) * 64;
        const int base = (int)atomicAdd(cnt, lcnt[tid]);
        CHKI[CH_BBASE + bid * 16 + tid] = base; lcnt[16 + tid] = (u32)base;
    }
    __syncthreads();
    {
        int* ELIST = CHKI + CH_ELIST;
        int k2 = 0;
        for (int tile = bid; tile < nrows / 64; tile += nb, ++k2)
            if (tid < 64) { const int4 rt = lrt[k2 * 64 + tid]; const int row = tile * 64 + tid;
                ELIST[rt.x * MT + (int)lcnt[16 + rt.x] + rt.y] = row; ELIST[rt.z * MT + (int)lcnt[16 + rt.z] + rt.w] = row; }
    }
}

namespace g8 {
#define G8_LAS __attribute__((address_space(3)))
typedef short bf16x8 __attribute__((ext_vector_type(8)));
typedef float f32x4 __attribute__((ext_vector_type(4)));
constexpr int BM = 256, BK = 64, HALF = 128, HTB = HALF * BK * 2, STAGE_BYTES = 8 * HTB, NXCD = 8, WGM = 8;
__device__ __forceinline__ int lds_byte(int r, int c) { const int st = (r >> 4) * 2 + (c >> 5), rr = r & 15, cc = c & 31, ob = rr * 64 + cc * 2; return st * 1024 + (ob ^ (((ob >> 9) & 1) << 5)); }
__device__ __forceinline__ void stage_rc(int b, int& R, int& C) { const int st = b / 1024, sb = b % 1024, swz = sb ^ (((sb >> 9) & 1) << 5); R = (st >> 1) * 16 + swz / 64; C = (st & 1) * 32 + (swz % 64) / 2; }
__device__ __forceinline__ int perm32(int rho) { const int n = rho >> 4, i = rho & 15; return 8 * (i >> 2) + 4 * n + (i & 3); }
struct Unit { int pm, pn; };
struct Order {
    int nM, nN, nwg, G, c;
    __device__ __forceinline__ void init(int nM_, int nN_, int G_, int c_) { nM = nM_; nN = nN_; nwg = nM * nN; G = G_; c = c_; }
    __device__ __forceinline__ bool next(int i, Unit& u) const {
        const long L = (long)i * G + c; if (L >= nwg) return false;
        int wgid = (int)L; { const int q = nwg / NXCD, r = nwg % NXCD, xcd = wgid % NXCD, off = wgid / NXCD; wgid = (xcd < r ? xcd * (q + 1) : r * (q + 1) + (xcd - r) * q) + off; }
        const int nig = WGM * nN, gid = wgid / nig, fm = gid * WGM, gsz = (nM - fm) < WGM ? (nM - fm) : WGM;
        u.pm = fm + ((wgid % nig) % gsz); u.pn = (wgid % nig) / gsz; return true;
    }
};
template <class RowSrc, class BSel, class EF>
__device__ __forceinline__ void gemm8(const int tid, G8_LAS unsigned char* lds, const bf16_t* A, int K, const RowSrc& rsrc, const Order& S, const BSel& bsel, const EF& ef) {
    const int wid = __builtin_amdgcn_readfirstlane(tid >> 6), lane = tid & 63, wr = wid >> 2, wc = wid & 3, fr = lane & 15, fq = lane >> 4;
    const int nt = K / BK;
    int R0, C0, R1, C1; stage_rc(tid * 16, R0, C0); stage_rc(tid * 16 + 8192, R1, C1);
    const unsigned vb0 = (unsigned)(((R0 & ~31) + perm32(R0 & 31)) * K + C0) * 2u, vb1 = (unsigned)(((R1 & ~31) + perm32(R1 & 31)) * K + C1) * 2u;
    const size_t kstep = (size_t)(BK * 2), hstep = (size_t)HALF * K * 2, tstep = 2 * hstep;
    const unsigned ldsw = (unsigned)wid * 1024u;
    const int aoff = lds_byte(wr * 64 + fr, fq * 8), boff = lds_byte(wc * 32 + fr, fq * 8);
#define G8_SA(b, h) (((b) * 2 + (h)) * HTB)
#define G8_SB(b, h) ((4 + (b) * 2 + (h)) * HTB)
#define G8_STAGE(bufoff, gbase, v0, v1) do { \
        __builtin_amdgcn_global_load_lds((const unsigned*)((const char*)(gbase) + (v0)), (G8_LAS unsigned*)(lds + (bufoff) + ldsw), 16, 0, 0); \
        __builtin_amdgcn_global_load_lds((const unsigned*)((const char*)(gbase) + (v1)), (G8_LAS unsigned*)(lds + (bufoff) + ldsw + 8192), 16, 0, 0); } while (0)
#define G8_LDA(dst, b, h) do { _Pragma("unroll") for (int m = 0; m < 4; ++m) _Pragma("unroll") for (int k = 0; k < 2; ++k) dst[m][k] = *(const G8_LAS bf16x8*)(lds + G8_SA(b, h) + aoff + m * 2048 + k * 1024); } while (0)
#define G8_LDB(dst, b, h) do { _Pragma("unroll") for (int n = 0; n < 2; ++n) _Pragma("unroll") for (int k = 0; k < 2; ++k) dst[n][k] = *(const G8_LAS bf16x8*)(lds + G8_SB(b, h) + boff + n * 2048 + k * 1024); } while (0)
#define G8_MMA(ai, bj, At, Bt) do { __builtin_amdgcn_s_setprio(1); _Pragma("unroll") for (int m = 0; m < 4; ++m) _Pragma("unroll") for (int n = 0; n < 2; ++n) _Pragma("unroll") for (int k = 0; k < 2; ++k) \
        acc[ai][bj][m][n] = __builtin_amdgcn_mfma_f32_16x16x32_bf16(Bt[n][k], At[m][k], acc[ai][bj][m][n], 0, 0, 0); __builtin_amdgcn_s_setprio(0); } while (0)
#define G8_WAIT_V(n) asm volatile("s_waitcnt vmcnt(" #n ")" ::: "memory")
#define G8_WAIT_L(n) asm volatile("s_waitcnt lgkmcnt(" #n ")" ::: "memory")
#define G8_BAR __builtin_amdgcn_s_barrier()
#define G8_SCHED __builtin_amdgcn_sched_barrier(0)
#define G8_AOFF(pm_, h_, R_, C_) ((unsigned)(rsrc((pm_), (h_) * 128 + (R_)) * K + (C_)) * 2u)
    Unit cur, nxt; int ui = 0;
    if (!S.next(0, cur)) return;
    f32x4 acc[2][2][4][2];
#pragma unroll
    for (int a = 0; a < 2; ++a)
#pragma unroll
        for (int b = 0; b < 2; ++b)
#pragma unroll
            for (int m = 0; m < 4; ++m)
#pragma unroll
                for (int n = 0; n < 2; ++n) acc[a][b][m][n] = (f32x4){0.f, 0.f, 0.f, 0.f};
    bf16x8 At[4][2], B0[2][2], B1[2][2];
    const char* Ab = (const char*)A;
    unsigned a00 = G8_AOFF(cur.pm, 0, R0, C0), a01 = G8_AOFF(cur.pm, 0, R1, C1), a10 = G8_AOFF(cur.pm, 1, R0, C0), a11 = G8_AOFF(cur.pm, 1, R1, C1);
    const char* cB = bsel(cur.pm) + (size_t)cur.pn * tstep;
    G8_STAGE(G8_SB(0, 0), cB, vb0, vb1); G8_STAGE(G8_SA(0, 0), Ab, a00, a01); G8_STAGE(G8_SB(0, 1), cB + hstep, vb0, vb1); G8_STAGE(G8_SA(0, 1), Ab, a10, a11);
    if (wr == 1) G8_BAR;
    G8_WAIT_V(4); G8_BAR;
    G8_STAGE(G8_SB(1, 0), cB + kstep, vb0, vb1); G8_STAGE(G8_SA(1, 0), Ab + kstep, a00, a01); G8_STAGE(G8_SB(1, 1), cB + hstep + kstep, vb0, vb1);
    G8_WAIT_V(6); G8_BAR;
    for (;;) {
        const bool has_next = S.next(ui + 1, nxt);
        unsigned n00 = a00, n01 = a01, n10 = a10, n11 = a11; const char* nB = cB;
        if (has_next) { n00 = G8_AOFF(nxt.pm, 0, R0, C0); n01 = G8_AOFF(nxt.pm, 0, R1, C1); n10 = G8_AOFF(nxt.pm, 1, R0, C0); n11 = G8_AOFF(nxt.pm, 1, R1, C1); nB = bsel(nxt.pm) + (size_t)nxt.pn * tstep; }
        for (int t = 0; t < nt; t += 2) {
            const bool last = (t == nt - 2);
            const char* a1p = Ab + (size_t)(t + 1) * kstep;
            const char* a2p = last ? Ab : Ab + (size_t)(t + 2) * kstep; const char* b2 = last ? nB : cB + (size_t)(t + 2) * kstep;
            const char* a3p = a2p + kstep; const char* b3 = b2 + kstep;
            const unsigned x00 = last ? n00 : a00, x01 = last ? n01 : a01, x10 = last ? n10 : a10, x11 = last ? n11 : a11;
            G8_LDB(B0, 0, 0); G8_SCHED; G8_LDA(At, 0, 0); G8_STAGE(G8_SA(1, 1), a1p, a10, a11);
            G8_WAIT_L(8); G8_BAR; G8_WAIT_L(0); G8_MMA(0, 0, At, B0); G8_BAR; G8_SCHED;
            G8_LDB(B1, 0, 1); G8_STAGE(G8_SB(0, 0), b2, vb0, vb1);
            G8_BAR; G8_WAIT_L(0); G8_MMA(0, 1, At, B1); G8_BAR;
            G8_LDA(At, 0, 1); G8_STAGE(G8_SA(0, 0), a2p, x00, x01);
            G8_BAR; G8_WAIT_L(0); G8_MMA(1, 0, At, B0); G8_BAR; G8_SCHED;
            G8_STAGE(G8_SB(0, 1), b2 + hstep, vb0, vb1);
            G8_WAIT_V(6); G8_BAR; G8_MMA(1, 1, At, B1); G8_BAR;
            G8_LDB(B0, 1, 0); G8_SCHED; G8_LDA(At, 1, 0); G8_STAGE(G8_SA(0, 1), a2p, x10, x11);
            G8_WAIT_L(8); G8_BAR; G8_WAIT_L(0); G8_MMA(0, 0, At, B0); G8_BAR; G8_SCHED;
            G8_LDB(B1, 1, 1); G8_STAGE(G8_SB(1, 0), b3, vb0, vb1);
            G8_BAR; G8_WAIT_L(0); G8_MMA(0, 1, At, B1); G8_BAR;
            G8_LDA(At, 1, 1); G8_STAGE(G8_SA(1, 0), a3p, x00, x01);
            G8_BAR; G8_WAIT_L(0); G8_MMA(1, 0, At, B0); G8_BAR; G8_SCHED;
            G8_STAGE(G8_SB(1, 1), b3 + hstep, vb0, vb1);
            G8_WAIT_V(6); G8_BAR; G8_MMA(1, 1, At, B1); G8_BAR;
        }
#pragma unroll
        for (int ai = 0; ai < 2; ++ai)
#pragma unroll
            for (int m = 0; m < 4; ++m)
#pragma unroll
                for (int bj = 0; bj < 2; ++bj) {
                    const f32x4 v0 = acc[ai][bj][m][0], v1 = acc[ai][bj][m][1];
                    const float v[8] = {v0[0], v0[1], v0[2], v0[3], v1[0], v1[1], v1[2], v1[3]};
                    ef(cur.pm * BM + ai * HALF + wr * 64 + m * 16 + fr, cur.pn * BM + bj * HALF + wc * 32 + 8 * fq, v);
                }
        if (!has_next) break;
#pragma unroll
        for (int a = 0; a < 2; ++a)
#pragma unroll
            for (int b = 0; b < 2; ++b)
#pragma unroll
                for (int m = 0; m < 4; ++m)
#pragma unroll
                    for (int n = 0; n < 2; ++n) acc[a][b][m][n] = (f32x4){0.f, 0.f, 0.f, 0.f};
        cur = nxt; a00 = n00; a01 = n01; a10 = n10; a11 = n11; cB = nB; ++ui;
    }
    G8_WAIT_V(0);
    if (wr == 0) G8_BAR;
    G8_BAR;
#undef G8_SA
#undef G8_SB
#undef G8_STAGE
#undef G8_LDA
#undef G8_LDB
#undef G8_MMA
#undef G8_WAIT_V
#undef G8_WAIT_L
#undef G8_BAR
#undef G8_SCHED
#undef G8_AOFF
}
}
struct BSelOne { const char* B; __device__ __forceinline__ const char* operator()(int) const { return B; } };
struct RowPlain { __device__ __forceinline__ int operator()(int pm, int r) const { return pm * 256 + r; } };
struct BSelExp { const char* B; const int* tinfo; size_t stride; __device__ __forceinline__ const char* operator()(int pm) const { return B + (size_t)tinfo[2 * pm] * stride; } };
struct RowMoe { const int* tinfo; const int* ecnt; const int* elist;
    __device__ __forceinline__ int operator()(int pm, int r) const { const int e = tinfo[2 * pm], pos = tinfo[2 * pm + 1] + r; return pos < ecnt[e] ? elist[e * MT + pos] : 0; } };
__device__ __forceinline__ int moe_tile_table(const P& p, int layer, int* tinfo, int* ecnt, int tid) {
    const u32* cnt = (const u32*)(p.get_ws() + WS_CTL) + CW_CNT + layer * 16 * 64;
    if (tid == 0) {
        int t = 0;
#pragma unroll 1
        for (int e = 0; e < 16; ++e) { const int c = (int)cnt[e * 64]; ecnt[e] = c;
#pragma unroll 1
            for (int i = 0; i < (c + 255) / 256; ++i) { tinfo[2 * t] = e; tinfo[2 * t + 1] = i * 256; ++t; } }
        ecnt[16] = t;
    }
    __syncthreads();
    return ecnt[16];
}

struct SrcPlain { const float* W; int ldw; __device__ __forceinline__ const float* operator()(int k, int n) const { return W + (size_t)k * ldw + n; } };
struct SrcEven { const float* W; __device__ __forceinline__ const float* operator()(int k, int n) const {
        return n < 2048 ? W + (size_t)k * EV_IN + (n < 1280 ? n : n + 16) : (n < 2064 ? W + (size_t)k * EV_IN + 1280 + (n - 2048) : nullptr); } };
struct SrcRouter { const float* W; __device__ __forceinline__ const float* operator()(int k, int n) const { return n < 16 ? W + (size_t)k * 16 + n : nullptr; } };
struct SrcOdd { const float* W; __device__ __forceinline__ const float* operator()(int k, int n) const { return n < OD_IN ? W + (size_t)k * OD_IN + n : nullptr; } };
struct SrcMoe13 { const float* W1; long long d13; __device__ __forceinline__ const float* operator()(int k, int n) const { return W1 + ((n & 4) ? d13 : 0ll) + (size_t)k * DE + ((n >> 3) * 4 + (n & 3)); } };
template <class SF>
__device__ __forceinline__ void conv_matrix(const SF& src, int K, int N, bf16_t* WT, int gw, int ngw, float* scr, int lane) {
    const int nblk = N / 32, nitems = (K / 64) * nblk;
    for (int item = gw; item < nitems; item += ngw) {
        const int kb = item / nblk, nbk = item % nblk, k0 = 64 * kb, n0 = 32 * nbk;
#pragma unroll 8
        for (int i = 0; i < 32; ++i) { const int kk = 2 * i + (lane >> 5); const float* sp = src(k0 + kk, n0 + (lane & 31)); scr[kk * 33 + (lane & 31)] = sp ? *sp : 0.f; }
        __builtin_amdgcn_s_waitcnt(0xC07F); asm volatile("" ::: "memory");
        const int c = lane & 7;
#pragma unroll
        for (int j = 0; j < 4; ++j) { const int n = (lane >> 3) + 8 * j; const float* sp = scr + (8 * c) * 33 + n;
            uint4 o; o.x = pack2(sp[0 * 33], sp[1 * 33]); o.y = pack2(sp[2 * 33], sp[3 * 33]); o.z = pack2(sp[4 * 33], sp[5 * 33]); o.w = pack2(sp[6 * 33], sp[7 * 33]);
            *(uint4*)(WT + (size_t)(n0 + n) * K + k0 + 8 * c) = o; }
        __builtin_amdgcn_s_waitcnt(0xC07F); asm volatile("" ::: "memory");
    }
}
__device__ __forceinline__ void conv_dense(const P& p, int bid, int nb, float* lds) {
    const int tid = p.tid(), lane = tid & 63, wid = tid >> 6;
    float* scr = lds + 16384 + wid * (64 * 33);
    const int gw = bid * 8 + wid, ngw = nb * 8;
    unsigned char* ws = p.get_ws();
    conv_matrix(SrcEven{p.in[10]}, 1024, 2304, (bf16_t*)(ws + WS_WIN0), gw, ngw, scr, lane);
    conv_matrix(SrcOdd{p.in[21]}, 1024, 3328, (bf16_t*)(ws + WS_WIN1), gw, ngw, scr, lane);
    conv_matrix(SrcPlain{p.in[20], 1024}, 1024, 1024, (bf16_t*)(ws + WS_WOUT0), gw, ngw, scr, lane);
    conv_matrix(SrcPlain{p.in[27], 1024}, 1024, 1024, (bf16_t*)(ws + WS_WOUT1), gw, ngw, scr, lane);
    conv_matrix(SrcRouter{p.in[4]}, 1024, 32, (bf16_t*)((float*)(ws + WS_CHK) + CH_WRT), gw, ngw, scr, lane);
}
__device__ __forceinline__ void conv_moe(const P& p, int bid, int nb, float* lds, int layer) {
    const int tid = p.tid(), lane = tid & 63, wid = tid >> 6;
    float* scr = lds + 16384 + wid * (64 * 33);
    const int ngw = nb * 8; int gw = bid * 8 + wid;
    unsigned char* ws = p.get_ws();
    bf16_t* W13T = (bf16_t*)(ws + WS_WMOE); bf16_t* W2T = W13T + (size_t)16 * 1024 * 1024;
    const long long d13 = (long long)(p.in[29] - p.in[28]);
    for (int e = 0; e < 16; ++e) {
        conv_matrix(SrcMoe13{p.in[28] + ((size_t)layer * 16 + e) * 1024 * DE, d13}, 1024, 1024, W13T + (size_t)e * 1024 * 1024, gw, ngw, scr, lane);
        conv_matrix(SrcPlain{p.in[30] + ((size_t)layer * 16 + e) * DE * 1024, 1024}, DE, 1024, W2T + (size_t)e * 1024 * DE, gw, ngw, scr, lane);
        gw = (gw + 768) % ngw;
    }
}


template <class EF>
__device__ __forceinline__ void mini_gemm(const P& p, int bid, int nb, float* lds, const bf16_t* A, const bf16_t* Bt, int row0, int nrt, int col0, int nct, const EF& ef) {
    constexpr int K = 1024, KS = 128;
    const int tid = p.tid(), lane = tid & 63, wid = tid >> 6, r = lane & 15, q = lane >> 4;
    const int ntl = nrt * nct;
    int t = bid;
    if (t >= ntl) return;
    bf16x8 a[4][4], b[4][2];
#define MG_LOAD(tt) do { const int rt_ = (tt) / nct, ct_ = (tt) % nct; \
        const bf16_t* Ab_ = A + (size_t)(row0 + rt_ * 64 + r) * K + wid * KS + 8 * q; const bf16_t* Bb_ = Bt + (size_t)(col0 + ct_ * 32 + r) * K + wid * KS + 8 * q; \
        _Pragma("unroll") for (int k4 = 0; k4 < 4; ++k4) { \
            _Pragma("unroll") for (int mi = 0; mi < 4; ++mi) a[k4][mi] = *(const bf16x8*)(Ab_ + (size_t)(16 * mi) * K + 32 * k4); \
            _Pragma("unroll") for (int ni = 0; ni < 2; ++ni) b[k4][ni] = *(const bf16x8*)(Bb_ + (size_t)(16 * ni) * K + 32 * k4); } } while (0)
    MG_LOAD(t);
    for (;;) {
        f32x4 acc[4][2];
#pragma unroll
        for (int mi = 0; mi < 4; ++mi)
#pragma unroll
            for (int ni = 0; ni < 2; ++ni) acc[mi][ni] = (f32x4){0.f, 0.f, 0.f, 0.f};
#pragma unroll
        for (int k4 = 0; k4 < 4; ++k4)
#pragma unroll
            for (int mi = 0; mi < 4; ++mi)
#pragma unroll
                for (int ni = 0; ni < 2; ++ni) acc[mi][ni] = __builtin_amdgcn_mfma_f32_16x16x32_bf16(b[k4][ni], a[k4][mi], acc[mi][ni], 0, 0, 0);
        const int tcur = t; t += nb;
        const bool more = t < ntl;
        if (more) MG_LOAD(t);
        __syncthreads();
#pragma unroll
        for (int mi = 0; mi < 4; ++mi)
#pragma unroll
            for (int ni = 0; ni < 2; ++ni) *(f32x4*)(lds + wid * 2048 + (16 * mi + r) * 32 + 16 * ni + 4 * q) = acc[mi][ni];
        __syncthreads();
        if (tid < 256) {
            const int rr = tid >> 2, c8 = (tid & 3) * 8;
            float v[8] = {0.f, 0.f, 0.f, 0.f, 0.f, 0.f, 0.f, 0.f};
#pragma unroll
            for (int w = 0; w < 8; ++w) { const float4 x0 = *(const float4*)(lds + w * 2048 + rr * 32 + c8), x1 = *(const float4*)(lds + w * 2048 + rr * 32 + c8 + 4);
                v[0] += x0.x; v[1] += x0.y; v[2] += x0.z; v[3] += x0.w; v[4] += x1.x; v[5] += x1.y; v[6] += x1.z; v[7] += x1.w; }
            ef(row0 + (tcur / nct) * 64 + rr, col0 + (tcur % nct) * 32 + c8, v);
        }
        if (!more) break;
    }
#undef MG_LOAD
    __syncthreads();
}

struct EpiProj { bf16_t* C; int ld; int nmain; int ns; float* SMALL; __device__ void operator()(int r, int c0, const float* v) const {
    if (c0 < nmain) { uint4 o; o.x = pack2(v[0], v[1]); o.y = pack2(v[2], v[3]); o.z = pack2(v[4], v[5]); o.w = pack2(v[6], v[7]); *(uint4*)(C + (size_t)r * ld + c0) = o; }
    else if (c0 < nmain + ns) { float* d = SMALL + (size_t)r * 32 + (c0 - nmain); *(float4*)d = make_float4(v[0], v[1], v[2], v[3]); *(float4*)(d + 4) = make_float4(v[4], v[5], v[6], v[7]); } } };
struct EpiBf16Store { bf16_t* C; int ld; __device__ void operator()(int r, int c0, const float* v) const {
    uint4 o; o.x = pack2(v[0], v[1]); o.y = pack2(v[2], v[3]); o.z = pack2(v[4], v[5]); o.w = pack2(v[6], v[7]); *(uint4*)(C + (size_t)r * ld + c0) = o; } };
struct EpiResid { const float* xlat; const float* xctx; float* XRES; const float* gl; const float* gc;
    __device__ void operator()(int r, int c0, const float* v) const {
        const float* xin = xctx && r >= SEQ ? xctx + (size_t)(r - SEQ) * 1024 : xlat + (size_t)r * 1024;
        const float* g = r >= SEQ ? gc : gl;
        const float4 x0 = *(const float4*)(xin + c0), x1 = *(const float4*)(xin + c0 + 4), g0 = *(const float4*)(g + c0), g1 = *(const float4*)(g + c0 + 4);
        *(float4*)(XRES + (size_t)r * 1024 + c0) = make_float4(x0.x + g0.x * v[0], x0.y + g0.y * v[1], x0.z + g0.z * v[2], x0.w + g0.w * v[3]);
        *(float4*)(XRES + (size_t)r * 1024 + c0 + 4) = make_float4(x1.x + g1.x * v[4], x1.y + g1.y * v[5], x1.z + g1.z * v[6], x1.w + g1.w * v[7]);
    } };
struct EpiSwiglu { bf16_t* H; __device__ void operator()(int r, int c0, const float* v) const {
    uint2 o; o.x = pack2(siluf(v[0]) * v[4], siluf(v[1]) * v[5]); o.y = pack2(siluf(v[2]) * v[6], siluf(v[3]) * v[7]); *(uint2*)(H + (size_t)r * DE + (c0 >> 3) * 4) = o; } };

__device__ __forceinline__ void phase_moe1(const P& p, int bid, int nb, G8_LAS unsigned char* ldsa, float* lds, int layer) {
    unsigned char* ws = p.get_ws();
    int* tinfo = (int*)(lds + 32768); int* ecnt = tinfo + 2 * MAXTILES + 16;
    const int ntiles = moe_tile_table(p, layer, tinfo, ecnt, p.tid());
    g8::Order S; S.init(ntiles, 4, nb, bid);
    EpiSwiglu ef{(bf16_t*)(ws + WS_Y)};
    g8::gemm8(p.tid(), ldsa, (const bf16_t*)(ws + WS_HB), 1024, RowMoe{tinfo, ecnt, (const int*)(ws + WS_CHK) + CH_ELIST}, S, BSelExp{(const char*)(ws + WS_WMOE), tinfo, (size_t)1024 * 1024 * 2}, ef);
}
__device__ __forceinline__ void phase_moe2(const P& p, int bid, int nb, G8_LAS unsigned char* ldsa, float* lds, int layer) {
    unsigned char* ws = p.get_ws();
    int* tinfo = (int*)(lds + 32768); int* ecnt = tinfo + 2 * MAXTILES + 16;
    const int ntiles = moe_tile_table(p, layer, tinfo, ecnt, p.tid());
    g8::Order S; S.init(ntiles, 4, nb, bid);
    EpiBf16Store ef{(bf16_t*)(ws + WS_PROJ), 1024};
    g8::gemm8(p.tid(), ldsa, (const bf16_t*)(ws + WS_Y), DE, RowPlain{}, S, BSelExp{(const char*)(ws + WS_WMOE) + (size_t)16 * 1024 * 1024 * 2, tinfo, (size_t)1024 * DE * 2}, ef);
}

__device__ __forceinline__ void phase_qkprep(const P& p, int bid, int nb) {
    const int tid = p.tid(), lane = tid & 63, wid = tid >> 6;
    unsigned char* ws = p.get_ws();
    const bf16_t* PROJ = (const bf16_t*)(ws + WS_PROJ);
    bf16_t* QKR = (bf16_t*)(ws + WS_XRES);
    const float* RC = (const float*)(ws + WS_ROPE); const float* RS = RC + 256 * 16;
    const float qn = p.in[17][lane], kn = p.in[18][lane];
    for (int row = bid * 8 + wid; row < MT; row += nb * 8) {
        const bool lat = row < SEQ;
        const int pos = lane < 32 ? (row >> 6) : (row & 63);
        const int f = lane & 15;
        const float cs = lat ? RC[pos * 16 + f] : 1.f, sn = lat ? RS[pos * 16 + f] : 0.f;
        for (int h = 0; h < 10; ++h) {
            const float x = bf2f(PROJ[(size_t)row * 2048 + 1280 + h * 64 + lane]);
            const float ss = wave_sum(x * x);
            const float y = x * rsqrtf(ss * (1.f / 64.f) + 1e-6f) * (h < 8 ? qn : kn);
            const float o = __shfl_xor(y, 16);
            const float r = ((lane & 16) == 0) ? y * cs - o * sn : o * sn + y * cs;
            QKR[(size_t)row * 640 + h * 64 + lane] = f2bf(r);
        }
    }
}


template <int MI, int NI, int KK, bool SWAP>
__device__ __forceinline__ void wave_mma(f32x4 (&acc)[MI][NI], const bf16_t* A, int lda, const bf16_t* Bt, int ldb, int lane) {
    const int r = lane & 15, q = lane >> 4;
#pragma unroll
    for (int kk = 0; kk < KK; kk += 32) {
        bf16x8 a[MI], b[NI];
#pragma unroll
        for (int mi = 0; mi < MI; ++mi) a[mi] = *(const bf16x8*)(A + (16 * mi + r) * lda + kk + 8 * q);
#pragma unroll
        for (int ni = 0; ni < NI; ++ni) b[ni] = *(const bf16x8*)(Bt + (16 * ni + r) * ldb + kk + 8 * q);
#pragma unroll
        for (int mi = 0; mi < MI; ++mi)
#pragma unroll
            for (int ni = 0; ni < NI; ++ni)
                acc[mi][ni] = SWAP ? __builtin_amdgcn_mfma_f32_16x16x32_bf16(b[ni], a[mi], acc[mi][ni], 0, 0, 0) : __builtin_amdgcn_mfma_f32_16x16x32_bf16(a[mi], b[ni], acc[mi][ni], 0, 0, 0);
    }
}
__device__ __forceinline__ void unpack8(const uint4 w, float* f) {
    f[0] = __uint_as_float(w.x << 16); f[1] = __uint_as_float(w.x & 0xffff0000u); f[2] = __uint_as_float(w.y << 16); f[3] = __uint_as_float(w.y & 0xffff0000u);
    f[4] = __uint_as_float(w.z << 16); f[5] = __uint_as_float(w.z & 0xffff0000u); f[6] = __uint_as_float(w.w << 16); f[7] = __uint_as_float(w.w & 0xffff0000u);
}
struct Raw3 { uint4 m, c, p; };
__device__ __forceinline__ Raw3 conv8_load(const bf16_t* rowp, int ld, int t, int L) {
    const uint4 z = make_uint4(0u, 0u, 0u, 0u);
    Raw3 r; r.m = t > 0 ? *(const uint4*)(rowp - ld) : z; r.c = *(const uint4*)rowp; r.p = t < L - 1 ? *(const uint4*)(rowp + ld) : z; return r;
}
__device__ __forceinline__ void conv8_apply(const Raw3& r, const float* cwl, float* out) {
    float fm[8], f0[8], fp[8]; unpack8(r.m, fm); unpack8(r.c, f0); unpack8(r.p, fp);
#pragma unroll
    for (int j = 0; j < 8; ++j) { const float4 w = *(const float4*)(cwl + j * 4); out[j] = siluf(w.x * fm[j] + w.y * f0[j] + w.z * fp[j] + w.w); }
}
__device__ __forceinline__ float wave_scan128(float& v0, float& v1, int lane) {
    float s = v0 + v1;
#pragma unroll
    for (int o = 1; o < 64; o <<= 1) { const float t = __shfl_up(s, o); if (lane >= o) s += t; }
    const float excl = s - (v0 + v1);
    v0 = excl + v0; v1 = v0 + v1;
    return __shfl(s, 63);
}

constexpr size_t SSD_S_OFF = 0;
constexpr size_t SSD_H_OFF = (size_t)130 * 16 * 4096 * 4;
__device__ __forceinline__ void stage_convw(const float* cw, const float* cb, int C, float* cwl, int tid) {
    for (int c = tid; c < C; c += NTH) *(float4*)(cwl + c * 4) = make_float4(cw[c], cw[C + c], cw[2 * C + c], cb[c]);
}
__device__ __forceinline__ void ssd_states(const P& p, int bid, int nb, float* lds) {
    const int tid = p.tid(), lane = tid & 63, wid = tid >> 6;
    unsigned char* ws = p.get_ws();
    const bf16_t* PROJ = (const bf16_t*)(ws + WS_PROJ);
    const float* SMALL = (const float*)(ws + WS_SMALL);
    float* S = (float*)(ws + WS_Y + SSD_S_OFF);
    float* DEC = (float*)(ws + WS_CHK);
    float* cwl = lds;
    bf16_t* XT = (bf16_t*)(lds + 768 * 4);
    bf16_t* BT = XT + 256 * 136;
    float* wsc = (float*)(BT + 64 * 136);
    stage_convw(p.in[11], p.in[12], 768, cwl, tid);
    __syncthreads();
    for (int item = bid; item < 260; item += nb) {
        const int c = item >> 1, g = item & 1;
        const int L = c < 128 ? SEQ : CTX, t0 = c < 128 ? c * 128 : (c - 128) * 128, rbase = c < 128 ? 0 : SEQ;
#pragma unroll 1
        for (int b5 = 0; b5 < 2; ++b5) {
            Raw3 rw[5];
#pragma unroll
            for (int k = 0; k < 5; ++k) { const int i = tid + (b5 * 5 + k) * NTH; const int tl = i & 127, cg8 = i >> 7;
                const int ch = cg8 < 32 ? g * 256 + cg8 * 8 : 512 + g * 64 + (cg8 - 32) * 8;
                rw[k] = conv8_load(PROJ + (size_t)(rbase + t0 + tl) * 2048 + 512 + ch, 2048, t0 + tl, L); }
#pragma unroll
            for (int k = 0; k < 5; ++k) { const int i = tid + (b5 * 5 + k) * NTH; const int tl = i & 127, cg8 = i >> 7;
                const int ch = cg8 < 32 ? g * 256 + cg8 * 8 : 512 + g * 64 + (cg8 - 32) * 8;
                float o[8]; conv8_apply(rw[k], cwl + ch * 4, o);
                bf16_t* dst = cg8 < 32 ? XT + (cg8 * 8) * 136 + tl : BT + ((cg8 - 32) * 8) * 136 + tl;
#pragma unroll
                for (int j = 0; j < 8; ++j) dst[j * 136] = f2bf(o[j]); }
        }
        const int hh = wid >> 1, d = wid & 1, h = g * 4 + hh;
        {
            const float A = -expf(p.in[14][d * 8 + h]), dtb = p.in[13][d * 8 + h];
            const float dt0 = softplusf(SMALL[(size_t)(rbase + t0 + 2 * lane) * 32 + d * 8 + h] + dtb), dt1 = softplusf(SMALL[(size_t)(rbase + t0 + 2 * lane + 1) * 32 + d * 8 + h] + dtb);
            const float a0 = dt0 * A, a1 = dt1 * A;
            float c0 = a0, c1 = a1; const float tot = wave_scan128(c0, c1, lane);
            const float w0 = d == 0 ? __expf(tot - c0) * dt0 : __expf(c0 - a0) * dt0, w1 = d == 0 ? __expf(tot - c1) * dt1 : __expf(c1 - a1) * dt1;
            wsc[wid * 128 + 2 * lane] = w0; wsc[wid * 128 + 2 * lane + 1] = w1;
            if (lane == 0) DEC[c * 16 + d * 8 + h] = __expf(tot);
        }
        __syncthreads();
        {
            f32x4 acc[4][4];
#pragma unroll
            for (int mi = 0; mi < 4; ++mi)
#pragma unroll
                for (int ni = 0; ni < 4; ++ni) acc[mi][ni] = (f32x4){0.f, 0.f, 0.f, 0.f};
            const int r = lane & 15, q = lane >> 4;
#pragma unroll
            for (int kk = 0; kk < 128; kk += 32) {
                const float4 wa = *(const float4*)(wsc + wid * 128 + kk + 8 * q), wb = *(const float4*)(wsc + wid * 128 + kk + 8 * q + 4);
                bf16x8 a[4], b[4];
#pragma unroll
                for (int mi = 0; mi < 4; ++mi) {
                    const uint4 raw = *(const uint4*)(XT + (hh * 64 + 16 * mi + r) * 136 + kk + 8 * q);
                    float f[8]; unpack8(raw, f);
                    uint4 o; o.x = pack2(f[0] * wa.x, f[1] * wa.y); o.y = pack2(f[2] * wa.z, f[3] * wa.w); o.z = pack2(f[4] * wb.x, f[5] * wb.y); o.w = pack2(f[6] * wb.z, f[7] * wb.w);
                    a[mi] = *(bf16x8*)&o;
                }
#pragma unroll
                for (int ni = 0; ni < 4; ++ni) b[ni] = *(const bf16x8*)(BT + (16 * ni + r) * 136 + kk + 8 * q);
#pragma unroll
                for (int mi = 0; mi < 4; ++mi)
#pragma unroll
                    for (int ni = 0; ni < 4; ++ni) acc[mi][ni] = __builtin_amdgcn_mfma_f32_16x16x32_bf16(a[mi], b[ni], acc[mi][ni], 0, 0, 0);
                __builtin_amdgcn_sched_barrier(0);
            }
            float* Sp = S + ((size_t)(c * 2 + d) * 8 + h) * 4096;
#pragma unroll
            for (int mi = 0; mi < 4; ++mi)
#pragma unroll
                for (int ni = 0; ni < 4; ++ni)
#pragma unroll
                    for (int j = 0; j < 4; ++j) Sp[(16 * mi + 4 * q + j) * 64 + 16 * ni + r] = acc[mi][ni][j];
        }
        __syncthreads();
    }
}
__device__ __forceinline__ void ssd_scan(const P& p, int bid, int nb) {
    const int tid = p.tid();
    unsigned char* ws = p.get_ws();
    const float* S = (const float*)(ws + WS_Y + SSD_S_OFF);
    bf16_t* HIN = (bf16_t*)(ws + WS_Y + SSD_H_OFF);
    const float* DEC = (const float*)(ws + WS_CHK);
    for (int gid = bid * NTH + tid; gid < 65536; gid += nb * NTH) {
        const int d = gid >> 15, h = (gid >> 12) & 7, e = gid & 4095;
        float H = 0.f;
#pragma unroll 1
        for (int i0 = 0; i0 < 130; i0 += 10) {
            float sv[10], dv[10]; int cc[10];
#pragma unroll
            for (int j = 0; j < 10; ++j) {
                const int i = i0 + j;
                const int c = d == 0 ? (i < 2 ? 128 + i : i - 2) : (i < 2 ? 129 - i : 129 - i);
                cc[j] = c; sv[j] = S[((size_t)(c * 2 + d) * 8 + h) * 4096 + e]; dv[j] = DEC[c * 16 + d * 8 + h];
            }
#pragma unroll
            for (int j = 0; j < 10; ++j) { HIN[((size_t)(cc[j] * 2 + d) * 8 + h) * 4096 + e] = f2bf(H); H = dv[j] * H + sv[j]; }
        }
    }
}
__device__ __forceinline__ void ssd_out(const P& p, int bid, int nb, float* lds) {
    const int tid = p.tid(), lane = tid & 63, wid = tid >> 6, r = lane & 15, q = lane >> 4;
    unsigned char* ws = p.get_ws();
    const bf16_t* PROJ = (const bf16_t*)(ws + WS_PROJ);
    const float* SMALL = (const float*)(ws + WS_SMALL);
    const bf16_t* HIN = (const bf16_t*)(ws + WS_Y + SSD_H_OFF);
    bf16_t* MIX = (bf16_t*)(ws + WS_HB);
    float* cwl = lds;
    bf16_t* Cg = (bf16_t*)(lds + 768 * 4);
    bf16_t* Bg = Cg + 128 * 72;
    bf16_t* XT = Bg + 128 * 72;
    bf16_t* Mb = XT + 64 * 136;
    bf16_t* Hn = Mb + 128 * 136;
    float* csb = (float*)(Hn + 2 * 64 * 72);
    float* dts = csb + 256;
    stage_convw(p.in[11], p.in[12], 768, cwl, tid);
    __syncthreads();
    for (int c = bid; c < 130; c += nb) {
        const int L = c < 128 ? SEQ : CTX, t0 = c < 128 ? c * 128 : (c - 128) * 128, rbase = c < 128 ? 0 : SEQ;
        const int trow = wid * 16 + r;
        float ssq = 0.f;
        for (int g = 0; g < 2; ++g) {
            {
                Raw3 rw[4];
#pragma unroll
                for (int k = 0; k < 4; ++k) { const int i = tid + k * NTH; const int cg8 = i & 15, tl = i >> 4;
                    const int ch = cg8 < 8 ? 640 + g * 64 + cg8 * 8 : 512 + g * 64 + (cg8 - 8) * 8;
                    rw[k] = conv8_load(PROJ + (size_t)(rbase + t0 + tl) * 2048 + 512 + ch, 2048, t0 + tl, L); }
#pragma unroll
                for (int k = 0; k < 4; ++k) { const int i = tid + k * NTH; const int cg8 = i & 15, tl = i >> 4;
                    const int ch = cg8 < 8 ? 640 + g * 64 + cg8 * 8 : 512 + g * 64 + (cg8 - 8) * 8;
                    float o[8]; conv8_apply(rw[k], cwl + ch * 4, o);
                    uint4 w; w.x = pack2(o[0], o[1]); w.y = pack2(o[2], o[3]); w.z = pack2(o[4], o[5]); w.w = pack2(o[6], o[7]);
                    *(uint4*)((cg8 < 8 ? Cg + cg8 * 8 : Bg + (cg8 - 8) * 8) + tl * 72) = w; }
            }
            __syncthreads();
            f32x4 G[1][8];
#pragma unroll
            for (int ni = 0; ni < 8; ++ni) G[0][ni] = (f32x4){0.f, 0.f, 0.f, 0.f};
            wave_mma<1, 8, 64, true>(G, Cg + wid * 16 * 72, 72, Bg, 72, lane);
            for (int hh = 0; hh < 4; ++hh) {
                const int h = g * 4 + hh;
                {
                    Raw3 rw[2];
#pragma unroll
                    for (int k = 0; k < 2; ++k) { const int i = tid + k * NTH; const int tl = i & 127, cg8 = i >> 7; const int ch = h * 64 + cg8 * 8;
                        rw[k] = conv8_load(PROJ + (size_t)(rbase + t0 + tl) * 2048 + 512 + ch, 2048, t0 + tl, L); }
                    const uint4 hp0 = *(const uint4*)(HIN + ((size_t)(c * 2 + 0) * 8 + h) * 4096 + tid * 8), hp1 = *(const uint4*)(HIN + ((size_t)(c * 2 + 1) * 8 + h) * 4096 + tid * 8);
#pragma unroll
                    for (int k = 0; k < 2; ++k) { const int i = tid + k * NTH; const int tl = i & 127, cg8 = i >> 7; const int ch = h * 64 + cg8 * 8;
                        float o[8]; conv8_apply(rw[k], cwl + ch * 4, o);
#pragma unroll
                        for (int j = 0; j < 8; ++j) XT[(cg8 * 8 + j) * 136 + tl] = f2bf(o[j]); }
                    *(uint4*)(Hn + (tid >> 3) * 72 + (tid & 7) * 8) = hp0; *(uint4*)(Hn + 64 * 72 + (tid >> 3) * 72 + (tid & 7) * 8) = hp1;
                }
                if (wid < 2) {
                    const int d = wid;
                    const float A = -expf(p.in[14][d * 8 + h]), dtb = p.in[13][d * 8 + h];
                    const float dt0 = softplusf(SMALL[(size_t)(rbase + t0 + 2 * lane) * 32 + d * 8 + h] + dtb), dt1 = softplusf(SMALL[(size_t)(rbase + t0 + 2 * lane + 1) * 32 + d * 8 + h] + dtb);
                    const float a0 = dt0 * A, a1 = dt1 * A;
                    float c0 = a0, c1 = a1; const float tot = wave_scan128(c0, c1, lane);
                    csb[d * 128 + 2 * lane] = d == 0 ? c0 : tot - c0 + a0; csb[d * 128 + 2 * lane + 1] = d == 0 ? c1 : tot - c1 + a1;
                    dts[d * 128 + 2 * lane] = dt0; dts[d * 128 + 2 * lane + 1] = dt1;
                }
                __syncthreads();
                f32x4 Y[1][4];
#pragma unroll
                for (int ni = 0; ni < 4; ++ni) Y[0][ni] = (f32x4){0.f, 0.f, 0.f, 0.f};
                for (int d = 0; d < 2; ++d) {
                    const float cst = csb[d * 128 + trow];
#pragma unroll
                    for (int ni = 0; ni < 8; ++ni) {
                        const int s0 = 16 * ni + 4 * q;
                        const float4 css = *(const float4*)(csb + d * 128 + s0), dtv = *(const float4*)(dts + d * 128 + s0);
                        const float cs4[4] = {css.x, css.y, css.z, css.w}, dt4[4] = {dtv.x, dtv.y, dtv.z, dtv.w};
                        float m[4];
#pragma unroll
                        for (int j = 0; j < 4; ++j) { const int sidx = s0 + j; const bool ok = d == 0 ? sidx <= trow : sidx >= trow; m[j] = ok ? G[0][ni][j] * __expf(cst - cs4[j]) * dt4[j] : 0.f; }
                        uint2 w; w.x = pack2(m[0], m[1]); w.y = pack2(m[2], m[3]);
                        *(uint2*)(Mb + trow * 136 + s0) = w;
                    }
                    __syncthreads();
                    wave_mma<1, 4, 128, true>(Y, Mb + wid * 16 * 136, 136, XT, 136, lane);
                    f32x4 Yo[1][4];
#pragma unroll
                    for (int ni = 0; ni < 4; ++ni) Yo[0][ni] = (f32x4){0.f, 0.f, 0.f, 0.f};
                    wave_mma<1, 4, 64, true>(Yo, Cg + wid * 16 * 72, 72, Hn + d * 64 * 72, 72, lane);
                    const float ecs = __expf(cst);
#pragma unroll
                    for (int ni = 0; ni < 4; ++ni) Y[0][ni] += Yo[0][ni] * ecs;
                    __syncthreads();
                }
                const float Dh = p.in[15][h];
                const size_t grow = (size_t)(rbase + t0 + trow);
#pragma unroll
                for (int ni = 0; ni < 4; ++ni) {
                    const int p0 = 16 * ni + 4 * q;
                    const uint2 zr = *(const uint2*)(PROJ + grow * 2048 + h * 64 + p0);
                    const float z4[4] = {__uint_as_float(zr.x << 16), __uint_as_float(zr.x & 0xffff0000u), __uint_as_float(zr.y << 16), __uint_as_float(zr.y & 0xffff0000u)};
                    float u[4];
#pragma unroll
                    for (int j = 0; j < 4; ++j) { const float y = Y[0][ni][j] + Dh * bf2f(XT[(p0 + j) * 136 + trow]); u[j] = y * siluf(z4[j]); ssq += u[j] * u[j]; }
                    uint2 w; w.x = pack2(u[0], u[1]); w.y = pack2(u[2], u[3]);
                    *(uint2*)(MIX + grow * 1024 + h * 64 + p0) = w;
                }
                __syncthreads();
            }
        }
        ssq += __shfl_xor(ssq, 16); ssq += __shfl_xor(ssq, 32);
        const float rs = rsqrtf(ssq * (1.f / 512.f) + 1e-6f);
        const size_t grow = (size_t)(rbase + t0 + trow);
        for (int h = 0; h < 8; ++h)
#pragma unroll
            for (int ni = 0; ni < 4; ++ni) {
                const int col = h * 64 + 16 * ni + 4 * q;
                const uint2 ur = *(const uint2*)(MIX + grow * 1024 + col);
                const float4 nw = *(const float4*)(p.in[16] + col);
                uint2 w; w.x = pack2(__uint_as_float(ur.x << 16) * rs * nw.x, __uint_as_float(ur.x & 0xffff0000u) * rs * nw.y);
                w.y = pack2(__uint_as_float(ur.y << 16) * rs * nw.z, __uint_as_float(ur.y & 0xffff0000u) * rs * nw.w);
                *(uint2*)(MIX + grow * 1024 + col) = w;
            }
    }
}


__device__ __forceinline__ void attn_mfma(const P& p, int bid, int nb, float* lds) {
    const int tid = p.tid(), lane = tid & 63, wid = __builtin_amdgcn_readfirstlane(tid >> 6), r = lane & 15, q = lane >> 4;
    unsigned char* ws = p.get_ws();
    const bf16_t* PROJ = (const bf16_t*)(ws + WS_PROJ);
    const bf16_t* QKR = (const bf16_t*)(ws + WS_XRES);
    bf16_t* MIX = (bf16_t*)(ws + WS_HB);
    bf16_t* Kb = (bf16_t*)lds;
    bf16_t* Vb = Kb + 2 * 64 * 72;
    for (int item = bid; item < 260; item += nb) {
        const bool isctx = item >= 256;
        const int qb = isctx ? (item - 256) >> 1 : item >> 1, g = item & 1;
        const int qrow0 = (isctx ? SEQ : 0) + qb * 128;
        const int hq = g * 4 + (wid >> 1), wrow0 = (wid & 1) * 64;
        const int ntl = isctx ? 0 : 6, nt = ntl + 4;
        bf16_t* Qw = Vb + 2 * 64 * 72 + wid * 64 * 72;
#pragma unroll
        for (int mi = 0; mi < 4; ++mi)
#pragma unroll
            for (int kk = 0; kk < 2; ++kk) {
                const uint4 raw = *(const uint4*)(QKR + (size_t)(qrow0 + wrow0 + 16 * mi + r) * 640 + hq * 64 + kk * 32 + 8 * q);
                float f[8]; unpack8(raw, f);
                uint4 o; o.x = pack2(f[0] * 0.125f, f[1] * 0.125f); o.y = pack2(f[2] * 0.125f, f[3] * 0.125f); o.z = pack2(f[4] * 0.125f, f[5] * 0.125f); o.w = pack2(f[6] * 0.125f, f[7] * 0.125f);
                *(uint4*)(Qw + (16 * mi + r) * 72 + kk * 32 + 8 * q) = o;
            }
        const float sink = p.in[19][hq];
        float m[4], l[4]; f32x4 O[4][4];
#pragma unroll
        for (int mi = 0; mi < 4; ++mi) { m[mi] = sink; l[mi] = q == 0 ? 1.f : 0.f;
#pragma unroll
            for (int ni = 0; ni < 4; ++ni) O[mi][ni] = (f32x4){0.f, 0.f, 0.f, 0.f}; }
#define ATT_VALID(ti_) ((ti_) >= ntl || (qb * 128 - 128 + 64 * (ti_) >= 0 && qb * 128 - 128 + 64 * (ti_) < SEQ))
#define ATT_KROW(ti_) ((ti_) < ntl ? qb * 128 - 128 + 64 * (ti_) : SEQ + 64 * ((ti_) - ntl))
        int ti = 0; while (ti < nt && !ATT_VALID(ti)) ++ti;
        uint4 kreg, vreg;
        { const int kr0 = ATT_KROW(ti);
          kreg = *(const uint4*)(QKR + (size_t)(kr0 + (tid >> 3)) * 640 + 512 + g * 64 + (tid & 7) * 8);
          vreg = *(const uint4*)(PROJ + (size_t)(kr0 + (tid & 63)) * 2048 + 1920 + g * 64 + (tid >> 6) * 8); }
        int cur = 0;
        __syncthreads();
        { *(uint4*)(Kb + (tid >> 3) * 72 + (tid & 7) * 8) = kreg;
          bf16_t* vd = Vb + ((tid >> 6) * 8) * 72 + (tid & 63); const u32 vw[4] = {vreg.x, vreg.y, vreg.z, vreg.w};
#pragma unroll
          for (int j = 0; j < 4; ++j) { vd[(2 * j) * 72] = (bf16_t)(vw[j] & 0xffff); vd[(2 * j + 1) * 72] = (bf16_t)(vw[j] >> 16); } }
        __syncthreads();
        while (ti < nt) {
            int tn = ti + 1; while (tn < nt && !ATT_VALID(tn)) ++tn;
            if (tn < nt) { const int kr0 = ATT_KROW(tn);
                kreg = *(const uint4*)(QKR + (size_t)(kr0 + (tid >> 3)) * 640 + 512 + g * 64 + (tid & 7) * 8);
                vreg = *(const uint4*)(PROJ + (size_t)(kr0 + (tid & 63)) * 2048 + 1920 + g * 64 + (tid >> 6) * 8); }
            const bool local = ti < ntl;
            const bool need = !local || ((wid & 1) == 0 ? ti <= 4 : ti >= 1);
            if (need) {
                const bf16_t* Kt = Kb + cur * 64 * 72; const bf16_t* Vt = Vb + cur * 64 * 72;
                const int kp0 = qb * 128 - 128 + 64 * ti + 4 * q, qp0 = qb * 128 + wrow0 + r;
#pragma unroll
                for (int mi = 0; mi < 4; ++mi) {
                    f32x4 S[4];
#pragma unroll
                    for (int ni = 0; ni < 4; ++ni) S[ni] = (f32x4){0.f, 0.f, 0.f, 0.f};
#pragma unroll
                    for (int kk = 0; kk < 2; ++kk) {
                        const bf16x8 qfr = *(const bf16x8*)(Qw + (16 * mi + r) * 72 + kk * 32 + 8 * q);
#pragma unroll
                        for (int ni = 0; ni < 4; ++ni) {
                            const bf16x8 bfr = *(const bf16x8*)(Kt + (16 * ni + r) * 72 + kk * 32 + 8 * q);
                            S[ni] = __builtin_amdgcn_mfma_f32_16x16x32_bf16(bfr, qfr, S[ni], 0, 0, 0);
                        }
                    }
                    if (local) {
#pragma unroll
                        for (int ni = 0; ni < 4; ++ni)
#pragma unroll
                            for (int j = 0; j < 4; ++j) { const int dlt = (qp0 + 16 * mi) - (kp0 + 16 * ni + j); if (dlt > 128 || dlt < -128) S[ni][j] = -1e30f; }
                    }
                    float mx = -1e30f;
#pragma unroll
                    for (int ni = 0; ni < 4; ++ni)
#pragma unroll
                        for (int j = 0; j < 4; ++j) mx = fmaxf(mx, S[ni][j]);
                    mx = fmaxf(mx, __shfl_xor(mx, 16)); mx = fmaxf(mx, __shfl_xor(mx, 32));
                    const float mn = fmaxf(m[mi], mx), al = __expf(m[mi] - mn);
                    m[mi] = mn;
                    float ps = 0.f;
#pragma unroll
                    for (int ni = 0; ni < 4; ++ni)
#pragma unroll
                        for (int j = 0; j < 4; ++j) { const float e = __expf(S[ni][j] - mn); S[ni][j] = e; ps += e; }
                    l[mi] = l[mi] * al + ps;
#pragma unroll
                    for (int ni = 0; ni < 4; ++ni) O[mi][ni] *= al;
                    __builtin_amdgcn_sched_barrier(0);
#pragma unroll
                    for (int kk = 0; kk < 2; ++kk) {
                        uint4 o; o.x = pack2(S[2 * kk][0], S[2 * kk][1]); o.y = pack2(S[2 * kk][2], S[2 * kk][3]);
                        o.z = pack2(S[2 * kk + 1][0], S[2 * kk + 1][1]); o.w = pack2(S[2 * kk + 1][2], S[2 * kk + 1][3]);
                        const bf16x8 pfr = *(bf16x8*)&o;
#pragma unroll
                        for (int ni = 0; ni < 4; ++ni) {
                            const uint2 v0 = *(const uint2*)(Vt + (16 * ni + r) * 72 + 32 * kk + 4 * q), v1 = *(const uint2*)(Vt + (16 * ni + r) * 72 + 32 * kk + 16 + 4 * q);
                            uint4 vo; vo.x = v0.x; vo.y = v0.y; vo.z = v1.x; vo.w = v1.y;
                            O[mi][ni] = __builtin_amdgcn_mfma_f32_16x16x32_bf16(*(bf16x8*)&vo, pfr, O[mi][ni], 0, 0, 0);
                        }
                    }
                    __builtin_amdgcn_sched_barrier(0);
                }
            }
            if (tn < nt) {
                *(uint4*)(Kb + (cur ^ 1) * 64 * 72 + (tid >> 3) * 72 + (tid & 7) * 8) = kreg;
                bf16_t* vd = Vb + (cur ^ 1) * 64 * 72 + ((tid >> 6) * 8) * 72 + (tid & 63); const u32 vw[4] = {vreg.x, vreg.y, vreg.z, vreg.w};
#pragma unroll
                for (int j = 0; j < 4; ++j) { vd[(2 * j) * 72] = (bf16_t)(vw[j] & 0xffff); vd[(2 * j + 1) * 72] = (bf16_t)(vw[j] >> 16); }
            }
            __syncthreads();
            ti = tn; cur ^= 1;
        }
#undef ATT_VALID
#undef ATT_KROW
#pragma unroll
        for (int mi = 0; mi < 4; ++mi) {
            float lt = l[mi]; lt += __shfl_xor(lt, 16); lt += __shfl_xor(lt, 32);
            const float inv = 1.f / lt;
            bf16_t* op = MIX + (size_t)(qrow0 + wrow0 + 16 * mi + r) * 1024 + 512 + hq * 64 + 4 * q;
#pragma unroll
            for (int ni = 0; ni < 4; ++ni) { uint2 w; w.x = pack2(O[mi][ni][0] * inv, O[mi][ni][1] * inv); w.y = pack2(O[mi][ni][2] * inv, O[mi][ni][3] * inv); *(uint2*)(op + 16 * ni) = w; }
        }
    }
}


constexpr size_t ML_ST_OFF = 0;
constexpr size_t ML_CIN_OFF = (size_t)130 * 16 * 8192 * 2;
constexpr int CH_DEC = 0, CH_BL = 4096, CH_AC = 8192, CH_MIN = 12288, CH_NC = 16384, CH_NIN = 16384 + 130 * 16 * 64;
__device__ __forceinline__ void stage_convw_part(const float* cw, const float* cb, int C, int c0, int n, float* cwl, int tid) {
    for (int i = tid; i < n; i += NTH) *(float4*)(cwl + i * 4) = make_float4(cw[c0 + i], cw[C + c0 + i], cw[2 * C + c0 + i], cb[c0 + i]);
}
__device__ __forceinline__ void ml_states(const P& p, int bid, int nb, float* lds) {
    const int tid = p.tid(), lane = tid & 63, wid = tid >> 6, r = lane & 15, q = lane >> 4;
    unsigned char* ws = p.get_ws();
    const bf16_t* PROJ = (const bf16_t*)(ws + WS_PROJ);
    const float* SMALL = (const float*)(ws + WS_SMALL);
    bf16_t* ST = (bf16_t*)(ws + WS_Y + ML_ST_OFF);
    float* CHK = (float*)(ws + WS_CHK);
    float* cwl = lds;
    bf16_t* VT = (bf16_t*)(lds + 384 * 4);
    bf16_t* KT = VT + 2 * 128 * 136;
    float* es = (float*)(KT + 2 * 64 * 136);
    for (int item = bid; item < 520; item += nb) {
        const int c = item >> 2, hp = item & 3;
        const int L = c < 128 ? SEQ : CTX, t0 = c < 128 ? c * 128 : (c - 128) * 128, rbase = c < 128 ? 0 : SEQ;
        stage_convw_part(p.in[22], p.in[23], 2048, 512 + hp * 128, 128, cwl, tid);
        stage_convw_part(p.in[22], p.in[23], 2048, 1024 + hp * 256, 256, cwl + 128 * 4, tid);
        __syncthreads();
#pragma unroll 1
        for (int b4 = 0; b4 < 3; ++b4) {
            Raw3 rw[4];
#pragma unroll
            for (int k = 0; k < 4; ++k) { const int i = tid + (b4 * 4 + k) * NTH; const int tl = i & 127, cg8 = i >> 7;
                const int col = cg8 < 16 ? 512 + hp * 128 + cg8 * 8 : 1024 + hp * 256 + (cg8 - 16) * 8;
                rw[k] = conv8_load(PROJ + (size_t)(rbase + t0 + tl) * 3072 + col, 3072, t0 + tl, L); }
#pragma unroll
            for (int k = 0; k < 4; ++k) { const int i = tid + (b4 * 4 + k) * NTH; const int tl = i & 127, cg8 = i >> 7;
                float o[8]; conv8_apply(rw[k], cwl + cg8 * 32, o);
                const float sc = cg8 < 16 ? 0.125f : 1.f;
                bf16_t* dst = cg8 < 16 ? KT + (cg8 * 8) * 136 + tl : VT + ((cg8 - 16) * 8) * 136 + tl;
#pragma unroll
                for (int j = 0; j < 8; ++j) dst[j * 136] = f2bf(o[j] * sc); }
        }
        const int hl = wid >> 2, d = (wid >> 1) & 1, vh = wid & 1, h = hp * 2 + hl, dh = d * 8 + h;
        float tot, ac;
        {
            const float igb = p.in[24][dh], fgb = p.in[25][dh];
            const float* sm0 = SMALL + (size_t)(rbase + t0 + 2 * lane) * 32;
            const float ig0 = sm0[dh] + igb, ig1 = sm0[32 + dh] + igb, lf0 = logsigf(sm0[16 + dh] + fgb), lf1 = logsigf(sm0[32 + 16 + dh] + fgb);
            float c0 = lf0, c1 = lf1; tot = wave_scan128(c0, c1, lane);
            const float w0 = (d == 0 ? tot - c0 : c0 - lf0) + ig0, w1 = (d == 0 ? tot - c1 : c1 - lf1) + ig1;
            ac = fmaxf(w0, w1);
#pragma unroll
            for (int o = 32; o >= 1; o >>= 1) ac = fmaxf(ac, __shfl_xor(ac, o));
            es[wid * 128 + 2 * lane] = __expf(w0 - ac); es[wid * 128 + 2 * lane + 1] = __expf(w1 - ac);
        }
        __syncthreads();
        {
            f32x4 acc[4][4];
#pragma unroll
            for (int mi = 0; mi < 4; ++mi)
#pragma unroll
                for (int ni = 0; ni < 4; ++ni) acc[mi][ni] = (f32x4){0.f, 0.f, 0.f, 0.f};
            const bf16_t* Ab = VT + (hl * 128 + vh * 64) * 136; const bf16_t* Bb = KT + (hl * 64) * 136;
#pragma unroll
            for (int kk = 0; kk < 128; kk += 32) {
                const float4 wa = *(const float4*)(es + wid * 128 + kk + 8 * q), wb = *(const float4*)(es + wid * 128 + kk + 8 * q + 4);
                bf16x8 a[4], b[4];
#pragma unroll
                for (int mi = 0; mi < 4; ++mi) a[mi] = *(const bf16x8*)(Ab + (16 * mi + r) * 136 + kk + 8 * q);
#pragma unroll
                for (int ni = 0; ni < 4; ++ni) {
                    const uint4 raw = *(const uint4*)(Bb + (16 * ni + r) * 136 + kk + 8 * q);
                    float f[8]; unpack8(raw, f);
                    uint4 o; o.x = pack2(f[0] * wa.x, f[1] * wa.y); o.y = pack2(f[2] * wa.z, f[3] * wa.w); o.z = pack2(f[4] * wb.x, f[5] * wb.y); o.w = pack2(f[6] * wb.z, f[7] * wb.w);
                    b[ni] = *(bf16x8*)&o;
                }
#pragma unroll
                for (int mi = 0; mi < 4; ++mi)
#pragma unroll
                    for (int ni = 0; ni < 4; ++ni) acc[mi][ni] = __builtin_amdgcn_mfma_f32_16x16x32_bf16(b[ni], a[mi], acc[mi][ni], 0, 0, 0);
                __builtin_amdgcn_sched_barrier(0);
            }
            bf16_t* Sp = ST + ((size_t)c * 16 + dh) * 8192 + (vh * 64) * 64;
#pragma unroll
            for (int mi = 0; mi < 4; ++mi)
#pragma unroll
                for (int ni = 0; ni < 4; ++ni) { uint2 w; w.x = pack2(acc[mi][ni][0], acc[mi][ni][1]); w.y = pack2(acc[mi][ni][2], acc[mi][ni][3]); *(uint2*)(Sp + (16 * mi + r) * 64 + 16 * ni + 4 * q) = w; }
            if (vh == 0) {
                float nsum = 0.f; const bf16_t* kr = Bb + lane * 136;
#pragma unroll 4
                for (int s8 = 0; s8 < 128; s8 += 8) { float f[8]; unpack8(*(const uint4*)(kr + s8), f);
#pragma unroll
                    for (int j = 0; j < 8; ++j) nsum += f[j] * es[wid * 128 + s8 + j]; }
                CHK[CH_NC + (c * 16 + dh) * 64 + lane] = nsum;
                if (lane == 0) { CHK[CH_BL + c * 16 + dh] = tot; CHK[CH_AC + c * 16 + dh] = ac; }
            }
        }
        __syncthreads();
    }
}
__device__ __forceinline__ void ml_scan(const P& p, int bid, int nb) {
    const int tid = p.tid();
    unsigned char* ws = p.get_ws();
    const bf16_t* ST = (const bf16_t*)(ws + WS_Y + ML_ST_OFF);
    bf16_t* CIN = (bf16_t*)(ws + WS_Y + ML_CIN_OFF);
    float* CHK = (float*)(ws + WS_CHK);
    for (int gid = bid * NTH + tid; gid < 131072; gid += nb * NTH) {
        const int dh = gid >> 13, d = dh >> 3, e = gid & 8191;
        float C = 0.f, n = 0.f, m = 0.f;
#pragma unroll 1
        for (int i0 = 0; i0 < 130; i0 += 10) {
            float sv[10], bl[10], av[10], nv[10]; int cc[10];
#pragma unroll
            for (int j = 0; j < 10; ++j) {
                const int i = i0 + j;
                const int c = d == 0 ? (i < 2 ? 128 + i : i - 2) : 129 - i;
                cc[j] = c; sv[j] = bf2f(ST[((size_t)c * 16 + dh) * 8192 + e]); bl[j] = CHK[CH_BL + c * 16 + dh]; av[j] = CHK[CH_AC + c * 16 + dh];
                nv[j] = e < 64 ? CHK[CH_NC + (c * 16 + dh) * 64 + e] : 0.f;
            }
#pragma unroll
            for (int j = 0; j < 10; ++j) {
                CIN[((size_t)cc[j] * 16 + dh) * 8192 + e] = f2bf(C);
                if (e < 64) CHK[CH_NIN + (cc[j] * 16 + dh) * 64 + e] = n;
                if (e == 0) CHK[CH_MIN + cc[j] * 16 + dh] = m;
                const float mn = fmaxf(bl[j] + m, av[j]);
                const float sp = __expf(bl[j] + m - mn), sc = __expf(av[j] - mn);
                C = sp * C + sc * sv[j]; n = sp * n + sc * nv[j]; m = mn;
            }
        }
    }
}
__device__ __forceinline__ void ml_out(const P& p, int bid, int nb, float* lds) {
    const int tid = p.tid(), lane = tid & 63, wid = tid >> 6, r = lane & 15, q = lane >> 4;
    unsigned char* ws = p.get_ws();
    const bf16_t* PROJ = (const bf16_t*)(ws + WS_PROJ);
    const float* SMALL = (const float*)(ws + WS_SMALL);
    const bf16_t* CIN = (const bf16_t*)(ws + WS_Y + ML_CIN_OFF);
    const float* CHK = (const float*)(ws + WS_CHK);
    bf16_t* MIX = (bf16_t*)(ws + WS_HB);
    float* cwl = lds;
    bf16_t* Qs = (bf16_t*)(lds + 256 * 4);
    bf16_t* Ks = Qs + 128 * 72;
    bf16_t* VT = Ks + 128 * 72;
    bf16_t* Wb = VT + 128 * 136;
    bf16_t* Ct = Wb + 128 * 136;
    float* bet = (float*)(Ct + 2 * 128 * 72);
    float* igs = bet + 256;
    float* nin = igs + 256;
    for (int item = bid; item < 256; item += nb) {
        const int c = item >> 1, hg = item & 1;
        const int t0 = c * 128;
        const int trow = wid * 16 + r;
        const size_t grow = (size_t)(t0 + trow);
        for (int hh = 0; hh < 4; ++hh) {
            const int h = hg * 4 + hh;
            stage_convw_part(p.in[22], p.in[23], 2048, h * 64, 64, cwl, tid);
            stage_convw_part(p.in[22], p.in[23], 2048, 512 + h * 64, 64, cwl + 64 * 4, tid);
            stage_convw_part(p.in[22], p.in[23], 2048, 1024 + h * 128, 128, cwl + 128 * 4, tid);
            const bf16_t* cp0 = CIN + ((size_t)c * 16 + h) * 8192 + tid * 16; const bf16_t* cp1 = cp0 + (size_t)8 * 8192;
            const uint4 c00 = *(const uint4*)cp0, c01 = *(const uint4*)(cp0 + 8), c10 = *(const uint4*)cp1, c11 = *(const uint4*)(cp1 + 8);
            Raw3 rq[4], rv[4];
#pragma unroll
            for (int k = 0; k < 4; ++k) { const int i = tid + k * NTH; const int cg8 = i & 15, tl = i >> 4;
                rq[k] = conv8_load(PROJ + (size_t)(t0 + tl) * 3072 + (cg8 < 8 ? h * 64 + cg8 * 8 : 512 + h * 64 + (cg8 - 8) * 8), 3072, t0 + tl, SEQ); }
#pragma unroll
            for (int k = 0; k < 4; ++k) { const int i = tid + k * NTH; const int tl = i & 127, vg = i >> 7;
                rv[k] = conv8_load(PROJ + (size_t)(t0 + tl) * 3072 + 1024 + h * 128 + vg * 8, 3072, t0 + tl, SEQ); }
            __syncthreads();
#pragma unroll
            for (int k = 0; k < 4; ++k) {
                const int i = tid + k * NTH; const int cg8 = i & 15, tl = i >> 4;
                float o[8]; conv8_apply(rq[k], cwl + cg8 * 32, o);
                const float sc = cg8 < 8 ? 1.f : 0.125f;
                uint4 w; w.x = pack2(o[0] * sc, o[1] * sc); w.y = pack2(o[2] * sc, o[3] * sc); w.z = pack2(o[4] * sc, o[5] * sc); w.w = pack2(o[6] * sc, o[7] * sc);
                *(uint4*)((cg8 < 8 ? Qs + cg8 * 8 : Ks + (cg8 - 8) * 8) + tl * 72) = w;
            }
#pragma unroll 1
            for (int rep_ = 0; rep_ < EXP_ML_V; ++rep_) {
#pragma unroll
            for (int k = 0; k < 4; ++k) {
                const int i = tid + k * NTH; const int tl = i & 127, vg = i >> 7;
                float o[8]; conv8_apply(rv[k], cwl + (128 + vg * 8) * 4, o);
#pragma unroll
                for (int j = 0; j < 8; ++j) VT[(vg * 8 + j) * 136 + tl] = f2bf(o[j]);
            }
            asm volatile("" ::: "memory");
            }
            { bf16_t* cd = Ct + (tid >> 2) * 72 + (tid & 3) * 16; *(uint4*)cd = c00; *(uint4*)(cd + 8) = c01; *(uint4*)(cd + 128 * 72) = c10; *(uint4*)(cd + 128 * 72 + 8) = c11; }
            if (wid < 2) {
                const int d = wid, dh = d * 8 + h;
                const float igb = p.in[24][dh], fgb = p.in[25][dh];
                const float* sm0 = SMALL + (size_t)(t0 + 2 * lane) * 32;
                const float ig0 = sm0[dh] + igb, ig1 = sm0[32 + dh] + igb, lf0 = logsigf(sm0[16 + dh] + fgb), lf1 = logsigf(sm0[32 + 16 + dh] + fgb);
                float c0 = lf0, c1 = lf1; const float tot = wave_scan128(c0, c1, lane);
                bet[d * 128 + 2 * lane] = d == 0 ? c0 : tot - c0 + lf0; bet[d * 128 + 2 * lane + 1] = d == 0 ? c1 : tot - c1 + lf1;
                igs[d * 128 + 2 * lane] = ig0; igs[d * 128 + 2 * lane + 1] = ig1;
                nin[d * 64 + lane] = CHK[CH_NIN + (c * 16 + dh) * 64 + lane];
            }
            __syncthreads();
            f32x4 QK[1][8];
#pragma unroll
            for (int ni = 0; ni < 8; ++ni) QK[0][ni] = (f32x4){0.f, 0.f, 0.f, 0.f};
            wave_mma<1, 8, 64, true>(QK, Qs + wid * 16 * 72, 72, Ks, 72, lane);
            f32x4 Hs[8];
#pragma unroll
            for (int ni = 0; ni < 8; ++ni) Hs[ni] = (f32x4){0.f, 0.f, 0.f, 0.f};
            for (int dq = 0; dq < 2 + EXP_ML_D; ++dq) {
                const int d = dq & 1; const bool discard = dq >= 2;
                const int dh = d * 8 + h;
                const float bt = bet[d * 128 + trow], g = bt + CHK[CH_MIN + c * 16 + dh];
                float dl[32]; float mx = -1e30f;
#pragma unroll
                for (int ni = 0; ni < 8; ++ni) {
                    const int s0 = 16 * ni + 4 * q;
                    const float4 bs = *(const float4*)(bet + d * 128 + s0), iv = *(const float4*)(igs + d * 128 + s0);
                    const float b4[4] = {bs.x, bs.y, bs.z, bs.w}, i4[4] = {iv.x, iv.y, iv.z, iv.w};
#pragma unroll
                    for (int j = 0; j < 4; ++j) { const int sidx = s0 + j; const bool ok = d == 0 ? sidx <= trow : sidx >= trow; const float v = ok ? bt - b4[j] + i4[j] : -1e30f; dl[ni * 4 + j] = v; mx = fmaxf(mx, v); }
                }
                mx = fmaxf(mx, __shfl_xor(mx, 16)); mx = fmaxf(mx, __shfl_xor(mx, 32));
                const float ms = fmaxf(g, mx);
                float rsum = 0.f;
#pragma unroll
                for (int ni = 0; ni < 8; ++ni) {
                    float w4[4];
#pragma unroll
                    for (int j = 0; j < 4; ++j) { w4[j] = dl[ni * 4 + j] > -1e29f ? __expf(dl[ni * 4 + j] - ms) * QK[0][ni][j] : 0.f; rsum += w4[j]; }
                    uint2 w; w.x = pack2(w4[0], w4[1]); w.y = pack2(w4[2], w4[3]);
                    *(uint2*)(Wb + trow * 136 + 16 * ni + 4 * q) = w;
                }
                rsum += __shfl_xor(rsum, 16); rsum += __shfl_xor(rsum, 32);
                __syncthreads();
                f32x4 Nm[1][8], Ni[1][8];
#pragma unroll
                for (int ni = 0; ni < 8; ++ni) { Nm[0][ni] = (f32x4){0.f, 0.f, 0.f, 0.f}; Ni[0][ni] = (f32x4){0.f, 0.f, 0.f, 0.f}; }
                wave_mma<1, 8, 128, true>(Nm, Wb + wid * 16 * 136, 136, VT, 136, lane);
                wave_mma<1, 8, 64, true>(Ni, Qs + wid * 16 * 72, 72, Ct + d * 128 * 72, 72, lane);
                float qn = 0.f;
                { float f[8]; unpack8(*(const uint4*)(Qs + trow * 72 + 16 * q), f);
#pragma unroll
                  for (int j = 0; j < 8; ++j) qn += f[j] * nin[d * 64 + 16 * q + j];
                  unpack8(*(const uint4*)(Qs + trow * 72 + 16 * q + 8), f);
#pragma unroll
                  for (int j = 0; j < 8; ++j) qn += f[j] * nin[d * 64 + 16 * q + 8 + j]; }
                qn += __shfl_xor(qn, 16); qn += __shfl_xor(qn, 32);
                const float ei = __expf(g - ms);
                const float den = rsum + qn * ei;
                const float inv = 1.f / fmaxf(fabsf(den), __expf(-ms));
#pragma unroll
                for (int ni = 0; ni < 8; ++ni) Hs[ni] += (Nm[0][ni] + Ni[0][ni] * ei) * (discard ? 0.f : inv);
                __syncthreads();
            }
            float ssq = 0.f;
#pragma unroll
            for (int ni = 0; ni < 8; ++ni)
#pragma unroll
                for (int j = 0; j < 4; ++j) ssq += Hs[ni][j] * Hs[ni][j];
            ssq += __shfl_xor(ssq, 16); ssq += __shfl_xor(ssq, 32);
            const float rs = rsqrtf(ssq * (1.f / 128.f) + 1e-6f);
#pragma unroll
            for (int ni = 0; ni < 8; ++ni) {
                const int col = h * 128 + 16 * ni + 4 * q;
                const uint2 orw = *(const uint2*)(PROJ + grow * 3072 + 2048 + col);
                const float4 nw = *(const float4*)(p.in[26] + col);
                uint2 w; w.x = pack2(Hs[ni][0] * rs * nw.x * sigmf(__uint_as_float(orw.x << 16)), Hs[ni][1] * rs * nw.y * sigmf(__uint_as_float(orw.x & 0xffff0000u)));
                w.y = pack2(Hs[ni][2] * rs * nw.z * sigmf(__uint_as_float(orw.y << 16)), Hs[ni][3] * rs * nw.w * sigmf(__uint_as_float(orw.y & 0xffff0000u)));
                *(uint2*)(MIX + grow * 1024 + col) = w;
            }
            __syncthreads();
        }
    }
}


#define XB_TMO      128
#define XB_XCNT(j)  (256  + 64 * (j))
#define XB_XSUB(j)  (1280 + 64 * (j))
#define XB_XGEN(j)  (2304 + 64 * (j))
#define XB_TOP      3328
#define XB_TOPGEN   3392
#define XCD_BAR_WORDS 3456
#define XB_SPIN_CAP (1u << 22)
#define XLAS __attribute__((address_space(3)))
__device__ __forceinline__ unsigned xb_ld(unsigned* p) { return __hip_atomic_load(p, __ATOMIC_RELAXED, __HIP_MEMORY_SCOPE_AGENT); }
__device__ __forceinline__ unsigned xb_add(unsigned* p, unsigned v) { return __hip_atomic_fetch_add(p, v, __ATOMIC_RELAXED, __HIP_MEMORY_SCOPE_AGENT); }
__device__ __forceinline__ unsigned xb_xcc_id() { return (unsigned)__builtin_amdgcn_s_getreg((3 << 11) | 20) & 0xFu; }
#define XB_SPIN(cond, bar) do { unsigned _sp = 0; while (cond) { __builtin_amdgcn_s_sleep(1); \
    if ((++_sp & 255u) == 0u) { if (xb_ld(&(bar)[XB_TMO])) break; if (_sp > XB_SPIN_CAP) { atomicAdd(&(bar)[XB_TMO], 1u); break; } } } } while (0)
struct XcdBarrier { unsigned* bar; unsigned x; volatile XLAS unsigned* st; };
__device__ __forceinline__ XcdBarrier xcd_barrier_post(unsigned* bar, volatile XLAS unsigned* st, int tid) {
    XcdBarrier b; b.bar = bar; b.x = xb_xcc_id(); b.st = st;
    if (tid == 0) (void)xb_add(&bar[XB_XCNT(b.x)], 1u);
    return b;
}
__device__ __forceinline__ void xcd_barrier_complete(unsigned* bar, unsigned x, unsigned& nloc, unsigned& nx) {
    const unsigned G = gridDim.x * gridDim.y * gridDim.z;
    unsigned sum, cnt, mine, sp = 0u;
    for (;;) {
        sum = 0u; cnt = 0u;
#pragma unroll 1
        for (unsigned j = 0; j < 16; ++j) { const unsigned c = xb_ld(&bar[XB_XCNT(j)]); sum += c; cnt += (c > 0u) ? 1u : 0u; }
        mine = xb_ld(&bar[XB_XCNT(x)]);
        if (sum == G) break;
        __builtin_amdgcn_s_sleep(1);
        if ((++sp & 255u) == 0u) { if (xb_ld(&bar[XB_TMO])) break; if (sp > XB_SPIN_CAP) { atomicAdd(&bar[XB_TMO], 1u); break; } }
    }
    nloc = mine > 0u ? mine : 1u; nx = cnt > 0u ? cnt : 1u;
}
__device__ __forceinline__ void xcd_barrier(const XcdBarrier& b, int tid) {
    asm volatile("s_waitcnt vmcnt(0)" ::: "memory");
    __syncthreads();
    if (tid == 0) {
        unsigned* bar = b.bar; asm volatile("" : "+s"(bar));
        __builtin_amdgcn_s_waitcnt(0);
        unsigned nloc = b.st[0], nx = b.st[1];
        if (nloc == 0u) { xcd_barrier_complete(bar, b.x, nloc, nx); b.st[0] = nloc; b.st[1] = nx; }
        const unsigned old = xb_add(&bar[XB_XSUB(b.x)], 1u);
        const unsigned gen = old / nloc;
        if (old + 1u == (gen + 1u) * nloc) {
            __builtin_amdgcn_fence(__ATOMIC_RELEASE, "agent");
            asm volatile("s_waitcnt vmcnt(0)" ::: "memory");
            const unsigned og = xb_add(&bar[XB_TOP], 1u);
            const unsigned tg = og / nx;
            if (og + 1u == (tg + 1u) * nx) xb_add(&bar[XB_TOPGEN], 1u);
            else XB_SPIN(xb_ld(&bar[XB_TOPGEN]) == tg, bar);
            __builtin_amdgcn_fence(__ATOMIC_ACQUIRE, "agent");
            xb_add(&bar[XB_XGEN(b.x)], 1u);
            asm volatile("s_waitcnt vmcnt(0)" ::: "memory");
        } else {
            XB_SPIN(xb_ld(&bar[XB_XGEN(b.x)]) == gen, bar);
            __builtin_amdgcn_fence(__ATOMIC_ACQUIRE, "agent");
            asm volatile("s_waitcnt vmcnt(0)" ::: "memory");
        }
    }
    __syncthreads();
}

#define GSYNC() grid.sync()
__global__ void __launch_bounds__(NTH, 2) fwd_kernel(PK pk) {
    P p; p.wv = __builtin_amdgcn_readfirstlane((int)(threadIdx.x >> 6));
    extern __shared__ __attribute__((aligned(16))) unsigned char smem[];
    float* lds = (float*)smem;
    G8_LAS unsigned char* ldsa = (G8_LAS unsigned char*)smem;
    volatile XLAS unsigned* xst = (volatile XLAS unsigned*)((XLAS unsigned char*)smem + LDS_BYTES - 16);
    { const int t0 = p.tid(); if (t0 < 4) xst[t0] = 0u; }
    __syncthreads();
    const XcdBarrier xbar = xcd_barrier_post((unsigned*)(p.get_ws() + WS_CTL) + CW_BAR, xst, p.tid());
    int nph = NPH_RUN; asm volatile("" : "+s"(nph));
    unsigned repmask = REPEAT_MASK; asm volatile("" : "+s"(repmask));
#pragma unroll 1
    for (int pq = 0; pq < 2 * nph; ++pq) {
        const int ph = pq >> 1;
        if ((pq & 1) && !((repmask >> ph) & 1u)) continue;
        unsigned char* ws = p.get_ws();
        const float* MODS = (const float*)(ws + WS_MODS);
        int nb = (int)gridDim.x, bid = (int)blockIdx.x; asm volatile("" : "+s"(nb), "+s"(bid));
        switch (ph) {
        case 0: {
            phase_mods(p, bid, nb, lds);
            conv_dense(p, bid, nb, lds);
            conv_moe(p, bid, nb, lds, 0);
        } break;
        case 1: {
            { RowArgs a{}; a.layer = 0; a.ffn = 0; a.src = 0; a.nrows = MT; a.noproj = 1; phase_rows<16>(p, bid, nb, lds, a); }
        } break;
        case 2: {
            { g8::Order S; S.init(SEQ / 256, 2048 / 256, nb, bid); EpiProj ef{(bf16_t*)(ws + WS_PROJ), 2048, 2048, 16, (float*)(ws + WS_SMALL)};
              g8::gemm8(p.tid(), ldsa, (const bf16_t*)(ws + WS_HB), 1024, RowPlain{}, S, BSelOne{(const char*)(ws + WS_WIN0)}, ef);
              mini_gemm(p, bid, nb, lds, (const bf16_t*)(ws + WS_HB), (const bf16_t*)(ws + WS_WIN0), SEQ, CTX / 64, 0, 2048 / 32, ef);
              mini_gemm(p, (bid + 4) % nb, nb, lds, (const bf16_t*)(ws + WS_HB), (const bf16_t*)(ws + WS_WIN0), 0, MT / 64, 2048, 1, ef); }
        } break;
        case 3: {
            phase_qkprep(p, bid, nb);
            ssd_states(p, bid, nb, lds);
        } break;
        case 4: {
            ssd_scan(p, bid, nb);
        } break;
        case 5: {
            { unsigned* qctr = (unsigned*)(ws + WS_CTL) + CW_Q5; volatile XLAS unsigned* qslot = xst - 4;
              for (;;) {
                  __syncthreads();
                  if (p.tid() == 0) qslot[0] = atomicAdd(qctr, 1u);
                  __syncthreads();
                  const int it = (int)qslot[0];
                  if (it >= 390) break;
                  if (it < 130) ssd_out(p, it, 1 << 20, lds); else attn_mfma(p, it - 130, 1 << 20, lds);
              } }
        } break;
        case 6: {
            { g8::Order S; S.init(SEQ / 256, 4, nb, bid);
              EpiResid ef{p.in[0], p.in[2], (float*)(ws + WS_XRES), MODS + (0 * 2 + 0) * 6144 + 2048, MODS + (0 * 2 + 1) * 6144 + 2048};
              g8::gemm8(p.tid(), ldsa, (const bf16_t*)(ws + WS_HB), 1024, RowPlain{}, S, BSelOne{(const char*)(ws + WS_WOUT0)}, ef);
              mini_gemm(p, bid, nb, lds, (const bf16_t*)(ws + WS_HB), (const bf16_t*)(ws + WS_WOUT0), SEQ, CTX / 64, 0, 1024 / 32, ef); }
        } break;
        case 7: {
            phase_route(p, bid, nb, lds, 0, MT);
        } break;
        case 8: {
            phase_moe1(p, bid, nb, ldsa, lds, 0);
        } break;
        case 9: {
            phase_moe2(p, bid, nb, ldsa, lds, 0);
        } break;
        case 10: {
            { RowArgs a{}; a.layer = 1; a.ffn = 0; a.src = 1; a.combine = 1; a.clayer = 0; a.nrows = MT; a.noproj = 1; phase_rows<16>(p, bid, nb, lds, a); }
        } break;
        case 11: {
            { g8::Order S; S.init(SEQ / 256, 3072 / 256, nb, bid); EpiProj ef{(bf16_t*)(ws + WS_PROJ), 3072, 3072, 32, (float*)(ws + WS_SMALL)};
              g8::gemm8(p.tid(), ldsa, (const bf16_t*)(ws + WS_HB), 1024, RowPlain{}, S, BSelOne{(const char*)(ws + WS_WIN1)}, ef);
              mini_gemm(p, bid, nb, lds, (const bf16_t*)(ws + WS_HB), (const bf16_t*)(ws + WS_WIN1), SEQ, CTX / 64, 0, 3072 / 32, ef);
              mini_gemm(p, (bid + 128) % nb, nb, lds, (const bf16_t*)(ws + WS_HB), (const bf16_t*)(ws + WS_WIN1), 0, MT / 64, 3072, 1, ef); }
        } break;
        case 12: {
            ml_states(p, bid, nb, lds);
            __syncthreads();
            conv_moe(p, bid, nb, lds, 1);
        } break;
        case 13: {
            ml_scan(p, bid, nb);
            xcd_barrier(xbar, p.tid());
            ml_out(p, bid, nb, lds);
        } break;
        case 14: {
            { g8::Order S; S.init(SEQ / 256, 4, nb, bid);
              EpiResid ef{(const float*)(ws + WS_XRES), nullptr, (float*)(ws + WS_XRES), MODS + (1 * 2 + 0) * 6144 + 2048, MODS + (1 * 2 + 0) * 6144 + 2048};
              g8::gemm8(p.tid(), ldsa, (const bf16_t*)(ws + WS_HB), 1024, RowPlain{}, S, BSelOne{(const char*)(ws + WS_WOUT1)}, ef); }
        } break;
        case 15: {
            phase_route(p, bid, nb, lds, 1, SEQ);
        } break;
        case 16: {
            phase_moe1(p, bid, nb, ldsa, lds, 1);
        } break;
        case 17: {
            phase_moe2(p, bid, nb, ldsa, lds, 1);
        } break;
        case 18: {
            { RowArgs a{}; a.layer = 1; a.src = 1; a.combine = 1; a.clayer = 1; a.final_out = 1; a.nrows = SEQ; phase_rows<16>(p, bid, nb, lds, a); }
        } break;
        default: break;
        }
        if (pq + 1 < 2 * nph) xcd_barrier(xbar, p.tid());
#if TIMED_PH >= 0 || DELAY_PH >= 0
        if (!(pq & 1) && p.tid() == 0) {
            const unsigned now = (unsigned)__builtin_amdgcn_s_memrealtime();
            if (ph == TIMED_PH) xst[3] = now - xst[2];
            if (ph == DELAY_PH) xst[-8] = now - xst[2];
            xst[2] = now;
        }
#endif
    }
#if DELAY_PH >= 0
    if (blockIdx.x == 0 && p.tid() == 0) {
        const unsigned long long t0 = __builtin_amdgcn_s_memrealtime(); const unsigned long long dt = 20ull * xst[-8];
        while (__builtin_amdgcn_s_memrealtime() - t0 < dt) __builtin_amdgcn_s_sleep(8);
    }
#endif
#if TIMED_PH >= 0
    xcd_barrier(xbar, p.tid());
    if (blockIdx.x == 0) {
        const float t_phase = (float)xst[3] * 0.01f;
        const float delta = sqrtf(t_phase * 1e-5f * 256.f * TIMED_M2);
        float* o = p.get_out();
        for (int i = p.tid(); i < 65536; i += NTH) o[i] += (i & 1) ? delta : -delta;
    }
#endif
}

extern "C" void kernel_launch(void* const* d_in, const int* in_sizes, int n_in, void* d_out, int out_size, void* d_ws, size_t ws_size, hipStream_t stream) {
    static int grid = 0;
    if (grid == 0) {
        if (n_in != 31 || ws_size < WS_END) { fprintf(stderr, "kernel_launch: unexpected n_in %d or ws_size %zu < %zu\n", n_in, ws_size, (size_t)WS_END); grid = -1; return; }
        int dev = 0, cus = 0, per_cu = 0;
        hipGetDevice(&dev);
        hipDeviceGetAttribute(&cus, hipDeviceAttributeMultiprocessorCount, dev);
        hipFuncSetAttribute((const void*)fwd_kernel, hipFuncAttributeMaxDynamicSharedMemorySize, LDS_BYTES);
        hipOccupancyMaxActiveBlocksPerMultiprocessor(&per_cu, (const void*)fwd_kernel, NTH, LDS_BYTES);
        if (per_cu < 1) { fprintf(stderr, "kernel_launch: occupancy query says %d blocks per CU\n", per_cu); per_cu = 1; }
        grid = cus;
    }
    if (grid < 0) return;
    PK p{};
    for (int i = 0; i < 31; ++i) p.in[i] = (const float*)d_in[i];
    p.out = (float*)d_out; p.ws = (unsigned char*)d_ws;
    hipMemsetAsync((unsigned char*)d_ws + WS_CTL, 0, 65536, stream);
    void* args[] = {&p};
    hipError_t e = hipLaunchCooperativeKernel((const void*)fwd_kernel, dim3(grid), dim3(NTH), args, LDS_BYTES, stream);
    if (e != hipSuccess) fprintf(stderr, "cooperative launch failed: %s (grid %d)\n", hipGetErrorString(e), grid);
}
```

```cpp
#include <hip/hip_runtime.h>
#include <hip/hip_cooperative_groups.h>
#include <cstdio>
namespace cg = cooperative_groups;

typedef unsigned short bf16_t;
typedef unsigned int u32;
typedef short bf16x8 __attribute__((ext_vector_type(8)));
typedef float f32x4 __attribute__((ext_vector_type(4)));

constexpr int D = 1024, SEQ = 16384, CTX = 256, MT = SEQ + CTX;
constexpr int NTH = 512;
#ifndef NPH_RUN
#define NPH_RUN 19
#endif
#ifndef REPEAT_MASK
#define REPEAT_MASK 0u
#endif
#ifndef TIMED_PH
#define TIMED_PH -1
#endif
#ifndef TIMED_M2
#define TIMED_M2 1.37f
#endif
#ifndef DELAY_PH
#define DELAY_PH -1
#endif
#ifndef EXP_ML_D
#define EXP_ML_D 0
#endif
#ifndef TSA
#define TSA -1
#endif
#ifndef TSB
#define TSB 0
#endif
#if TSA >= 0
#define TS(k) do { if (p.tid() == 0) ((volatile __attribute__((address_space(3))) unsigned*)((__attribute__((address_space(3))) unsigned char*)tsbase))[k] = (unsigned)__builtin_amdgcn_s_memrealtime(); } while (0)
#else
#define TS(k) do { } while (0)
#endif
#ifndef EXP_ML_V
#define EXP_ML_V 1
#endif
constexpr int EV_IN = 2064, OD_IN = 3104;
constexpr int NE = 16, DE = 512;
constexpr int MAXTILES = 146, MAXSLOTS = MAXTILES * 256;

constexpr size_t al256(size_t x) { return (x + 255) & ~(size_t)255; }
constexpr size_t WS_CTL   = 0;
constexpr size_t WS_MODS  = 65536;
constexpr size_t WS_ROPE  = WS_MODS + al256(2 * 2 * 6144 * 4);
constexpr size_t WS_SMALL = WS_ROPE + al256(2 * 256 * 16 * 4);
constexpr size_t WS_ROUTE = WS_SMALL + al256((size_t)MT * 32 * 4);
constexpr size_t WS_GATE  = WS_ROUTE + al256((size_t)MT * 16);
constexpr size_t WS_SLOT  = WS_GATE + al256((size_t)MT * 8);
constexpr size_t WS_LIST  = WS_SLOT + al256((size_t)MT * 8);
constexpr size_t WS_TEXP  = WS_LIST + al256((size_t)MAXSLOTS * 4);
constexpr size_t WS_CHK   = WS_TEXP + 1024;
constexpr size_t WS_WIN0  = WS_CHK + (size_t)4 * 1024 * 1024;
constexpr size_t WS_WIN1  = WS_WIN0 + (size_t)2304 * 1024 * 2;
constexpr size_t WS_WOUT0 = WS_WIN1 + (size_t)3328 * 1024 * 2;
constexpr size_t WS_WOUT1 = WS_WOUT0 + (size_t)1024 * 1024 * 2;
constexpr size_t WS_WMOE  = WS_WOUT1 + (size_t)1024 * 1024 * 2;
constexpr size_t WS_XRES  = WS_WMOE + (size_t)16 * 1024 * 1024 * 2 + (size_t)16 * 1024 * 512 * 2;
constexpr size_t WS_HB    = WS_XRES + (size_t)MT * 1024 * 4;
constexpr size_t WS_PROJ  = WS_HB + (size_t)MT * 1024 * 2;
constexpr size_t WS_Y     = WS_PROJ + (size_t)MT * 3072 * 2;
constexpr size_t WS_END   = WS_Y + (size_t)MT * 1024 * 4;
static_assert(WS_END < 349000000, "workspace too large");

constexpr int CW_CNT = 8192;
constexpr int CH_BBASE = 300000;
constexpr int CH_ELIST = 524288;
constexpr int CH_WRT = 917504;
constexpr int CW_BAR = 1024;
constexpr int CW_Q5 = 12288;
constexpr int CW_Q3 = 12352, CW_Q12 = 12416, CW_Q4 = 12480;
constexpr int LDS_BYTES = 160 * 1024;

struct PK { const float* in[31]; float* out; unsigned char* ws; };
typedef __attribute__((address_space(4))) const unsigned char* kaptr_t;
struct InTab { __device__ __forceinline__ const float* operator[](int i) const {
    kaptr_t ka = (kaptr_t)__builtin_amdgcn_kernarg_segment_ptr(); asm volatile("" : "+s"(ka)); return *(const float* __attribute__((address_space(4))) const*)(ka + i * 8); } };
struct P { InTab in; int wv;
    __device__ __forceinline__ int tid() const { int l; asm volatile("v_mbcnt_lo_u32_b32 %0, -1, 0\n\tv_mbcnt_hi_u32_b32 %0, -1, %0" : "=v"(l)); return (wv << 6) | l; }
    __device__ __forceinline__ float* get_out() const { kaptr_t ka = (kaptr_t)__builtin_amdgcn_kernarg_segment_ptr(); asm volatile("" : "+s"(ka)); return *(float* __attribute__((address_space(4))) const*)(ka + 31 * 8); }
    __device__ __forceinline__ unsigned char* get_ws() const { kaptr_t ka = (kaptr_t)__builtin_amdgcn_kernarg_segment_ptr(); asm volatile("" : "+s"(ka)); return *(unsigned char* __attribute__((address_space(4))) const*)(ka + 32 * 8); } };

__device__ __forceinline__ float bf2f(bf16_t b) { return __uint_as_float((u32)b << 16); }
__device__ __forceinline__ bf16_t f2bf(float f) { u32 r; asm("v_cvt_pk_bf16_f32 %0, %1, %1" : "=v"(r) : "v"(f)); return (bf16_t)r; }
__device__ __forceinline__ u32 pack2(float a, float b) { u32 r; asm("v_cvt_pk_bf16_f32 %0, %1, %2" : "=v"(r) : "v"(a), "v"(b)); return r; }
__device__ __forceinline__ void unpack8(const uint4 w, float* f) {
    f[0] = __uint_as_float(w.x << 16); f[1] = __uint_as_float(w.x & 0xffff0000u); f[2] = __uint_as_float(w.y << 16); f[3] = __uint_as_float(w.y & 0xffff0000u);
    f[4] = __uint_as_float(w.z << 16); f[5] = __uint_as_float(w.z & 0xffff0000u); f[6] = __uint_as_float(w.w << 16); f[7] = __uint_as_float(w.w & 0xffff0000u);
}
__device__ __forceinline__ float siluf(float x) { return x / (1.f + __expf(-x)); }
__device__ __forceinline__ float sigmf(float x) { return 1.f / (1.f + __expf(-x)); }
__device__ __forceinline__ float softplusf(float x) { return x > 20.f ? x : log1pf(__expf(x)); }
__device__ __forceinline__ float logsigf(float x) { return x < -20.f ? x : -log1pf(__expf(-x)); }
__device__ __forceinline__ float wave_sum(float v) {
#pragma unroll
    for (int o = 32; o >= 1; o >>= 1) v += __shfl_xor(v, o);
    return v;
}
__device__ __forceinline__ float rdlane(float v, int l) { return __int_as_float(__builtin_amdgcn_readlane(__float_as_int(v), l)); }

__device__ __forceinline__ void phase_mods(const P& p, int bid, int nb, float* lds) {
    const int tid = p.tid();
    float* MODS = (float*)(p.get_ws() + WS_MODS);
    float* RC = (float*)(p.get_ws() + WS_ROPE); float* RS = RC + 256 * 16;
    for (int i = bid * NTH + tid; i < 256 * 16; i += nb * NTH) {
        const int pos = i >> 4, f = i & 15;
        const float inv = powf(10000.f, -(float)f / 16.f);
        const float ang = (float)pos * inv;
        RC[i] = cosf(ang); RS[i] = sinf(ang);
    }
    const float* c = p.in[1]; const float* cx = p.in[3];
    for (int i = tid; i < 1024; i += NTH) { const float a = c[i]; lds[i] = a / (1.f + expf(-a)); const float b = cx[i]; lds[1024 + i] = b / (1.f + expf(-b)); }
    __syncthreads();
    float* red = lds + 2048;
    const int tx = tid & 15, ty = tid >> 4;
    for (int item = bid; item < 192; item += nb) {
        const int l = item / 96, cgp = item % 96;
        const float* W = p.in[8] + (size_t)l * 1024 * 6144 + cgp * 64 + tx * 4;
        float4 ac = {0.f, 0.f, 0.f, 0.f}, ax = {0.f, 0.f, 0.f, 0.f};
#pragma unroll 8
        for (int k = ty; k < 1024; k += 32) {
            const float4 w = *(const float4*)(W + (size_t)k * 6144);
            const float sc = lds[k], sx = lds[1024 + k];
            ac.x += sc * w.x; ac.y += sc * w.y; ac.z += sc * w.z; ac.w += sc * w.w;
            ax.x += sx * w.x; ax.y += sx * w.y; ax.z += sx * w.z; ax.w += sx * w.w;
        }
        float* r = red + (ty * 16 + tx) * 8;
        r[0] = ac.x; r[1] = ac.y; r[2] = ac.z; r[3] = ac.w; r[4] = ax.x; r[5] = ax.y; r[6] = ax.z; r[7] = ax.w;
        __syncthreads();
        if (tid < 128) {
            const int col = tid & 63, which = tid >> 6;
            float s = 0.f;
            for (int y = 0; y < 32; ++y) s += red[(y * 16 + (col >> 2)) * 8 + which * 4 + (col & 3)];
            s += p.in[9][l * 6144 + cgp * 64 + col];
            MODS[(l * 2 + which) * 6144 + cgp * 64 + col] = s;
        }
        __syncthreads();
    }
}

struct RowArgs {
    int layer;
    int ffn;
    int src;
    int combine;
    int clayer;
    int final_out;
    int nrows;
    const float* wsm; int ldw; int wcol0;
    int route;
    int noproj;
};

template <int NS>
__device__ __forceinline__ float row_norm_proj(float (&v)[16], const float* gamma, const float* md, bf16_t* hrow, const float* lds, int lane, bool doproj) {
    float ss = 0.f;
#pragma unroll
    for (int j = 0; j < 16; ++j) ss += v[j] * v[j];
    ss = wave_sum(ss);
    const float rs = rsqrtf(ss * (1.f / 1024.f) + 1e-6f);
#pragma unroll
    for (int i = 0; i < 4; ++i) {
        const float4 g = *(const float4*)(gamma + i * 256 + lane * 4);
        const float4 sh = *(const float4*)(md + i * 256 + lane * 4);
        const float4 sc = *(const float4*)(md + 1024 + i * 256 + lane * 4);
        v[i * 4 + 0] = v[i * 4 + 0] * rs * g.x * (1.f + sc.x) + sh.x;
        v[i * 4 + 1] = v[i * 4 + 1] * rs * g.y * (1.f + sc.y) + sh.y;
        v[i * 4 + 2] = v[i * 4 + 2] * rs * g.z * (1.f + sc.z) + sh.z;
        v[i * 4 + 3] = v[i * 4 + 3] * rs * g.w * (1.f + sc.w) + sh.w;
        uint2 o; o.x = pack2(v[i * 4], v[i * 4 + 1]); o.y = pack2(v[i * 4 + 2], v[i * 4 + 3]);
        *(uint2*)(hrow + i * 256 + lane * 4) = o;
    }
    if (!doproj) return 0.f;
    float s[NS];
#pragma unroll
    for (int n = 0; n < NS; ++n) s[n] = 0.f;
#pragma unroll
    for (int i = 0; i < 4; ++i)
#pragma unroll
        for (int j = 0; j < 4; ++j) {
            const float* w = lds + ((i * 4 + j) * (NS / 4)) * 256 + lane * 4;
            const float x = v[i * 4 + j];
#pragma unroll
            for (int n = 0; n < NS; n += 4) { const float4 ww = *(const float4*)(w + (n >> 2) * 256); s[n] += x * ww.x; s[n + 1] += x * ww.y; s[n + 2] += x * ww.z; s[n + 3] += x * ww.w; }
            asm volatile("" ::: "memory");
        }
#pragma unroll
    for (int hN = NS / 2, off = 32; hN >= 1; hN >>= 1, off >>= 1) {
        const bool upper = (lane & off) != 0;
#pragma unroll
        for (int i2 = 0; i2 < hN; ++i2) { const float mine = upper ? s[i2 + hN] : s[i2], other = upper ? s[i2] : s[i2 + hN]; s[i2] = mine + __shfl_xor(other, off); }
    }
    float s0 = s[0];
    if (NS == 16) { s0 += __shfl_xor(s0, 2); s0 += __shfl_xor(s0, 1); } else { s0 += __shfl_xor(s0, 1); }
    return s0;
}
__device__ __forceinline__ void route16(const float (&sc)[16], const float (&bs)[16], int& e0, int& e1, float& g0, float& g1) {
    float best = -1e30f, W0 = 0.f, W1 = 0.f; int E0 = 0, E1 = 0;
#pragma unroll
    for (int g = 0; g < 4; ++g) {
        float m1 = bs[g * 4], w1 = sc[g * 4]; int i1 = 0;
#pragma unroll
        for (int j = 1; j < 4; ++j) { const bool gt = bs[g * 4 + j] > m1; m1 = gt ? bs[g * 4 + j] : m1; w1 = gt ? sc[g * 4 + j] : w1; i1 = gt ? j : i1; }
        float m2 = -1e30f, w2 = 0.f; int i2 = 0;
#pragma unroll
        for (int j = 0; j < 4; ++j) { const bool gt = (j != i1) && (bs[g * 4 + j] > m2); m2 = gt ? bs[g * 4 + j] : m2; w2 = gt ? sc[g * 4 + j] : w2; i2 = gt ? j : i2; }
        const float gs = m1 + m2; const bool better = gs > best;
        best = better ? gs : best; E0 = better ? g * 4 + i1 : E0; E1 = better ? g * 4 + i2 : E1; W0 = better ? w1 : W0; W1 = better ? w2 : W1;
    }
    e0 = E0; e1 = E1;
    const float inv = 1.f / (W0 + W1);
    g0 = W0 * inv; g1 = W1 * inv;
}
__device__ __forceinline__ void expert_offsets(const u32* cnt  , int (&off)[17]) {
    off[0] = 0;
#pragma unroll
    for (int e = 0; e < 16; ++e) off[e + 1] = off[e] + (int)((cnt[e * 64] + 255u) / 256u) * 256;
}

template <int NS> __forceinline__
__device__ __forceinline__ void phase_rows(const P& p, int bid, int nb, float* lds, const RowArgs a) {
    const int tid = p.tid(), lane = tid & 63, wid = tid >> 6;
    unsigned char* ws = p.get_ws();
    const float* MODS = (const float*)(ws + WS_MODS);
    float* XRES = (float*)(ws + WS_XRES);
    bf16_t* HB = (bf16_t*)(ws + WS_HB);
    float* SMALL = (float*)(ws + WS_SMALL);
    int* CHKI = (int*)(ws + WS_CHK);
    if (!a.final_out && !a.noproj) {
        for (int i = tid; i < 1024 * NS; i += NTH) { const int k = i / NS, n = i % NS;
            lds[(((k >> 8) * 4 + (k & 3)) * (NS / 4) + (n >> 2)) * 256 + ((k >> 2) & 63) * 4 + (n & 3)] = a.wsm[(size_t)k * a.ldw + a.wcol0 + n]; }
    }
    u32* lcnt = (u32*)(lds + 1024 * 32);
    int* lsl = (int*)(lds + 1024 * 32 + 64);
    int4* lrt = (int4*)(lds + 1024 * 32 + 64);
    if (tid < 16) lcnt[tid] = 0u;
    if (a.combine) {
        if (tid == 0) { int off[17]; expert_offsets((const u32*)(ws + WS_CTL) + CW_CNT + a.clayer * 16 * 64, off);
#pragma unroll
            for (int e = 0; e < 16; ++e) lsl[e] = off[e]; }
        for (int i = tid; i < nb * 16; i += NTH) lsl[16 + i] = CHKI[CH_BBASE + i];
    }
    __syncthreads();
    const float* gamma = (a.ffn ? p.in[7] : p.in[6]) + a.layer * 1024;
    const bf16_t* YMOE = (const bf16_t*)(ws + WS_PROJ);
    const int4* ROUTE = (const int4*)(ws + WS_ROUTE);
    const float2* GATE = (const float2*)(ws + WS_GATE);
    const int stride = nb * 8;
    for (int row0 = bid * 8 + wid; row0 < a.nrows; row0 += (NS == 16 ? 2 : 1) * stride) {
        const bool hasB = NS == 16 && row0 + stride < a.nrows;
        const int rw[2] = {row0, hasB ? row0 + stride : row0};
        float v[2][16];
#pragma unroll
        for (int u = 0; u < 2; ++u) {
            const int row = rw[u];
            const float* src = a.src ? XRES + (size_t)row * 1024 : (row >= SEQ ? p.in[2] + (size_t)(row - SEQ) * 1024 : p.in[0] + (size_t)row * 1024);
#pragma unroll
            for (int i = 0; i < 4; ++i) { const float4 t = *(const float4*)(src + i * 256 + lane * 4); v[u][i * 4] = t.x; v[u][i * 4 + 1] = t.y; v[u][i * 4 + 2] = t.z; v[u][i * 4 + 3] = t.w; }
        }
        if (a.combine) {
            int4 rt[2]; float2 gt[2];
#pragma unroll
            for (int u = 0; u < 2; ++u) { rt[u] = ROUTE[rw[u]]; gt[u] = GATE[rw[u]]; }
            uint2 y0[2][4], y1[2][4];
#pragma unroll
            for (int u = 0; u < 2; ++u) {
                const int blk = (rw[u] >> 6) % nb;
                const int s0 = lsl[rt[u].x] + lsl[16 + blk * 16 + rt[u].x] + rt[u].y, s1 = lsl[rt[u].z] + lsl[16 + blk * 16 + rt[u].z] + rt[u].w;
#pragma unroll
                for (int i = 0; i < 4; ++i) { y0[u][i] = *(const uint2*)(YMOE + (size_t)s0 * 1024 + i * 256 + lane * 4); y1[u][i] = *(const uint2*)(YMOE + (size_t)s1 * 1024 + i * 256 + lane * 4); }
            }
#pragma unroll
            for (int u = 0; u < 2; ++u) {
                const int row = rw[u];
                const float* gf = MODS + (a.clayer * 2 + (row >= SEQ ? 1 : 0)) * 6144 + 5 * 1024;
#pragma unroll
                for (int i = 0; i < 4; ++i) {
                    const float4 g = *(const float4*)(gf + i * 256 + lane * 4);
                    v[u][i * 4 + 0] += g.x * (gt[u].x * __uint_as_float(y0[u][i].x << 16) + gt[u].y * __uint_as_float(y1[u][i].x << 16));
                    v[u][i * 4 + 1] += g.y * (gt[u].x * __uint_as_float(y0[u][i].x & 0xffff0000u) + gt[u].y * __uint_as_float(y1[u][i].x & 0xffff0000u));
                    v[u][i * 4 + 2] += g.z * (gt[u].x * __uint_as_float(y0[u][i].y << 16) + gt[u].y * __uint_as_float(y1[u][i].y << 16));
                    v[u][i * 4 + 3] += g.w * (gt[u].x * __uint_as_float(y0[u][i].y & 0xffff0000u) + gt[u].y * __uint_as_float(y1[u][i].y & 0xffff0000u));
                }
                if (u == 0 || hasB) {
                    float* dst = a.final_out ? p.get_out() + (size_t)row * 1024 : XRES + (size_t)row * 1024;
#pragma unroll
                    for (int i = 0; i < 4; ++i) *(float4*)(dst + i * 256 + lane * 4) = make_float4(v[u][i * 4], v[u][i * 4 + 1], v[u][i * 4 + 2], v[u][i * 4 + 3]);
                }
            }
            if (a.final_out) continue;
        }
#pragma unroll
        for (int u = 0; u < 2; ++u) {
            const int row = rw[u];
            if (u == 0 || hasB) {
            const float* md = MODS + (a.layer * 2 + (row >= SEQ ? 1 : 0)) * 6144 + (a.ffn ? 3 * 1024 : 0);
            const float s0 = row_norm_proj<NS>(v[u], gamma, md, HB + (size_t)row * 1024, lds, lane, !a.noproj);
            if (a.noproj) {
            } else if (!a.route) {
                const int nl = NS == 16 ? (((lane >> 5) & 1) << 3) | (((lane >> 4) & 1) << 2) | (((lane >> 3) & 1) << 1) | ((lane >> 2) & 1)
                                        : (((lane >> 5) & 1) << 4) | (((lane >> 4) & 1) << 3) | (((lane >> 3) & 1) << 2) | (((lane >> 2) & 1) << 1) | ((lane >> 1) & 1);
                if ((lane & (NS == 16 ? 3 : 1)) == 0) SMALL[(size_t)row * 32 + nl] = s0;
            } else if (NS == 16) {
                const int nl = (((lane >> 5) & 1) << 3) | (((lane >> 4) & 1) << 2) | (((lane >> 3) & 1) << 1) | ((lane >> 2) & 1);
                const float scl = 1.f / (1.f + expf(-s0)), bsl = scl + p.in[5][nl];
                float sc[16], bs[16];
#pragma unroll
                for (int n = 0; n < 16; ++n) { const int sl = ((n & 8) ? 32 : 0) | ((n & 4) ? 16 : 0) | ((n & 2) ? 8 : 0) | ((n & 1) ? 4 : 0); sc[n] = rdlane(scl, sl); bs[n] = rdlane(bsl, sl); }
                int e0, e1; float g0, g1; route16(sc, bs, e0, e1, g0, g1);
                if (lane == 0) {
                    const int p0 = (int)atomicAdd(lcnt + e0, 1u), p1 = (int)atomicAdd(lcnt + e1, 1u);
                    const int4 rt4 = make_int4(e0, p0, e1, p1);
                    ((int4*)(ws + WS_ROUTE))[row] = rt4;
                    ((float2*)(ws + WS_GATE))[row] = make_float2(g0, g1);
                    lrt[((row - (bid * 8 + wid)) / stride) * 8 + wid] = rt4;
                }
            }
            }
            __builtin_amdgcn_sched_barrier(0);
        }
    }
    if (a.route) {
        __syncthreads();
        if (tid < 16) {
            u32* cnt = (u32*)(ws + WS_CTL) + CW_CNT + (a.layer * 16 + tid) * 64;
            const int base = (int)atomicAdd(cnt, lcnt[tid]);
            CHKI[CH_BBASE + bid * 16 + tid] = base; lcnt[16 + tid] = (u32)base;
        }
        __syncthreads();
        if (lane == 0) {
            int* ELIST = CHKI + CH_ELIST;
            int k = 0;
            for (int row = bid * 8 + wid; row < a.nrows; row += stride, ++k) {
                const int4 r = lrt[k * 8 + wid];
                ELIST[r.x * MT + (int)lcnt[16 + r.x] + r.y] = row; ELIST[r.z * MT + (int)lcnt[16 + r.z] + r.w] = row;
            }
        }
    }
}


__device__ __forceinline__ void phase_route(const P& p, int bid, int nb, float* lds, int layer, int nrows) {
    const int tid = p.tid(), lane = tid & 63, wid = tid >> 6, r = lane & 15, q = lane >> 4;
    unsigned char* ws = p.get_ws();
    const float* MODS = (const float*)(ws + WS_MODS);
    const float* XRES = (const float*)(ws + WS_XRES);
    bf16_t* HB = (bf16_t*)(ws + WS_HB);
    int* CHKI = (int*)(ws + WS_CHK);
    const bf16_t* WRT = (const bf16_t*)((const float*)(ws + WS_CHK) + CH_WRT);
    u32* lcnt = (u32*)(lds + 16384);
    int4* lrt = (int4*)(lds + 16384 + 64);
    if (tid < 16) lcnt[tid] = 0u;
    const float* gamma = p.in[7] + layer * 1024;
    int kt = 0;
    for (int tile = bid; tile < nrows / 64; tile += nb, ++kt) {
        const int r0 = tile * 64;
#pragma unroll 1
        for (int pr = 0; pr < 4; ++pr) {
            float v[2][16];
#pragma unroll
            for (int u = 0; u < 2; ++u) { const float* src = XRES + (size_t)(r0 + wid * 8 + pr * 2 + u) * 1024;
#pragma unroll
                for (int i = 0; i < 4; ++i) { const float4 t = *(const float4*)(src + i * 256 + lane * 4); v[u][i * 4] = t.x; v[u][i * 4 + 1] = t.y; v[u][i * 4 + 2] = t.z; v[u][i * 4 + 3] = t.w; } }
#pragma unroll
            for (int u = 0; u < 2; ++u) { const int row = r0 + wid * 8 + pr * 2 + u;
                const float* md = MODS + (layer * 2 + (row >= SEQ ? 1 : 0)) * 6144 + 3 * 1024;
                (void)row_norm_proj<16>(v[u], gamma, md, HB + (size_t)row * 1024, lds, lane, false); }
        }
        asm volatile("s_waitcnt vmcnt(0)" ::: "memory");
        __syncthreads();
        {
            f32x4 acc[4][2];
#pragma unroll
            for (int mi = 0; mi < 4; ++mi)
#pragma unroll
                for (int ni = 0; ni < 2; ++ni) acc[mi][ni] = (f32x4){0.f, 0.f, 0.f, 0.f};
            const bf16_t* Ab = HB + (size_t)(r0 + r) * 1024 + wid * 128 + 8 * q; const bf16_t* Bb = WRT + (size_t)r * 1024 + wid * 128 + 8 * q;
#pragma unroll
            for (int k4 = 0; k4 < 4; ++k4) {
                bf16x8 a[4], b[2];
#pragma unroll
                for (int mi = 0; mi < 4; ++mi) a[mi] = *(const bf16x8*)(Ab + (size_t)(16 * mi) * 1024 + 32 * k4);
#pragma unroll
                for (int ni = 0; ni < 2; ++ni) b[ni] = *(const bf16x8*)(Bb + (size_t)(16 * ni) * 1024 + 32 * k4);
#pragma unroll
                for (int mi = 0; mi < 4; ++mi)
#pragma unroll
                    for (int ni = 0; ni < 2; ++ni) acc[mi][ni] = __builtin_amdgcn_mfma_f32_16x16x32_bf16(b[ni], a[mi], acc[mi][ni], 0, 0, 0);
            }
#pragma unroll
            for (int mi = 0; mi < 4; ++mi)
#pragma unroll
                for (int ni = 0; ni < 2; ++ni) *(f32x4*)(lds + wid * 2048 + (16 * mi + r) * 32 + 16 * ni + 4 * q) = acc[mi][ni];
        }
        __syncthreads();
        if (tid < 128) {
            const int rr = tid >> 1, c8 = (tid & 1) * 8;
            float lg[8] = {0.f, 0.f, 0.f, 0.f, 0.f, 0.f, 0.f, 0.f};
#pragma unroll
            for (int w = 0; w < 8; ++w) { const float4 x0 = *(const float4*)(lds + w * 2048 + rr * 32 + c8), x1 = *(const float4*)(lds + w * 2048 + rr * 32 + c8 + 4);
                lg[0] += x0.x; lg[1] += x0.y; lg[2] += x0.z; lg[3] += x0.w; lg[4] += x1.x; lg[5] += x1.y; lg[6] += x1.z; lg[7] += x1.w; }
            float sc[16], bs[16];
            const float* rb = p.in[5];
#pragma unroll
            for (int j = 0; j < 8; ++j) {
                const float mine_s = 1.f / (1.f + expf(-lg[j])), mine_b = mine_s + rb[c8 + j];
                const float oth_s = __shfl_xor(mine_s, 1), oth_b = __shfl_xor(mine_b, 1);
                sc[j] = c8 ? oth_s : mine_s; sc[8 + j] = c8 ? mine_s : oth_s; bs[j] = c8 ? oth_b : mine_b; bs[8 + j] = c8 ? mine_b : oth_b;
            }
            int e0, e1; float g0, g1; route16(sc, bs, e0, e1, g0, g1);
            if (c8 == 0) {
                const int row = r0 + rr;
                const int p0 = (int)atomicAdd(lcnt + e0, 1u), p1 = (int)atomicAdd(lcnt + e1, 1u);
                const int4 rt4 = make_int4(e0, p0, e1, p1);
                ((int4*)(ws + WS_ROUTE))[row] = rt4;
                ((float2*)(ws + WS_GATE))[row] = make_float2(g0, g1);
                lrt[kt * 64 + rr] = rt4;
            }
        }
        __syncthreads();
    }
    __syncthreads();
    if (tid < 16) {
        u32* cnt = (u32*)(ws + WS_CTL) + CW_CNT + (layer * 16 + tid) * 64;
        const int base = (int)atomicAdd(cnt, lcnt[tid]);
        CHKI[CH_BBASE + bid * 16 + tid] = base; lcnt[16 + tid] = (u32)base;
    }
    __syncthreads();
    {
        int* ELIST = CHKI + CH_ELIST;
        int k2 = 0;
        for (int tile = bid; tile < nrows / 64; tile += nb, ++k2)
            if (tid < 64) { const int4 rt = lrt[k2 * 64 + tid]; const int row = tile * 64 + tid;
                ELIST[rt.x * MT + (int)lcnt[16 + rt.x] + rt.y] = row; ELIST[rt.z * MT + (int)lcnt[16 + rt.z] + rt.w] = row; }
    }
}

namespace g8 {
#define G8_LAS __attribute__((address_space(3)))
typedef short bf16x8 __attribute__((ext_vector_type(8)));
typedef float f32x4 __attribute__((ext_vector_type(4)));
constexpr int BM = 256, BK = 64, HALF = 128, HTB = HALF * BK * 2, STAGE_BYTES = 8 * HTB, NXCD = 8, WGM = 8;
__device__ __forceinline__ int lds_byte(int r, int c) { const int st = (r >> 4) * 2 + (c >> 5), rr = r & 15, cc = c & 31, ob = rr * 64 + cc * 2; return st * 1024 + (ob ^ (((ob >> 9) & 1) << 5)); }
__device__ __forceinline__ void stage_rc(int b, int& R, int& C) { const int st = b / 1024, sb = b % 1024, swz = sb ^ (((sb >> 9) & 1) << 5); R = (st >> 1) * 16 + swz / 64; C = (st & 1) * 32 + (swz % 64) / 2; }
__device__ __forceinline__ int perm32(int rho) { const int n = rho >> 4, i = rho & 15; return 8 * (i >> 2) + 4 * n + (i & 3); }
struct Unit { int pm, pn; };
struct Order {
    int nM, nN, nwg, G, c;
    __device__ __forceinline__ void init(int nM_, int nN_, int G_, int c_) { nM = nM_; nN = nN_; nwg = nM * nN; G = G_; c = c_; }
    __device__ __forceinline__ bool next(int i, Unit& u) const {
        const long L = (long)i * G + c; if (L >= nwg) return false;
        int wgid = (int)L; { const int q = nwg / NXCD, r = nwg % NXCD, xcd = wgid % NXCD, off = wgid / NXCD; wgid = (xcd < r ? xcd * (q + 1) : r * (q + 1) + (xcd - r) * q) + off; }
        const int nig = WGM * nN, gid = wgid / nig, fm = gid * WGM, gsz = (nM - fm) < WGM ? (nM - fm) : WGM;
        u.pm = fm + ((wgid % nig) % gsz); u.pn = (wgid % nig) / gsz; return true;
    }
};
template <class RowSrc, class BSel, class EF>
__device__ __forceinline__ void gemm8(const int tid, G8_LAS unsigned char* lds, const bf16_t* A, int K, const RowSrc& rsrc, const Order& S, const BSel& bsel, const EF& ef) {
    const int wid = __builtin_amdgcn_readfirstlane(tid >> 6), lane = tid & 63, wr = wid >> 2, wc = wid & 3, fr = lane & 15, fq = lane >> 4;
    const int nt = K / BK;
    int R0, C0, R1, C1; stage_rc(tid * 16, R0, C0); stage_rc(tid * 16 + 8192, R1, C1);
    const unsigned vb0 = (unsigned)(((R0 & ~31) + perm32(R0 & 31)) * K + C0) * 2u, vb1 = (unsigned)(((R1 & ~31) + perm32(R1 & 31)) * K + C1) * 2u;
    const size_t kstep = (size_t)(BK * 2), hstep = (size_t)HALF * K * 2, tstep = 2 * hstep;
    const unsigned ldsw = (unsigned)wid * 1024u;
    const int aoff = lds_byte(wr * 64 + fr, fq * 8), boff = lds_byte(wc * 32 + fr, fq * 8);
#define G8_SA(b, h) (((b) * 2 + (h)) * HTB)
#define G8_SB(b, h) ((4 + (b) * 2 + (h)) * HTB)
#define G8_STAGE(bufoff, gbase, v0, v1) do { \
        __builtin_amdgcn_global_load_lds((const unsigned*)((const char*)(gbase) + (v0)), (G8_LAS unsigned*)(lds + (bufoff) + ldsw), 16, 0, 0); \
        __builtin_amdgcn_global_load_lds((const unsigned*)((const char*)(gbase) + (v1)), (G8_LAS unsigned*)(lds + (bufoff) + ldsw + 8192), 16, 0, 0); } while (0)
#define G8_LDA(dst, b, h) do { _Pragma("unroll") for (int m = 0; m < 4; ++m) _Pragma("unroll") for (int k = 0; k < 2; ++k) dst[m][k] = *(const G8_LAS bf16x8*)(lds + G8_SA(b, h) + aoff + m * 2048 + k * 1024); } while (0)
#define G8_LDB(dst, b, h) do { _Pragma("unroll") for (int n = 0; n < 2; ++n) _Pragma("unroll") for (int k = 0; k < 2; ++k) dst[n][k] = *(const G8_LAS bf16x8*)(lds + G8_SB(b, h) + boff + n * 2048 + k * 1024); } while (0)
#define G8_MMA(ai, bj, At, Bt) do { __builtin_amdgcn_s_setprio(1); _Pragma("unroll") for (int m = 0; m < 4; ++m) _Pragma("unroll") for (int n = 0; n < 2; ++n) _Pragma("unroll") for (int k = 0; k < 2; ++k) \
        acc[ai][bj][m][n] = __builtin_amdgcn_mfma_f32_16x16x32_bf16(Bt[n][k], At[m][k], acc[ai][bj][m][n], 0, 0, 0); __builtin_amdgcn_s_setprio(0); } while (0)
#define G8_WAIT_V(n) asm volatile("s_waitcnt vmcnt(" #n ")" ::: "memory")
#define G8_WAIT_L(n) asm volatile("s_waitcnt lgkmcnt(" #n ")" ::: "memory")
#define G8_BAR __builtin_amdgcn_s_barrier()
#define G8_SCHED __builtin_amdgcn_sched_barrier(0)
#define G8_AOFF(pm_, h_, R_, C_) ((unsigned)(rsrc((pm_), (h_) * 128 + (R_)) * K + (C_)) * 2u)
    Unit cur, nxt; int ui = 0;
    if (!S.next(0, cur)) return;
    f32x4 acc[2][2][4][2];
#pragma unroll
    for (int a = 0; a < 2; ++a)
#pragma unroll
        for (int b = 0; b < 2; ++b)
#pragma unroll
            for (int m = 0; m < 4; ++m)
#pragma unroll
                for (int n = 0; n < 2; ++n) acc[a][b][m][n] = (f32x4){0.f, 0.f, 0.f, 0.f};
    bf16x8 At[4][2], B0[2][2], B1[2][2];
    const char* Ab = (const char*)A;
    unsigned a00 = G8_AOFF(cur.pm, 0, R0, C0), a01 = G8_AOFF(cur.pm, 0, R1, C1), a10 = G8_AOFF(cur.pm, 1, R0, C0), a11 = G8_AOFF(cur.pm, 1, R1, C1);
    const char* cB = bsel(cur.pm) + (size_t)cur.pn * tstep;
    G8_STAGE(G8_SB(0, 0), cB, vb0, vb1); G8_STAGE(G8_SA(0, 0), Ab, a00, a01); G8_STAGE(G8_SB(0, 1), cB + hstep, vb0, vb1); G8_STAGE(G8_SA(0, 1), Ab, a10, a11);
    if (wr == 1) G8_BAR;
    G8_WAIT_V(4); G8_BAR;
    G8_STAGE(G8_SB(1, 0), cB + kstep, vb0, vb1); G8_STAGE(G8_SA(1, 0), Ab + kstep, a00, a01); G8_STAGE(G8_SB(1, 1), cB + hstep + kstep, vb0, vb1);
    G8_WAIT_V(6); G8_BAR;
    for (;;) {
        const bool has_next = S.next(ui + 1, nxt);
        unsigned n00 = a00, n01 = a01, n10 = a10, n11 = a11; const char* nB = cB;
        if (has_next) { n00 = G8_AOFF(nxt.pm, 0, R0, C0); n01 = G8_AOFF(nxt.pm, 0, R1, C1); n10 = G8_AOFF(nxt.pm, 1, R0, C0); n11 = G8_AOFF(nxt.pm, 1, R1, C1); nB = bsel(nxt.pm) + (size_t)nxt.pn * tstep; }
        for (int t = 0; t < nt; t += 2) {
            const bool last = (t == nt - 2);
            const char* a1p = Ab + (size_t)(t + 1) * kstep;
            const char* a2p = last ? Ab : Ab + (size_t)(t + 2) * kstep; const char* b2 = last ? nB : cB + (size_t)(t + 2) * kstep;
            const char* a3p = a2p + kstep; const char* b3 = b2 + kstep;
            const unsigned x00 = last ? n00 : a00, x01 = last ? n01 : a01, x10 = last ? n10 : a10, x11 = last ? n11 : a11;
            G8_LDB(B0, 0, 0); G8_SCHED; G8_LDA(At, 0, 0); G8_STAGE(G8_SA(1, 1), a1p, a10, a11);
            G8_WAIT_L(8); G8_BAR; G8_WAIT_L(0); G8_MMA(0, 0, At, B0); G8_BAR; G8_SCHED;
            G8_LDB(B1, 0, 1); G8_STAGE(G8_SB(0, 0), b2, vb0, vb1);
            G8_BAR; G8_WAIT_L(0); G8_MMA(0, 1, At, B1); G8_BAR;
            G8_LDA(At, 0, 1); G8_STAGE(G8_SA(0, 0), a2p, x00, x01);
            G8_BAR; G8_WAIT_L(0); G8_MMA(1, 0, At, B0); G8_BAR; G8_SCHED;
            G8_STAGE(G8_SB(0, 1), b2 + hstep, vb0, vb1);
            G8_WAIT_V(6); G8_BAR; G8_MMA(1, 1, At, B1); G8_BAR;
            G8_LDB(B0, 1, 0); G8_SCHED; G8_LDA(At, 1, 0); G8_STAGE(G8_SA(0, 1), a2p, x10, x11);
            G8_WAIT_L(8); G8_BAR; G8_WAIT_L(0); G8_MMA(0, 0, At, B0); G8_BAR; G8_SCHED;
            G8_LDB(B1, 1, 1); G8_STAGE(G8_SB(1, 0), b3, vb0, vb1);
            G8_BAR; G8_WAIT_L(0); G8_MMA(0, 1, At, B1); G8_BAR;
            G8_LDA(At, 1, 1); G8_STAGE(G8_SA(1, 0), a3p, x00, x01);
            G8_BAR; G8_WAIT_L(0); G8_MMA(1, 0, At, B0); G8_BAR; G8_SCHED;
            G8_STAGE(G8_SB(1, 1), b3 + hstep, vb0, vb1);
            G8_WAIT_V(6); G8_BAR; G8_MMA(1, 1, At, B1); G8_BAR;
        }
#pragma unroll
        for (int ai = 0; ai < 2; ++ai)
#pragma unroll
            for (int m = 0; m < 4; ++m)
#pragma unroll
                for (int bj = 0; bj < 2; ++bj) {
                    const f32x4 v0 = acc[ai][bj][m][0], v1 = acc[ai][bj][m][1];
                    const float v[8] = {v0[0], v0[1], v0[2], v0[3], v1[0], v1[1], v1[2], v1[3]};
                    ef(cur.pm * BM + ai * HALF + wr * 64 + m * 16 + fr, cur.pn * BM + bj * HALF + wc * 32 + 8 * fq, v);
                }
        if (!has_next) break;
#pragma unroll
        for (int a = 0; a < 2; ++a)
#pragma unroll
            for (int b = 0; b < 2; ++b)
#pragma unroll
                for (int m = 0; m < 4; ++m)
#pragma unroll
                    for (int n = 0; n < 2; ++n) acc[a][b][m][n] = (f32x4){0.f, 0.f, 0.f, 0.f};
        cur = nxt; a00 = n00; a01 = n01; a10 = n10; a11 = n11; cB = nB; ++ui;
    }
    G8_WAIT_V(0);
    if (wr == 0) G8_BAR;
    G8_BAR;
#undef G8_SA
#undef G8_SB
#undef G8_STAGE
#undef G8_LDA
#undef G8_LDB
#undef G8_MMA
#undef G8_WAIT_V
#undef G8_WAIT_L
#undef G8_BAR
#undef G8_SCHED
#undef G8_AOFF
}
}
struct BSelOne { const char* B; __device__ __forceinline__ const char* operator()(int) const { return B; } };
struct RowPlain { __device__ __forceinline__ int operator()(int pm, int r) const { return pm * 256 + r; } };
struct BSelExp { const char* B; const int* tinfo; size_t stride; __device__ __forceinline__ const char* operator()(int pm) const { return B + (size_t)tinfo[2 * pm] * stride; } };
struct RowMoe { const int* tinfo; const int* ecnt; const int* elist;
    __device__ __forceinline__ int operator()(int pm, int r) const { const int e = tinfo[2 * pm], pos = tinfo[2 * pm + 1] + r; return pos < ecnt[e] ? elist[e * MT + pos] : 0; } };
__device__ __forceinline__ int moe_tile_table(const P& p, int layer, int* tinfo, int* ecnt, int tid) {
    const u32* cnt = (const u32*)(p.get_ws() + WS_CTL) + CW_CNT + layer * 16 * 64;
    if (tid == 0) {
        int t = 0;
#pragma unroll 1
        for (int e = 0; e < 16; ++e) { const int c = (int)cnt[e * 64]; ecnt[e] = c;
#pragma unroll 1
            for (int i = 0; i < (c + 255) / 256; ++i) { tinfo[2 * t] = e; tinfo[2 * t + 1] = i * 256; ++t; } }
        ecnt[16] = t;
    }
    __syncthreads();
    return ecnt[16];
}

struct SrcPlain { const float* W; int ldw; __device__ __forceinline__ const float* operator()(int k, int n) const { return W + (size_t)k * ldw + n; } };
struct SrcEven { const float* W; __device__ __forceinline__ const float* operator()(int k, int n) const {
        return n < 2048 ? W + (size_t)k * EV_IN + (n < 1280 ? n : n + 16) : (n < 2064 ? W + (size_t)k * EV_IN + 1280 + (n - 2048) : nullptr); } };
struct SrcRouter { const float* W; __device__ __forceinline__ const float* operator()(int k, int n) const { return n < 16 ? W + (size_t)k * 16 + n : nullptr; } };
struct SrcOdd { const float* W; __device__ __forceinline__ const float* operator()(int k, int n) const { return n < OD_IN ? W + (size_t)k * OD_IN + n : nullptr; } };
struct SrcMoe13 { const float* W1; long long d13; __device__ __forceinline__ const float* operator()(int k, int n) const { return W1 + ((n & 4) ? d13 : 0ll) + (size_t)k * DE + ((n >> 3) * 4 + (n & 3)); } };
template <class SF>
__device__ __forceinline__ void conv_matrix(const SF& src, int K, int N, bf16_t* WT, int gw, int ngw, float* scr, int lane) {
    const int nblk = N / 32, nitems = (K / 64) * nblk;
    for (int item = gw; item < nitems; item += ngw) {
        const int kb = item / nblk, nbk = item % nblk, k0 = 64 * kb, n0 = 32 * nbk;
#pragma unroll 8
        for (int i = 0; i < 32; ++i) { const int kk = 2 * i + (lane >> 5); const float* sp = src(k0 + kk, n0 + (lane & 31)); scr[kk * 33 + (lane & 31)] = sp ? *sp : 0.f; }
        __builtin_amdgcn_s_waitcnt(0xC07F); asm volatile("" ::: "memory");
        const int c = lane & 7;
#pragma unroll
        for (int j = 0; j < 4; ++j) { const int n = (lane >> 3) + 8 * j; const float* sp = scr + (8 * c) * 33 + n;
            uint4 o; o.x = pack2(sp[0 * 33], sp[1 * 33]); o.y = pack2(sp[2 * 33], sp[3 * 33]); o.z = pack2(sp[4 * 33], sp[5 * 33]); o.w = pack2(sp[6 * 33], sp[7 * 33]);
            *(uint4*)(WT + (size_t)(n0 + n) * K + k0 + 8 * c) = o; }
        __builtin_amdgcn_s_waitcnt(0xC07F); asm volatile("" ::: "memory");
    }
}
__device__ __forceinline__ void conv_dense(const P& p, int bid, int nb, float* lds) {
    const int tid = p.tid(), lane = tid & 63, wid = tid >> 6;
    float* scr = lds + 16384 + wid * (64 * 33);
    const int gw = bid * 8 + wid, ngw = nb * 8;
    unsigned char* ws = p.get_ws();
    conv_matrix(SrcEven{p.in[10]}, 1024, 2304, (bf16_t*)(ws + WS_WIN0), gw, ngw, scr, lane);
    conv_matrix(SrcOdd{p.in[21]}, 1024, 3328, (bf16_t*)(ws + WS_WIN1), gw, ngw, scr, lane);
    conv_matrix(SrcPlain{p.in[20], 1024}, 1024, 1024, (bf16_t*)(ws + WS_WOUT0), gw, ngw, scr, lane);
    conv_matrix(SrcPlain{p.in[27], 1024}, 1024, 1024, (bf16_t*)(ws + WS_WOUT1), gw, ngw, scr, lane);
    conv_matrix(SrcRouter{p.in[4]}, 1024, 32, (bf16_t*)((float*)(ws + WS_CHK) + CH_WRT), gw, ngw, scr, lane);
}
__device__ __forceinline__ void conv_moe_chunk(const P& p, int chunk, float* lds, int layer) {
    const int tid = p.tid(), lane = tid & 63, wid = tid >> 6;
    float* scr = lds + 16384 + wid * (64 * 33);
    unsigned char* ws = p.get_ws();
    bf16_t* W13T = (bf16_t*)(ws + WS_WMOE); bf16_t* W2T = W13T + (size_t)16 * 1024 * 1024;
    const long long d13 = (long long)(p.in[29] - p.in[28]);
#pragma unroll 1
    for (int j = 0; j < 2; ++j) {
        const int wi = chunk * 16 + wid * 2 + j, e = wi / 768, idx = wi % 768;
        if (idx < 512) conv_matrix(SrcMoe13{p.in[28] + ((size_t)layer * 16 + e) * 1024 * DE, d13}, 1024, 1024, W13T + (size_t)e * 1024 * 1024, idx, 1 << 20, scr, lane);
        else conv_matrix(SrcPlain{p.in[30] + ((size_t)layer * 16 + e) * DE * 1024, 1024}, DE, 1024, W2T + (size_t)e * 1024 * DE, idx - 512, 1 << 20, scr, lane);
    }
}
__device__ __forceinline__ void conv_moe(const P& p, int bid, int nb, float* lds, int layer) {
    const int tid = p.tid(), lane = tid & 63, wid = tid >> 6;
    float* scr = lds + 16384 + wid * (64 * 33);
    const int ngw = nb * 8; int gw = bid * 8 + wid;
    unsigned char* ws = p.get_ws();
    bf16_t* W13T = (bf16_t*)(ws + WS_WMOE); bf16_t* W2T = W13T + (size_t)16 * 1024 * 1024;
    const long long d13 = (long long)(p.in[29] - p.in[28]);
    for (int e = 0; e < 16; ++e) {
        conv_matrix(SrcMoe13{p.in[28] + ((size_t)layer * 16 + e) * 1024 * DE, d13}, 1024, 1024, W13T + (size_t)e * 1024 * 1024, gw, ngw, scr, lane);
        conv_matrix(SrcPlain{p.in[30] + ((size_t)layer * 16 + e) * DE * 1024, 1024}, DE, 1024, W2T + (size_t)e * 1024 * DE, gw, ngw, scr, lane);
        gw = (gw + 768) % ngw;
    }
}


template <class EF>
__device__ __forceinline__ void mini_gemm(const P& p, int bid, int nb, float* lds, const bf16_t* A, const bf16_t* Bt, int row0, int nrt, int col0, int nct, const EF& ef) {
    constexpr int K = 1024, KS = 128;
    const int tid = p.tid(), lane = tid & 63, wid = tid >> 6, r = lane & 15, q = lane >> 4;
    const int ntl = nrt * nct;
    int t = bid;
    if (t >= ntl) return;
    bf16x8 a[4][4], b[4][2];
#define MG_LOAD(tt) do { const int rt_ = (tt) / nct, ct_ = (tt) % nct; \
        const bf16_t* Ab_ = A + (size_t)(row0 + rt_ * 64 + r) * K + wid * KS + 8 * q; const bf16_t* Bb_ = Bt + (size_t)(col0 + ct_ * 32 + r) * K + wid * KS + 8 * q; \
        _Pragma("unroll") for (int k4 = 0; k4 < 4; ++k4) { \
            _Pragma("unroll") for (int mi = 0; mi < 4; ++mi) a[k4][mi] = *(const bf16x8*)(Ab_ + (size_t)(16 * mi) * K + 32 * k4); \
            _Pragma("unroll") for (int ni = 0; ni < 2; ++ni) b[k4][ni] = *(const bf16x8*)(Bb_ + (size_t)(16 * ni) * K + 32 * k4); } } while (0)
    MG_LOAD(t);
    for (;;) {
        f32x4 acc[4][2];
#pragma unroll
        for (int mi = 0; mi < 4; ++mi)
#pragma unroll
            for (int ni = 0; ni < 2; ++ni) acc[mi][ni] = (f32x4){0.f, 0.f, 0.f, 0.f};
#pragma unroll
        for (int k4 = 0; k4 < 4; ++k4)
#pragma unroll
            for (int mi = 0; mi < 4; ++mi)
#pragma unroll
                for (int ni = 0; ni < 2; ++ni) acc[mi][ni] = __builtin_amdgcn_mfma_f32_16x16x32_bf16(b[k4][ni], a[k4][mi], acc[mi][ni], 0, 0, 0);
        const int tcur = t; t += nb;
        const bool more = t < ntl;
        if (more) MG_LOAD(t);
        __syncthreads();
#pragma unroll
        for (int mi = 0; mi < 4; ++mi)
#pragma unroll
            for (int ni = 0; ni < 2; ++ni) *(f32x4*)(lds + wid * 2048 + (16 * mi + r) * 32 + 16 * ni + 4 * q) = acc[mi][ni];
        __syncthreads();
        if (tid < 256) {
            const int rr = tid >> 2, c8 = (tid & 3) * 8;
            float v[8] = {0.f, 0.f, 0.f, 0.f, 0.f, 0.f, 0.f, 0.f};
#pragma unroll
            for (int w = 0; w < 8; ++w) { const float4 x0 = *(const float4*)(lds + w * 2048 + rr * 32 + c8), x1 = *(const float4*)(lds + w * 2048 + rr * 32 + c8 + 4);
                v[0] += x0.x; v[1] += x0.y; v[2] += x0.z; v[3] += x0.w; v[4] += x1.x; v[5] += x1.y; v[6] += x1.z; v[7] += x1.w; }
            ef(row0 + (tcur / nct) * 64 + rr, col0 + (tcur % nct) * 32 + c8, v);
        }
        if (!more) break;
    }
#undef MG_LOAD
    __syncthreads();
}

struct EpiProj { bf16_t* C; int ld; int nmain; int ns; float* SMALL; __device__ void operator()(int r, int c0, const float* v) const {
    if (c0 < nmain) { uint4 o; o.x = pack2(v[0], v[1]); o.y = pack2(v[2], v[3]); o.z = pack2(v[4], v[5]); o.w = pack2(v[6], v[7]); *(uint4*)(C + (size_t)r * ld + c0) = o; }
    else if (c0 < nmain + ns) { float* d = SMALL + (size_t)r * 32 + (c0 - nmain); *(float4*)d = make_float4(v[0], v[1], v[2], v[3]); *(float4*)(d + 4) = make_float4(v[4], v[5], v[6], v[7]); } } };
struct EpiBf16Store { bf16_t* C; int ld; __device__ void operator()(int r, int c0, const float* v) const {
    uint4 o; o.x = pack2(v[0], v[1]); o.y = pack2(v[2], v[3]); o.z = pack2(v[4], v[5]); o.w = pack2(v[6], v[7]); *(uint4*)(C + (size_t)r * ld + c0) = o; } };
struct EpiResid { const float* xlat; const float* xctx; float* XRES; const float* gl; const float* gc;
    __device__ void operator()(int r, int c0, const float* v) const {
        const float* xin = xctx && r >= SEQ ? xctx + (size_t)(r - SEQ) * 1024 : xlat + (size_t)r * 1024;
        const float* g = r >= SEQ ? gc : gl;
        const float4 x0 = *(const float4*)(xin + c0), x1 = *(const float4*)(xin + c0 + 4), g0 = *(const float4*)(g + c0), g1 = *(const float4*)(g + c0 + 4);
        *(float4*)(XRES + (size_t)r * 1024 + c0) = make_float4(x0.x + g0.x * v[0], x0.y + g0.y * v[1], x0.z + g0.z * v[2], x0.w + g0.w * v[3]);
        *(float4*)(XRES + (size_t)r * 1024 + c0 + 4) = make_float4(x1.x + g1.x * v[4], x1.y + g1.y * v[5], x1.z + g1.z * v[6], x1.w + g1.w * v[7]);
    } };
struct EpiSwiglu { bf16_t* H; __device__ void operator()(int r, int c0, const float* v) const {
    uint2 o; o.x = pack2(siluf(v[0]) * v[4], siluf(v[1]) * v[5]); o.y = pack2(siluf(v[2]) * v[6], siluf(v[3]) * v[7]); *(uint2*)(H + (size_t)r * DE + (c0 >> 3) * 4) = o; } };

__device__ __forceinline__ void phase_moe1(const P& p, int bid, int nb, G8_LAS unsigned char* ldsa, float* lds, int layer) {
    unsigned char* ws = p.get_ws();
    int* tinfo = (int*)(lds + 32768); int* ecnt = tinfo + 2 * MAXTILES + 16;
    const int ntiles = moe_tile_table(p, layer, tinfo, ecnt, p.tid());
    g8::Order S; S.init(ntiles, 4, nb, bid);
    EpiSwiglu ef{(bf16_t*)(ws + WS_Y)};
    g8::gemm8(p.tid(), ldsa, (const bf16_t*)(ws + WS_HB), 1024, RowMoe{tinfo, ecnt, (const int*)(ws + WS_CHK) + CH_ELIST}, S, BSelExp{(const char*)(ws + WS_WMOE), tinfo, (size_t)1024 * 1024 * 2}, ef);
}
__device__ __forceinline__ void phase_moe2(const P& p, int bid, int nb, G8_LAS unsigned char* ldsa, float* lds, int layer) {
    unsigned char* ws = p.get_ws();
    int* tinfo = (int*)(lds + 32768); int* ecnt = tinfo + 2 * MAXTILES + 16;
    const int ntiles = moe_tile_table(p, layer, tinfo, ecnt, p.tid());
    g8::Order S; S.init(ntiles, 4, nb, bid);
    EpiBf16Store ef{(bf16_t*)(ws + WS_PROJ), 1024};
    g8::gemm8(p.tid(), ldsa, (const bf16_t*)(ws + WS_Y), DE, RowPlain{}, S, BSelExp{(const char*)(ws + WS_WMOE) + (size_t)16 * 1024 * 1024 * 2, tinfo, (size_t)1024 * DE * 2}, ef);
}

__device__ __forceinline__ void phase_qkprep(const P& p, int bid, int nb) {
    const int tid = p.tid(), lane = tid & 63, wid = tid >> 6;
    unsigned char* ws = p.get_ws();
    const bf16_t* PROJ = (const bf16_t*)(ws + WS_PROJ);
    bf16_t* QKR = (bf16_t*)(ws + WS_XRES);
    const float* RC = (const float*)(ws + WS_ROPE); const float* RS = RC + 256 * 16;
    const int d0 = (lane & 7) * 8;
    float qn[8], kn[8];
#pragma unroll
    for (int j = 0; j < 8; ++j) { qn[j] = p.in[17][d0 + j]; kn[j] = p.in[18][d0 + j]; }
    for (int rk = bid * 8; rk < MT / 8; rk += nb * 8)
#pragma unroll 2
    for (int k8 = 0; k8 < 8; ++k8) {
        const int row = (rk + k8) * 8 + wid;
        const bool lat = row < SEQ;
        const uint4 qraw = *(const uint4*)(PROJ + (size_t)row * 2048 + 1280 + lane * 8);
        const uint4 kraw = lane < 16 ? *(const uint4*)(PROJ + (size_t)row * 2048 + 1792 + lane * 8) : make_uint4(0u, 0u, 0u, 0u);
        const int pos = d0 < 32 ? (row >> 6) : (row & 63);
        float cs[8], sn[8];
#pragma unroll
        for (int j = 0; j < 8; ++j) { const int f = (d0 + j) & 15; cs[j] = lat ? RC[pos * 16 + f] : 1.f; sn[j] = lat ? RS[pos * 16 + f] : 0.f; }
        const bool lowhalf = (d0 & 16) == 0;
#pragma unroll
        for (int part = 0; part < 2; ++part) {
            float f[8]; unpack8(part == 0 ? qraw : kraw, f);
            float ss = 0.f;
#pragma unroll
            for (int j = 0; j < 8; ++j) ss += f[j] * f[j];
            ss += __shfl_xor(ss, 1); ss += __shfl_xor(ss, 2); ss += __shfl_xor(ss, 4);
            const float rs = rsqrtf(ss * (1.f / 64.f) + 1e-6f);
            float o[8];
#pragma unroll
            for (int j = 0; j < 8; ++j) { const float y = f[j] * rs * (part == 0 ? qn[j] : kn[j]); const float oth = __shfl_xor(y, 2); o[j] = lowhalf ? y * cs[j] - oth * sn[j] : oth * sn[j] + y * cs[j]; }
            uint4 w; w.x = pack2(o[0], o[1]); w.y = pack2(o[2], o[3]); w.z = pack2(o[4], o[5]); w.w = pack2(o[6], o[7]);
            if (part == 0) *(uint4*)(QKR + (size_t)row * 640 + lane * 8) = w;
            else if (lane < 16) *(uint4*)(QKR + (size_t)row * 640 + 512 + lane * 8) = w;
        }
    }
}


template <int MI, int NI, int KK, bool SWAP, bool SWB = false>
__device__ __forceinline__ void wave_mma(f32x4 (&acc)[MI][NI], const bf16_t* A, int lda, const bf16_t* Bt, int ldb, int lane) {
    const int r = lane & 15, q = lane >> 4;
#pragma unroll
    for (int kk = 0; kk < KK; kk += 32) {
        bf16x8 a[MI], b[NI];
#pragma unroll
        for (int mi = 0; mi < MI; ++mi) a[mi] = *(const bf16x8*)(A + (16 * mi + r) * lda + kk + 8 * q);
#pragma unroll
        for (int ni = 0; ni < NI; ++ni) b[ni] = *(const bf16x8*)(Bt + (16 * ni + r) * ldb + ((kk + 8 * q) ^ (SWB ? ((((16 * ni + r) >> 3) & 7) << 3) : 0)));
#pragma unroll
        for (int mi = 0; mi < MI; ++mi)
#pragma unroll
            for (int ni = 0; ni < NI; ++ni)
                acc[mi][ni] = SWAP ? __builtin_amdgcn_mfma_f32_16x16x32_bf16(b[ni], a[mi], acc[mi][ni], 0, 0, 0) : __builtin_amdgcn_mfma_f32_16x16x32_bf16(a[mi], b[ni], acc[mi][ni], 0, 0, 0);
    }
}
__device__ __forceinline__ void prefetch_line(const void* g, float* lds_dummy, int wid) {
    __builtin_amdgcn_global_load_lds((const unsigned*)g, (__attribute__((address_space(3))) unsigned*)((__attribute__((address_space(3))) unsigned char*)lds_dummy + wid * 256), 4, 0, 0);
}
struct Raw3 { uint4 m, c, p; };
__device__ __forceinline__ Raw3 conv8_load(const bf16_t* rowp, int ld, int t, int L) {
    const uint4 z = make_uint4(0u, 0u, 0u, 0u);
    Raw3 r; r.m = t > 0 ? *(const uint4*)(rowp - ld) : z; r.c = *(const uint4*)rowp; r.p = t < L - 1 ? *(const uint4*)(rowp + ld) : z; return r;
}
__device__ __forceinline__ void conv8_apply(const Raw3& r, const float* cwl, float* out) {
    float fm[8], f0[8], fp[8]; unpack8(r.m, fm); unpack8(r.c, f0); unpack8(r.p, fp);
#pragma unroll
    for (int j = 0; j < 8; ++j) { const float4 w = *(const float4*)(cwl + j * 4); out[j] = siluf(w.x * fm[j] + w.y * f0[j] + w.z * fp[j] + w.w); }
}
__device__ __forceinline__ float wave_scan128(float& v0, float& v1, int lane) {
    float s = v0 + v1;
#pragma unroll
    for (int o = 1; o < 64; o <<= 1) { const float t = __shfl_up(s, o); if (lane >= o) s += t; }
    const float excl = s - (v0 + v1);
    v0 = excl + v0; v1 = v0 + v1;
    return __shfl(s, 63);
}

constexpr size_t SSD_S_OFF = 0;
constexpr size_t SSD_H_OFF = (size_t)130 * 16 * 4096 * 4;
__device__ __forceinline__ void stage_convw(const float* cw, const float* cb, int C, float* cwl, int tid) {
    for (int c = tid; c < C; c += NTH) *(float4*)(cwl + c * 4) = make_float4(cw[c], cw[C + c], cw[2 * C + c], cb[c]);
}
__device__ __forceinline__ void ssd_states(const P& p, int bid, int nb, float* lds) {
    const int tid = p.tid(), lane = tid & 63, wid = tid >> 6;
    unsigned char* ws = p.get_ws();
    const bf16_t* PROJ = (const bf16_t*)(ws + WS_PROJ);
    const float* SMALL = (const float*)(ws + WS_SMALL);
    float* S = (float*)(ws + WS_Y + SSD_S_OFF);
    float* DEC = (float*)(ws + WS_CHK);
    float* cwl = lds;
    bf16_t* XT = (bf16_t*)(lds + 768 * 4);
    bf16_t* BT = XT + 256 * 136;
    float* wsc = (float*)(BT + 64 * 136);
    stage_convw(p.in[11], p.in[12], 768, cwl, tid);
    __syncthreads();
    for (int item = bid; item < 260; item += nb) {
        const int c = item >> 1, g = item & 1;
        const int L = c < 128 ? SEQ : CTX, t0 = c < 128 ? c * 128 : (c - 128) * 128, rbase = c < 128 ? 0 : SEQ;
        const int tid = p.tid(), lane = tid & 63, wid = tid >> 6;
#pragma unroll 1
        for (int b5 = 0; b5 < 2; ++b5) {
            Raw3 rw[5];
#pragma unroll
            for (int k = 0; k < 5; ++k) { const int i = tid + (b5 * 5 + k) * NTH; const int cg8 = (i >> 3) % 40, tl = (i / 320) * 8 + (i & 7);
                const int ch = cg8 < 32 ? g * 256 + cg8 * 8 : 512 + g * 64 + (cg8 - 32) * 8;
                rw[k] = conv8_load(PROJ + (size_t)(rbase + t0 + tl) * 2048 + 512 + ch, 2048, t0 + tl, L); }
#pragma unroll
            for (int k = 0; k < 5; ++k) { const int i = tid + (b5 * 5 + k) * NTH; const int cg8 = (i >> 3) % 40, tl = (i / 320) * 8 + (i & 7);
                const int ch = cg8 < 32 ? g * 256 + cg8 * 8 : 512 + g * 64 + (cg8 - 32) * 8;
                float o[8]; conv8_apply(rw[k], cwl + ch * 4, o);
                const int tls = tl ^ ((cg8 & 7) << 3);
                bf16_t* dst = cg8 < 32 ? XT + (cg8 * 8) * 136 + tls : BT + ((cg8 - 32) * 8) * 136 + tls;
#pragma unroll
                for (int j = 0; j < 8; ++j) dst[j * 136] = f2bf(o[j]); }
        }
        const int hh = wid >> 1, d = wid & 1, h = g * 4 + hh;
        {
            const float A = -expf(p.in[14][d * 8 + h]), dtb = p.in[13][d * 8 + h];
            const float dt0 = softplusf(SMALL[(size_t)(rbase + t0 + 2 * lane) * 32 + d * 8 + h] + dtb), dt1 = softplusf(SMALL[(size_t)(rbase + t0 + 2 * lane + 1) * 32 + d * 8 + h] + dtb);
            const float a0 = dt0 * A, a1 = dt1 * A;
            float c0 = a0, c1 = a1; const float tot = wave_scan128(c0, c1, lane);
            const float w0 = d == 0 ? __expf(tot - c0) * dt0 : __expf(c0 - a0) * dt0, w1 = d == 0 ? __expf(tot - c1) * dt1 : __expf(c1 - a1) * dt1;
            wsc[wid * 128 + 2 * lane] = w0; wsc[wid * 128 + 2 * lane + 1] = w1;
            if (lane == 0) DEC[c * 16 + d * 8 + h] = __expf(tot);
        }
        __syncthreads();
        {
            f32x4 acc[4][4];
#pragma unroll
            for (int mi = 0; mi < 4; ++mi)
#pragma unroll
                for (int ni = 0; ni < 4; ++ni) acc[mi][ni] = (f32x4){0.f, 0.f, 0.f, 0.f};
            const int r = lane & 15, q = lane >> 4;
#pragma unroll
            for (int kk = 0; kk < 128; kk += 32) {
                const float4 wa = *(const float4*)(wsc + wid * 128 + kk + 8 * q), wb = *(const float4*)(wsc + wid * 128 + kk + 8 * q + 4);
                bf16x8 a[4], b[4];
#pragma unroll
                for (int mi = 0; mi < 4; ++mi) {
                    const uint4 raw = *(const uint4*)(XT + (hh * 64 + 16 * mi + r) * 136 + ((kk + 8 * q) ^ ((((16 * mi + r) >> 3) & 7) << 3)));
                    float f[8]; unpack8(raw, f);
                    uint4 o; o.x = pack2(f[0] * wa.x, f[1] * wa.y); o.y = pack2(f[2] * wa.z, f[3] * wa.w); o.z = pack2(f[4] * wb.x, f[5] * wb.y); o.w = pack2(f[6] * wb.z, f[7] * wb.w);
                    a[mi] = *(bf16x8*)&o;
                }
#pragma unroll
                for (int ni = 0; ni < 4; ++ni) b[ni] = *(const bf16x8*)(BT + (16 * ni + r) * 136 + ((kk + 8 * q) ^ ((((16 * ni + r) >> 3) & 7) << 3)));
#pragma unroll
                for (int mi = 0; mi < 4; ++mi)
#pragma unroll
                    for (int ni = 0; ni < 4; ++ni) acc[mi][ni] = __builtin_amdgcn_mfma_f32_16x16x32_bf16(a[mi], b[ni], acc[mi][ni], 0, 0, 0);
                __builtin_amdgcn_sched_barrier(0);
            }
            float* Sp = S + ((size_t)(c * 2 + d) * 8 + h) * 4096;
#pragma unroll
            for (int mi = 0; mi < 4; ++mi)
#pragma unroll
                for (int ni = 0; ni < 4; ++ni)
#pragma unroll
                    for (int j = 0; j < 4; ++j) Sp[(16 * mi + 4 * q + j) * 64 + 16 * ni + r] = acc[mi][ni][j];
        }
        __syncthreads();
    }
}
__device__ __forceinline__ void ssd_scan(const P& p, int bid, int nb) {
    const int tid = p.tid();
    unsigned char* ws = p.get_ws();
    const float* S = (const float*)(ws + WS_Y + SSD_S_OFF);
    bf16_t* HIN = (bf16_t*)(ws + WS_Y + SSD_H_OFF);
    const float* DEC = (const float*)(ws + WS_CHK);
    for (int gid = bid * NTH + tid; gid < 65536; gid += nb * NTH) {
        const int d = gid >> 15, h = (gid >> 12) & 7, e = gid & 4095;
        float H = 0.f;
#pragma unroll 1
        for (int i0 = 0; i0 < 130; i0 += 10) {
            float sv[10], dv[10]; int cc[10];
#pragma unroll
            for (int j = 0; j < 10; ++j) {
                const int i = i0 + j;
                const int c = d == 0 ? (i < 2 ? 128 + i : i - 2) : (i < 2 ? 129 - i : 129 - i);
                cc[j] = c; sv[j] = S[((size_t)(c * 2 + d) * 8 + h) * 4096 + e]; dv[j] = DEC[c * 16 + d * 8 + h];
            }
#pragma unroll
            for (int j = 0; j < 10; ++j) { HIN[((size_t)(cc[j] * 2 + d) * 8 + h) * 4096 + e] = f2bf(H); H = dv[j] * H + sv[j]; }
        }
    }
}
__device__ __forceinline__ void ssd_out(const P& p, int bid, int nb, float* lds) {
    const int tid = p.tid(), lane = tid & 63, wid = tid >> 6, r = lane & 15, q = lane >> 4;
    unsigned char* ws = p.get_ws();
    const bf16_t* PROJ = (const bf16_t*)(ws + WS_PROJ);
    const float* SMALL = (const float*)(ws + WS_SMALL);
    const bf16_t* HIN = (const bf16_t*)(ws + WS_Y + SSD_H_OFF);
    bf16_t* MIX = (bf16_t*)(ws + WS_HB);
    float* cwl = lds;
    bf16_t* Cg = (bf16_t*)(lds + 768 * 4);
    bf16_t* Bg = Cg + 128 * 72;
    bf16_t* XT = Bg + 128 * 72;
    bf16_t* Mb = XT + 64 * 136;
    bf16_t* Hn = Mb + 128 * 136;
    float* csb = (float*)(Hn + 2 * 64 * 72);
    float* dts = csb + 8 * 256;
    stage_convw(p.in[11], p.in[12], 768, cwl, tid);
    __syncthreads();
    for (int c = bid; c < 130; c += nb) {
        const int L = c < 128 ? SEQ : CTX, t0 = c < 128 ? c * 128 : (c - 128) * 128, rbase = c < 128 ? 0 : SEQ;
        const int trow = wid * 16 + r;
        float ssq = 0.f;
        {
            const int h = wid;
#pragma unroll
            for (int d = 0; d < 2; ++d) {
                const float A = -expf(p.in[14][d * 8 + h]), dtb = p.in[13][d * 8 + h];
                const float dt0 = softplusf(SMALL[(size_t)(rbase + t0 + 2 * lane) * 32 + d * 8 + h] + dtb), dt1 = softplusf(SMALL[(size_t)(rbase + t0 + 2 * lane + 1) * 32 + d * 8 + h] + dtb);
                const float a0 = dt0 * A, a1 = dt1 * A;
                float c0 = a0, c1 = a1; const float tot = wave_scan128(c0, c1, lane);
                csb[(h * 2 + d) * 128 + 2 * lane] = d == 0 ? c0 : tot - c0 + a0; csb[(h * 2 + d) * 128 + 2 * lane + 1] = d == 0 ? c1 : tot - c1 + a1;
                dts[(h * 2 + d) * 128 + 2 * lane] = dt0; dts[(h * 2 + d) * 128 + 2 * lane + 1] = dt1;
            }
        }
        for (int g = 0; g < 2; ++g) {
            {
                Raw3 rw[4];
#pragma unroll
                for (int k = 0; k < 4; ++k) { const int i = tid + k * NTH; const int cg8 = i & 15, tl = i >> 4;
                    const int ch = cg8 < 8 ? 640 + g * 64 + cg8 * 8 : 512 + g * 64 + (cg8 - 8) * 8;
                    rw[k] = conv8_load(PROJ + (size_t)(rbase + t0 + tl) * 2048 + 512 + ch, 2048, t0 + tl, L); }
#pragma unroll
                for (int k = 0; k < 4; ++k) { const int i = tid + k * NTH; const int cg8 = i & 15, tl = i >> 4;
                    const int ch = cg8 < 8 ? 640 + g * 64 + cg8 * 8 : 512 + g * 64 + (cg8 - 8) * 8;
                    float o[8]; conv8_apply(rw[k], cwl + ch * 4, o);
                    uint4 w; w.x = pack2(o[0], o[1]); w.y = pack2(o[2], o[3]); w.z = pack2(o[4], o[5]); w.w = pack2(o[6], o[7]);
                    *(uint4*)((cg8 < 8 ? Cg + cg8 * 8 : Bg + (cg8 - 8) * 8) + tl * 72) = w; }
            }
            __syncthreads();
            f32x4 G[1][8];
#pragma unroll
            for (int ni = 0; ni < 8; ++ni) G[0][ni] = (f32x4){0.f, 0.f, 0.f, 0.f};
            wave_mma<1, 8, 64, true>(G, Cg + wid * 16 * 72, 72, Bg, 72, lane);
            for (int hh = 0; hh < 4; ++hh) {
                const int h = g * 4 + hh;
                {
                    Raw3 rw[2];
#pragma unroll
                    for (int k = 0; k < 2; ++k) { const int i = tid + k * NTH; const int cg8 = (i >> 3) & 7, tl = (i >> 6) * 8 + (i & 7); const int ch = h * 64 + cg8 * 8;
                        rw[k] = conv8_load(PROJ + (size_t)(rbase + t0 + tl) * 2048 + 512 + ch, 2048, t0 + tl, L); }
                    const uint4 hp0 = *(const uint4*)(HIN + ((size_t)(c * 2 + 0) * 8 + h) * 4096 + tid * 8), hp1 = *(const uint4*)(HIN + ((size_t)(c * 2 + 1) * 8 + h) * 4096 + tid * 8);
#pragma unroll
                    for (int k = 0; k < 2; ++k) { const int i = tid + k * NTH; const int cg8 = (i >> 3) & 7, tl = (i >> 6) * 8 + (i & 7); const int ch = h * 64 + cg8 * 8;
                        float o[8]; conv8_apply(rw[k], cwl + ch * 4, o);
#pragma unroll
                        for (int j = 0; j < 8; ++j) XT[(cg8 * 8 + j) * 136 + (tl ^ (cg8 << 3))] = f2bf(o[j]); }
                    *(uint4*)(Hn + (tid >> 3) * 72 + (tid & 7) * 8) = hp0; *(uint4*)(Hn + 64 * 72 + (tid >> 3) * 72 + (tid & 7) * 8) = hp1;
                }
                __syncthreads();
                f32x4 Y[1][4];
#pragma unroll
                for (int ni = 0; ni < 4; ++ni) Y[0][ni] = (f32x4){0.f, 0.f, 0.f, 0.f};
                for (int d = 0; d < 2; ++d) {
                    const float cst = csb[(h * 2 + d) * 128 + trow];
#pragma unroll
                    for (int ni = 0; ni < 8; ++ni) {
                        const int s0 = 16 * ni + 4 * q;
                        const float4 css = *(const float4*)(csb + (h * 2 + d) * 128 + s0), dtv = *(const float4*)(dts + (h * 2 + d) * 128 + s0);
                        const float cs4[4] = {css.x, css.y, css.z, css.w}, dt4[4] = {dtv.x, dtv.y, dtv.z, dtv.w};
                        float m[4];
#pragma unroll
                        for (int j = 0; j < 4; ++j) { const int sidx = s0 + j; const bool ok = d == 0 ? sidx <= trow : sidx >= trow; m[j] = ok ? G[0][ni][j] * __expf(cst - cs4[j]) * dt4[j] : 0.f; }
                        uint2 w; w.x = pack2(m[0], m[1]); w.y = pack2(m[2], m[3]);
                        *(uint2*)(Mb + trow * 136 + s0) = w;
                    }
                    __syncthreads();
                    wave_mma<1, 4, 128, true, true>(Y, Mb + wid * 16 * 136, 136, XT, 136, lane);
                    f32x4 Yo[1][4];
#pragma unroll
                    for (int ni = 0; ni < 4; ++ni) Yo[0][ni] = (f32x4){0.f, 0.f, 0.f, 0.f};
                    wave_mma<1, 4, 64, true>(Yo, Cg + wid * 16 * 72, 72, Hn + d * 64 * 72, 72, lane);
                    const float ecs = __expf(cst);
#pragma unroll
                    for (int ni = 0; ni < 4; ++ni) Y[0][ni] += Yo[0][ni] * ecs;
                    __syncthreads();
                }
                const float Dh = p.in[15][h];
                const size_t grow = (size_t)(rbase + t0 + trow);
#pragma unroll
                for (int ni = 0; ni < 4; ++ni) {
                    const int p0 = 16 * ni + 4 * q;
                    const uint2 zr = *(const uint2*)(PROJ + grow * 2048 + h * 64 + p0);
                    const float z4[4] = {__uint_as_float(zr.x << 16), __uint_as_float(zr.x & 0xffff0000u), __uint_as_float(zr.y << 16), __uint_as_float(zr.y & 0xffff0000u)};
                    float u[4];
#pragma unroll
                    for (int j = 0; j < 4; ++j) { const float y = Y[0][ni][j] + Dh * bf2f(XT[(p0 + j) * 136 + (trow ^ ((((p0 + j) >> 3) & 7) << 3))]); u[j] = y * siluf(z4[j]); ssq += u[j] * u[j]; }
                    uint2 w; w.x = pack2(u[0], u[1]); w.y = pack2(u[2], u[3]);
                    *(uint2*)(MIX + grow * 1024 + h * 64 + p0) = w;
                }
                __syncthreads();
            }
        }
        ssq += __shfl_xor(ssq, 16); ssq += __shfl_xor(ssq, 32);
        const float rs = rsqrtf(ssq * (1.f / 512.f) + 1e-6f);
        const size_t grow = (size_t)(rbase + t0 + trow);
        for (int h = 0; h < 8; ++h)
#pragma unroll
            for (int ni = 0; ni < 4; ++ni) {
                const int col = h * 64 + 16 * ni + 4 * q;
                const uint2 ur = *(const uint2*)(MIX + grow * 1024 + col);
                const float4 nw = *(const float4*)(p.in[16] + col);
                uint2 w; w.x = pack2(__uint_as_float(ur.x << 16) * rs * nw.x, __uint_as_float(ur.x & 0xffff0000u) * rs * nw.y);
                w.y = pack2(__uint_as_float(ur.y << 16) * rs * nw.z, __uint_as_float(ur.y & 0xffff0000u) * rs * nw.w);
                *(uint2*)(MIX + grow * 1024 + col) = w;
            }
    }
}


__device__ __forceinline__ void attn_mfma(const P& p, int bid, int nb, float* lds) {
    const int tid = p.tid(), lane = tid & 63, wid = __builtin_amdgcn_readfirstlane(tid >> 6), r = lane & 15, q = lane >> 4;
    unsigned char* ws = p.get_ws();
    const bf16_t* PROJ = (const bf16_t*)(ws + WS_PROJ);
    const bf16_t* QKR = (const bf16_t*)(ws + WS_XRES);
    bf16_t* MIX = (bf16_t*)(ws + WS_HB);
    bf16_t* Kb = (bf16_t*)lds;
    bf16_t* Vb = Kb + 2 * 64 * 72;
    for (int item = bid; item < 260; item += nb) {
        const bool isctx = item >= 256;
        const int qb = isctx ? (item - 256) >> 1 : item >> 1, g = item & 1;
        const int qrow0 = (isctx ? SEQ : 0) + qb * 128;
        const int hq = g * 4 + (wid >> 1), wrow0 = (wid & 1) * 64;
        const int ntl = isctx ? 0 : 6, nt = ntl + 4;
        bf16_t* Qw = Vb + 2 * 64 * 72 + wid * 64 * 72;
#pragma unroll
        for (int mi = 0; mi < 4; ++mi)
#pragma unroll
            for (int kk = 0; kk < 2; ++kk) {
                const uint4 raw = *(const uint4*)(QKR + (size_t)(qrow0 + wrow0 + 16 * mi + r) * 640 + hq * 64 + kk * 32 + 8 * q);
                float f[8]; unpack8(raw, f);
                uint4 o; o.x = pack2(f[0] * 0.125f, f[1] * 0.125f); o.y = pack2(f[2] * 0.125f, f[3] * 0.125f); o.z = pack2(f[4] * 0.125f, f[5] * 0.125f); o.w = pack2(f[6] * 0.125f, f[7] * 0.125f);
                *(uint4*)(Qw + (16 * mi + r) * 72 + kk * 32 + 8 * q) = o;
            }
        const float sink = p.in[19][hq];
        float m[4], l[4]; f32x4 O[4][4];
#pragma unroll
        for (int mi = 0; mi < 4; ++mi) { m[mi] = sink; l[mi] = q == 0 ? 1.f : 0.f;
#pragma unroll
            for (int ni = 0; ni < 4; ++ni) O[mi][ni] = (f32x4){0.f, 0.f, 0.f, 0.f}; }
#define ATT_VALID(ti_) ((ti_) >= ntl || (qb * 128 - 128 + 64 * (ti_) >= 0 && qb * 128 - 128 + 64 * (ti_) < SEQ))
#define ATT_KROW(ti_) ((ti_) < ntl ? qb * 128 - 128 + 64 * (ti_) : SEQ + 64 * ((ti_) - ntl))
        int ti = 0; while (ti < nt && !ATT_VALID(ti)) ++ti;
        uint4 kreg, vreg;
        { const int kr0 = ATT_KROW(ti);
          kreg = *(const uint4*)(QKR + (size_t)(kr0 + (tid >> 3)) * 640 + 512 + g * 64 + (tid & 7) * 8);
          vreg = *(const uint4*)(PROJ + (size_t)(kr0 + (tid >> 3)) * 2048 + 1920 + g * 64 + (tid & 7) * 8); }
        int cur = 0;
        __syncthreads();
        { *(uint4*)(Kb + (tid >> 3) * 72 + (tid & 7) * 8) = kreg;
          bf16_t* vd = Vb + ((tid & 7) * 8) * 72 + ((tid >> 3) ^ ((tid & 7) << 3)); const u32 vw[4] = {vreg.x, vreg.y, vreg.z, vreg.w};
#pragma unroll
          for (int j = 0; j < 4; ++j) { vd[(2 * j) * 72] = (bf16_t)(vw[j] & 0xffff); vd[(2 * j + 1) * 72] = (bf16_t)(vw[j] >> 16); } }
        __syncthreads();
        while (ti < nt) {
            int tn = ti + 1; while (tn < nt && !ATT_VALID(tn)) ++tn;
            if (tn < nt) { const int kr0 = ATT_KROW(tn);
                kreg = *(const uint4*)(QKR + (size_t)(kr0 + (tid >> 3)) * 640 + 512 + g * 64 + (tid & 7) * 8);
                vreg = *(const uint4*)(PROJ + (size_t)(kr0 + (tid >> 3)) * 2048 + 1920 + g * 64 + (tid & 7) * 8); }
            const bool local = ti < ntl;
            const bool need = !local || ((wid & 1) == 0 ? ti <= 4 : ti >= 1);
            if (need) {
                const bf16_t* Kt = Kb + cur * 64 * 72; const bf16_t* Vt = Vb + cur * 64 * 72;
                const int kp0 = qb * 128 - 128 + 64 * ti + 4 * q, qp0 = qb * 128 + wrow0 + r;
#pragma unroll
                for (int mi = 0; mi < 4; ++mi) {
                    f32x4 S[4];
#pragma unroll
                    for (int ni = 0; ni < 4; ++ni) S[ni] = (f32x4){0.f, 0.f, 0.f, 0.f};
#pragma unroll
                    for (int kk = 0; kk < 2; ++kk) {
                        const bf16x8 qfr = *(const bf16x8*)(Qw + (16 * mi + r) * 72 + kk * 32 + 8 * q);
#pragma unroll
                        for (int ni = 0; ni < 4; ++ni) {
                            const bf16x8 bfr = *(const bf16x8*)(Kt + (16 * ni + r) * 72 + kk * 32 + 8 * q);
                            S[ni] = __builtin_amdgcn_mfma_f32_16x16x32_bf16(bfr, qfr, S[ni], 0, 0, 0);
                        }
                    }
                    if (local) {
#pragma unroll
                        for (int ni = 0; ni < 4; ++ni)
#pragma unroll
                            for (int j = 0; j < 4; ++j) { const int dlt = (qp0 + 16 * mi) - (kp0 + 16 * ni + j); if (dlt > 128 || dlt < -128) S[ni][j] = -1e30f; }
                    }
                    float mx = -1e30f;
#pragma unroll
                    for (int ni = 0; ni < 4; ++ni)
#pragma unroll
                        for (int j = 0; j < 4; ++j) mx = fmaxf(mx, S[ni][j]);
                    mx = fmaxf(mx, __shfl_xor(mx, 16)); mx = fmaxf(mx, __shfl_xor(mx, 32));
                    const float mn = fmaxf(m[mi], mx), al = __expf(m[mi] - mn);
                    m[mi] = mn;
                    float ps = 0.f;
#pragma unroll
                    for (int ni = 0; ni < 4; ++ni)
#pragma unroll
                        for (int j = 0; j < 4; ++j) { const float e = __expf(S[ni][j] - mn); S[ni][j] = e; ps += e; }
                    l[mi] = l[mi] * al + ps;
#pragma unroll
                    for (int ni = 0; ni < 4; ++ni) O[mi][ni] *= al;
                    __builtin_amdgcn_sched_barrier(0);
#pragma unroll
                    for (int kk = 0; kk < 2; ++kk) {
                        uint4 o; o.x = pack2(S[2 * kk][0], S[2 * kk][1]); o.y = pack2(S[2 * kk][2], S[2 * kk][3]);
                        o.z = pack2(S[2 * kk + 1][0], S[2 * kk + 1][1]); o.w = pack2(S[2 * kk + 1][2], S[2 * kk + 1][3]);
                        const bf16x8 pfr = *(bf16x8*)&o;
#pragma unroll
                        for (int ni = 0; ni < 4; ++ni) {
                            const int vsw = (((16 * ni + r) >> 3) & 7) << 3;
                            const uint2 v0 = *(const uint2*)(Vt + (16 * ni + r) * 72 + ((32 * kk + 4 * q) ^ vsw)), v1 = *(const uint2*)(Vt + (16 * ni + r) * 72 + ((32 * kk + 16 + 4 * q) ^ vsw));
                            uint4 vo; vo.x = v0.x; vo.y = v0.y; vo.z = v1.x; vo.w = v1.y;
                            O[mi][ni] = __builtin_amdgcn_mfma_f32_16x16x32_bf16(*(bf16x8*)&vo, pfr, O[mi][ni], 0, 0, 0);
                        }
                    }
                    __builtin_amdgcn_sched_barrier(0);
                }
            }
            if (tn < nt) {
                *(uint4*)(Kb + (cur ^ 1) * 64 * 72 + (tid >> 3) * 72 + (tid & 7) * 8) = kreg;
                bf16_t* vd = Vb + (cur ^ 1) * 64 * 72 + ((tid & 7) * 8) * 72 + ((tid >> 3) ^ ((tid & 7) << 3)); const u32 vw[4] = {vreg.x, vreg.y, vreg.z, vreg.w};
#pragma unroll
                for (int j = 0; j < 4; ++j) { vd[(2 * j) * 72] = (bf16_t)(vw[j] & 0xffff); vd[(2 * j + 1) * 72] = (bf16_t)(vw[j] >> 16); }
            }
            __syncthreads();
            ti = tn; cur ^= 1;
        }
#undef ATT_VALID
#undef ATT_KROW
#pragma unroll
        for (int mi = 0; mi < 4; ++mi) {
            float lt = l[mi]; lt += __shfl_xor(lt, 16); lt += __shfl_xor(lt, 32);
            const float inv = 1.f / lt;
            bf16_t* op = MIX + (size_t)(qrow0 + wrow0 + 16 * mi + r) * 1024 + 512 + hq * 64 + 4 * q;
#pragma unroll
            for (int ni = 0; ni < 4; ++ni) { uint2 w; w.x = pack2(O[mi][ni][0] * inv, O[mi][ni][1] * inv); w.y = pack2(O[mi][ni][2] * inv, O[mi][ni][3] * inv); *(uint2*)(op + 16 * ni) = w; }
        }
    }
}


constexpr size_t ML_ST_OFF = 0;
constexpr size_t ML_CIN_OFF = (size_t)130 * 16 * 8192 * 2;
constexpr int CH_DEC = 0, CH_BL = 4096, CH_AC = 8192, CH_MIN = 12288, CH_NC = 16384, CH_NIN = 16384 + 130 * 16 * 64;
__device__ __forceinline__ void stage_convw_part(const float* cw, const float* cb, int C, int c0, int n, float* cwl, int tid) {
    for (int i = tid; i < n; i += NTH) *(float4*)(cwl + i * 4) = make_float4(cw[c0 + i], cw[C + c0 + i], cw[2 * C + c0 + i], cb[c0 + i]);
}
__device__ __forceinline__ void ml_states(const P& p, int bid, int nb, float* lds) {
    const int tid = p.tid(), lane = tid & 63, wid = tid >> 6, r = lane & 15, q = lane >> 4;
    unsigned char* ws = p.get_ws();
    const bf16_t* PROJ = (const bf16_t*)(ws + WS_PROJ);
    const float* SMALL = (const float*)(ws + WS_SMALL);
    bf16_t* ST = (bf16_t*)(ws + WS_Y + ML_ST_OFF);
    float* CHK = (float*)(ws + WS_CHK);
    float* cwl = lds;
    bf16_t* VT = (bf16_t*)(lds + 384 * 4);
    bf16_t* KT = VT + 2 * 128 * 136;
    float* es = (float*)(KT + 2 * 64 * 136);
    for (int item = bid; item < 520; item += nb) {
        const int c = item >> 2, hp = item & 3;
        const int L = c < 128 ? SEQ : CTX, t0 = c < 128 ? c * 128 : (c - 128) * 128, rbase = c < 128 ? 0 : SEQ;
        if (tid < 384) { const int ch = tid < 128 ? 512 + hp * 128 + tid : 1024 + hp * 256 + (tid - 128);
            const float* cw = p.in[22]; *(float4*)(cwl + tid * 4) = make_float4(cw[ch], cw[2048 + ch], cw[4096 + ch], p.in[23][ch]); }
        __syncthreads();
#pragma unroll 1
        for (int b4 = 0; b4 < 3; ++b4) {
            Raw3 rw[4];
#pragma unroll
            for (int k = 0; k < 4; ++k) { const int i = tid + (b4 * 4 + k) * NTH; const int cg8 = (i >> 3) % 48, tl = (i / 384) * 8 + (i & 7);
                const int col = cg8 < 16 ? 512 + hp * 128 + cg8 * 8 : 1024 + hp * 256 + (cg8 - 16) * 8;
                rw[k] = conv8_load(PROJ + (size_t)(rbase + t0 + tl) * 3072 + col, 3072, t0 + tl, L); }
#pragma unroll
            for (int k = 0; k < 4; ++k) { const int i = tid + (b4 * 4 + k) * NTH; const int cg8 = (i >> 3) % 48, tl = (i / 384) * 8 + (i & 7);
                float o[8]; conv8_apply(rw[k], cwl + cg8 * 32, o);
                const float sc = cg8 < 16 ? 0.125f : 1.f;
                const int tls = tl ^ ((cg8 & 7) << 3);
                bf16_t* dst = cg8 < 16 ? KT + (cg8 * 8) * 136 + tls : VT + ((cg8 - 16) * 8) * 136 + tls;
#pragma unroll
                for (int j = 0; j < 8; ++j) dst[j * 136] = f2bf(o[j] * sc); }
        }
        const int hl = wid >> 2, d = (wid >> 1) & 1, vh = wid & 1, h = hp * 2 + hl, dh = d * 8 + h;
        float tot, ac;
        {
            const float igb = p.in[24][dh], fgb = p.in[25][dh];
            const float* sm0 = SMALL + (size_t)(rbase + t0 + 2 * lane) * 32;
            const float ig0 = sm0[dh] + igb, ig1 = sm0[32 + dh] + igb, lf0 = logsigf(sm0[16 + dh] + fgb), lf1 = logsigf(sm0[32 + 16 + dh] + fgb);
            float c0 = lf0, c1 = lf1; tot = wave_scan128(c0, c1, lane);
            const float w0 = (d == 0 ? tot - c0 : c0 - lf0) + ig0, w1 = (d == 0 ? tot - c1 : c1 - lf1) + ig1;
            ac = fmaxf(w0, w1);
#pragma unroll
            for (int o = 32; o >= 1; o >>= 1) ac = fmaxf(ac, __shfl_xor(ac, o));
            es[wid * 128 + 2 * lane] = __expf(w0 - ac); es[wid * 128 + 2 * lane + 1] = __expf(w1 - ac);
        }
        __syncthreads();
        {
            f32x4 acc[4][4];
#pragma unroll
            for (int mi = 0; mi < 4; ++mi)
#pragma unroll
                for (int ni = 0; ni < 4; ++ni) acc[mi][ni] = (f32x4){0.f, 0.f, 0.f, 0.f};
            const bf16_t* Ab = VT + (hl * 128 + vh * 64) * 136; const bf16_t* Bb = KT + (hl * 64) * 136;
#pragma unroll
            for (int kk = 0; kk < 128; kk += 32) {
                const float4 wa = *(const float4*)(es + wid * 128 + kk + 8 * q), wb = *(const float4*)(es + wid * 128 + kk + 8 * q + 4);
                bf16x8 a[4], b[4];
#pragma unroll
                for (int mi = 0; mi < 4; ++mi) a[mi] = *(const bf16x8*)(Ab + (16 * mi + r) * 136 + ((kk + 8 * q) ^ ((((16 * mi + r) >> 3) & 7) << 3)));
#pragma unroll
                for (int ni = 0; ni < 4; ++ni) {
                    const uint4 raw = *(const uint4*)(Bb + (16 * ni + r) * 136 + ((kk + 8 * q) ^ ((((16 * ni + r) >> 3) & 7) << 3)));
                    float f[8]; unpack8(raw, f);
                    uint4 o; o.x = pack2(f[0] * wa.x, f[1] * wa.y); o.y = pack2(f[2] * wa.z, f[3] * wa.w); o.z = pack2(f[4] * wb.x, f[5] * wb.y); o.w = pack2(f[6] * wb.z, f[7] * wb.w);
                    b[ni] = *(bf16x8*)&o;
                }
#pragma unroll
                for (int mi = 0; mi < 4; ++mi)
#pragma unroll
                    for (int ni = 0; ni < 4; ++ni) acc[mi][ni] = __builtin_amdgcn_mfma_f32_16x16x32_bf16(b[ni], a[mi], acc[mi][ni], 0, 0, 0);
                __builtin_amdgcn_sched_barrier(0);
            }
            bf16_t* Sp = ST + ((size_t)c * 16 + dh) * 8192 + (vh * 64) * 64;
#pragma unroll
            for (int mi = 0; mi < 4; ++mi)
#pragma unroll
                for (int ni = 0; ni < 4; ++ni) { uint2 w; w.x = pack2(acc[mi][ni][0], acc[mi][ni][1]); w.y = pack2(acc[mi][ni][2], acc[mi][ni][3]); *(uint2*)(Sp + (16 * mi + r) * 64 + 16 * ni + 4 * q) = w; }
            if (vh == 0) {
                float nsum = 0.f; const bf16_t* kr = Bb + lane * 136;
#pragma unroll 4
                for (int s8 = 0; s8 < 128; s8 += 8) { float f[8]; unpack8(*(const uint4*)(kr + (s8 ^ (((lane >> 3) & 7) << 3))), f);
#pragma unroll
                    for (int j = 0; j < 8; ++j) nsum += f[j] * es[wid * 128 + s8 + j]; }
                CHK[CH_NC + (c * 16 + dh) * 64 + lane] = nsum;
                if (lane == 0) { CHK[CH_BL + c * 16 + dh] = tot; CHK[CH_AC + c * 16 + dh] = ac; }
            }
        }
        __syncthreads();
    }
}
__device__ __forceinline__ void ml_scan(const P& p, int bid, int nb) {
    const int tid = p.tid();
    unsigned char* ws = p.get_ws();
    const bf16_t* ST = (const bf16_t*)(ws + WS_Y + ML_ST_OFF);
    bf16_t* CIN = (bf16_t*)(ws + WS_Y + ML_CIN_OFF);
    float* CHK = (float*)(ws + WS_CHK);
    for (int gid = bid * NTH + tid; gid < 131072; gid += nb * NTH) {
        const int dh = gid >> 13, d = dh >> 3, e = gid & 8191;
        float C = 0.f, n = 0.f, m = 0.f;
#pragma unroll 1
        for (int i0 = 0; i0 < 130; i0 += 10) {
            float sv[10], bl[10], av[10], nv[10]; int cc[10];
#pragma unroll
            for (int j = 0; j < 10; ++j) {
                const int i = i0 + j;
                const int c = d == 0 ? (i < 2 ? 128 + i : i - 2) : 129 - i;
                cc[j] = c; sv[j] = bf2f(ST[((size_t)c * 16 + dh) * 8192 + e]); bl[j] = CHK[CH_BL + c * 16 + dh]; av[j] = CHK[CH_AC + c * 16 + dh];
                nv[j] = e < 64 ? CHK[CH_NC + (c * 16 + dh) * 64 + e] : 0.f;
            }
#pragma unroll
            for (int j = 0; j < 10; ++j) {
                CIN[((size_t)cc[j] * 16 + dh) * 8192 + e] = f2bf(C);
                if (e < 64) CHK[CH_NIN + (cc[j] * 16 + dh) * 64 + e] = n;
                if (e == 0) CHK[CH_MIN + cc[j] * 16 + dh] = m;
                const float mn = fmaxf(bl[j] + m, av[j]);
                const float sp = __expf(bl[j] + m - mn), sc = __expf(av[j] - mn);
                C = sp * C + sc * sv[j]; n = sp * n + sc * nv[j]; m = mn;
            }
        }
    }
}
__device__ __forceinline__ void ml_out(const P& p, int bid, int nb, float* lds) {
    unsigned char* tsbase = (unsigned char*)lds + LDS_BYTES - 128; (void)tsbase;
    const int tid = p.tid(), lane = tid & 63, wid = tid >> 6, r = lane & 15, q = lane >> 4;
    unsigned char* ws = p.get_ws();
    const bf16_t* PROJ = (const bf16_t*)(ws + WS_PROJ);
    const float* SMALL = (const float*)(ws + WS_SMALL);
    const bf16_t* CIN = (const bf16_t*)(ws + WS_Y + ML_CIN_OFF);
    const float* CHK = (const float*)(ws + WS_CHK);
    bf16_t* MIX = (bf16_t*)(ws + WS_HB);
    float* cwl = lds;
    bf16_t* Qs = (bf16_t*)(lds + 256 * 4);
    bf16_t* Ks = Qs + 128 * 72;
    bf16_t* VT = Ks + 128 * 72;
    bf16_t* Wb = VT + 128 * 136;
    bf16_t* Ct = Wb + 128 * 136;
    float* bet = (float*)(Ct + 2 * 128 * 72);
    float* igs = bet + 8 * 128;
    float* nin = igs + 8 * 128;
    float* mins = nin + 8 * 64;
    for (int item = bid; item < 256; item += nb) {
        const int c = item >> 1, hg = item & 1;
        const int t0 = c * 128;
        const int trow = wid * 16 + r;
        const size_t grow = (size_t)(t0 + trow);
        __syncthreads();
        {
            const int d = wid & 1, dh = d * 8 + hg * 4 + (wid >> 1), cb8 = wid;
            const float igb = p.in[24][dh], fgb = p.in[25][dh];
            const float* sm0 = SMALL + (size_t)(t0 + 2 * lane) * 32;
            const float ig0 = sm0[dh] + igb, ig1 = sm0[32 + dh] + igb, lf0 = logsigf(sm0[16 + dh] + fgb), lf1 = logsigf(sm0[32 + 16 + dh] + fgb);
            float c0 = lf0, c1 = lf1; const float tot = wave_scan128(c0, c1, lane);
            bet[cb8 * 128 + 2 * lane] = d == 0 ? c0 : tot - c0 + lf0; bet[cb8 * 128 + 2 * lane + 1] = d == 0 ? c1 : tot - c1 + lf1;
            igs[cb8 * 128 + 2 * lane] = ig0; igs[cb8 * 128 + 2 * lane + 1] = ig1;
            nin[cb8 * 64 + lane] = CHK[CH_NIN + (c * 16 + dh) * 64 + lane];
            if (lane == 0) mins[cb8] = CHK[CH_MIN + c * 16 + dh];
        }
        for (int hh = 0; hh < 4; ++hh) {
            const int h = hg * 4 + hh;
            const int tid = p.tid(), lane = tid & 63, wid = tid >> 6, r = lane & 15, q = lane >> 4;
            const int trow = wid * 16 + r;
            const size_t grow = (size_t)(t0 + trow);
            if (hh == 0) TS(0);
            if (hh == 1) TS(5);
            if (tid < 256) { const int ch = tid < 64 ? h * 64 + tid : (tid < 128 ? 512 + h * 64 + (tid - 64) : 1024 + h * 128 + (tid - 128));
                const float* cw = p.in[22]; *(float4*)(cwl + tid * 4) = make_float4(cw[ch], cw[2048 + ch], cw[4096 + ch], p.in[23][ch]); }
            if (hh < 3) {
                float* dummy = (float*)((unsigned char*)lds + LDS_BYTES - 4096);
#pragma unroll
                for (int j = 0; j < 2; ++j) {
                    const int idx = tid + j * NTH, hn = h + 1;
                    const bf16_t* g;
                    if (idx < 520) { const int rr = idx < 130 ? idx : (idx < 260 ? idx - 130 : (idx - 260) >> 1);
                        int t = t0 - 1 + rr; t = t < 0 ? 0 : (t > SEQ - 1 ? SEQ - 1 : t);
                        const int col = idx < 130 ? hn * 64 : (idx < 260 ? 512 + hn * 64 : 1024 + hn * 128 + ((idx - 260) & 1) * 64);
                        g = PROJ + (size_t)t * 3072 + col; }
                    else { const int li = idx - 520; g = CIN + ((size_t)c * 16 + (li >> 7) * 8 + hn) * 8192 + (li & 127) * 64; }
                    if (idx < 776) prefetch_line(g, dummy, wid);
                }
            }
            const bf16_t* cp0 = CIN + ((size_t)c * 16 + h) * 8192 + tid * 16; const bf16_t* cp1 = cp0 + (size_t)8 * 8192;
            const uint4 c00 = *(const uint4*)cp0, c01 = *(const uint4*)(cp0 + 8), c10 = *(const uint4*)cp1, c11 = *(const uint4*)(cp1 + 8);
            Raw3 rq[4], rv[4];
#pragma unroll
            for (int k = 0; k < 4; ++k) { const int i = tid + k * NTH; const int cg8 = i & 15, tl = i >> 4;
                rq[k] = conv8_load(PROJ + (size_t)(t0 + tl) * 3072 + (cg8 < 8 ? h * 64 + cg8 * 8 : 512 + h * 64 + (cg8 - 8) * 8), 3072, t0 + tl, SEQ); }
#pragma unroll
            for (int k = 0; k < 4; ++k) { const int i = tid + k * NTH; const int vg = (i >> 3) & 15, tl = (i >> 7) * 8 + (i & 7);
                rv[k] = conv8_load(PROJ + (size_t)(t0 + tl) * 3072 + 1024 + h * 128 + vg * 8, 3072, t0 + tl, SEQ); }
            if (hh == 0) TS(6);
            __syncthreads();
            if (hh == 0) TS(7);
#pragma unroll
            for (int k = 0; k < 4; ++k) {
                const int i = tid + k * NTH; const int cg8 = i & 15, tl = i >> 4;
                float o[8]; conv8_apply(rq[k], cwl + cg8 * 32, o);
                const float sc = cg8 < 8 ? 1.f : 0.125f;
                uint4 w; w.x = pack2(o[0] * sc, o[1] * sc); w.y = pack2(o[2] * sc, o[3] * sc); w.z = pack2(o[4] * sc, o[5] * sc); w.w = pack2(o[6] * sc, o[7] * sc);
                *(uint4*)((cg8 < 8 ? Qs + cg8 * 8 : Ks + (cg8 - 8) * 8) + tl * 72) = w;
            }
            if (hh == 0) TS(8);
#pragma unroll 1
            for (int rep_ = 0; rep_ < EXP_ML_V; ++rep_) {
#pragma unroll
            for (int k = 0; k < 4; ++k) {
                const int i = tid + k * NTH; const int vg = (i >> 3) & 15, tl = (i >> 7) * 8 + (i & 7);
                float o[8]; conv8_apply(rv[k], cwl + (128 + vg * 8) * 4, o);
#pragma unroll
                for (int j = 0; j < 8; ++j) VT[(vg * 8 + j) * 136 + (tl ^ ((vg & 7) << 3))] = f2bf(o[j]);
            }
            asm volatile("" ::: "memory");
            }
            if (hh == 0) TS(9);
            { bf16_t* cd = Ct + (tid >> 2) * 72 + (tid & 3) * 16; *(uint4*)cd = c00; *(uint4*)(cd + 8) = c01; *(uint4*)(cd + 128 * 72) = c10; *(uint4*)(cd + 128 * 72 + 8) = c11; }
            __syncthreads();
            if (hh == 0) TS(1);
            f32x4 QK[1][8];
#pragma unroll
            for (int ni = 0; ni < 8; ++ni) QK[0][ni] = (f32x4){0.f, 0.f, 0.f, 0.f};
            wave_mma<1, 8, 64, true>(QK, Qs + wid * 16 * 72, 72, Ks, 72, lane);
            if (hh == 0) TS(2);
            f32x4 Hs[8];
#pragma unroll
            for (int ni = 0; ni < 8; ++ni) Hs[ni] = (f32x4){0.f, 0.f, 0.f, 0.f};
            for (int dq = 0; dq < 2 + EXP_ML_D; ++dq) {
                const int d = dq & 1; const bool discard = dq >= 2;
                const int dh = d * 8 + h;
                const float bt = bet[(hh * 2 + d) * 128 + trow], g = bt + mins[hh * 2 + d];
                float dl[32]; float mx = -1e30f;
#pragma unroll
                for (int ni = 0; ni < 8; ++ni) {
                    const int s0 = 16 * ni + 4 * q;
                    const float4 bs = *(const float4*)(bet + (hh * 2 + d) * 128 + s0), iv = *(const float4*)(igs + (hh * 2 + d) * 128 + s0);
                    const float b4[4] = {bs.x, bs.y, bs.z, bs.w}, i4[4] = {iv.x, iv.y, iv.z, iv.w};
#pragma unroll
                    for (int j = 0; j < 4; ++j) { const int sidx = s0 + j; const bool ok = d == 0 ? sidx <= trow : sidx >= trow; const float v = ok ? bt - b4[j] + i4[j] : -1e30f; dl[ni * 4 + j] = v; mx = fmaxf(mx, v); }
                }
                mx = fmaxf(mx, __shfl_xor(mx, 16)); mx = fmaxf(mx, __shfl_xor(mx, 32));
                const float ms = fmaxf(g, mx);
                float rsum = 0.f;
#pragma unroll
                for (int ni = 0; ni < 8; ++ni) {
                    float w4[4];
#pragma unroll
                    for (int j = 0; j < 4; ++j) { w4[j] = dl[ni * 4 + j] > -1e29f ? __expf(dl[ni * 4 + j] - ms) * QK[0][ni][j] : 0.f; rsum += w4[j]; }
                    uint2 w; w.x = pack2(w4[0], w4[1]); w.y = pack2(w4[2], w4[3]);
                    *(uint2*)(Wb + trow * 136 + 16 * ni + 4 * q) = w;
                }
                rsum += __shfl_xor(rsum, 16); rsum += __shfl_xor(rsum, 32);
                __syncthreads();
                f32x4 Nm[1][8], Ni[1][8];
#pragma unroll
                for (int ni = 0; ni < 8; ++ni) { Nm[0][ni] = (f32x4){0.f, 0.f, 0.f, 0.f}; Ni[0][ni] = (f32x4){0.f, 0.f, 0.f, 0.f}; }
                wave_mma<1, 8, 128, true, true>(Nm, Wb + wid * 16 * 136, 136, VT, 136, lane);
                wave_mma<1, 8, 64, true>(Ni, Qs + wid * 16 * 72, 72, Ct + d * 128 * 72, 72, lane);
                float qn = 0.f;
                { float f[8]; unpack8(*(const uint4*)(Qs + trow * 72 + 16 * q), f);
#pragma unroll
                  for (int j = 0; j < 8; ++j) qn += f[j] * nin[(hh * 2 + d) * 64 + 16 * q + j];
                  unpack8(*(const uint4*)(Qs + trow * 72 + 16 * q + 8), f);
#pragma unroll
                  for (int j = 0; j < 8; ++j) qn += f[j] * nin[(hh * 2 + d) * 64 + 16 * q + 8 + j]; }
                qn += __shfl_xor(qn, 16); qn += __shfl_xor(qn, 32);
                const float ei = __expf(g - ms);
                const float den = rsum + qn * ei;
                const float inv = 1.f / fmaxf(fabsf(den), __expf(-ms));
#pragma unroll
                for (int ni = 0; ni < 8; ++ni) Hs[ni] += (Nm[0][ni] + Ni[0][ni] * ei) * (discard ? 0.f : inv);
                __syncthreads();
            }
            if (hh == 0) TS(3);
            float ssq = 0.f;
#pragma unroll
            for (int ni = 0; ni < 8; ++ni)
#pragma unroll
                for (int j = 0; j < 4; ++j) ssq += Hs[ni][j] * Hs[ni][j];
            ssq += __shfl_xor(ssq, 16); ssq += __shfl_xor(ssq, 32);
            const float rs = rsqrtf(ssq * (1.f / 128.f) + 1e-6f);
#pragma unroll
            for (int ni = 0; ni < 8; ++ni) {
                const int col = h * 128 + 16 * ni + 4 * q;
                const uint2 orw = *(const uint2*)(PROJ + grow * 3072 + 2048 + col);
                const float4 nw = *(const float4*)(p.in[26] + col);
                uint2 w; w.x = pack2(Hs[ni][0] * rs * nw.x * sigmf(__uint_as_float(orw.x << 16)), Hs[ni][1] * rs * nw.y * sigmf(__uint_as_float(orw.x & 0xffff0000u)));
                w.y = pack2(Hs[ni][2] * rs * nw.z * sigmf(__uint_as_float(orw.y << 16)), Hs[ni][3] * rs * nw.w * sigmf(__uint_as_float(orw.y & 0xffff0000u)));
                *(uint2*)(MIX + grow * 1024 + col) = w;
            }
            __syncthreads();
        }
    }
}


#define XB_TMO      128
#define XB_XCNT(j)  (256  + 64 * (j))
#define XB_XSUB(j)  (1280 + 64 * (j))
#define XB_XGEN(j)  (2304 + 64 * (j))
#define XB_TOP      3328
#define XB_TOPGEN   3392
#define XCD_BAR_WORDS 3456
#define XB_SPIN_CAP (1u << 22)
#define XLAS __attribute__((address_space(3)))
__device__ __forceinline__ unsigned xb_ld(unsigned* p) { return __hip_atomic_load(p, __ATOMIC_RELAXED, __HIP_MEMORY_SCOPE_AGENT); }
__device__ __forceinline__ unsigned xb_add(unsigned* p, unsigned v) { return __hip_atomic_fetch_add(p, v, __ATOMIC_RELAXED, __HIP_MEMORY_SCOPE_AGENT); }
__device__ __forceinline__ unsigned xb_xcc_id() { return (unsigned)__builtin_amdgcn_s_getreg((3 << 11) | 20) & 0xFu; }
#define XB_SPIN(cond, bar) do { unsigned _sp = 0; while (cond) { __builtin_amdgcn_s_sleep(1); \
    if ((++_sp & 255u) == 0u) { if (xb_ld(&(bar)[XB_TMO])) break; if (_sp > XB_SPIN_CAP) { atomicAdd(&(bar)[XB_TMO], 1u); break; } } } } while (0)
struct XcdBarrier { unsigned* bar; unsigned x; volatile XLAS unsigned* st; };
__device__ __forceinline__ XcdBarrier xcd_barrier_post(unsigned* bar, volatile XLAS unsigned* st, int tid) {
    XcdBarrier b; b.bar = bar; b.x = xb_xcc_id(); b.st = st;
    if (tid == 0) (void)xb_add(&bar[XB_XCNT(b.x)], 1u);
    return b;
}
__device__ __forceinline__ void xcd_barrier_complete(unsigned* bar, unsigned x, unsigned& nloc, unsigned& nx) {
    const unsigned G = gridDim.x * gridDim.y * gridDim.z;
    unsigned sum, cnt, mine, sp = 0u;
    for (;;) {
        sum = 0u; cnt = 0u;
#pragma unroll 1
        for (unsigned j = 0; j < 16; ++j) { const unsigned c = xb_ld(&bar[XB_XCNT(j)]); sum += c; cnt += (c > 0u) ? 1u : 0u; }
        mine = xb_ld(&bar[XB_XCNT(x)]);
        if (sum == G) break;
        __builtin_amdgcn_s_sleep(1);
        if ((++sp & 255u) == 0u) { if (xb_ld(&bar[XB_TMO])) break; if (sp > XB_SPIN_CAP) { atomicAdd(&bar[XB_TMO], 1u); break; } }
    }
    nloc = mine > 0u ? mine : 1u; nx = cnt > 0u ? cnt : 1u;
}
__device__ __forceinline__ void xcd_barrier(const XcdBarrier& b, int tid) {
    asm volatile("s_waitcnt vmcnt(0)" ::: "memory");
    __syncthreads();
    if (tid == 0) {
        unsigned* bar = b.bar; asm volatile("" : "+s"(bar));
        __builtin_amdgcn_s_waitcnt(0);
        unsigned nloc = b.st[0], nx = b.st[1];
        if (nloc == 0u) { xcd_barrier_complete(bar, b.x, nloc, nx); b.st[0] = nloc; b.st[1] = nx; }
        const unsigned old = xb_add(&bar[XB_XSUB(b.x)], 1u);
        const unsigned gen = old / nloc;
        if (old + 1u == (gen + 1u) * nloc) {
            __builtin_amdgcn_fence(__ATOMIC_RELEASE, "agent");
            asm volatile("s_waitcnt vmcnt(0)" ::: "memory");
            const unsigned og = xb_add(&bar[XB_TOP], 1u);
            const unsigned tg = og / nx;
            if (og + 1u == (tg + 1u) * nx) xb_add(&bar[XB_TOPGEN], 1u);
            else XB_SPIN(xb_ld(&bar[XB_TOPGEN]) == tg, bar);
            __builtin_amdgcn_fence(__ATOMIC_ACQUIRE, "agent");
            xb_add(&bar[XB_XGEN(b.x)], 1u);
            asm volatile("s_waitcnt vmcnt(0)" ::: "memory");
        } else {
            XB_SPIN(xb_ld(&bar[XB_XGEN(b.x)]) == gen, bar);
            __builtin_amdgcn_fence(__ATOMIC_ACQUIRE, "agent");
            asm volatile("s_waitcnt vmcnt(0)" ::: "memory");
        }
    }
    __syncthreads();
}

#define GSYNC() grid.sync()
__global__ void __launch_bounds__(NTH, 2) fwd_kernel(PK pk) {
    P p; p.wv = __builtin_amdgcn_readfirstlane((int)(threadIdx.x >> 6));
    extern __shared__ __attribute__((aligned(16))) unsigned char smem[];
    float* lds = (float*)smem;
    G8_LAS unsigned char* ldsa = (G8_LAS unsigned char*)smem;
    volatile XLAS unsigned* xst = (volatile XLAS unsigned*)((XLAS unsigned char*)smem + LDS_BYTES - 16);
    { const int t0 = p.tid(); if (t0 < 4) xst[t0] = 0u; }
    __syncthreads();
    const XcdBarrier xbar = xcd_barrier_post((unsigned*)(p.get_ws() + WS_CTL) + CW_BAR, xst, p.tid());
    int nph = NPH_RUN; asm volatile("" : "+s"(nph));
    unsigned repmask = REPEAT_MASK; asm volatile("" : "+s"(repmask));
#pragma unroll 1
    for (int pq = 0; pq < 2 * nph; ++pq) {
        const int ph = pq >> 1;
        if ((pq & 1) && !((repmask >> ph) & 1u)) continue;
        unsigned char* ws = p.get_ws();
        const float* MODS = (const float*)(ws + WS_MODS);
        int nb = (int)gridDim.x, bid = (int)blockIdx.x; asm volatile("" : "+s"(nb), "+s"(bid));
        switch (ph) {
        case 0: {
            phase_mods(p, bid, nb, lds);
            conv_dense(p, bid, nb, lds);
        } break;
        case 1: {
            { RowArgs a{}; a.layer = 0; a.ffn = 0; a.src = 0; a.nrows = MT; a.noproj = 1; phase_rows<16>(p, bid, nb, lds, a); }
        } break;
        case 2: {
            { g8::Order S; S.init(SEQ / 256, 2048 / 256, nb, bid); EpiProj ef{(bf16_t*)(ws + WS_PROJ), 2048, 2048, 16, (float*)(ws + WS_SMALL)};
              g8::gemm8(p.tid(), ldsa, (const bf16_t*)(ws + WS_HB), 1024, RowPlain{}, S, BSelOne{(const char*)(ws + WS_WIN0)}, ef);
              mini_gemm(p, bid, nb, lds, (const bf16_t*)(ws + WS_HB), (const bf16_t*)(ws + WS_WIN0), SEQ, CTX / 64, 0, 2048 / 32, ef);
              mini_gemm(p, (bid + 4) % nb, nb, lds, (const bf16_t*)(ws + WS_HB), (const bf16_t*)(ws + WS_WIN0), 0, MT / 64, 2048, 1, ef); }
        } break;
        case 3: {
            { unsigned* qctr = (unsigned*)(ws + WS_CTL) + CW_Q3; volatile XLAS unsigned* qslot = xst - 4;
              for (;;) {
                  __syncthreads();
                  if (p.tid() == 0) qslot[0] = atomicAdd(qctr, 1u);
                  __syncthreads();
                  const int it = (int)qslot[0];
                  if (it >= 520) break;
                  if (it < 260) ssd_states(p, it, 1 << 20, lds); else phase_qkprep(p, it - 260, 1 << 20);
              } }
        } break;
        case 4: {
            ssd_scan(p, bid, nb);
            { unsigned* qctr = (unsigned*)(ws + WS_CTL) + CW_Q4; volatile XLAS unsigned* qslot = xst - 4;
              for (;;) {
                  __syncthreads();
                  if (p.tid() == 0) qslot[0] = atomicAdd(qctr, 1u);
                  __syncthreads();
                  const int it = (int)qslot[0];
                  if (it >= 260) break;
                  attn_mfma(p, it, 1 << 20, lds);
              } }
        } break;
        case 5: {
            { unsigned* qctr = (unsigned*)(ws + WS_CTL) + CW_Q5; volatile XLAS unsigned* qslot = xst - 4;
              for (;;) {
                  __syncthreads();
                  if (p.tid() == 0) qslot[0] = atomicAdd(qctr, 1u);
                  __syncthreads();
                  const int it = (int)qslot[0];
                  if (it >= 130 + 768) break;
                  if (it < 130) ssd_out(p, it, 1 << 20, lds); else conv_moe_chunk(p, it - 130, lds, 0);
              } }
        } break;
        case 6: {
            { g8::Order S; S.init(SEQ / 256, 4, nb, bid);
              EpiResid ef{p.in[0], p.in[2], (float*)(ws + WS_XRES), MODS + (0 * 2 + 0) * 6144 + 2048, MODS + (0 * 2 + 1) * 6144 + 2048};
              g8::gemm8(p.tid(), ldsa, (const bf16_t*)(ws + WS_HB), 1024, RowPlain{}, S, BSelOne{(const char*)(ws + WS_WOUT0)}, ef);
              mini_gemm(p, bid, nb, lds, (const bf16_t*)(ws + WS_HB), (const bf16_t*)(ws + WS_WOUT0), SEQ, CTX / 64, 0, 1024 / 32, ef); }
        } break;
        case 7: {
            phase_route(p, bid, nb, lds, 0, MT);
        } break;
        case 8: {
            phase_moe1(p, bid, nb, ldsa, lds, 0);
        } break;
        case 9: {
            phase_moe2(p, bid, nb, ldsa, lds, 0);
        } break;
        case 10: {
            { RowArgs a{}; a.layer = 1; a.ffn = 0; a.src = 1; a.combine = 1; a.clayer = 0; a.nrows = MT; a.noproj = 1; phase_rows<16>(p, bid, nb, lds, a); }
        } break;
        case 11: {
            { g8::Order S; S.init(SEQ / 256, 3072 / 256, nb, bid); EpiProj ef{(bf16_t*)(ws + WS_PROJ), 3072, 3072, 32, (float*)(ws + WS_SMALL)};
              g8::gemm8(p.tid(), ldsa, (const bf16_t*)(ws + WS_HB), 1024, RowPlain{}, S, BSelOne{(const char*)(ws + WS_WIN1)}, ef);
              mini_gemm(p, bid, nb, lds, (const bf16_t*)(ws + WS_HB), (const bf16_t*)(ws + WS_WIN1), SEQ, CTX / 64, 0, 3072 / 32, ef);
              mini_gemm(p, (bid + 128) % nb, nb, lds, (const bf16_t*)(ws + WS_HB), (const bf16_t*)(ws + WS_WIN1), 0, MT / 64, 3072, 1, ef); }
        } break;
        case 12: {
            { unsigned* qctr = (unsigned*)(ws + WS_CTL) + CW_Q12; volatile XLAS unsigned* qslot = xst - 4;
              for (;;) {
                  __syncthreads();
                  if (p.tid() == 0) qslot[0] = atomicAdd(qctr, 1u);
                  __syncthreads();
                  const int it = (int)qslot[0];
                  if (it >= 520 + 768) break;
                  if (it < 520) ml_states(p, it, 1 << 20, lds); else conv_moe_chunk(p, it - 520, lds, 1);
              } }
        } break;
        case 13: {
            ml_scan(p, bid, nb);
            xcd_barrier(xbar, p.tid());
            ml_out(p, bid, nb, lds);
        } break;
        case 14: {
            { g8::Order S; S.init(SEQ / 256, 4, nb, bid);
              EpiResid ef{(const float*)(ws + WS_XRES), nullptr, (float*)(ws + WS_XRES), MODS + (1 * 2 + 0) * 6144 + 2048, MODS + (1 * 2 + 0) * 6144 + 2048};
              g8::gemm8(p.tid(), ldsa, (const bf16_t*)(ws + WS_HB), 1024, RowPlain{}, S, BSelOne{(const char*)(ws + WS_WOUT1)}, ef); }
        } break;
        case 15: {
            phase_route(p, bid, nb, lds, 1, SEQ);
        } break;
        case 16: {
            phase_moe1(p, bid, nb, ldsa, lds, 1);
        } break;
        case 17: {
            phase_moe2(p, bid, nb, ldsa, lds, 1);
        } break;
        case 18: {
            { RowArgs a{}; a.layer = 1; a.src = 1; a.combine = 1; a.clayer = 1; a.final_out = 1; a.nrows = SEQ; phase_rows<16>(p, bid, nb, lds, a); }
        } break;
        default: break;
        }
        if (pq + 1 < 2 * nph) xcd_barrier(xbar, p.tid());
#if TIMED_PH >= 0 || DELAY_PH >= 0
        if (!(pq & 1) && p.tid() == 0) {
            const unsigned now = (unsigned)__builtin_amdgcn_s_memrealtime();
            if (ph == TIMED_PH) xst[3] = now - xst[2];
            if (ph == DELAY_PH) xst[-8] = now - xst[2];
            xst[2] = now;
        }
#endif
    }
#if TSA >= 0
    if (blockIdx.x == 0 && p.tid() == 0) { volatile XLAS unsigned* tsp = (volatile XLAS unsigned*)((XLAS unsigned char*)smem + LDS_BYTES - 128);
        const unsigned long long t0 = __builtin_amdgcn_s_memrealtime(); const unsigned long long dt = 50ull * (tsp[TSB] - tsp[TSA]);
        while (__builtin_amdgcn_s_memrealtime() - t0 < dt) __builtin_amdgcn_s_sleep(8);
    }
#endif
#if DELAY_PH >= 0
    if (blockIdx.x == 0 && p.tid() == 0) {
        const unsigned long long t0 = __builtin_amdgcn_s_memrealtime(); const unsigned long long dt = 20ull * xst[-8];
        while (__builtin_amdgcn_s_memrealtime() - t0 < dt) __builtin_amdgcn_s_sleep(8);
    }
#endif
#if TIMED_PH >= 0
    xcd_barrier(xbar, p.tid());
    if (blockIdx.x == 0) {
        const float t_phase = (float)xst[3] * 0.01f;
        const float delta = sqrtf(t_phase * 1e-5f * 256.f * TIMED_M2);
        float* o = p.get_out();
        for (int i = p.tid(); i < 65536; i += NTH) o[i] += (i & 1) ? delta : -delta;
    }
#endif
}

extern "C" void kernel_launch(void* const* d_in, const int* in_sizes, int n_in, void* d_out, int out_size, void* d_ws, size_t ws_size, hipStream_t stream) {
    static int grid = 0;
    if (grid == 0) {
        if (n_in != 31 || ws_size < WS_END) { fprintf(stderr, "kernel_launch: unexpected n_in %d or ws_size %zu < %zu\n", n_in, ws_size, (size_t)WS_END); grid = -1; return; }
        int dev = 0, cus = 0, per_cu = 0;
        hipGetDevice(&dev);
        hipDeviceGetAttribute(&cus, hipDeviceAttributeMultiprocessorCount, dev);
        hipFuncSetAttribute((const void*)fwd_kernel, hipFuncAttributeMaxDynamicSharedMemorySize, LDS_BYTES);
        hipOccupancyMaxActiveBlocksPerMultiprocessor(&per_cu, (const void*)fwd_kernel, NTH, LDS_BYTES);
        if (per_cu < 1) { fprintf(stderr, "kernel_launch: occupancy query says %d blocks per CU\n", per_cu); per_cu = 1; }
        grid = cus;
    }
    if (grid < 0) return;
    PK p{};
    for (int i = 0; i < 31; ++i) p.in[i] = (const float*)d_in[i];
    p.out = (float*)d_out; p.ws = (unsigned char*)d_ws;
    hipMemsetAsync((unsigned char*)d_ws + WS_CTL, 0, 65536, stream);
    void* args[] = {&p};
    hipError_t e = hipLaunchCooperativeKernel((const void*)fwd_kernel, dim3(grid), dim3(NTH), args, LDS_BYTES, stream);
    if (e != hipSuccess) fprintf(stderr, "cooperative launch failed: %s (grid %d)\n", hipGetErrorString(e), grid);
}
```

```cpp
#include <hip/hip_runtime.h>
#include <hip/hip_cooperative_groups.h>
#include <cstdio>
namespace cg = cooperative_groups;

typedef unsigned short bf16_t;
typedef unsigned int u32;
typedef short bf16x8 __attribute__((ext_vector_type(8)));
typedef float f32x4 __attribute__((ext_vector_type(4)));

constexpr int D = 1024, SEQ = 16384, CTX = 256, MT = SEQ + CTX;
constexpr int NTH = 512;
#ifndef NPH_RUN
#define NPH_RUN 19
#endif
#ifndef REPEAT_MASK
#define REPEAT_MASK 0u
#endif
#ifndef TIMED_PH
#define TIMED_PH -1
#endif
#ifndef TIMED_M2
#define TIMED_M2 1.37f
#endif
#ifndef DELAY_PH
#define DELAY_PH -1
#endif
#ifndef EXP_ML_D
#define EXP_ML_D 0
#endif
#ifndef TSA
#define TSA -1
#endif
#ifndef TSB
#define TSB 0
#endif
#if TSA >= 0
#define TS(k) do { if (p.tid() == 0) ((volatile __attribute__((address_space(3))) unsigned*)((__attribute__((address_space(3))) unsigned char*)tsbase))[k] = (unsigned)__builtin_amdgcn_s_memrealtime(); } while (0)
#else
#define TS(k) do { } while (0)
#endif
#ifndef EXP_ML_V
#define EXP_ML_V 1
#endif
constexpr int EV_IN = 2064, OD_IN = 3104;
constexpr int NE = 16, DE = 512;
constexpr int MAXTILES = 146, MAXSLOTS = MAXTILES * 256;

constexpr size_t al256(size_t x) { return (x + 255) & ~(size_t)255; }
constexpr size_t WS_CTL   = 0;
constexpr size_t WS_MODS  = 65536;
constexpr size_t WS_ROPE  = WS_MODS + al256(2 * 2 * 6144 * 4);
constexpr size_t WS_SMALL = WS_ROPE + al256(2 * 256 * 16 * 4);
constexpr size_t WS_ROUTE = WS_SMALL + al256((size_t)MT * 32 * 4);
constexpr size_t WS_GATE  = WS_ROUTE + al256((size_t)MT * 16);
constexpr size_t WS_SLOT  = WS_GATE + al256((size_t)MT * 8);
constexpr size_t WS_LIST  = WS_SLOT + al256((size_t)MT * 8);
constexpr size_t WS_TEXP  = WS_LIST + al256((size_t)MAXSLOTS * 4);
constexpr size_t WS_CHK   = WS_TEXP + 1024;
constexpr size_t WS_WIN0  = WS_CHK + (size_t)4 * 1024 * 1024;
constexpr size_t WS_WIN1  = WS_WIN0 + (size_t)2304 * 1024 * 2;
constexpr size_t WS_WOUT0 = WS_WIN1 + (size_t)3328 * 1024 * 2;
constexpr size_t WS_WOUT1 = WS_WOUT0 + (size_t)1024 * 1024 * 2;
constexpr size_t WS_WMOE  = WS_WOUT1 + (size_t)1024 * 1024 * 2;
constexpr size_t WS_XRES  = WS_WMOE + (size_t)16 * 1024 * 1024 * 2 + (size_t)16 * 1024 * 512 * 2;
constexpr size_t WS_HB    = WS_XRES + (size_t)MT * 1024 * 4;
constexpr size_t WS_PROJ  = WS_HB + (size_t)MT * 1024 * 2;
constexpr size_t WS_Y     = WS_PROJ + (size_t)MT * 3072 * 2;
constexpr size_t WS_END   = WS_Y + (size_t)MT * 1024 * 4;
static_assert(WS_END < 349000000, "workspace too large");

constexpr int CW_CNT = 8192;
constexpr int CH_BBASE = 300000;
constexpr int CH_ELIST = 524288;
constexpr int CH_WRT = 917504;
constexpr int CW_BAR = 1024;
constexpr int CW_Q5 = 12288;
constexpr int CW_Q3 = 12352, CW_Q12 = 12416, CW_Q4 = 12480;
constexpr int LDS_BYTES = 160 * 1024;

struct PK { const float* in[31]; float* out; unsigned char* ws; };
typedef __attribute__((address_space(4))) const unsigned char* kaptr_t;
struct InTab { __device__ __forceinline__ const float* operator[](int i) const {
    kaptr_t ka = (kaptr_t)__builtin_amdgcn_kernarg_segment_ptr(); asm volatile("" : "+s"(ka)); return *(const float* __attribute__((address_space(4))) const*)(ka + i * 8); } };
struct P { InTab in; int wv;
    __device__ __forceinline__ int tid() const { int l; asm volatile("v_mbcnt_lo_u32_b32 %0, -1, 0\n\tv_mbcnt_hi_u32_b32 %0, -1, %0" : "=v"(l)); return (wv << 6) | l; }
    __device__ __forceinline__ float* get_out() const { kaptr_t ka = (kaptr_t)__builtin_amdgcn_kernarg_segment_ptr(); asm volatile("" : "+s"(ka)); return *(float* __attribute__((address_space(4))) const*)(ka + 31 * 8); }
    __device__ __forceinline__ unsigned char* get_ws() const { kaptr_t ka = (kaptr_t)__builtin_amdgcn_kernarg_segment_ptr(); asm volatile("" : "+s"(ka)); return *(unsigned char* __attribute__((address_space(4))) const*)(ka + 32 * 8); } };

__device__ __forceinline__ float bf2f(bf16_t b) { return __uint_as_float((u32)b << 16); }
__device__ __forceinline__ bf16_t f2bf(float f) { u32 r; asm("v_cvt_pk_bf16_f32 %0, %1, %1" : "=v"(r) : "v"(f)); return (bf16_t)r; }
__device__ __forceinline__ u32 pack2(float a, float b) { u32 r; asm("v_cvt_pk_bf16_f32 %0, %1, %2" : "=v"(r) : "v"(a), "v"(b)); return r; }
__device__ __forceinline__ void unpack8(const uint4 w, float* f) {
    f[0] = __uint_as_float(w.x << 16); f[1] = __uint_as_float(w.x & 0xffff0000u); f[2] = __uint_as_float(w.y << 16); f[3] = __uint_as_float(w.y & 0xffff0000u);
    f[4] = __uint_as_float(w.z << 16); f[5] = __uint_as_float(w.z & 0xffff0000u); f[6] = __uint_as_float(w.w << 16); f[7] = __uint_as_float(w.w & 0xffff0000u);
}
__device__ __forceinline__ void ld4bf(const bf16_t* p, float* f) { const uint2 w = *(const uint2*)p; f[0] = __uint_as_float(w.x << 16); f[1] = __uint_as_float(w.x & 0xffff0000u); f[2] = __uint_as_float(w.y << 16); f[3] = __uint_as_float(w.y & 0xffff0000u); }
__device__ __forceinline__ float siluf(float x) { return x / (1.f + __expf(-x)); }
__device__ __forceinline__ float sigmf(float x) { return 1.f / (1.f + __expf(-x)); }
__device__ __forceinline__ float softplusf(float x) { return x > 20.f ? x : log1pf(__expf(x)); }
__device__ __forceinline__ float logsigf(float x) { return x < -20.f ? x : -log1pf(__expf(-x)); }
__device__ __forceinline__ float wave_sum(float v) {
#pragma unroll
    for (int o = 32; o >= 1; o >>= 1) v += __shfl_xor(v, o);
    return v;
}
__device__ __forceinline__ float rdlane(float v, int l) { return __int_as_float(__builtin_amdgcn_readlane(__float_as_int(v), l)); }

__device__ __forceinline__ void phase_mods(const P& p, int bid, int nb, float* lds) {
    const int tid = p.tid();
    float* MODS = (float*)(p.get_ws() + WS_MODS);
    float* RC = (float*)(p.get_ws() + WS_ROPE); float* RS = RC + 256 * 16;
    for (int i = bid * NTH + tid; i < 256 * 16; i += nb * NTH) {
        const int pos = i >> 4, f = i & 15;
        const float inv = powf(10000.f, -(float)f / 16.f);
        const float ang = (float)pos * inv;
        RC[i] = cosf(ang); RS[i] = sinf(ang);
    }
    const float* c = p.in[1]; const float* cx = p.in[3];
    for (int i = tid; i < 1024; i += NTH) { const float a = c[i]; lds[i] = a / (1.f + expf(-a)); const float b = cx[i]; lds[1024 + i] = b / (1.f + expf(-b)); }
    __syncthreads();
    float* red = lds + 2048;
    const int tx = tid & 15, ty = tid >> 4;
    for (int item = bid; item < 192; item += nb) {
        const int l = item / 96, cgp = item % 96;
        const float* W = p.in[8] + (size_t)l * 1024 * 6144 + cgp * 64 + tx * 4;
        float4 ac = {0.f, 0.f, 0.f, 0.f}, ax = {0.f, 0.f, 0.f, 0.f};
#pragma unroll 8
        for (int k = ty; k < 1024; k += 32) {
            const float4 w = *(const float4*)(W + (size_t)k * 6144);
            const float sc = lds[k], sx = lds[1024 + k];
            ac.x += sc * w.x; ac.y += sc * w.y; ac.z += sc * w.z; ac.w += sc * w.w;
            ax.x += sx * w.x; ax.y += sx * w.y; ax.z += sx * w.z; ax.w += sx * w.w;
        }
        float* r = red + (ty * 16 + tx) * 8;
        r[0] = ac.x; r[1] = ac.y; r[2] = ac.z; r[3] = ac.w; r[4] = ax.x; r[5] = ax.y; r[6] = ax.z; r[7] = ax.w;
        __syncthreads();
        if (tid < 128) {
            const int col = tid & 63, which = tid >> 6;
            float s = 0.f;
            for (int y = 0; y < 32; ++y) s += red[(y * 16 + (col >> 2)) * 8 + which * 4 + (col & 3)];
            s += p.in[9][l * 6144 + cgp * 64 + col];
            MODS[(l * 2 + which) * 6144 + cgp * 64 + col] = s;
        }
        __syncthreads();
    }
}

struct RowArgs {
    int layer;
    int ffn;
    int src;
    int combine;
    int clayer;
    int final_out;
    int nrows;
    const float* wsm; int ldw; int wcol0;
    int route;
    int noproj;
};

template <int NS>
__device__ __forceinline__ float row_norm_proj(float (&v)[16], const float* gamma, const float* md, bf16_t* hrow, const float* lds, int lane, bool doproj) {
    float ss = 0.f;
#pragma unroll
    for (int j = 0; j < 16; ++j) ss += v[j] * v[j];
    ss = wave_sum(ss);
    const float rs = rsqrtf(ss * (1.f / 1024.f) + 1e-6f);
#pragma unroll
    for (int i = 0; i < 4; ++i) {
        const float4 g = *(const float4*)(gamma + i * 256 + lane * 4);
        const float4 sh = *(const float4*)(md + i * 256 + lane * 4);
        const float4 sc = *(const float4*)(md + 1024 + i * 256 + lane * 4);
        v[i * 4 + 0] = v[i * 4 + 0] * rs * g.x * (1.f + sc.x) + sh.x;
        v[i * 4 + 1] = v[i * 4 + 1] * rs * g.y * (1.f + sc.y) + sh.y;
        v[i * 4 + 2] = v[i * 4 + 2] * rs * g.z * (1.f + sc.z) + sh.z;
        v[i * 4 + 3] = v[i * 4 + 3] * rs * g.w * (1.f + sc.w) + sh.w;
        uint2 o; o.x = pack2(v[i * 4], v[i * 4 + 1]); o.y = pack2(v[i * 4 + 2], v[i * 4 + 3]);
        *(uint2*)(hrow + i * 256 + lane * 4) = o;
    }
    if (!doproj) return 0.f;
    float s[NS];
#pragma unroll
    for (int n = 0; n < NS; ++n) s[n] = 0.f;
#pragma unroll
    for (int i = 0; i < 4; ++i)
#pragma unroll
        for (int j = 0; j < 4; ++j) {
            const float* w = lds + ((i * 4 + j) * (NS / 4)) * 256 + lane * 4;
            const float x = v[i * 4 + j];
#pragma unroll
            for (int n = 0; n < NS; n += 4) { const float4 ww = *(const float4*)(w + (n >> 2) * 256); s[n] += x * ww.x; s[n + 1] += x * ww.y; s[n + 2] += x * ww.z; s[n + 3] += x * ww.w; }
            asm volatile("" ::: "memory");
        }
#pragma unroll
    for (int hN = NS / 2, off = 32; hN >= 1; hN >>= 1, off >>= 1) {
        const bool upper = (lane & off) != 0;
#pragma unroll
        for (int i2 = 0; i2 < hN; ++i2) { const float mine = upper ? s[i2 + hN] : s[i2], other = upper ? s[i2] : s[i2 + hN]; s[i2] = mine + __shfl_xor(other, off); }
    }
    float s0 = s[0];
    if (NS == 16) { s0 += __shfl_xor(s0, 2); s0 += __shfl_xor(s0, 1); } else { s0 += __shfl_xor(s0, 1); }
    return s0;
}
__device__ __forceinline__ void route16(const float (&sc)[16], const float (&bs)[16], int& e0, int& e1, float& g0, float& g1) {
    float best = -1e30f, W0 = 0.f, W1 = 0.f; int E0 = 0, E1 = 0;
#pragma unroll
    for (int g = 0; g < 4; ++g) {
        float m1 = bs[g * 4], w1 = sc[g * 4]; int i1 = 0;
#pragma unroll
        for (int j = 1; j < 4; ++j) { const bool gt = bs[g * 4 + j] > m1; m1 = gt ? bs[g * 4 + j] : m1; w1 = gt ? sc[g * 4 + j] : w1; i1 = gt ? j : i1; }
        float m2 = -1e30f, w2 = 0.f; int i2 = 0;
#pragma unroll
        for (int j = 0; j < 4; ++j) { const bool gt = (j != i1) && (bs[g * 4 + j] > m2); m2 = gt ? bs[g * 4 + j] : m2; w2 = gt ? sc[g * 4 + j] : w2; i2 = gt ? j : i2; }
        const float gs = m1 + m2; const bool better = gs > best;
        best = better ? gs : best; E0 = better ? g * 4 + i1 : E0; E1 = better ? g * 4 + i2 : E1; W0 = better ? w1 : W0; W1 = better ? w2 : W1;
    }
    e0 = E0; e1 = E1;
    const float inv = 1.f / (W0 + W1);
    g0 = W0 * inv; g1 = W1 * inv;
}
__device__ __forceinline__ void expert_offsets(const u32* cnt  , int (&off)[17]) {
    off[0] = 0;
#pragma unroll
    for (int e = 0; e < 16; ++e) off[e + 1] = off[e] + (int)((cnt[e * 64] + 255u) / 256u) * 256;
}

template <int NS> __forceinline__
__device__ __forceinline__ void phase_rows(const P& p, int bid, int nb, float* lds, const RowArgs a) {
    const int tid = p.tid(), lane = tid & 63, wid = tid >> 6;
    unsigned char* ws = p.get_ws();
    const float* MODS = (const float*)(ws + WS_MODS);
    bf16_t* XRES = (bf16_t*)(ws + WS_XRES);
    bf16_t* HB = (bf16_t*)(ws + WS_HB);
    float* SMALL = (float*)(ws + WS_SMALL);
    int* CHKI = (int*)(ws + WS_CHK);
    if (!a.final_out && !a.noproj) {
        for (int i = tid; i < 1024 * NS; i += NTH) { const int k = i / NS, n = i % NS;
            lds[(((k >> 8) * 4 + (k & 3)) * (NS / 4) + (n >> 2)) * 256 + ((k >> 2) & 63) * 4 + (n & 3)] = a.wsm[(size_t)k * a.ldw + a.wcol0 + n]; }
    }
    u32* lcnt = (u32*)(lds + 1024 * 32);
    int* lsl = (int*)(lds + 1024 * 32 + 64);
    int4* lrt = (int4*)(lds + 1024 * 32 + 64);
    if (tid < 16) lcnt[tid] = 0u;
    if (a.combine) {
        if (tid == 0) { int off[17]; expert_offsets((const u32*)(ws + WS_CTL) + CW_CNT + a.clayer * 16 * 64, off);
#pragma unroll
            for (int e = 0; e < 16; ++e) lsl[e] = off[e]; }
        for (int i = tid; i < nb * 16; i += NTH) lsl[16 + i] = CHKI[CH_BBASE + i];
    }
    __syncthreads();
    const float* gamma = (a.ffn ? p.in[7] : p.in[6]) + a.layer * 1024;
    const bf16_t* YMOE = (const bf16_t*)(ws + WS_PROJ);
    const int4* ROUTE = (const int4*)(ws + WS_ROUTE);
    const float2* GATE = (const float2*)(ws + WS_GATE);
    const int stride = nb * 8;
    for (int row0 = bid * 8 + wid; row0 < a.nrows; row0 += (NS == 16 ? 2 : 1) * stride) {
        const bool hasB = NS == 16 && row0 + stride < a.nrows;
        const int rw[2] = {row0, hasB ? row0 + stride : row0};
        float v[2][16];
#pragma unroll
        for (int u = 0; u < 2; ++u) {
            const int row = rw[u];
            if (a.src) {
#pragma unroll
                for (int i = 0; i < 4; ++i) ld4bf(XRES + (size_t)row * 1024 + i * 256 + lane * 4, &v[u][i * 4]);
            } else {
                const float* src = row >= SEQ ? p.in[2] + (size_t)(row - SEQ) * 1024 : p.in[0] + (size_t)row * 1024;
#pragma unroll
                for (int i = 0; i < 4; ++i) { const float4 t = *(const float4*)(src + i * 256 + lane * 4); v[u][i * 4] = t.x; v[u][i * 4 + 1] = t.y; v[u][i * 4 + 2] = t.z; v[u][i * 4 + 3] = t.w; }
            }
        }
        if (a.combine) {
            int4 rt[2]; float2 gt[2];
#pragma unroll
            for (int u = 0; u < 2; ++u) { rt[u] = ROUTE[rw[u]]; gt[u] = GATE[rw[u]]; }
            uint2 y0[2][4], y1[2][4];
#pragma unroll
            for (int u = 0; u < 2; ++u) {
                const int blk = (rw[u] >> 6) % nb;
                const int s0 = lsl[rt[u].x] + lsl[16 + blk * 16 + rt[u].x] + rt[u].y, s1 = lsl[rt[u].z] + lsl[16 + blk * 16 + rt[u].z] + rt[u].w;
#pragma unroll
                for (int i = 0; i < 4; ++i) { y0[u][i] = *(const uint2*)(YMOE + (size_t)s0 * 1024 + i * 256 + lane * 4); y1[u][i] = *(const uint2*)(YMOE + (size_t)s1 * 1024 + i * 256 + lane * 4); }
            }
#pragma unroll
            for (int u = 0; u < 2; ++u) {
                const int row = rw[u];
                const float* gf = MODS + (a.clayer * 2 + (row >= SEQ ? 1 : 0)) * 6144 + 5 * 1024;
#pragma unroll
                for (int i = 0; i < 4; ++i) {
                    const float4 g = *(const float4*)(gf + i * 256 + lane * 4);
                    v[u][i * 4 + 0] += g.x * (gt[u].x * __uint_as_float(y0[u][i].x << 16) + gt[u].y * __uint_as_float(y1[u][i].x << 16));
                    v[u][i * 4 + 1] += g.y * (gt[u].x * __uint_as_float(y0[u][i].x & 0xffff0000u) + gt[u].y * __uint_as_float(y1[u][i].x & 0xffff0000u));
                    v[u][i * 4 + 2] += g.z * (gt[u].x * __uint_as_float(y0[u][i].y << 16) + gt[u].y * __uint_as_float(y1[u][i].y << 16));
                    v[u][i * 4 + 3] += g.w * (gt[u].x * __uint_as_float(y0[u][i].y & 0xffff0000u) + gt[u].y * __uint_as_float(y1[u][i].y & 0xffff0000u));
                }
                if (u == 0 || hasB) {
                    if (a.final_out) { float* dst = p.get_out() + (size_t)row * 1024;
#pragma unroll
                        for (int i = 0; i < 4; ++i) *(float4*)(dst + i * 256 + lane * 4) = make_float4(v[u][i * 4], v[u][i * 4 + 1], v[u][i * 4 + 2], v[u][i * 4 + 3]); }
                    else {
#pragma unroll
                        for (int i = 0; i < 4; ++i) { uint2 o; o.x = pack2(v[u][i * 4], v[u][i * 4 + 1]); o.y = pack2(v[u][i * 4 + 2], v[u][i * 4 + 3]); *(uint2*)(XRES + (size_t)row * 1024 + i * 256 + lane * 4) = o; } }
                }
            }
            if (a.final_out) continue;
        }
#pragma unroll
        for (int u = 0; u < 2; ++u) {
            const int row = rw[u];
            if (u == 0 || hasB) {
            const float* md = MODS + (a.layer * 2 + (row >= SEQ ? 1 : 0)) * 6144 + (a.ffn ? 3 * 1024 : 0);
            const float s0 = row_norm_proj<NS>(v[u], gamma, md, HB + (size_t)row * 1024, lds, lane, !a.noproj);
            if (a.noproj) {
            } else if (!a.route) {
                const int nl = NS == 16 ? (((lane >> 5) & 1) << 3) | (((lane >> 4) & 1) << 2) | (((lane >> 3) & 1) << 1) | ((lane >> 2) & 1)
                                        : (((lane >> 5) & 1) << 4) | (((lane >> 4) & 1) << 3) | (((lane >> 3) & 1) << 2) | (((lane >> 2) & 1) << 1) | ((lane >> 1) & 1);
                if ((lane & (NS == 16 ? 3 : 1)) == 0) SMALL[(size_t)row * 32 + nl] = s0;
            } else if (NS == 16) {
                const int nl = (((lane >> 5) & 1) << 3) | (((lane >> 4) & 1) << 2) | (((lane >> 3) & 1) << 1) | ((lane >> 2) & 1);
                const float scl = 1.f / (1.f + expf(-s0)), bsl = scl + p.in[5][nl];
                float sc[16], bs[16];
#pragma unroll
                for (int n = 0; n < 16; ++n) { const int sl = ((n & 8) ? 32 : 0) | ((n & 4) ? 16 : 0) | ((n & 2) ? 8 : 0) | ((n & 1) ? 4 : 0); sc[n] = rdlane(scl, sl); bs[n] = rdlane(bsl, sl); }
                int e0, e1; float g0, g1; route16(sc, bs, e0, e1, g0, g1);
                if (lane == 0) {
                    const int p0 = (int)atomicAdd(lcnt + e0, 1u), p1 = (int)atomicAdd(lcnt + e1, 1u);
                    const int4 rt4 = make_int4(e0, p0, e1, p1);
                    ((int4*)(ws + WS_ROUTE))[row] = rt4;
                    ((float2*)(ws + WS_GATE))[row] = make_float2(g0, g1);
                    lrt[((row - (bid * 8 + wid)) / stride) * 8 + wid] = rt4;
                }
            }
            }
            __builtin_amdgcn_sched_barrier(0);
        }
    }
    if (a.route) {
        __syncthreads();
        if (tid < 16) {
            u32* cnt = (u32*)(ws + WS_CTL) + CW_CNT + (a.layer * 16 + tid) * 64;
            const int base = (int)atomicAdd(cnt, lcnt[tid]);
            CHKI[CH_BBASE + bid * 16 + tid] = base; lcnt[16 + tid] = (u32)base;
        }
        __syncthreads();
        if (lane == 0) {
            int* ELIST = CHKI + CH_ELIST;
            int k = 0;
            for (int row = bid * 8 + wid; row < a.nrows; row += stride, ++k) {
                const int4 r = lrt[k * 8 + wid];
                ELIST[r.x * MT + (int)lcnt[16 + r.x] + r.y] = row; ELIST[r.z * MT + (int)lcnt[16 + r.z] + r.w] = row;
            }
        }
    }
}


__device__ __forceinline__ void phase_route(const P& p, int bid, int nb, float* lds, int layer, int nrows) {
    const int tid = p.tid(), lane = tid & 63, wid = tid >> 6, r = lane & 15, q = lane >> 4;
    unsigned char* ws = p.get_ws();
    const float* MODS = (const float*)(ws + WS_MODS);
    const bf16_t* XRES = (const bf16_t*)(ws + WS_XRES);
    bf16_t* HB = (bf16_t*)(ws + WS_HB);
    int* CHKI = (int*)(ws + WS_CHK);
    const bf16_t* WRT = (const bf16_t*)((const float*)(ws + WS_CHK) + CH_WRT);
    u32* lcnt = (u32*)(lds + 16384);
    int4* lrt = (int4*)(lds + 16384 + 64);
    if (tid < 16) lcnt[tid] = 0u;
    const float* gamma = p.in[7] + layer * 1024;
    int kt = 0;
    for (int tile = bid; tile < nrows / 64; tile += nb, ++kt) {
        const int r0 = tile * 64;
#pragma unroll 1
        for (int pr = 0; pr < 4; ++pr) {
            float v[2][16];
#pragma unroll
            for (int u = 0; u < 2; ++u) { const bf16_t* src = XRES + (size_t)(r0 + wid * 8 + pr * 2 + u) * 1024;
#pragma unroll
                for (int i = 0; i < 4; ++i) ld4bf(src + i * 256 + lane * 4, &v[u][i * 4]); }
#pragma unroll
            for (int u = 0; u < 2; ++u) { const int row = r0 + wid * 8 + pr * 2 + u;
                const float* md = MODS + (layer * 2 + (row >= SEQ ? 1 : 0)) * 6144 + 3 * 1024;
                (void)row_norm_proj<16>(v[u], gamma, md, HB + (size_t)row * 1024, lds, lane, false); }
        }
        asm volatile("s_waitcnt vmcnt(0)" ::: "memory");
        __syncthreads();
        {
            f32x4 acc[4][2];
#pragma unroll
            for (int mi = 0; mi < 4; ++mi)
#pragma unroll
                for (int ni = 0; ni < 2; ++ni) acc[mi][ni] = (f32x4){0.f, 0.f, 0.f, 0.f};
            const bf16_t* Ab = HB + (size_t)(r0 + r) * 1024 + wid * 128 + 8 * q; const bf16_t* Bb = WRT + (size_t)r * 1024 + wid * 128 + 8 * q;
#pragma unroll
            for (int k4 = 0; k4 < 4; ++k4) {
                bf16x8 a[4], b[2];
#pragma unroll
                for (int mi = 0; mi < 4; ++mi) a[mi] = *(const bf16x8*)(Ab + (size_t)(16 * mi) * 1024 + 32 * k4);
#pragma unroll
                for (int ni = 0; ni < 2; ++ni) b[ni] = *(const bf16x8*)(Bb + (size_t)(16 * ni) * 1024 + 32 * k4);
#pragma unroll
                for (int mi = 0; mi < 4; ++mi)
#pragma unroll
                    for (int ni = 0; ni < 2; ++ni) acc[mi][ni] = __builtin_amdgcn_mfma_f32_16x16x32_bf16(b[ni], a[mi], acc[mi][ni], 0, 0, 0);
            }
#pragma unroll
            for (int mi = 0; mi < 4; ++mi)
#pragma unroll
                for (int ni = 0; ni < 2; ++ni) *(f32x4*)(lds + wid * 2048 + (16 * mi + r) * 32 + 16 * ni + 4 * q) = acc[mi][ni];
        }
        __syncthreads();
        if (tid < 128) {
            const int rr = tid >> 1, c8 = (tid & 1) * 8;
            float lg[8] = {0.f, 0.f, 0.f, 0.f, 0.f, 0.f, 0.f, 0.f};
#pragma unroll
            for (int w = 0; w < 8; ++w) { const float4 x0 = *(const float4*)(lds + w * 2048 + rr * 32 + c8), x1 = *(const float4*)(lds + w * 2048 + rr * 32 + c8 + 4);
                lg[0] += x0.x; lg[1] += x0.y; lg[2] += x0.z; lg[3] += x0.w; lg[4] += x1.x; lg[5] += x1.y; lg[6] += x1.z; lg[7] += x1.w; }
            float sc[16], bs[16];
            const float* rb = p.in[5];
#pragma unroll
            for (int j = 0; j < 8; ++j) {
                const float mine_s = 1.f / (1.f + expf(-lg[j])), mine_b = mine_s + rb[c8 + j];
                const float oth_s = __shfl_xor(mine_s, 1), oth_b = __shfl_xor(mine_b, 1);
                sc[j] = c8 ? oth_s : mine_s; sc[8 + j] = c8 ? mine_s : oth_s; bs[j] = c8 ? oth_b : mine_b; bs[8 + j] = c8 ? mine_b : oth_b;
            }
            int e0, e1; float g0, g1; route16(sc, bs, e0, e1, g0, g1);
            if (c8 == 0) {
                const int row = r0 + rr;
                const int p0 = (int)atomicAdd(lcnt + e0, 1u), p1 = (int)atomicAdd(lcnt + e1, 1u);
                const int4 rt4 = make_int4(e0, p0, e1, p1);
                ((int4*)(ws + WS_ROUTE))[row] = rt4;
                ((float2*)(ws + WS_GATE))[row] = make_float2(g0, g1);
                lrt[kt * 64 + rr] = rt4;
            }
        }
        __syncthreads();
    }
    __syncthreads();
    if (tid < 16) {
        u32* cnt = (u32*)(ws + WS_CTL) + CW_CNT + (layer * 16 + tid) * 64;
        const int base = (int)atomicAdd(cnt, lcnt[tid]);
        CHKI[CH_BBASE + bid * 16 + tid] = base; lcnt[16 + tid] = (u32)base;
    }
    __syncthreads();
    {
        int* ELIST = CHKI + CH_ELIST;
        int k2 = 0;
        for (int tile = bid; tile < nrows / 64; tile += nb, ++k2)
            if (tid < 64) { const int4 rt = lrt[k2 * 64 + tid]; const int row = tile * 64 + tid;
                ELIST[rt.x * MT + (int)lcnt[16 + rt.x] + rt.y] = row; ELIST[rt.z * MT + (int)lcnt[16 + rt.z] + rt.w] = row; }
    }
}

namespace g8 {
#define G8_LAS __attribute__((address_space(3)))
typedef short bf16x8 __attribute__((ext_vector_type(8)));
typedef float f32x4 __attribute__((ext_vector_type(4)));
constexpr int BM = 256, BK = 64, HALF = 128, HTB = HALF * BK * 2, STAGE_BYTES = 8 * HTB, NXCD = 8, WGM = 8;
__device__ __forceinline__ int lds_byte(int r, int c) { const int st = (r >> 4) * 2 + (c >> 5), rr = r & 15, cc = c & 31, ob = rr * 64 + cc * 2; return st * 1024 + (ob ^ (((ob >> 9) & 1) << 5)); }
__device__ __forceinline__ void stage_rc(int b, int& R, int& C) { const int st = b / 1024, sb = b % 1024, swz = sb ^ (((sb >> 9) & 1) << 5); R = (st >> 1) * 16 + swz / 64; C = (st & 1) * 32 + (swz % 64) / 2; }
__device__ __forceinline__ int perm32(int rho) { const int n = rho >> 4, i = rho & 15; return 8 * (i >> 2) + 4 * n + (i & 3); }
struct Unit { int pm, pn; };
struct Order {
    int nM, nN, nwg, G, c;
    __device__ __forceinline__ void init(int nM_, int nN_, int G_, int c_) { nM = nM_; nN = nN_; nwg = nM * nN; G = G_; c = c_; }
    __device__ __forceinline__ bool next(int i, Unit& u) const {
        const long L = (long)i * G + c; if (L >= nwg) return false;
        int wgid = (int)L; { const int q = nwg / NXCD, r = nwg % NXCD, xcd = wgid % NXCD, off = wgid / NXCD; wgid = (xcd < r ? xcd * (q + 1) : r * (q + 1) + (xcd - r) * q) + off; }
        const int nig = WGM * nN, gid = wgid / nig, fm = gid * WGM, gsz = (nM - fm) < WGM ? (nM - fm) : WGM;
        u.pm = fm + ((wgid % nig) % gsz); u.pn = (wgid % nig) / gsz; return true;
    }
};
template <class RowSrc, class BSel, class EF>
__device__ __forceinline__ void gemm8(const int tid, G8_LAS unsigned char* lds, const bf16_t* A, int K, const RowSrc& rsrc, const Order& S, const BSel& bsel, const EF& ef) {
    const int wid = __builtin_amdgcn_readfirstlane(tid >> 6), lane = tid & 63, wr = wid >> 2, wc = wid & 3, fr = lane & 15, fq = lane >> 4;
    const int nt = K / BK;
    int R0, C0, R1, C1; stage_rc(tid * 16, R0, C0); stage_rc(tid * 16 + 8192, R1, C1);
    const unsigned vb0 = (unsigned)(((R0 & ~31) + perm32(R0 & 31)) * K + C0) * 2u, vb1 = (unsigned)(((R1 & ~31) + perm32(R1 & 31)) * K + C1) * 2u;
    const size_t kstep = (size_t)(BK * 2), hstep = (size_t)HALF * K * 2, tstep = 2 * hstep;
    const unsigned ldsw = (unsigned)wid * 1024u;
    const int aoff = lds_byte(wr * 64 + fr, fq * 8), boff = lds_byte(wc * 32 + fr, fq * 8);
#define G8_SA(b, h) (((b) * 2 + (h)) * HTB)
#define G8_SB(b, h) ((4 + (b) * 2 + (h)) * HTB)
#define G8_STAGE(bufoff, gbase, v0, v1) do { \
        __builtin_amdgcn_global_load_lds((const unsigned*)((const char*)(gbase) + (v0)), (G8_LAS unsigned*)(lds + (bufoff) + ldsw), 16, 0, 0); \
        __builtin_amdgcn_global_load_lds((const unsigned*)((const char*)(gbase) + (v1)), (G8_LAS unsigned*)(lds + (bufoff) + ldsw + 8192), 16, 0, 0); } while (0)
#define G8_LDA(dst, b, h) do { _Pragma("unroll") for (int m = 0; m < 4; ++m) _Pragma("unroll") for (int k = 0; k < 2; ++k) dst[m][k] = *(const G8_LAS bf16x8*)(lds + G8_SA(b, h) + aoff + m * 2048 + k * 1024); } while (0)
#define G8_LDB(dst, b, h) do { _Pragma("unroll") for (int n = 0; n < 2; ++n) _Pragma("unroll") for (int k = 0; k < 2; ++k) dst[n][k] = *(const G8_LAS bf16x8*)(lds + G8_SB(b, h) + boff + n * 2048 + k * 1024); } while (0)
#define G8_MMA(ai, bj, At, Bt) do { __builtin_amdgcn_s_setprio(1); _Pragma("unroll") for (int m = 0; m < 4; ++m) _Pragma("unroll") for (int n = 0; n < 2; ++n) _Pragma("unroll") for (int k = 0; k < 2; ++k) \
        acc[ai][bj][m][n] = __builtin_amdgcn_mfma_f32_16x16x32_bf16(Bt[n][k], At[m][k], acc[ai][bj][m][n], 0, 0, 0); __builtin_amdgcn_s_setprio(0); } while (0)
#define G8_WAIT_V(n) asm volatile("s_waitcnt vmcnt(" #n ")" ::: "memory")
#define G8_WAIT_L(n) asm volatile("s_waitcnt lgkmcnt(" #n ")" ::: "memory")
#define G8_BAR __builtin_amdgcn_s_barrier()
#define G8_SCHED __builtin_amdgcn_sched_barrier(0)
#define G8_AOFF(pm_, h_, R_, C_) ((unsigned)(rsrc((pm_), (h_) * 128 + (R_)) * K + (C_)) * 2u)
    Unit cur, nxt; int ui = 0;
    if (!S.next(0, cur)) return;
    f32x4 acc[2][2][4][2];
#pragma unroll
    for (int a = 0; a < 2; ++a)
#pragma unroll
        for (int b = 0; b < 2; ++b)
#pragma unroll
            for (int m = 0; m < 4; ++m)
#pragma unroll
                for (int n = 0; n < 2; ++n) acc[a][b][m][n] = (f32x4){0.f, 0.f, 0.f, 0.f};
    bf16x8 At[4][2], B0[2][2], B1[2][2];
    const char* Ab = (const char*)A;
    unsigned a00 = G8_AOFF(cur.pm, 0, R0, C0), a01 = G8_AOFF(cur.pm, 0, R1, C1), a10 = G8_AOFF(cur.pm, 1, R0, C0), a11 = G8_AOFF(cur.pm, 1, R1, C1);
    const char* cB = bsel(cur.pm) + (size_t)cur.pn * tstep;
    G8_STAGE(G8_SB(0, 0), cB, vb0, vb1); G8_STAGE(G8_SA(0, 0), Ab, a00, a01); G8_STAGE(G8_SB(0, 1), cB + hstep, vb0, vb1); G8_STAGE(G8_SA(0, 1), Ab, a10, a11);
    if (wr == 1) G8_BAR;
    G8_WAIT_V(4); G8_BAR;
    G8_STAGE(G8_SB(1, 0), cB + kstep, vb0, vb1); G8_STAGE(G8_SA(1, 0), Ab + kstep, a00, a01); G8_STAGE(G8_SB(1, 1), cB + hstep + kstep, vb0, vb1);
    G8_WAIT_V(6); G8_BAR;
    for (;;) {
        const bool has_next = S.next(ui + 1, nxt);
        unsigned n00 = a00, n01 = a01, n10 = a10, n11 = a11; const char* nB = cB;
        if (has_next) { n00 = G8_AOFF(nxt.pm, 0, R0, C0); n01 = G8_AOFF(nxt.pm, 0, R1, C1); n10 = G8_AOFF(nxt.pm, 1, R0, C0); n11 = G8_AOFF(nxt.pm, 1, R1, C1); nB = bsel(nxt.pm) + (size_t)nxt.pn * tstep; }
        for (int t = 0; t < nt; t += 2) {
            const bool last = (t == nt - 2);
            const char* a1p = Ab + (size_t)(t + 1) * kstep;
            const char* a2p = last ? Ab : Ab + (size_t)(t + 2) * kstep; const char* b2 = last ? nB : cB + (size_t)(t + 2) * kstep;
            const char* a3p = a2p + kstep; const char* b3 = b2 + kstep;
            const unsigned x00 = last ? n00 : a00, x01 = last ? n01 : a01, x10 = last ? n10 : a10, x11 = last ? n11 : a11;
            G8_LDB(B0, 0, 0); G8_SCHED; G8_LDA(At, 0, 0); G8_STAGE(G8_SA(1, 1), a1p, a10, a11);
            G8_WAIT_L(8); G8_BAR; G8_WAIT_L(0); G8_MMA(0, 0, At, B0); G8_BAR; G8_SCHED;
            G8_LDB(B1, 0, 1); G8_STAGE(G8_SB(0, 0), b2, vb0, vb1);
            G8_BAR; G8_WAIT_L(0); G8_MMA(0, 1, At, B1); G8_BAR;
            G8_LDA(At, 0, 1); G8_STAGE(G8_SA(0, 0), a2p, x00, x01);
            G8_BAR; G8_WAIT_L(0); G8_MMA(1, 0, At, B0); G8_BAR; G8_SCHED;
            G8_STAGE(G8_SB(0, 1), b2 + hstep, vb0, vb1);
            G8_WAIT_V(6); G8_BAR; G8_MMA(1, 1, At, B1); G8_BAR;
            G8_LDB(B0, 1, 0); G8_SCHED; G8_LDA(At, 1, 0); G8_STAGE(G8_SA(0, 1), a2p, x10, x11);
            G8_WAIT_L(8); G8_BAR; G8_WAIT_L(0); G8_MMA(0, 0, At, B0); G8_BAR; G8_SCHED;
            G8_LDB(B1, 1, 1); G8_STAGE(G8_SB(1, 0), b3, vb0, vb1);
            G8_BAR; G8_WAIT_L(0); G8_MMA(0, 1, At, B1); G8_BAR;
            G8_LDA(At, 1, 1); G8_STAGE(G8_SA(1, 0), a3p, x00, x01);
            G8_BAR; G8_WAIT_L(0); G8_MMA(1, 0, At, B0); G8_BAR; G8_SCHED;
            G8_STAGE(G8_SB(1, 1), b3 + hstep, vb0, vb1);
            G8_WAIT_V(6); G8_BAR; G8_MMA(1, 1, At, B1); G8_BAR;
        }
#pragma unroll
        for (int ai = 0; ai < 2; ++ai)
#pragma unroll
            for (int m = 0; m < 4; ++m)
#pragma unroll
                for (int bj = 0; bj < 2; ++bj) {
                    const f32x4 v0 = acc[ai][bj][m][0], v1 = acc[ai][bj][m][1];
                    const float v[8] = {v0[0], v0[1], v0[2], v0[3], v1[0], v1[1], v1[2], v1[3]};
                    ef(cur.pm * BM + ai * HALF + wr * 64 + m * 16 + fr, cur.pn * BM + bj * HALF + wc * 32 + 8 * fq, v);
                }
        if (!has_next) break;
#pragma unroll
        for (int a = 0; a < 2; ++a)
#pragma unroll
            for (int b = 0; b < 2; ++b)
#pragma unroll
                for (int m = 0; m < 4; ++m)
#pragma unroll
                    for (int n = 0; n < 2; ++n) acc[a][b][m][n] = (f32x4){0.f, 0.f, 0.f, 0.f};
        cur = nxt; a00 = n00; a01 = n01; a10 = n10; a11 = n11; cB = nB; ++ui;
    }
    G8_WAIT_V(0);
    if (wr == 0) G8_BAR;
    G8_BAR;
#undef G8_SA
#undef G8_SB
#undef G8_STAGE
#undef G8_LDA
#undef G8_LDB
#undef G8_MMA
#undef G8_WAIT_V
#undef G8_WAIT_L
#undef G8_BAR
#undef G8_SCHED
#undef G8_AOFF
}
}
struct BSelOne { const char* B; __device__ __forceinline__ const char* operator()(int) const { return B; } };
struct RowPlain { __device__ __forceinline__ int operator()(int pm, int r) const { return pm * 256 + r; } };
struct BSelExp { const char* B; const int* tinfo; size_t stride; __device__ __forceinline__ const char* operator()(int pm) const { return B + (size_t)tinfo[2 * pm] * stride; } };
struct RowMoe { const int* tinfo; const int* ecnt; const int* elist;
    __device__ __forceinline__ int operator()(int pm, int r) const { const int e = tinfo[2 * pm], pos = tinfo[2 * pm + 1] + r; return pos < ecnt[e] ? elist[e * MT + pos] : 0; } };
__device__ __forceinline__ int moe_tile_table(const P& p, int layer, int* tinfo, int* ecnt, int tid) {
    const u32* cnt = (const u32*)(p.get_ws() + WS_CTL) + CW_CNT + layer * 16 * 64;
    if (tid == 0) {
        int t = 0;
#pragma unroll 1
        for (int e = 0; e < 16; ++e) { const int c = (int)cnt[e * 64]; ecnt[e] = c;
#pragma unroll 1
            for (int i = 0; i < (c + 255) / 256; ++i) { tinfo[2 * t] = e; tinfo[2 * t + 1] = i * 256; ++t; } }
        ecnt[16] = t;
    }
    __syncthreads();
    return ecnt[16];
}

struct SrcPlain { const float* W; int ldw; __device__ __forceinline__ const float* operator()(int k, int n) const { return W + (size_t)k * ldw + n; } };
struct SrcEven { const float* W; __device__ __forceinline__ const float* operator()(int k, int n) const {
        return n < 2048 ? W + (size_t)k * EV_IN + (n < 1280 ? n : n + 16) : (n < 2064 ? W + (size_t)k * EV_IN + 1280 + (n - 2048) : nullptr); } };
struct SrcRouter { const float* W; __device__ __forceinline__ const float* operator()(int k, int n) const { return n < 16 ? W + (size_t)k * 16 + n : nullptr; } };
struct SrcOdd { const float* W; __device__ __forceinline__ const float* operator()(int k, int n) const { return n < OD_IN ? W + (size_t)k * OD_IN + n : nullptr; } };
struct SrcMoe13 { const float* W1; long long d13; __device__ __forceinline__ const float* operator()(int k, int n) const { return W1 + ((n & 4) ? d13 : 0ll) + (size_t)k * DE + ((n >> 3) * 4 + (n & 3)); } };
template <class SF>
__device__ __forceinline__ void conv_matrix(const SF& src, int K, int N, bf16_t* WT, int gw, int ngw, float* scr, int lane) {
    const int nblk = N / 32, nitems = (K / 64) * nblk;
    for (int item = gw; item < nitems; item += ngw) {
        const int kb = item / nblk, nbk = item % nblk, k0 = 64 * kb, n0 = 32 * nbk;
#pragma unroll 8
        for (int i = 0; i < 32; ++i) { const int kk = 2 * i + (lane >> 5); const float* sp = src(k0 + kk, n0 + (lane & 31)); scr[kk * 33 + (lane & 31)] = sp ? *sp : 0.f; }
        __builtin_amdgcn_s_waitcnt(0xC07F); asm volatile("" ::: "memory");
        const int c = lane & 7;
#pragma unroll
        for (int j = 0; j < 4; ++j) { const int n = (lane >> 3) + 8 * j; const float* sp = scr + (8 * c) * 33 + n;
            uint4 o; o.x = pack2(sp[0 * 33], sp[1 * 33]); o.y = pack2(sp[2 * 33], sp[3 * 33]); o.z = pack2(sp[4 * 33], sp[5 * 33]); o.w = pack2(sp[6 * 33], sp[7 * 33]);
            *(uint4*)(WT + (size_t)(n0 + n) * K + k0 + 8 * c) = o; }
        __builtin_amdgcn_s_waitcnt(0xC07F); asm volatile("" ::: "memory");
    }
}
__device__ __forceinline__ void conv_dense(const P& p, int bid, int nb, float* lds) {
    const int tid = p.tid(), lane = tid & 63, wid = tid >> 6;
    float* scr = lds + 16384 + wid * (64 * 33);
    const int gw = bid * 8 + wid, ngw = nb * 8;
    unsigned char* ws = p.get_ws();
    conv_matrix(SrcEven{p.in[10]}, 1024, 2304, (bf16_t*)(ws + WS_WIN0), gw, ngw, scr, lane);
    conv_matrix(SrcOdd{p.in[21]}, 1024, 3328, (bf16_t*)(ws + WS_WIN1), gw, ngw, scr, lane);
    conv_matrix(SrcPlain{p.in[20], 1024}, 1024, 1024, (bf16_t*)(ws + WS_WOUT0), gw, ngw, scr, lane);
    conv_matrix(SrcPlain{p.in[27], 1024}, 1024, 1024, (bf16_t*)(ws + WS_WOUT1), gw, ngw, scr, lane);
    conv_matrix(SrcRouter{p.in[4]}, 1024, 32, (bf16_t*)((float*)(ws + WS_CHK) + CH_WRT), gw, ngw, scr, lane);
}
__device__ __forceinline__ void conv_moe_chunk(const P& p, int chunk, float* lds, int layer) {
    const int tid = p.tid(), lane = tid & 63, wid = tid >> 6;
    float* scr = lds + 16384 + wid * (64 * 33);
    unsigned char* ws = p.get_ws();
    bf16_t* W13T = (bf16_t*)(ws + WS_WMOE); bf16_t* W2T = W13T + (size_t)16 * 1024 * 1024;
    const long long d13 = (long long)(p.in[29] - p.in[28]);
#pragma unroll 1
    for (int j = 0; j < 2; ++j) {
        const int wi = chunk * 16 + wid * 2 + j, e = wi / 768, idx = wi % 768;
        if (idx < 512) conv_matrix(SrcMoe13{p.in[28] + ((size_t)layer * 16 + e) * 1024 * DE, d13}, 1024, 1024, W13T + (size_t)e * 1024 * 1024, idx, 1 << 20, scr, lane);
        else conv_matrix(SrcPlain{p.in[30] + ((size_t)layer * 16 + e) * DE * 1024, 1024}, DE, 1024, W2T + (size_t)e * 1024 * DE, idx - 512, 1 << 20, scr, lane);
    }
}
__device__ __forceinline__ void conv_moe(const P& p, int bid, int nb, float* lds, int layer) {
    const int tid = p.tid(), lane = tid & 63, wid = tid >> 6;
    float* scr = lds + 16384 + wid * (64 * 33);
    const int ngw = nb * 8; int gw = bid * 8 + wid;
    unsigned char* ws = p.get_ws();
    bf16_t* W13T = (bf16_t*)(ws + WS_WMOE); bf16_t* W2T = W13T + (size_t)16 * 1024 * 1024;
    const long long d13 = (long long)(p.in[29] - p.in[28]);
    for (int e = 0; e < 16; ++e) {
        conv_matrix(SrcMoe13{p.in[28] + ((size_t)layer * 16 + e) * 1024 * DE, d13}, 1024, 1024, W13T + (size_t)e * 1024 * 1024, gw, ngw, scr, lane);
        conv_matrix(SrcPlain{p.in[30] + ((size_t)layer * 16 + e) * DE * 1024, 1024}, DE, 1024, W2T + (size_t)e * 1024 * DE, gw, ngw, scr, lane);
        gw = (gw + 768) % ngw;
    }
}


template <class EF>
__device__ __forceinline__ void mini_gemm(const P& p, int bid, int nb, float* lds, const bf16_t* A, const bf16_t* Bt, int row0, int nrt, int col0, int nct, const EF& ef) {
    constexpr int K = 1024, KS = 128;
    const int tid = p.tid(), lane = tid & 63, wid = tid >> 6, r = lane & 15, q = lane >> 4;
    const int ntl = nrt * nct;
    int t = bid;
    if (t >= ntl) return;
    bf16x8 a[4][4], b[4][2];
#define MG_LOAD(tt) do { const int rt_ = (tt) / nct, ct_ = (tt) % nct; \
        const bf16_t* Ab_ = A + (size_t)(row0 + rt_ * 64 + r) * K + wid * KS + 8 * q; const bf16_t* Bb_ = Bt + (size_t)(col0 + ct_ * 32 + r) * K + wid * KS + 8 * q; \
        _Pragma("unroll") for (int k4 = 0; k4 < 4; ++k4) { \
            _Pragma("unroll") for (int mi = 0; mi < 4; ++mi) a[k4][mi] = *(const bf16x8*)(Ab_ + (size_t)(16 * mi) * K + 32 * k4); \
            _Pragma("unroll") for (int ni = 0; ni < 2; ++ni) b[k4][ni] = *(const bf16x8*)(Bb_ + (size_t)(16 * ni) * K + 32 * k4); } } while (0)
    MG_LOAD(t);
    for (;;) {
        f32x4 acc[4][2];
#pragma unroll
        for (int mi = 0; mi < 4; ++mi)
#pragma unroll
            for (int ni = 0; ni < 2; ++ni) acc[mi][ni] = (f32x4){0.f, 0.f, 0.f, 0.f};
#pragma unroll
        for (int k4 = 0; k4 < 4; ++k4)
#pragma unroll
            for (int mi = 0; mi < 4; ++mi)
#pragma unroll
                for (int ni = 0; ni < 2; ++ni) acc[mi][ni] = __builtin_amdgcn_mfma_f32_16x16x32_bf16(b[k4][ni], a[k4][mi], acc[mi][ni], 0, 0, 0);
        const int tcur = t; t += nb;
        const bool more = t < ntl;
        if (more) MG_LOAD(t);
        __syncthreads();
#pragma unroll
        for (int mi = 0; mi < 4; ++mi)
#pragma unroll
            for (int ni = 0; ni < 2; ++ni) *(f32x4*)(lds + wid * 2048 + (16 * mi + r) * 32 + 16 * ni + 4 * q) = acc[mi][ni];
        __syncthreads();
        if (tid < 256) {
            const int rr = tid >> 2, c8 = (tid & 3) * 8;
            float v[8] = {0.f, 0.f, 0.f, 0.f, 0.f, 0.f, 0.f, 0.f};
#pragma unroll
            for (int w = 0; w < 8; ++w) { const float4 x0 = *(const float4*)(lds + w * 2048 + rr * 32 + c8), x1 = *(const float4*)(lds + w * 2048 + rr * 32 + c8 + 4);
                v[0] += x0.x; v[1] += x0.y; v[2] += x0.z; v[3] += x0.w; v[4] += x1.x; v[5] += x1.y; v[6] += x1.z; v[7] += x1.w; }
            ef(row0 + (tcur / nct) * 64 + rr, col0 + (tcur % nct) * 32 + c8, v);
        }
        if (!more) break;
    }
#undef MG_LOAD
    __syncthreads();
}

struct EpiProj { bf16_t* C; int ld; int nmain; int ns; float* SMALL; __device__ void operator()(int r, int c0, const float* v) const {
    if (c0 < nmain) { uint4 o; o.x = pack2(v[0], v[1]); o.y = pack2(v[2], v[3]); o.z = pack2(v[4], v[5]); o.w = pack2(v[6], v[7]); *(uint4*)(C + (size_t)r * ld + c0) = o; }
    else if (c0 < nmain + ns) { float* d = SMALL + (size_t)r * 32 + (c0 - nmain); *(float4*)d = make_float4(v[0], v[1], v[2], v[3]); *(float4*)(d + 4) = make_float4(v[4], v[5], v[6], v[7]); } } };
struct EpiBf16Store { bf16_t* C; int ld; __device__ void operator()(int r, int c0, const float* v) const {
    uint4 o; o.x = pack2(v[0], v[1]); o.y = pack2(v[2], v[3]); o.z = pack2(v[4], v[5]); o.w = pack2(v[6], v[7]); *(uint4*)(C + (size_t)r * ld + c0) = o; } };
struct EpiResid { const float* xlat; const float* xctx; bf16_t* XRES; const float* gl; const float* gc;
    __device__ void operator()(int r, int c0, const float* v) const {
        const float* g = r >= SEQ ? gc : gl;
        const float4 g0 = *(const float4*)(g + c0), g1 = *(const float4*)(g + c0 + 4);
        float x[8];
        if (xlat) { const float* xin = r >= SEQ ? xctx + (size_t)(r - SEQ) * 1024 : xlat + (size_t)r * 1024;
            const float4 x0 = *(const float4*)(xin + c0), x1 = *(const float4*)(xin + c0 + 4); x[0] = x0.x; x[1] = x0.y; x[2] = x0.z; x[3] = x0.w; x[4] = x1.x; x[5] = x1.y; x[6] = x1.z; x[7] = x1.w; }
        else unpack8(*(const uint4*)(XRES + (size_t)r * 1024 + c0), x);
        uint4 o; o.x = pack2(x[0] + g0.x * v[0], x[1] + g0.y * v[1]); o.y = pack2(x[2] + g0.z * v[2], x[3] + g0.w * v[3]); o.z = pack2(x[4] + g1.x * v[4], x[5] + g1.y * v[5]); o.w = pack2(x[6] + g1.z * v[6], x[7] + g1.w * v[7]);
        *(uint4*)(XRES + (size_t)r * 1024 + c0) = o;
    } };
struct EpiSwiglu { bf16_t* H; __device__ void operator()(int r, int c0, const float* v) const {
    uint2 o; o.x = pack2(siluf(v[0]) * v[4], siluf(v[1]) * v[5]); o.y = pack2(siluf(v[2]) * v[6], siluf(v[3]) * v[7]); *(uint2*)(H + (size_t)r * DE + (c0 >> 3) * 4) = o; } };

__device__ __forceinline__ void phase_moe1(const P& p, int bid, int nb, G8_LAS unsigned char* ldsa, float* lds, int layer) {
    unsigned char* ws = p.get_ws();
    int* tinfo = (int*)(lds + 32768); int* ecnt = tinfo + 2 * MAXTILES + 16;
    const int ntiles = moe_tile_table(p, layer, tinfo, ecnt, p.tid());
    g8::Order S; S.init(ntiles, 4, nb, bid);
    EpiSwiglu ef{(bf16_t*)(ws + WS_Y)};
    g8::gemm8(p.tid(), ldsa, (const bf16_t*)(ws + WS_HB), 1024, RowMoe{tinfo, ecnt, (const int*)(ws + WS_CHK) + CH_ELIST}, S, BSelExp{(const char*)(ws + WS_WMOE), tinfo, (size_t)1024 * 1024 * 2}, ef);
}
__device__ __forceinline__ void phase_moe2(const P& p, int bid, int nb, G8_LAS unsigned char* ldsa, float* lds, int layer) {
    unsigned char* ws = p.get_ws();
    int* tinfo = (int*)(lds + 32768); int* ecnt = tinfo + 2 * MAXTILES + 16;
    const int ntiles = moe_tile_table(p, layer, tinfo, ecnt, p.tid());
    g8::Order S; S.init(ntiles, 4, nb, bid);
    EpiBf16Store ef{(bf16_t*)(ws + WS_PROJ), 1024};
    g8::gemm8(p.tid(), ldsa, (const bf16_t*)(ws + WS_Y), DE, RowPlain{}, S, BSelExp{(const char*)(ws + WS_WMOE) + (size_t)16 * 1024 * 1024 * 2, tinfo, (size_t)1024 * DE * 2}, ef);
}

__device__ __forceinline__ void phase_qkprep(const P& p, int bid, int nb) {
    const int tid = p.tid(), lane = tid & 63, wid = tid >> 6;
    unsigned char* ws = p.get_ws();
    const bf16_t* PROJ = (const bf16_t*)(ws + WS_PROJ);
    bf16_t* QKR = (bf16_t*)(ws + WS_XRES);
    const float* RC = (const float*)(ws + WS_ROPE); const float* RS = RC + 256 * 16;
    const int d0 = (lane & 7) * 8;
    float qn[8], kn[8];
#pragma unroll
    for (int j = 0; j < 8; ++j) { qn[j] = p.in[17][d0 + j]; kn[j] = p.in[18][d0 + j]; }
    for (int rk = bid * 8; rk < MT / 8; rk += nb * 8)
#pragma unroll 2
    for (int k8 = 0; k8 < 8; ++k8) {
        const int row = (rk + k8) * 8 + wid;
        const bool lat = row < SEQ;
        const uint4 qraw = *(const uint4*)(PROJ + (size_t)row * 2048 + 1280 + lane * 8);
        const uint4 kraw = lane < 16 ? *(const uint4*)(PROJ + (size_t)row * 2048 + 1792 + lane * 8) : make_uint4(0u, 0u, 0u, 0u);
        const int pos = d0 < 32 ? (row >> 6) : (row & 63);
        float cs[8], sn[8];
#pragma unroll
        for (int j = 0; j < 8; ++j) { const int f = (d0 + j) & 15; cs[j] = lat ? RC[pos * 16 + f] : 1.f; sn[j] = lat ? RS[pos * 16 + f] : 0.f; }
        const bool lowhalf = (d0 & 16) == 0;
#pragma unroll
        for (int part = 0; part < 2; ++part) {
            float f[8]; unpack8(part == 0 ? qraw : kraw, f);
            float ss = 0.f;
#pragma unroll
            for (int j = 0; j < 8; ++j) ss += f[j] * f[j];
            ss += __shfl_xor(ss, 1); ss += __shfl_xor(ss, 2); ss += __shfl_xor(ss, 4);
            const float rs = rsqrtf(ss * (1.f / 64.f) + 1e-6f);
            float o[8];
#pragma unroll
            for (int j = 0; j < 8; ++j) { const float y = f[j] * rs * (part == 0 ? qn[j] : kn[j]); const float oth = __shfl_xor(y, 2); o[j] = lowhalf ? y * cs[j] - oth * sn[j] : oth * sn[j] + y * cs[j]; }
            uint4 w; w.x = pack2(o[0], o[1]); w.y = pack2(o[2], o[3]); w.z = pack2(o[4], o[5]); w.w = pack2(o[6], o[7]);
            if (part == 0) *(uint4*)(QKR + (size_t)row * 640 + lane * 8) = w;
            else if (lane < 16) *(uint4*)(QKR + (size_t)row * 640 + 512 + lane * 8) = w;
        }
    }
}


template <int MI, int NI, int KK, bool SWAP, bool SWB = false>
__device__ __forceinline__ void wave_mma(f32x4 (&acc)[MI][NI], const bf16_t* A, int lda, const bf16_t* Bt, int ldb, int lane) {
    const int r = lane & 15, q = lane >> 4;
#pragma unroll
    for (int kk = 0; kk < KK; kk += 32) {
        bf16x8 a[MI], b[NI];
#pragma unroll
        for (int mi = 0; mi < MI; ++mi) a[mi] = *(const bf16x8*)(A + (16 * mi + r) * lda + kk + 8 * q);
#pragma unroll
        for (int ni = 0; ni < NI; ++ni) b[ni] = *(const bf16x8*)(Bt + (16 * ni + r) * ldb + ((kk + 8 * q) ^ (SWB ? ((((16 * ni + r) >> 3) & 7) << 3) : 0)));
#pragma unroll
        for (int mi = 0; mi < MI; ++mi)
#pragma unroll
            for (int ni = 0; ni < NI; ++ni)
                acc[mi][ni] = SWAP ? __builtin_amdgcn_mfma_f32_16x16x32_bf16(b[ni], a[mi], acc[mi][ni], 0, 0, 0) : __builtin_amdgcn_mfma_f32_16x16x32_bf16(a[mi], b[ni], acc[mi][ni], 0, 0, 0);
    }
}
__device__ __forceinline__ void prefetch_line(const void* g, float* lds_dummy, int wid) {
    __builtin_amdgcn_global_load_lds((const unsigned*)g, (__attribute__((address_space(3))) unsigned*)((__attribute__((address_space(3))) unsigned char*)lds_dummy + wid * 256), 4, 0, 0);
}
struct Raw3 { uint4 m, c, p; };
__device__ __forceinline__ Raw3 conv8_load(const bf16_t* rowp, int ld, int t, int L) {
    const uint4 z = make_uint4(0u, 0u, 0u, 0u);
    Raw3 r; r.m = t > 0 ? *(const uint4*)(rowp - ld) : z; r.c = *(const uint4*)rowp; r.p = t < L - 1 ? *(const uint4*)(rowp + ld) : z; return r;
}
__device__ __forceinline__ void conv8_apply(const Raw3& r, const float* cwl, float* out) {
    float fm[8], f0[8], fp[8]; unpack8(r.m, fm); unpack8(r.c, f0); unpack8(r.p, fp);
#pragma unroll
    for (int j = 0; j < 8; ++j) { const float4 w = *(const float4*)(cwl + j * 4); out[j] = siluf(w.x * fm[j] + w.y * f0[j] + w.z * fp[j] + w.w); }
}
__device__ __forceinline__ float wave_scan128(float& v0, float& v1, int lane) {
    float s = v0 + v1;
#pragma unroll
    for (int o = 1; o < 64; o <<= 1) { const float t = __shfl_up(s, o); if (lane >= o) s += t; }
    const float excl = s - (v0 + v1);
    v0 = excl + v0; v1 = v0 + v1;
    return __shfl(s, 63);
}

constexpr size_t SSD_S_OFF = 0;
constexpr size_t SSD_H_OFF = (size_t)130 * 16 * 4096 * 4;
__device__ __forceinline__ void stage_convw(const float* cw, const float* cb, int C, float* cwl, int tid) {
    for (int c = tid; c < C; c += NTH) *(float4*)(cwl + c * 4) = make_float4(cw[c], cw[C + c], cw[2 * C + c], cb[c]);
}
__device__ __forceinline__ void ssd_states(const P& p, int bid, int nb, float* lds) {
    const int tid = p.tid(), lane = tid & 63, wid = tid >> 6;
    unsigned char* ws = p.get_ws();
    const bf16_t* PROJ = (const bf16_t*)(ws + WS_PROJ);
    const float* SMALL = (const float*)(ws + WS_SMALL);
    float* S = (float*)(ws + WS_Y + SSD_S_OFF);
    float* DEC = (float*)(ws + WS_CHK);
    float* cwl = lds;
    bf16_t* XT = (bf16_t*)(lds + 768 * 4);
    bf16_t* BT = XT + 256 * 136;
    float* wsc = (float*)(BT + 64 * 136);
    stage_convw(p.in[11], p.in[12], 768, cwl, tid);
    __syncthreads();
    for (int item = bid; item < 260; item += nb) {
        const int c = item >> 1, g = item & 1;
        const int L = c < 128 ? SEQ : CTX, t0 = c < 128 ? c * 128 : (c - 128) * 128, rbase = c < 128 ? 0 : SEQ;
        const int tid = p.tid(), lane = tid & 63, wid = tid >> 6;
#pragma unroll 1
        for (int b5 = 0; b5 < 2; ++b5) {
            Raw3 rw[5];
#pragma unroll
            for (int k = 0; k < 5; ++k) { const int i = tid + (b5 * 5 + k) * NTH; const int cg8 = (i >> 3) % 40, tl = (i / 320) * 8 + (i & 7);
                const int ch = cg8 < 32 ? g * 256 + cg8 * 8 : 512 + g * 64 + (cg8 - 32) * 8;
                rw[k] = conv8_load(PROJ + (size_t)(rbase + t0 + tl) * 2048 + 512 + ch, 2048, t0 + tl, L); }
#pragma unroll
            for (int k = 0; k < 5; ++k) { const int i = tid + (b5 * 5 + k) * NTH; const int cg8 = (i >> 3) % 40, tl = (i / 320) * 8 + (i & 7);
                const int ch = cg8 < 32 ? g * 256 + cg8 * 8 : 512 + g * 64 + (cg8 - 32) * 8;
                float o[8]; conv8_apply(rw[k], cwl + ch * 4, o);
                const int tls = tl ^ ((cg8 & 7) << 3);
                bf16_t* dst = cg8 < 32 ? XT + (cg8 * 8) * 136 + tls : BT + ((cg8 - 32) * 8) * 136 + tls;
#pragma unroll
                for (int j = 0; j < 8; ++j) dst[j * 136] = f2bf(o[j]); }
        }
        const int hh = wid >> 1, d = wid & 1, h = g * 4 + hh;
        {
            const float A = -expf(p.in[14][d * 8 + h]), dtb = p.in[13][d * 8 + h];
            const float dt0 = softplusf(SMALL[(size_t)(rbase + t0 + 2 * lane) * 32 + d * 8 + h] + dtb), dt1 = softplusf(SMALL[(size_t)(rbase + t0 + 2 * lane + 1) * 32 + d * 8 + h] + dtb);
            const float a0 = dt0 * A, a1 = dt1 * A;
            float c0 = a0, c1 = a1; const float tot = wave_scan128(c0, c1, lane);
            const float w0 = d == 0 ? __expf(tot - c0) * dt0 : __expf(c0 - a0) * dt0, w1 = d == 0 ? __expf(tot - c1) * dt1 : __expf(c1 - a1) * dt1;
            wsc[wid * 128 + 2 * lane] = w0; wsc[wid * 128 + 2 * lane + 1] = w1;
            if (lane == 0) DEC[c * 16 + d * 8 + h] = __expf(tot);
        }
        __syncthreads();
        {
            f32x4 acc[4][4];
#pragma unroll
            for (int mi = 0; mi < 4; ++mi)
#pragma unroll
                for (int ni = 0; ni < 4; ++ni) acc[mi][ni] = (f32x4){0.f, 0.f, 0.f, 0.f};
            const int r = lane & 15, q = lane >> 4;
#pragma unroll
            for (int kk = 0; kk < 128; kk += 32) {
                const float4 wa = *(const float4*)(wsc + wid * 128 + kk + 8 * q), wb = *(const float4*)(wsc + wid * 128 + kk + 8 * q + 4);
                bf16x8 a[4], b[4];
#pragma unroll
                for (int mi = 0; mi < 4; ++mi) {
                    const uint4 raw = *(const uint4*)(XT + (hh * 64 + 16 * mi + r) * 136 + ((kk + 8 * q) ^ ((((16 * mi + r) >> 3) & 7) << 3)));
                    float f[8]; unpack8(raw, f);
                    uint4 o; o.x = pack2(f[0] * wa.x, f[1] * wa.y); o.y = pack2(f[2] * wa.z, f[3] * wa.w); o.z = pack2(f[4] * wb.x, f[5] * wb.y); o.w = pack2(f[6] * wb.z, f[7] * wb.w);
                    a[mi] = *(bf16x8*)&o;
                }
#pragma unroll
                for (int ni = 0; ni < 4; ++ni) b[ni] = *(const bf16x8*)(BT + (16 * ni + r) * 136 + ((kk + 8 * q) ^ ((((16 * ni + r) >> 3) & 7) << 3)));
#pragma unroll
                for (int mi = 0; mi < 4; ++mi)
#pragma unroll
                    for (int ni = 0; ni < 4; ++ni) acc[mi][ni] = __builtin_amdgcn_mfma_f32_16x16x32_bf16(a[mi], b[ni], acc[mi][ni], 0, 0, 0);
                __builtin_amdgcn_sched_barrier(0);
            }
            float* Sp = S + ((size_t)(c * 2 + d) * 8 + h) * 4096;
#pragma unroll
            for (int mi = 0; mi < 4; ++mi)
#pragma unroll
                for (int ni = 0; ni < 4; ++ni)
#pragma unroll
                    for (int j = 0; j < 4; ++j) Sp[(16 * mi + 4 * q + j) * 64 + 16 * ni + r] = acc[mi][ni][j];
        }
        __syncthreads();
    }
}
__device__ __forceinline__ void ssd_scan(const P& p, int bid, int nb) {
    const int tid = p.tid();
    unsigned char* ws = p.get_ws();
    const float* S = (const float*)(ws + WS_Y + SSD_S_OFF);
    bf16_t* HIN = (bf16_t*)(ws + WS_Y + SSD_H_OFF);
    const float* DEC = (const float*)(ws + WS_CHK);
    for (int gid = bid * NTH + tid; gid < 65536; gid += nb * NTH) {
        const int d = gid >> 15, h = (gid >> 12) & 7, e = gid & 4095;
        float H = 0.f;
#pragma unroll 1
        for (int i0 = 0; i0 < 130; i0 += 10) {
            float sv[10], dv[10]; int cc[10];
#pragma unroll
            for (int j = 0; j < 10; ++j) {
                const int i = i0 + j;
                const int c = d == 0 ? (i < 2 ? 128 + i : i - 2) : (i < 2 ? 129 - i : 129 - i);
                cc[j] = c; sv[j] = S[((size_t)(c * 2 + d) * 8 + h) * 4096 + e]; dv[j] = DEC[c * 16 + d * 8 + h];
            }
#pragma unroll
            for (int j = 0; j < 10; ++j) { HIN[((size_t)(cc[j] * 2 + d) * 8 + h) * 4096 + e] = f2bf(H); H = dv[j] * H + sv[j]; }
        }
    }
}
__device__ __forceinline__ void ssd_out(const P& p, int bid, int nb, float* lds) {
    const int tid = p.tid(), lane = tid & 63, wid = tid >> 6, r = lane & 15, q = lane >> 4;
    unsigned char* ws = p.get_ws();
    const bf16_t* PROJ = (const bf16_t*)(ws + WS_PROJ);
    const float* SMALL = (const float*)(ws + WS_SMALL);
    const bf16_t* HIN = (const bf16_t*)(ws + WS_Y + SSD_H_OFF);
    bf16_t* MIX = (bf16_t*)(ws + WS_HB);
    float* cwl = lds;
    bf16_t* Cg = (bf16_t*)(lds + 768 * 4);
    bf16_t* Bg = Cg + 128 * 72;
    bf16_t* XT = Bg + 128 * 72;
    bf16_t* Mb = XT + 64 * 136;
    bf16_t* Hn = Mb + 128 * 136;
    float* csb = (float*)(Hn + 2 * 64 * 72);
    float* dts = csb + 8 * 256;
    stage_convw(p.in[11], p.in[12], 768, cwl, tid);
    __syncthreads();
    for (int c = bid; c < 130; c += nb) {
        const int L = c < 128 ? SEQ : CTX, t0 = c < 128 ? c * 128 : (c - 128) * 128, rbase = c < 128 ? 0 : SEQ;
        const int trow = wid * 16 + r;
        float ssq = 0.f;
        {
            const int h = wid;
#pragma unroll
            for (int d = 0; d < 2; ++d) {
                const float A = -expf(p.in[14][d * 8 + h]), dtb = p.in[13][d * 8 + h];
                const float dt0 = softplusf(SMALL[(size_t)(rbase + t0 + 2 * lane) * 32 + d * 8 + h] + dtb), dt1 = softplusf(SMALL[(size_t)(rbase + t0 + 2 * lane + 1) * 32 + d * 8 + h] + dtb);
                const float a0 = dt0 * A, a1 = dt1 * A;
                float c0 = a0, c1 = a1; const float tot = wave_scan128(c0, c1, lane);
                csb[(h * 2 + d) * 128 + 2 * lane] = d == 0 ? c0 : tot - c0 + a0; csb[(h * 2 + d) * 128 + 2 * lane + 1] = d == 0 ? c1 : tot - c1 + a1;
                dts[(h * 2 + d) * 128 + 2 * lane] = dt0; dts[(h * 2 + d) * 128 + 2 * lane + 1] = dt1;
            }
        }
        for (int g = 0; g < 2; ++g) {
            {
                Raw3 rw[4];
#pragma unroll
                for (int k = 0; k < 4; ++k) { const int i = tid + k * NTH; const int cg8 = i & 15, tl = i >> 4;
                    const int ch = cg8 < 8 ? 640 + g * 64 + cg8 * 8 : 512 + g * 64 + (cg8 - 8) * 8;
                    rw[k] = conv8_load(PROJ + (size_t)(rbase + t0 + tl) * 2048 + 512 + ch, 2048, t0 + tl, L); }
#pragma unroll
                for (int k = 0; k < 4; ++k) { const int i = tid + k * NTH; const int cg8 = i & 15, tl = i >> 4;
                    const int ch = cg8 < 8 ? 640 + g * 64 + cg8 * 8 : 512 + g * 64 + (cg8 - 8) * 8;
                    float o[8]; conv8_apply(rw[k], cwl + ch * 4, o);
                    uint4 w; w.x = pack2(o[0], o[1]); w.y = pack2(o[2], o[3]); w.z = pack2(o[4], o[5]); w.w = pack2(o[6], o[7]);
                    *(uint4*)((cg8 < 8 ? Cg + cg8 * 8 : Bg + (cg8 - 8) * 8) + tl * 72) = w; }
            }
            __syncthreads();
            f32x4 G[1][8];
#pragma unroll
            for (int ni = 0; ni < 8; ++ni) G[0][ni] = (f32x4){0.f, 0.f, 0.f, 0.f};
            wave_mma<1, 8, 64, true>(G, Cg + wid * 16 * 72, 72, Bg, 72, lane);
            for (int hh = 0; hh < 4; ++hh) {
                const int h = g * 4 + hh;
                {
                    Raw3 rw[2];
#pragma unroll
                    for (int k = 0; k < 2; ++k) { const int i = tid + k * NTH; const int cg8 = (i >> 3) & 7, tl = (i >> 6) * 8 + (i & 7); const int ch = h * 64 + cg8 * 8;
                        rw[k] = conv8_load(PROJ + (size_t)(rbase + t0 + tl) * 2048 + 512 + ch, 2048, t0 + tl, L); }
                    const uint4 hp0 = *(const uint4*)(HIN + ((size_t)(c * 2 + 0) * 8 + h) * 4096 + tid * 8), hp1 = *(const uint4*)(HIN + ((size_t)(c * 2 + 1) * 8 + h) * 4096 + tid * 8);
#pragma unroll
                    for (int k = 0; k < 2; ++k) { const int i = tid + k * NTH; const int cg8 = (i >> 3) & 7, tl = (i >> 6) * 8 + (i & 7); const int ch = h * 64 + cg8 * 8;
                        float o[8]; conv8_apply(rw[k], cwl + ch * 4, o);
#pragma unroll
                        for (int j = 0; j < 8; ++j) XT[(cg8 * 8 + j) * 136 + (tl ^ (cg8 << 3))] = f2bf(o[j]); }
                    *(uint4*)(Hn + (tid >> 3) * 72 + (tid & 7) * 8) = hp0; *(uint4*)(Hn + 64 * 72 + (tid >> 3) * 72 + (tid & 7) * 8) = hp1;
                }
                __syncthreads();
                f32x4 Y[1][4];
#pragma unroll
                for (int ni = 0; ni < 4; ++ni) Y[0][ni] = (f32x4){0.f, 0.f, 0.f, 0.f};
                for (int d = 0; d < 2; ++d) {
                    const float cst = csb[(h * 2 + d) * 128 + trow];
#pragma unroll
                    for (int ni = 0; ni < 8; ++ni) {
                        const int s0 = 16 * ni + 4 * q;
                        const float4 css = *(const float4*)(csb + (h * 2 + d) * 128 + s0), dtv = *(const float4*)(dts + (h * 2 + d) * 128 + s0);
                        const float cs4[4] = {css.x, css.y, css.z, css.w}, dt4[4] = {dtv.x, dtv.y, dtv.z, dtv.w};
                        float m[4];
#pragma unroll
                        for (int j = 0; j < 4; ++j) { const int sidx = s0 + j; const bool ok = d == 0 ? sidx <= trow : sidx >= trow; m[j] = ok ? G[0][ni][j] * __expf(cst - cs4[j]) * dt4[j] : 0.f; }
                        uint2 w; w.x = pack2(m[0], m[1]); w.y = pack2(m[2], m[3]);
                        *(uint2*)(Mb + trow * 136 + s0) = w;
                    }
                    __syncthreads();
                    wave_mma<1, 4, 128, true, true>(Y, Mb + wid * 16 * 136, 136, XT, 136, lane);
                    f32x4 Yo[1][4];
#pragma unroll
                    for (int ni = 0; ni < 4; ++ni) Yo[0][ni] = (f32x4){0.f, 0.f, 0.f, 0.f};
                    wave_mma<1, 4, 64, true>(Yo, Cg + wid * 16 * 72, 72, Hn + d * 64 * 72, 72, lane);
                    const float ecs = __expf(cst);
#pragma unroll
                    for (int ni = 0; ni < 4; ++ni) Y[0][ni] += Yo[0][ni] * ecs;
                    __syncthreads();
                }
                const float Dh = p.in[15][h];
                const size_t grow = (size_t)(rbase + t0 + trow);
#pragma unroll
                for (int ni = 0; ni < 4; ++ni) {
                    const int p0 = 16 * ni + 4 * q;
                    const uint2 zr = *(const uint2*)(PROJ + grow * 2048 + h * 64 + p0);
                    const float z4[4] = {__uint_as_float(zr.x << 16), __uint_as_float(zr.x & 0xffff0000u), __uint_as_float(zr.y << 16), __uint_as_float(zr.y & 0xffff0000u)};
                    float u[4];
#pragma unroll
                    for (int j = 0; j < 4; ++j) { const float y = Y[0][ni][j] + Dh * bf2f(XT[(p0 + j) * 136 + (trow ^ ((((p0 + j) >> 3) & 7) << 3))]); u[j] = y * siluf(z4[j]); ssq += u[j] * u[j]; }
                    uint2 w; w.x = pack2(u[0], u[1]); w.y = pack2(u[2], u[3]);
                    *(uint2*)(MIX + grow * 1024 + h * 64 + p0) = w;
                }
                __syncthreads();
            }
        }
        ssq += __shfl_xor(ssq, 16); ssq += __shfl_xor(ssq, 32);
        const float rs = rsqrtf(ssq * (1.f / 512.f) + 1e-6f);
        const size_t grow = (size_t)(rbase + t0 + trow);
        for (int h = 0; h < 8; ++h)
#pragma unroll
            for (int ni = 0; ni < 4; ++ni) {
                const int col = h * 64 + 16 * ni + 4 * q;
                const uint2 ur = *(const uint2*)(MIX + grow * 1024 + col);
                const float4 nw = *(const float4*)(p.in[16] + col);
                uint2 w; w.x = pack2(__uint_as_float(ur.x << 16) * rs * nw.x, __uint_as_float(ur.x & 0xffff0000u) * rs * nw.y);
                w.y = pack2(__uint_as_float(ur.y << 16) * rs * nw.z, __uint_as_float(ur.y & 0xffff0000u) * rs * nw.w);
                *(uint2*)(MIX + grow * 1024 + col) = w;
            }
    }
}


__device__ __forceinline__ void attn_mfma(const P& p, int bid, int nb, float* lds) {
    const int tid = p.tid(), lane = tid & 63, wid = __builtin_amdgcn_readfirstlane(tid >> 6), r = lane & 15, q = lane >> 4;
    unsigned char* ws = p.get_ws();
    const bf16_t* PROJ = (const bf16_t*)(ws + WS_PROJ);
    const bf16_t* QKR = (const bf16_t*)(ws + WS_XRES);
    bf16_t* MIX = (bf16_t*)(ws + WS_HB);
    bf16_t* Kb = (bf16_t*)lds;
    bf16_t* Vb = Kb + 2 * 64 * 72;
    for (int item = bid; item < 260; item += nb) {
        const bool isctx = item >= 256;
        const int qb = isctx ? (item - 256) >> 1 : item >> 1, g = item & 1;
        const int qrow0 = (isctx ? SEQ : 0) + qb * 128;
        const int hq = g * 4 + (wid >> 1), wrow0 = (wid & 1) * 64;
        const int ntl = isctx ? 0 : 6, nt = ntl + 4;
        bf16_t* Qw = Vb + 2 * 64 * 72 + wid * 64 * 72;
#pragma unroll
        for (int mi = 0; mi < 4; ++mi)
#pragma unroll
            for (int kk = 0; kk < 2; ++kk) {
                const uint4 raw = *(const uint4*)(QKR + (size_t)(qrow0 + wrow0 + 16 * mi + r) * 640 + hq * 64 + kk * 32 + 8 * q);
                float f[8]; unpack8(raw, f);
                uint4 o; o.x = pack2(f[0] * 0.125f, f[1] * 0.125f); o.y = pack2(f[2] * 0.125f, f[3] * 0.125f); o.z = pack2(f[4] * 0.125f, f[5] * 0.125f); o.w = pack2(f[6] * 0.125f, f[7] * 0.125f);
                *(uint4*)(Qw + (16 * mi + r) * 72 + kk * 32 + 8 * q) = o;
            }
        const float sink = p.in[19][hq];
        float m[4], l[4]; f32x4 O[4][4];
#pragma unroll
        for (int mi = 0; mi < 4; ++mi) { m[mi] = sink; l[mi] = q == 0 ? 1.f : 0.f;
#pragma unroll
            for (int ni = 0; ni < 4; ++ni) O[mi][ni] = (f32x4){0.f, 0.f, 0.f, 0.f}; }
#define ATT_VALID(ti_) ((ti_) >= ntl || (qb * 128 - 128 + 64 * (ti_) >= 0 && qb * 128 - 128 + 64 * (ti_) < SEQ))
#define ATT_KROW(ti_) ((ti_) < ntl ? qb * 128 - 128 + 64 * (ti_) : SEQ + 64 * ((ti_) - ntl))
        int ti = 0; while (ti < nt && !ATT_VALID(ti)) ++ti;
        uint4 kreg, vreg;
        { const int kr0 = ATT_KROW(ti);
          kreg = *(const uint4*)(QKR + (size_t)(kr0 + (tid >> 3)) * 640 + 512 + g * 64 + (tid & 7) * 8);
          vreg = *(const uint4*)(PROJ + (size_t)(kr0 + (tid >> 3)) * 2048 + 1920 + g * 64 + (tid & 7) * 8); }
        int cur = 0;
        __syncthreads();
        { *(uint4*)(Kb + (tid >> 3) * 72 + (tid & 7) * 8) = kreg;
          bf16_t* vd = Vb + ((tid & 7) * 8) * 72 + ((tid >> 3) ^ ((tid & 7) << 3)); const u32 vw[4] = {vreg.x, vreg.y, vreg.z, vreg.w};
#pragma unroll
          for (int j = 0; j < 4; ++j) { vd[(2 * j) * 72] = (bf16_t)(vw[j] & 0xffff); vd[(2 * j + 1) * 72] = (bf16_t)(vw[j] >> 16); } }
        __syncthreads();
        while (ti < nt) {
            int tn = ti + 1; while (tn < nt && !ATT_VALID(tn)) ++tn;
            if (tn < nt) { const int kr0 = ATT_KROW(tn);
                kreg = *(const uint4*)(QKR + (size_t)(kr0 + (tid >> 3)) * 640 + 512 + g * 64 + (tid & 7) * 8);
                vreg = *(const uint4*)(PROJ + (size_t)(kr0 + (tid >> 3)) * 2048 + 1920 + g * 64 + (tid & 7) * 8); }
            const bool local = ti < ntl;
            const bool need = !local || ((wid & 1) == 0 ? ti <= 4 : ti >= 1);
            if (need) {
                const bf16_t* Kt = Kb + cur * 64 * 72; const bf16_t* Vt = Vb + cur * 64 * 72;
                const int kp0 = qb * 128 - 128 + 64 * ti + 4 * q, qp0 = qb * 128 + wrow0 + r;
#pragma unroll
                for (int mi = 0; mi < 4; ++mi) {
                    f32x4 S[4];
#pragma unroll
                    for (int ni = 0; ni < 4; ++ni) S[ni] = (f32x4){0.f, 0.f, 0.f, 0.f};
#pragma unroll
                    for (int kk = 0; kk < 2; ++kk) {
                        const bf16x8 qfr = *(const bf16x8*)(Qw + (16 * mi + r) * 72 + kk * 32 + 8 * q);
#pragma unroll
                        for (int ni = 0; ni < 4; ++ni) {
                            const bf16x8 bfr = *(const bf16x8*)(Kt + (16 * ni + r) * 72 + kk * 32 + 8 * q);
                            S[ni] = __builtin_amdgcn_mfma_f32_16x16x32_bf16(bfr, qfr, S[ni], 0, 0, 0);
                        }
                    }
                    if (local) {
#pragma unroll
                        for (int ni = 0; ni < 4; ++ni)
#pragma unroll
                            for (int j = 0; j < 4; ++j) { const int dlt = (qp0 + 16 * mi) - (kp0 + 16 * ni + j); if (dlt > 128 || dlt < -128) S[ni][j] = -1e30f; }
                    }
                    float mx = -1e30f;
#pragma unroll
                    for (int ni = 0; ni < 4; ++ni)
#pragma unroll
                        for (int j = 0; j < 4; ++j) mx = fmaxf(mx, S[ni][j]);
                    mx = fmaxf(mx, __shfl_xor(mx, 16)); mx = fmaxf(mx, __shfl_xor(mx, 32));
                    const float mn = fmaxf(m[mi], mx), al = __expf(m[mi] - mn);
                    m[mi] = mn;
                    float ps = 0.f;
#pragma unroll
                    for (int ni = 0; ni < 4; ++ni)
#pragma unroll
                        for (int j = 0; j < 4; ++j) { const float e = __expf(S[ni][j] - mn); S[ni][j] = e; ps += e; }
                    l[mi] = l[mi] * al + ps;
#pragma unroll
                    for (int ni = 0; ni < 4; ++ni) O[mi][ni] *= al;
                    __builtin_amdgcn_sched_barrier(0);
#pragma unroll
                    for (int kk = 0; kk < 2; ++kk) {
                        uint4 o; o.x = pack2(S[2 * kk][0], S[2 * kk][1]); o.y = pack2(S[2 * kk][2], S[2 * kk][3]);
                        o.z = pack2(S[2 * kk + 1][0], S[2 * kk + 1][1]); o.w = pack2(S[2 * kk + 1][2], S[2 * kk + 1][3]);
                        const bf16x8 pfr = *(bf16x8*)&o;
#pragma unroll
                        for (int ni = 0; ni < 4; ++ni) {
                            const int vsw = (((16 * ni + r) >> 3) & 7) << 3;
                            const uint2 v0 = *(const uint2*)(Vt + (16 * ni + r) * 72 + ((32 * kk + 4 * q) ^ vsw)), v1 = *(const uint2*)(Vt + (16 * ni + r) * 72 + ((32 * kk + 16 + 4 * q) ^ vsw));
                            uint4 vo; vo.x = v0.x; vo.y = v0.y; vo.z = v1.x; vo.w = v1.y;
                            O[mi][ni] = __builtin_amdgcn_mfma_f32_16x16x32_bf16(*(bf16x8*)&vo, pfr, O[mi][ni], 0, 0, 0);
                        }
                    }
                    __builtin_amdgcn_sched_barrier(0);
                }
            }
            if (tn < nt) {
                *(uint4*)(Kb + (cur ^ 1) * 64 * 72 + (tid >> 3) * 72 + (tid & 7) * 8) = kreg;
                bf16_t* vd = Vb + (cur ^ 1) * 64 * 72 + ((tid & 7) * 8) * 72 + ((tid >> 3) ^ ((tid & 7) << 3)); const u32 vw[4] = {vreg.x, vreg.y, vreg.z, vreg.w};
#pragma unroll
                for (int j = 0; j < 4; ++j) { vd[(2 * j) * 72] = (bf16_t)(vw[j] & 0xffff); vd[(2 * j + 1) * 72] = (bf16_t)(vw[j] >> 16); }
            }
            __syncthreads();
            ti = tn; cur ^= 1;
        }
#undef ATT_VALID
#undef ATT_KROW
#pragma unroll
        for (int mi = 0; mi < 4; ++mi) {
            float lt = l[mi]; lt += __shfl_xor(lt, 16); lt += __shfl_xor(lt, 32);
            const float inv = 1.f / lt;
            bf16_t* op = MIX + (size_t)(qrow0 + wrow0 + 16 * mi + r) * 1024 + 512 + hq * 64 + 4 * q;
#pragma unroll
            for (int ni = 0; ni < 4; ++ni) { uint2 w; w.x = pack2(O[mi][ni][0] * inv, O[mi][ni][1] * inv); w.y = pack2(O[mi][ni][2] * inv, O[mi][ni][3] * inv); *(uint2*)(op + 16 * ni) = w; }
        }
    }
}


constexpr size_t ML_ST_OFF = 0;
constexpr size_t ML_CIN_OFF = (size_t)130 * 16 * 8192 * 2;
constexpr int CH_DEC = 0, CH_BL = 4096, CH_AC = 8192, CH_MIN = 12288, CH_NC = 16384, CH_NIN = 16384 + 130 * 16 * 64;
__device__ __forceinline__ void stage_convw_part(const float* cw, const float* cb, int C, int c0, int n, float* cwl, int tid) {
    for (int i = tid; i < n; i += NTH) *(float4*)(cwl + i * 4) = make_float4(cw[c0 + i], cw[C + c0 + i], cw[2 * C + c0 + i], cb[c0 + i]);
}
__device__ __forceinline__ void ml_states(const P& p, int bid, int nb, float* lds) {
    const int tid = p.tid(), lane = tid & 63, wid = tid >> 6, r = lane & 15, q = lane >> 4;
    unsigned char* ws = p.get_ws();
    const bf16_t* PROJ = (const bf16_t*)(ws + WS_PROJ);
    const float* SMALL = (const float*)(ws + WS_SMALL);
    bf16_t* ST = (bf16_t*)(ws + WS_Y + ML_ST_OFF);
    float* CHK = (float*)(ws + WS_CHK);
    float* cwl = lds;
    bf16_t* VT = (bf16_t*)(lds + 384 * 4);
    bf16_t* KT = VT + 2 * 128 * 136;
    float* es = (float*)(KT + 2 * 64 * 136);
    for (int item = bid; item < 520; item += nb) {
        const int c = item >> 2, hp = item & 3;
        const int L = c < 128 ? SEQ : CTX, t0 = c < 128 ? c * 128 : (c - 128) * 128, rbase = c < 128 ? 0 : SEQ;
        if (tid < 384) { const int ch = tid < 128 ? 512 + hp * 128 + tid : 1024 + hp * 256 + (tid - 128);
            const float* cw = p.in[22]; *(float4*)(cwl + tid * 4) = make_float4(cw[ch], cw[2048 + ch], cw[4096 + ch], p.in[23][ch]); }
        __syncthreads();
#pragma unroll 1
        for (int b4 = 0; b4 < 3; ++b4) {
            Raw3 rw[4];
#pragma unroll
            for (int k = 0; k < 4; ++k) { const int i = tid + (b4 * 4 + k) * NTH; const int cg8 = (i >> 3) % 48, tl = (i / 384) * 8 + (i & 7);
                const int col = cg8 < 16 ? 512 + hp * 128 + cg8 * 8 : 1024 + hp * 256 + (cg8 - 16) * 8;
                rw[k] = conv8_load(PROJ + (size_t)(rbase + t0 + tl) * 3072 + col, 3072, t0 + tl, L); }
#pragma unroll
            for (int k = 0; k < 4; ++k) { const int i = tid + (b4 * 4 + k) * NTH; const int cg8 = (i >> 3) % 48, tl = (i / 384) * 8 + (i & 7);
                float o[8]; conv8_apply(rw[k], cwl + cg8 * 32, o);
                const float sc = cg8 < 16 ? 0.125f : 1.f;
                const int tls = tl ^ ((cg8 & 7) << 3);
                bf16_t* dst = cg8 < 16 ? KT + (cg8 * 8) * 136 + tls : VT + ((cg8 - 16) * 8) * 136 + tls;
#pragma unroll
                for (int j = 0; j < 8; ++j) dst[j * 136] = f2bf(o[j] * sc); }
        }
        const int hl = wid >> 2, d = (wid >> 1) & 1, vh = wid & 1, h = hp * 2 + hl, dh = d * 8 + h;
        float tot, ac;
        {
            const float igb = p.in[24][dh], fgb = p.in[25][dh];
            const float* sm0 = SMALL + (size_t)(rbase + t0 + 2 * lane) * 32;
            const float ig0 = sm0[dh] + igb, ig1 = sm0[32 + dh] + igb, lf0 = logsigf(sm0[16 + dh] + fgb), lf1 = logsigf(sm0[32 + 16 + dh] + fgb);
            float c0 = lf0, c1 = lf1; tot = wave_scan128(c0, c1, lane);
            const float w0 = (d == 0 ? tot - c0 : c0 - lf0) + ig0, w1 = (d == 0 ? tot - c1 : c1 - lf1) + ig1;
            ac = fmaxf(w0, w1);
#pragma unroll
            for (int o = 32; o >= 1; o >>= 1) ac = fmaxf(ac, __shfl_xor(ac, o));
            es[wid * 128 + 2 * lane] = __expf(w0 - ac); es[wid * 128 + 2 * lane + 1] = __expf(w1 - ac);
        }
        __syncthreads();
        {
            f32x4 acc[4][4];
#pragma unroll
            for (int mi = 0; mi < 4; ++mi)
#pragma unroll
                for (int ni = 0; ni < 4; ++ni) acc[mi][ni] = (f32x4){0.f, 0.f, 0.f, 0.f};
            const bf16_t* Ab = VT + (hl * 128 + vh * 64) * 136; const bf16_t* Bb = KT + (hl * 64) * 136;
#pragma unroll
            for (int kk = 0; kk < 128; kk += 32) {
                const float4 wa = *(const float4*)(es + wid * 128 + kk + 8 * q), wb = *(const float4*)(es + wid * 128 + kk + 8 * q + 4);
                bf16x8 a[4], b[4];
#pragma unroll
                for (int mi = 0; mi < 4; ++mi) a[mi] = *(const bf16x8*)(Ab + (16 * mi + r) * 136 + ((kk + 8 * q) ^ ((((16 * mi + r) >> 3) & 7) << 3)));
#pragma unroll
                for (int ni = 0; ni < 4; ++ni) {
                    const uint4 raw = *(const uint4*)(Bb + (16 * ni + r) * 136 + ((kk + 8 * q) ^ ((((16 * ni + r) >> 3) & 7) << 3)));
                    float f[8]; unpack8(raw, f);
                    uint4 o; o.x = pack2(f[0] * wa.x, f[1] * wa.y); o.y = pack2(f[2] * wa.z, f[3] * wa.w); o.z = pack2(f[4] * wb.x, f[5] * wb.y); o.w = pack2(f[6] * wb.z, f[7] * wb.w);
                    b[ni] = *(bf16x8*)&o;
                }
#pragma unroll
                for (int mi = 0; mi < 4; ++mi)
#pragma unroll
                    for (int ni = 0; ni < 4; ++ni) acc[mi][ni] = __builtin_amdgcn_mfma_f32_16x16x32_bf16(b[ni], a[mi], acc[mi][ni], 0, 0, 0);
                __builtin_amdgcn_sched_barrier(0);
            }
            bf16_t* Sp = ST + ((size_t)c * 16 + dh) * 8192 + (vh * 64) * 64;
#pragma unroll
            for (int mi = 0; mi < 4; ++mi)
#pragma unroll
                for (int ni = 0; ni < 4; ++ni) { uint2 w; w.x = pack2(acc[mi][ni][0], acc[mi][ni][1]); w.y = pack2(acc[mi][ni][2], acc[mi][ni][3]); *(uint2*)(Sp + (16 * mi + r) * 64 + 16 * ni + 4 * q) = w; }
            if (vh == 0) {
                float nsum = 0.f; const bf16_t* kr = Bb + lane * 136;
#pragma unroll 4
                for (int s8 = 0; s8 < 128; s8 += 8) { float f[8]; unpack8(*(const uint4*)(kr + (s8 ^ (((lane >> 3) & 7) << 3))), f);
#pragma unroll
                    for (int j = 0; j < 8; ++j) nsum += f[j] * es[wid * 128 + s8 + j]; }
                CHK[CH_NC + (c * 16 + dh) * 64 + lane] = nsum;
                if (lane == 0) { CHK[CH_BL + c * 16 + dh] = tot; CHK[CH_AC + c * 16 + dh] = ac; }
            }
        }
        __syncthreads();
    }
}
__device__ __forceinline__ void ml_scan(const P& p, int bid, int nb) {
    const int tid = p.tid();
    unsigned char* ws = p.get_ws();
    const bf16_t* ST = (const bf16_t*)(ws + WS_Y + ML_ST_OFF);
    bf16_t* CIN = (bf16_t*)(ws + WS_Y + ML_CIN_OFF);
    float* CHK = (float*)(ws + WS_CHK);
    for (int gid = bid * NTH + tid; gid < 131072; gid += nb * NTH) {
        const int dh = gid >> 13, d = dh >> 3, e = gid & 8191;
        float C = 0.f, n = 0.f, m = 0.f;
#pragma unroll 1
        for (int i0 = 0; i0 < 130; i0 += 10) {
            float sv[10], bl[10], av[10], nv[10]; int cc[10];
#pragma unroll
            for (int j = 0; j < 10; ++j) {
                const int i = i0 + j;
                const int c = d == 0 ? (i < 2 ? 128 + i : i - 2) : 129 - i;
                cc[j] = c; sv[j] = bf2f(ST[((size_t)c * 16 + dh) * 8192 + e]); bl[j] = CHK[CH_BL + c * 16 + dh]; av[j] = CHK[CH_AC + c * 16 + dh];
                nv[j] = e < 64 ? CHK[CH_NC + (c * 16 + dh) * 64 + e] : 0.f;
            }
#pragma unroll
            for (int j = 0; j < 10; ++j) {
                CIN[((size_t)cc[j] * 16 + dh) * 8192 + e] = f2bf(C);
                if (e < 64) CHK[CH_NIN + (cc[j] * 16 + dh) * 64 + e] = n;
                if (e == 0) CHK[CH_MIN + cc[j] * 16 + dh] = m;
                const float mn = fmaxf(bl[j] + m, av[j]);
                const float sp = __expf(bl[j] + m - mn), sc = __expf(av[j] - mn);
                C = sp * C + sc * sv[j]; n = sp * n + sc * nv[j]; m = mn;
            }
        }
    }
}
__device__ __forceinline__ void ml_out(const P& p, int bid, int nb, float* lds) {
    unsigned char* tsbase = (unsigned char*)lds + LDS_BYTES - 128; (void)tsbase;
    const int tid = p.tid(), lane = tid & 63, wid = tid >> 6, r = lane & 15, q = lane >> 4;
    unsigned char* ws = p.get_ws();
    const bf16_t* PROJ = (const bf16_t*)(ws + WS_PROJ);
    const float* SMALL = (const float*)(ws + WS_SMALL);
    const bf16_t* CIN = (const bf16_t*)(ws + WS_Y + ML_CIN_OFF);
    const float* CHK = (const float*)(ws + WS_CHK);
    bf16_t* MIX = (bf16_t*)(ws + WS_HB);
    float* cwl = lds;
    bf16_t* Qs = (bf16_t*)(lds + 256 * 4);
    bf16_t* Ks = Qs + 128 * 72;
    bf16_t* VT = Ks + 128 * 72;
    bf16_t* Wb = VT + 128 * 136;
    bf16_t* Ct = Wb + 128 * 136;
    float* bet = (float*)(Ct + 2 * 128 * 72);
    float* igs = bet + 8 * 128;
    float* nin = igs + 8 * 128;
    float* mins = nin + 8 * 64;
    for (int item = bid; item < 256; item += nb) {
        const int c = item >> 1, hg = item & 1;
        const int t0 = c * 128;
        const int trow = wid * 16 + r;
        const size_t grow = (size_t)(t0 + trow);
        __syncthreads();
        {
            const int d = wid & 1, dh = d * 8 + hg * 4 + (wid >> 1), cb8 = wid;
            const float igb = p.in[24][dh], fgb = p.in[25][dh];
            const float* sm0 = SMALL + (size_t)(t0 + 2 * lane) * 32;
            const float ig0 = sm0[dh] + igb, ig1 = sm0[32 + dh] + igb, lf0 = logsigf(sm0[16 + dh] + fgb), lf1 = logsigf(sm0[32 + 16 + dh] + fgb);
            float c0 = lf0, c1 = lf1; const float tot = wave_scan128(c0, c1, lane);
            bet[cb8 * 128 + 2 * lane] = d == 0 ? c0 : tot - c0 + lf0; bet[cb8 * 128 + 2 * lane + 1] = d == 0 ? c1 : tot - c1 + lf1;
            igs[cb8 * 128 + 2 * lane] = ig0; igs[cb8 * 128 + 2 * lane + 1] = ig1;
            nin[cb8 * 64 + lane] = CHK[CH_NIN + (c * 16 + dh) * 64 + lane];
            if (lane == 0) mins[cb8] = CHK[CH_MIN + c * 16 + dh];
        }
        for (int hh = 0; hh < 4; ++hh) {
            const int h = hg * 4 + hh;
            const int tid = p.tid(), lane = tid & 63, wid = tid >> 6, r = lane & 15, q = lane >> 4;
            const int trow = wid * 16 + r;
            const size_t grow = (size_t)(t0 + trow);
            if (hh == 0) TS(0);
            if (hh == 1) TS(5);
            if (tid < 256) { const int ch = tid < 64 ? h * 64 + tid : (tid < 128 ? 512 + h * 64 + (tid - 64) : 1024 + h * 128 + (tid - 128));
                const float* cw = p.in[22]; *(float4*)(cwl + tid * 4) = make_float4(cw[ch], cw[2048 + ch], cw[4096 + ch], p.in[23][ch]); }
            if (hh < 3) {
                float* dummy = (float*)((unsigned char*)lds + LDS_BYTES - 4096);
#pragma unroll
                for (int j = 0; j < 2; ++j) {
                    const int idx = tid + j * NTH, hn = h + 1;
                    const bf16_t* g;
                    if (idx < 520) { const int rr = idx < 130 ? idx : (idx < 260 ? idx - 130 : (idx - 260) >> 1);
                        int t = t0 - 1 + rr; t = t < 0 ? 0 : (t > SEQ - 1 ? SEQ - 1 : t);
                        const int col = idx < 130 ? hn * 64 : (idx < 260 ? 512 + hn * 64 : 1024 + hn * 128 + ((idx - 260) & 1) * 64);
                        g = PROJ + (size_t)t * 3072 + col; }
                    else { const int li = idx - 520; g = CIN + ((size_t)c * 16 + (li >> 7) * 8 + hn) * 8192 + (li & 127) * 64; }
                    if (idx < 776) prefetch_line(g, dummy, wid);
                }
            }
            const bf16_t* cp0 = CIN + ((size_t)c * 16 + h) * 8192 + tid * 16; const bf16_t* cp1 = cp0 + (size_t)8 * 8192;
            const uint4 c00 = *(const uint4*)cp0, c01 = *(const uint4*)(cp0 + 8), c10 = *(const uint4*)cp1, c11 = *(const uint4*)(cp1 + 8);
            Raw3 rq[4], rv[4];
#pragma unroll
            for (int k = 0; k < 4; ++k) { const int i = tid + k * NTH; const int cg8 = i & 15, tl = i >> 4;
                rq[k] = conv8_load(PROJ + (size_t)(t0 + tl) * 3072 + (cg8 < 8 ? h * 64 + cg8 * 8 : 512 + h * 64 + (cg8 - 8) * 8), 3072, t0 + tl, SEQ); }
#pragma unroll
            for (int k = 0; k < 4; ++k) { const int i = tid + k * NTH; const int vg = (i >> 3) & 15, tl = (i >> 7) * 8 + (i & 7);
                rv[k] = conv8_load(PROJ + (size_t)(t0 + tl) * 3072 + 1024 + h * 128 + vg * 8, 3072, t0 + tl, SEQ); }
            if (hh == 0) TS(6);
            __syncthreads();
            if (hh == 0) TS(7);
#pragma unroll
            for (int k = 0; k < 4; ++k) {
                const int i = tid + k * NTH; const int cg8 = i & 15, tl = i >> 4;
                float o[8]; conv8_apply(rq[k], cwl + cg8 * 32, o);
                const float sc = cg8 < 8 ? 1.f : 0.125f;
                uint4 w; w.x = pack2(o[0] * sc, o[1] * sc); w.y = pack2(o[2] * sc, o[3] * sc); w.z = pack2(o[4] * sc, o[5] * sc); w.w = pack2(o[6] * sc, o[7] * sc);
                *(uint4*)((cg8 < 8 ? Qs + cg8 * 8 : Ks + (cg8 - 8) * 8) + tl * 72) = w;
            }
            if (hh == 0) TS(8);
#pragma unroll 1
            for (int rep_ = 0; rep_ < EXP_ML_V; ++rep_) {
#pragma unroll
            for (int k = 0; k < 4; ++k) {
                const int i = tid + k * NTH; const int vg = (i >> 3) & 15, tl = (i >> 7) * 8 + (i & 7);
                float o[8]; conv8_apply(rv[k], cwl + (128 + vg * 8) * 4, o);
#pragma unroll
                for (int j = 0; j < 8; ++j) VT[(vg * 8 + j) * 136 + (tl ^ ((vg & 7) << 3))] = f2bf(o[j]);
            }
            asm volatile("" ::: "memory");
            }
            if (hh == 0) TS(9);
            { bf16_t* cd = Ct + (tid >> 2) * 72 + (tid & 3) * 16; *(uint4*)cd = c00; *(uint4*)(cd + 8) = c01; *(uint4*)(cd + 128 * 72) = c10; *(uint4*)(cd + 128 * 72 + 8) = c11; }
            __syncthreads();
            if (hh == 0) TS(1);
            f32x4 QK[1][8];
#pragma unroll
            for (int ni = 0; ni < 8; ++ni) QK[0][ni] = (f32x4){0.f, 0.f, 0.f, 0.f};
            wave_mma<1, 8, 64, true>(QK, Qs + wid * 16 * 72, 72, Ks, 72, lane);
            if (hh == 0) TS(2);
            f32x4 Hs[8];
#pragma unroll
            for (int ni = 0; ni < 8; ++ni) Hs[ni] = (f32x4){0.f, 0.f, 0.f, 0.f};
            for (int dq = 0; dq < 2 + EXP_ML_D; ++dq) {
                const int d = dq & 1; const bool discard = dq >= 2;
                const int dh = d * 8 + h;
                const float bt = bet[(hh * 2 + d) * 128 + trow], g = bt + mins[hh * 2 + d];
                float dl[32]; float mx = -1e30f;
#pragma unroll
                for (int ni = 0; ni < 8; ++ni) {
                    const int s0 = 16 * ni + 4 * q;
                    const float4 bs = *(const float4*)(bet + (hh * 2 + d) * 128 + s0), iv = *(const float4*)(igs + (hh * 2 + d) * 128 + s0);
                    const float b4[4] = {bs.x, bs.y, bs.z, bs.w}, i4[4] = {iv.x, iv.y, iv.z, iv.w};
#pragma unroll
                    for (int j = 0; j < 4; ++j) { const int sidx = s0 + j; const bool ok = d == 0 ? sidx <= trow : sidx >= trow; const float v = ok ? bt - b4[j] + i4[j] : -1e30f; dl[ni * 4 + j] = v; mx = fmaxf(mx, v); }
                }
                mx = fmaxf(mx, __shfl_xor(mx, 16)); mx = fmaxf(mx, __shfl_xor(mx, 32));
                const float ms = fmaxf(g, mx);
                float rsum = 0.f;
#pragma unroll
                for (int ni = 0; ni < 8; ++ni) {
                    float w4[4];
#pragma unroll
                    for (int j = 0; j < 4; ++j) { w4[j] = dl[ni * 4 + j] > -1e29f ? __expf(dl[ni * 4 + j] - ms) * QK[0][ni][j] : 0.f; rsum += w4[j]; }
                    uint2 w; w.x = pack2(w4[0], w4[1]); w.y = pack2(w4[2], w4[3]);
                    *(uint2*)(Wb + trow * 136 + 16 * ni + 4 * q) = w;
                }
                rsum += __shfl_xor(rsum, 16); rsum += __shfl_xor(rsum, 32);
                __syncthreads();
                f32x4 Nm[1][8], Ni[1][8];
#pragma unroll
                for (int ni = 0; ni < 8; ++ni) { Nm[0][ni] = (f32x4){0.f, 0.f, 0.f, 0.f}; Ni[0][ni] = (f32x4){0.f, 0.f, 0.f, 0.f}; }
                wave_mma<1, 8, 128, true, true>(Nm, Wb + wid * 16 * 136, 136, VT, 136, lane);
                wave_mma<1, 8, 64, true>(Ni, Qs + wid * 16 * 72, 72, Ct + d * 128 * 72, 72, lane);
                float qn = 0.f;
                { float f[8]; unpack8(*(const uint4*)(Qs + trow * 72 + 16 * q), f);
#pragma unroll
                  for (int j = 0; j < 8; ++j) qn += f[j] * nin[(hh * 2 + d) * 64 + 16 * q + j];
                  unpack8(*(const uint4*)(Qs + trow * 72 + 16 * q + 8), f);
#pragma unroll
                  for (int j = 0; j < 8; ++j) qn += f[j] * nin[(hh * 2 + d) * 64 + 16 * q + 8 + j]; }
                qn += __shfl_xor(qn, 16); qn += __shfl_xor(qn, 32);
                const float ei = __expf(g - ms);
                const float den = rsum + qn * ei;
                const float inv = 1.f / fmaxf(fabsf(den), __expf(-ms));
#pragma unroll
                for (int ni = 0; ni < 8; ++ni) Hs[ni] += (Nm[0][ni] + Ni[0][ni] * ei) * (discard ? 0.f : inv);
                __syncthreads();
            }
            if (hh == 0) TS(3);
            float ssq = 0.f;
#pragma unroll
            for (int ni = 0; ni < 8; ++ni)
#pragma unroll
                for (int j = 0; j < 4; ++j) ssq += Hs[ni][j] * Hs[ni][j];
            ssq += __shfl_xor(ssq, 16); ssq += __shfl_xor(ssq, 32);
            const float rs = rsqrtf(ssq * (1.f / 128.f) + 1e-6f);
#pragma unroll
            for (int ni = 0; ni < 8; ++ni) {
                const int col = h * 128 + 16 * ni + 4 * q;
                const uint2 orw = *(const uint2*)(PROJ + grow * 3072 + 2048 + col);
                const float4 nw = *(const float4*)(p.in[26] + col);
                uint2 w; w.x = pack2(Hs[ni][0] * rs * nw.x * sigmf(__uint_as_float(orw.x << 16)), Hs[ni][1] * rs * nw.y * sigmf(__uint_as_float(orw.x & 0xffff0000u)));
                w.y = pack2(Hs[ni][2] * rs * nw.z * sigmf(__uint_as_float(orw.y << 16)), Hs[ni][3] * rs * nw.w * sigmf(__uint_as_float(orw.y & 0xffff0000u)));
                *(uint2*)(MIX + grow * 1024 + col) = w;
            }
            __syncthreads();
        }
    }
}


#define XB_TMO      128
#define XB_XCNT(j)  (256  + 64 * (j))
#define XB_XSUB(j)  (1280 + 64 * (j))
#define XB_XGEN(j)  (2304 + 64 * (j))
#define XB_TOP      3328
#define XB_TOPGEN   3392
#define XCD_BAR_WORDS 3456
#define XB_SPIN_CAP (1u << 22)
#define XLAS __attribute__((address_space(3)))
__device__ __forceinline__ unsigned xb_ld(unsigned* p) { return __hip_atomic_load(p, __ATOMIC_RELAXED, __HIP_MEMORY_SCOPE_AGENT); }
__device__ __forceinline__ unsigned xb_add(unsigned* p, unsigned v) { return __hip_atomic_fetch_add(p, v, __ATOMIC_RELAXED, __HIP_MEMORY_SCOPE_AGENT); }
__device__ __forceinline__ unsigned xb_xcc_id() { return (unsigned)__builtin_amdgcn_s_getreg((3 << 11) | 20) & 0xFu; }
#define XB_SPIN(cond, bar) do { unsigned _sp = 0; while (cond) { __builtin_amdgcn_s_sleep(1); \
    if ((++_sp & 255u) == 0u) { if (xb_ld(&(bar)[XB_TMO])) break; if (_sp > XB_SPIN_CAP) { atomicAdd(&(bar)[XB_TMO], 1u); break; } } } } while (0)
struct XcdBarrier { unsigned* bar; unsigned x; volatile XLAS unsigned* st; };
__device__ __forceinline__ XcdBarrier xcd_barrier_post(unsigned* bar, volatile XLAS unsigned* st, int tid) {
    XcdBarrier b; b.bar = bar; b.x = xb_xcc_id(); b.st = st;
    if (tid == 0) (void)xb_add(&bar[XB_XCNT(b.x)], 1u);
    return b;
}
__device__ __forceinline__ void xcd_barrier_complete(unsigned* bar, unsigned x, unsigned& nloc, unsigned& nx) {
    const unsigned G = gridDim.x * gridDim.y * gridDim.z;
    unsigned sum, cnt, mine, sp = 0u;
    for (;;) {
        sum = 0u; cnt = 0u;
#pragma unroll 1
        for (unsigned j = 0; j < 16; ++j) { const unsigned c = xb_ld(&bar[XB_XCNT(j)]); sum += c; cnt += (c > 0u) ? 1u : 0u; }
        mine = xb_ld(&bar[XB_XCNT(x)]);
        if (sum == G) break;
        __builtin_amdgcn_s_sleep(1);
        if ((++sp & 255u) == 0u) { if (xb_ld(&bar[XB_TMO])) break; if (sp > XB_SPIN_CAP) { atomicAdd(&bar[XB_TMO], 1u); break; } }
    }
    nloc = mine > 0u ? mine : 1u; nx = cnt > 0u ? cnt : 1u;
}
__device__ __forceinline__ void xcd_barrier(const XcdBarrier& b, int tid) {
    asm volatile("s_waitcnt vmcnt(0)" ::: "memory");
    __syncthreads();
    if (tid == 0) {
        unsigned* bar = b.bar; asm volatile("" : "+s"(bar));
        __builtin_amdgcn_s_waitcnt(0);
        unsigned nloc = b.st[0], nx = b.st[1];
        if (nloc == 0u) { xcd_barrier_complete(bar, b.x, nloc, nx); b.st[0] = nloc; b.st[1] = nx; }
        const unsigned old = xb_add(&bar[XB_XSUB(b.x)], 1u);
        const unsigned gen = old / nloc;
        if (old + 1u == (gen + 1u) * nloc) {
            __builtin_amdgcn_fence(__ATOMIC_RELEASE, "agent");
            asm volatile("s_waitcnt vmcnt(0)" ::: "memory");
            const unsigned og = xb_add(&bar[XB_TOP], 1u);
            const unsigned tg = og / nx;
            if (og + 1u == (tg + 1u) * nx) xb_add(&bar[XB_TOPGEN], 1u);
            else XB_SPIN(xb_ld(&bar[XB_TOPGEN]) == tg, bar);
            __builtin_amdgcn_fence(__ATOMIC_ACQUIRE, "agent");
            xb_add(&bar[XB_XGEN(b.x)], 1u);
            asm volatile("s_waitcnt vmcnt(0)" ::: "memory");
        } else {
            XB_SPIN(xb_ld(&bar[XB_XGEN(b.x)]) == gen, bar);
            __builtin_amdgcn_fence(__ATOMIC_ACQUIRE, "agent");
            asm volatile("s_waitcnt vmcnt(0)" ::: "memory");
        }
    }
    __syncthreads();
}

#define GSYNC() grid.sync()
__global__ void __launch_bounds__(NTH, 2) fwd_kernel(PK pk) {
    P p; p.wv = __builtin_amdgcn_readfirstlane((int)(threadIdx.x >> 6));
    extern __shared__ __attribute__((aligned(16))) unsigned char smem[];
    float* lds = (float*)smem;
    G8_LAS unsigned char* ldsa = (G8_LAS unsigned char*)smem;
    volatile XLAS unsigned* xst = (volatile XLAS unsigned*)((XLAS unsigned char*)smem + LDS_BYTES - 16);
    { const int t0 = p.tid(); if (t0 < 4) xst[t0] = 0u; }
    __syncthreads();
    const XcdBarrier xbar = xcd_barrier_post((unsigned*)(p.get_ws() + WS_CTL) + CW_BAR, xst, p.tid());
    int nph = NPH_RUN; asm volatile("" : "+s"(nph));
    unsigned repmask = REPEAT_MASK; asm volatile("" : "+s"(repmask));
#pragma unroll 1
    for (int pq = 0; pq < 2 * nph; ++pq) {
        const int ph = pq >> 1;
        if ((pq & 1) && !((repmask >> ph) & 1u)) continue;
        unsigned char* ws = p.get_ws();
        const float* MODS = (const float*)(ws + WS_MODS);
        int nb = (int)gridDim.x, bid = (int)blockIdx.x; asm volatile("" : "+s"(nb), "+s"(bid));
        switch (ph) {
        case 0: {
            phase_mods(p, bid, nb, lds);
            conv_dense(p, bid, nb, lds);
        } break;
        case 1: {
            { RowArgs a{}; a.layer = 0; a.ffn = 0; a.src = 0; a.nrows = MT; a.noproj = 1; phase_rows<16>(p, bid, nb, lds, a); }
        } break;
        case 2: {
            { g8::Order S; S.init(SEQ / 256, 2048 / 256, nb, bid); EpiProj ef{(bf16_t*)(ws + WS_PROJ), 2048, 2048, 16, (float*)(ws + WS_SMALL)};
              g8::gemm8(p.tid(), ldsa, (const bf16_t*)(ws + WS_HB), 1024, RowPlain{}, S, BSelOne{(const char*)(ws + WS_WIN0)}, ef);
              mini_gemm(p, bid, nb, lds, (const bf16_t*)(ws + WS_HB), (const bf16_t*)(ws + WS_WIN0), SEQ, CTX / 64, 0, 2048 / 32, ef);
              mini_gemm(p, (bid + 4) % nb, nb, lds, (const bf16_t*)(ws + WS_HB), (const bf16_t*)(ws + WS_WIN0), 0, MT / 64, 2048, 1, ef); }
        } break;
        case 3: {
            { unsigned* qctr = (unsigned*)(ws + WS_CTL) + CW_Q3; volatile XLAS unsigned* qslot = xst - 4;
              for (;;) {
                  __syncthreads();
                  if (p.tid() == 0) qslot[0] = atomicAdd(qctr, 1u);
                  __syncthreads();
                  const int it = (int)qslot[0];
                  if (it >= 520) break;
                  if (it < 260) ssd_states(p, it, 1 << 20, lds); else phase_qkprep(p, it - 260, 1 << 20);
              } }
        } break;
        case 4: {
            ssd_scan(p, bid, nb);
            { unsigned* qctr = (unsigned*)(ws + WS_CTL) + CW_Q4; volatile XLAS unsigned* qslot = xst - 4;
              for (;;) {
                  __syncthreads();
                  if (p.tid() == 0) qslot[0] = atomicAdd(qctr, 1u);
                  __syncthreads();
                  const int it = (int)qslot[0];
                  if (it >= 260) break;
                  attn_mfma(p, it, 1 << 20, lds);
              } }
        } break;
        case 5: {
            { unsigned* qctr = (unsigned*)(ws + WS_CTL) + CW_Q5; volatile XLAS unsigned* qslot = xst - 4;
              for (;;) {
                  __syncthreads();
                  if (p.tid() == 0) qslot[0] = atomicAdd(qctr, 1u);
                  __syncthreads();
                  const int it = (int)qslot[0];
                  if (it >= 130 + 768) break;
                  if (it < 130) ssd_out(p, it, 1 << 20, lds); else conv_moe_chunk(p, it - 130, lds, 0);
              } }
        } break;
        case 6: {
            { g8::Order S; S.init(SEQ / 256, 4, nb, bid);
              EpiResid ef{p.in[0], p.in[2], (bf16_t*)(ws + WS_XRES), MODS + (0 * 2 + 0) * 6144 + 2048, MODS + (0 * 2 + 1) * 6144 + 2048};
              g8::gemm8(p.tid(), ldsa, (const bf16_t*)(ws + WS_HB), 1024, RowPlain{}, S, BSelOne{(const char*)(ws + WS_WOUT0)}, ef);
              mini_gemm(p, bid, nb, lds, (const bf16_t*)(ws + WS_HB), (const bf16_t*)(ws + WS_WOUT0), SEQ, CTX / 64, 0, 1024 / 32, ef); }
        } break;
        case 7: {
            phase_route(p, bid, nb, lds, 0, MT);
        } break;
        case 8: {
            phase_moe1(p, bid, nb, ldsa, lds, 0);
        } break;
        case 9: {
            phase_moe2(p, bid, nb, ldsa, lds, 0);
        } break;
        case 10: {
            { RowArgs a{}; a.layer = 1; a.ffn = 0; a.src = 1; a.combine = 1; a.clayer = 0; a.nrows = MT; a.noproj = 1; phase_rows<16>(p, bid, nb, lds, a); }
        } break;
        case 11: {
            { g8::Order S; S.init(SEQ / 256, 3072 / 256, nb, bid); EpiProj ef{(bf16_t*)(ws + WS_PROJ), 3072, 3072, 32, (float*)(ws + WS_SMALL)};
              g8::gemm8(p.tid(), ldsa, (const bf16_t*)(ws + WS_HB), 1024, RowPlain{}, S, BSelOne{(const char*)(ws + WS_WIN1)}, ef);
              mini_gemm(p, bid, nb, lds, (const bf16_t*)(ws + WS_HB), (const bf16_t*)(ws + WS_WIN1), SEQ, CTX / 64, 0, 3072 / 32, ef);
              mini_gemm(p, (bid + 128) % nb, nb, lds, (const bf16_t*)(ws + WS_HB), (const bf16_t*)(ws + WS_WIN1), 0, MT / 64, 3072, 1, ef); }
        } break;
        case 12: {
            { unsigned* qctr = (unsigned*)(ws + WS_CTL) + CW_Q12; volatile XLAS unsigned* qslot = xst - 4;
              for (;;) {
                  __syncthreads();
                  if (p.tid() == 0) qslot[0] = atomicAdd(qctr, 1u);
                  __syncthreads();
                  const int it = (int)qslot[0];
                  if (it >= 520 + 768) break;
                  if (it < 520) ml_states(p, it, 1 << 20, lds); else conv_moe_chunk(p, it - 520, lds, 1);
              } }
        } break;
        case 13: {
            ml_scan(p, bid, nb);
            xcd_barrier(xbar, p.tid());
            ml_out(p, bid, nb, lds);
        } break;
        case 14: {
            { g8::Order S; S.init(SEQ / 256, 4, nb, bid);
              EpiResid ef{nullptr, nullptr, (bf16_t*)(ws + WS_XRES), MODS + (1 * 2 + 0) * 6144 + 2048, MODS + (1 * 2 + 0) * 6144 + 2048};
              g8::gemm8(p.tid(), ldsa, (const bf16_t*)(ws + WS_HB), 1024, RowPlain{}, S, BSelOne{(const char*)(ws + WS_WOUT1)}, ef); }
        } break;
        case 15: {
            phase_route(p, bid, nb, lds, 1, SEQ);
        } break;
        case 16: {
            phase_moe1(p, bid, nb, ldsa, lds, 1);
        } break;
        case 17: {
            phase_moe2(p, bid, nb, ldsa, lds, 1);
        } break;
        case 18: {
            { RowArgs a{}; a.layer = 1; a.src = 1; a.combine = 1; a.clayer = 1; a.final_out = 1; a.nrows = SEQ; phase_rows<16>(p, bid, nb, lds, a); }
        } break;
        default: break;
        }
        if (pq + 1 < 2 * nph) xcd_barrier(xbar, p.tid());
#if TIMED_PH >= 0 || DELAY_PH >= 0
        if (!(pq & 1) && p.tid() == 0) {
            const unsigned now = (unsigned)__builtin_amdgcn_s_memrealtime();
            if (ph == TIMED_PH) xst[3] = now - xst[2];
            if (ph == DELAY_PH) xst[-8] = now - xst[2];
            xst[2] = now;
        }
#endif
    }
#if TSA >= 0
    if (blockIdx.x == 0 && p.tid() == 0) { volatile XLAS unsigned* tsp = (volatile XLAS unsigned*)((XLAS unsigned char*)smem + LDS_BYTES - 128);
        const unsigned long long t0 = __builtin_amdgcn_s_memrealtime(); const unsigned long long dt = 50ull * (tsp[TSB] - tsp[TSA]);
        while (__builtin_amdgcn_s_memrealtime() - t0 < dt) __builtin_amdgcn_s_sleep(8);
    }
#endif
#if DELAY_PH >= 0
    if (blockIdx.x == 0 && p.tid() == 0) {
        const unsigned long long t0 = __builtin_amdgcn_s_memrealtime(); const unsigned long long dt = 20ull * xst[-8];
        while (__builtin_amdgcn_s_memrealtime() - t0 < dt) __builtin_amdgcn_s_sleep(8);
    }
#endif
#if TIMED_PH >= 0
    xcd_barrier(xbar, p.tid());
    if (blockIdx.x == 0) {
        const float t_phase = (float)xst[3] * 0.01f;
        const float delta = sqrtf(t_phase * 1e-5f * 256.f * TIMED_M2);
        float* o = p.get_out();
        for (int i = p.tid(); i < 65536; i += NTH) o[i] += (i & 1) ? delta : -delta;
    }
#endif
}

extern "C" void kernel_launch(void* const* d_in, const int* in_sizes, int n_in, void* d_out, int out_size, void* d_ws, size_t ws_size, hipStream_t stream) {
    static int grid = 0;
    if (grid == 0) {
        if (n_in != 31 || ws_size < WS_END) { fprintf(stderr, "kernel_launch: unexpected n_in %d or ws_size %zu < %zu\n", n_in, ws_size, (size_t)WS_END); grid = -1; return; }
        int dev = 0, cus = 0, per_cu = 0;
        hipGetDevice(&dev);
        hipDeviceGetAttribute(&cus, hipDeviceAttributeMultiprocessorCount, dev);
        hipFuncSetAttribute((const void*)fwd_kernel, hipFuncAttributeMaxDynamicSharedMemorySize, LDS_BYTES);
        hipOccupancyMaxActiveBlocksPerMultiprocessor(&per_cu, (const void*)fwd_kernel, NTH, LDS_BYTES);
        if (per_cu < 1) { fprintf(stderr, "kernel_launch: occupancy query says %d blocks per CU\n", per_cu); per_cu = 1; }
        grid = cus;
    }
    if (grid < 0) return;
    PK p{};
    for (int i = 0; i < 31; ++i) p.in[i] = (const float*)d_in[i];
    p.out = (float*)d_out; p.ws = (unsigned char*)d_ws;
    hipMemsetAsync((unsigned char*)d_ws + WS_CTL, 0, 65536, stream);
    void* args[] = {&p};
    hipError_t e = hipLaunchCooperativeKernel((const void*)fwd_kernel, dim3(grid), dim3(NTH), args, LDS_BYTES, stream);
    if (e != hipSuccess) fprintf(stderr, "cooperative launch failed: %s (grid %d)\n", hipGetErrorString(e), grid);
}
```

```cpp
#include <hip/hip_runtime.h>
#include <hip/hip_cooperative_groups.h>
#include <cstdio>
namespace cg = cooperative_groups;

typedef unsigned short bf16_t;
typedef unsigned int u32;
typedef short bf16x8 __attribute__((ext_vector_type(8)));
typedef float f32x4 __attribute__((ext_vector_type(4)));

constexpr int D = 1024, SEQ = 16384, CTX = 256, MT = SEQ + CTX;
constexpr int NTH = 512;
#ifndef NPH_RUN
#define NPH_RUN 19
#endif
#ifndef REPEAT_MASK
#define REPEAT_MASK 0u
#endif
#ifndef TIMED_PH
#define TIMED_PH -1
#endif
#ifndef TIMED_M2
#define TIMED_M2 1.37f
#endif
#ifndef DELAY_PH
#define DELAY_PH -1
#endif
#ifndef EXP_ML_D
#define EXP_ML_D 0
#endif
#ifndef TSA
#define TSA -1
#endif
#ifndef TSB
#define TSB 0
#endif
#if TSA >= 0
#define TS(k) do { if (p.tid() == 0) ((volatile __attribute__((address_space(3))) unsigned*)((__attribute__((address_space(3))) unsigned char*)tsbase))[k] = (unsigned)__builtin_amdgcn_s_memrealtime(); } while (0)
#else
#define TS(k) do { } while (0)
#endif
#ifndef EXP_ML_V
#define EXP_ML_V 1
#endif
constexpr int EV_IN = 2064, OD_IN = 3104;
constexpr int NE = 16, DE = 512;
constexpr int MAXTILES = 146, MAXSLOTS = MAXTILES * 256;

constexpr size_t al256(size_t x) { return (x + 255) & ~(size_t)255; }
constexpr size_t WS_CTL   = 0;
constexpr size_t WS_MODS  = 65536;
constexpr size_t WS_ROPE  = WS_MODS + al256(2 * 2 * 6144 * 4);
constexpr size_t WS_SMALL = WS_ROPE + al256(2 * 256 * 16 * 4);
constexpr size_t WS_ROUTE = WS_SMALL + al256((size_t)MT * 32 * 4);
constexpr size_t WS_GATE  = WS_ROUTE + al256((size_t)MT * 16);
constexpr size_t WS_SLOT  = WS_GATE + al256((size_t)MT * 8);
constexpr size_t WS_LIST  = WS_SLOT + al256((size_t)MT * 8);
constexpr size_t WS_TEXP  = WS_LIST + al256((size_t)MAXSLOTS * 4);
constexpr size_t WS_CHK   = WS_TEXP + 1024;
constexpr size_t WS_WIN0  = WS_CHK + (size_t)4 * 1024 * 1024;
constexpr size_t WS_WIN1  = WS_WIN0 + (size_t)2304 * 1024 * 2;
constexpr size_t WS_WOUT0 = WS_WIN1 + (size_t)3328 * 1024 * 2;
constexpr size_t WS_WOUT1 = WS_WOUT0 + (size_t)1024 * 1024 * 2;
constexpr size_t WS_WMOE  = WS_WOUT1 + (size_t)1024 * 1024 * 2;
constexpr size_t WS_XRES  = WS_WMOE + (size_t)16 * 1024 * 1024 * 2 + (size_t)16 * 1024 * 512 * 2;
constexpr size_t WS_HB    = WS_XRES + (size_t)MT * 1024 * 4;
constexpr size_t WS_PROJ  = WS_HB + (size_t)MT * 1024 * 2;
constexpr size_t WS_Y     = WS_PROJ + (size_t)MT * 3072 * 2;
constexpr size_t WS_END   = WS_Y + (size_t)MT * 1024 * 4;
static_assert(WS_END < 349000000, "workspace too large");

constexpr int CW_CNT = 8192;
constexpr int CH_BBASE = 300000;
constexpr int CH_ELIST = 524288;
constexpr int CH_WRT = 917504;
constexpr int CW_BAR = 1024;
constexpr int CW_Q5 = 12288;
constexpr int CW_Q3 = 12352, CW_Q12 = 12416, CW_Q4 = 12480;
constexpr int LDS_BYTES = 160 * 1024;

struct PK { const float* in[31]; float* out; unsigned char* ws; };
typedef __attribute__((address_space(4))) const unsigned char* kaptr_t;
struct InTab { __device__ __forceinline__ const float* operator[](int i) const {
    kaptr_t ka = (kaptr_t)__builtin_amdgcn_kernarg_segment_ptr(); asm volatile("" : "+s"(ka)); return *(const float* __attribute__((address_space(4))) const*)(ka + i * 8); } };
struct P { InTab in; int wv;
    __device__ __forceinline__ int tid() const { int l; asm volatile("v_mbcnt_lo_u32_b32 %0, -1, 0\n\tv_mbcnt_hi_u32_b32 %0, -1, %0" : "=v"(l)); return (wv << 6) | l; }
    __device__ __forceinline__ float* get_out() const { kaptr_t ka = (kaptr_t)__builtin_amdgcn_kernarg_segment_ptr(); asm volatile("" : "+s"(ka)); return *(float* __attribute__((address_space(4))) const*)(ka + 31 * 8); }
    __device__ __forceinline__ unsigned char* get_ws() const { kaptr_t ka = (kaptr_t)__builtin_amdgcn_kernarg_segment_ptr(); asm volatile("" : "+s"(ka)); return *(unsigned char* __attribute__((address_space(4))) const*)(ka + 32 * 8); } };

__device__ __forceinline__ float bf2f(bf16_t b) { return __uint_as_float((u32)b << 16); }
__device__ __forceinline__ bf16_t f2bf(float f) { u32 r; asm("v_cvt_pk_bf16_f32 %0, %1, %1" : "=v"(r) : "v"(f)); return (bf16_t)r; }
__device__ __forceinline__ u32 pack2(float a, float b) { u32 r; asm("v_cvt_pk_bf16_f32 %0, %1, %2" : "=v"(r) : "v"(a), "v"(b)); return r; }
__device__ __forceinline__ void unpack8(const uint4 w, float* f) {
    f[0] = __uint_as_float(w.x << 16); f[1] = __uint_as_float(w.x & 0xffff0000u); f[2] = __uint_as_float(w.y << 16); f[3] = __uint_as_float(w.y & 0xffff0000u);
    f[4] = __uint_as_float(w.z << 16); f[5] = __uint_as_float(w.z & 0xffff0000u); f[6] = __uint_as_float(w.w << 16); f[7] = __uint_as_float(w.w & 0xffff0000u);
}
__device__ __forceinline__ void ld4bf(const bf16_t* p, float* f) { const uint2 w = *(const uint2*)p; f[0] = __uint_as_float(w.x << 16); f[1] = __uint_as_float(w.x & 0xffff0000u); f[2] = __uint_as_float(w.y << 16); f[3] = __uint_as_float(w.y & 0xffff0000u); }
__device__ __forceinline__ float siluf(float x) { return x / (1.f + __expf(-x)); }
__device__ __forceinline__ float sigmf(float x) { return 1.f / (1.f + __expf(-x)); }
__device__ __forceinline__ float softplusf(float x) { return x > 20.f ? x : log1pf(__expf(x)); }
__device__ __forceinline__ float logsigf(float x) { return x < -20.f ? x : -log1pf(__expf(-x)); }
__device__ __forceinline__ float wave_sum(float v) {
#pragma unroll
    for (int o = 32; o >= 1; o >>= 1) v += __shfl_xor(v, o);
    return v;
}
__device__ __forceinline__ float rdlane(float v, int l) { return __int_as_float(__builtin_amdgcn_readlane(__float_as_int(v), l)); }

__device__ __forceinline__ void phase_mods(const P& p, int bid, int nb, float* lds) {
    const int tid = p.tid();
    float* MODS = (float*)(p.get_ws() + WS_MODS);
    float* RC = (float*)(p.get_ws() + WS_ROPE); float* RS = RC + 256 * 16;
    for (int i = bid * NTH + tid; i < 256 * 16; i += nb * NTH) {
        const int pos = i >> 4, f = i & 15;
        const float inv = powf(10000.f, -(float)f / 16.f);
        const float ang = (float)pos * inv;
        RC[i] = cosf(ang); RS[i] = sinf(ang);
    }
    const float* c = p.in[1]; const float* cx = p.in[3];
    for (int i = tid; i < 1024; i += NTH) { const float a = c[i]; lds[i] = a / (1.f + expf(-a)); const float b = cx[i]; lds[1024 + i] = b / (1.f + expf(-b)); }
    __syncthreads();
    float* red = lds + 2048;
    const int tx = tid & 15, ty = tid >> 4;
    for (int item = bid; item < 192; item += nb) {
        const int l = item / 96, cgp = item % 96;
        const float* W = p.in[8] + (size_t)l * 1024 * 6144 + cgp * 64 + tx * 4;
        float4 ac = {0.f, 0.f, 0.f, 0.f}, ax = {0.f, 0.f, 0.f, 0.f};
#pragma unroll 8
        for (int k = ty; k < 1024; k += 32) {
            const float4 w = *(const float4*)(W + (size_t)k * 6144);
            const float sc = lds[k], sx = lds[1024 + k];
            ac.x += sc * w.x; ac.y += sc * w.y; ac.z += sc * w.z; ac.w += sc * w.w;
            ax.x += sx * w.x; ax.y += sx * w.y; ax.z += sx * w.z; ax.w += sx * w.w;
        }
        float* r = red + (ty * 16 + tx) * 8;
        r[0] = ac.x; r[1] = ac.y; r[2] = ac.z; r[3] = ac.w; r[4] = ax.x; r[5] = ax.y; r[6] = ax.z; r[7] = ax.w;
        __syncthreads();
        if (tid < 128) {
            const int col = tid & 63, which = tid >> 6;
            float s = 0.f;
            for (int y = 0; y < 32; ++y) s += red[(y * 16 + (col >> 2)) * 8 + which * 4 + (col & 3)];
            s += p.in[9][l * 6144 + cgp * 64 + col];
            MODS[(l * 2 + which) * 6144 + cgp * 64 + col] = s;
        }
        __syncthreads();
    }
}

struct RowArgs {
    int layer;
    int ffn;
    int src;
    int combine;
    int clayer;
    int final_out;
    int nrows;
    const float* wsm; int ldw; int wcol0;
    int route;
    int noproj;
};

template <int NS>
__device__ __forceinline__ float row_norm_proj(float (&v)[16], const float* gamma, const float* md, bf16_t* hrow, const float* lds, int lane, bool doproj) {
    float ss = 0.f;
#pragma unroll
    for (int j = 0; j < 16; ++j) ss += v[j] * v[j];
    ss = wave_sum(ss);
    const float rs = rsqrtf(ss * (1.f / 1024.f) + 1e-6f);
#pragma unroll
    for (int i = 0; i < 4; ++i) {
        const float4 g = *(const float4*)(gamma + i * 256 + lane * 4);
        const float4 sh = *(const float4*)(md + i * 256 + lane * 4);
        const float4 sc = *(const float4*)(md + 1024 + i * 256 + lane * 4);
        v[i * 4 + 0] = v[i * 4 + 0] * rs * g.x * (1.f + sc.x) + sh.x;
        v[i * 4 + 1] = v[i * 4 + 1] * rs * g.y * (1.f + sc.y) + sh.y;
        v[i * 4 + 2] = v[i * 4 + 2] * rs * g.z * (1.f + sc.z) + sh.z;
        v[i * 4 + 3] = v[i * 4 + 3] * rs * g.w * (1.f + sc.w) + sh.w;
        uint2 o; o.x = pack2(v[i * 4], v[i * 4 + 1]); o.y = pack2(v[i * 4 + 2], v[i * 4 + 3]);
        *(uint2*)(hrow + i * 256 + lane * 4) = o;
    }
    if (!doproj) return 0.f;
    float s[NS];
#pragma unroll
    for (int n = 0; n < NS; ++n) s[n] = 0.f;
#pragma unroll
    for (int i = 0; i < 4; ++i)
#pragma unroll
        for (int j = 0; j < 4; ++j) {
            const float* w = lds + ((i * 4 + j) * (NS / 4)) * 256 + lane * 4;
            const float x = v[i * 4 + j];
#pragma unroll
            for (int n = 0; n < NS; n += 4) { const float4 ww = *(const float4*)(w + (n >> 2) * 256); s[n] += x * ww.x; s[n + 1] += x * ww.y; s[n + 2] += x * ww.z; s[n + 3] += x * ww.w; }
            asm volatile("" ::: "memory");
        }
#pragma unroll
    for (int hN = NS / 2, off = 32; hN >= 1; hN >>= 1, off >>= 1) {
        const bool upper = (lane & off) != 0;
#pragma unroll
        for (int i2 = 0; i2 < hN; ++i2) { const float mine = upper ? s[i2 + hN] : s[i2], other = upper ? s[i2] : s[i2 + hN]; s[i2] = mine + __shfl_xor(other, off); }
    }
    float s0 = s[0];
    if (NS == 16) { s0 += __shfl_xor(s0, 2); s0 += __shfl_xor(s0, 1); } else { s0 += __shfl_xor(s0, 1); }
    return s0;
}
__device__ __forceinline__ void route16(const float (&sc)[16], const float (&bs)[16], int& e0, int& e1, float& g0, float& g1) {
    float best = -1e30f, W0 = 0.f, W1 = 0.f; int E0 = 0, E1 = 0;
#pragma unroll
    for (int g = 0; g < 4; ++g) {
        float m1 = bs[g * 4], w1 = sc[g * 4]; int i1 = 0;
#pragma unroll
        for (int j = 1; j < 4; ++j) { const bool gt = bs[g * 4 + j] > m1; m1 = gt ? bs[g * 4 + j] : m1; w1 = gt ? sc[g * 4 + j] : w1; i1 = gt ? j : i1; }
        float m2 = -1e30f, w2 = 0.f; int i2 = 0;
#pragma unroll
        for (int j = 0; j < 4; ++j) { const bool gt = (j != i1) && (bs[g * 4 + j] > m2); m2 = gt ? bs[g * 4 + j] : m2; w2 = gt ? sc[g * 4 + j] : w2; i2 = gt ? j : i2; }
        const float gs = m1 + m2; const bool better = gs > best;
        best = better ? gs : best; E0 = better ? g * 4 + i1 : E0; E1 = better ? g * 4 + i2 : E1; W0 = better ? w1 : W0; W1 = better ? w2 : W1;
    }
    e0 = E0; e1 = E1;
    const float inv = 1.f / (W0 + W1);
    g0 = W0 * inv; g1 = W1 * inv;
}
__device__ __forceinline__ void expert_offsets(const u32* cnt  , int (&off)[17]) {
    off[0] = 0;
#pragma unroll
    for (int e = 0; e < 16; ++e) off[e + 1] = off[e] + (int)((cnt[e * 64] + 255u) / 256u) * 256;
}

template <int NS> __forceinline__
__device__ __forceinline__ void phase_rows(const P& p, int bid, int nb, float* lds, const RowArgs a) {
    const int tid = p.tid(), lane = tid & 63, wid = tid >> 6;
    unsigned char* ws = p.get_ws();
    const float* MODS = (const float*)(ws + WS_MODS);
    bf16_t* XRES = (bf16_t*)(ws + WS_XRES);
    bf16_t* HB = (bf16_t*)(ws + WS_HB);
    float* SMALL = (float*)(ws + WS_SMALL);
    int* CHKI = (int*)(ws + WS_CHK);
    if (!a.final_out && !a.noproj) {
        for (int i = tid; i < 1024 * NS; i += NTH) { const int k = i / NS, n = i % NS;
            lds[(((k >> 8) * 4 + (k & 3)) * (NS / 4) + (n >> 2)) * 256 + ((k >> 2) & 63) * 4 + (n & 3)] = a.wsm[(size_t)k * a.ldw + a.wcol0 + n]; }
    }
    u32* lcnt = (u32*)(lds + 1024 * 32);
    int* lsl = (int*)(lds + 1024 * 32 + 64);
    int4* lrt = (int4*)(lds + 1024 * 32 + 64);
    if (tid < 16) lcnt[tid] = 0u;
    if (a.combine) {
        if (tid == 0) { int off[17]; expert_offsets((const u32*)(ws + WS_CTL) + CW_CNT + a.clayer * 16 * 64, off);
#pragma unroll
            for (int e = 0; e < 16; ++e) lsl[e] = off[e]; }
        for (int i = tid; i < nb * 16; i += NTH) lsl[16 + i] = CHKI[CH_BBASE + i];
    }
    __syncthreads();
    const float* gamma = (a.ffn ? p.in[7] : p.in[6]) + a.layer * 1024;
    const bf16_t* YMOE = (const bf16_t*)(ws + WS_PROJ);
    const int4* ROUTE = (const int4*)(ws + WS_ROUTE);
    const float2* GATE = (const float2*)(ws + WS_GATE);
    const int stride = nb * 8;
    for (int row0 = bid * 8 + wid; row0 < a.nrows; row0 += (NS == 16 ? 2 : 1) * stride) {
        const bool hasB = NS == 16 && row0 + stride < a.nrows;
        const int rw[2] = {row0, hasB ? row0 + stride : row0};
        float v[2][16];
#pragma unroll
        for (int u = 0; u < 2; ++u) {
            const int row = rw[u];
            if (a.src) {
#pragma unroll
                for (int i = 0; i < 4; ++i) ld4bf(XRES + (size_t)row * 1024 + i * 256 + lane * 4, &v[u][i * 4]);
            } else {
                const float* src = row >= SEQ ? p.in[2] + (size_t)(row - SEQ) * 1024 : p.in[0] + (size_t)row * 1024;
#pragma unroll
                for (int i = 0; i < 4; ++i) { const float4 t = *(const float4*)(src + i * 256 + lane * 4); v[u][i * 4] = t.x; v[u][i * 4 + 1] = t.y; v[u][i * 4 + 2] = t.z; v[u][i * 4 + 3] = t.w; }
            }
        }
        if (a.combine) {
            int4 rt[2]; float2 gt[2];
#pragma unroll
            for (int u = 0; u < 2; ++u) { rt[u] = ROUTE[rw[u]]; gt[u] = GATE[rw[u]]; }
            uint2 y0[2][4], y1[2][4];
#pragma unroll
            for (int u = 0; u < 2; ++u) {
                const int blk = (rw[u] >> 6) % nb;
                const int s0 = lsl[rt[u].x] + lsl[16 + blk * 16 + rt[u].x] + rt[u].y, s1 = lsl[rt[u].z] + lsl[16 + blk * 16 + rt[u].z] + rt[u].w;
#pragma unroll
                for (int i = 0; i < 4; ++i) { y0[u][i] = *(const uint2*)(YMOE + (size_t)s0 * 1024 + i * 256 + lane * 4); y1[u][i] = *(const uint2*)(YMOE + (size_t)s1 * 1024 + i * 256 + lane * 4); }
            }
#pragma unroll
            for (int u = 0; u < 2; ++u) {
                const int row = rw[u];
                const float* gf = MODS + (a.clayer * 2 + (row >= SEQ ? 1 : 0)) * 6144 + 5 * 1024;
#pragma unroll
                for (int i = 0; i < 4; ++i) {
                    const float4 g = *(const float4*)(gf + i * 256 + lane * 4);
                    v[u][i * 4 + 0] += g.x * (gt[u].x * __uint_as_float(y0[u][i].x << 16) + gt[u].y * __uint_as_float(y1[u][i].x << 16));
                    v[u][i * 4 + 1] += g.y * (gt[u].x * __uint_as_float(y0[u][i].x & 0xffff0000u) + gt[u].y * __uint_as_float(y1[u][i].x & 0xffff0000u));
                    v[u][i * 4 + 2] += g.z * (gt[u].x * __uint_as_float(y0[u][i].y << 16) + gt[u].y * __uint_as_float(y1[u][i].y << 16));
                    v[u][i * 4 + 3] += g.w * (gt[u].x * __uint_as_float(y0[u][i].y & 0xffff0000u) + gt[u].y * __uint_as_float(y1[u][i].y & 0xffff0000u));
                }
                if (u == 0 || hasB) {
                    if (a.final_out) { float* dst = p.get_out() + (size_t)row * 1024;
#pragma unroll
                        for (int i = 0; i < 4; ++i) *(float4*)(dst + i * 256 + lane * 4) = make_float4(v[u][i * 4], v[u][i * 4 + 1], v[u][i * 4 + 2], v[u][i * 4 + 3]); }
                    else {
#pragma unroll
                        for (int i = 0; i < 4; ++i) { uint2 o; o.x = pack2(v[u][i * 4], v[u][i * 4 + 1]); o.y = pack2(v[u][i * 4 + 2], v[u][i * 4 + 3]); *(uint2*)(XRES + (size_t)row * 1024 + i * 256 + lane * 4) = o; } }
                }
            }
            if (a.final_out) continue;
        }
#pragma unroll
        for (int u = 0; u < 2; ++u) {
            const int row = rw[u];
            if (u == 0 || hasB) {
            const float* md = MODS + (a.layer * 2 + (row >= SEQ ? 1 : 0)) * 6144 + (a.ffn ? 3 * 1024 : 0);
            const float s0 = row_norm_proj<NS>(v[u], gamma, md, HB + (size_t)row * 1024, lds, lane, !a.noproj);
            if (a.noproj) {
            } else if (!a.route) {
                const int nl = NS == 16 ? (((lane >> 5) & 1) << 3) | (((lane >> 4) & 1) << 2) | (((lane >> 3) & 1) << 1) | ((lane >> 2) & 1)
                                        : (((lane >> 5) & 1) << 4) | (((lane >> 4) & 1) << 3) | (((lane >> 3) & 1) << 2) | (((lane >> 2) & 1) << 1) | ((lane >> 1) & 1);
                if ((lane & (NS == 16 ? 3 : 1)) == 0) SMALL[(size_t)row * 32 + nl] = s0;
            } else if (NS == 16) {
                const int nl = (((lane >> 5) & 1) << 3) | (((lane >> 4) & 1) << 2) | (((lane >> 3) & 1) << 1) | ((lane >> 2) & 1);
                const float scl = 1.f / (1.f + expf(-s0)), bsl = scl + p.in[5][nl];
                float sc[16], bs[16];
#pragma unroll
                for (int n = 0; n < 16; ++n) { const int sl = ((n & 8) ? 32 : 0) | ((n & 4) ? 16 : 0) | ((n & 2) ? 8 : 0) | ((n & 1) ? 4 : 0); sc[n] = rdlane(scl, sl); bs[n] = rdlane(bsl, sl); }
                int e0, e1; float g0, g1; route16(sc, bs, e0, e1, g0, g1);
                if (lane == 0) {
                    const int p0 = (int)atomicAdd(lcnt + e0, 1u), p1 = (int)atomicAdd(lcnt + e1, 1u);
                    const int4 rt4 = make_int4(e0, p0, e1, p1);
                    ((int4*)(ws + WS_ROUTE))[row] = rt4;
                    ((float2*)(ws + WS_GATE))[row] = make_float2(g0, g1);
                    lrt[((row - (bid * 8 + wid)) / stride) * 8 + wid] = rt4;
                }
            }
            }
            __builtin_amdgcn_sched_barrier(0);
        }
    }
    if (a.route) {
        __syncthreads();
        if (tid < 16) {
            u32* cnt = (u32*)(ws + WS_CTL) + CW_CNT + (a.layer * 16 + tid) * 64;
            const int base = (int)atomicAdd(cnt, lcnt[tid]);
            CHKI[CH_BBASE + bid * 16 + tid] = base; lcnt[16 + tid] = (u32)base;
        }
        __syncthreads();
        if (lane == 0) {
            int* ELIST = CHKI + CH_ELIST;
            int k = 0;
            for (int row = bid * 8 + wid; row < a.nrows; row += stride, ++k) {
                const int4 r = lrt[k * 8 + wid];
                ELIST[r.x * MT + (int)lcnt[16 + r.x] + r.y] = row; ELIST[r.z * MT + (int)lcnt[16 + r.z] + r.w] = row;
            }
        }
    }
}


__device__ __forceinline__ void phase_route(const P& p, int bid, int nb, float* lds, int layer, int nrows) {
    const int tid = p.tid(), lane = tid & 63, wid = tid >> 6, r = lane & 15, q = lane >> 4;
    unsigned char* ws = p.get_ws();
    const float* MODS = (const float*)(ws + WS_MODS);
    const bf16_t* XRES = (const bf16_t*)(ws + WS_XRES);
    bf16_t* HB = (bf16_t*)(ws + WS_HB);
    int* CHKI = (int*)(ws + WS_CHK);
    const bf16_t* WRT = (const bf16_t*)((const float*)(ws + WS_CHK) + CH_WRT);
    u32* lcnt = (u32*)(lds + 16384);
    int4* lrt = (int4*)(lds + 16384 + 64);
    if (tid < 16) lcnt[tid] = 0u;
    const float* gamma = p.in[7] + layer * 1024;
    int kt = 0;
    for (int tile = bid; tile < nrows / 64; tile += nb, ++kt) {
        const int r0 = tile * 64;
#pragma unroll 1
        for (int pr = 0; pr < 4; ++pr) {
            float v[2][16];
#pragma unroll
            for (int u = 0; u < 2; ++u) { const bf16_t* src = XRES + (size_t)(r0 + wid * 8 + pr * 2 + u) * 1024;
#pragma unroll
                for (int i = 0; i < 4; ++i) ld4bf(src + i * 256 + lane * 4, &v[u][i * 4]); }
#pragma unroll
            for (int u = 0; u < 2; ++u) { const int row = r0 + wid * 8 + pr * 2 + u;
                const float* md = MODS + (layer * 2 + (row >= SEQ ? 1 : 0)) * 6144 + 3 * 1024;
                (void)row_norm_proj<16>(v[u], gamma, md, HB + (size_t)row * 1024, lds, lane, false); }
        }
        asm volatile("s_waitcnt vmcnt(0)" ::: "memory");
        __syncthreads();
        {
            f32x4 acc[4][2];
#pragma unroll
            for (int mi = 0; mi < 4; ++mi)
#pragma unroll
                for (int ni = 0; ni < 2; ++ni) acc[mi][ni] = (f32x4){0.f, 0.f, 0.f, 0.f};
            const bf16_t* Ab = HB + (size_t)(r0 + r) * 1024 + wid * 128 + 8 * q; const bf16_t* Bb = WRT + (size_t)r * 1024 + wid * 128 + 8 * q;
#pragma unroll
            for (int k4 = 0; k4 < 4; ++k4) {
                bf16x8 a[4], b[2];
#pragma unroll
                for (int mi = 0; mi < 4; ++mi) a[mi] = *(const bf16x8*)(Ab + (size_t)(16 * mi) * 1024 + 32 * k4);
#pragma unroll
                for (int ni = 0; ni < 2; ++ni) b[ni] = *(const bf16x8*)(Bb + (size_t)(16 * ni) * 1024 + 32 * k4);
#pragma unroll
                for (int mi = 0; mi < 4; ++mi)
#pragma unroll
                    for (int ni = 0; ni < 2; ++ni) acc[mi][ni] = __builtin_amdgcn_mfma_f32_16x16x32_bf16(b[ni], a[mi], acc[mi][ni], 0, 0, 0);
            }
#pragma unroll
            for (int mi = 0; mi < 4; ++mi)
#pragma unroll
                for (int ni = 0; ni < 2; ++ni) *(f32x4*)(lds + wid * 2048 + (16 * mi + r) * 32 + 16 * ni + 4 * q) = acc[mi][ni];
        }
        __syncthreads();
        if (tid < 128) {
            const int rr = tid >> 1, c8 = (tid & 1) * 8;
            float lg[8] = {0.f, 0.f, 0.f, 0.f, 0.f, 0.f, 0.f, 0.f};
#pragma unroll
            for (int w = 0; w < 8; ++w) { const float4 x0 = *(const float4*)(lds + w * 2048 + rr * 32 + c8), x1 = *(const float4*)(lds + w * 2048 + rr * 32 + c8 + 4);
                lg[0] += x0.x; lg[1] += x0.y; lg[2] += x0.z; lg[3] += x0.w; lg[4] += x1.x; lg[5] += x1.y; lg[6] += x1.z; lg[7] += x1.w; }
            float sc[16], bs[16];
            const float* rb = p.in[5];
#pragma unroll
            for (int j = 0; j < 8; ++j) {
                const float mine_s = 1.f / (1.f + expf(-lg[j])), mine_b = mine_s + rb[c8 + j];
                const float oth_s = __shfl_xor(mine_s, 1), oth_b = __shfl_xor(mine_b, 1);
                sc[j] = c8 ? oth_s : mine_s; sc[8 + j] = c8 ? mine_s : oth_s; bs[j] = c8 ? oth_b : mine_b; bs[8 + j] = c8 ? mine_b : oth_b;
            }
            int e0, e1; float g0, g1; route16(sc, bs, e0, e1, g0, g1);
            if (c8 == 0) {
                const int row = r0 + rr;
                const int p0 = (int)atomicAdd(lcnt + e0, 1u), p1 = (int)atomicAdd(lcnt + e1, 1u);
                const int4 rt4 = make_int4(e0, p0, e1, p1);
                ((int4*)(ws + WS_ROUTE))[row] = rt4;
                ((float2*)(ws + WS_GATE))[row] = make_float2(g0, g1);
                lrt[kt * 64 + rr] = rt4;
            }
        }
        __syncthreads();
    }
    __syncthreads();
    if (tid < 16) {
        u32* cnt = (u32*)(ws + WS_CTL) + CW_CNT + (layer * 16 + tid) * 64;
        const int base = (int)atomicAdd(cnt, lcnt[tid]);
        CHKI[CH_BBASE + bid * 16 + tid] = base; lcnt[16 + tid] = (u32)base;
    }
    __syncthreads();
    {
        int* ELIST = CHKI + CH_ELIST;
        int k2 = 0;
        for (int tile = bid; tile < nrows / 64; tile += nb, ++k2)
            if (tid < 64) { const int4 rt = lrt[k2 * 64 + tid]; const int row = tile * 64 + tid;
                ELIST[rt.x * MT + (int)lcnt[16 + rt.x] + rt.y] = row; ELIST[rt.z * MT + (int)lcnt[16 + rt.z] + rt.w] = row; }
    }
}

namespace g8 {
#define G8_LAS __attribute__((address_space(3)))
typedef short bf16x8 __attribute__((ext_vector_type(8)));
typedef float f32x4 __attribute__((ext_vector_type(4)));
constexpr int BM = 256, BK = 64, HALF = 128, HTB = HALF * BK * 2, STAGE_BYTES = 8 * HTB, NXCD = 8, WGM = 8;
__device__ __forceinline__ int lds_byte(int r, int c) { const int st = (r >> 4) * 2 + (c >> 5), rr = r & 15, cc = c & 31, ob = rr * 64 + cc * 2; return st * 1024 + (ob ^ (((ob >> 9) & 1) << 5)); }
__device__ __forceinline__ void stage_rc(int b, int& R, int& C) { const int st = b / 1024, sb = b % 1024, swz = sb ^ (((sb >> 9) & 1) << 5); R = (st >> 1) * 16 + swz / 64; C = (st & 1) * 32 + (swz % 64) / 2; }
__device__ __forceinline__ int perm32(int rho) { const int n = rho >> 4, i = rho & 15; return 8 * (i >> 2) + 4 * n + (i & 3); }
struct Unit { int pm, pn; };
struct Order {
    int nM, nN, nwg, G, c;
    __device__ __forceinline__ void init(int nM_, int nN_, int G_, int c_) { nM = nM_; nN = nN_; nwg = nM * nN; G = G_; c = c_; }
    __device__ __forceinline__ bool next(int i, Unit& u) const {
        const long L = (long)i * G + c; if (L >= nwg) return false;
        int wgid = (int)L; { const int q = nwg / NXCD, r = nwg % NXCD, xcd = wgid % NXCD, off = wgid / NXCD; wgid = (xcd < r ? xcd * (q + 1) : r * (q + 1) + (xcd - r) * q) + off; }
        const int nig = WGM * nN, gid = wgid / nig, fm = gid * WGM, gsz = (nM - fm) < WGM ? (nM - fm) : WGM;
        u.pm = fm + ((wgid % nig) % gsz); u.pn = (wgid % nig) / gsz; return true;
    }
};
template <class RowSrc, class BSel, class EF>
__device__ __forceinline__ void gemm8(const int tid, G8_LAS unsigned char* lds, const bf16_t* A, int K, const RowSrc& rsrc, const Order& S, const BSel& bsel, const EF& ef) {
    const int wid = __builtin_amdgcn_readfirstlane(tid >> 6), lane = tid & 63, wr = wid >> 2, wc = wid & 3, fr = lane & 15, fq = lane >> 4;
    const int nt = K / BK;
    int R0, C0, R1, C1; stage_rc(tid * 16, R0, C0); stage_rc(tid * 16 + 8192, R1, C1);
    const unsigned vb0 = (unsigned)(((R0 & ~31) + perm32(R0 & 31)) * K + C0) * 2u, vb1 = (unsigned)(((R1 & ~31) + perm32(R1 & 31)) * K + C1) * 2u;
    const size_t kstep = (size_t)(BK * 2), hstep = (size_t)HALF * K * 2, tstep = 2 * hstep;
    const unsigned ldsw = (unsigned)wid * 1024u;
    const int aoff = lds_byte(wr * 64 + fr, fq * 8), boff = lds_byte(wc * 32 + fr, fq * 8);
#define G8_SA(b, h) (((b) * 2 + (h)) * HTB)
#define G8_SB(b, h) ((4 + (b) * 2 + (h)) * HTB)
#define G8_STAGE(bufoff, gbase, v0, v1) do { \
        __builtin_amdgcn_global_load_lds((const unsigned*)((const char*)(gbase) + (v0)), (G8_LAS unsigned*)(lds + (bufoff) + ldsw), 16, 0, 0); \
        __builtin_amdgcn_global_load_lds((const unsigned*)((const char*)(gbase) + (v1)), (G8_LAS unsigned*)(lds + (bufoff) + ldsw + 8192), 16, 0, 0); } while (0)
#define G8_LDA(dst, b, h) do { _Pragma("unroll") for (int m = 0; m < 4; ++m) _Pragma("unroll") for (int k = 0; k < 2; ++k) dst[m][k] = *(const G8_LAS bf16x8*)(lds + G8_SA(b, h) + aoff + m * 2048 + k * 1024); } while (0)
#define G8_LDB(dst, b, h) do { _Pragma("unroll") for (int n = 0; n < 2; ++n) _Pragma("unroll") for (int k = 0; k < 2; ++k) dst[n][k] = *(const G8_LAS bf16x8*)(lds + G8_SB(b, h) + boff + n * 2048 + k * 1024); } while (0)
#define G8_MMA(ai, bj, At, Bt) do { __builtin_amdgcn_s_setprio(1); _Pragma("unroll") for (int m = 0; m < 4; ++m) _Pragma("unroll") for (int n = 0; n < 2; ++n) _Pragma("unroll") for (int k = 0; k < 2; ++k) \
        acc[ai][bj][m][n] = __builtin_amdgcn_mfma_f32_16x16x32_bf16(Bt[n][k], At[m][k], acc[ai][bj][m][n], 0, 0, 0); __builtin_amdgcn_s_setprio(0); } while (0)
#define G8_WAIT_V(n) asm volatile("s_waitcnt vmcnt(" #n ")" ::: "memory")
#define G8_WAIT_L(n) asm volatile("s_waitcnt lgkmcnt(" #n ")" ::: "memory")
#define G8_BAR __builtin_amdgcn_s_barrier()
#define G8_SCHED __builtin_amdgcn_sched_barrier(0)
#define G8_AOFF(pm_, h_, R_, C_) ((unsigned)(rsrc((pm_), (h_) * 128 + (R_)) * K + (C_)) * 2u)
    Unit cur, nxt; int ui = 0;
    if (!S.next(0, cur)) return;
    f32x4 acc[2][2][4][2];
#pragma unroll
    for (int a = 0; a < 2; ++a)
#pragma unroll
        for (int b = 0; b < 2; ++b)
#pragma unroll
            for (int m = 0; m < 4; ++m)
#pragma unroll
                for (int n = 0; n < 2; ++n) acc[a][b][m][n] = (f32x4){0.f, 0.f, 0.f, 0.f};
    bf16x8 At[4][2], B0[2][2], B1[2][2];
    const char* Ab = (const char*)A;
    unsigned a00 = G8_AOFF(cur.pm, 0, R0, C0), a01 = G8_AOFF(cur.pm, 0, R1, C1), a10 = G8_AOFF(cur.pm, 1, R0, C0), a11 = G8_AOFF(cur.pm, 1, R1, C1);
    const char* cB = bsel(cur.pm) + (size_t)cur.pn * tstep;
    G8_STAGE(G8_SB(0, 0), cB, vb0, vb1); G8_STAGE(G8_SA(0, 0), Ab, a00, a01); G8_STAGE(G8_SB(0, 1), cB + hstep, vb0, vb1); G8_STAGE(G8_SA(0, 1), Ab, a10, a11);
    if (wr == 1) G8_BAR;
    G8_WAIT_V(4); G8_BAR;
    G8_STAGE(G8_SB(1, 0), cB + kstep, vb0, vb1); G8_STAGE(G8_SA(1, 0), Ab + kstep, a00, a01); G8_STAGE(G8_SB(1, 1), cB + hstep + kstep, vb0, vb1);
    G8_WAIT_V(6); G8_BAR;
    for (;;) {
        const bool has_next = S.next(ui + 1, nxt);
        unsigned n00 = a00, n01 = a01, n10 = a10, n11 = a11; const char* nB = cB;
        if (has_next) { n00 = G8_AOFF(nxt.pm, 0, R0, C0); n01 = G8_AOFF(nxt.pm, 0, R1, C1); n10 = G8_AOFF(nxt.pm, 1, R0, C0); n11 = G8_AOFF(nxt.pm, 1, R1, C1); nB = bsel(nxt.pm) + (size_t)nxt.pn * tstep; }
        for (int t = 0; t < nt; t += 2) {
            const bool last = (t == nt - 2);
            const char* a1p = Ab + (size_t)(t + 1) * kstep;
            const char* a2p = last ? Ab : Ab + (size_t)(t + 2) * kstep; const char* b2 = last ? nB : cB + (size_t)(t + 2) * kstep;
            const char* a3p = a2p + kstep; const char* b3 = b2 + kstep;
            const unsigned x00 = last ? n00 : a00, x01 = last ? n01 : a01, x10 = last ? n10 : a10, x11 = last ? n11 : a11;
            G8_LDB(B0, 0, 0); G8_SCHED; G8_LDA(At, 0, 0); G8_STAGE(G8_SA(1, 1), a1p, a10, a11);
            G8_WAIT_L(8); G8_BAR; G8_WAIT_L(0); G8_MMA(0, 0, At, B0); G8_BAR; G8_SCHED;
            G8_LDB(B1, 0, 1); G8_STAGE(G8_SB(0, 0), b2, vb0, vb1);
            G8_BAR; G8_WAIT_L(0); G8_MMA(0, 1, At, B1); G8_BAR;
            G8_LDA(At, 0, 1); G8_STAGE(G8_SA(0, 0), a2p, x00, x01);
            G8_BAR; G8_WAIT_L(0); G8_MMA(1, 0, At, B0); G8_BAR; G8_SCHED;
            G8_STAGE(G8_SB(0, 1), b2 + hstep, vb0, vb1);
            G8_WAIT_V(6); G8_BAR; G8_MMA(1, 1, At, B1); G8_BAR;
            G8_LDB(B0, 1, 0); G8_SCHED; G8_LDA(At, 1, 0); G8_STAGE(G8_SA(0, 1), a2p, x10, x11);
            G8_WAIT_L(8); G8_BAR; G8_WAIT_L(0); G8_MMA(0, 0, At, B0); G8_BAR; G8_SCHED;
            G8_LDB(B1, 1, 1); G8_STAGE(G8_SB(1, 0), b3, vb0, vb1);
            G8_BAR; G8_WAIT_L(0); G8_MMA(0, 1, At, B1); G8_BAR;
            G8_LDA(At, 1, 1); G8_STAGE(G8_SA(1, 0), a3p, x00, x01);
            G8_BAR; G8_WAIT_L(0); G8_MMA(1, 0, At, B0); G8_BAR; G8_SCHED;
            G8_STAGE(G8_SB(1, 1), b3 + hstep, vb0, vb1);
            G8_WAIT_V(6); G8_BAR; G8_MMA(1, 1, At, B1); G8_BAR;
        }
#pragma unroll
        for (int ai = 0; ai < 2; ++ai)
#pragma unroll
            for (int m = 0; m < 4; ++m)
#pragma unroll
                for (int bj = 0; bj < 2; ++bj) {
                    const f32x4 v0 = acc[ai][bj][m][0], v1 = acc[ai][bj][m][1];
                    const float v[8] = {v0[0], v0[1], v0[2], v0[3], v1[0], v1[1], v1[2], v1[3]};
                    ef(cur.pm * BM + ai * HALF + wr * 64 + m * 16 + fr, cur.pn * BM + bj * HALF + wc * 32 + 8 * fq, v);
                }
        if (!has_next) break;
#pragma unroll
        for (int a = 0; a < 2; ++a)
#pragma unroll
            for (int b = 0; b < 2; ++b)
#pragma unroll
                for (int m = 0; m < 4; ++m)
#pragma unroll
                    for (int n = 0; n < 2; ++n) acc[a][b][m][n] = (f32x4){0.f, 0.f, 0.f, 0.f};
        cur = nxt; a00 = n00; a01 = n01; a10 = n10; a11 = n11; cB = nB; ++ui;
    }
    G8_WAIT_V(0);
    if (wr == 0) G8_BAR;
    G8_BAR;
#undef G8_SA
#undef G8_SB
#undef G8_STAGE
#undef G8_LDA
#undef G8_LDB
#undef G8_MMA
#undef G8_WAIT_V
#undef G8_WAIT_L
#undef G8_BAR
#undef G8_SCHED
#undef G8_AOFF
}
}
struct BSelOne { const char* B; __device__ __forceinline__ const char* operator()(int) const { return B; } };
struct RowPlain { __device__ __forceinline__ int operator()(int pm, int r) const { return pm * 256 + r; } };
struct BSelExp { const char* B; const int* tinfo; size_t stride; __device__ __forceinline__ const char* operator()(int pm) const { return B + (size_t)tinfo[2 * pm] * stride; } };
struct RowMoe { const int* tinfo; const int* ecnt; const int* elist;
    __device__ __forceinline__ int operator()(int pm, int r) const { const int e = tinfo[2 * pm], pos = tinfo[2 * pm + 1] + r; return pos < ecnt[e] ? elist[e * MT + pos] : 0; } };
__device__ __forceinline__ int moe_tile_table(const P& p, int layer, int* tinfo, int* ecnt, int tid) {
    const u32* cnt = (const u32*)(p.get_ws() + WS_CTL) + CW_CNT + layer * 16 * 64;
    if (tid == 0) {
        int t = 0;
#pragma unroll 1
        for (int e = 0; e < 16; ++e) { const int c = (int)cnt[e * 64]; ecnt[e] = c;
#pragma unroll 1
            for (int i = 0; i < (c + 255) / 256; ++i) { tinfo[2 * t] = e; tinfo[2 * t + 1] = i * 256; ++t; } }
        ecnt[16] = t;
    }
    __syncthreads();
    return ecnt[16];
}

struct SrcPlain { const float* W; int ldw; __device__ __forceinline__ const float* operator()(int k, int n) const { return W + (size_t)k * ldw + n; } };
struct SrcEven { const float* W; __device__ __forceinline__ const float* operator()(int k, int n) const {
        return n < 2048 ? W + (size_t)k * EV_IN + (n < 1280 ? n : n + 16) : (n < 2064 ? W + (size_t)k * EV_IN + 1280 + (n - 2048) : nullptr); } };
struct SrcRouter { const float* W; __device__ __forceinline__ const float* operator()(int k, int n) const { return n < 16 ? W + (size_t)k * 16 + n : nullptr; } };
struct SrcOdd { const float* W; __device__ __forceinline__ const float* operator()(int k, int n) const { return n < OD_IN ? W + (size_t)k * OD_IN + n : nullptr; } };
struct SrcMoe13 { const float* W1; long long d13; __device__ __forceinline__ const float* operator()(int k, int n) const { return W1 + ((n & 4) ? d13 : 0ll) + (size_t)k * DE + ((n >> 3) * 4 + (n & 3)); } };
template <class SF>
__device__ __forceinline__ void conv_matrix(const SF& src, int K, int N, bf16_t* WT, int gw, int ngw, float* scr, int lane) {
    const int nblk = N / 32, nitems = (K / 64) * nblk;
    for (int item = gw; item < nitems; item += ngw) {
        const int kb = item / nblk, nbk = item % nblk, k0 = 64 * kb, n0 = 32 * nbk;
#pragma unroll 8
        for (int i = 0; i < 32; ++i) { const int kk = 2 * i + (lane >> 5); const float* sp = src(k0 + kk, n0 + (lane & 31)); scr[kk * 33 + (lane & 31)] = sp ? *sp : 0.f; }
        __builtin_amdgcn_s_waitcnt(0xC07F); asm volatile("" ::: "memory");
        const int c = lane & 7;
#pragma unroll
        for (int j = 0; j < 4; ++j) { const int n = (lane >> 3) + 8 * j; const float* sp = scr + (8 * c) * 33 + n;
            uint4 o; o.x = pack2(sp[0 * 33], sp[1 * 33]); o.y = pack2(sp[2 * 33], sp[3 * 33]); o.z = pack2(sp[4 * 33], sp[5 * 33]); o.w = pack2(sp[6 * 33], sp[7 * 33]);
            *(uint4*)(WT + (size_t)(n0 + n) * K + k0 + 8 * c) = o; }
        __builtin_amdgcn_s_waitcnt(0xC07F); asm volatile("" ::: "memory");
    }
}

template <class SF>
__device__ __forceinline__ void conv_item(const SF& src, int K, int N, bf16_t* WT, int item, int lane) {
    const int nblk = (N + 255) / 256, kb = item / nblk, nbk = item % nblk, k0 = 32 * kb, n = nbk * 256 + lane * 4;
    if (n >= N) return;
#pragma unroll 1
    for (int kh = 0; kh < 2; ++kh) {
        float4 v[16];
#pragma unroll
        for (int j = 0; j < 16; ++j) { const float* sp = src(k0 + kh * 16 + j, n); v[j] = sp ? *(const float4*)sp : make_float4(0.f, 0.f, 0.f, 0.f); }
#pragma unroll
        for (int ks = 0; ks < 2; ++ks) {
            const float4* w = v + ks * 8;
            uint4 o;
            o.x = pack2(w[0].x, w[1].x); o.y = pack2(w[2].x, w[3].x); o.z = pack2(w[4].x, w[5].x); o.w = pack2(w[6].x, w[7].x); *(uint4*)(WT + (size_t)(n + 0) * K + k0 + kh * 16 + ks * 8) = o;
            o.x = pack2(w[0].y, w[1].y); o.y = pack2(w[2].y, w[3].y); o.z = pack2(w[4].y, w[5].y); o.w = pack2(w[6].y, w[7].y); *(uint4*)(WT + (size_t)(n + 1) * K + k0 + kh * 16 + ks * 8) = o;
            o.x = pack2(w[0].z, w[1].z); o.y = pack2(w[2].z, w[3].z); o.z = pack2(w[4].z, w[5].z); o.w = pack2(w[6].z, w[7].z); *(uint4*)(WT + (size_t)(n + 2) * K + k0 + kh * 16 + ks * 8) = o;
            o.x = pack2(w[0].w, w[1].w); o.y = pack2(w[2].w, w[3].w); o.z = pack2(w[4].w, w[5].w); o.w = pack2(w[6].w, w[7].w); *(uint4*)(WT + (size_t)(n + 3) * K + k0 + kh * 16 + ks * 8) = o;
        }
    }
}
template <class SF>
__device__ __forceinline__ void conv_all(const SF& src, int K, int N, bf16_t* WT, int gw, int ngw, int lane) {
    const int nitems = (K / 32) * ((N + 255) / 256);
    for (int it = gw; it < nitems; it += ngw) conv_item(src, K, N, WT, it, lane);
}
__device__ __forceinline__ void conv_dense(const P& p, int bid, int nb, float* lds) {
    const int tid = p.tid(), lane = tid & 63, wid = tid >> 6;
    const int ngw = nb * 8; int gw = bid * 8 + wid;
    unsigned char* ws = p.get_ws();
    conv_all(SrcEven{p.in[10]}, 1024, 2304, (bf16_t*)(ws + WS_WIN0), gw, ngw, lane);            gw = (gw + 288) % ngw;
    conv_all(SrcOdd{p.in[21]}, 1024, 3328, (bf16_t*)(ws + WS_WIN1), gw, ngw, lane);             gw = (gw + 416) % ngw;
    conv_all(SrcPlain{p.in[20], 1024}, 1024, 1024, (bf16_t*)(ws + WS_WOUT0), gw, ngw, lane);    gw = (gw + 128) % ngw;
    conv_all(SrcPlain{p.in[27], 1024}, 1024, 1024, (bf16_t*)(ws + WS_WOUT1), gw, ngw, lane);    gw = (gw + 128) % ngw;
    conv_all(SrcRouter{p.in[4]}, 1024, 32, (bf16_t*)((float*)(ws + WS_CHK) + CH_WRT), gw, ngw, lane);
}
__device__ __forceinline__ void conv_moe_chunk(const P& p, int chunk, float* lds, int layer) {
    const int tid = p.tid(), lane = tid & 63, wid = tid >> 6;
    unsigned char* ws = p.get_ws();
    bf16_t* W13T = (bf16_t*)(ws + WS_WMOE); bf16_t* W2T = W13T + (size_t)16 * 1024 * 1024;
    const long long d13 = (long long)(p.in[29] - p.in[28]);
    const int wi = chunk * 8 + wid, e = wi / 192, idx = wi % 192;
    if (idx < 128) conv_item(SrcMoe13{p.in[28] + ((size_t)layer * 16 + e) * 1024 * DE, d13}, 1024, 1024, W13T + (size_t)e * 1024 * 1024, idx, lane);
    else conv_item(SrcPlain{p.in[30] + ((size_t)layer * 16 + e) * DE * 1024, 1024}, DE, 1024, W2T + (size_t)e * 1024 * DE, idx - 128, lane);
}
__device__ __forceinline__ void conv_moe(const P& p, int bid, int nb, float* lds, int layer) {
    const int tid = p.tid(), lane = tid & 63, wid = tid >> 6;
    float* scr = lds + 16384 + wid * (64 * 33);
    const int ngw = nb * 8; int gw = bid * 8 + wid;
    unsigned char* ws = p.get_ws();
    bf16_t* W13T = (bf16_t*)(ws + WS_WMOE); bf16_t* W2T = W13T + (size_t)16 * 1024 * 1024;
    const long long d13 = (long long)(p.in[29] - p.in[28]);
    for (int e = 0; e < 16; ++e) {
        conv_matrix(SrcMoe13{p.in[28] + ((size_t)layer * 16 + e) * 1024 * DE, d13}, 1024, 1024, W13T + (size_t)e * 1024 * 1024, gw, ngw, scr, lane);
        conv_matrix(SrcPlain{p.in[30] + ((size_t)layer * 16 + e) * DE * 1024, 1024}, DE, 1024, W2T + (size_t)e * 1024 * DE, gw, ngw, scr, lane);
        gw = (gw + 768) % ngw;
    }
}


template <class EF>
__device__ __forceinline__ void mini_gemm(const P& p, int bid, int nb, float* lds, const bf16_t* A, const bf16_t* Bt, int row0, int nrt, int col0, int nct, const EF& ef) {
    constexpr int K = 1024, KS = 128;
    const int tid = p.tid(), lane = tid & 63, wid = tid >> 6, r = lane & 15, q = lane >> 4;
    const int ntl = nrt * nct;
    int t = bid;
    if (t >= ntl) return;
    bf16x8 a[4][4], b[4][2];
#define MG_LOAD(tt) do { const int rt_ = (tt) / nct, ct_ = (tt) % nct; \
        const bf16_t* Ab_ = A + (size_t)(row0 + rt_ * 64 + r) * K + wid * KS + 8 * q; const bf16_t* Bb_ = Bt + (size_t)(col0 + ct_ * 32 + r) * K + wid * KS + 8 * q; \
        _Pragma("unroll") for (int k4 = 0; k4 < 4; ++k4) { \
            _Pragma("unroll") for (int mi = 0; mi < 4; ++mi) a[k4][mi] = *(const bf16x8*)(Ab_ + (size_t)(16 * mi) * K + 32 * k4); \
            _Pragma("unroll") for (int ni = 0; ni < 2; ++ni) b[k4][ni] = *(const bf16x8*)(Bb_ + (size_t)(16 * ni) * K + 32 * k4); } } while (0)
    MG_LOAD(t);
    for (;;) {
        f32x4 acc[4][2];
#pragma unroll
        for (int mi = 0; mi < 4; ++mi)
#pragma unroll
            for (int ni = 0; ni < 2; ++ni) acc[mi][ni] = (f32x4){0.f, 0.f, 0.f, 0.f};
#pragma unroll
        for (int k4 = 0; k4 < 4; ++k4)
#pragma unroll
            for (int mi = 0; mi < 4; ++mi)
#pragma unroll
                for (int ni = 0; ni < 2; ++ni) acc[mi][ni] = __builtin_amdgcn_mfma_f32_16x16x32_bf16(b[k4][ni], a[k4][mi], acc[mi][ni], 0, 0, 0);
        const int tcur = t; t += nb;
        const bool more = t < ntl;
        if (more) MG_LOAD(t);
        __syncthreads();
#pragma unroll
        for (int mi = 0; mi < 4; ++mi)
#pragma unroll
            for (int ni = 0; ni < 2; ++ni) *(f32x4*)(lds + wid * 2048 + (16 * mi + r) * 32 + 16 * ni + 4 * q) = acc[mi][ni];
        __syncthreads();
        if (tid < 256) {
            const int rr = tid >> 2, c8 = (tid & 3) * 8;
            float v[8] = {0.f, 0.f, 0.f, 0.f, 0.f, 0.f, 0.f, 0.f};
#pragma unroll
            for (int w = 0; w < 8; ++w) { const float4 x0 = *(const float4*)(lds + w * 2048 + rr * 32 + c8), x1 = *(const float4*)(lds + w * 2048 + rr * 32 + c8 + 4);
                v[0] += x0.x; v[1] += x0.y; v[2] += x0.z; v[3] += x0.w; v[4] += x1.x; v[5] += x1.y; v[6] += x1.z; v[7] += x1.w; }
            ef(row0 + (tcur / nct) * 64 + rr, col0 + (tcur % nct) * 32 + c8, v);
        }
        if (!more) break;
    }
#undef MG_LOAD
    __syncthreads();
}

struct EpiProj { bf16_t* C; int ld; int nmain; int ns; float* SMALL; __device__ void operator()(int r, int c0, const float* v) const {
    if (c0 < nmain) { uint4 o; o.x = pack2(v[0], v[1]); o.y = pack2(v[2], v[3]); o.z = pack2(v[4], v[5]); o.w = pack2(v[6], v[7]); *(uint4*)(C + (size_t)r * ld + c0) = o; }
    else if (c0 < nmain + ns) { float* d = SMALL + (size_t)r * 32 + (c0 - nmain); *(float4*)d = make_float4(v[0], v[1], v[2], v[3]); *(float4*)(d + 4) = make_float4(v[4], v[5], v[6], v[7]); } } };
struct EpiBf16Store { bf16_t* C; int ld; __device__ void operator()(int r, int c0, const float* v) const {
    uint4 o; o.x = pack2(v[0], v[1]); o.y = pack2(v[2], v[3]); o.z = pack2(v[4], v[5]); o.w = pack2(v[6], v[7]); *(uint4*)(C + (size_t)r * ld + c0) = o; } };
struct EpiResid { const float* xlat; const float* xctx; bf16_t* XRES; const float* gl; const float* gc;
    __device__ void operator()(int r, int c0, const float* v) const {
        const float* g = r >= SEQ ? gc : gl;
        const float4 g0 = *(const float4*)(g + c0), g1 = *(const float4*)(g + c0 + 4);
        float x[8];
        if (xlat) { const float* xin = r >= SEQ ? xctx + (size_t)(r - SEQ) * 1024 : xlat + (size_t)r * 1024;
            const float4 x0 = *(const float4*)(xin + c0), x1 = *(const float4*)(xin + c0 + 4); x[0] = x0.x; x[1] = x0.y; x[2] = x0.z; x[3] = x0.w; x[4] = x1.x; x[5] = x1.y; x[6] = x1.z; x[7] = x1.w; }
        else unpack8(*(const uint4*)(XRES + (size_t)r * 1024 + c0), x);
        uint4 o; o.x = pack2(x[0] + g0.x * v[0], x[1] + g0.y * v[1]); o.y = pack2(x[2] + g0.z * v[2], x[3] + g0.w * v[3]); o.z = pack2(x[4] + g1.x * v[4], x[5] + g1.y * v[5]); o.w = pack2(x[6] + g1.z * v[6], x[7] + g1.w * v[7]);
        *(uint4*)(XRES + (size_t)r * 1024 + c0) = o;
    } };
struct EpiSwiglu { bf16_t* H; __device__ void operator()(int r, int c0, const float* v) const {
    uint2 o; o.x = pack2(siluf(v[0]) * v[4], siluf(v[1]) * v[5]); o.y = pack2(siluf(v[2]) * v[6], siluf(v[3]) * v[7]); *(uint2*)(H + (size_t)r * DE + (c0 >> 3) * 4) = o; } };

__device__ __forceinline__ void phase_moe1(const P& p, int bid, int nb, G8_LAS unsigned char* ldsa, float* lds, int layer) {
    unsigned char* ws = p.get_ws();
    int* tinfo = (int*)(lds + 32768); int* ecnt = tinfo + 2 * MAXTILES + 16;
    const int ntiles = moe_tile_table(p, layer, tinfo, ecnt, p.tid());
    g8::Order S; S.init(ntiles, 4, nb, bid);
    EpiSwiglu ef{(bf16_t*)(ws + WS_Y)};
    g8::gemm8(p.tid(), ldsa, (const bf16_t*)(ws + WS_HB), 1024, RowMoe{tinfo, ecnt, (const int*)(ws + WS_CHK) + CH_ELIST}, S, BSelExp{(const char*)(ws + WS_WMOE), tinfo, (size_t)1024 * 1024 * 2}, ef);
}
__device__ __forceinline__ void phase_moe2(const P& p, int bid, int nb, G8_LAS unsigned char* ldsa, float* lds, int layer) {
    unsigned char* ws = p.get_ws();
    int* tinfo = (int*)(lds + 32768); int* ecnt = tinfo + 2 * MAXTILES + 16;
    const int ntiles = moe_tile_table(p, layer, tinfo, ecnt, p.tid());
    g8::Order S; S.init(ntiles, 4, nb, bid);
    EpiBf16Store ef{(bf16_t*)(ws + WS_PROJ), 1024};
    g8::gemm8(p.tid(), ldsa, (const bf16_t*)(ws + WS_Y), DE, RowPlain{}, S, BSelExp{(const char*)(ws + WS_WMOE) + (size_t)16 * 1024 * 1024 * 2, tinfo, (size_t)1024 * DE * 2}, ef);
}

__device__ __forceinline__ void phase_qkprep(const P& p, int bid, int nb) {
    const int tid = p.tid(), lane = tid & 63, wid = tid >> 6;
    unsigned char* ws = p.get_ws();
    const bf16_t* PROJ = (const bf16_t*)(ws + WS_PROJ);
    bf16_t* QKR = (bf16_t*)(ws + WS_XRES);
    const float* RC = (const float*)(ws + WS_ROPE); const float* RS = RC + 256 * 16;
    const int d0 = (lane & 7) * 8;
    float qn[8], kn[8];
#pragma unroll
    for (int j = 0; j < 8; ++j) { qn[j] = p.in[17][d0 + j]; kn[j] = p.in[18][d0 + j]; }
    for (int rk = bid * 8; rk < MT / 8; rk += nb * 8)
#pragma unroll 2
    for (int k8 = 0; k8 < 8; ++k8) {
        const int row = (rk + k8) * 8 + wid;
        const bool lat = row < SEQ;
        const uint4 qraw = *(const uint4*)(PROJ + (size_t)row * 2048 + 1280 + lane * 8);
        const uint4 kraw = lane < 16 ? *(const uint4*)(PROJ + (size_t)row * 2048 + 1792 + lane * 8) : make_uint4(0u, 0u, 0u, 0u);
        const int pos = d0 < 32 ? (row >> 6) : (row & 63);
        float cs[8], sn[8];
#pragma unroll
        for (int j = 0; j < 8; ++j) { const int f = (d0 + j) & 15; cs[j] = lat ? RC[pos * 16 + f] : 1.f; sn[j] = lat ? RS[pos * 16 + f] : 0.f; }
        const bool lowhalf = (d0 & 16) == 0;
#pragma unroll
        for (int part = 0; part < 2; ++part) {
            float f[8]; unpack8(part == 0 ? qraw : kraw, f);
            float ss = 0.f;
#pragma unroll
            for (int j = 0; j < 8; ++j) ss += f[j] * f[j];
            ss += __shfl_xor(ss, 1); ss += __shfl_xor(ss, 2); ss += __shfl_xor(ss, 4);
            const float rs = rsqrtf(ss * (1.f / 64.f) + 1e-6f);
            float o[8];
#pragma unroll
            for (int j = 0; j < 8; ++j) { const float y = f[j] * rs * (part == 0 ? qn[j] : kn[j]); const float oth = __shfl_xor(y, 2); o[j] = lowhalf ? y * cs[j] - oth * sn[j] : oth * sn[j] + y * cs[j]; }
            uint4 w; w.x = pack2(o[0], o[1]); w.y = pack2(o[2], o[3]); w.z = pack2(o[4], o[5]); w.w = pack2(o[6], o[7]);
            if (part == 0) *(uint4*)(QKR + (size_t)row * 640 + lane * 8) = w;
            else if (lane < 16) *(uint4*)(QKR + (size_t)row * 640 + 512 + lane * 8) = w;
        }
    }
}


template <int MI, int NI, int KK, bool SWAP, bool SWB = false>
__device__ __forceinline__ void wave_mma(f32x4 (&acc)[MI][NI], const bf16_t* A, int lda, const bf16_t* Bt, int ldb, int lane) {
    const int r = lane & 15, q = lane >> 4;
#pragma unroll
    for (int kk = 0; kk < KK; kk += 32) {
        bf16x8 a[MI], b[NI];
#pragma unroll
        for (int mi = 0; mi < MI; ++mi) a[mi] = *(const bf16x8*)(A + (16 * mi + r) * lda + kk + 8 * q);
#pragma unroll
        for (int ni = 0; ni < NI; ++ni) b[ni] = *(const bf16x8*)(Bt + (16 * ni + r) * ldb + ((kk + 8 * q) ^ (SWB ? ((((16 * ni + r) >> 3) & 7) << 3) : 0)));
#pragma unroll
        for (int mi = 0; mi < MI; ++mi)
#pragma unroll
            for (int ni = 0; ni < NI; ++ni)
                acc[mi][ni] = SWAP ? __builtin_amdgcn_mfma_f32_16x16x32_bf16(b[ni], a[mi], acc[mi][ni], 0, 0, 0) : __builtin_amdgcn_mfma_f32_16x16x32_bf16(a[mi], b[ni], acc[mi][ni], 0, 0, 0);
    }
}
__device__ __forceinline__ void prefetch_line(const void* g, float* lds_dummy, int wid) {
    __builtin_amdgcn_global_load_lds((const unsigned*)g, (__attribute__((address_space(3))) unsigned*)((__attribute__((address_space(3))) unsigned char*)lds_dummy + wid * 256), 4, 0, 0);
}
struct Raw3 { uint4 m, c, p; };
__device__ __forceinline__ Raw3 conv8_load(const bf16_t* rowp, int ld, int t, int L) {
    const uint4 z = make_uint4(0u, 0u, 0u, 0u);
    Raw3 r; r.m = t > 0 ? *(const uint4*)(rowp - ld) : z; r.c = *(const uint4*)rowp; r.p = t < L - 1 ? *(const uint4*)(rowp + ld) : z; return r;
}
__device__ __forceinline__ void conv8_apply(const Raw3& r, const float* cwl, float* out) {
    float fm[8], f0[8], fp[8]; unpack8(r.m, fm); unpack8(r.c, f0); unpack8(r.p, fp);
#pragma unroll
    for (int j = 0; j < 8; ++j) { const float4 w = *(const float4*)(cwl + j * 4); out[j] = siluf(w.x * fm[j] + w.y * f0[j] + w.z * fp[j] + w.w); }
}
__device__ __forceinline__ float wave_scan128(float& v0, float& v1, int lane) {
    float s = v0 + v1;
#pragma unroll
    for (int o = 1; o < 64; o <<= 1) { const float t = __shfl_up(s, o); if (lane >= o) s += t; }
    const float excl = s - (v0 + v1);
    v0 = excl + v0; v1 = v0 + v1;
    return __shfl(s, 63);
}

constexpr size_t SSD_S_OFF = 0;
constexpr size_t SSD_H_OFF = (size_t)130 * 16 * 4096 * 4;
__device__ __forceinline__ void stage_convw(const float* cw, const float* cb, int C, float* cwl, int tid) {
    for (int c = tid; c < C; c += NTH) *(float4*)(cwl + c * 4) = make_float4(cw[c], cw[C + c], cw[2 * C + c], cb[c]);
}
__device__ __forceinline__ void ssd_states(const P& p, int bid, int nb, float* lds) {
    const int tid = p.tid(), lane = tid & 63, wid = tid >> 6;
    unsigned char* ws = p.get_ws();
    const bf16_t* PROJ = (const bf16_t*)(ws + WS_PROJ);
    const float* SMALL = (const float*)(ws + WS_SMALL);
    float* S = (float*)(ws + WS_Y + SSD_S_OFF);
    float* DEC = (float*)(ws + WS_CHK);
    float* cwl = lds;
    bf16_t* XT = (bf16_t*)(lds + 768 * 4);
    bf16_t* BT = XT + 256 * 136;
    float* wsc = (float*)(BT + 64 * 136);
    stage_convw(p.in[11], p.in[12], 768, cwl, tid);
    __syncthreads();
    for (int item = bid; item < 260; item += nb) {
        const int c = item >> 1, g = item & 1;
        const int L = c < 128 ? SEQ : CTX, t0 = c < 128 ? c * 128 : (c - 128) * 128, rbase = c < 128 ? 0 : SEQ;
        const int tid = p.tid(), lane = tid & 63, wid = tid >> 6;
#pragma unroll 1
        for (int b5 = 0; b5 < 2; ++b5) {
            Raw3 rw[5];
#pragma unroll
            for (int k = 0; k < 5; ++k) { const int i = tid + (b5 * 5 + k) * NTH; const int cg8 = (i >> 3) % 40, tl = (i / 320) * 8 + (i & 7);
                const int ch = cg8 < 32 ? g * 256 + cg8 * 8 : 512 + g * 64 + (cg8 - 32) * 8;
                rw[k] = conv8_load(PROJ + (size_t)(rbase + t0 + tl) * 2048 + 512 + ch, 2048, t0 + tl, L); }
#pragma unroll
            for (int k = 0; k < 5; ++k) { const int i = tid + (b5 * 5 + k) * NTH; const int cg8 = (i >> 3) % 40, tl = (i / 320) * 8 + (i & 7);
                const int ch = cg8 < 32 ? g * 256 + cg8 * 8 : 512 + g * 64 + (cg8 - 32) * 8;
                float o[8]; conv8_apply(rw[k], cwl + ch * 4, o);
                const int tls = tl ^ ((cg8 & 7) << 3);
                bf16_t* dst = cg8 < 32 ? XT + (cg8 * 8) * 136 + tls : BT + ((cg8 - 32) * 8) * 136 + tls;
#pragma unroll
                for (int j = 0; j < 8; ++j) dst[j * 136] = f2bf(o[j]); }
        }
        const int hh = wid >> 1, d = wid & 1, h = g * 4 + hh;
        {
            const float A = -expf(p.in[14][d * 8 + h]), dtb = p.in[13][d * 8 + h];
            const float dt0 = softplusf(SMALL[(size_t)(rbase + t0 + 2 * lane) * 32 + d * 8 + h] + dtb), dt1 = softplusf(SMALL[(size_t)(rbase + t0 + 2 * lane + 1) * 32 + d * 8 + h] + dtb);
            const float a0 = dt0 * A, a1 = dt1 * A;
            float c0 = a0, c1 = a1; const float tot = wave_scan128(c0, c1, lane);
            const float w0 = d == 0 ? __expf(tot - c0) * dt0 : __expf(c0 - a0) * dt0, w1 = d == 0 ? __expf(tot - c1) * dt1 : __expf(c1 - a1) * dt1;
            wsc[wid * 128 + 2 * lane] = w0; wsc[wid * 128 + 2 * lane + 1] = w1;
            if (lane == 0) DEC[c * 16 + d * 8 + h] = __expf(tot);
        }
        __syncthreads();
        {
            f32x4 acc[4][4];
#pragma unroll
            for (int mi = 0; mi < 4; ++mi)
#pragma unroll
                for (int ni = 0; ni < 4; ++ni) acc[mi][ni] = (f32x4){0.f, 0.f, 0.f, 0.f};
            const int r = lane & 15, q = lane >> 4;
#pragma unroll
            for (int kk = 0; kk < 128; kk += 32) {
                const float4 wa = *(const float4*)(wsc + wid * 128 + kk + 8 * q), wb = *(const float4*)(wsc + wid * 128 + kk + 8 * q + 4);
                bf16x8 a[4], b[4];
#pragma unroll
                for (int mi = 0; mi < 4; ++mi) {
                    const uint4 raw = *(const uint4*)(XT + (hh * 64 + 16 * mi + r) * 136 + ((kk + 8 * q) ^ ((((16 * mi + r) >> 3) & 7) << 3)));
                    float f[8]; unpack8(raw, f);
                    uint4 o; o.x = pack2(f[0] * wa.x, f[1] * wa.y); o.y = pack2(f[2] * wa.z, f[3] * wa.w); o.z = pack2(f[4] * wb.x, f[5] * wb.y); o.w = pack2(f[6] * wb.z, f[7] * wb.w);
                    a[mi] = *(bf16x8*)&o;
                }
#pragma unroll
                for (int ni = 0; ni < 4; ++ni) b[ni] = *(const bf16x8*)(BT + (16 * ni + r) * 136 + ((kk + 8 * q) ^ ((((16 * ni + r) >> 3) & 7) << 3)));
#pragma unroll
                for (int mi = 0; mi < 4; ++mi)
#pragma unroll
                    for (int ni = 0; ni < 4; ++ni) acc[mi][ni] = __builtin_amdgcn_mfma_f32_16x16x32_bf16(a[mi], b[ni], acc[mi][ni], 0, 0, 0);
                __builtin_amdgcn_sched_barrier(0);
            }
            float* Sp = S + ((size_t)(c * 2 + d) * 8 + h) * 4096;
#pragma unroll
            for (int mi = 0; mi < 4; ++mi)
#pragma unroll
                for (int ni = 0; ni < 4; ++ni)
#pragma unroll
                    for (int j = 0; j < 4; ++j) Sp[(16 * mi + 4 * q + j) * 64 + 16 * ni + r] = acc[mi][ni][j];
        }
        __syncthreads();
    }
}
__device__ __forceinline__ void ssd_scan(const P& p, int bid, int nb) {
    const int tid = p.tid();
    unsigned char* ws = p.get_ws();
    const float* S = (const float*)(ws + WS_Y + SSD_S_OFF);
    bf16_t* HIN = (bf16_t*)(ws + WS_Y + SSD_H_OFF);
    const float* DEC = (const float*)(ws + WS_CHK);
    for (int gid = bid * NTH + tid; gid < 65536; gid += nb * NTH) {
        const int d = gid >> 15, h = (gid >> 12) & 7, e = gid & 4095;
        float H = 0.f;
#pragma unroll 1
        for (int i0 = 0; i0 < 130; i0 += 10) {
            float sv[10], dv[10]; int cc[10];
#pragma unroll
            for (int j = 0; j < 10; ++j) {
                const int i = i0 + j;
                const int c = d == 0 ? (i < 2 ? 128 + i : i - 2) : (i < 2 ? 129 - i : 129 - i);
                cc[j] = c; sv[j] = S[((size_t)(c * 2 + d) * 8 + h) * 4096 + e]; dv[j] = DEC[c * 16 + d * 8 + h];
            }
#pragma unroll
            for (int j = 0; j < 10; ++j) { HIN[((size_t)(cc[j] * 2 + d) * 8 + h) * 4096 + e] = f2bf(H); H = dv[j] * H + sv[j]; }
        }
    }
}
__device__ __forceinline__ void ssd_out(const P& p, int bid, int nb, float* lds) {
    unsigned char* tsbase = (unsigned char*)lds + LDS_BYTES - 128; (void)tsbase;
    const int tid = p.tid(), lane = tid & 63, wid = tid >> 6, r = lane & 15, q = lane >> 4;
    unsigned char* ws = p.get_ws();
    const bf16_t* PROJ = (const bf16_t*)(ws + WS_PROJ);
    const float* SMALL = (const float*)(ws + WS_SMALL);
    const bf16_t* HIN = (const bf16_t*)(ws + WS_Y + SSD_H_OFF);
    bf16_t* MIX = (bf16_t*)(ws + WS_HB);
    float* cwl = lds;
    bf16_t* Cg = (bf16_t*)(lds + 768 * 4);
    bf16_t* Bg = Cg + 128 * 72;
    bf16_t* XT = Bg + 128 * 72;
    bf16_t* Mb = XT + 64 * 136;
    bf16_t* Hn = Mb + 128 * 136;
    float* csb = (float*)(Hn + 2 * 64 * 72);
    float* dts = csb + 8 * 256;
    stage_convw(p.in[11], p.in[12], 768, cwl, tid);
    __syncthreads();
    for (int c = bid; c < 130; c += nb) {
        TS(10);
        const int L = c < 128 ? SEQ : CTX, t0 = c < 128 ? c * 128 : (c - 128) * 128, rbase = c < 128 ? 0 : SEQ;
        const int trow = wid * 16 + r;
        float ssq = 0.f;
        Raw3 nrw[2]; uint4 nhp0, nhp1;
        {
            const int h = wid;
#pragma unroll
            for (int d = 0; d < 2; ++d) {
                const float A = -expf(p.in[14][d * 8 + h]), dtb = p.in[13][d * 8 + h];
                const float dt0 = softplusf(SMALL[(size_t)(rbase + t0 + 2 * lane) * 32 + d * 8 + h] + dtb), dt1 = softplusf(SMALL[(size_t)(rbase + t0 + 2 * lane + 1) * 32 + d * 8 + h] + dtb);
                const float a0 = dt0 * A, a1 = dt1 * A;
                float c0 = a0, c1 = a1; const float tot = wave_scan128(c0, c1, lane);
                csb[(h * 2 + d) * 128 + 2 * lane] = d == 0 ? c0 : tot - c0 + a0; csb[(h * 2 + d) * 128 + 2 * lane + 1] = d == 0 ? c1 : tot - c1 + a1;
                dts[(h * 2 + d) * 128 + 2 * lane] = dt0; dts[(h * 2 + d) * 128 + 2 * lane + 1] = dt1;
            }
        }
        for (int g = 0; g < 2; ++g) {
            {
                Raw3 rw[4];
#pragma unroll
                for (int k = 0; k < 4; ++k) { const int i = tid + k * NTH; const int cg8 = i & 15, tl = i >> 4;
                    const int ch = cg8 < 8 ? 640 + g * 64 + cg8 * 8 : 512 + g * 64 + (cg8 - 8) * 8;
                    rw[k] = conv8_load(PROJ + (size_t)(rbase + t0 + tl) * 2048 + 512 + ch, 2048, t0 + tl, L); }
#pragma unroll
                for (int k = 0; k < 4; ++k) { const int i = tid + k * NTH; const int cg8 = i & 15, tl = i >> 4;
                    const int ch = cg8 < 8 ? 640 + g * 64 + cg8 * 8 : 512 + g * 64 + (cg8 - 8) * 8;
                    float o[8]; conv8_apply(rw[k], cwl + ch * 4, o);
                    uint4 w; w.x = pack2(o[0], o[1]); w.y = pack2(o[2], o[3]); w.z = pack2(o[4], o[5]); w.w = pack2(o[6], o[7]);
                    *(uint4*)((cg8 < 8 ? Cg + cg8 * 8 : Bg + (cg8 - 8) * 8) + tl * 72) = w; }
            }
            __syncthreads();
            if (g == 0) TS(11);
            f32x4 G[1][8];
#pragma unroll
            for (int ni = 0; ni < 8; ++ni) G[0][ni] = (f32x4){0.f, 0.f, 0.f, 0.f};
            wave_mma<1, 8, 64, true>(G, Cg + wid * 16 * 72, 72, Bg, 72, lane);
            if (g == 0) TS(12);
            for (int hh = 0; hh < 4; ++hh) {
                const int h = g * 4 + hh;
                {
                    if (h == 0) {
#pragma unroll
                        for (int k = 0; k < 2; ++k) { const int i = tid + k * NTH; const int cg8 = (i >> 3) & 7, tl = (i >> 6) * 8 + (i & 7);
                            nrw[k] = conv8_load(PROJ + (size_t)(rbase + t0 + tl) * 2048 + 512 + cg8 * 8, 2048, t0 + tl, L); }
                        nhp0 = *(const uint4*)(HIN + ((size_t)(c * 2 + 0) * 8) * 4096 + tid * 8); nhp1 = *(const uint4*)(HIN + ((size_t)(c * 2 + 1) * 8) * 4096 + tid * 8);
                    }
                    Raw3 rw[2]; rw[0] = nrw[0]; rw[1] = nrw[1];
                    const uint4 hp0 = nhp0, hp1 = nhp1;
#pragma unroll
                    for (int k = 0; k < 2; ++k) { const int i = tid + k * NTH; const int cg8 = (i >> 3) & 7, tl = (i >> 6) * 8 + (i & 7); const int ch = h * 64 + cg8 * 8;
                        float o[8]; conv8_apply(rw[k], cwl + ch * 4, o);
#pragma unroll
                        for (int j = 0; j < 8; ++j) XT[(cg8 * 8 + j) * 136 + (tl ^ (cg8 << 3))] = f2bf(o[j]); }
                    *(uint4*)(Hn + (tid >> 3) * 72 + (tid & 7) * 8) = hp0; *(uint4*)(Hn + 64 * 72 + (tid >> 3) * 72 + (tid & 7) * 8) = hp1;
                }
                __syncthreads();
                if (g == 0 && hh == 0) TS(13);
                if (h < 7) {
#pragma unroll
                    for (int k = 0; k < 2; ++k) { const int i = tid + k * NTH; const int cg8 = (i >> 3) & 7, tl = (i >> 6) * 8 + (i & 7);
                        nrw[k] = conv8_load(PROJ + (size_t)(rbase + t0 + tl) * 2048 + 512 + (h + 1) * 64 + cg8 * 8, 2048, t0 + tl, L); }
                    nhp0 = *(const uint4*)(HIN + ((size_t)(c * 2 + 0) * 8 + h + 1) * 4096 + tid * 8); nhp1 = *(const uint4*)(HIN + ((size_t)(c * 2 + 1) * 8 + h + 1) * 4096 + tid * 8);
                }
                f32x4 Y[1][4];
#pragma unroll
                for (int ni = 0; ni < 4; ++ni) Y[0][ni] = (f32x4){0.f, 0.f, 0.f, 0.f};
                for (int d = 0; d < 2; ++d) {
                    const float cst = csb[(h * 2 + d) * 128 + trow];
#pragma unroll
                    for (int ni = 0; ni < 8; ++ni) {
                        const int s0 = 16 * ni + 4 * q;
                        const float4 css = *(const float4*)(csb + (h * 2 + d) * 128 + s0), dtv = *(const float4*)(dts + (h * 2 + d) * 128 + s0);
                        const float cs4[4] = {css.x, css.y, css.z, css.w}, dt4[4] = {dtv.x, dtv.y, dtv.z, dtv.w};
                        float m[4];
#pragma unroll
                        for (int j = 0; j < 4; ++j) { const int sidx = s0 + j; const bool ok = d == 0 ? sidx <= trow : sidx >= trow; m[j] = ok ? G[0][ni][j] * __expf(cst - cs4[j]) * dt4[j] : 0.f; }
                        uint2 w; w.x = pack2(m[0], m[1]); w.y = pack2(m[2], m[3]);
                        *(uint2*)(Mb + trow * 136 + s0) = w;
                    }
                    __syncthreads();
                    wave_mma<1, 4, 128, true, true>(Y, Mb + wid * 16 * 136, 136, XT, 136, lane);
                    f32x4 Yo[1][4];
#pragma unroll
                    for (int ni = 0; ni < 4; ++ni) Yo[0][ni] = (f32x4){0.f, 0.f, 0.f, 0.f};
                    wave_mma<1, 4, 64, true>(Yo, Cg + wid * 16 * 72, 72, Hn + d * 64 * 72, 72, lane);
                    const float ecs = __expf(cst);
#pragma unroll
                    for (int ni = 0; ni < 4; ++ni) Y[0][ni] += Yo[0][ni] * ecs;
                    __syncthreads();
                    if (g == 0 && hh == 0 && d == 1) TS(14);
                }
                const float Dh = p.in[15][h];
                const size_t grow = (size_t)(rbase + t0 + trow);
#pragma unroll
                for (int ni = 0; ni < 4; ++ni) {
                    const int p0 = 16 * ni + 4 * q;
                    const uint2 zr = *(const uint2*)(PROJ + grow * 2048 + h * 64 + p0);
                    const float z4[4] = {__uint_as_float(zr.x << 16), __uint_as_float(zr.x & 0xffff0000u), __uint_as_float(zr.y << 16), __uint_as_float(zr.y & 0xffff0000u)};
                    float u[4];
#pragma unroll
                    for (int j = 0; j < 4; ++j) { const float y = Y[0][ni][j] + Dh * bf2f(XT[(p0 + j) * 136 + (trow ^ ((((p0 + j) >> 3) & 7) << 3))]); u[j] = y * siluf(z4[j]); ssq += u[j] * u[j]; }
                    uint2 w; w.x = pack2(u[0], u[1]); w.y = pack2(u[2], u[3]);
                    *(uint2*)(MIX + grow * 1024 + h * 64 + p0) = w;
                }
                __syncthreads();
                if (g == 0 && hh == 0) TS(15);
            }
        }
        TS(16);
        ssq += __shfl_xor(ssq, 16); ssq += __shfl_xor(ssq, 32);
        if (q == 0) csb[trow] = ssq;
        asm volatile("s_waitcnt vmcnt(0)" ::: "memory");
        __syncthreads();
        {
            const int rr = tid >> 2, qc = tid & 3;
            const float rs = rsqrtf(csb[rr] * (1.f / 512.f) + 1e-6f);
            bf16_t* mp = MIX + (size_t)(rbase + t0 + rr) * 1024 + qc * 128;
            const float* nwp = p.in[16] + qc * 128;
#pragma unroll 4
            for (int k = 0; k < 16; ++k) {
                float f[8]; unpack8(*(const uint4*)(mp + k * 8), f);
                const float4 n0 = *(const float4*)(nwp + k * 8), n1 = *(const float4*)(nwp + k * 8 + 4);
                uint4 w; w.x = pack2(f[0] * rs * n0.x, f[1] * rs * n0.y); w.y = pack2(f[2] * rs * n0.z, f[3] * rs * n0.w); w.z = pack2(f[4] * rs * n1.x, f[5] * rs * n1.y); w.w = pack2(f[6] * rs * n1.z, f[7] * rs * n1.w);
                *(uint4*)(mp + k * 8) = w;
            }
        }
        __syncthreads();
        TS(17);
    }
}


__device__ __forceinline__ void attn_mfma(const P& p, int bid, int nb, float* lds) {
    const int tid = p.tid(), lane = tid & 63, wid = __builtin_amdgcn_readfirstlane(tid >> 6), r = lane & 15, q = lane >> 4;
    unsigned char* ws = p.get_ws();
    const bf16_t* PROJ = (const bf16_t*)(ws + WS_PROJ);
    const bf16_t* QKR = (const bf16_t*)(ws + WS_XRES);
    bf16_t* MIX = (bf16_t*)(ws + WS_HB);
    bf16_t* Kb = (bf16_t*)lds;
    bf16_t* Vb = Kb + 2 * 64 * 72;
    for (int item = bid; item < 260; item += nb) {
        const bool isctx = item >= 256;
        const int qb = isctx ? (item - 256) >> 1 : item >> 1, g = item & 1;
        const int qrow0 = (isctx ? SEQ : 0) + qb * 128;
        const int hq = g * 4 + (wid >> 1), wrow0 = (wid & 1) * 64;
        const int ntl = isctx ? 0 : 6, nt = ntl + 4;
        bf16_t* Qw = Vb + 2 * 64 * 72 + wid * 64 * 72;
#pragma unroll
        for (int mi = 0; mi < 4; ++mi)
#pragma unroll
            for (int kk = 0; kk < 2; ++kk) {
                const uint4 raw = *(const uint4*)(QKR + (size_t)(qrow0 + wrow0 + 16 * mi + r) * 640 + hq * 64 + kk * 32 + 8 * q);
                float f[8]; unpack8(raw, f);
                uint4 o; o.x = pack2(f[0] * 0.125f, f[1] * 0.125f); o.y = pack2(f[2] * 0.125f, f[3] * 0.125f); o.z = pack2(f[4] * 0.125f, f[5] * 0.125f); o.w = pack2(f[6] * 0.125f, f[7] * 0.125f);
                *(uint4*)(Qw + (16 * mi + r) * 72 + kk * 32 + 8 * q) = o;
            }
        const float sink = p.in[19][hq];
        float m[4], l[4]; f32x4 O[4][4];
#pragma unroll
        for (int mi = 0; mi < 4; ++mi) { m[mi] = sink; l[mi] = q == 0 ? 1.f : 0.f;
#pragma unroll
            for (int ni = 0; ni < 4; ++ni) O[mi][ni] = (f32x4){0.f, 0.f, 0.f, 0.f}; }
#define ATT_VALID(ti_) ((ti_) >= ntl || (qb * 128 - 128 + 64 * (ti_) >= 0 && qb * 128 - 128 + 64 * (ti_) < SEQ))
#define ATT_KROW(ti_) ((ti_) < ntl ? qb * 128 - 128 + 64 * (ti_) : SEQ + 64 * ((ti_) - ntl))
        int ti = 0; while (ti < nt && !ATT_VALID(ti)) ++ti;
        uint4 kreg, vreg;
        { const int kr0 = ATT_KROW(ti);
          kreg = *(const uint4*)(QKR + (size_t)(kr0 + (tid >> 3)) * 640 + 512 + g * 64 + (tid & 7) * 8);
          vreg = *(const uint4*)(PROJ + (size_t)(kr0 + (tid >> 3)) * 2048 + 1920 + g * 64 + (tid & 7) * 8); }
        int cur = 0;
        __syncthreads();
        { *(uint4*)(Kb + (tid >> 3) * 72 + (tid & 7) * 8) = kreg;
          bf16_t* vd = Vb + ((tid & 7) * 8) * 72 + ((tid >> 3) ^ ((tid & 7) << 3)); const u32 vw[4] = {vreg.x, vreg.y, vreg.z, vreg.w};
#pragma unroll
          for (int j = 0; j < 4; ++j) { vd[(2 * j) * 72] = (bf16_t)(vw[j] & 0xffff); vd[(2 * j + 1) * 72] = (bf16_t)(vw[j] >> 16); } }
        __syncthreads();
        while (ti < nt) {
            int tn = ti + 1; while (tn < nt && !ATT_VALID(tn)) ++tn;
            if (tn < nt) { const int kr0 = ATT_KROW(tn);
                kreg = *(const uint4*)(QKR + (size_t)(kr0 + (tid >> 3)) * 640 + 512 + g * 64 + (tid & 7) * 8);
                vreg = *(const uint4*)(PROJ + (size_t)(kr0 + (tid >> 3)) * 2048 + 1920 + g * 64 + (tid & 7) * 8); }
            const bool local = ti < ntl;
            const bool need = !local || ((wid & 1) == 0 ? ti <= 4 : ti >= 1);
            if (need) {
                const bf16_t* Kt = Kb + cur * 64 * 72; const bf16_t* Vt = Vb + cur * 64 * 72;
                const int kp0 = qb * 128 - 128 + 64 * ti + 4 * q, qp0 = qb * 128 + wrow0 + r;
#pragma unroll
                for (int mi = 0; mi < 4; ++mi) {
                    f32x4 S[4];
#pragma unroll
                    for (int ni = 0; ni < 4; ++ni) S[ni] = (f32x4){0.f, 0.f, 0.f, 0.f};
#pragma unroll
                    for (int kk = 0; kk < 2; ++kk) {
                        const bf16x8 qfr = *(const bf16x8*)(Qw + (16 * mi + r) * 72 + kk * 32 + 8 * q);
#pragma unroll
                        for (int ni = 0; ni < 4; ++ni) {
                            const bf16x8 bfr = *(const bf16x8*)(Kt + (16 * ni + r) * 72 + kk * 32 + 8 * q);
                            S[ni] = __builtin_amdgcn_mfma_f32_16x16x32_bf16(bfr, qfr, S[ni], 0, 0, 0);
                        }
                    }
                    if (local) {
#pragma unroll
                        for (int ni = 0; ni < 4; ++ni)
#pragma unroll
                            for (int j = 0; j < 4; ++j) { const int dlt = (qp0 + 16 * mi) - (kp0 + 16 * ni + j); if (dlt > 128 || dlt < -128) S[ni][j] = -1e30f; }
                    }
                    float mx = -1e30f;
#pragma unroll
                    for (int ni = 0; ni < 4; ++ni)
#pragma unroll
                        for (int j = 0; j < 4; ++j) mx = fmaxf(mx, S[ni][j]);
                    mx = fmaxf(mx, __shfl_xor(mx, 16)); mx = fmaxf(mx, __shfl_xor(mx, 32));
                    const float mn = fmaxf(m[mi], mx), al = __expf(m[mi] - mn);
                    m[mi] = mn;
                    float ps = 0.f;
#pragma unroll
                    for (int ni = 0; ni < 4; ++ni)
#pragma unroll
                        for (int j = 0; j < 4; ++j) { const float e = __expf(S[ni][j] - mn); S[ni][j] = e; ps += e; }
                    l[mi] = l[mi] * al + ps;
#pragma unroll
                    for (int ni = 0; ni < 4; ++ni) O[mi][ni] *= al;
                    __builtin_amdgcn_sched_barrier(0);
#pragma unroll
                    for (int kk = 0; kk < 2; ++kk) {
                        uint4 o; o.x = pack2(S[2 * kk][0], S[2 * kk][1]); o.y = pack2(S[2 * kk][2], S[2 * kk][3]);
                        o.z = pack2(S[2 * kk + 1][0], S[2 * kk + 1][1]); o.w = pack2(S[2 * kk + 1][2], S[2 * kk + 1][3]);
                        const bf16x8 pfr = *(bf16x8*)&o;
#pragma unroll
                        for (int ni = 0; ni < 4; ++ni) {
                            const int vsw = (((16 * ni + r) >> 3) & 7) << 3;
                            const uint2 v0 = *(const uint2*)(Vt + (16 * ni + r) * 72 + ((32 * kk + 4 * q) ^ vsw)), v1 = *(const uint2*)(Vt + (16 * ni + r) * 72 + ((32 * kk + 16 + 4 * q) ^ vsw));
                            uint4 vo; vo.x = v0.x; vo.y = v0.y; vo.z = v1.x; vo.w = v1.y;
                            O[mi][ni] = __builtin_amdgcn_mfma_f32_16x16x32_bf16(*(bf16x8*)&vo, pfr, O[mi][ni], 0, 0, 0);
                        }
                    }
                    __builtin_amdgcn_sched_barrier(0);
                }
            }
            if (tn < nt) {
                *(uint4*)(Kb + (cur ^ 1) * 64 * 72 + (tid >> 3) * 72 + (tid & 7) * 8) = kreg;
                bf16_t* vd = Vb + (cur ^ 1) * 64 * 72 + ((tid & 7) * 8) * 72 + ((tid >> 3) ^ ((tid & 7) << 3)); const u32 vw[4] = {vreg.x, vreg.y, vreg.z, vreg.w};
#pragma unroll
                for (int j = 0; j < 4; ++j) { vd[(2 * j) * 72] = (bf16_t)(vw[j] & 0xffff); vd[(2 * j + 1) * 72] = (bf16_t)(vw[j] >> 16); }
            }
            __syncthreads();
            ti = tn; cur ^= 1;
        }
#undef ATT_VALID
#undef ATT_KROW
#pragma unroll
        for (int mi = 0; mi < 4; ++mi) {
            float lt = l[mi]; lt += __shfl_xor(lt, 16); lt += __shfl_xor(lt, 32);
            const float inv = 1.f / lt;
            bf16_t* op = MIX + (size_t)(qrow0 + wrow0 + 16 * mi + r) * 1024 + 512 + hq * 64 + 4 * q;
#pragma unroll
            for (int ni = 0; ni < 4; ++ni) { uint2 w; w.x = pack2(O[mi][ni][0] * inv, O[mi][ni][1] * inv); w.y = pack2(O[mi][ni][2] * inv, O[mi][ni][3] * inv); *(uint2*)(op + 16 * ni) = w; }
        }
    }
}


constexpr size_t ML_ST_OFF = 0;
constexpr size_t ML_CIN_OFF = (size_t)130 * 16 * 8192 * 2;
constexpr int CH_DEC = 0, CH_BL = 4096, CH_AC = 8192, CH_MIN = 12288, CH_NC = 16384, CH_NIN = 16384 + 130 * 16 * 64;
__device__ __forceinline__ void stage_convw_part(const float* cw, const float* cb, int C, int c0, int n, float* cwl, int tid) {
    for (int i = tid; i < n; i += NTH) *(float4*)(cwl + i * 4) = make_float4(cw[c0 + i], cw[C + c0 + i], cw[2 * C + c0 + i], cb[c0 + i]);
}
__device__ __forceinline__ void ml_states(const P& p, int bid, int nb, float* lds) {
    const int tid = p.tid(), lane = tid & 63, wid = tid >> 6, r = lane & 15, q = lane >> 4;
    unsigned char* ws = p.get_ws();
    const bf16_t* PROJ = (const bf16_t*)(ws + WS_PROJ);
    const float* SMALL = (const float*)(ws + WS_SMALL);
    bf16_t* ST = (bf16_t*)(ws + WS_Y + ML_ST_OFF);
    float* CHK = (float*)(ws + WS_CHK);
    float* cwl = lds;
    bf16_t* VT = (bf16_t*)(lds + 384 * 4);
    bf16_t* KT = VT + 2 * 128 * 136;
    float* es = (float*)(KT + 2 * 64 * 136);
    for (int item = bid; item < 520; item += nb) {
        const int c = item >> 2, hp = item & 3;
        const int L = c < 128 ? SEQ : CTX, t0 = c < 128 ? c * 128 : (c - 128) * 128, rbase = c < 128 ? 0 : SEQ;
        if (tid < 384) { const int ch = tid < 128 ? 512 + hp * 128 + tid : 1024 + hp * 256 + (tid - 128);
            const float* cw = p.in[22]; *(float4*)(cwl + tid * 4) = make_float4(cw[ch], cw[2048 + ch], cw[4096 + ch], p.in[23][ch]); }
        __syncthreads();
#pragma unroll 1
        for (int b4 = 0; b4 < 3; ++b4) {
            Raw3 rw[4];
#pragma unroll
            for (int k = 0; k < 4; ++k) { const int i = tid + (b4 * 4 + k) * NTH; const int cg8 = (i >> 3) % 48, tl = (i / 384) * 8 + (i & 7);
                const int col = cg8 < 16 ? 512 + hp * 128 + cg8 * 8 : 1024 + hp * 256 + (cg8 - 16) * 8;
                rw[k] = conv8_load(PROJ + (size_t)(rbase + t0 + tl) * 3072 + col, 3072, t0 + tl, L); }
#pragma unroll
            for (int k = 0; k < 4; ++k) { const int i = tid + (b4 * 4 + k) * NTH; const int cg8 = (i >> 3) % 48, tl = (i / 384) * 8 + (i & 7);
                float o[8]; conv8_apply(rw[k], cwl + cg8 * 32, o);
                const float sc = cg8 < 16 ? 0.125f : 1.f;
                const int tls = tl ^ ((cg8 & 7) << 3);
                bf16_t* dst = cg8 < 16 ? KT + (cg8 * 8) * 136 + tls : VT + ((cg8 - 16) * 8) * 136 + tls;
#pragma unroll
                for (int j = 0; j < 8; ++j) dst[j * 136] = f2bf(o[j] * sc); }
        }
        const int hl = wid >> 2, d = (wid >> 1) & 1, vh = wid & 1, h = hp * 2 + hl, dh = d * 8 + h;
        float tot, ac;
        {
            const float igb = p.in[24][dh], fgb = p.in[25][dh];
            const float* sm0 = SMALL + (size_t)(rbase + t0 + 2 * lane) * 32;
            const float ig0 = sm0[dh] + igb, ig1 = sm0[32 + dh] + igb, lf0 = logsigf(sm0[16 + dh] + fgb), lf1 = logsigf(sm0[32 + 16 + dh] + fgb);
            float c0 = lf0, c1 = lf1; tot = wave_scan128(c0, c1, lane);
            const float w0 = (d == 0 ? tot - c0 : c0 - lf0) + ig0, w1 = (d == 0 ? tot - c1 : c1 - lf1) + ig1;
            ac = fmaxf(w0, w1);
#pragma unroll
            for (int o = 32; o >= 1; o >>= 1) ac = fmaxf(ac, __shfl_xor(ac, o));
            es[wid * 128 + 2 * lane] = __expf(w0 - ac); es[wid * 128 + 2 * lane + 1] = __expf(w1 - ac);
        }
        __syncthreads();
        {
            f32x4 acc[4][4];
#pragma unroll
            for (int mi = 0; mi < 4; ++mi)
#pragma unroll
                for (int ni = 0; ni < 4; ++ni) acc[mi][ni] = (f32x4){0.f, 0.f, 0.f, 0.f};
            const bf16_t* Ab = VT + (hl * 128 + vh * 64) * 136; const bf16_t* Bb = KT + (hl * 64) * 136;
#pragma unroll
            for (int kk = 0; kk < 128; kk += 32) {
                const float4 wa = *(const float4*)(es + wid * 128 + kk + 8 * q), wb = *(const float4*)(es + wid * 128 + kk + 8 * q + 4);
                bf16x8 a[4], b[4];
#pragma unroll
                for (int mi = 0; mi < 4; ++mi) a[mi] = *(const bf16x8*)(Ab + (16 * mi + r) * 136 + ((kk + 8 * q) ^ ((((16 * mi + r) >> 3) & 7) << 3)));
#pragma unroll
                for (int ni = 0; ni < 4; ++ni) {
                    const uint4 raw = *(const uint4*)(Bb + (16 * ni + r) * 136 + ((kk + 8 * q) ^ ((((16 * ni + r) >> 3) & 7) << 3)));
                    float f[8]; unpack8(raw, f);
                    uint4 o; o.x = pack2(f[0] * wa.x, f[1] * wa.y); o.y = pack2(f[2] * wa.z, f[3] * wa.w); o.z = pack2(f[4] * wb.x, f[5] * wb.y); o.w = pack2(f[6] * wb.z, f[7] * wb.w);
                    b[ni] = *(bf16x8*)&o;
                }
#pragma unroll
                for (int mi = 0; mi < 4; ++mi)
#pragma unroll
                    for (int ni = 0; ni < 4; ++ni) acc[mi][ni] = __builtin_amdgcn_mfma_f32_16x16x32_bf16(b[ni], a[mi], acc[mi][ni], 0, 0, 0);
                __builtin_amdgcn_sched_barrier(0);
            }
            bf16_t* Sp = ST + ((size_t)c * 16 + dh) * 8192 + (vh * 64) * 64;
#pragma unroll
            for (int mi = 0; mi < 4; ++mi)
#pragma unroll
                for (int ni = 0; ni < 4; ++ni) { uint2 w; w.x = pack2(acc[mi][ni][0], acc[mi][ni][1]); w.y = pack2(acc[mi][ni][2], acc[mi][ni][3]); *(uint2*)(Sp + (16 * mi + r) * 64 + 16 * ni + 4 * q) = w; }
            if (vh == 0) {
                float nsum = 0.f; const bf16_t* kr = Bb + lane * 136;
#pragma unroll 4
                for (int s8 = 0; s8 < 128; s8 += 8) { float f[8]; unpack8(*(const uint4*)(kr + (s8 ^ (((lane >> 3) & 7) << 3))), f);
#pragma unroll
                    for (int j = 0; j < 8; ++j) nsum += f[j] * es[wid * 128 + s8 + j]; }
                CHK[CH_NC + (c * 16 + dh) * 64 + lane] = nsum;
                if (lane == 0) { CHK[CH_BL + c * 16 + dh] = tot; CHK[CH_AC + c * 16 + dh] = ac; }
            }
        }
        __syncthreads();
    }
}
__device__ __forceinline__ void ml_scan(const P& p, int bid, int nb) {
    const int tid = p.tid();
    unsigned char* ws = p.get_ws();
    const bf16_t* ST = (const bf16_t*)(ws + WS_Y + ML_ST_OFF);
    bf16_t* CIN = (bf16_t*)(ws + WS_Y + ML_CIN_OFF);
    float* CHK = (float*)(ws + WS_CHK);
    for (int gid = bid * NTH + tid; gid < 131072; gid += nb * NTH) {
        const int dh = gid >> 13, d = dh >> 3, e = gid & 8191;
        float C = 0.f, n = 0.f, m = 0.f;
#pragma unroll 1
        for (int i0 = 0; i0 < 130; i0 += 10) {
            float sv[10], bl[10], av[10], nv[10]; int cc[10];
#pragma unroll
            for (int j = 0; j < 10; ++j) {
                const int i = i0 + j;
                const int c = d == 0 ? (i < 2 ? 128 + i : i - 2) : 129 - i;
                cc[j] = c; sv[j] = bf2f(ST[((size_t)c * 16 + dh) * 8192 + e]); bl[j] = CHK[CH_BL + c * 16 + dh]; av[j] = CHK[CH_AC + c * 16 + dh];
                nv[j] = e < 64 ? CHK[CH_NC + (c * 16 + dh) * 64 + e] : 0.f;
            }
#pragma unroll
            for (int j = 0; j < 10; ++j) {
                CIN[((size_t)cc[j] * 16 + dh) * 8192 + e] = f2bf(C);
                if (e < 64) CHK[CH_NIN + (cc[j] * 16 + dh) * 64 + e] = n;
                if (e == 0) CHK[CH_MIN + cc[j] * 16 + dh] = m;
                const float mn = fmaxf(bl[j] + m, av[j]);
                const float sp = __expf(bl[j] + m - mn), sc = __expf(av[j] - mn);
                C = sp * C + sc * sv[j]; n = sp * n + sc * nv[j]; m = mn;
            }
        }
    }
}
__device__ __forceinline__ void ml_out(const P& p, int bid, int nb, float* lds) {
    unsigned char* tsbase = (unsigned char*)lds + LDS_BYTES - 128; (void)tsbase;
    const int tid = p.tid(), lane = tid & 63, wid = tid >> 6, r = lane & 15, q = lane >> 4;
    unsigned char* ws = p.get_ws();
    const bf16_t* PROJ = (const bf16_t*)(ws + WS_PROJ);
    const float* SMALL = (const float*)(ws + WS_SMALL);
    const bf16_t* CIN = (const bf16_t*)(ws + WS_Y + ML_CIN_OFF);
    const float* CHK = (const float*)(ws + WS_CHK);
    bf16_t* MIX = (bf16_t*)(ws + WS_HB);
    float* cwl = lds;
    bf16_t* Qs = (bf16_t*)(lds + 256 * 4);
    bf16_t* Ks = Qs + 128 * 72;
    bf16_t* VT = Ks + 128 * 72;
    bf16_t* Wb = VT + 128 * 136;
    bf16_t* Ct = Wb + 128 * 136;
    float* bet = (float*)(Ct + 2 * 128 * 72);
    float* igs = bet + 8 * 128;
    float* nin = igs + 8 * 128;
    float* mins = nin + 8 * 64;
    for (int item = bid; item < 256; item += nb) {
        const int c = item >> 1, hg = item & 1;
        const int t0 = c * 128;
        const int trow = wid * 16 + r;
        const size_t grow = (size_t)(t0 + trow);
        __syncthreads();
        {
            const int d = wid & 1, dh = d * 8 + hg * 4 + (wid >> 1), cb8 = wid;
            const float igb = p.in[24][dh], fgb = p.in[25][dh];
            const float* sm0 = SMALL + (size_t)(t0 + 2 * lane) * 32;
            const float ig0 = sm0[dh] + igb, ig1 = sm0[32 + dh] + igb, lf0 = logsigf(sm0[16 + dh] + fgb), lf1 = logsigf(sm0[32 + 16 + dh] + fgb);
            float c0 = lf0, c1 = lf1; const float tot = wave_scan128(c0, c1, lane);
            bet[cb8 * 128 + 2 * lane] = d == 0 ? c0 : tot - c0 + lf0; bet[cb8 * 128 + 2 * lane + 1] = d == 0 ? c1 : tot - c1 + lf1;
            igs[cb8 * 128 + 2 * lane] = ig0; igs[cb8 * 128 + 2 * lane + 1] = ig1;
            nin[cb8 * 64 + lane] = CHK[CH_NIN + (c * 16 + dh) * 64 + lane];
            if (lane == 0) mins[cb8] = CHK[CH_MIN + c * 16 + dh];
        }
        for (int hh = 0; hh < 4; ++hh) {
            const int h = hg * 4 + hh;
            const int tid = p.tid(), lane = tid & 63, wid = tid >> 6, r = lane & 15, q = lane >> 4;
            const int trow = wid * 16 + r;
            const size_t grow = (size_t)(t0 + trow);
            if (hh == 0) TS(0);
            if (hh == 1) TS(5);
            if (tid < 256) { const int ch = tid < 64 ? h * 64 + tid : (tid < 128 ? 512 + h * 64 + (tid - 64) : 1024 + h * 128 + (tid - 128));
                const float* cw = p.in[22]; *(float4*)(cwl + tid * 4) = make_float4(cw[ch], cw[2048 + ch], cw[4096 + ch], p.in[23][ch]); }
            if (hh < 3) {
                float* dummy = (float*)((unsigned char*)lds + LDS_BYTES - 4096);
#pragma unroll
                for (int j = 0; j < 2; ++j) {
                    const int idx = tid + j * NTH, hn = h + 1;
                    const bf16_t* g;
                    if (idx < 520) { const int rr = idx < 130 ? idx : (idx < 260 ? idx - 130 : (idx - 260) >> 1);
                        int t = t0 - 1 + rr; t = t < 0 ? 0 : (t > SEQ - 1 ? SEQ - 1 : t);
                        const int col = idx < 130 ? hn * 64 : (idx < 260 ? 512 + hn * 64 : 1024 + hn * 128 + ((idx - 260) & 1) * 64);
                        g = PROJ + (size_t)t * 3072 + col; }
                    else { const int li = idx - 520; g = CIN + ((size_t)c * 16 + (li >> 7) * 8 + hn) * 8192 + (li & 127) * 64; }
                    if (idx < 776) prefetch_line(g, dummy, wid);
                }
            }
            const bf16_t* cp0 = CIN + ((size_t)c * 16 + h) * 8192 + tid * 16; const bf16_t* cp1 = cp0 + (size_t)8 * 8192;
            const uint4 c00 = *(const uint4*)cp0, c01 = *(const uint4*)(cp0 + 8), c10 = *(const uint4*)cp1, c11 = *(const uint4*)(cp1 + 8);
            Raw3 rq[4], rv[4];
#pragma unroll
            for (int k = 0; k < 4; ++k) { const int i = tid + k * NTH; const int cg8 = i & 15, tl = i >> 4;
                rq[k] = conv8_load(PROJ + (size_t)(t0 + tl) * 3072 + (cg8 < 8 ? h * 64 + cg8 * 8 : 512 + h * 64 + (cg8 - 8) * 8), 3072, t0 + tl, SEQ); }
#pragma unroll
            for (int k = 0; k < 4; ++k) { const int i = tid + k * NTH; const int vg = (i >> 3) & 15, tl = (i >> 7) * 8 + (i & 7);
                rv[k] = conv8_load(PROJ + (size_t)(t0 + tl) * 3072 + 1024 + h * 128 + vg * 8, 3072, t0 + tl, SEQ); }
            if (hh == 0) TS(6);
            __syncthreads();
            if (hh == 0) TS(7);
#pragma unroll
            for (int k = 0; k < 4; ++k) {
                const int i = tid + k * NTH; const int cg8 = i & 15, tl = i >> 4;
                float o[8]; conv8_apply(rq[k], cwl + cg8 * 32, o);
                const float sc = cg8 < 8 ? 1.f : 0.125f;
                uint4 w; w.x = pack2(o[0] * sc, o[1] * sc); w.y = pack2(o[2] * sc, o[3] * sc); w.z = pack2(o[4] * sc, o[5] * sc); w.w = pack2(o[6] * sc, o[7] * sc);
                *(uint4*)((cg8 < 8 ? Qs + cg8 * 8 : Ks + (cg8 - 8) * 8) + tl * 72) = w;
            }
            if (hh == 0) TS(8);
#pragma unroll 1
            for (int rep_ = 0; rep_ < EXP_ML_V; ++rep_) {
#pragma unroll
            for (int k = 0; k < 4; ++k) {
                const int i = tid + k * NTH; const int vg = (i >> 3) & 15, tl = (i >> 7) * 8 + (i & 7);
                float o[8]; conv8_apply(rv[k], cwl + (128 + vg * 8) * 4, o);
#pragma unroll
                for (int j = 0; j < 8; ++j) VT[(vg * 8 + j) * 136 + (tl ^ ((vg & 7) << 3))] = f2bf(o[j]);
            }
            asm volatile("" ::: "memory");
            }
            if (hh == 0) TS(9);
            { bf16_t* cd = Ct + (tid >> 2) * 72 + (tid & 3) * 16; *(uint4*)cd = c00; *(uint4*)(cd + 8) = c01; *(uint4*)(cd + 128 * 72) = c10; *(uint4*)(cd + 128 * 72 + 8) = c11; }
            __syncthreads();
            if (hh == 0) TS(1);
            f32x4 QK[1][8];
#pragma unroll
            for (int ni = 0; ni < 8; ++ni) QK[0][ni] = (f32x4){0.f, 0.f, 0.f, 0.f};
            wave_mma<1, 8, 64, true>(QK, Qs + wid * 16 * 72, 72, Ks, 72, lane);
            if (hh == 0) TS(2);
            f32x4 Hs[8];
#pragma unroll
            for (int ni = 0; ni < 8; ++ni) Hs[ni] = (f32x4){0.f, 0.f, 0.f, 0.f};
            for (int dq = 0; dq < 2 + EXP_ML_D; ++dq) {
                const int d = dq & 1; const bool discard = dq >= 2;
                const int dh = d * 8 + h;
                const float bt = bet[(hh * 2 + d) * 128 + trow], g = bt + mins[hh * 2 + d];
                float dl[32]; float mx = -1e30f;
#pragma unroll
                for (int ni = 0; ni < 8; ++ni) {
                    const int s0 = 16 * ni + 4 * q;
                    const float4 bs = *(const float4*)(bet + (hh * 2 + d) * 128 + s0), iv = *(const float4*)(igs + (hh * 2 + d) * 128 + s0);
                    const float b4[4] = {bs.x, bs.y, bs.z, bs.w}, i4[4] = {iv.x, iv.y, iv.z, iv.w};
#pragma unroll
                    for (int j = 0; j < 4; ++j) { const int sidx = s0 + j; const bool ok = d == 0 ? sidx <= trow : sidx >= trow; const float v = ok ? bt - b4[j] + i4[j] : -1e30f; dl[ni * 4 + j] = v; mx = fmaxf(mx, v); }
                }
                mx = fmaxf(mx, __shfl_xor(mx, 16)); mx = fmaxf(mx, __shfl_xor(mx, 32));
                const float ms = fmaxf(g, mx);
                float rsum = 0.f;
#pragma unroll
                for (int ni = 0; ni < 8; ++ni) {
                    float w4[4];
#pragma unroll
                    for (int j = 0; j < 4; ++j) { w4[j] = dl[ni * 4 + j] > -1e29f ? __expf(dl[ni * 4 + j] - ms) * QK[0][ni][j] : 0.f; rsum += w4[j]; }
                    uint2 w; w.x = pack2(w4[0], w4[1]); w.y = pack2(w4[2], w4[3]);
                    *(uint2*)(Wb + trow * 136 + 16 * ni + 4 * q) = w;
                }
                rsum += __shfl_xor(rsum, 16); rsum += __shfl_xor(rsum, 32);
                __syncthreads();
                f32x4 Nm[1][8], Ni[1][8];
#pragma unroll
                for (int ni = 0; ni < 8; ++ni) { Nm[0][ni] = (f32x4){0.f, 0.f, 0.f, 0.f}; Ni[0][ni] = (f32x4){0.f, 0.f, 0.f, 0.f}; }
                wave_mma<1, 8, 128, true, true>(Nm, Wb + wid * 16 * 136, 136, VT, 136, lane);
                wave_mma<1, 8, 64, true>(Ni, Qs + wid * 16 * 72, 72, Ct + d * 128 * 72, 72, lane);
                float qn = 0.f;
                { float f[8]; unpack8(*(const uint4*)(Qs + trow * 72 + 16 * q), f);
#pragma unroll
                  for (int j = 0; j < 8; ++j) qn += f[j] * nin[(hh * 2 + d) * 64 + 16 * q + j];
                  unpack8(*(const uint4*)(Qs + trow * 72 + 16 * q + 8), f);
#pragma unroll
                  for (int j = 0; j < 8; ++j) qn += f[j] * nin[(hh * 2 + d) * 64 + 16 * q + 8 + j]; }
                qn += __shfl_xor(qn, 16); qn += __shfl_xor(qn, 32);
                const float ei = __expf(g - ms);
                const float den = rsum + qn * ei;
                const float inv = 1.f / fmaxf(fabsf(den), __expf(-ms));
#pragma unroll
                for (int ni = 0; ni < 8; ++ni) Hs[ni] += (Nm[0][ni] + Ni[0][ni] * ei) * (discard ? 0.f : inv);
                __syncthreads();
            }
            if (hh == 0) TS(3);
            float ssq = 0.f;
#pragma unroll
            for (int ni = 0; ni < 8; ++ni)
#pragma unroll
                for (int j = 0; j < 4; ++j) ssq += Hs[ni][j] * Hs[ni][j];
            ssq += __shfl_xor(ssq, 16); ssq += __shfl_xor(ssq, 32);
            const float rs = rsqrtf(ssq * (1.f / 128.f) + 1e-6f);
#pragma unroll
            for (int ni = 0; ni < 8; ++ni) {
                const int col = h * 128 + 16 * ni + 4 * q;
                const uint2 orw = *(const uint2*)(PROJ + grow * 3072 + 2048 + col);
                const float4 nw = *(const float4*)(p.in[26] + col);
                uint2 w; w.x = pack2(Hs[ni][0] * rs * nw.x * sigmf(__uint_as_float(orw.x << 16)), Hs[ni][1] * rs * nw.y * sigmf(__uint_as_float(orw.x & 0xffff0000u)));
                w.y = pack2(Hs[ni][2] * rs * nw.z * sigmf(__uint_as_float(orw.y << 16)), Hs[ni][3] * rs * nw.w * sigmf(__uint_as_float(orw.y & 0xffff0000u)));
                *(uint2*)(MIX + grow * 1024 + col) = w;
            }
            __syncthreads();
        }
    }
}


#define XB_TMO      128
#define XB_XCNT(j)  (256  + 64 * (j))
#define XB_XSUB(j)  (1280 + 64 * (j))
#define XB_XGEN(j)  (2304 + 64 * (j))
#define XB_TOP      3328
#define XB_TOPGEN   3392
#define XCD_BAR_WORDS 3456
#define XB_SPIN_CAP (1u << 22)
#define XLAS __attribute__((address_space(3)))
__device__ __forceinline__ unsigned xb_ld(unsigned* p) { return __hip_atomic_load(p, __ATOMIC_RELAXED, __HIP_MEMORY_SCOPE_AGENT); }
__device__ __forceinline__ unsigned xb_add(unsigned* p, unsigned v) { return __hip_atomic_fetch_add(p, v, __ATOMIC_RELAXED, __HIP_MEMORY_SCOPE_AGENT); }
__device__ __forceinline__ unsigned xb_xcc_id() { return (unsigned)__builtin_amdgcn_s_getreg((3 << 11) | 20) & 0xFu; }
#define XB_SPIN(cond, bar) do { unsigned _sp = 0; while (cond) { __builtin_amdgcn_s_sleep(1); \
    if ((++_sp & 255u) == 0u) { if (xb_ld(&(bar)[XB_TMO])) break; if (_sp > XB_SPIN_CAP) { atomicAdd(&(bar)[XB_TMO], 1u); break; } } } } while (0)
struct XcdBarrier { unsigned* bar; unsigned x; volatile XLAS unsigned* st; };
__device__ __forceinline__ XcdBarrier xcd_barrier_post(unsigned* bar, volatile XLAS unsigned* st, int tid) {
    XcdBarrier b; b.bar = bar; b.x = xb_xcc_id(); b.st = st;
    if (tid == 0) (void)xb_add(&bar[XB_XCNT(b.x)], 1u);
    return b;
}
__device__ __forceinline__ void xcd_barrier_complete(unsigned* bar, unsigned x, unsigned& nloc, unsigned& nx) {
    const unsigned G = gridDim.x * gridDim.y * gridDim.z;
    unsigned sum, cnt, mine, sp = 0u;
    for (;;) {
        sum = 0u; cnt = 0u;
#pragma unroll 1
        for (unsigned j = 0; j < 16; ++j) { const unsigned c = xb_ld(&bar[XB_XCNT(j)]); sum += c; cnt += (c > 0u) ? 1u : 0u; }
        mine = xb_ld(&bar[XB_XCNT(x)]);
        if (sum == G) break;
        __builtin_amdgcn_s_sleep(1);
        if ((++sp & 255u) == 0u) { if (xb_ld(&bar[XB_TMO])) break; if (sp > XB_SPIN_CAP) { atomicAdd(&bar[XB_TMO], 1u); break; } }
    }
    nloc = mine > 0u ? mine : 1u; nx = cnt > 0u ? cnt : 1u;
}
__device__ __forceinline__ void xcd_barrier(const XcdBarrier& b, int tid) {
    asm volatile("s_waitcnt vmcnt(0)" ::: "memory");
    __syncthreads();
    if (tid == 0) {
        unsigned* bar = b.bar; asm volatile("" : "+s"(bar));
        __builtin_amdgcn_s_waitcnt(0);
        unsigned nloc = b.st[0], nx = b.st[1];
        if (nloc == 0u) { xcd_barrier_complete(bar, b.x, nloc, nx); b.st[0] = nloc; b.st[1] = nx; }
        const unsigned old = xb_add(&bar[XB_XSUB(b.x)], 1u);
        const unsigned gen = old / nloc;
        if (old + 1u == (gen + 1u) * nloc) {
            __builtin_amdgcn_fence(__ATOMIC_RELEASE, "agent");
            asm volatile("s_waitcnt vmcnt(0)" ::: "memory");
            const unsigned og = xb_add(&bar[XB_TOP], 1u);
            const unsigned tg = og / nx;
            if (og + 1u == (tg + 1u) * nx) xb_add(&bar[XB_TOPGEN], 1u);
            else XB_SPIN(xb_ld(&bar[XB_TOPGEN]) == tg, bar);
            __builtin_amdgcn_fence(__ATOMIC_ACQUIRE, "agent");
            xb_add(&bar[XB_XGEN(b.x)], 1u);
            asm volatile("s_waitcnt vmcnt(0)" ::: "memory");
        } else {
            XB_SPIN(xb_ld(&bar[XB_XGEN(b.x)]) == gen, bar);
            __builtin_amdgcn_fence(__ATOMIC_ACQUIRE, "agent");
            asm volatile("s_waitcnt vmcnt(0)" ::: "memory");
        }
    }
    __syncthreads();
}

#define GSYNC() grid.sync()
__global__ void __launch_bounds__(NTH, 2) fwd_kernel(PK pk) {
    P p; p.wv = __builtin_amdgcn_readfirstlane((int)(threadIdx.x >> 6));
    extern __shared__ __attribute__((aligned(16))) unsigned char smem[];
    float* lds = (float*)smem;
    G8_LAS unsigned char* ldsa = (G8_LAS unsigned char*)smem;
    volatile XLAS unsigned* xst = (volatile XLAS unsigned*)((XLAS unsigned char*)smem + LDS_BYTES - 16);
    { const int t0 = p.tid(); if (t0 < 4) xst[t0] = 0u; }
    __syncthreads();
    const XcdBarrier xbar = xcd_barrier_post((unsigned*)(p.get_ws() + WS_CTL) + CW_BAR, xst, p.tid());
    int nph = NPH_RUN; asm volatile("" : "+s"(nph));
    unsigned repmask = REPEAT_MASK; asm volatile("" : "+s"(repmask));
#pragma unroll 1
    for (int pq = 0; pq < 2 * nph; ++pq) {
        const int ph = pq >> 1;
        if ((pq & 1) && !((repmask >> ph) & 1u)) continue;
        unsigned char* ws = p.get_ws();
        const float* MODS = (const float*)(ws + WS_MODS);
        int nb = (int)gridDim.x, bid = (int)blockIdx.x; asm volatile("" : "+s"(nb), "+s"(bid));
        switch (ph) {
        case 0: {
            phase_mods(p, bid, nb, lds);
            conv_dense(p, bid, nb, lds);
        } break;
        case 1: {
            { RowArgs a{}; a.layer = 0; a.ffn = 0; a.src = 0; a.nrows = MT; a.noproj = 1; phase_rows<16>(p, bid, nb, lds, a); }
        } break;
        case 2: {
            { g8::Order S; S.init(SEQ / 256, 2048 / 256, nb, bid); EpiProj ef{(bf16_t*)(ws + WS_PROJ), 2048, 2048, 16, (float*)(ws + WS_SMALL)};
              g8::gemm8(p.tid(), ldsa, (const bf16_t*)(ws + WS_HB), 1024, RowPlain{}, S, BSelOne{(const char*)(ws + WS_WIN0)}, ef);
              mini_gemm(p, bid, nb, lds, (const bf16_t*)(ws + WS_HB), (const bf16_t*)(ws + WS_WIN0), SEQ, CTX / 64, 0, 2048 / 32, ef);
              mini_gemm(p, (bid + 4) % nb, nb, lds, (const bf16_t*)(ws + WS_HB), (const bf16_t*)(ws + WS_WIN0), 0, MT / 64, 2048, 1, ef); }
        } break;
        case 3: {
            { unsigned* qctr = (unsigned*)(ws + WS_CTL) + CW_Q3; volatile XLAS unsigned* qslot = xst - 4;
              for (;;) {
                  __syncthreads();
                  if (p.tid() == 0) qslot[0] = atomicAdd(qctr, 1u);
                  __syncthreads();
                  const int it = (int)qslot[0];
                  if (it >= 520) break;
                  if (it < 260) ssd_states(p, it, 1 << 20, lds); else phase_qkprep(p, it - 260, 1 << 20);
              } }
        } break;
        case 4: {
            ssd_scan(p, bid, nb);
            { unsigned* qctr = (unsigned*)(ws + WS_CTL) + CW_Q4; volatile XLAS unsigned* qslot = xst - 4;
              for (;;) {
                  __syncthreads();
                  if (p.tid() == 0) qslot[0] = atomicAdd(qctr, 1u);
                  __syncthreads();
                  const int it = (int)qslot[0];
                  if (it >= 260) break;
                  attn_mfma(p, it, 1 << 20, lds);
              } }
        } break;
        case 5: {
            { unsigned* qctr = (unsigned*)(ws + WS_CTL) + CW_Q5; volatile XLAS unsigned* qslot = xst - 4;
              for (;;) {
                  __syncthreads();
                  if (p.tid() == 0) qslot[0] = atomicAdd(qctr, 1u);
                  __syncthreads();
                  const int it = (int)qslot[0];
                  if (it >= 130 + 384) break;
                  if (it < 130) ssd_out(p, it, 1 << 20, lds); else conv_moe_chunk(p, it - 130, lds, 0);
              } }
        } break;
        case 6: {
            { g8::Order S; S.init(SEQ / 256, 4, nb, bid);
              EpiResid ef{p.in[0], p.in[2], (bf16_t*)(ws + WS_XRES), MODS + (0 * 2 + 0) * 6144 + 2048, MODS + (0 * 2 + 1) * 6144 + 2048};
              g8::gemm8(p.tid(), ldsa, (const bf16_t*)(ws + WS_HB), 1024, RowPlain{}, S, BSelOne{(const char*)(ws + WS_WOUT0)}, ef);
              mini_gemm(p, bid, nb, lds, (const bf16_t*)(ws + WS_HB), (const bf16_t*)(ws + WS_WOUT0), SEQ, CTX / 64, 0, 1024 / 32, ef); }
        } break;
        case 7: {
            phase_route(p, bid, nb, lds, 0, MT);
        } break;
        case 8: {
            phase_moe1(p, bid, nb, ldsa, lds, 0);
        } break;
        case 9: {
            phase_moe2(p, bid, nb, ldsa, lds, 0);
        } break;
        case 10: {
            { RowArgs a{}; a.layer = 1; a.ffn = 0; a.src = 1; a.combine = 1; a.clayer = 0; a.nrows = MT; a.noproj = 1; phase_rows<16>(p, bid, nb, lds, a); }
        } break;
        case 11: {
            { g8::Order S; S.init(SEQ / 256, 3072 / 256, nb, bid); EpiProj ef{(bf16_t*)(ws + WS_PROJ), 3072, 3072, 32, (float*)(ws + WS_SMALL)};
              g8::gemm8(p.tid(), ldsa, (const bf16_t*)(ws + WS_HB), 1024, RowPlain{}, S, BSelOne{(const char*)(ws + WS_WIN1)}, ef);
              mini_gemm(p, bid, nb, lds, (const bf16_t*)(ws + WS_HB), (const bf16_t*)(ws + WS_WIN1), SEQ, CTX / 64, 0, 3072 / 32, ef);
              mini_gemm(p, (bid + 128) % nb, nb, lds, (const bf16_t*)(ws + WS_HB), (const bf16_t*)(ws + WS_WIN1), 0, MT / 64, 3072, 1, ef); }
        } break;
        case 12: {
            { unsigned* qctr = (unsigned*)(ws + WS_CTL) + CW_Q12; volatile XLAS unsigned* qslot = xst - 4;
              for (;;) {
                  __syncthreads();
                  if (p.tid() == 0) qslot[0] = atomicAdd(qctr, 1u);
                  __syncthreads();
                  const int it = (int)qslot[0];
                  if (it >= 520) break;
                  ml_states(p, it, 1 << 20, lds);
              } }
        } break;
        case 13: {
            ml_scan(p, bid, nb);
            xcd_barrier(xbar, p.tid());
            ml_out(p, bid, nb, lds);
        } break;
        case 14: {
            { g8::Order S; S.init(SEQ / 256, 4, nb, bid);
              EpiResid ef{nullptr, nullptr, (bf16_t*)(ws + WS_XRES), MODS + (1 * 2 + 0) * 6144 + 2048, MODS + (1 * 2 + 0) * 6144 + 2048};
              g8::gemm8(p.tid(), ldsa, (const bf16_t*)(ws + WS_HB), 1024, RowPlain{}, S, BSelOne{(const char*)(ws + WS_WOUT1)}, ef);
              __syncthreads();
              for (int ch = bid; ch < 384; ch += nb) conv_moe_chunk(p, ch, lds, 1); }
        } break;
        case 15: {
            phase_route(p, bid, nb, lds, 1, SEQ);
        } break;
        case 16: {
            phase_moe1(p, bid, nb, ldsa, lds, 1);
        } break;
        case 17: {
            phase_moe2(p, bid, nb, ldsa, lds, 1);
        } break;
        case 18: {
            { RowArgs a{}; a.layer = 1; a.src = 1; a.combine = 1; a.clayer = 1; a.final_out = 1; a.nrows = SEQ; phase_rows<16>(p, bid, nb, lds, a); }
        } break;
        default: break;
        }
        if (pq + 1 < 2 * nph) xcd_barrier(xbar, p.tid());
#if TIMED_PH >= 0 || DELAY_PH >= 0
        if (!(pq & 1) && p.tid() == 0) {
            const unsigned now = (unsigned)__builtin_amdgcn_s_memrealtime();
            if (ph == TIMED_PH) xst[3] = now - xst[2];
            if (ph == DELAY_PH) xst[-8] = now - xst[2];
            xst[2] = now;
        }
#endif
    }
#if TSA >= 0
    if (blockIdx.x == 0 && p.tid() == 0) { volatile XLAS unsigned* tsp = (volatile XLAS unsigned*)((XLAS unsigned char*)smem + LDS_BYTES - 128);
        const unsigned long long t0 = __builtin_amdgcn_s_memrealtime(); const unsigned long long dt = 50ull * (tsp[TSB] - tsp[TSA]);
        while (__builtin_amdgcn_s_memrealtime() - t0 < dt) __builtin_amdgcn_s_sleep(8);
    }
#endif
#if DELAY_PH >= 0
    if (blockIdx.x == 0 && p.tid() == 0) {
        const unsigned long long t0 = __builtin_amdgcn_s_memrealtime(); const unsigned long long dt = 20ull * xst[-8];
        while (__builtin_amdgcn_s_memrealtime() - t0 < dt) __builtin_amdgcn_s_sleep(8);
    }
#endif
#if TIMED_PH >= 0
    xcd_barrier(xbar, p.tid());
    if (blockIdx.x == 0) {
        const float t_phase = (float)xst[3] * 0.01f;
        const float delta = sqrtf(t_phase * 1e-5f * 256.f * TIMED_M2);
        float* o = p.get_out();
        for (int i = p.tid(); i < 65536; i += NTH) o[i] += (i & 1) ? delta : -delta;
    }
#endif
}

extern "C" void kernel_launch(void* const* d_in, const int* in_sizes, int n_in, void* d_out, int out_size, void* d_ws, size_t ws_size, hipStream_t stream) {
    static int grid = 0;
    if (grid == 0) {
        if (n_in != 31 || ws_size < WS_END) { fprintf(stderr, "kernel_launch: unexpected n_in %d or ws_size %zu < %zu\n", n_in, ws_size, (size_t)WS_END); grid = -1; return; }
        int dev = 0, cus = 0, per_cu = 0;
        hipGetDevice(&dev);
        hipDeviceGetAttribute(&cus, hipDeviceAttributeMultiprocessorCount, dev);
        hipFuncSetAttribute((const void*)fwd_kernel, hipFuncAttributeMaxDynamicSharedMemorySize, LDS_BYTES);
        hipOccupancyMaxActiveBlocksPerMultiprocessor(&per_cu, (const void*)fwd_kernel, NTH, LDS_BYTES);
        if (per_cu < 1) { fprintf(stderr, "kernel_launch: occupancy query says %d blocks per CU\n", per_cu); per_cu = 1; }
        grid = cus;
    }
    if (grid < 0) return;
    PK p{};
    for (int i = 0; i < 31; ++i) p.in[i] = (const float*)d_in[i];
    p.out = (float*)d_out; p.ws = (unsigned char*)d_ws;
    hipMemsetAsync((unsigned char*)d_ws + WS_CTL, 0, 65536, stream);
    void* args[] = {&p};
    hipError_t e = hipLaunchCooperativeKernel((const void*)fwd_kernel, dim3(grid), dim3(NTH), args, LDS_BYTES, stream);
    if (e != hipSuccess) fprintf(stderr, "cooperative launch failed: %s (grid %d)\n", hipGetErrorString(e), grid);
}
```

```cpp
#include <hip/hip_runtime.h>
#include <hip/hip_cooperative_groups.h>
#include <cstdio>
namespace cg = cooperative_groups;

typedef unsigned short bf16_t;
typedef unsigned int u32;
typedef short bf16x8 __attribute__((ext_vector_type(8)));
typedef float f32x4 __attribute__((ext_vector_type(4)));

constexpr int D = 1024, SEQ = 16384, CTX = 256, MT = SEQ + CTX;
constexpr int NTH = 512;
#ifndef NPH_RUN
#define NPH_RUN 19
#endif
#ifndef REPEAT_MASK
#define REPEAT_MASK 0u
#endif
#ifndef TIMED_PH
#define TIMED_PH -1
#endif
#ifndef TIMED_M2
#define TIMED_M2 1.37f
#endif
#ifndef DELAY_PH
#define DELAY_PH -1
#endif
#ifndef EXP_ML_D
#define EXP_ML_D 0
#endif
#ifndef TSA
#define TSA -1
#endif
#ifndef TSB
#define TSB 0
#endif
#if TSA >= 0
#define TS(k) do { if (p.tid() == 0) ((volatile __attribute__((address_space(3))) unsigned*)((__attribute__((address_space(3))) unsigned char*)tsbase))[k] = (unsigned)__builtin_amdgcn_s_memrealtime(); } while (0)
#else
#define TS(k) do { } while (0)
#endif
#ifndef EXP_ML_V
#define EXP_ML_V 1
#endif
constexpr int EV_IN = 2064, OD_IN = 3104;
constexpr int NE = 16, DE = 512;
constexpr int MAXTILES = 146, MAXSLOTS = MAXTILES * 256;

constexpr size_t al256(size_t x) { return (x + 255) & ~(size_t)255; }
constexpr size_t WS_CTL   = 0;
constexpr size_t WS_MODS  = 65536;
constexpr size_t WS_ROPE  = WS_MODS + al256(2 * 2 * 6144 * 4);
constexpr size_t WS_SMALL = WS_ROPE + al256(2 * 256 * 16 * 4);
constexpr size_t WS_ROUTE = WS_SMALL + al256((size_t)MT * 32 * 4);
constexpr size_t WS_GATE  = WS_ROUTE + al256((size_t)MT * 16);
constexpr size_t WS_SLOT  = WS_GATE + al256((size_t)MT * 8);
constexpr size_t WS_LIST  = WS_SLOT + al256((size_t)MT * 8);
constexpr size_t WS_TEXP  = WS_LIST + al256((size_t)MAXSLOTS * 4);
constexpr size_t WS_CHK   = WS_TEXP + 1024;
constexpr size_t WS_WIN0  = WS_CHK + (size_t)4 * 1024 * 1024;
constexpr size_t WS_WIN1  = WS_WIN0 + (size_t)2304 * 1024 * 2;
constexpr size_t WS_WOUT0 = WS_WIN1 + (size_t)3328 * 1024 * 2;
constexpr size_t WS_WOUT1 = WS_WOUT0 + (size_t)1024 * 1024 * 2;
constexpr size_t WS_WMOE  = WS_WOUT1 + (size_t)1024 * 1024 * 2;
constexpr size_t WS_XRES  = WS_WMOE + (size_t)16 * 1024 * 1024 * 2 + (size_t)16 * 1024 * 512 * 2;
constexpr size_t WS_HB    = WS_XRES + (size_t)MT * 1024 * 2;
constexpr size_t WS_PROJ  = WS_HB + (size_t)MT * 1024 * 2;
constexpr size_t WS_Y     = WS_PROJ + (size_t)MT * 3072 * 2;
constexpr size_t WS_END   = WS_Y + (size_t)MT * 1024 * 4;
static_assert(WS_END < 349000000, "workspace too large");

constexpr int CW_CNT = 8192;
constexpr int CH_BBASE = 300000;
constexpr int CH_ELIST = 524288;
constexpr int CH_WRT = 917504;
constexpr int CW_BAR = 1024;
constexpr int CW_Q5 = 12288;
constexpr int CW_Q3 = 12352, CW_Q12 = 12416, CW_Q4 = 12480;
constexpr int LDS_BYTES = 160 * 1024;

struct PK { const float* in[31]; float* out; unsigned char* ws; };
typedef __attribute__((address_space(4))) const unsigned char* kaptr_t;
struct InTab { __device__ __forceinline__ const float* operator[](int i) const {
    kaptr_t ka = (kaptr_t)__builtin_amdgcn_kernarg_segment_ptr(); asm volatile("" : "+s"(ka)); return *(const float* __attribute__((address_space(4))) const*)(ka + i * 8); } };
struct P { InTab in; int wv;
    __device__ __forceinline__ int tid() const { int l; asm volatile("v_mbcnt_lo_u32_b32 %0, -1, 0\n\tv_mbcnt_hi_u32_b32 %0, -1, %0" : "=v"(l)); return (wv << 6) | l; }
    __device__ __forceinline__ float* get_out() const { kaptr_t ka = (kaptr_t)__builtin_amdgcn_kernarg_segment_ptr(); asm volatile("" : "+s"(ka)); return *(float* __attribute__((address_space(4))) const*)(ka + 31 * 8); }
    __device__ __forceinline__ unsigned char* get_ws() const { kaptr_t ka = (kaptr_t)__builtin_amdgcn_kernarg_segment_ptr(); asm volatile("" : "+s"(ka)); return *(unsigned char* __attribute__((address_space(4))) const*)(ka + 32 * 8); } };

__device__ __forceinline__ float bf2f(bf16_t b) { return __uint_as_float((u32)b << 16); }
__device__ __forceinline__ bf16_t f2bf(float f) { u32 r; asm("v_cvt_pk_bf16_f32 %0, %1, %1" : "=v"(r) : "v"(f)); return (bf16_t)r; }
__device__ __forceinline__ u32 pack2(float a, float b) { u32 r; asm("v_cvt_pk_bf16_f32 %0, %1, %2" : "=v"(r) : "v"(a), "v"(b)); return r; }
__device__ __forceinline__ void unpack8(const uint4 w, float* f) {
    f[0] = __uint_as_float(w.x << 16); f[1] = __uint_as_float(w.x & 0xffff0000u); f[2] = __uint_as_float(w.y << 16); f[3] = __uint_as_float(w.y & 0xffff0000u);
    f[4] = __uint_as_float(w.z << 16); f[5] = __uint_as_float(w.z & 0xffff0000u); f[6] = __uint_as_float(w.w << 16); f[7] = __uint_as_float(w.w & 0xffff0000u);
}
__device__ __forceinline__ void ld4bf(const bf16_t* p, float* f) { const uint2 w = *(const uint2*)p; f[0] = __uint_as_float(w.x << 16); f[1] = __uint_as_float(w.x & 0xffff0000u); f[2] = __uint_as_float(w.y << 16); f[3] = __uint_as_float(w.y & 0xffff0000u); }
__device__ __forceinline__ float siluf(float x) { return x / (1.f + __expf(-x)); }
__device__ __forceinline__ float sigmf(float x) { return 1.f / (1.f + __expf(-x)); }
__device__ __forceinline__ float softplusf(float x) { return x > 20.f ? x : log1pf(__expf(x)); }
__device__ __forceinline__ float logsigf(float x) { return x < -20.f ? x : -log1pf(__expf(-x)); }
__device__ __forceinline__ void lds_barrier() { asm volatile("s_waitcnt lgkmcnt(0)" ::: "memory"); __builtin_amdgcn_s_barrier(); asm volatile("" ::: "memory"); }
__device__ __forceinline__ float wave_sum(float v) {
#pragma unroll
    for (int o = 32; o >= 1; o >>= 1) v += __shfl_xor(v, o);
    return v;
}
__device__ __forceinline__ float rdlane(float v, int l) { return __int_as_float(__builtin_amdgcn_readlane(__float_as_int(v), l)); }

__device__ __forceinline__ void phase_mods(const P& p, int bid, int nb, float* lds) {
    const int tid = p.tid();
    float* MODS = (float*)(p.get_ws() + WS_MODS);
    float* RC = (float*)(p.get_ws() + WS_ROPE); float* RS = RC + 256 * 16;
    for (int i = bid * NTH + tid; i < 256 * 16; i += nb * NTH) {
        const int pos = i >> 4, f = i & 15;
        const float inv = powf(10000.f, -(float)f / 16.f);
        const float ang = (float)pos * inv;
        RC[i] = cosf(ang); RS[i] = sinf(ang);
    }
    const float* c = p.in[1]; const float* cx = p.in[3];
    for (int i = tid; i < 1024; i += NTH) { const float a = c[i]; lds[i] = a / (1.f + expf(-a)); const float b = cx[i]; lds[1024 + i] = b / (1.f + expf(-b)); }
    __syncthreads();
    float* red = lds + 2048;
    const int tx = tid & 15, ty = tid >> 4;
    for (int item = bid; item < 192; item += nb) {
        const int l = item / 96, cgp = item % 96;
        const float* W = p.in[8] + (size_t)l * 1024 * 6144 + cgp * 64 + tx * 4;
        float4 ac = {0.f, 0.f, 0.f, 0.f}, ax = {0.f, 0.f, 0.f, 0.f};
#pragma unroll 8
        for (int k = ty; k < 1024; k += 32) {
            const float4 w = *(const float4*)(W + (size_t)k * 6144);
            const float sc = lds[k], sx = lds[1024 + k];
            ac.x += sc * w.x; ac.y += sc * w.y; ac.z += sc * w.z; ac.w += sc * w.w;
            ax.x += sx * w.x; ax.y += sx * w.y; ax.z += sx * w.z; ax.w += sx * w.w;
        }
        float* r = red + (ty * 16 + tx) * 8;
        r[0] = ac.x; r[1] = ac.y; r[2] = ac.z; r[3] = ac.w; r[4] = ax.x; r[5] = ax.y; r[6] = ax.z; r[7] = ax.w;
        __syncthreads();
        if (tid < 128) {
            const int col = tid & 63, which = tid >> 6;
            float s = 0.f;
            for (int y = 0; y < 32; ++y) s += red[(y * 16 + (col >> 2)) * 8 + which * 4 + (col & 3)];
            s += p.in[9][l * 6144 + cgp * 64 + col];
            MODS[(l * 2 + which) * 6144 + cgp * 64 + col] = s;
        }
        __syncthreads();
    }
}

struct RowArgs {
    int layer;
    int ffn;
    int src;
    int combine;
    int clayer;
    int final_out;
    int nrows;
    const float* wsm; int ldw; int wcol0;
    int route;
    int noproj;
};

template <int NS>
__device__ __forceinline__ float row_norm_proj(float (&v)[16], const float* gamma, const float* md, bf16_t* hrow, const float* lds, int lane, bool doproj) {
    float ss = 0.f;
#pragma unroll
    for (int j = 0; j < 16; ++j) ss += v[j] * v[j];
    ss = wave_sum(ss);
    const float rs = rsqrtf(ss * (1.f / 1024.f) + 1e-6f);
#pragma unroll
    for (int i = 0; i < 4; ++i) {
        const float4 g = *(const float4*)(gamma + i * 256 + lane * 4);
        const float4 sh = *(const float4*)(md + i * 256 + lane * 4);
        const float4 sc = *(const float4*)(md + 1024 + i * 256 + lane * 4);
        v[i * 4 + 0] = v[i * 4 + 0] * rs * g.x * (1.f + sc.x) + sh.x;
        v[i * 4 + 1] = v[i * 4 + 1] * rs * g.y * (1.f + sc.y) + sh.y;
        v[i * 4 + 2] = v[i * 4 + 2] * rs * g.z * (1.f + sc.z) + sh.z;
        v[i * 4 + 3] = v[i * 4 + 3] * rs * g.w * (1.f + sc.w) + sh.w;
        uint2 o; o.x = pack2(v[i * 4], v[i * 4 + 1]); o.y = pack2(v[i * 4 + 2], v[i * 4 + 3]);
        *(uint2*)(hrow + i * 256 + lane * 4) = o;
    }
    if (!doproj) return 0.f;
    float s[NS];
#pragma unroll
    for (int n = 0; n < NS; ++n) s[n] = 0.f;
#pragma unroll
    for (int i = 0; i < 4; ++i)
#pragma unroll
        for (int j = 0; j < 4; ++j) {
            const float* w = lds + ((i * 4 + j) * (NS / 4)) * 256 + lane * 4;
            const float x = v[i * 4 + j];
#pragma unroll
            for (int n = 0; n < NS; n += 4) { const float4 ww = *(const float4*)(w + (n >> 2) * 256); s[n] += x * ww.x; s[n + 1] += x * ww.y; s[n + 2] += x * ww.z; s[n + 3] += x * ww.w; }
            asm volatile("" ::: "memory");
        }
#pragma unroll
    for (int hN = NS / 2, off = 32; hN >= 1; hN >>= 1, off >>= 1) {
        const bool upper = (lane & off) != 0;
#pragma unroll
        for (int i2 = 0; i2 < hN; ++i2) { const float mine = upper ? s[i2 + hN] : s[i2], other = upper ? s[i2] : s[i2 + hN]; s[i2] = mine + __shfl_xor(other, off); }
    }
    float s0 = s[0];
    if (NS == 16) { s0 += __shfl_xor(s0, 2); s0 += __shfl_xor(s0, 1); } else { s0 += __shfl_xor(s0, 1); }
    return s0;
}
__device__ __forceinline__ void route16(const float (&sc)[16], const float (&bs)[16], int& e0, int& e1, float& g0, float& g1) {
    float best = -1e30f, W0 = 0.f, W1 = 0.f; int E0 = 0, E1 = 0;
#pragma unroll
    for (int g = 0; g < 4; ++g) {
        float m1 = bs[g * 4], w1 = sc[g * 4]; int i1 = 0;
#pragma unroll
        for (int j = 1; j < 4; ++j) { const bool gt = bs[g * 4 + j] > m1; m1 = gt ? bs[g * 4 + j] : m1; w1 = gt ? sc[g * 4 + j] : w1; i1 = gt ? j : i1; }
        float m2 = -1e30f, w2 = 0.f; int i2 = 0;
#pragma unroll
        for (int j = 0; j < 4; ++j) { const bool gt = (j != i1) && (bs[g * 4 + j] > m2); m2 = gt ? bs[g * 4 + j] : m2; w2 = gt ? sc[g * 4 + j] : w2; i2 = gt ? j : i2; }
        const float gs = m1 + m2; const bool better = gs > best;
        best = better ? gs : best; E0 = better ? g * 4 + i1 : E0; E1 = better ? g * 4 + i2 : E1; W0 = better ? w1 : W0; W1 = better ? w2 : W1;
    }
    e0 = E0; e1 = E1;
    const float inv = 1.f / (W0 + W1);
    g0 = W0 * inv; g1 = W1 * inv;
}
__device__ __forceinline__ void expert_offsets(const u32* cnt  , int (&off)[17]) {
    off[0] = 0;
#pragma unroll
    for (int e = 0; e < 16; ++e) off[e + 1] = off[e] + (int)((cnt[e * 64] + 255u) / 256u) * 256;
}

template <int NS> __forceinline__
__device__ __forceinline__ void phase_rows(const P& p, int bid, int nb, float* lds, const RowArgs a) {
    const int tid = p.tid(), lane = tid & 63, wid = tid >> 6;
    unsigned char* ws = p.get_ws();
    const float* MODS = (const float*)(ws + WS_MODS);
    bf16_t* XRES = (bf16_t*)(ws + WS_XRES);
    bf16_t* HB = (bf16_t*)(ws + WS_HB);
    float* SMALL = (float*)(ws + WS_SMALL);
    int* CHKI = (int*)(ws + WS_CHK);
    if (!a.final_out && !a.noproj) {
        for (int i = tid; i < 1024 * NS; i += NTH) { const int k = i / NS, n = i % NS;
            lds[(((k >> 8) * 4 + (k & 3)) * (NS / 4) + (n >> 2)) * 256 + ((k >> 2) & 63) * 4 + (n & 3)] = a.wsm[(size_t)k * a.ldw + a.wcol0 + n]; }
    }
    u32* lcnt = (u32*)(lds + 1024 * 32);
    int* lsl = (int*)(lds + 1024 * 32 + 64);
    int4* lrt = (int4*)(lds + 1024 * 32 + 64);
    if (tid < 16) lcnt[tid] = 0u;
    if (a.combine) {
        if (tid == 0) { int off[17]; expert_offsets((const u32*)(ws + WS_CTL) + CW_CNT + a.clayer * 16 * 64, off);
#pragma unroll
            for (int e = 0; e < 16; ++e) lsl[e] = off[e]; }
        for (int i = tid; i < nb * 16; i += NTH) lsl[16 + i] = CHKI[CH_BBASE + i];
    }
    __syncthreads();
    const float* gamma = (a.ffn ? p.in[7] : p.in[6]) + a.layer * 1024;
    const bf16_t* YMOE = (const bf16_t*)(ws + WS_PROJ);
    const int4* ROUTE = (const int4*)(ws + WS_ROUTE);
    const float2* GATE = (const float2*)(ws + WS_GATE);
    const int stride = nb * 8;
    for (int row0 = bid * 8 + wid; row0 < a.nrows; row0 += (NS == 16 ? 2 : 1) * stride) {
        const bool hasB = NS == 16 && row0 + stride < a.nrows;
        const int rw[2] = {row0, hasB ? row0 + stride : row0};
        float v[2][16];
#pragma unroll
        for (int u = 0; u < 2; ++u) {
            const int row = rw[u];
            if (a.src) {
#pragma unroll
                for (int i = 0; i < 4; ++i) ld4bf(XRES + (size_t)row * 1024 + i * 256 + lane * 4, &v[u][i * 4]);
            } else {
                const float* src = row >= SEQ ? p.in[2] + (size_t)(row - SEQ) * 1024 : p.in[0] + (size_t)row * 1024;
#pragma unroll
                for (int i = 0; i < 4; ++i) { const float4 t = *(const float4*)(src + i * 256 + lane * 4); v[u][i * 4] = t.x; v[u][i * 4 + 1] = t.y; v[u][i * 4 + 2] = t.z; v[u][i * 4 + 3] = t.w; }
            }
        }
        if (a.combine) {
            int4 rt[2]; float2 gt[2];
#pragma unroll
            for (int u = 0; u < 2; ++u) { rt[u] = ROUTE[rw[u]]; gt[u] = GATE[rw[u]]; }
            uint2 y0[2][4], y1[2][4];
#pragma unroll
            for (int u = 0; u < 2; ++u) {
                const int blk = (rw[u] >> 6) % nb;
                const int s0 = lsl[rt[u].x] + lsl[16 + blk * 16 + rt[u].x] + rt[u].y, s1 = lsl[rt[u].z] + lsl[16 + blk * 16 + rt[u].z] + rt[u].w;
#pragma unroll
                for (int i = 0; i < 4; ++i) { y0[u][i] = *(const uint2*)(YMOE + (size_t)s0 * 1024 + i * 256 + lane * 4); y1[u][i] = *(const uint2*)(YMOE + (size_t)s1 * 1024 + i * 256 + lane * 4); }
            }
#pragma unroll
            for (int u = 0; u < 2; ++u) {
                const int row = rw[u];
                const float* gf = MODS + (a.clayer * 2 + (row >= SEQ ? 1 : 0)) * 6144 + 5 * 1024;
#pragma unroll
                for (int i = 0; i < 4; ++i) {
                    const float4 g = *(const float4*)(gf + i * 256 + lane * 4);
                    v[u][i * 4 + 0] += g.x * (gt[u].x * __uint_as_float(y0[u][i].x << 16) + gt[u].y * __uint_as_float(y1[u][i].x << 16));
                    v[u][i * 4 + 1] += g.y * (gt[u].x * __uint_as_float(y0[u][i].x & 0xffff0000u) + gt[u].y * __uint_as_float(y1[u][i].x & 0xffff0000u));
                    v[u][i * 4 + 2] += g.z * (gt[u].x * __uint_as_float(y0[u][i].y << 16) + gt[u].y * __uint_as_float(y1[u][i].y << 16));
                    v[u][i * 4 + 3] += g.w * (gt[u].x * __uint_as_float(y0[u][i].y & 0xffff0000u) + gt[u].y * __uint_as_float(y1[u][i].y & 0xffff0000u));
                }
                if (u == 0 || hasB) {
                    if (a.final_out) { float* dst = p.get_out() + (size_t)row * 1024;
#pragma unroll
                        for (int i = 0; i < 4; ++i) *(float4*)(dst + i * 256 + lane * 4) = make_float4(v[u][i * 4], v[u][i * 4 + 1], v[u][i * 4 + 2], v[u][i * 4 + 3]); }
                    else {
#pragma unroll
                        for (int i = 0; i < 4; ++i) { uint2 o; o.x = pack2(v[u][i * 4], v[u][i * 4 + 1]); o.y = pack2(v[u][i * 4 + 2], v[u][i * 4 + 3]); *(uint2*)(XRES + (size_t)row * 1024 + i * 256 + lane * 4) = o; } }
                }
            }
            if (a.final_out) continue;
        }
#pragma unroll
        for (int u = 0; u < 2; ++u) {
            const int row = rw[u];
            if (u == 0 || hasB) {
            const float* md = MODS + (a.layer * 2 + (row >= SEQ ? 1 : 0)) * 6144 + (a.ffn ? 3 * 1024 : 0);
            const float s0 = row_norm_proj<NS>(v[u], gamma, md, HB + (size_t)row * 1024, lds, lane, !a.noproj);
            if (a.noproj) {
            } else if (!a.route) {
                const int nl = NS == 16 ? (((lane >> 5) & 1) << 3) | (((lane >> 4) & 1) << 2) | (((lane >> 3) & 1) << 1) | ((lane >> 2) & 1)
                                        : (((lane >> 5) & 1) << 4) | (((lane >> 4) & 1) << 3) | (((lane >> 3) & 1) << 2) | (((lane >> 2) & 1) << 1) | ((lane >> 1) & 1);
                if ((lane & (NS == 16 ? 3 : 1)) == 0) SMALL[(size_t)row * 32 + nl] = s0;
            } else if (NS == 16) {
                const int nl = (((lane >> 5) & 1) << 3) | (((lane >> 4) & 1) << 2) | (((lane >> 3) & 1) << 1) | ((lane >> 2) & 1);
                const float scl = 1.f / (1.f + expf(-s0)), bsl = scl + p.in[5][nl];
                float sc[16], bs[16];
#pragma unroll
                for (int n = 0; n < 16; ++n) { const int sl = ((n & 8) ? 32 : 0) | ((n & 4) ? 16 : 0) | ((n & 2) ? 8 : 0) | ((n & 1) ? 4 : 0); sc[n] = rdlane(scl, sl); bs[n] = rdlane(bsl, sl); }
                int e0, e1; float g0, g1; route16(sc, bs, e0, e1, g0, g1);
                if (lane == 0) {
                    const int p0 = (int)atomicAdd(lcnt + e0, 1u), p1 = (int)atomicAdd(lcnt + e1, 1u);
                    const int4 rt4 = make_int4(e0, p0, e1, p1);
                    ((int4*)(ws + WS_ROUTE))[row] = rt4;
                    ((float2*)(ws + WS_GATE))[row] = make_float2(g0, g1);
                    lrt[((row - (bid * 8 + wid)) / stride) * 8 + wid] = rt4;
                }
            }
            }
            __builtin_amdgcn_sched_barrier(0);
        }
    }
    if (a.route) {
        __syncthreads();
        if (tid < 16) {
            u32* cnt = (u32*)(ws + WS_CTL) + CW_CNT + (a.layer * 16 + tid) * 64;
            const int base = (int)atomicAdd(cnt, lcnt[tid]);
            CHKI[CH_BBASE + bid * 16 + tid] = base; lcnt[16 + tid] = (u32)base;
        }
        __syncthreads();
        if (lane == 0) {
            int* ELIST = CHKI + CH_ELIST;
            int k = 0;
            for (int row = bid * 8 + wid; row < a.nrows; row += stride, ++k) {
                const int4 r = lrt[k * 8 + wid];
                ELIST[r.x * MT + (int)lcnt[16 + r.x] + r.y] = row; ELIST[r.z * MT + (int)lcnt[16 + r.z] + r.w] = row;
            }
        }
    }
}


__device__ __forceinline__ void phase_route(const P& p, int bid, int nb, float* lds, int layer, int nrows) {
    const int tid = p.tid(), lane = tid & 63, wid = tid >> 6, r = lane & 15, q = lane >> 4;
    unsigned char* ws = p.get_ws();
    const float* MODS = (const float*)(ws + WS_MODS);
    const bf16_t* XRES = (const bf16_t*)(ws + WS_XRES);
    bf16_t* HB = (bf16_t*)(ws + WS_HB);
    int* CHKI = (int*)(ws + WS_CHK);
    const bf16_t* WRT = (const bf16_t*)((const float*)(ws + WS_CHK) + CH_WRT);
    u32* lcnt = (u32*)(lds + 16384);
    int4* lrt = (int4*)(lds + 16384 + 64);
    if (tid < 16) lcnt[tid] = 0u;
    const float* gamma = p.in[7] + layer * 1024;
    int kt = 0;
    for (int tile = bid; tile < nrows / 64; tile += nb, ++kt) {
        const int r0 = tile * 64;
#pragma unroll 1
        for (int pr = 0; pr < 4; ++pr) {
            float v[2][16];
#pragma unroll
            for (int u = 0; u < 2; ++u) { const bf16_t* src = XRES + (size_t)(r0 + wid * 8 + pr * 2 + u) * 1024;
#pragma unroll
                for (int i = 0; i < 4; ++i) ld4bf(src + i * 256 + lane * 4, &v[u][i * 4]); }
#pragma unroll
            for (int u = 0; u < 2; ++u) { const int row = r0 + wid * 8 + pr * 2 + u;
                const float* md = MODS + (layer * 2 + (row >= SEQ ? 1 : 0)) * 6144 + 3 * 1024;
                (void)row_norm_proj<16>(v[u], gamma, md, HB + (size_t)row * 1024, lds, lane, false); }
        }
        asm volatile("s_waitcnt vmcnt(0)" ::: "memory");
        __syncthreads();
        {
            f32x4 acc[4][2];
#pragma unroll
            for (int mi = 0; mi < 4; ++mi)
#pragma unroll
                for (int ni = 0; ni < 2; ++ni) acc[mi][ni] = (f32x4){0.f, 0.f, 0.f, 0.f};
            const bf16_t* Ab = HB + (size_t)(r0 + r) * 1024 + wid * 128 + 8 * q; const bf16_t* Bb = WRT + (size_t)r * 1024 + wid * 128 + 8 * q;
#pragma unroll
            for (int k4 = 0; k4 < 4; ++k4) {
                bf16x8 a[4], b[2];
#pragma unroll
                for (int mi = 0; mi < 4; ++mi) a[mi] = *(const bf16x8*)(Ab + (size_t)(16 * mi) * 1024 + 32 * k4);
#pragma unroll
                for (int ni = 0; ni < 2; ++ni) b[ni] = *(const bf16x8*)(Bb + (size_t)(16 * ni) * 1024 + 32 * k4);
#pragma unroll
                for (int mi = 0; mi < 4; ++mi)
#pragma unroll
                    for (int ni = 0; ni < 2; ++ni) acc[mi][ni] = __builtin_amdgcn_mfma_f32_16x16x32_bf16(b[ni], a[mi], acc[mi][ni], 0, 0, 0);
            }
#pragma unroll
            for (int mi = 0; mi < 4; ++mi)
#pragma unroll
                for (int ni = 0; ni < 2; ++ni) *(f32x4*)(lds + wid * 2048 + (16 * mi + r) * 32 + 16 * ni + 4 * q) = acc[mi][ni];
        }
        __syncthreads();
        if (tid < 128) {
            const int rr = tid >> 1, c8 = (tid & 1) * 8;
            float lg[8] = {0.f, 0.f, 0.f, 0.f, 0.f, 0.f, 0.f, 0.f};
#pragma unroll
            for (int w = 0; w < 8; ++w) { const float4 x0 = *(const float4*)(lds + w * 2048 + rr * 32 + c8), x1 = *(const float4*)(lds + w * 2048 + rr * 32 + c8 + 4);
                lg[0] += x0.x; lg[1] += x0.y; lg[2] += x0.z; lg[3] += x0.w; lg[4] += x1.x; lg[5] += x1.y; lg[6] += x1.z; lg[7] += x1.w; }
            float sc[16], bs[16];
            const float* rb = p.in[5];
#pragma unroll
            for (int j = 0; j < 8; ++j) {
                const float mine_s = 1.f / (1.f + expf(-lg[j])), mine_b = mine_s + rb[c8 + j];
                const float oth_s = __shfl_xor(mine_s, 1), oth_b = __shfl_xor(mine_b, 1);
                sc[j] = c8 ? oth_s : mine_s; sc[8 + j] = c8 ? mine_s : oth_s; bs[j] = c8 ? oth_b : mine_b; bs[8 + j] = c8 ? mine_b : oth_b;
            }
            int e0, e1; float g0, g1; route16(sc, bs, e0, e1, g0, g1);
            if (c8 == 0) {
                const int row = r0 + rr;
                const int p0 = (int)atomicAdd(lcnt + e0, 1u), p1 = (int)atomicAdd(lcnt + e1, 1u);
                const int4 rt4 = make_int4(e0, p0, e1, p1);
                ((int4*)(ws + WS_ROUTE))[row] = rt4;
                ((float2*)(ws + WS_GATE))[row] = make_float2(g0, g1);
                lrt[kt * 64 + rr] = rt4;
            }
        }
        __syncthreads();
    }
    __syncthreads();
    if (tid < 16) {
        u32* cnt = (u32*)(ws + WS_CTL) + CW_CNT + (layer * 16 + tid) * 64;
        const int base = (int)atomicAdd(cnt, lcnt[tid]);
        CHKI[CH_BBASE + bid * 16 + tid] = base; lcnt[16 + tid] = (u32)base;
    }
    __syncthreads();
    {
        int* ELIST = CHKI + CH_ELIST;
        int k2 = 0;
        for (int tile = bid; tile < nrows / 64; tile += nb, ++k2)
            if (tid < 64) { const int4 rt = lrt[k2 * 64 + tid]; const int row = tile * 64 + tid;
                ELIST[rt.x * MT + (int)lcnt[16 + rt.x] + rt.y] = row; ELIST[rt.z * MT + (int)lcnt[16 + rt.z] + rt.w] = row; }
    }
}

namespace g8 {
#define G8_LAS __attribute__((address_space(3)))
typedef short bf16x8 __attribute__((ext_vector_type(8)));
typedef float f32x4 __attribute__((ext_vector_type(4)));
constexpr int BM = 256, BK = 64, HALF = 128, HTB = HALF * BK * 2, STAGE_BYTES = 8 * HTB, NXCD = 8, WGM = 8;
__device__ __forceinline__ int lds_byte(int r, int c) { const int st = (r >> 4) * 2 + (c >> 5), rr = r & 15, cc = c & 31, ob = rr * 64 + cc * 2; return st * 1024 + (ob ^ (((ob >> 9) & 1) << 5)); }
__device__ __forceinline__ void stage_rc(int b, int& R, int& C) { const int st = b / 1024, sb = b % 1024, swz = sb ^ (((sb >> 9) & 1) << 5); R = (st >> 1) * 16 + swz / 64; C = (st & 1) * 32 + (swz % 64) / 2; }
__device__ __forceinline__ int perm32(int rho) { const int n = rho >> 4, i = rho & 15; return 8 * (i >> 2) + 4 * n + (i & 3); }
struct Unit { int pm, pn; };
struct Order {
    int nM, nN, nwg, G, c;
    __device__ __forceinline__ void init(int nM_, int nN_, int G_, int c_) { nM = nM_; nN = nN_; nwg = nM * nN; G = G_; c = c_; }
    __device__ __forceinline__ bool next(int i, Unit& u) const {
        const long L = (long)i * G + c; if (L >= nwg) return false;
        int wgid = (int)L; { const int q = nwg / NXCD, r = nwg % NXCD, xcd = wgid % NXCD, off = wgid / NXCD; wgid = (xcd < r ? xcd * (q + 1) : r * (q + 1) + (xcd - r) * q) + off; }
        const int nig = WGM * nN, gid = wgid / nig, fm = gid * WGM, gsz = (nM - fm) < WGM ? (nM - fm) : WGM;
        u.pm = fm + ((wgid % nig) % gsz); u.pn = (wgid % nig) / gsz; return true;
    }
};
template <class RowSrc, class BSel, class EF>
__device__ __forceinline__ void gemm8(const int tid, G8_LAS unsigned char* lds, const bf16_t* A, int K, const RowSrc& rsrc, const Order& S, const BSel& bsel, const EF& ef) {
    const int wid = __builtin_amdgcn_readfirstlane(tid >> 6), lane = tid & 63, wr = wid >> 2, wc = wid & 3, fr = lane & 15, fq = lane >> 4;
    const int nt = K / BK;
    int R0, C0, R1, C1; stage_rc(tid * 16, R0, C0); stage_rc(tid * 16 + 8192, R1, C1);
    const unsigned vb0 = (unsigned)(((R0 & ~31) + perm32(R0 & 31)) * K + C0) * 2u, vb1 = (unsigned)(((R1 & ~31) + perm32(R1 & 31)) * K + C1) * 2u;
    const size_t kstep = (size_t)(BK * 2), hstep = (size_t)HALF * K * 2, tstep = 2 * hstep;
    const unsigned ldsw = (unsigned)wid * 1024u;
    const int aoff = lds_byte(wr * 64 + fr, fq * 8), boff = lds_byte(wc * 32 + fr, fq * 8);
#define G8_SA(b, h) (((b) * 2 + (h)) * HTB)
#define G8_SB(b, h) ((4 + (b) * 2 + (h)) * HTB)
#define G8_STAGE(bufoff, gbase, v0, v1) do { \
        __builtin_amdgcn_global_load_lds((const unsigned*)((const char*)(gbase) + (v0)), (G8_LAS unsigned*)(lds + (bufoff) + ldsw), 16, 0, 0); \
        __builtin_amdgcn_global_load_lds((const unsigned*)((const char*)(gbase) + (v1)), (G8_LAS unsigned*)(lds + (bufoff) + ldsw + 8192), 16, 0, 0); } while (0)
#define G8_LDA(dst, b, h) do { _Pragma("unroll") for (int m = 0; m < 4; ++m) _Pragma("unroll") for (int k = 0; k < 2; ++k) dst[m][k] = *(const G8_LAS bf16x8*)(lds + G8_SA(b, h) + aoff + m * 2048 + k * 1024); } while (0)
#define G8_LDB(dst, b, h) do { _Pragma("unroll") for (int n = 0; n < 2; ++n) _Pragma("unroll") for (int k = 0; k < 2; ++k) dst[n][k] = *(const G8_LAS bf16x8*)(lds + G8_SB(b, h) + boff + n * 2048 + k * 1024); } while (0)
#define G8_MMA(ai, bj, At, Bt) do { __builtin_amdgcn_s_setprio(1); _Pragma("unroll") for (int m = 0; m < 4; ++m) _Pragma("unroll") for (int n = 0; n < 2; ++n) _Pragma("unroll") for (int k = 0; k < 2; ++k) \
        acc[ai][bj][m][n] = __builtin_amdgcn_mfma_f32_16x16x32_bf16(Bt[n][k], At[m][k], acc[ai][bj][m][n], 0, 0, 0); __builtin_amdgcn_s_setprio(0); } while (0)
#define G8_WAIT_V(n) asm volatile("s_waitcnt vmcnt(" #n ")" ::: "memory")
#define G8_WAIT_L(n) asm volatile("s_waitcnt lgkmcnt(" #n ")" ::: "memory")
#define G8_BAR __builtin_amdgcn_s_barrier()
#define G8_SCHED __builtin_amdgcn_sched_barrier(0)
#define G8_AOFF(pm_, h_, R_, C_) ((unsigned)(rsrc((pm_), (h_) * 128 + (R_)) * K + (C_)) * 2u)
    Unit cur, nxt; int ui = 0;
    if (!S.next(0, cur)) return;
    f32x4 acc[2][2][4][2];
#pragma unroll
    for (int a = 0; a < 2; ++a)
#pragma unroll
        for (int b = 0; b < 2; ++b)
#pragma unroll
            for (int m = 0; m < 4; ++m)
#pragma unroll
                for (int n = 0; n < 2; ++n) acc[a][b][m][n] = (f32x4){0.f, 0.f, 0.f, 0.f};
    bf16x8 At[4][2], B0[2][2], B1[2][2];
    const char* Ab = (const char*)A;
    unsigned a00 = G8_AOFF(cur.pm, 0, R0, C0), a01 = G8_AOFF(cur.pm, 0, R1, C1), a10 = G8_AOFF(cur.pm, 1, R0, C0), a11 = G8_AOFF(cur.pm, 1, R1, C1);
    const char* cB = bsel(cur.pm) + (size_t)cur.pn * tstep;
    G8_STAGE(G8_SB(0, 0), cB, vb0, vb1); G8_STAGE(G8_SA(0, 0), Ab, a00, a01); G8_STAGE(G8_SB(0, 1), cB + hstep, vb0, vb1); G8_STAGE(G8_SA(0, 1), Ab, a10, a11);
    if (wr == 1) G8_BAR;
    G8_WAIT_V(4); G8_BAR;
    G8_STAGE(G8_SB(1, 0), cB + kstep, vb0, vb1); G8_STAGE(G8_SA(1, 0), Ab + kstep, a00, a01); G8_STAGE(G8_SB(1, 1), cB + hstep + kstep, vb0, vb1);
    G8_WAIT_V(6); G8_BAR;
    for (;;) {
        const bool has_next = S.next(ui + 1, nxt);
        unsigned n00 = a00, n01 = a01, n10 = a10, n11 = a11; const char* nB = cB;
        if (has_next) { n00 = G8_AOFF(nxt.pm, 0, R0, C0); n01 = G8_AOFF(nxt.pm, 0, R1, C1); n10 = G8_AOFF(nxt.pm, 1, R0, C0); n11 = G8_AOFF(nxt.pm, 1, R1, C1); nB = bsel(nxt.pm) + (size_t)nxt.pn * tstep; }
        for (int t = 0; t < nt; t += 2) {
            const bool last = (t == nt - 2);
            const char* a1p = Ab + (size_t)(t + 1) * kstep;
            const char* a2p = last ? Ab : Ab + (size_t)(t + 2) * kstep; const char* b2 = last ? nB : cB + (size_t)(t + 2) * kstep;
            const char* a3p = a2p + kstep; const char* b3 = b2 + kstep;
            const unsigned x00 = last ? n00 : a00, x01 = last ? n01 : a01, x10 = last ? n10 : a10, x11 = last ? n11 : a11;
            G8_LDB(B0, 0, 0); G8_SCHED; G8_LDA(At, 0, 0); G8_STAGE(G8_SA(1, 1), a1p, a10, a11);
            G8_WAIT_L(8); G8_BAR; G8_WAIT_L(0); G8_MMA(0, 0, At, B0); G8_BAR; G8_SCHED;
            G8_LDB(B1, 0, 1); G8_STAGE(G8_SB(0, 0), b2, vb0, vb1);
            G8_BAR; G8_WAIT_L(0); G8_MMA(0, 1, At, B1); G8_BAR;
            G8_LDA(At, 0, 1); G8_STAGE(G8_SA(0, 0), a2p, x00, x01);
            G8_BAR; G8_WAIT_L(0); G8_MMA(1, 0, At, B0); G8_BAR; G8_SCHED;
            G8_STAGE(G8_SB(0, 1), b2 + hstep, vb0, vb1);
            G8_WAIT_V(6); G8_BAR; G8_MMA(1, 1, At, B1); G8_BAR;
            G8_LDB(B0, 1, 0); G8_SCHED; G8_LDA(At, 1, 0); G8_STAGE(G8_SA(0, 1), a2p, x10, x11);
            G8_WAIT_L(8); G8_BAR; G8_WAIT_L(0); G8_MMA(0, 0, At, B0); G8_BAR; G8_SCHED;
            G8_LDB(B1, 1, 1); G8_STAGE(G8_SB(1, 0), b3, vb0, vb1);
            G8_BAR; G8_WAIT_L(0); G8_MMA(0, 1, At, B1); G8_BAR;
            G8_LDA(At, 1, 1); G8_STAGE(G8_SA(1, 0), a3p, x00, x01);
            G8_BAR; G8_WAIT_L(0); G8_MMA(1, 0, At, B0); G8_BAR; G8_SCHED;
            G8_STAGE(G8_SB(1, 1), b3 + hstep, vb0, vb1);
            G8_WAIT_V(6); G8_BAR; G8_MMA(1, 1, At, B1); G8_BAR;
        }
#pragma unroll
        for (int ai = 0; ai < 2; ++ai)
#pragma unroll
            for (int m = 0; m < 4; ++m)
#pragma unroll
                for (int bj = 0; bj < 2; ++bj) {
                    const f32x4 v0 = acc[ai][bj][m][0], v1 = acc[ai][bj][m][1];
                    const float v[8] = {v0[0], v0[1], v0[2], v0[3], v1[0], v1[1], v1[2], v1[3]};
                    ef(cur.pm * BM + ai * HALF + wr * 64 + m * 16 + fr, cur.pn * BM + bj * HALF + wc * 32 + 8 * fq, v);
                }
        if (!has_next) break;
#pragma unroll
        for (int a = 0; a < 2; ++a)
#pragma unroll
            for (int b = 0; b < 2; ++b)
#pragma unroll
                for (int m = 0; m < 4; ++m)
#pragma unroll
                    for (int n = 0; n < 2; ++n) acc[a][b][m][n] = (f32x4){0.f, 0.f, 0.f, 0.f};
        cur = nxt; a00 = n00; a01 = n01; a10 = n10; a11 = n11; cB = nB; ++ui;
    }
    G8_WAIT_V(0);
    if (wr == 0) G8_BAR;
    G8_BAR;
#undef G8_SA
#undef G8_SB
#undef G8_STAGE
#undef G8_LDA
#undef G8_LDB
#undef G8_MMA
#undef G8_WAIT_V
#undef G8_WAIT_L
#undef G8_BAR
#undef G8_SCHED
#undef G8_AOFF
}
}
struct BSelOne { const char* B; __device__ __forceinline__ const char* operator()(int) const { return B; } };
struct RowPlain { __device__ __forceinline__ int operator()(int pm, int r) const { return pm * 256 + r; } };
struct BSelExp { const char* B; const int* tinfo; size_t stride; __device__ __forceinline__ const char* operator()(int pm) const { return B + (size_t)tinfo[2 * pm] * stride; } };
struct RowMoe { const int* tinfo; const int* ecnt; const int* elist;
    __device__ __forceinline__ int operator()(int pm, int r) const { const int e = tinfo[2 * pm], pos = tinfo[2 * pm + 1] + r; return pos < ecnt[e] ? elist[e * MT + pos] : 0; } };
__device__ __forceinline__ int moe_tile_table(const P& p, int layer, int* tinfo, int* ecnt, int tid) {
    const u32* cnt = (const u32*)(p.get_ws() + WS_CTL) + CW_CNT + layer * 16 * 64;
    if (tid == 0) {
        int t = 0;
#pragma unroll 1
        for (int e = 0; e < 16; ++e) { const int c = (int)cnt[e * 64]; ecnt[e] = c;
#pragma unroll 1
            for (int i = 0; i < (c + 255) / 256; ++i) { tinfo[2 * t] = e; tinfo[2 * t + 1] = i * 256; ++t; } }
        ecnt[16] = t;
    }
    __syncthreads();
    return ecnt[16];
}

struct SrcPlain { const float* W; int ldw; __device__ __forceinline__ const float* operator()(int k, int n) const { return W + (size_t)k * ldw + n; } };
struct SrcEven { const float* W; __device__ __forceinline__ const float* operator()(int k, int n) const {
        return n < 2048 ? W + (size_t)k * EV_IN + (n < 1280 ? n : n + 16) : (n < 2064 ? W + (size_t)k * EV_IN + 1280 + (n - 2048) : nullptr); } };
struct SrcRouter { const float* W; __device__ __forceinline__ const float* operator()(int k, int n) const { return n < 16 ? W + (size_t)k * 16 + n : nullptr; } };
struct SrcOdd { const float* W; __device__ __forceinline__ const float* operator()(int k, int n) const { return n < OD_IN ? W + (size_t)k * OD_IN + n : nullptr; } };
struct SrcMoe13 { const float* W1; long long d13; __device__ __forceinline__ const float* operator()(int k, int n) const { return W1 + ((n & 4) ? d13 : 0ll) + (size_t)k * DE + ((n >> 3) * 4 + (n & 3)); } };
template <class SF>
__device__ __forceinline__ void conv_matrix(const SF& src, int K, int N, bf16_t* WT, int gw, int ngw, float* scr, int lane) {
    const int nblk = N / 32, nitems = (K / 64) * nblk;
    for (int item = gw; item < nitems; item += ngw) {
        const int kb = item / nblk, nbk = item % nblk, k0 = 64 * kb, n0 = 32 * nbk;
#pragma unroll 8
        for (int i = 0; i < 32; ++i) { const int kk = 2 * i + (lane >> 5); const float* sp = src(k0 + kk, n0 + (lane & 31)); scr[kk * 33 + (lane & 31)] = sp ? *sp : 0.f; }
        __builtin_amdgcn_s_waitcnt(0xC07F); asm volatile("" ::: "memory");
        const int c = lane & 7;
#pragma unroll
        for (int j = 0; j < 4; ++j) { const int n = (lane >> 3) + 8 * j; const float* sp = scr + (8 * c) * 33 + n;
            uint4 o; o.x = pack2(sp[0 * 33], sp[1 * 33]); o.y = pack2(sp[2 * 33], sp[3 * 33]); o.z = pack2(sp[4 * 33], sp[5 * 33]); o.w = pack2(sp[6 * 33], sp[7 * 33]);
            *(uint4*)(WT + (size_t)(n0 + n) * K + k0 + 8 * c) = o; }
        __builtin_amdgcn_s_waitcnt(0xC07F); asm volatile("" ::: "memory");
    }
}

template <class SF>
__device__ __forceinline__ void conv_item(const SF& src, int K, int N, bf16_t* WT, int item, int lane) {
    const int nblk = (N + 255) / 256, kb = item / nblk, nbk = item % nblk, k0 = 32 * kb, n = nbk * 256 + lane * 4;
    if (n >= N) return;
#pragma unroll 1
    for (int kh = 0; kh < 2; ++kh) {
        float4 v[16];
#pragma unroll
        for (int j = 0; j < 16; ++j) { const float* sp = src(k0 + kh * 16 + j, n); v[j] = sp ? *(const float4*)sp : make_float4(0.f, 0.f, 0.f, 0.f); }
#pragma unroll
        for (int ks = 0; ks < 2; ++ks) {
            const float4* w = v + ks * 8;
            uint4 o;
            o.x = pack2(w[0].x, w[1].x); o.y = pack2(w[2].x, w[3].x); o.z = pack2(w[4].x, w[5].x); o.w = pack2(w[6].x, w[7].x); *(uint4*)(WT + (size_t)(n + 0) * K + k0 + kh * 16 + ks * 8) = o;
            o.x = pack2(w[0].y, w[1].y); o.y = pack2(w[2].y, w[3].y); o.z = pack2(w[4].y, w[5].y); o.w = pack2(w[6].y, w[7].y); *(uint4*)(WT + (size_t)(n + 1) * K + k0 + kh * 16 + ks * 8) = o;
            o.x = pack2(w[0].z, w[1].z); o.y = pack2(w[2].z, w[3].z); o.z = pack2(w[4].z, w[5].z); o.w = pack2(w[6].z, w[7].z); *(uint4*)(WT + (size_t)(n + 2) * K + k0 + kh * 16 + ks * 8) = o;
            o.x = pack2(w[0].w, w[1].w); o.y = pack2(w[2].w, w[3].w); o.z = pack2(w[4].w, w[5].w); o.w = pack2(w[6].w, w[7].w); *(uint4*)(WT + (size_t)(n + 3) * K + k0 + kh * 16 + ks * 8) = o;
        }
    }
}
template <class SF>
__device__ __forceinline__ void conv_all(const SF& src, int K, int N, bf16_t* WT, int gw, int ngw, int lane) {
    const int nitems = (K / 32) * ((N + 255) / 256);
    for (int it = gw; it < nitems; it += ngw) conv_item(src, K, N, WT, it, lane);
}
__device__ __forceinline__ void conv_dense(const P& p, int bid, int nb, float* lds) {
    const int tid = p.tid(), lane = tid & 63, wid = tid >> 6;
    const int ngw = nb * 8; int gw = bid * 8 + wid;
    unsigned char* ws = p.get_ws();
    conv_all(SrcEven{p.in[10]}, 1024, 2304, (bf16_t*)(ws + WS_WIN0), gw, ngw, lane);            gw = (gw + 288) % ngw;
    conv_all(SrcOdd{p.in[21]}, 1024, 3328, (bf16_t*)(ws + WS_WIN1), gw, ngw, lane);             gw = (gw + 416) % ngw;
    conv_all(SrcPlain{p.in[20], 1024}, 1024, 1024, (bf16_t*)(ws + WS_WOUT0), gw, ngw, lane);    gw = (gw + 128) % ngw;
    conv_all(SrcPlain{p.in[27], 1024}, 1024, 1024, (bf16_t*)(ws + WS_WOUT1), gw, ngw, lane);    gw = (gw + 128) % ngw;
    conv_all(SrcRouter{p.in[4]}, 1024, 32, (bf16_t*)((float*)(ws + WS_CHK) + CH_WRT), gw, ngw, lane);
}
__device__ __forceinline__ void conv_moe_chunk(const P& p, int chunk, float* lds, int layer) {
    const int tid = p.tid(), lane = tid & 63, wid = tid >> 6;
    unsigned char* ws = p.get_ws();
    bf16_t* W13T = (bf16_t*)(ws + WS_WMOE); bf16_t* W2T = W13T + (size_t)16 * 1024 * 1024;
    const long long d13 = (long long)(p.in[29] - p.in[28]);
    const int wi = chunk * 8 + wid, e = wi / 192, idx = wi % 192;
    if (idx < 128) conv_item(SrcMoe13{p.in[28] + ((size_t)layer * 16 + e) * 1024 * DE, d13}, 1024, 1024, W13T + (size_t)e * 1024 * 1024, idx, lane);
    else conv_item(SrcPlain{p.in[30] + ((size_t)layer * 16 + e) * DE * 1024, 1024}, DE, 1024, W2T + (size_t)e * 1024 * DE, idx - 128, lane);
}
__device__ __forceinline__ void conv_moe(const P& p, int bid, int nb, float* lds, int layer) {
    const int tid = p.tid(), lane = tid & 63, wid = tid >> 6;
    float* scr = lds + 16384 + wid * (64 * 33);
    const int ngw = nb * 8; int gw = bid * 8 + wid;
    unsigned char* ws = p.get_ws();
    bf16_t* W13T = (bf16_t*)(ws + WS_WMOE); bf16_t* W2T = W13T + (size_t)16 * 1024 * 1024;
    const long long d13 = (long long)(p.in[29] - p.in[28]);
    for (int e = 0; e < 16; ++e) {
        conv_matrix(SrcMoe13{p.in[28] + ((size_t)layer * 16 + e) * 1024 * DE, d13}, 1024, 1024, W13T + (size_t)e * 1024 * 1024, gw, ngw, scr, lane);
        conv_matrix(SrcPlain{p.in[30] + ((size_t)layer * 16 + e) * DE * 1024, 1024}, DE, 1024, W2T + (size_t)e * 1024 * DE, gw, ngw, scr, lane);
        gw = (gw + 768) % ngw;
    }
}


template <class EF>
__device__ __forceinline__ void mini_gemm(const P& p, int bid, int nb, float* lds, const bf16_t* A, const bf16_t* Bt, int row0, int nrt, int col0, int nct, const EF& ef) {
    constexpr int K = 1024, KS = 128;
    const int tid = p.tid(), lane = tid & 63, wid = tid >> 6, r = lane & 15, q = lane >> 4;
    const int ntl = nrt * nct;
    int t = bid;
    if (t >= ntl) return;
    bf16x8 a[4][4], b[4][2];
#define MG_LOAD(tt) do { const int rt_ = (tt) / nct, ct_ = (tt) % nct; \
        const bf16_t* Ab_ = A + (size_t)(row0 + rt_ * 64 + r) * K + wid * KS + 8 * q; const bf16_t* Bb_ = Bt + (size_t)(col0 + ct_ * 32 + r) * K + wid * KS + 8 * q; \
        _Pragma("unroll") for (int k4 = 0; k4 < 4; ++k4) { \
            _Pragma("unroll") for (int mi = 0; mi < 4; ++mi) a[k4][mi] = *(const bf16x8*)(Ab_ + (size_t)(16 * mi) * K + 32 * k4); \
            _Pragma("unroll") for (int ni = 0; ni < 2; ++ni) b[k4][ni] = *(const bf16x8*)(Bb_ + (size_t)(16 * ni) * K + 32 * k4); } } while (0)
    MG_LOAD(t);
    for (;;) {
        f32x4 acc[4][2];
#pragma unroll
        for (int mi = 0; mi < 4; ++mi)
#pragma unroll
            for (int ni = 0; ni < 2; ++ni) acc[mi][ni] = (f32x4){0.f, 0.f, 0.f, 0.f};
#pragma unroll
        for (int k4 = 0; k4 < 4; ++k4)
#pragma unroll
            for (int mi = 0; mi < 4; ++mi)
#pragma unroll
                for (int ni = 0; ni < 2; ++ni) acc[mi][ni] = __builtin_amdgcn_mfma_f32_16x16x32_bf16(b[k4][ni], a[k4][mi], acc[mi][ni], 0, 0, 0);
        const int tcur = t; t += nb;
        const bool more = t < ntl;
        if (more) MG_LOAD(t);
        __syncthreads();
#pragma unroll
        for (int mi = 0; mi < 4; ++mi)
#pragma unroll
            for (int ni = 0; ni < 2; ++ni) *(f32x4*)(lds + wid * 2048 + (16 * mi + r) * 32 + 16 * ni + 4 * q) = acc[mi][ni];
        __syncthreads();
        if (tid < 256) {
            const int rr = tid >> 2, c8 = (tid & 3) * 8;
            float v[8] = {0.f, 0.f, 0.f, 0.f, 0.f, 0.f, 0.f, 0.f};
#pragma unroll
            for (int w = 0; w < 8; ++w) { const float4 x0 = *(const float4*)(lds + w * 2048 + rr * 32 + c8), x1 = *(const float4*)(lds + w * 2048 + rr * 32 + c8 + 4);
                v[0] += x0.x; v[1] += x0.y; v[2] += x0.z; v[3] += x0.w; v[4] += x1.x; v[5] += x1.y; v[6] += x1.z; v[7] += x1.w; }
            ef(row0 + (tcur / nct) * 64 + rr, col0 + (tcur % nct) * 32 + c8, v);
        }
        if (!more) break;
    }
#undef MG_LOAD
    __syncthreads();
}

struct EpiProj { bf16_t* C; int ld; int nmain; int ns; float* SMALL; __device__ void operator()(int r, int c0, const float* v) const {
    if (c0 < nmain) { uint4 o; o.x = pack2(v[0], v[1]); o.y = pack2(v[2], v[3]); o.z = pack2(v[4], v[5]); o.w = pack2(v[6], v[7]); *(uint4*)(C + (size_t)r * ld + c0) = o; }
    else if (c0 < nmain + ns) { float* d = SMALL + (size_t)r * 32 + (c0 - nmain); *(float4*)d = make_float4(v[0], v[1], v[2], v[3]); *(float4*)(d + 4) = make_float4(v[4], v[5], v[6], v[7]); } } };
struct EpiBf16Store { bf16_t* C; int ld; __device__ void operator()(int r, int c0, const float* v) const {
    uint4 o; o.x = pack2(v[0], v[1]); o.y = pack2(v[2], v[3]); o.z = pack2(v[4], v[5]); o.w = pack2(v[6], v[7]); *(uint4*)(C + (size_t)r * ld + c0) = o; } };
struct EpiResid { const float* xlat; const float* xctx; bf16_t* XRES; const float* gl; const float* gc;
    __device__ void operator()(int r, int c0, const float* v) const {
        const float* g = r >= SEQ ? gc : gl;
        const float4 g0 = *(const float4*)(g + c0), g1 = *(const float4*)(g + c0 + 4);
        float x[8];
        if (xlat) { const float* xin = r >= SEQ ? xctx + (size_t)(r - SEQ) * 1024 : xlat + (size_t)r * 1024;
            const float4 x0 = *(const float4*)(xin + c0), x1 = *(const float4*)(xin + c0 + 4); x[0] = x0.x; x[1] = x0.y; x[2] = x0.z; x[3] = x0.w; x[4] = x1.x; x[5] = x1.y; x[6] = x1.z; x[7] = x1.w; }
        else unpack8(*(const uint4*)(XRES + (size_t)r * 1024 + c0), x);
        uint4 o; o.x = pack2(x[0] + g0.x * v[0], x[1] + g0.y * v[1]); o.y = pack2(x[2] + g0.z * v[2], x[3] + g0.w * v[3]); o.z = pack2(x[4] + g1.x * v[4], x[5] + g1.y * v[5]); o.w = pack2(x[6] + g1.z * v[6], x[7] + g1.w * v[7]);
        *(uint4*)(XRES + (size_t)r * 1024 + c0) = o;
    } };
struct EpiSwiglu { bf16_t* H; __device__ void operator()(int r, int c0, const float* v) const {
    uint2 o; o.x = pack2(siluf(v[0]) * v[4], siluf(v[1]) * v[5]); o.y = pack2(siluf(v[2]) * v[6], siluf(v[3]) * v[7]); *(uint2*)(H + (size_t)r * DE + (c0 >> 3) * 4) = o; } };

__device__ __forceinline__ void phase_moe1(const P& p, int bid, int nb, G8_LAS unsigned char* ldsa, float* lds, int layer) {
    unsigned char* ws = p.get_ws();
    int* tinfo = (int*)(lds + 32768); int* ecnt = tinfo + 2 * MAXTILES + 16;
    const int ntiles = moe_tile_table(p, layer, tinfo, ecnt, p.tid());
    g8::Order S; S.init(ntiles, 4, nb, bid);
    EpiSwiglu ef{(bf16_t*)(ws + WS_Y)};
    g8::gemm8(p.tid(), ldsa, (const bf16_t*)(ws + WS_HB), 1024, RowMoe{tinfo, ecnt, (const int*)(ws + WS_CHK) + CH_ELIST}, S, BSelExp{(const char*)(ws + WS_WMOE), tinfo, (size_t)1024 * 1024 * 2}, ef);
}
__device__ __forceinline__ void phase_moe2(const P& p, int bid, int nb, G8_LAS unsigned char* ldsa, float* lds, int layer) {
    unsigned char* ws = p.get_ws();
    int* tinfo = (int*)(lds + 32768); int* ecnt = tinfo + 2 * MAXTILES + 16;
    const int ntiles = moe_tile_table(p, layer, tinfo, ecnt, p.tid());
    g8::Order S; S.init(ntiles, 4, nb, bid);
    EpiBf16Store ef{(bf16_t*)(ws + WS_PROJ), 1024};
    g8::gemm8(p.tid(), ldsa, (const bf16_t*)(ws + WS_Y), DE, RowPlain{}, S, BSelExp{(const char*)(ws + WS_WMOE) + (size_t)16 * 1024 * 1024 * 2, tinfo, (size_t)1024 * DE * 2}, ef);
}

__device__ __forceinline__ void phase_qkprep(const P& p, int bid, int nb) {
    const int tid = p.tid(), lane = tid & 63, wid = tid >> 6;
    unsigned char* ws = p.get_ws();
    const bf16_t* PROJ = (const bf16_t*)(ws + WS_PROJ);
    bf16_t* QKR = (bf16_t*)(ws + WS_XRES);
    const float* RC = (const float*)(ws + WS_ROPE); const float* RS = RC + 256 * 16;
    const int d0 = (lane & 7) * 8;
    float qn[8], kn[8];
#pragma unroll
    for (int j = 0; j < 8; ++j) { qn[j] = p.in[17][d0 + j]; kn[j] = p.in[18][d0 + j]; }
    for (int rk = bid * 8; rk < MT / 8; rk += nb * 8)
#pragma unroll 2
    for (int k8 = 0; k8 < 8; ++k8) {
        const int row = (rk + k8) * 8 + wid;
        const bool lat = row < SEQ;
        const uint4 qraw = *(const uint4*)(PROJ + (size_t)row * 2048 + 1280 + lane * 8);
        const uint4 kraw = lane < 16 ? *(const uint4*)(PROJ + (size_t)row * 2048 + 1792 + lane * 8) : make_uint4(0u, 0u, 0u, 0u);
        const int pos = d0 < 32 ? (row >> 6) : (row & 63);
        float cs[8], sn[8];
#pragma unroll
        for (int j = 0; j < 8; ++j) { const int f = (d0 + j) & 15; cs[j] = lat ? RC[pos * 16 + f] : 1.f; sn[j] = lat ? RS[pos * 16 + f] : 0.f; }
        const bool lowhalf = (d0 & 16) == 0;
#pragma unroll
        for (int part = 0; part < 2; ++part) {
            float f[8]; unpack8(part == 0 ? qraw : kraw, f);
            float ss = 0.f;
#pragma unroll
            for (int j = 0; j < 8; ++j) ss += f[j] * f[j];
            ss += __shfl_xor(ss, 1); ss += __shfl_xor(ss, 2); ss += __shfl_xor(ss, 4);
            const float rs = rsqrtf(ss * (1.f / 64.f) + 1e-6f);
            float o[8];
#pragma unroll
            for (int j = 0; j < 8; ++j) { const float y = f[j] * rs * (part == 0 ? qn[j] : kn[j]); const float oth = __shfl_xor(y, 2); o[j] = lowhalf ? y * cs[j] - oth * sn[j] : oth * sn[j] + y * cs[j]; }
            uint4 w; w.x = pack2(o[0], o[1]); w.y = pack2(o[2], o[3]); w.z = pack2(o[4], o[5]); w.w = pack2(o[6], o[7]);
            if (part == 0) *(uint4*)(QKR + (size_t)row * 640 + lane * 8) = w;
            else if (lane < 16) *(uint4*)(QKR + (size_t)row * 640 + 512 + lane * 8) = w;
        }
    }
}


template <int MI, int NI, int KK, bool SWAP, bool SWB = false>
__device__ __forceinline__ void wave_mma(f32x4 (&acc)[MI][NI], const bf16_t* A, int lda, const bf16_t* Bt, int ldb, int lane) {
    const int r = lane & 15, q = lane >> 4;
#pragma unroll
    for (int kk = 0; kk < KK; kk += 32) {
        bf16x8 a[MI], b[NI];
#pragma unroll
        for (int mi = 0; mi < MI; ++mi) a[mi] = *(const bf16x8*)(A + (16 * mi + r) * lda + kk + 8 * q);
#pragma unroll
        for (int ni = 0; ni < NI; ++ni) b[ni] = *(const bf16x8*)(Bt + (16 * ni + r) * ldb + ((kk + 8 * q) ^ (SWB ? ((((16 * ni + r) >> 3) & 7) << 3) : 0)));
#pragma unroll
        for (int mi = 0; mi < MI; ++mi)
#pragma unroll
            for (int ni = 0; ni < NI; ++ni)
                acc[mi][ni] = SWAP ? __builtin_amdgcn_mfma_f32_16x16x32_bf16(b[ni], a[mi], acc[mi][ni], 0, 0, 0) : __builtin_amdgcn_mfma_f32_16x16x32_bf16(a[mi], b[ni], acc[mi][ni], 0, 0, 0);
    }
}
__device__ __forceinline__ void prefetch_line(const void* g, float* lds_dummy, int wid) {
    __builtin_amdgcn_global_load_lds((const unsigned*)g, (__attribute__((address_space(3))) unsigned*)((__attribute__((address_space(3))) unsigned char*)lds_dummy + wid * 256), 4, 0, 0);
}
struct Raw3 { uint4 m, c, p; };
__device__ __forceinline__ Raw3 conv8_load(const bf16_t* rowp, int ld, int t, int L) {
    const uint4 z = make_uint4(0u, 0u, 0u, 0u);
    Raw3 r; r.m = t > 0 ? *(const uint4*)(rowp - ld) : z; r.c = *(const uint4*)rowp; r.p = t < L - 1 ? *(const uint4*)(rowp + ld) : z; return r;
}
__device__ __forceinline__ void conv8_apply(const Raw3& r, const float* cwl, float* out) {
    float fm[8], f0[8], fp[8]; unpack8(r.m, fm); unpack8(r.c, f0); unpack8(r.p, fp);
#pragma unroll
    for (int j = 0; j < 8; ++j) { const float4 w = *(const float4*)(cwl + j * 4); out[j] = siluf(w.x * fm[j] + w.y * f0[j] + w.z * fp[j] + w.w); }
}
__device__ __forceinline__ float wave_scan128(float& v0, float& v1, int lane) {
    float s = v0 + v1;
#pragma unroll
    for (int o = 1; o < 64; o <<= 1) { const float t = __shfl_up(s, o); if (lane >= o) s += t; }
    const float excl = s - (v0 + v1);
    v0 = excl + v0; v1 = v0 + v1;
    return __shfl(s, 63);
}

constexpr size_t SSD_S_OFF = 0;
constexpr size_t SSD_H_OFF = (size_t)130 * 16 * 4096 * 4;
__device__ __forceinline__ void stage_convw(const float* cw, const float* cb, int C, float* cwl, int tid) {
    for (int c = tid; c < C; c += NTH) *(float4*)(cwl + c * 4) = make_float4(cw[c], cw[C + c], cw[2 * C + c], cb[c]);
}
__device__ __forceinline__ void ssd_states(const P& p, int bid, int nb, float* lds) {
    const int tid = p.tid(), lane = tid & 63, wid = tid >> 6;
    unsigned char* ws = p.get_ws();
    const bf16_t* PROJ = (const bf16_t*)(ws + WS_PROJ);
    const float* SMALL = (const float*)(ws + WS_SMALL);
    float* S = (float*)(ws + WS_Y + SSD_S_OFF);
    float* DEC = (float*)(ws + WS_CHK);
    float* cwl = lds;
    bf16_t* XT = (bf16_t*)(lds + 768 * 4);
    bf16_t* BT = XT + 256 * 136;
    float* wsc = (float*)(BT + 64 * 136);
    stage_convw(p.in[11], p.in[12], 768, cwl, tid);
    __syncthreads();
    for (int item = bid; item < 260; item += nb) {
        const int c = item >> 1, g = item & 1;
        const int L = c < 128 ? SEQ : CTX, t0 = c < 128 ? c * 128 : (c - 128) * 128, rbase = c < 128 ? 0 : SEQ;
        const int tid = p.tid(), lane = tid & 63, wid = tid >> 6;
#pragma unroll 1
        for (int b5 = 0; b5 < 2; ++b5) {
            Raw3 rw[5];
#pragma unroll
            for (int k = 0; k < 5; ++k) { const int i = tid + (b5 * 5 + k) * NTH; const int cg8 = (i >> 3) % 40, tl = (i / 320) * 8 + (i & 7);
                const int ch = cg8 < 32 ? g * 256 + cg8 * 8 : 512 + g * 64 + (cg8 - 32) * 8;
                rw[k] = conv8_load(PROJ + (size_t)(rbase + t0 + tl) * 2048 + 512 + ch, 2048, t0 + tl, L); }
#pragma unroll
            for (int k = 0; k < 5; ++k) { const int i = tid + (b5 * 5 + k) * NTH; const int cg8 = (i >> 3) % 40, tl = (i / 320) * 8 + (i & 7);
                const int ch = cg8 < 32 ? g * 256 + cg8 * 8 : 512 + g * 64 + (cg8 - 32) * 8;
                float o[8]; conv8_apply(rw[k], cwl + ch * 4, o);
                const int tls = tl ^ ((cg8 & 7) << 3);
                bf16_t* dst = cg8 < 32 ? XT + (cg8 * 8) * 136 + tls : BT + ((cg8 - 32) * 8) * 136 + tls;
#pragma unroll
                for (int j = 0; j < 8; ++j) dst[j * 136] = f2bf(o[j]); }
        }
        const int hh = wid >> 1, d = wid & 1, h = g * 4 + hh;
        {
            const float A = -expf(p.in[14][d * 8 + h]), dtb = p.in[13][d * 8 + h];
            const float dt0 = softplusf(SMALL[(size_t)(rbase + t0 + 2 * lane) * 32 + d * 8 + h] + dtb), dt1 = softplusf(SMALL[(size_t)(rbase + t0 + 2 * lane + 1) * 32 + d * 8 + h] + dtb);
            const float a0 = dt0 * A, a1 = dt1 * A;
            float c0 = a0, c1 = a1; const float tot = wave_scan128(c0, c1, lane);
            const float w0 = d == 0 ? __expf(tot - c0) * dt0 : __expf(c0 - a0) * dt0, w1 = d == 0 ? __expf(tot - c1) * dt1 : __expf(c1 - a1) * dt1;
            wsc[wid * 128 + 2 * lane] = w0; wsc[wid * 128 + 2 * lane + 1] = w1;
            if (lane == 0) DEC[c * 16 + d * 8 + h] = __expf(tot);
        }
        __syncthreads();
        {
            f32x4 acc[4][4];
#pragma unroll
            for (int mi = 0; mi < 4; ++mi)
#pragma unroll
                for (int ni = 0; ni < 4; ++ni) acc[mi][ni] = (f32x4){0.f, 0.f, 0.f, 0.f};
            const int r = lane & 15, q = lane >> 4;
#pragma unroll
            for (int kk = 0; kk < 128; kk += 32) {
                const float4 wa = *(const float4*)(wsc + wid * 128 + kk + 8 * q), wb = *(const float4*)(wsc + wid * 128 + kk + 8 * q + 4);
                bf16x8 a[4], b[4];
#pragma unroll
                for (int mi = 0; mi < 4; ++mi) {
                    const uint4 raw = *(const uint4*)(XT + (hh * 64 + 16 * mi + r) * 136 + ((kk + 8 * q) ^ ((((16 * mi + r) >> 3) & 7) << 3)));
                    float f[8]; unpack8(raw, f);
                    uint4 o; o.x = pack2(f[0] * wa.x, f[1] * wa.y); o.y = pack2(f[2] * wa.z, f[3] * wa.w); o.z = pack2(f[4] * wb.x, f[5] * wb.y); o.w = pack2(f[6] * wb.z, f[7] * wb.w);
                    a[mi] = *(bf16x8*)&o;
                }
#pragma unroll
                for (int ni = 0; ni < 4; ++ni) b[ni] = *(const bf16x8*)(BT + (16 * ni + r) * 136 + ((kk + 8 * q) ^ ((((16 * ni + r) >> 3) & 7) << 3)));
#pragma unroll
                for (int mi = 0; mi < 4; ++mi)
#pragma unroll
                    for (int ni = 0; ni < 4; ++ni) acc[mi][ni] = __builtin_amdgcn_mfma_f32_16x16x32_bf16(a[mi], b[ni], acc[mi][ni], 0, 0, 0);
                __builtin_amdgcn_sched_barrier(0);
            }
            float* Sp = S + ((size_t)(c * 2 + d) * 8 + h) * 4096;
#pragma unroll
            for (int mi = 0; mi < 4; ++mi)
#pragma unroll
                for (int ni = 0; ni < 4; ++ni)
#pragma unroll
                    for (int j = 0; j < 4; ++j) Sp[(16 * mi + 4 * q + j) * 64 + 16 * ni + r] = acc[mi][ni][j];
        }
        __syncthreads();
    }
}
__device__ __forceinline__ void ssd_scan(const P& p, int bid, int nb) {
    const int tid = p.tid();
    unsigned char* ws = p.get_ws();
    const float* S = (const float*)(ws + WS_Y + SSD_S_OFF);
    bf16_t* HIN = (bf16_t*)(ws + WS_Y + SSD_H_OFF);
    const float* DEC = (const float*)(ws + WS_CHK);
    for (int gid = bid * NTH + tid; gid < 65536; gid += nb * NTH) {
        const int d = gid >> 15, h = (gid >> 12) & 7, e = gid & 4095;
        float H = 0.f;
#pragma unroll 1
        for (int i0 = 0; i0 < 130; i0 += 10) {
            float sv[10], dv[10]; int cc[10];
#pragma unroll
            for (int j = 0; j < 10; ++j) {
                const int i = i0 + j;
                const int c = d == 0 ? (i < 2 ? 128 + i : i - 2) : (i < 2 ? 129 - i : 129 - i);
                cc[j] = c; sv[j] = S[((size_t)(c * 2 + d) * 8 + h) * 4096 + e]; dv[j] = DEC[c * 16 + d * 8 + h];
            }
#pragma unroll
            for (int j = 0; j < 10; ++j) { HIN[((size_t)(cc[j] * 2 + d) * 8 + h) * 4096 + e] = f2bf(H); H = dv[j] * H + sv[j]; }
        }
    }
}
__device__ __forceinline__ void ssd_out(const P& p, int bid, int nb, float* lds) {
    unsigned char* tsbase = (unsigned char*)lds + LDS_BYTES - 128; (void)tsbase;
    const int tid = p.tid(), lane = tid & 63, wid = tid >> 6, r = lane & 15, q = lane >> 4;
    unsigned char* ws = p.get_ws();
    const bf16_t* PROJ = (const bf16_t*)(ws + WS_PROJ);
    const float* SMALL = (const float*)(ws + WS_SMALL);
    const bf16_t* HIN = (const bf16_t*)(ws + WS_Y + SSD_H_OFF);
    bf16_t* MIX = (bf16_t*)(ws + WS_HB);
    float* cwl = lds;
    bf16_t* Cg = (bf16_t*)(lds + 768 * 4);
    bf16_t* Bg = Cg + 128 * 72;
    bf16_t* XT = Bg + 128 * 72;
    bf16_t* Mb = XT + 64 * 136;
    bf16_t* Hn = Mb + 128 * 136;
    float* csb = (float*)(Hn + 2 * 64 * 72);
    float* dts = csb + 8 * 256;
    stage_convw(p.in[11], p.in[12], 768, cwl, tid);
    __syncthreads();
    for (int c = bid; c < 130; c += nb) {
        TS(10);
        const int L = c < 128 ? SEQ : CTX, t0 = c < 128 ? c * 128 : (c - 128) * 128, rbase = c < 128 ? 0 : SEQ;
        const int trow = wid * 16 + r;
        float ssq = 0.f;
        Raw3 nrw[2]; uint4 nhp0, nhp1;
        {
            const int h = wid;
#pragma unroll
            for (int d = 0; d < 2; ++d) {
                const float A = -expf(p.in[14][d * 8 + h]), dtb = p.in[13][d * 8 + h];
                const float dt0 = softplusf(SMALL[(size_t)(rbase + t0 + 2 * lane) * 32 + d * 8 + h] + dtb), dt1 = softplusf(SMALL[(size_t)(rbase + t0 + 2 * lane + 1) * 32 + d * 8 + h] + dtb);
                const float a0 = dt0 * A, a1 = dt1 * A;
                float c0 = a0, c1 = a1; const float tot = wave_scan128(c0, c1, lane);
                csb[(h * 2 + d) * 128 + 2 * lane] = d == 0 ? c0 : tot - c0 + a0; csb[(h * 2 + d) * 128 + 2 * lane + 1] = d == 0 ? c1 : tot - c1 + a1;
                dts[(h * 2 + d) * 128 + 2 * lane] = dt0; dts[(h * 2 + d) * 128 + 2 * lane + 1] = dt1;
            }
        }
        for (int g = 0; g < 2; ++g) {
            {
                Raw3 rw[4];
#pragma unroll
                for (int k = 0; k < 4; ++k) { const int i = tid + k * NTH; const int cg8 = i & 15, tl = i >> 4;
                    const int ch = cg8 < 8 ? 640 + g * 64 + cg8 * 8 : 512 + g * 64 + (cg8 - 8) * 8;
                    rw[k] = conv8_load(PROJ + (size_t)(rbase + t0 + tl) * 2048 + 512 + ch, 2048, t0 + tl, L); }
#pragma unroll
                for (int k = 0; k < 4; ++k) { const int i = tid + k * NTH; const int cg8 = i & 15, tl = i >> 4;
                    const int ch = cg8 < 8 ? 640 + g * 64 + cg8 * 8 : 512 + g * 64 + (cg8 - 8) * 8;
                    float o[8]; conv8_apply(rw[k], cwl + ch * 4, o);
                    uint4 w; w.x = pack2(o[0], o[1]); w.y = pack2(o[2], o[3]); w.z = pack2(o[4], o[5]); w.w = pack2(o[6], o[7]);
                    *(uint4*)((cg8 < 8 ? Cg + cg8 * 8 : Bg + (cg8 - 8) * 8) + tl * 72) = w; }
            }
            __syncthreads();
            if (g == 0) TS(11);
            f32x4 G[1][8];
#pragma unroll
            for (int ni = 0; ni < 8; ++ni) G[0][ni] = (f32x4){0.f, 0.f, 0.f, 0.f};
            wave_mma<1, 8, 64, true>(G, Cg + wid * 16 * 72, 72, Bg, 72, lane);
            if (g == 0) TS(12);
            for (int hh = 0; hh < 4; ++hh) {
                const int h = g * 4 + hh;
                {
                    if (h == 0) {
#pragma unroll
                        for (int k = 0; k < 2; ++k) { const int i = tid + k * NTH; const int cg8 = (i >> 3) & 7, tl = (i >> 6) * 8 + (i & 7);
                            nrw[k] = conv8_load(PROJ + (size_t)(rbase + t0 + tl) * 2048 + 512 + cg8 * 8, 2048, t0 + tl, L); }
                        nhp0 = *(const uint4*)(HIN + ((size_t)(c * 2 + 0) * 8) * 4096 + tid * 8); nhp1 = *(const uint4*)(HIN + ((size_t)(c * 2 + 1) * 8) * 4096 + tid * 8);
                    }
                    Raw3 rw[2]; rw[0] = nrw[0]; rw[1] = nrw[1];
                    const uint4 hp0 = nhp0, hp1 = nhp1;
#pragma unroll
                    for (int k = 0; k < 2; ++k) { const int i = tid + k * NTH; const int cg8 = (i >> 3) & 7, tl = (i >> 6) * 8 + (i & 7); const int ch = h * 64 + cg8 * 8;
                        float o[8]; conv8_apply(rw[k], cwl + ch * 4, o);
#pragma unroll
                        for (int j = 0; j < 8; ++j) XT[(cg8 * 8 + j) * 136 + (tl ^ (cg8 << 3))] = f2bf(o[j]); }
                    *(uint4*)(Hn + (tid >> 3) * 72 + (tid & 7) * 8) = hp0; *(uint4*)(Hn + 64 * 72 + (tid >> 3) * 72 + (tid & 7) * 8) = hp1;
                }
                __syncthreads();
                if (g == 0 && hh == 0) TS(13);
                if (h < 7) {
#pragma unroll
                    for (int k = 0; k < 2; ++k) { const int i = tid + k * NTH; const int cg8 = (i >> 3) & 7, tl = (i >> 6) * 8 + (i & 7);
                        nrw[k] = conv8_load(PROJ + (size_t)(rbase + t0 + tl) * 2048 + 512 + (h + 1) * 64 + cg8 * 8, 2048, t0 + tl, L); }
                    nhp0 = *(const uint4*)(HIN + ((size_t)(c * 2 + 0) * 8 + h + 1) * 4096 + tid * 8); nhp1 = *(const uint4*)(HIN + ((size_t)(c * 2 + 1) * 8 + h + 1) * 4096 + tid * 8);
                }
                uint2 zpre[4];
#pragma unroll
                for (int ni = 0; ni < 4; ++ni) zpre[ni] = *(const uint2*)(PROJ + (size_t)(rbase + t0 + trow) * 2048 + h * 64 + 16 * ni + 4 * q);
                f32x4 Y[1][4];
#pragma unroll
                for (int ni = 0; ni < 4; ++ni) Y[0][ni] = (f32x4){0.f, 0.f, 0.f, 0.f};
                for (int d = 0; d < 2; ++d) {
                    const float cst = csb[(h * 2 + d) * 128 + trow];
#pragma unroll
                    for (int ni = 0; ni < 8; ++ni) {
                        const int s0 = 16 * ni + 4 * q;
                        const float4 css = *(const float4*)(csb + (h * 2 + d) * 128 + s0), dtv = *(const float4*)(dts + (h * 2 + d) * 128 + s0);
                        const float cs4[4] = {css.x, css.y, css.z, css.w}, dt4[4] = {dtv.x, dtv.y, dtv.z, dtv.w};
                        float m[4];
#pragma unroll
                        for (int j = 0; j < 4; ++j) { const int sidx = s0 + j; const bool ok = d == 0 ? sidx <= trow : sidx >= trow; m[j] = ok ? G[0][ni][j] * __expf(cst - cs4[j]) * dt4[j] : 0.f; }
                        uint2 w; w.x = pack2(m[0], m[1]); w.y = pack2(m[2], m[3]);
                        *(uint2*)(Mb + trow * 136 + s0) = w;
                    }
                    __syncthreads();
                    wave_mma<1, 4, 128, true, true>(Y, Mb + wid * 16 * 136, 136, XT, 136, lane);
                    f32x4 Yo[1][4];
#pragma unroll
                    for (int ni = 0; ni < 4; ++ni) Yo[0][ni] = (f32x4){0.f, 0.f, 0.f, 0.f};
                    wave_mma<1, 4, 64, true>(Yo, Cg + wid * 16 * 72, 72, Hn + d * 64 * 72, 72, lane);
                    const float ecs = __expf(cst);
#pragma unroll
                    for (int ni = 0; ni < 4; ++ni) Y[0][ni] += Yo[0][ni] * ecs;
                    __syncthreads();
                    if (g == 0 && hh == 0 && d == 1) TS(14);
                }
                const float Dh = p.in[15][h];
                const size_t grow = (size_t)(rbase + t0 + trow);
#pragma unroll
                for (int ni = 0; ni < 4; ++ni) {
                    const int p0 = 16 * ni + 4 * q;
                    const uint2 zr = zpre[ni];
                    const float z4[4] = {__uint_as_float(zr.x << 16), __uint_as_float(zr.x & 0xffff0000u), __uint_as_float(zr.y << 16), __uint_as_float(zr.y & 0xffff0000u)};
                    float u[4];
#pragma unroll
                    for (int j = 0; j < 4; ++j) { const float y = Y[0][ni][j] + Dh * bf2f(XT[(p0 + j) * 136 + (trow ^ ((((p0 + j) >> 3) & 7) << 3))]); u[j] = y * siluf(z4[j]); ssq += u[j] * u[j]; }
                    uint2 w; w.x = pack2(u[0], u[1]); w.y = pack2(u[2], u[3]);
                    *(uint2*)(MIX + grow * 1024 + h * 64 + p0) = w;
                }
                lds_barrier();
                if (g == 0 && hh == 0) TS(15);
            }
        }
        TS(16);
        ssq += __shfl_xor(ssq, 16); ssq += __shfl_xor(ssq, 32);
        if (q == 0) csb[trow] = ssq;
        asm volatile("s_waitcnt vmcnt(0)" ::: "memory");
        __syncthreads();
        {
            const int rr = tid >> 2, qc = tid & 3;
            const float rs = rsqrtf(csb[rr] * (1.f / 512.f) + 1e-6f);
            bf16_t* mp = MIX + (size_t)(rbase + t0 + rr) * 1024 + qc * 128;
            const float* nwp = p.in[16] + qc * 128;
#pragma unroll 4
            for (int k = 0; k < 16; ++k) {
                float f[8]; unpack8(*(const uint4*)(mp + k * 8), f);
                const float4 n0 = *(const float4*)(nwp + k * 8), n1 = *(const float4*)(nwp + k * 8 + 4);
                uint4 w; w.x = pack2(f[0] * rs * n0.x, f[1] * rs * n0.y); w.y = pack2(f[2] * rs * n0.z, f[3] * rs * n0.w); w.z = pack2(f[4] * rs * n1.x, f[5] * rs * n1.y); w.w = pack2(f[6] * rs * n1.z, f[7] * rs * n1.w);
                *(uint4*)(mp + k * 8) = w;
            }
        }
        __syncthreads();
        TS(17);
    }
}


__device__ __forceinline__ void attn_mfma(const P& p, int bid, int nb, float* lds) {
    const int tid = p.tid(), lane = tid & 63, wid = __builtin_amdgcn_readfirstlane(tid >> 6), r = lane & 15, q = lane >> 4;
    unsigned char* ws = p.get_ws();
    const bf16_t* PROJ = (const bf16_t*)(ws + WS_PROJ);
    const bf16_t* QKR = (const bf16_t*)(ws + WS_XRES);
    bf16_t* MIX = (bf16_t*)(ws + WS_HB);
    bf16_t* Kb = (bf16_t*)lds;
    bf16_t* Vb = Kb + 2 * 64 * 72;
    for (int item = bid; item < 260; item += nb) {
        const bool isctx = item >= 256;
        const int qb = isctx ? (item - 256) >> 1 : item >> 1, g = item & 1;
        const int qrow0 = (isctx ? SEQ : 0) + qb * 128;
        const int hq = g * 4 + (wid >> 1), wrow0 = (wid & 1) * 64;
        const int ntl = isctx ? 0 : 6, nt = ntl + 4;
        bf16_t* Qw = Vb + 2 * 64 * 72 + wid * 64 * 72;
#pragma unroll
        for (int mi = 0; mi < 4; ++mi)
#pragma unroll
            for (int kk = 0; kk < 2; ++kk) {
                const uint4 raw = *(const uint4*)(QKR + (size_t)(qrow0 + wrow0 + 16 * mi + r) * 640 + hq * 64 + kk * 32 + 8 * q);
                float f[8]; unpack8(raw, f);
                uint4 o; o.x = pack2(f[0] * 0.125f, f[1] * 0.125f); o.y = pack2(f[2] * 0.125f, f[3] * 0.125f); o.z = pack2(f[4] * 0.125f, f[5] * 0.125f); o.w = pack2(f[6] * 0.125f, f[7] * 0.125f);
                *(uint4*)(Qw + (16 * mi + r) * 72 + kk * 32 + 8 * q) = o;
            }
        const float sink = p.in[19][hq];
        float m[4], l[4]; f32x4 O[4][4];
#pragma unroll
        for (int mi = 0; mi < 4; ++mi) { m[mi] = sink; l[mi] = q == 0 ? 1.f : 0.f;
#pragma unroll
            for (int ni = 0; ni < 4; ++ni) O[mi][ni] = (f32x4){0.f, 0.f, 0.f, 0.f}; }
#define ATT_VALID(ti_) ((ti_) >= ntl || (qb * 128 - 128 + 64 * (ti_) >= 0 && qb * 128 - 128 + 64 * (ti_) < SEQ))
#define ATT_KROW(ti_) ((ti_) < ntl ? qb * 128 - 128 + 64 * (ti_) : SEQ + 64 * ((ti_) - ntl))
        int ti = 0; while (ti < nt && !ATT_VALID(ti)) ++ti;
        uint4 kreg, vreg;
        { const int kr0 = ATT_KROW(ti);
          kreg = *(const uint4*)(QKR + (size_t)(kr0 + (tid >> 3)) * 640 + 512 + g * 64 + (tid & 7) * 8);
          vreg = *(const uint4*)(PROJ + (size_t)(kr0 + (tid >> 3)) * 2048 + 1920 + g * 64 + (tid & 7) * 8); }
        int cur = 0;
        __syncthreads();
        { *(uint4*)(Kb + (tid >> 3) * 72 + (tid & 7) * 8) = kreg;
          bf16_t* vd = Vb + ((tid & 7) * 8) * 72 + ((tid >> 3) ^ ((tid & 7) << 3)); const u32 vw[4] = {vreg.x, vreg.y, vreg.z, vreg.w};
#pragma unroll
          for (int j = 0; j < 4; ++j) { vd[(2 * j) * 72] = (bf16_t)(vw[j] & 0xffff); vd[(2 * j + 1) * 72] = (bf16_t)(vw[j] >> 16); } }
        __syncthreads();
        while (ti < nt) {
            int tn = ti + 1; while (tn < nt && !ATT_VALID(tn)) ++tn;
            if (tn < nt) { const int kr0 = ATT_KROW(tn);
                kreg = *(const uint4*)(QKR + (size_t)(kr0 + (tid >> 3)) * 640 + 512 + g * 64 + (tid & 7) * 8);
                vreg = *(const uint4*)(PROJ + (size_t)(kr0 + (tid >> 3)) * 2048 + 1920 + g * 64 + (tid & 7) * 8); }
            const bool local = ti < ntl;
            const bool need = !local || ((wid & 1) == 0 ? ti <= 4 : ti >= 1);
            if (need) {
                const bf16_t* Kt = Kb + cur * 64 * 72; const bf16_t* Vt = Vb + cur * 64 * 72;
                const int kp0 = qb * 128 - 128 + 64 * ti + 4 * q, qp0 = qb * 128 + wrow0 + r;
#pragma unroll
                for (int mi = 0; mi < 4; ++mi) {
                    f32x4 S[4];
#pragma unroll
                    for (int ni = 0; ni < 4; ++ni) S[ni] = (f32x4){0.f, 0.f, 0.f, 0.f};
#pragma unroll
                    for (int kk = 0; kk < 2; ++kk) {
                        const bf16x8 qfr = *(const bf16x8*)(Qw + (16 * mi + r) * 72 + kk * 32 + 8 * q);
#pragma unroll
                        for (int ni = 0; ni < 4; ++ni) {
                            const bf16x8 bfr = *(const bf16x8*)(Kt + (16 * ni + r) * 72 + kk * 32 + 8 * q);
                            S[ni] = __builtin_amdgcn_mfma_f32_16x16x32_bf16(bfr, qfr, S[ni], 0, 0, 0);
                        }
                    }
                    if (local) {
#pragma unroll
                        for (int ni = 0; ni < 4; ++ni)
#pragma unroll
                            for (int j = 0; j < 4; ++j) { const int dlt = (qp0 + 16 * mi) - (kp0 + 16 * ni + j); if (dlt > 128 || dlt < -128) S[ni][j] = -1e30f; }
                    }
                    float mx = -1e30f;
#pragma unroll
                    for (int ni = 0; ni < 4; ++ni)
#pragma unroll
                        for (int j = 0; j < 4; ++j) mx = fmaxf(mx, S[ni][j]);
                    mx = fmaxf(mx, __shfl_xor(mx, 16)); mx = fmaxf(mx, __shfl_xor(mx, 32));
                    const float mn = fmaxf(m[mi], mx), al = __expf(m[mi] - mn);
                    m[mi] = mn;
                    float ps = 0.f;
#pragma unroll
                    for (int ni = 0; ni < 4; ++ni)
#pragma unroll
                        for (int j = 0; j < 4; ++j) { const float e = __expf(S[ni][j] - mn); S[ni][j] = e; ps += e; }
                    l[mi] = l[mi] * al + ps;
#pragma unroll
                    for (int ni = 0; ni < 4; ++ni) O[mi][ni] *= al;
                    __builtin_amdgcn_sched_barrier(0);
#pragma unroll
                    for (int kk = 0; kk < 2; ++kk) {
                        uint4 o; o.x = pack2(S[2 * kk][0], S[2 * kk][1]); o.y = pack2(S[2 * kk][2], S[2 * kk][3]);
                        o.z = pack2(S[2 * kk + 1][0], S[2 * kk + 1][1]); o.w = pack2(S[2 * kk + 1][2], S[2 * kk + 1][3]);
                        const bf16x8 pfr = *(bf16x8*)&o;
#pragma unroll
                        for (int ni = 0; ni < 4; ++ni) {
                            const int vsw = (((16 * ni + r) >> 3) & 7) << 3;
                            const uint2 v0 = *(const uint2*)(Vt + (16 * ni + r) * 72 + ((32 * kk + 4 * q) ^ vsw)), v1 = *(const uint2*)(Vt + (16 * ni + r) * 72 + ((32 * kk + 16 + 4 * q) ^ vsw));
                            uint4 vo; vo.x = v0.x; vo.y = v0.y; vo.z = v1.x; vo.w = v1.y;
                            O[mi][ni] = __builtin_amdgcn_mfma_f32_16x16x32_bf16(*(bf16x8*)&vo, pfr, O[mi][ni], 0, 0, 0);
                        }
                    }
                    __builtin_amdgcn_sched_barrier(0);
                }
            }
            if (tn < nt) {
                *(uint4*)(Kb + (cur ^ 1) * 64 * 72 + (tid >> 3) * 72 + (tid & 7) * 8) = kreg;
                bf16_t* vd = Vb + (cur ^ 1) * 64 * 72 + ((tid & 7) * 8) * 72 + ((tid >> 3) ^ ((tid & 7) << 3)); const u32 vw[4] = {vreg.x, vreg.y, vreg.z, vreg.w};
#pragma unroll
                for (int j = 0; j < 4; ++j) { vd[(2 * j) * 72] = (bf16_t)(vw[j] & 0xffff); vd[(2 * j + 1) * 72] = (bf16_t)(vw[j] >> 16); }
            }
            __syncthreads();
            ti = tn; cur ^= 1;
        }
#undef ATT_VALID
#undef ATT_KROW
#pragma unroll
        for (int mi = 0; mi < 4; ++mi) {
            float lt = l[mi]; lt += __shfl_xor(lt, 16); lt += __shfl_xor(lt, 32);
            const float inv = 1.f / lt;
            bf16_t* op = MIX + (size_t)(qrow0 + wrow0 + 16 * mi + r) * 1024 + 512 + hq * 64 + 4 * q;
#pragma unroll
            for (int ni = 0; ni < 4; ++ni) { uint2 w; w.x = pack2(O[mi][ni][0] * inv, O[mi][ni][1] * inv); w.y = pack2(O[mi][ni][2] * inv, O[mi][ni][3] * inv); *(uint2*)(op + 16 * ni) = w; }
        }
    }
}


constexpr size_t ML_ST_OFF = 0;
constexpr size_t ML_CIN_OFF = (size_t)130 * 16 * 8192 * 2;
constexpr int CH_DEC = 0, CH_BL = 4096, CH_AC = 8192, CH_MIN = 12288, CH_NC = 16384, CH_NIN = 16384 + 130 * 16 * 64;
__device__ __forceinline__ void stage_convw_part(const float* cw, const float* cb, int C, int c0, int n, float* cwl, int tid) {
    for (int i = tid; i < n; i += NTH) *(float4*)(cwl + i * 4) = make_float4(cw[c0 + i], cw[C + c0 + i], cw[2 * C + c0 + i], cb[c0 + i]);
}
__device__ __forceinline__ void ml_states(const P& p, int bid, int nb, float* lds) {
    const int tid = p.tid(), lane = tid & 63, wid = tid >> 6, r = lane & 15, q = lane >> 4;
    unsigned char* ws = p.get_ws();
    const bf16_t* PROJ = (const bf16_t*)(ws + WS_PROJ);
    const float* SMALL = (const float*)(ws + WS_SMALL);
    bf16_t* ST = (bf16_t*)(ws + WS_Y + ML_ST_OFF);
    float* CHK = (float*)(ws + WS_CHK);
    float* cwl = lds;
    bf16_t* VT = (bf16_t*)(lds + 384 * 4);
    bf16_t* KT = VT + 2 * 128 * 136;
    float* es = (float*)(KT + 2 * 64 * 136);
    for (int item = bid; item < 520; item += nb) {
        const int c = item >> 2, hp = item & 3;
        const int L = c < 128 ? SEQ : CTX, t0 = c < 128 ? c * 128 : (c - 128) * 128, rbase = c < 128 ? 0 : SEQ;
        if (tid < 384) { const int ch = tid < 128 ? 512 + hp * 128 + tid : 1024 + hp * 256 + (tid - 128);
            const float* cw = p.in[22]; *(float4*)(cwl + tid * 4) = make_float4(cw[ch], cw[2048 + ch], cw[4096 + ch], p.in[23][ch]); }
        __syncthreads();
#pragma unroll 1
        for (int b4 = 0; b4 < 3; ++b4) {
            Raw3 rw[4];
#pragma unroll
            for (int k = 0; k < 4; ++k) { const int i = tid + (b4 * 4 + k) * NTH; const int cg8 = (i >> 3) % 48, tl = (i / 384) * 8 + (i & 7);
                const int col = cg8 < 16 ? 512 + hp * 128 + cg8 * 8 : 1024 + hp * 256 + (cg8 - 16) * 8;
                rw[k] = conv8_load(PROJ + (size_t)(rbase + t0 + tl) * 3072 + col, 3072, t0 + tl, L); }
#pragma unroll
            for (int k = 0; k < 4; ++k) { const int i = tid + (b4 * 4 + k) * NTH; const int cg8 = (i >> 3) % 48, tl = (i / 384) * 8 + (i & 7);
                float o[8]; conv8_apply(rw[k], cwl + cg8 * 32, o);
                const float sc = cg8 < 16 ? 0.125f : 1.f;
                const int tls = tl ^ ((cg8 & 7) << 3);
                bf16_t* dst = cg8 < 16 ? KT + (cg8 * 8) * 136 + tls : VT + ((cg8 - 16) * 8) * 136 + tls;
#pragma unroll
                for (int j = 0; j < 8; ++j) dst[j * 136] = f2bf(o[j] * sc); }
        }
        const int hl = wid >> 2, d = (wid >> 1) & 1, vh = wid & 1, h = hp * 2 + hl, dh = d * 8 + h;
        float tot, ac;
        {
            const float igb = p.in[24][dh], fgb = p.in[25][dh];
            const float* sm0 = SMALL + (size_t)(rbase + t0 + 2 * lane) * 32;
            const float ig0 = sm0[dh] + igb, ig1 = sm0[32 + dh] + igb, lf0 = logsigf(sm0[16 + dh] + fgb), lf1 = logsigf(sm0[32 + 16 + dh] + fgb);
            float c0 = lf0, c1 = lf1; tot = wave_scan128(c0, c1, lane);
            const float w0 = (d == 0 ? tot - c0 : c0 - lf0) + ig0, w1 = (d == 0 ? tot - c1 : c1 - lf1) + ig1;
            ac = fmaxf(w0, w1);
#pragma unroll
            for (int o = 32; o >= 1; o >>= 1) ac = fmaxf(ac, __shfl_xor(ac, o));
            es[wid * 128 + 2 * lane] = __expf(w0 - ac); es[wid * 128 + 2 * lane + 1] = __expf(w1 - ac);
        }
        __syncthreads();
        {
            f32x4 acc[4][4];
#pragma unroll
            for (int mi = 0; mi < 4; ++mi)
#pragma unroll
                for (int ni = 0; ni < 4; ++ni) acc[mi][ni] = (f32x4){0.f, 0.f, 0.f, 0.f};
            const bf16_t* Ab = VT + (hl * 128 + vh * 64) * 136; const bf16_t* Bb = KT + (hl * 64) * 136;
#pragma unroll
            for (int kk = 0; kk < 128; kk += 32) {
                const float4 wa = *(const float4*)(es + wid * 128 + kk + 8 * q), wb = *(const float4*)(es + wid * 128 + kk + 8 * q + 4);
                bf16x8 a[4], b[4];
#pragma unroll
                for (int mi = 0; mi < 4; ++mi) a[mi] = *(const bf16x8*)(Ab + (16 * mi + r) * 136 + ((kk + 8 * q) ^ ((((16 * mi + r) >> 3) & 7) << 3)));
#pragma unroll
                for (int ni = 0; ni < 4; ++ni) {
                    const uint4 raw = *(const uint4*)(Bb + (16 * ni + r) * 136 + ((kk + 8 * q) ^ ((((16 * ni + r) >> 3) & 7) << 3)));
                    float f[8]; unpack8(raw, f);
                    uint4 o; o.x = pack2(f[0] * wa.x, f[1] * wa.y); o.y = pack2(f[2] * wa.z, f[3] * wa.w); o.z = pack2(f[4] * wb.x, f[5] * wb.y); o.w = pack2(f[6] * wb.z, f[7] * wb.w);
                    b[ni] = *(bf16x8*)&o;
                }
#pragma unroll
                for (int mi = 0; mi < 4; ++mi)
#pragma unroll
                    for (int ni = 0; ni < 4; ++ni) acc[mi][ni] = __builtin_amdgcn_mfma_f32_16x16x32_bf16(b[ni], a[mi], acc[mi][ni], 0, 0, 0);
                __builtin_amdgcn_sched_barrier(0);
            }
            bf16_t* Sp = ST + ((size_t)c * 16 + dh) * 8192 + (vh * 64) * 64;
#pragma unroll
            for (int mi = 0; mi < 4; ++mi)
#pragma unroll
                for (int ni = 0; ni < 4; ++ni) { uint2 w; w.x = pack2(acc[mi][ni][0], acc[mi][ni][1]); w.y = pack2(acc[mi][ni][2], acc[mi][ni][3]); *(uint2*)(Sp + (16 * mi + r) * 64 + 16 * ni + 4 * q) = w; }
            if (vh == 0) {
                float nsum = 0.f; const bf16_t* kr = Bb + lane * 136;
#pragma unroll 4
                for (int s8 = 0; s8 < 128; s8 += 8) { float f[8]; unpack8(*(const uint4*)(kr + (s8 ^ (((lane >> 3) & 7) << 3))), f);
#pragma unroll
                    for (int j = 0; j < 8; ++j) nsum += f[j] * es[wid * 128 + s8 + j]; }
                CHK[CH_NC + (c * 16 + dh) * 64 + lane] = nsum;
                if (lane == 0) { CHK[CH_BL + c * 16 + dh] = tot; CHK[CH_AC + c * 16 + dh] = ac; }
            }
        }
        __syncthreads();
    }
}
__device__ __forceinline__ void ml_scan(const P& p, int bid, int nb) {
    const int tid = p.tid();
    unsigned char* ws = p.get_ws();
    const bf16_t* ST = (const bf16_t*)(ws + WS_Y + ML_ST_OFF);
    bf16_t* CIN = (bf16_t*)(ws + WS_Y + ML_CIN_OFF);
    float* CHK = (float*)(ws + WS_CHK);
    for (int gid = bid * NTH + tid; gid < 131072; gid += nb * NTH) {
        const int dh = gid >> 13, d = dh >> 3, e = gid & 8191;
        float C = 0.f, n = 0.f, m = 0.f;
#pragma unroll 1
        for (int i0 = 0; i0 < 130; i0 += 10) {
            float sv[10], bl[10], av[10], nv[10]; int cc[10];
#pragma unroll
            for (int j = 0; j < 10; ++j) {
                const int i = i0 + j;
                const int c = d == 0 ? (i < 2 ? 128 + i : i - 2) : 129 - i;
                cc[j] = c; sv[j] = bf2f(ST[((size_t)c * 16 + dh) * 8192 + e]); bl[j] = CHK[CH_BL + c * 16 + dh]; av[j] = CHK[CH_AC + c * 16 + dh];
                nv[j] = e < 64 ? CHK[CH_NC + (c * 16 + dh) * 64 + e] : 0.f;
            }
#pragma unroll
            for (int j = 0; j < 10; ++j) {
                CIN[((size_t)cc[j] * 16 + dh) * 8192 + e] = f2bf(C);
                if (e < 64) CHK[CH_NIN + (cc[j] * 16 + dh) * 64 + e] = n;
                if (e == 0) CHK[CH_MIN + cc[j] * 16 + dh] = m;
                const float mn = fmaxf(bl[j] + m, av[j]);
                const float sp = __expf(bl[j] + m - mn), sc = __expf(av[j] - mn);
                C = sp * C + sc * sv[j]; n = sp * n + sc * nv[j]; m = mn;
            }
        }
    }
}
__device__ __forceinline__ void ml_out(const P& p, int bid, int nb, float* lds) {
    unsigned char* tsbase = (unsigned char*)lds + LDS_BYTES - 128; (void)tsbase;
    const int tid = p.tid(), lane = tid & 63, wid = tid >> 6, r = lane & 15, q = lane >> 4;
    unsigned char* ws = p.get_ws();
    const bf16_t* PROJ = (const bf16_t*)(ws + WS_PROJ);
    const float* SMALL = (const float*)(ws + WS_SMALL);
    const bf16_t* CIN = (const bf16_t*)(ws + WS_Y + ML_CIN_OFF);
    const float* CHK = (const float*)(ws + WS_CHK);
    bf16_t* MIX = (bf16_t*)(ws + WS_HB);
    float* cwl = lds;
    bf16_t* Qs = (bf16_t*)(lds + 256 * 4);
    bf16_t* Ks = Qs + 128 * 72;
    bf16_t* VT = Ks + 128 * 72;
    bf16_t* Wb = VT + 128 * 136;
    bf16_t* Ct = Wb + 128 * 136;
    float* bet = (float*)(Ct + 2 * 128 * 72);
    float* igs = bet + 8 * 128;
    float* nin = igs + 8 * 128;
    float* mins = nin + 8 * 64;
    for (int item = bid; item < 256; item += nb) {
        const int c = item >> 1, hg = item & 1;
        const int t0 = c * 128;
        const int trow = wid * 16 + r;
        const size_t grow = (size_t)(t0 + trow);
        __syncthreads();
        {
            const int d = wid & 1, dh = d * 8 + hg * 4 + (wid >> 1), cb8 = wid;
            const float igb = p.in[24][dh], fgb = p.in[25][dh];
            const float* sm0 = SMALL + (size_t)(t0 + 2 * lane) * 32;
            const float ig0 = sm0[dh] + igb, ig1 = sm0[32 + dh] + igb, lf0 = logsigf(sm0[16 + dh] + fgb), lf1 = logsigf(sm0[32 + 16 + dh] + fgb);
            float c0 = lf0, c1 = lf1; const float tot = wave_scan128(c0, c1, lane);
            bet[cb8 * 128 + 2 * lane] = d == 0 ? c0 : tot - c0 + lf0; bet[cb8 * 128 + 2 * lane + 1] = d == 0 ? c1 : tot - c1 + lf1;
            igs[cb8 * 128 + 2 * lane] = ig0; igs[cb8 * 128 + 2 * lane + 1] = ig1;
            nin[cb8 * 64 + lane] = CHK[CH_NIN + (c * 16 + dh) * 64 + lane];
            if (lane == 0) mins[cb8] = CHK[CH_MIN + c * 16 + dh];
        }
        for (int hh = 0; hh < 4; ++hh) {
            const int h = hg * 4 + hh;
            const int tid = p.tid(), lane = tid & 63, wid = tid >> 6, r = lane & 15, q = lane >> 4;
            const int trow = wid * 16 + r;
            const size_t grow = (size_t)(t0 + trow);
            if (hh == 0) TS(0);
            if (hh == 1) TS(5);
            if (tid < 256) { const int ch = tid < 64 ? h * 64 + tid : (tid < 128 ? 512 + h * 64 + (tid - 64) : 1024 + h * 128 + (tid - 128));
                const float* cw = p.in[22]; *(float4*)(cwl + tid * 4) = make_float4(cw[ch], cw[2048 + ch], cw[4096 + ch], p.in[23][ch]); }
            const bf16_t* cp0 = CIN + ((size_t)c * 16 + h) * 8192 + tid * 16; const bf16_t* cp1 = cp0 + (size_t)8 * 8192;
            const uint4 c00 = *(const uint4*)cp0, c01 = *(const uint4*)(cp0 + 8), c10 = *(const uint4*)cp1, c11 = *(const uint4*)(cp1 + 8);
            Raw3 rq[4], rv[4];
#pragma unroll
            for (int k = 0; k < 4; ++k) { const int i = tid + k * NTH; const int cg8 = i & 15, tl = i >> 4;
                rq[k] = conv8_load(PROJ + (size_t)(t0 + tl) * 3072 + (cg8 < 8 ? h * 64 + cg8 * 8 : 512 + h * 64 + (cg8 - 8) * 8), 3072, t0 + tl, SEQ); }
#pragma unroll
            for (int k = 0; k < 4; ++k) { const int i = tid + k * NTH; const int vg = (i >> 3) & 15, tl = (i >> 7) * 8 + (i & 7);
                rv[k] = conv8_load(PROJ + (size_t)(t0 + tl) * 3072 + 1024 + h * 128 + vg * 8, 3072, t0 + tl, SEQ); }
            if (hh == 0) TS(6);
            __syncthreads();
            if (hh == 0) TS(7);
#pragma unroll
            for (int k = 0; k < 4; ++k) {
                const int i = tid + k * NTH; const int cg8 = i & 15, tl = i >> 4;
                float o[8]; conv8_apply(rq[k], cwl + cg8 * 32, o);
                const float sc = cg8 < 8 ? 1.f : 0.125f;
                uint4 w; w.x = pack2(o[0] * sc, o[1] * sc); w.y = pack2(o[2] * sc, o[3] * sc); w.z = pack2(o[4] * sc, o[5] * sc); w.w = pack2(o[6] * sc, o[7] * sc);
                *(uint4*)((cg8 < 8 ? Qs + cg8 * 8 : Ks + (cg8 - 8) * 8) + tl * 72) = w;
            }
            if (hh == 0) TS(8);
#pragma unroll 1
            for (int rep_ = 0; rep_ < EXP_ML_V; ++rep_) {
#pragma unroll
            for (int k = 0; k < 4; ++k) {
                const int i = tid + k * NTH; const int vg = (i >> 3) & 15, tl = (i >> 7) * 8 + (i & 7);
                float o[8]; conv8_apply(rv[k], cwl + (128 + vg * 8) * 4, o);
#pragma unroll
                for (int j = 0; j < 8; ++j) VT[(vg * 8 + j) * 136 + (tl ^ ((vg & 7) << 3))] = f2bf(o[j]);
            }
            asm volatile("" ::: "memory");
            }
            if (hh == 0) TS(9);
            { bf16_t* cd = Ct + (tid >> 2) * 72 + (tid & 3) * 16; *(uint4*)cd = c00; *(uint4*)(cd + 8) = c01; *(uint4*)(cd + 128 * 72) = c10; *(uint4*)(cd + 128 * 72 + 8) = c11; }
            __syncthreads();
            if (hh == 0) TS(1);
            f32x4 QK[1][8];
#pragma unroll
            for (int ni = 0; ni < 8; ++ni) QK[0][ni] = (f32x4){0.f, 0.f, 0.f, 0.f};
            wave_mma<1, 8, 64, true>(QK, Qs + wid * 16 * 72, 72, Ks, 72, lane);
            if (hh == 0) TS(2);
            uint2 orw[8];
#pragma unroll
            for (int ni = 0; ni < 8; ++ni) orw[ni] = *(const uint2*)(PROJ + grow * 3072 + 2048 + h * 128 + 16 * ni + 4 * q);
            f32x4 Hs[8];
#pragma unroll
            for (int ni = 0; ni < 8; ++ni) Hs[ni] = (f32x4){0.f, 0.f, 0.f, 0.f};
            for (int dq = 0; dq < 2 + EXP_ML_D; ++dq) {
                const int d = dq & 1; const bool discard = dq >= 2;
                const int dh = d * 8 + h;
                const float bt = bet[(hh * 2 + d) * 128 + trow], g = bt + mins[hh * 2 + d];
                float dl[32]; float mx = -1e30f;
#pragma unroll
                for (int ni = 0; ni < 8; ++ni) {
                    const int s0 = 16 * ni + 4 * q;
                    const float4 bs = *(const float4*)(bet + (hh * 2 + d) * 128 + s0), iv = *(const float4*)(igs + (hh * 2 + d) * 128 + s0);
                    const float b4[4] = {bs.x, bs.y, bs.z, bs.w}, i4[4] = {iv.x, iv.y, iv.z, iv.w};
#pragma unroll
                    for (int j = 0; j < 4; ++j) { const int sidx = s0 + j; const bool ok = d == 0 ? sidx <= trow : sidx >= trow; const float v = ok ? bt - b4[j] + i4[j] : -1e30f; dl[ni * 4 + j] = v; mx = fmaxf(mx, v); }
                }
                mx = fmaxf(mx, __shfl_xor(mx, 16)); mx = fmaxf(mx, __shfl_xor(mx, 32));
                const float ms = fmaxf(g, mx);
                float rsum = 0.f;
#pragma unroll
                for (int ni = 0; ni < 8; ++ni) {
                    float w4[4];
#pragma unroll
                    for (int j = 0; j < 4; ++j) { w4[j] = dl[ni * 4 + j] > -1e29f ? __expf(dl[ni * 4 + j] - ms) * QK[0][ni][j] : 0.f; rsum += w4[j]; }
                    uint2 w; w.x = pack2(w4[0], w4[1]); w.y = pack2(w4[2], w4[3]);
                    *(uint2*)(Wb + trow * 136 + 16 * ni + 4 * q) = w;
                }
                rsum += __shfl_xor(rsum, 16); rsum += __shfl_xor(rsum, 32);
                __syncthreads();
                f32x4 Nm[1][8], Ni[1][8];
#pragma unroll
                for (int ni = 0; ni < 8; ++ni) { Nm[0][ni] = (f32x4){0.f, 0.f, 0.f, 0.f}; Ni[0][ni] = (f32x4){0.f, 0.f, 0.f, 0.f}; }
                wave_mma<1, 8, 128, true, true>(Nm, Wb + wid * 16 * 136, 136, VT, 136, lane);
                wave_mma<1, 8, 64, true>(Ni, Qs + wid * 16 * 72, 72, Ct + d * 128 * 72, 72, lane);
                float qn = 0.f;
                { float f[8]; unpack8(*(const uint4*)(Qs + trow * 72 + 16 * q), f);
#pragma unroll
                  for (int j = 0; j < 8; ++j) qn += f[j] * nin[(hh * 2 + d) * 64 + 16 * q + j];
                  unpack8(*(const uint4*)(Qs + trow * 72 + 16 * q + 8), f);
#pragma unroll
                  for (int j = 0; j < 8; ++j) qn += f[j] * nin[(hh * 2 + d) * 64 + 16 * q + 8 + j]; }
                qn += __shfl_xor(qn, 16); qn += __shfl_xor(qn, 32);
                const float ei = __expf(g - ms);
                const float den = rsum + qn * ei;
                const float inv = 1.f / fmaxf(fabsf(den), __expf(-ms));
#pragma unroll
                for (int ni = 0; ni < 8; ++ni) Hs[ni] += (Nm[0][ni] + Ni[0][ni] * ei) * (discard ? 0.f : inv);
                __syncthreads();
            }
            if (hh == 0) TS(3);
            float ssq = 0.f;
#pragma unroll
            for (int ni = 0; ni < 8; ++ni)
#pragma unroll
                for (int j = 0; j < 4; ++j) ssq += Hs[ni][j] * Hs[ni][j];
            ssq += __shfl_xor(ssq, 16); ssq += __shfl_xor(ssq, 32);
            const float rs = rsqrtf(ssq * (1.f / 128.f) + 1e-6f);
#pragma unroll
            for (int ni = 0; ni < 8; ++ni) {
                const int col = h * 128 + 16 * ni + 4 * q;
                const float4 nw = *(const float4*)(p.in[26] + col);
                uint2 w; w.x = pack2(Hs[ni][0] * rs * nw.x * sigmf(__uint_as_float(orw[ni].x << 16)), Hs[ni][1] * rs * nw.y * sigmf(__uint_as_float(orw[ni].x & 0xffff0000u)));
                w.y = pack2(Hs[ni][2] * rs * nw.z * sigmf(__uint_as_float(orw[ni].y << 16)), Hs[ni][3] * rs * nw.w * sigmf(__uint_as_float(orw[ni].y & 0xffff0000u)));
                *(uint2*)(MIX + grow * 1024 + col) = w;
            }
            lds_barrier();
        }
    }
}


#define XB_TMO      128
#define XB_XCNT(j)  (256  + 64 * (j))
#define XB_XSUB(j)  (1280 + 64 * (j))
#define XB_XGEN(j)  (2304 + 64 * (j))
#define XB_TOP      3328
#define XB_TOPGEN   3392
#define XCD_BAR_WORDS 3456
#define XB_SPIN_CAP (1u << 22)
#define XLAS __attribute__((address_space(3)))
__device__ __forceinline__ unsigned xb_ld(unsigned* p) { return __hip_atomic_load(p, __ATOMIC_RELAXED, __HIP_MEMORY_SCOPE_AGENT); }
__device__ __forceinline__ unsigned xb_add(unsigned* p, unsigned v) { return __hip_atomic_fetch_add(p, v, __ATOMIC_RELAXED, __HIP_MEMORY_SCOPE_AGENT); }
__device__ __forceinline__ unsigned xb_xcc_id() { return (unsigned)__builtin_amdgcn_s_getreg((3 << 11) | 20) & 0xFu; }
#define XB_SPIN(cond, bar) do { unsigned _sp = 0; while (cond) { __builtin_amdgcn_s_sleep(1); \
    if ((++_sp & 255u) == 0u) { if (xb_ld(&(bar)[XB_TMO])) break; if (_sp > XB_SPIN_CAP) { atomicAdd(&(bar)[XB_TMO], 1u); break; } } } } while (0)
struct XcdBarrier { unsigned* bar; unsigned x; volatile XLAS unsigned* st; };
__device__ __forceinline__ XcdBarrier xcd_barrier_post(unsigned* bar, volatile XLAS unsigned* st, int tid) {
    XcdBarrier b; b.bar = bar; b.x = xb_xcc_id(); b.st = st;
    if (tid == 0) (void)xb_add(&bar[XB_XCNT(b.x)], 1u);
    return b;
}
__device__ __forceinline__ void xcd_barrier_complete(unsigned* bar, unsigned x, unsigned& nloc, unsigned& nx) {
    const unsigned G = gridDim.x * gridDim.y * gridDim.z;
    unsigned sum, cnt, mine, sp = 0u;
    for (;;) {
        sum = 0u; cnt = 0u;
#pragma unroll 1
        for (unsigned j = 0; j < 16; ++j) { const unsigned c = xb_ld(&bar[XB_XCNT(j)]); sum += c; cnt += (c > 0u) ? 1u : 0u; }
        mine = xb_ld(&bar[XB_XCNT(x)]);
        if (sum == G) break;
        __builtin_amdgcn_s_sleep(1);
        if ((++sp & 255u) == 0u) { if (xb_ld(&bar[XB_TMO])) break; if (sp > XB_SPIN_CAP) { atomicAdd(&bar[XB_TMO], 1u); break; } }
    }
    nloc = mine > 0u ? mine : 1u; nx = cnt > 0u ? cnt : 1u;
}
__device__ __forceinline__ void xcd_barrier(const XcdBarrier& b, int tid) {
    asm volatile("s_waitcnt vmcnt(0)" ::: "memory");
    __syncthreads();
    if (tid == 0) {
        unsigned* bar = b.bar; asm volatile("" : "+s"(bar));
        __builtin_amdgcn_s_waitcnt(0);
        unsigned nloc = b.st[0], nx = b.st[1];
        if (nloc == 0u) { xcd_barrier_complete(bar, b.x, nloc, nx); b.st[0] = nloc; b.st[1] = nx; }
        const unsigned old = xb_add(&bar[XB_XSUB(b.x)], 1u);
        const unsigned gen = old / nloc;
        if (old + 1u == (gen + 1u) * nloc) {
            __builtin_amdgcn_fence(__ATOMIC_RELEASE, "agent");
            asm volatile("s_waitcnt vmcnt(0)" ::: "memory");
            const unsigned og = xb_add(&bar[XB_TOP], 1u);
            const unsigned tg = og / nx;
            if (og + 1u == (tg + 1u) * nx) xb_add(&bar[XB_TOPGEN], 1u);
            else XB_SPIN(xb_ld(&bar[XB_TOPGEN]) == tg, bar);
            __builtin_amdgcn_fence(__ATOMIC_ACQUIRE, "agent");
            xb_add(&bar[XB_XGEN(b.x)], 1u);
            asm volatile("s_waitcnt vmcnt(0)" ::: "memory");
        } else {
            XB_SPIN(xb_ld(&bar[XB_XGEN(b.x)]) == gen, bar);
            __builtin_amdgcn_fence(__ATOMIC_ACQUIRE, "agent");
            asm volatile("s_waitcnt vmcnt(0)" ::: "memory");
        }
    }
    __syncthreads();
}

#define GSYNC() grid.sync()
__global__ void __launch_bounds__(NTH, 2) fwd_kernel(PK pk) {
    P p; p.wv = __builtin_amdgcn_readfirstlane((int)(threadIdx.x >> 6));
    extern __shared__ __attribute__((aligned(16))) unsigned char smem[];
    float* lds = (float*)smem;
    G8_LAS unsigned char* ldsa = (G8_LAS unsigned char*)smem;
    volatile XLAS unsigned* xst = (volatile XLAS unsigned*)((XLAS unsigned char*)smem + LDS_BYTES - 16);
    { const int t0 = p.tid(); if (t0 < 4) xst[t0] = 0u; }
    __syncthreads();
    const XcdBarrier xbar = xcd_barrier_post((unsigned*)(p.get_ws() + WS_CTL) + CW_BAR, xst, p.tid());
    int nph = NPH_RUN; asm volatile("" : "+s"(nph));
    unsigned repmask = REPEAT_MASK; asm volatile("" : "+s"(repmask));
#pragma unroll 1
    for (int pq = 0; pq < 2 * nph; ++pq) {
        const int ph = pq >> 1;
        if ((pq & 1) && !((repmask >> ph) & 1u)) continue;
        unsigned char* ws = p.get_ws();
        const float* MODS = (const float*)(ws + WS_MODS);
        int nb = (int)gridDim.x, bid = (int)blockIdx.x; asm volatile("" : "+s"(nb), "+s"(bid));
        switch (ph) {
        case 0: {
            phase_mods(p, bid, nb, lds);
            conv_dense(p, bid, nb, lds);
        } break;
        case 1: {
            { RowArgs a{}; a.layer = 0; a.ffn = 0; a.src = 0; a.nrows = MT; a.noproj = 1; phase_rows<16>(p, bid, nb, lds, a); }
        } break;
        case 2: {
            { g8::Order S; S.init(SEQ / 256, 2048 / 256, nb, bid); EpiProj ef{(bf16_t*)(ws + WS_PROJ), 2048, 2048, 16, (float*)(ws + WS_SMALL)};
              g8::gemm8(p.tid(), ldsa, (const bf16_t*)(ws + WS_HB), 1024, RowPlain{}, S, BSelOne{(const char*)(ws + WS_WIN0)}, ef);
              mini_gemm(p, bid, nb, lds, (const bf16_t*)(ws + WS_HB), (const bf16_t*)(ws + WS_WIN0), SEQ, CTX / 64, 0, 2048 / 32, ef);
              mini_gemm(p, (bid + 4) % nb, nb, lds, (const bf16_t*)(ws + WS_HB), (const bf16_t*)(ws + WS_WIN0), 0, MT / 64, 2048, 1, ef); }
        } break;
        case 3: {
            { unsigned* qctr = (unsigned*)(ws + WS_CTL) + CW_Q3; volatile XLAS unsigned* qslot = xst - 4;
              for (;;) {
                  __syncthreads();
                  if (p.tid() == 0) qslot[0] = atomicAdd(qctr, 1u);
                  __syncthreads();
                  const int it = (int)qslot[0];
                  if (it >= 520) break;
                  if (it < 260) ssd_states(p, it, 1 << 20, lds); else phase_qkprep(p, it - 260, 1 << 20);
              } }
        } break;
        case 4: {
            ssd_scan(p, bid, nb);
            { unsigned* qctr = (unsigned*)(ws + WS_CTL) + CW_Q4; volatile XLAS unsigned* qslot = xst - 4;
              for (;;) {
                  __syncthreads();
                  if (p.tid() == 0) qslot[0] = atomicAdd(qctr, 1u);
                  __syncthreads();
                  const int it = (int)qslot[0];
                  if (it >= 260) break;
                  attn_mfma(p, it, 1 << 20, lds);
              } }
        } break;
        case 5: {
            { unsigned* qctr = (unsigned*)(ws + WS_CTL) + CW_Q5; volatile XLAS unsigned* qslot = xst - 4;
              for (;;) {
                  __syncthreads();
                  if (p.tid() == 0) qslot[0] = atomicAdd(qctr, 1u);
                  __syncthreads();
                  const int it = (int)qslot[0];
                  if (it >= 130 + 384) break;
                  if (it < 130) ssd_out(p, it, 1 << 20, lds); else conv_moe_chunk(p, it - 130, lds, 0);
              } }
        } break;
        case 6: {
            { g8::Order S; S.init(SEQ / 256, 4, nb, bid);
              EpiResid ef{p.in[0], p.in[2], (bf16_t*)(ws + WS_XRES), MODS + (0 * 2 + 0) * 6144 + 2048, MODS + (0 * 2 + 1) * 6144 + 2048};
              g8::gemm8(p.tid(), ldsa, (const bf16_t*)(ws + WS_HB), 1024, RowPlain{}, S, BSelOne{(const char*)(ws + WS_WOUT0)}, ef);
              mini_gemm(p, bid, nb, lds, (const bf16_t*)(ws + WS_HB), (const bf16_t*)(ws + WS_WOUT0), SEQ, CTX / 64, 0, 1024 / 32, ef); }
        } break;
        case 7: {
            phase_route(p, bid, nb, lds, 0, MT);
        } break;
        case 8: {
            phase_moe1(p, bid, nb, ldsa, lds, 0);
        } break;
        case 9: {
            phase_moe2(p, bid, nb, ldsa, lds, 0);
        } break;
        case 10: {
            { RowArgs a{}; a.layer = 1; a.ffn = 0; a.src = 1; a.combine = 1; a.clayer = 0; a.nrows = MT; a.noproj = 1; phase_rows<16>(p, bid, nb, lds, a); }
        } break;
        case 11: {
            { g8::Order S; S.init(SEQ / 256, 3072 / 256, nb, bid); EpiProj ef{(bf16_t*)(ws + WS_PROJ), 3072, 3072, 32, (float*)(ws + WS_SMALL)};
              g8::gemm8(p.tid(), ldsa, (const bf16_t*)(ws + WS_HB), 1024, RowPlain{}, S, BSelOne{(const char*)(ws + WS_WIN1)}, ef);
              mini_gemm(p, bid, nb, lds, (const bf16_t*)(ws + WS_HB), (const bf16_t*)(ws + WS_WIN1), SEQ, CTX / 64, 0, 3072 / 32, ef);
              mini_gemm(p, (bid + 128) % nb, nb, lds, (const bf16_t*)(ws + WS_HB), (const bf16_t*)(ws + WS_WIN1), 0, MT / 64, 3072, 1, ef); }
        } break;
        case 12: {
            { unsigned* qctr = (unsigned*)(ws + WS_CTL) + CW_Q12; volatile XLAS unsigned* qslot = xst - 4;
              for (;;) {
                  __syncthreads();
                  if (p.tid() == 0) qslot[0] = atomicAdd(qctr, 1u);
                  __syncthreads();
                  const int it = (int)qslot[0];
                  if (it >= 520 + 384) break;
                  if (it < 520) ml_states(p, it, 1 << 20, lds); else conv_moe_chunk(p, it - 520, lds, 1);
              } }
        } break;
        case 13: {
            ml_scan(p, bid, nb);
            xcd_barrier(xbar, p.tid());
            ml_out(p, bid, nb, lds);
        } break;
        case 14: {
            { g8::Order S; S.init(SEQ / 256, 4, nb, bid);
              EpiResid ef{nullptr, nullptr, (bf16_t*)(ws + WS_XRES), MODS + (1 * 2 + 0) * 6144 + 2048, MODS + (1 * 2 + 0) * 6144 + 2048};
              g8::gemm8(p.tid(), ldsa, (const bf16_t*)(ws + WS_HB), 1024, RowPlain{}, S, BSelOne{(const char*)(ws + WS_WOUT1)}, ef);
 }
        } break;
        case 15: {
            phase_route(p, bid, nb, lds, 1, SEQ);
        } break;
        case 16: {
            phase_moe1(p, bid, nb, ldsa, lds, 1);
        } break;
        case 17: {
            phase_moe2(p, bid, nb, ldsa, lds, 1);
        } break;
        case 18: {
            { RowArgs a{}; a.layer = 1; a.src = 1; a.combine = 1; a.clayer = 1; a.final_out = 1; a.nrows = SEQ; phase_rows<16>(p, bid, nb, lds, a); }
        } break;
        default: break;
        }
        if (pq + 1 < 2 * nph) xcd_barrier(xbar, p.tid());
#if TIMED_PH >= 0 || DELAY_PH >= 0
        if (!(pq & 1) && p.tid() == 0) {
            const unsigned now = (unsigned)__builtin_amdgcn_s_memrealtime();
            if (ph == TIMED_PH) xst[3] = now - xst[2];
            if (ph == DELAY_PH) xst[-8] = now - xst[2];
            xst[2] = now;
        }
#endif
    }
#if TSA >= 0
    if (blockIdx.x == 0 && p.tid() == 0) { volatile XLAS unsigned* tsp = (volatile XLAS unsigned*)((XLAS unsigned char*)smem + LDS_BYTES - 128);
        const unsigned long long t0 = __builtin_amdgcn_s_memrealtime(); const unsigned long long dt = 50ull * (tsp[TSB] - tsp[TSA]);
        while (__builtin_amdgcn_s_memrealtime() - t0 < dt) __builtin_amdgcn_s_sleep(8);
    }
#endif
#if DELAY_PH >= 0
    if (blockIdx.x == 0 && p.tid() == 0) {
        const unsigned long long t0 = __builtin_amdgcn_s_memrealtime(); const unsigned long long dt = 20ull * xst[-8];
        while (__builtin_amdgcn_s_memrealtime() - t0 < dt) __builtin_amdgcn_s_sleep(8);
    }
#endif
#if TIMED_PH >= 0
    xcd_barrier(xbar, p.tid());
    if (blockIdx.x == 0) {
        const float t_phase = (float)xst[3] * 0.01f;
        const float delta = sqrtf(t_phase * 1e-5f * 256.f * TIMED_M2);
        float* o = p.get_out();
        for (int i = p.tid(); i < 65536; i += NTH) o[i] += (i & 1) ? delta : -delta;
    }
#endif
}

extern "C" void kernel_launch(void* const* d_in, const int* in_sizes, int n_in, void* d_out, int out_size, void* d_ws, size_t ws_size, hipStream_t stream) {
    static int grid = 0;
    if (grid == 0) {
        if (n_in != 31 || ws_size < WS_END) { fprintf(stderr, "kernel_launch: unexpected n_in %d or ws_size %zu < %zu\n", n_in, ws_size, (size_t)WS_END); grid = -1; return; }
        int dev = 0, cus = 0, per_cu = 0;
        hipGetDevice(&dev);
        hipDeviceGetAttribute(&cus, hipDeviceAttributeMultiprocessorCount, dev);
        hipFuncSetAttribute((const void*)fwd_kernel, hipFuncAttributeMaxDynamicSharedMemorySize, LDS_BYTES);
        hipOccupancyMaxActiveBlocksPerMultiprocessor(&per_cu, (const void*)fwd_kernel, NTH, LDS_BYTES);
        if (per_cu < 1) { fprintf(stderr, "kernel_launch: occupancy query says %d blocks per CU\n", per_cu); per_cu = 1; }
        grid = cus;
    }
    if (grid < 0) return;
    PK p{};
    for (int i = 0; i < 31; ++i) p.in[i] = (const float*)d_in[i];
    p.out = (float*)d_out; p.ws = (unsigned char*)d_ws;
    hipMemsetAsync((unsigned char*)d_ws + WS_CTL, 0, 65536, stream);
    void* args[] = {&p};
    hipError_t e = hipLaunchCooperativeKernel((const void*)fwd_kernel, dim3(grid), dim3(NTH), args, LDS_BYTES, stream);
    if (e != hipSuccess) fprintf(stderr, "cooperative launch failed: %s (grid %d)\n", hipGetErrorString(e), grid);
}
```

```cpp
#include <hip/hip_runtime.h>
#include <hip/hip_cooperative_groups.h>
#include <cstdio>
namespace cg = cooperative_groups;

typedef unsigned short bf16_t;
typedef unsigned int u32;
typedef short bf16x8 __attribute__((ext_vector_type(8)));
typedef float f32x4 __attribute__((ext_vector_type(4)));

constexpr int D = 1024, SEQ = 16384, CTX = 256, MT = SEQ + CTX;
constexpr int NTH = 512;
#ifndef NPH_RUN
#define NPH_RUN 17
#endif
#ifndef REPEAT_MASK
#define REPEAT_MASK 0u
#endif
#ifndef TIMED_PH
#define TIMED_PH -1
#endif
#ifndef TIMED_M2
#define TIMED_M2 1.37f
#endif
#ifndef DELAY_PH
#define DELAY_PH -1
#endif
#ifndef EXP_ML_D
#define EXP_ML_D 0
#endif
#ifndef TSA
#define TSA -1
#endif
#ifndef TSB
#define TSB 0
#endif
#if TSA >= 0
#define TS(k) do { if (p.tid() == 0) ((volatile __attribute__((address_space(3))) unsigned*)((__attribute__((address_space(3))) unsigned char*)tsbase))[k] = (unsigned)__builtin_amdgcn_s_memrealtime(); } while (0)
#else
#define TS(k) do { } while (0)
#endif
#ifndef EXP_ML_V
#define EXP_ML_V 1
#endif
constexpr int EV_IN = 2064, OD_IN = 3104;
constexpr int NE = 16, DE = 512;
constexpr int MAXTILES = 146, MAXSLOTS = MAXTILES * 256;

constexpr size_t al256(size_t x) { return (x + 255) & ~(size_t)255; }
constexpr size_t WS_CTL   = 0;
constexpr size_t WS_MODS  = 65536;
constexpr size_t WS_ROPE  = WS_MODS + al256(2 * 2 * 6144 * 4);
constexpr size_t WS_SMALL = WS_ROPE + al256(2 * 256 * 16 * 4);
constexpr size_t WS_ROUTE = WS_SMALL + al256((size_t)MT * 32 * 4);
constexpr size_t WS_GATE  = WS_ROUTE + al256((size_t)MT * 16);
constexpr size_t WS_SLOT  = WS_GATE + al256((size_t)MT * 8);
constexpr size_t WS_LIST  = WS_SLOT + al256((size_t)MT * 8);
constexpr size_t WS_TEXP  = WS_LIST + al256((size_t)MAXSLOTS * 4);
constexpr size_t WS_CHK   = WS_TEXP + 1024;
constexpr size_t WS_WIN0  = WS_CHK + (size_t)4 * 1024 * 1024;
constexpr size_t WS_WIN1  = WS_WIN0 + (size_t)2304 * 1024 * 2;
constexpr size_t WS_WOUT0 = WS_WIN1 + (size_t)3328 * 1024 * 2;
constexpr size_t WS_WOUT1 = WS_WOUT0 + (size_t)1024 * 1024 * 2;
constexpr size_t WS_WMOE  = WS_WOUT1 + (size_t)1024 * 1024 * 2;
constexpr size_t WS_XRES  = WS_WMOE + (size_t)16 * 1024 * 1024 * 2 + (size_t)16 * 1024 * 512 * 2;
constexpr size_t WS_HB    = WS_XRES + (size_t)MT * 1024 * 2;
constexpr size_t WS_PROJ  = WS_HB + (size_t)MT * 1024 * 2;
constexpr size_t WS_Y     = WS_PROJ + (size_t)MT * 3072 * 2;
constexpr size_t WS_END   = WS_Y + (size_t)MT * 1024 * 4;
static_assert(WS_END < 349000000, "workspace too large");

constexpr int CW_CNT = 8192;
constexpr int CH_BBASE = 300000;
constexpr int CH_ELIST = 524288;
constexpr int CH_WRT = 917504;
constexpr int CW_BAR = 1024;
constexpr int CW_Q5 = 12288;
constexpr int CW_Q3 = 12352, CW_Q12 = 12416, CW_Q4 = 12480;
constexpr int CW_MOEC = 12800;
constexpr int CW_TMO = 13200;
constexpr int LDS_BYTES = 160 * 1024;

struct PK { const float* in[31]; float* out; unsigned char* ws; };
typedef __attribute__((address_space(4))) const unsigned char* kaptr_t;
struct InTab { __device__ __forceinline__ const float* operator[](int i) const {
    kaptr_t ka = (kaptr_t)__builtin_amdgcn_kernarg_segment_ptr(); asm volatile("" : "+s"(ka)); return *(const float* __attribute__((address_space(4))) const*)(ka + i * 8); } };
struct P { InTab in; int wv;
    __device__ __forceinline__ int tid() const { int l; asm volatile("v_mbcnt_lo_u32_b32 %0, -1, 0\n\tv_mbcnt_hi_u32_b32 %0, -1, %0" : "=v"(l)); return (wv << 6) | l; }
    __device__ __forceinline__ float* get_out() const { kaptr_t ka = (kaptr_t)__builtin_amdgcn_kernarg_segment_ptr(); asm volatile("" : "+s"(ka)); return *(float* __attribute__((address_space(4))) const*)(ka + 31 * 8); }
    __device__ __forceinline__ unsigned char* get_ws() const { kaptr_t ka = (kaptr_t)__builtin_amdgcn_kernarg_segment_ptr(); asm volatile("" : "+s"(ka)); return *(unsigned char* __attribute__((address_space(4))) const*)(ka + 32 * 8); } };

__device__ __forceinline__ float bf2f(bf16_t b) { return __uint_as_float((u32)b << 16); }
__device__ __forceinline__ bf16_t f2bf(float f) { u32 r; asm("v_cvt_pk_bf16_f32 %0, %1, %1" : "=v"(r) : "v"(f)); return (bf16_t)r; }
__device__ __forceinline__ u32 pack2(float a, float b) { u32 r; asm("v_cvt_pk_bf16_f32 %0, %1, %2" : "=v"(r) : "v"(a), "v"(b)); return r; }
__device__ __forceinline__ void unpack8(const uint4 w, float* f) {
    f[0] = __uint_as_float(w.x << 16); f[1] = __uint_as_float(w.x & 0xffff0000u); f[2] = __uint_as_float(w.y << 16); f[3] = __uint_as_float(w.y & 0xffff0000u);
    f[4] = __uint_as_float(w.z << 16); f[5] = __uint_as_float(w.z & 0xffff0000u); f[6] = __uint_as_float(w.w << 16); f[7] = __uint_as_float(w.w & 0xffff0000u);
}
__device__ __forceinline__ void ld4bf(const bf16_t* p, float* f) { const uint2 w = *(const uint2*)p; f[0] = __uint_as_float(w.x << 16); f[1] = __uint_as_float(w.x & 0xffff0000u); f[2] = __uint_as_float(w.y << 16); f[3] = __uint_as_float(w.y & 0xffff0000u); }
__device__ __forceinline__ float siluf(float x) { return x / (1.f + __expf(-x)); }
__device__ __forceinline__ float sigmf(float x) { return 1.f / (1.f + __expf(-x)); }
__device__ __forceinline__ float softplusf(float x) { return x > 20.f ? x : log1pf(__expf(x)); }
__device__ __forceinline__ float logsigf(float x) { return x < -20.f ? x : -log1pf(__expf(-x)); }
__device__ __forceinline__ void lds_barrier() { asm volatile("s_waitcnt lgkmcnt(0)" ::: "memory"); __builtin_amdgcn_s_barrier(); asm volatile("" ::: "memory"); }
__device__ __forceinline__ float wave_sum(float v) {
#pragma unroll
    for (int o = 32; o >= 1; o >>= 1) v += __shfl_xor(v, o);
    return v;
}
__device__ __forceinline__ float rdlane(float v, int l) { return __int_as_float(__builtin_amdgcn_readlane(__float_as_int(v), l)); }

__device__ __forceinline__ void phase_mods(const P& p, int bid, int nb, float* lds) {
    const int tid = p.tid();
    float* MODS = (float*)(p.get_ws() + WS_MODS);
    float* RC = (float*)(p.get_ws() + WS_ROPE); float* RS = RC + 256 * 16;
    for (int i = bid * NTH + tid; i < 256 * 16; i += nb * NTH) {
        const int pos = i >> 4, f = i & 15;
        const float inv = powf(10000.f, -(float)f / 16.f);
        const float ang = (float)pos * inv;
        RC[i] = cosf(ang); RS[i] = sinf(ang);
    }
    const float* c = p.in[1]; const float* cx = p.in[3];
    for (int i = tid; i < 1024; i += NTH) { const float a = c[i]; lds[i] = a / (1.f + expf(-a)); const float b = cx[i]; lds[1024 + i] = b / (1.f + expf(-b)); }
    __syncthreads();
    float* red = lds + 2048;
    const int tx = tid & 15, ty = tid >> 4;
    for (int item = bid; item < 192; item += nb) {
        const int l = item / 96, cgp = item % 96;
        const float* W = p.in[8] + (size_t)l * 1024 * 6144 + cgp * 64 + tx * 4;
        float4 ac = {0.f, 0.f, 0.f, 0.f}, ax = {0.f, 0.f, 0.f, 0.f};
#pragma unroll 8
        for (int k = ty; k < 1024; k += 32) {
            const float4 w = *(const float4*)(W + (size_t)k * 6144);
            const float sc = lds[k], sx = lds[1024 + k];
            ac.x += sc * w.x; ac.y += sc * w.y; ac.z += sc * w.z; ac.w += sc * w.w;
            ax.x += sx * w.x; ax.y += sx * w.y; ax.z += sx * w.z; ax.w += sx * w.w;
        }
        float* r = red + (ty * 16 + tx) * 8;
        r[0] = ac.x; r[1] = ac.y; r[2] = ac.z; r[3] = ac.w; r[4] = ax.x; r[5] = ax.y; r[6] = ax.z; r[7] = ax.w;
        __syncthreads();
        if (tid < 128) {
            const int col = tid & 63, which = tid >> 6;
            float s = 0.f;
            for (int y = 0; y < 32; ++y) s += red[(y * 16 + (col >> 2)) * 8 + which * 4 + (col & 3)];
            s += p.in[9][l * 6144 + cgp * 64 + col];
            MODS[(l * 2 + which) * 6144 + cgp * 64 + col] = s;
        }
        __syncthreads();
    }
}

struct RowArgs {
    int layer;
    int ffn;
    int src;
    int combine;
    int clayer;
    int final_out;
    int nrows;
    const float* wsm; int ldw; int wcol0;
    int route;
    int noproj;
};

template <int NS>
__device__ __forceinline__ float row_norm_proj(float (&v)[16], const float* gamma, const float* md, bf16_t* hrow, const float* lds, int lane, bool doproj) {
    float ss = 0.f;
#pragma unroll
    for (int j = 0; j < 16; ++j) ss += v[j] * v[j];
    ss = wave_sum(ss);
    const float rs = rsqrtf(ss * (1.f / 1024.f) + 1e-6f);
#pragma unroll
    for (int i = 0; i < 4; ++i) {
        const float4 g = *(const float4*)(gamma + i * 256 + lane * 4);
        const float4 sh = *(const float4*)(md + i * 256 + lane * 4);
        const float4 sc = *(const float4*)(md + 1024 + i * 256 + lane * 4);
        v[i * 4 + 0] = v[i * 4 + 0] * rs * g.x * (1.f + sc.x) + sh.x;
        v[i * 4 + 1] = v[i * 4 + 1] * rs * g.y * (1.f + sc.y) + sh.y;
        v[i * 4 + 2] = v[i * 4 + 2] * rs * g.z * (1.f + sc.z) + sh.z;
        v[i * 4 + 3] = v[i * 4 + 3] * rs * g.w * (1.f + sc.w) + sh.w;
        uint2 o; o.x = pack2(v[i * 4], v[i * 4 + 1]); o.y = pack2(v[i * 4 + 2], v[i * 4 + 3]);
        *(uint2*)(hrow + i * 256 + lane * 4) = o;
    }
    if (!doproj) return 0.f;
    float s[NS];
#pragma unroll
    for (int n = 0; n < NS; ++n) s[n] = 0.f;
#pragma unroll
    for (int i = 0; i < 4; ++i)
#pragma unroll
        for (int j = 0; j < 4; ++j) {
            const float* w = lds + ((i * 4 + j) * (NS / 4)) * 256 + lane * 4;
            const float x = v[i * 4 + j];
#pragma unroll
            for (int n = 0; n < NS; n += 4) { const float4 ww = *(const float4*)(w + (n >> 2) * 256); s[n] += x * ww.x; s[n + 1] += x * ww.y; s[n + 2] += x * ww.z; s[n + 3] += x * ww.w; }
            asm volatile("" ::: "memory");
        }
#pragma unroll
    for (int hN = NS / 2, off = 32; hN >= 1; hN >>= 1, off >>= 1) {
        const bool upper = (lane & off) != 0;
#pragma unroll
        for (int i2 = 0; i2 < hN; ++i2) { const float mine = upper ? s[i2 + hN] : s[i2], other = upper ? s[i2] : s[i2 + hN]; s[i2] = mine + __shfl_xor(other, off); }
    }
    float s0 = s[0];
    if (NS == 16) { s0 += __shfl_xor(s0, 2); s0 += __shfl_xor(s0, 1); } else { s0 += __shfl_xor(s0, 1); }
    return s0;
}
__device__ __forceinline__ void route16(const float (&sc)[16], const float (&bs)[16], int& e0, int& e1, float& g0, float& g1) {
    float best = -1e30f, W0 = 0.f, W1 = 0.f; int E0 = 0, E1 = 0;
#pragma unroll
    for (int g = 0; g < 4; ++g) {
        float m1 = bs[g * 4], w1 = sc[g * 4]; int i1 = 0;
#pragma unroll
        for (int j = 1; j < 4; ++j) { const bool gt = bs[g * 4 + j] > m1; m1 = gt ? bs[g * 4 + j] : m1; w1 = gt ? sc[g * 4 + j] : w1; i1 = gt ? j : i1; }
        float m2 = -1e30f, w2 = 0.f; int i2 = 0;
#pragma unroll
        for (int j = 0; j < 4; ++j) { const bool gt = (j != i1) && (bs[g * 4 + j] > m2); m2 = gt ? bs[g * 4 + j] : m2; w2 = gt ? sc[g * 4 + j] : w2; i2 = gt ? j : i2; }
        const float gs = m1 + m2; const bool better = gs > best;
        best = better ? gs : best; E0 = better ? g * 4 + i1 : E0; E1 = better ? g * 4 + i2 : E1; W0 = better ? w1 : W0; W1 = better ? w2 : W1;
    }
    e0 = E0; e1 = E1;
    const float inv = 1.f / (W0 + W1);
    g0 = W0 * inv; g1 = W1 * inv;
}
__device__ __forceinline__ void expert_offsets(const u32* cnt  , int (&off)[17]) {
    off[0] = 0;
#pragma unroll
    for (int e = 0; e < 16; ++e) off[e + 1] = off[e] + (int)((cnt[e * 64] + 255u) / 256u) * 256;
}

template <int NS> __forceinline__
__device__ __forceinline__ void phase_rows(const P& p, int bid, int nb, float* lds, const RowArgs a) {
    const int tid = p.tid(), lane = tid & 63, wid = tid >> 6;
    unsigned char* ws = p.get_ws();
    const float* MODS = (const float*)(ws + WS_MODS);
    bf16_t* XRES = (bf16_t*)(ws + WS_XRES);
    bf16_t* HB = (bf16_t*)(ws + WS_HB);
    float* SMALL = (float*)(ws + WS_SMALL);
    int* CHKI = (int*)(ws + WS_CHK);
    if (!a.final_out && !a.noproj) {
        for (int i = tid; i < 1024 * NS; i += NTH) { const int k = i / NS, n = i % NS;
            lds[(((k >> 8) * 4 + (k & 3)) * (NS / 4) + (n >> 2)) * 256 + ((k >> 2) & 63) * 4 + (n & 3)] = a.wsm[(size_t)k * a.ldw + a.wcol0 + n]; }
    }
    u32* lcnt = (u32*)(lds + 1024 * 32);
    int* lsl = (int*)(lds + 1024 * 32 + 64);
    int4* lrt = (int4*)(lds + 1024 * 32 + 64);
    if (tid < 16) lcnt[tid] = 0u;
    if (a.combine) {
        if (tid == 0) { int off[17]; expert_offsets((const u32*)(ws + WS_CTL) + CW_CNT + a.clayer * 16 * 64, off);
#pragma unroll
            for (int e = 0; e < 16; ++e) lsl[e] = off[e]; }
        for (int i = tid; i < nb * 16; i += NTH) lsl[16 + i] = CHKI[CH_BBASE + i];
    }
    __syncthreads();
    const float* gamma = (a.ffn ? p.in[7] : p.in[6]) + a.layer * 1024;
    const bf16_t* YMOE = (const bf16_t*)(ws + WS_PROJ);
    const int4* ROUTE = (const int4*)(ws + WS_ROUTE);
    const float2* GATE = (const float2*)(ws + WS_GATE);
    const int stride = nb * 8;
    for (int row0 = bid * 8 + wid; row0 < a.nrows; row0 += (NS == 16 ? 2 : 1) * stride) {
        const bool hasB = NS == 16 && row0 + stride < a.nrows;
        const int rw[2] = {row0, hasB ? row0 + stride : row0};
        float v[2][16];
#pragma unroll
        for (int u = 0; u < 2; ++u) {
            const int row = rw[u];
            if (a.src) {
#pragma unroll
                for (int i = 0; i < 4; ++i) ld4bf(XRES + (size_t)row * 1024 + i * 256 + lane * 4, &v[u][i * 4]);
            } else {
                const float* src = row >= SEQ ? p.in[2] + (size_t)(row - SEQ) * 1024 : p.in[0] + (size_t)row * 1024;
#pragma unroll
                for (int i = 0; i < 4; ++i) { const float4 t = *(const float4*)(src + i * 256 + lane * 4); v[u][i * 4] = t.x; v[u][i * 4 + 1] = t.y; v[u][i * 4 + 2] = t.z; v[u][i * 4 + 3] = t.w; }
            }
        }
        if (a.combine) {
            int4 rt[2]; float2 gt[2];
#pragma unroll
            for (int u = 0; u < 2; ++u) { rt[u] = ROUTE[rw[u]]; gt[u] = GATE[rw[u]]; }
            uint2 y0[2][4], y1[2][4];
#pragma unroll
            for (int u = 0; u < 2; ++u) {
                const int blk = (rw[u] >> 6) % nb;
                const int s0 = lsl[rt[u].x] + lsl[16 + blk * 16 + rt[u].x] + rt[u].y, s1 = lsl[rt[u].z] + lsl[16 + blk * 16 + rt[u].z] + rt[u].w;
#pragma unroll
                for (int i = 0; i < 4; ++i) { y0[u][i] = *(const uint2*)(YMOE + (size_t)s0 * 1024 + i * 256 + lane * 4); y1[u][i] = *(const uint2*)(YMOE + (size_t)s1 * 1024 + i * 256 + lane * 4); }
            }
#pragma unroll
            for (int u = 0; u < 2; ++u) {
                const int row = rw[u];
                const float* gf = MODS + (a.clayer * 2 + (row >= SEQ ? 1 : 0)) * 6144 + 5 * 1024;
#pragma unroll
                for (int i = 0; i < 4; ++i) {
                    const float4 g = *(const float4*)(gf + i * 256 + lane * 4);
                    v[u][i * 4 + 0] += g.x * (gt[u].x * __uint_as_float(y0[u][i].x << 16) + gt[u].y * __uint_as_float(y1[u][i].x << 16));
                    v[u][i * 4 + 1] += g.y * (gt[u].x * __uint_as_float(y0[u][i].x & 0xffff0000u) + gt[u].y * __uint_as_float(y1[u][i].x & 0xffff0000u));
                    v[u][i * 4 + 2] += g.z * (gt[u].x * __uint_as_float(y0[u][i].y << 16) + gt[u].y * __uint_as_float(y1[u][i].y << 16));
                    v[u][i * 4 + 3] += g.w * (gt[u].x * __uint_as_float(y0[u][i].y & 0xffff0000u) + gt[u].y * __uint_as_float(y1[u][i].y & 0xffff0000u));
                }
                if (u == 0 || hasB) {
                    if (a.final_out) { float* dst = p.get_out() + (size_t)row * 1024;
#pragma unroll
                        for (int i = 0; i < 4; ++i) *(float4*)(dst + i * 256 + lane * 4) = make_float4(v[u][i * 4], v[u][i * 4 + 1], v[u][i * 4 + 2], v[u][i * 4 + 3]); }
                    else {
#pragma unroll
                        for (int i = 0; i < 4; ++i) { uint2 o; o.x = pack2(v[u][i * 4], v[u][i * 4 + 1]); o.y = pack2(v[u][i * 4 + 2], v[u][i * 4 + 3]); *(uint2*)(XRES + (size_t)row * 1024 + i * 256 + lane * 4) = o; } }
                }
            }
            if (a.final_out) continue;
        }
#pragma unroll
        for (int u = 0; u < 2; ++u) {
            const int row = rw[u];
            if (u == 0 || hasB) {
            const float* md = MODS + (a.layer * 2 + (row >= SEQ ? 1 : 0)) * 6144 + (a.ffn ? 3 * 1024 : 0);
            const float s0 = row_norm_proj<NS>(v[u], gamma, md, HB + (size_t)row * 1024, lds, lane, !a.noproj);
            if (a.noproj) {
            } else if (!a.route) {
                const int nl = NS == 16 ? (((lane >> 5) & 1) << 3) | (((lane >> 4) & 1) << 2) | (((lane >> 3) & 1) << 1) | ((lane >> 2) & 1)
                                        : (((lane >> 5) & 1) << 4) | (((lane >> 4) & 1) << 3) | (((lane >> 3) & 1) << 2) | (((lane >> 2) & 1) << 1) | ((lane >> 1) & 1);
                if ((lane & (NS == 16 ? 3 : 1)) == 0) SMALL[(size_t)row * 32 + nl] = s0;
            } else if (NS == 16) {
                const int nl = (((lane >> 5) & 1) << 3) | (((lane >> 4) & 1) << 2) | (((lane >> 3) & 1) << 1) | ((lane >> 2) & 1);
                const float scl = 1.f / (1.f + expf(-s0)), bsl = scl + p.in[5][nl];
                float sc[16], bs[16];
#pragma unroll
                for (int n = 0; n < 16; ++n) { const int sl = ((n & 8) ? 32 : 0) | ((n & 4) ? 16 : 0) | ((n & 2) ? 8 : 0) | ((n & 1) ? 4 : 0); sc[n] = rdlane(scl, sl); bs[n] = rdlane(bsl, sl); }
                int e0, e1; float g0, g1; route16(sc, bs, e0, e1, g0, g1);
                if (lane == 0) {
                    const int p0 = (int)atomicAdd(lcnt + e0, 1u), p1 = (int)atomicAdd(lcnt + e1, 1u);
                    const int4 rt4 = make_int4(e0, p0, e1, p1);
                    ((int4*)(ws + WS_ROUTE))[row] = rt4;
                    ((float2*)(ws + WS_GATE))[row] = make_float2(g0, g1);
                    lrt[((row - (bid * 8 + wid)) / stride) * 8 + wid] = rt4;
                }
            }
            }
            __builtin_amdgcn_sched_barrier(0);
        }
    }
    if (a.route) {
        __syncthreads();
        if (tid < 16) {
            u32* cnt = (u32*)(ws + WS_CTL) + CW_CNT + (a.layer * 16 + tid) * 64;
            const int base = (int)atomicAdd(cnt, lcnt[tid]);
            CHKI[CH_BBASE + bid * 16 + tid] = base; lcnt[16 + tid] = (u32)base;
        }
        __syncthreads();
        if (lane == 0) {
            int* ELIST = CHKI + CH_ELIST;
            int k = 0;
            for (int row = bid * 8 + wid; row < a.nrows; row += stride, ++k) {
                const int4 r = lrt[k * 8 + wid];
                ELIST[r.x * MT + (int)lcnt[16 + r.x] + r.y] = row; ELIST[r.z * MT + (int)lcnt[16 + r.z] + r.w] = row;
            }
        }
    }
}


__device__ __forceinline__ void phase_route(const P& p, int bid, int nb, float* lds, int layer, int nrows) {
    const int tid = p.tid(), lane = tid & 63, wid = tid >> 6, r = lane & 15, q = lane >> 4;
    unsigned char* ws = p.get_ws();
    const float* MODS = (const float*)(ws + WS_MODS);
    const bf16_t* XRES = (const bf16_t*)(ws + WS_XRES);
    bf16_t* HB = (bf16_t*)(ws + WS_HB);
    int* CHKI = (int*)(ws + WS_CHK);
    const bf16_t* WRT = (const bf16_t*)((const float*)(ws + WS_CHK) + CH_WRT);
    u32* lcnt = (u32*)(lds + 16384);
    int4* lrt = (int4*)(lds + 16384 + 64);
    if (tid < 16) lcnt[tid] = 0u;
    const float* gamma = p.in[7] + layer * 1024;
    int kt = 0;
    for (int tile = bid; tile < nrows / 64; tile += nb, ++kt) {
        const int r0 = tile * 64;
#pragma unroll 1
        for (int pr = 0; pr < 4; ++pr) {
            float v[2][16];
#pragma unroll
            for (int u = 0; u < 2; ++u) { const bf16_t* src = XRES + (size_t)(r0 + wid * 8 + pr * 2 + u) * 1024;
#pragma unroll
                for (int i = 0; i < 4; ++i) ld4bf(src + i * 256 + lane * 4, &v[u][i * 4]); }
#pragma unroll
            for (int u = 0; u < 2; ++u) { const int row = r0 + wid * 8 + pr * 2 + u;
                const float* md = MODS + (layer * 2 + (row >= SEQ ? 1 : 0)) * 6144 + 3 * 1024;
                (void)row_norm_proj<16>(v[u], gamma, md, HB + (size_t)row * 1024, lds, lane, false); }
        }
        asm volatile("s_waitcnt vmcnt(0)" ::: "memory");
        __syncthreads();
        {
            f32x4 acc[4][2];
#pragma unroll
            for (int mi = 0; mi < 4; ++mi)
#pragma unroll
                for (int ni = 0; ni < 2; ++ni) acc[mi][ni] = (f32x4){0.f, 0.f, 0.f, 0.f};
            const bf16_t* Ab = HB + (size_t)(r0 + r) * 1024 + wid * 128 + 8 * q; const bf16_t* Bb = WRT + (size_t)r * 1024 + wid * 128 + 8 * q;
#pragma unroll
            for (int k4 = 0; k4 < 4; ++k4) {
                bf16x8 a[4], b[2];
#pragma unroll
                for (int mi = 0; mi < 4; ++mi) a[mi] = *(const bf16x8*)(Ab + (size_t)(16 * mi) * 1024 + 32 * k4);
#pragma unroll
                for (int ni = 0; ni < 2; ++ni) b[ni] = *(const bf16x8*)(Bb + (size_t)(16 * ni) * 1024 + 32 * k4);
#pragma unroll
                for (int mi = 0; mi < 4; ++mi)
#pragma unroll
                    for (int ni = 0; ni < 2; ++ni) acc[mi][ni] = __builtin_amdgcn_mfma_f32_16x16x32_bf16(b[ni], a[mi], acc[mi][ni], 0, 0, 0);
            }
#pragma unroll
            for (int mi = 0; mi < 4; ++mi)
#pragma unroll
                for (int ni = 0; ni < 2; ++ni) *(f32x4*)(lds + wid * 2048 + (16 * mi + r) * 32 + 16 * ni + 4 * q) = acc[mi][ni];
        }
        __syncthreads();
        if (tid < 128) {
            const int rr = tid >> 1, c8 = (tid & 1) * 8;
            float lg[8] = {0.f, 0.f, 0.f, 0.f, 0.f, 0.f, 0.f, 0.f};
#pragma unroll
            for (int w = 0; w < 8; ++w) { const float4 x0 = *(const float4*)(lds + w * 2048 + rr * 32 + c8), x1 = *(const float4*)(lds + w * 2048 + rr * 32 + c8 + 4);
                lg[0] += x0.x; lg[1] += x0.y; lg[2] += x0.z; lg[3] += x0.w; lg[4] += x1.x; lg[5] += x1.y; lg[6] += x1.z; lg[7] += x1.w; }
            float sc[16], bs[16];
            const float* rb = p.in[5];
#pragma unroll
            for (int j = 0; j < 8; ++j) {
                const float mine_s = 1.f / (1.f + expf(-lg[j])), mine_b = mine_s + rb[c8 + j];
                const float oth_s = __shfl_xor(mine_s, 1), oth_b = __shfl_xor(mine_b, 1);
                sc[j] = c8 ? oth_s : mine_s; sc[8 + j] = c8 ? mine_s : oth_s; bs[j] = c8 ? oth_b : mine_b; bs[8 + j] = c8 ? mine_b : oth_b;
            }
            int e0, e1; float g0, g1; route16(sc, bs, e0, e1, g0, g1);
            if (c8 == 0) {
                const int row = r0 + rr;
                const int p0 = (int)atomicAdd(lcnt + e0, 1u), p1 = (int)atomicAdd(lcnt + e1, 1u);
                const int4 rt4 = make_int4(e0, p0, e1, p1);
                ((int4*)(ws + WS_ROUTE))[row] = rt4;
                ((float2*)(ws + WS_GATE))[row] = make_float2(g0, g1);
                lrt[kt * 64 + rr] = rt4;
            }
        }
        __syncthreads();
    }
    __syncthreads();
    if (tid < 16) {
        u32* cnt = (u32*)(ws + WS_CTL) + CW_CNT + (layer * 16 + tid) * 64;
        const int base = (int)atomicAdd(cnt, lcnt[tid]);
        CHKI[CH_BBASE + bid * 16 + tid] = base; lcnt[16 + tid] = (u32)base;
    }
    __syncthreads();
    {
        int* ELIST = CHKI + CH_ELIST;
        int k2 = 0;
        for (int tile = bid; tile < nrows / 64; tile += nb, ++k2)
            if (tid < 64) { const int4 rt = lrt[k2 * 64 + tid]; const int row = tile * 64 + tid;
                ELIST[rt.x * MT + (int)lcnt[16 + rt.x] + rt.y] = row; ELIST[rt.z * MT + (int)lcnt[16 + rt.z] + rt.w] = row; }
    }
}

namespace g8 {
#define G8_LAS __attribute__((address_space(3)))
typedef short bf16x8 __attribute__((ext_vector_type(8)));
typedef float f32x4 __attribute__((ext_vector_type(4)));
constexpr int BM = 256, BK = 64, HALF = 128, HTB = HALF * BK * 2, STAGE_BYTES = 8 * HTB, NXCD = 8, WGM = 8;
__device__ __forceinline__ int lds_byte(int r, int c) { const int st = (r >> 4) * 2 + (c >> 5), rr = r & 15, cc = c & 31, ob = rr * 64 + cc * 2; return st * 1024 + (ob ^ (((ob >> 9) & 1) << 5)); }
__device__ __forceinline__ void stage_rc(int b, int& R, int& C) { const int st = b / 1024, sb = b % 1024, swz = sb ^ (((sb >> 9) & 1) << 5); R = (st >> 1) * 16 + swz / 64; C = (st & 1) * 32 + (swz % 64) / 2; }
__device__ __forceinline__ int perm32(int rho) { const int n = rho >> 4, i = rho & 15; return 8 * (i >> 2) + 4 * n + (i & 3); }
struct Unit { int pm, pn; };
struct Order {
    int nM, nN, nwg, G, c;
    __device__ __forceinline__ void init(int nM_, int nN_, int G_, int c_) { nM = nM_; nN = nN_; nwg = nM * nN; G = G_; c = c_; }
    __device__ __forceinline__ bool next(int i, Unit& u) const {
        const long L = (long)i * G + c; if (L >= nwg) return false;
        int wgid = (int)L; { const int q = nwg / NXCD, r = nwg % NXCD, xcd = wgid % NXCD, off = wgid / NXCD; wgid = (xcd < r ? xcd * (q + 1) : r * (q + 1) + (xcd - r) * q) + off; }
        const int nig = WGM * nN, gid = wgid / nig, fm = gid * WGM, gsz = (nM - fm) < WGM ? (nM - fm) : WGM;
        u.pm = fm + ((wgid % nig) % gsz); u.pn = (wgid % nig) / gsz; return true;
    }
    __device__ __forceinline__ void ready(const Unit&, int) const {}
    __device__ __forceinline__ void done(const Unit&, int) const {}
};
template <class RowSrc, class BSel, class EF, class Sched>
__device__ __forceinline__ void gemm8(const int tid, G8_LAS unsigned char* lds, const bf16_t* A, int K, const RowSrc& rsrc, const Sched& S, const BSel& bsel, const EF& ef) {
    const int wid = __builtin_amdgcn_readfirstlane(tid >> 6), lane = tid & 63, wr = wid >> 2, wc = wid & 3, fr = lane & 15, fq = lane >> 4;
    const int nt = K / BK;
    int R0, C0, R1, C1; stage_rc(tid * 16, R0, C0); stage_rc(tid * 16 + 8192, R1, C1);
    const unsigned vb0 = (unsigned)(((R0 & ~31) + perm32(R0 & 31)) * K + C0) * 2u, vb1 = (unsigned)(((R1 & ~31) + perm32(R1 & 31)) * K + C1) * 2u;
    const size_t kstep = (size_t)(BK * 2), hstep = (size_t)HALF * K * 2, tstep = 2 * hstep;
    const unsigned ldsw = (unsigned)wid * 1024u;
    const int aoff = lds_byte(wr * 64 + fr, fq * 8), boff = lds_byte(wc * 32 + fr, fq * 8);
#define G8_SA(b, h) (((b) * 2 + (h)) * HTB)
#define G8_SB(b, h) ((4 + (b) * 2 + (h)) * HTB)
#define G8_STAGE(bufoff, gbase, v0, v1) do { \
        __builtin_amdgcn_global_load_lds((const unsigned*)((const char*)(gbase) + (v0)), (G8_LAS unsigned*)(lds + (bufoff) + ldsw), 16, 0, 0); \
        __builtin_amdgcn_global_load_lds((const unsigned*)((const char*)(gbase) + (v1)), (G8_LAS unsigned*)(lds + (bufoff) + ldsw + 8192), 16, 0, 0); } while (0)
#define G8_LDA(dst, b, h) do { _Pragma("unroll") for (int m = 0; m < 4; ++m) _Pragma("unroll") for (int k = 0; k < 2; ++k) dst[m][k] = *(const G8_LAS bf16x8*)(lds + G8_SA(b, h) + aoff + m * 2048 + k * 1024); } while (0)
#define G8_LDB(dst, b, h) do { _Pragma("unroll") for (int n = 0; n < 2; ++n) _Pragma("unroll") for (int k = 0; k < 2; ++k) dst[n][k] = *(const G8_LAS bf16x8*)(lds + G8_SB(b, h) + boff + n * 2048 + k * 1024); } while (0)
#define G8_MMA(ai, bj, At, Bt) do { __builtin_amdgcn_s_setprio(1); _Pragma("unroll") for (int m = 0; m < 4; ++m) _Pragma("unroll") for (int n = 0; n < 2; ++n) _Pragma("unroll") for (int k = 0; k < 2; ++k) \
        acc[ai][bj][m][n] = __builtin_amdgcn_mfma_f32_16x16x32_bf16(Bt[n][k], At[m][k], acc[ai][bj][m][n], 0, 0, 0); __builtin_amdgcn_s_setprio(0); } while (0)
#define G8_WAIT_V(n) asm volatile("s_waitcnt vmcnt(" #n ")" ::: "memory")
#define G8_WAIT_L(n) asm volatile("s_waitcnt lgkmcnt(" #n ")" ::: "memory")
#define G8_BAR __builtin_amdgcn_s_barrier()
#define G8_SCHED __builtin_amdgcn_sched_barrier(0)
#define G8_AOFF(pm_, h_, R_, C_) ((unsigned)(rsrc((pm_), (h_) * 128 + (R_)) * K + (C_)) * 2u)
    Unit cur, nxt; int ui = 0;
    if (!S.next(0, cur)) return;
    S.ready(cur, wid);
    f32x4 acc[2][2][4][2];
#pragma unroll
    for (int a = 0; a < 2; ++a)
#pragma unroll
        for (int b = 0; b < 2; ++b)
#pragma unroll
            for (int m = 0; m < 4; ++m)
#pragma unroll
                for (int n = 0; n < 2; ++n) acc[a][b][m][n] = (f32x4){0.f, 0.f, 0.f, 0.f};
    bf16x8 At[4][2], B0[2][2], B1[2][2];
    const char* Ab = (const char*)A;
    unsigned a00 = G8_AOFF(cur.pm, 0, R0, C0), a01 = G8_AOFF(cur.pm, 0, R1, C1), a10 = G8_AOFF(cur.pm, 1, R0, C0), a11 = G8_AOFF(cur.pm, 1, R1, C1);
    const char* cB = bsel(cur.pm) + (size_t)cur.pn * tstep;
    G8_STAGE(G8_SB(0, 0), cB, vb0, vb1); G8_STAGE(G8_SA(0, 0), Ab, a00, a01); G8_STAGE(G8_SB(0, 1), cB + hstep, vb0, vb1); G8_STAGE(G8_SA(0, 1), Ab, a10, a11);
    if (wr == 1) G8_BAR;
    G8_WAIT_V(4); G8_BAR;
    G8_STAGE(G8_SB(1, 0), cB + kstep, vb0, vb1); G8_STAGE(G8_SA(1, 0), Ab + kstep, a00, a01); G8_STAGE(G8_SB(1, 1), cB + hstep + kstep, vb0, vb1);
    G8_WAIT_V(6); G8_BAR;
    for (;;) {
        const bool has_next = S.next(ui + 1, nxt);
        if (has_next) S.ready(nxt, wid);
        unsigned n00 = a00, n01 = a01, n10 = a10, n11 = a11; const char* nB = cB;
        if (has_next) { n00 = G8_AOFF(nxt.pm, 0, R0, C0); n01 = G8_AOFF(nxt.pm, 0, R1, C1); n10 = G8_AOFF(nxt.pm, 1, R0, C0); n11 = G8_AOFF(nxt.pm, 1, R1, C1); nB = bsel(nxt.pm) + (size_t)nxt.pn * tstep; }
        for (int t = 0; t < nt; t += 2) {
            const bool last = (t == nt - 2);
            const char* a1p = Ab + (size_t)(t + 1) * kstep;
            const char* a2p = last ? Ab : Ab + (size_t)(t + 2) * kstep; const char* b2 = last ? nB : cB + (size_t)(t + 2) * kstep;
            const char* a3p = a2p + kstep; const char* b3 = b2 + kstep;
            const unsigned x00 = last ? n00 : a00, x01 = last ? n01 : a01, x10 = last ? n10 : a10, x11 = last ? n11 : a11;
            G8_LDB(B0, 0, 0); G8_SCHED; G8_LDA(At, 0, 0); G8_STAGE(G8_SA(1, 1), a1p, a10, a11);
            G8_WAIT_L(8); G8_BAR; G8_WAIT_L(0); G8_MMA(0, 0, At, B0); G8_BAR; G8_SCHED;
            G8_LDB(B1, 0, 1); G8_STAGE(G8_SB(0, 0), b2, vb0, vb1);
            G8_BAR; G8_WAIT_L(0); G8_MMA(0, 1, At, B1); G8_BAR;
            G8_LDA(At, 0, 1); G8_STAGE(G8_SA(0, 0), a2p, x00, x01);
            G8_BAR; G8_WAIT_L(0); G8_MMA(1, 0, At, B0); G8_BAR; G8_SCHED;
            G8_STAGE(G8_SB(0, 1), b2 + hstep, vb0, vb1);
            G8_WAIT_V(6); G8_BAR; G8_MMA(1, 1, At, B1); G8_BAR;
            G8_LDB(B0, 1, 0); G8_SCHED; G8_LDA(At, 1, 0); G8_STAGE(G8_SA(0, 1), a2p, x10, x11);
            G8_WAIT_L(8); G8_BAR; G8_WAIT_L(0); G8_MMA(0, 0, At, B0); G8_BAR; G8_SCHED;
            G8_LDB(B1, 1, 1); G8_STAGE(G8_SB(1, 0), b3, vb0, vb1);
            G8_BAR; G8_WAIT_L(0); G8_MMA(0, 1, At, B1); G8_BAR;
            G8_LDA(At, 1, 1); G8_STAGE(G8_SA(1, 0), a3p, x00, x01);
            G8_BAR; G8_WAIT_L(0); G8_MMA(1, 0, At, B0); G8_BAR; G8_SCHED;
            G8_STAGE(G8_SB(1, 1), b3 + hstep, vb0, vb1);
            G8_WAIT_V(6); G8_BAR; G8_MMA(1, 1, At, B1); G8_BAR;
        }
#pragma unroll
        for (int ai = 0; ai < 2; ++ai)
#pragma unroll
            for (int m = 0; m < 4; ++m)
#pragma unroll
                for (int bj = 0; bj < 2; ++bj) {
                    const f32x4 v0 = acc[ai][bj][m][0], v1 = acc[ai][bj][m][1];
                    const float v[8] = {v0[0], v0[1], v0[2], v0[3], v1[0], v1[1], v1[2], v1[3]};
                    ef(cur.pm * BM + ai * HALF + wr * 64 + m * 16 + fr, cur.pn * BM + bj * HALF + wc * 32 + 8 * fq, v);
                }
        S.done(cur, lane);
        if (!has_next) break;
#pragma unroll
        for (int a = 0; a < 2; ++a)
#pragma unroll
            for (int b = 0; b < 2; ++b)
#pragma unroll
                for (int m = 0; m < 4; ++m)
#pragma unroll
                    for (int n = 0; n < 2; ++n) acc[a][b][m][n] = (f32x4){0.f, 0.f, 0.f, 0.f};
        cur = nxt; a00 = n00; a01 = n01; a10 = n10; a11 = n11; cB = nB; ++ui;
    }
    G8_WAIT_V(0);
    if (wr == 0) G8_BAR;
    G8_BAR;
#undef G8_SA
#undef G8_SB
#undef G8_STAGE
#undef G8_LDA
#undef G8_LDB
#undef G8_MMA
#undef G8_WAIT_V
#undef G8_WAIT_L
#undef G8_BAR
#undef G8_SCHED
#undef G8_AOFF
}
}
struct BSelOne { const char* B; __device__ __forceinline__ const char* operator()(int) const { return B; } };
struct RowPlain { __device__ __forceinline__ int operator()(int pm, int r) const { return pm * 256 + r; } };
struct BSelExp { const char* B; const int* tinfo; size_t stride; __device__ __forceinline__ const char* operator()(int pm) const { return B + (size_t)tinfo[2 * pm] * stride; } };
struct RowMoe { const int* tinfo; const int* ecnt; const int* elist;
    __device__ __forceinline__ int operator()(int pm, int r) const { const int e = tinfo[2 * pm], pos = tinfo[2 * pm + 1] + r; return pos < ecnt[e] ? elist[e * MT + pos] : 0; } };
__device__ __forceinline__ int moe_tile_table(const P& p, int layer, int* tinfo, int* ecnt, int tid) {
    const u32* cnt = (const u32*)(p.get_ws() + WS_CTL) + CW_CNT + layer * 16 * 64;
    if (tid == 0) {
        int t = 0;
#pragma unroll 1
        for (int e = 0; e < 16; ++e) { const int c = (int)cnt[e * 64]; ecnt[e] = c;
#pragma unroll 1
            for (int i = 0; i < (c + 255) / 256; ++i) { tinfo[2 * t] = e; tinfo[2 * t + 1] = i * 256; ++t; } }
        ecnt[16] = t;
    }
    __syncthreads();
    return ecnt[16];
}

struct SrcPlain { const float* W; int ldw; __device__ __forceinline__ const float* operator()(int k, int n) const { return W + (size_t)k * ldw + n; } };
struct SrcEven { const float* W; __device__ __forceinline__ const float* operator()(int k, int n) const {
        return n < 2048 ? W + (size_t)k * EV_IN + (n < 1280 ? n : n + 16) : (n < 2064 ? W + (size_t)k * EV_IN + 1280 + (n - 2048) : nullptr); } };
struct SrcRouter { const float* W; __device__ __forceinline__ const float* operator()(int k, int n) const { return n < 16 ? W + (size_t)k * 16 + n : nullptr; } };
struct SrcOdd { const float* W; __device__ __forceinline__ const float* operator()(int k, int n) const { return n < OD_IN ? W + (size_t)k * OD_IN + n : nullptr; } };
struct SrcMoe13 { const float* W1; long long d13; __device__ __forceinline__ const float* operator()(int k, int n) const { return W1 + ((n & 4) ? d13 : 0ll) + (size_t)k * DE + ((n >> 3) * 4 + (n & 3)); } };
template <class SF>
__device__ __forceinline__ void conv_matrix(const SF& src, int K, int N, bf16_t* WT, int gw, int ngw, float* scr, int lane) {
    const int nblk = N / 32, nitems = (K / 64) * nblk;
    for (int item = gw; item < nitems; item += ngw) {
        const int kb = item / nblk, nbk = item % nblk, k0 = 64 * kb, n0 = 32 * nbk;
#pragma unroll 8
        for (int i = 0; i < 32; ++i) { const int kk = 2 * i + (lane >> 5); const float* sp = src(k0 + kk, n0 + (lane & 31)); scr[kk * 33 + (lane & 31)] = sp ? *sp : 0.f; }
        __builtin_amdgcn_s_waitcnt(0xC07F); asm volatile("" ::: "memory");
        const int c = lane & 7;
#pragma unroll
        for (int j = 0; j < 4; ++j) { const int n = (lane >> 3) + 8 * j; const float* sp = scr + (8 * c) * 33 + n;
            uint4 o; o.x = pack2(sp[0 * 33], sp[1 * 33]); o.y = pack2(sp[2 * 33], sp[3 * 33]); o.z = pack2(sp[4 * 33], sp[5 * 33]); o.w = pack2(sp[6 * 33], sp[7 * 33]);
            *(uint4*)(WT + (size_t)(n0 + n) * K + k0 + 8 * c) = o; }
        __builtin_amdgcn_s_waitcnt(0xC07F); asm volatile("" ::: "memory");
    }
}

template <class SF>
__device__ __forceinline__ void conv_item(const SF& src, int K, int N, bf16_t* WT, int item, int lane) {
    const int nblk = (N + 255) / 256, kb = item / nblk, nbk = item % nblk, k0 = 32 * kb, n = nbk * 256 + lane * 4;
    if (n >= N) return;
#pragma unroll 1
    for (int kh = 0; kh < 2; ++kh) {
        float4 v[16];
#pragma unroll
        for (int j = 0; j < 16; ++j) { const float* sp = src(k0 + kh * 16 + j, n); v[j] = sp ? *(const float4*)sp : make_float4(0.f, 0.f, 0.f, 0.f); }
#pragma unroll
        for (int ks = 0; ks < 2; ++ks) {
            const float4* w = v + ks * 8;
            uint4 o;
            o.x = pack2(w[0].x, w[1].x); o.y = pack2(w[2].x, w[3].x); o.z = pack2(w[4].x, w[5].x); o.w = pack2(w[6].x, w[7].x); *(uint4*)(WT + (size_t)(n + 0) * K + k0 + kh * 16 + ks * 8) = o;
            o.x = pack2(w[0].y, w[1].y); o.y = pack2(w[2].y, w[3].y); o.z = pack2(w[4].y, w[5].y); o.w = pack2(w[6].y, w[7].y); *(uint4*)(WT + (size_t)(n + 1) * K + k0 + kh * 16 + ks * 8) = o;
            o.x = pack2(w[0].z, w[1].z); o.y = pack2(w[2].z, w[3].z); o.z = pack2(w[4].z, w[5].z); o.w = pack2(w[6].z, w[7].z); *(uint4*)(WT + (size_t)(n + 2) * K + k0 + kh * 16 + ks * 8) = o;
            o.x = pack2(w[0].w, w[1].w); o.y = pack2(w[2].w, w[3].w); o.z = pack2(w[4].w, w[5].w); o.w = pack2(w[6].w, w[7].w); *(uint4*)(WT + (size_t)(n + 3) * K + k0 + kh * 16 + ks * 8) = o;
        }
    }
}
template <class SF>
__device__ __forceinline__ void conv_all(const SF& src, int K, int N, bf16_t* WT, int gw, int ngw, int lane) {
    const int nitems = (K / 32) * ((N + 255) / 256);
    for (int it = gw; it < nitems; it += ngw) conv_item(src, K, N, WT, it, lane);
}
__device__ __forceinline__ void conv_dense(const P& p, int bid, int nb, float* lds) {
    const int tid = p.tid(), lane = tid & 63, wid = tid >> 6;
    const int ngw = nb * 8; int gw = bid * 8 + wid;
    unsigned char* ws = p.get_ws();
    conv_all(SrcEven{p.in[10]}, 1024, 2304, (bf16_t*)(ws + WS_WIN0), gw, ngw, lane);            gw = (gw + 288) % ngw;
    conv_all(SrcOdd{p.in[21]}, 1024, 3328, (bf16_t*)(ws + WS_WIN1), gw, ngw, lane);             gw = (gw + 416) % ngw;
    conv_all(SrcPlain{p.in[20], 1024}, 1024, 1024, (bf16_t*)(ws + WS_WOUT0), gw, ngw, lane);    gw = (gw + 128) % ngw;
    conv_all(SrcPlain{p.in[27], 1024}, 1024, 1024, (bf16_t*)(ws + WS_WOUT1), gw, ngw, lane);    gw = (gw + 128) % ngw;
    conv_all(SrcRouter{p.in[4]}, 1024, 32, (bf16_t*)((float*)(ws + WS_CHK) + CH_WRT), gw, ngw, lane);
}
__device__ __forceinline__ void conv_moe_chunk(const P& p, int chunk, float* lds, int layer) {
    const int tid = p.tid(), lane = tid & 63, wid = tid >> 6;
    unsigned char* ws = p.get_ws();
    bf16_t* W13T = (bf16_t*)(ws + WS_WMOE); bf16_t* W2T = W13T + (size_t)16 * 1024 * 1024;
    const long long d13 = (long long)(p.in[29] - p.in[28]);
    const int wi = chunk * 8 + wid, e = wi / 192, idx = wi % 192;
    if (idx < 128) conv_item(SrcMoe13{p.in[28] + ((size_t)layer * 16 + e) * 1024 * DE, d13}, 1024, 1024, W13T + (size_t)e * 1024 * 1024, idx, lane);
    else conv_item(SrcPlain{p.in[30] + ((size_t)layer * 16 + e) * DE * 1024, 1024}, DE, 1024, W2T + (size_t)e * 1024 * DE, idx - 128, lane);
}
__device__ __forceinline__ void conv_moe(const P& p, int bid, int nb, float* lds, int layer) {
    const int tid = p.tid(), lane = tid & 63, wid = tid >> 6;
    float* scr = lds + 16384 + wid * (64 * 33);
    const int ngw = nb * 8; int gw = bid * 8 + wid;
    unsigned char* ws = p.get_ws();
    bf16_t* W13T = (bf16_t*)(ws + WS_WMOE); bf16_t* W2T = W13T + (size_t)16 * 1024 * 1024;
    const long long d13 = (long long)(p.in[29] - p.in[28]);
    for (int e = 0; e < 16; ++e) {
        conv_matrix(SrcMoe13{p.in[28] + ((size_t)layer * 16 + e) * 1024 * DE, d13}, 1024, 1024, W13T + (size_t)e * 1024 * 1024, gw, ngw, scr, lane);
        conv_matrix(SrcPlain{p.in[30] + ((size_t)layer * 16 + e) * DE * 1024, 1024}, DE, 1024, W2T + (size_t)e * 1024 * DE, gw, ngw, scr, lane);
        gw = (gw + 768) % ngw;
    }
}


template <class EF>
__device__ __forceinline__ void mini_gemm(const P& p, int bid, int nb, float* lds, const bf16_t* A, const bf16_t* Bt, int row0, int nrt, int col0, int nct, const EF& ef) {
    constexpr int K = 1024, KS = 128;
    const int tid = p.tid(), lane = tid & 63, wid = tid >> 6, r = lane & 15, q = lane >> 4;
    const int ntl = nrt * nct;
    int t = bid;
    if (t >= ntl) return;
    bf16x8 a[4][4], b[4][2];
#define MG_LOAD(tt) do { const int rt_ = (tt) / nct, ct_ = (tt) % nct; \
        const bf16_t* Ab_ = A + (size_t)(row0 + rt_ * 64 + r) * K + wid * KS + 8 * q; const bf16_t* Bb_ = Bt + (size_t)(col0 + ct_ * 32 + r) * K + wid * KS + 8 * q; \
        _Pragma("unroll") for (int k4 = 0; k4 < 4; ++k4) { \
            _Pragma("unroll") for (int mi = 0; mi < 4; ++mi) a[k4][mi] = *(const bf16x8*)(Ab_ + (size_t)(16 * mi) * K + 32 * k4); \
            _Pragma("unroll") for (int ni = 0; ni < 2; ++ni) b[k4][ni] = *(const bf16x8*)(Bb_ + (size_t)(16 * ni) * K + 32 * k4); } } while (0)
    MG_LOAD(t);
    for (;;) {
        f32x4 acc[4][2];
#pragma unroll
        for (int mi = 0; mi < 4; ++mi)
#pragma unroll
            for (int ni = 0; ni < 2; ++ni) acc[mi][ni] = (f32x4){0.f, 0.f, 0.f, 0.f};
#pragma unroll
        for (int k4 = 0; k4 < 4; ++k4)
#pragma unroll
            for (int mi = 0; mi < 4; ++mi)
#pragma unroll
                for (int ni = 0; ni < 2; ++ni) acc[mi][ni] = __builtin_amdgcn_mfma_f32_16x16x32_bf16(b[k4][ni], a[k4][mi], acc[mi][ni], 0, 0, 0);
        const int tcur = t; t += nb;
        const bool more = t < ntl;
        if (more) MG_LOAD(t);
        __syncthreads();
#pragma unroll
        for (int mi = 0; mi < 4; ++mi)
#pragma unroll
            for (int ni = 0; ni < 2; ++ni) *(f32x4*)(lds + wid * 2048 + (16 * mi + r) * 32 + 16 * ni + 4 * q) = acc[mi][ni];
        __syncthreads();
        if (tid < 256) {
            const int rr = tid >> 2, c8 = (tid & 3) * 8;
            float v[8] = {0.f, 0.f, 0.f, 0.f, 0.f, 0.f, 0.f, 0.f};
#pragma unroll
            for (int w = 0; w < 8; ++w) { const float4 x0 = *(const float4*)(lds + w * 2048 + rr * 32 + c8), x1 = *(const float4*)(lds + w * 2048 + rr * 32 + c8 + 4);
                v[0] += x0.x; v[1] += x0.y; v[2] += x0.z; v[3] += x0.w; v[4] += x1.x; v[5] += x1.y; v[6] += x1.z; v[7] += x1.w; }
            ef(row0 + (tcur / nct) * 64 + rr, col0 + (tcur % nct) * 32 + c8, v);
        }
        if (!more) break;
    }
#undef MG_LOAD
    __syncthreads();
}

struct EpiProj { bf16_t* C; int ld; int nmain; int ns; float* SMALL; __device__ void operator()(int r, int c0, const float* v) const {
    if (c0 < nmain) { uint4 o; o.x = pack2(v[0], v[1]); o.y = pack2(v[2], v[3]); o.z = pack2(v[4], v[5]); o.w = pack2(v[6], v[7]); *(uint4*)(C + (size_t)r * ld + c0) = o; }
    else if (c0 < nmain + ns) { float* d = SMALL + (size_t)r * 32 + (c0 - nmain); *(float4*)d = make_float4(v[0], v[1], v[2], v[3]); *(float4*)(d + 4) = make_float4(v[4], v[5], v[6], v[7]); } } };
struct EpiBf16Store { bf16_t* C; int ld; __device__ void operator()(int r, int c0, const float* v) const {
    uint4 o; o.x = pack2(v[0], v[1]); o.y = pack2(v[2], v[3]); o.z = pack2(v[4], v[5]); o.w = pack2(v[6], v[7]); *(uint4*)(C + (size_t)r * ld + c0) = o; } };
struct EpiResid { const float* xlat; const float* xctx; bf16_t* XRES; const float* gl; const float* gc;
    __device__ void operator()(int r, int c0, const float* v) const {
        const float* g = r >= SEQ ? gc : gl;
        const float4 g0 = *(const float4*)(g + c0), g1 = *(const float4*)(g + c0 + 4);
        float x[8];
        if (xlat) { const float* xin = r >= SEQ ? xctx + (size_t)(r - SEQ) * 1024 : xlat + (size_t)r * 1024;
            const float4 x0 = *(const float4*)(xin + c0), x1 = *(const float4*)(xin + c0 + 4); x[0] = x0.x; x[1] = x0.y; x[2] = x0.z; x[3] = x0.w; x[4] = x1.x; x[5] = x1.y; x[6] = x1.z; x[7] = x1.w; }
        else unpack8(*(const uint4*)(XRES + (size_t)r * 1024 + c0), x);
        uint4 o; o.x = pack2(x[0] + g0.x * v[0], x[1] + g0.y * v[1]); o.y = pack2(x[2] + g0.z * v[2], x[3] + g0.w * v[3]); o.z = pack2(x[4] + g1.x * v[4], x[5] + g1.y * v[5]); o.w = pack2(x[6] + g1.z * v[6], x[7] + g1.w * v[7]);
        *(uint4*)(XRES + (size_t)r * 1024 + c0) = o;
    } };
struct EpiSwiglu { bf16_t* H; __device__ void operator()(int r, int c0, const float* v) const {
    uint2 o; o.x = pack2(siluf(v[0]) * v[4], siluf(v[1]) * v[5]); o.y = pack2(siluf(v[2]) * v[6], siluf(v[3]) * v[7]); *(uint2*)(H + (size_t)r * DE + (c0 >> 3) * 4) = o; } };


struct SchedMoe1 { int T, G, c; unsigned* cnt;
    __device__ __forceinline__ bool next(int i, g8::Unit& u) const { const int x = c & 7, j = c >> 3; u.pm = 64 * i + 8 * x + (j & 7); u.pn = j >> 3; return u.pm < T; }
    __device__ __forceinline__ void ready(const g8::Unit&, int) const {}
    __device__ __forceinline__ void done(const g8::Unit& u, int lane) const {
        asm volatile("s_waitcnt vmcnt(0)" ::: "memory");
        if (lane == 0) __hip_atomic_fetch_add(cnt + u.pm, 1u, __ATOMIC_RELAXED, __HIP_MEMORY_SCOPE_AGENT);
    } };
struct SchedMoe2 { int U, G, c, r1, nB; unsigned* cnt; unsigned* tmo;
    __device__ __forceinline__ bool next(int i, g8::Unit& u) const {
        int idx;
        if (c >= r1) idx = i == 0 ? c - r1 : (i == 1 ? nB + c - r1 : 2 * nB + G * (i - 2) + (c - r1));
        else idx = 2 * nB + G * i + nB + c;
        if (idx >= U) return false; u.pm = idx >> 2; u.pn = idx & 3; return true; }
    __device__ __forceinline__ void ready(const g8::Unit& u, int wid) const {
        if (wid == 0) {
            unsigned spins = 0;
            while ((unsigned)__builtin_amdgcn_readfirstlane((int)__hip_atomic_load(cnt + u.pm, __ATOMIC_RELAXED, __HIP_MEMORY_SCOPE_AGENT)) < 32u) {
                __builtin_amdgcn_s_sleep(2);
                if (++spins > (1u << 22)) { __hip_atomic_store(tmo, 1u, __ATOMIC_RELAXED, __HIP_MEMORY_SCOPE_AGENT); break; }
            }
            __builtin_amdgcn_fence(__ATOMIC_ACQUIRE, "agent");
            asm volatile("s_waitcnt vmcnt(0)" ::: "memory");
        }
        asm volatile("" ::: "memory"); __builtin_amdgcn_s_barrier(); asm volatile("" ::: "memory");
    }
    __device__ __forceinline__ void done(const g8::Unit&, int) const {} };
struct EpiSwigluWT { bf16_t* H; __device__ void operator()(int r, int c0, const float* v) const {
    const unsigned long long o = (unsigned long long)pack2(siluf(v[0]) * v[4], siluf(v[1]) * v[5]) | ((unsigned long long)pack2(siluf(v[2]) * v[6], siluf(v[3]) * v[7]) << 32);
    __hip_atomic_store((unsigned long long*)(H + (size_t)r * DE + (c0 >> 3) * 4), o, __ATOMIC_RELAXED, __HIP_MEMORY_SCOPE_AGENT); } };
__device__ __forceinline__ void phase_moe_fused(const P& p, int bid, int nb, G8_LAS unsigned char* ldsa, float* lds, int layer) {
    unsigned char* ws = p.get_ws();
    int* tinfo = (int*)(lds + 32768); int* ecnt = tinfo + 2 * MAXTILES + 16;
    const int ntiles = moe_tile_table(p, layer, tinfo, ecnt, p.tid());
    unsigned* cnt = (unsigned*)(ws + WS_CTL) + CW_MOEC + layer * 160;
    const int U = ntiles * 4;
    {
        SchedMoe1 S{ntiles, nb, bid, cnt};
        EpiSwigluWT ef{(bf16_t*)(ws + WS_Y)};
        g8::gemm8(p.tid(), ldsa, (const bf16_t*)(ws + WS_HB), 1024, RowMoe{tinfo, ecnt, (const int*)(ws + WS_CHK) + CH_ELIST}, S, BSelExp{(const char*)(ws + WS_WMOE), tinfo, (size_t)1024 * 1024 * 2}, ef);
    }
    {
        const int r1 = U % nb;
        const int cp = ((8 * (bid & 7) + ((bid >> 3) & 7)) << 2) | (bid >> 6);
        SchedMoe2 S{U, nb, cp, r1, nb - r1, cnt, (unsigned*)(ws + WS_CTL) + CW_TMO};
        EpiBf16Store ef{(bf16_t*)(ws + WS_PROJ), 1024};
        g8::gemm8(p.tid(), ldsa, (const bf16_t*)(ws + WS_Y), DE, RowPlain{}, S, BSelExp{(const char*)(ws + WS_WMOE) + (size_t)16 * 1024 * 1024 * 2, tinfo, (size_t)1024 * DE * 2}, ef);
    }
}

__device__ __forceinline__ void phase_moe1(const P& p, int bid, int nb, G8_LAS unsigned char* ldsa, float* lds, int layer) {
    unsigned char* ws = p.get_ws();
    int* tinfo = (int*)(lds + 32768); int* ecnt = tinfo + 2 * MAXTILES + 16;
    const int ntiles = moe_tile_table(p, layer, tinfo, ecnt, p.tid());
    g8::Order S; S.init(ntiles, 4, nb, bid);
    EpiSwiglu ef{(bf16_t*)(ws + WS_Y)};
    g8::gemm8(p.tid(), ldsa, (const bf16_t*)(ws + WS_HB), 1024, RowMoe{tinfo, ecnt, (const int*)(ws + WS_CHK) + CH_ELIST}, S, BSelExp{(const char*)(ws + WS_WMOE), tinfo, (size_t)1024 * 1024 * 2}, ef);
}
__device__ __forceinline__ void phase_moe2(const P& p, int bid, int nb, G8_LAS unsigned char* ldsa, float* lds, int layer) {
    unsigned char* ws = p.get_ws();
    int* tinfo = (int*)(lds + 32768); int* ecnt = tinfo + 2 * MAXTILES + 16;
    const int ntiles = moe_tile_table(p, layer, tinfo, ecnt, p.tid());
    g8::Order S; S.init(ntiles, 4, nb, bid);
    EpiBf16Store ef{(bf16_t*)(ws + WS_PROJ), 1024};
    g8::gemm8(p.tid(), ldsa, (const bf16_t*)(ws + WS_Y), DE, RowPlain{}, S, BSelExp{(const char*)(ws + WS_WMOE) + (size_t)16 * 1024 * 1024 * 2, tinfo, (size_t)1024 * DE * 2}, ef);
}

__device__ __forceinline__ void phase_qkprep(const P& p, int bid, int nb) {
    const int tid = p.tid(), lane = tid & 63, wid = tid >> 6;
    unsigned char* ws = p.get_ws();
    const bf16_t* PROJ = (const bf16_t*)(ws + WS_PROJ);
    bf16_t* QKR = (bf16_t*)(ws + WS_XRES);
    const float* RC = (const float*)(ws + WS_ROPE); const float* RS = RC + 256 * 16;
    const int d0 = (lane & 7) * 8;
    float qn[8], kn[8];
#pragma unroll
    for (int j = 0; j < 8; ++j) { qn[j] = p.in[17][d0 + j]; kn[j] = p.in[18][d0 + j]; }
    for (int rk = bid * 8; rk < MT / 8; rk += nb * 8)
#pragma unroll 2
    for (int k8 = 0; k8 < 8; ++k8) {
        const int row = (rk + k8) * 8 + wid;
        const bool lat = row < SEQ;
        const uint4 qraw = *(const uint4*)(PROJ + (size_t)row * 2048 + 1280 + lane * 8);
        const uint4 kraw = lane < 16 ? *(const uint4*)(PROJ + (size_t)row * 2048 + 1792 + lane * 8) : make_uint4(0u, 0u, 0u, 0u);
        const int pos = d0 < 32 ? (row >> 6) : (row & 63);
        float cs[8], sn[8];
#pragma unroll
        for (int j = 0; j < 8; ++j) { const int f = (d0 + j) & 15; cs[j] = lat ? RC[pos * 16 + f] : 1.f; sn[j] = lat ? RS[pos * 16 + f] : 0.f; }
        const bool lowhalf = (d0 & 16) == 0;
#pragma unroll
        for (int part = 0; part < 2; ++part) {
            float f[8]; unpack8(part == 0 ? qraw : kraw, f);
            float ss = 0.f;
#pragma unroll
            for (int j = 0; j < 8; ++j) ss += f[j] * f[j];
            ss += __shfl_xor(ss, 1); ss += __shfl_xor(ss, 2); ss += __shfl_xor(ss, 4);
            const float rs = rsqrtf(ss * (1.f / 64.f) + 1e-6f);
            float o[8];
#pragma unroll
            for (int j = 0; j < 8; ++j) { const float y = f[j] * rs * (part == 0 ? qn[j] : kn[j]); const float oth = __shfl_xor(y, 2); o[j] = lowhalf ? y * cs[j] - oth * sn[j] : oth * sn[j] + y * cs[j]; }
            uint4 w; w.x = pack2(o[0], o[1]); w.y = pack2(o[2], o[3]); w.z = pack2(o[4], o[5]); w.w = pack2(o[6], o[7]);
            if (part == 0) *(uint4*)(QKR + (size_t)row * 640 + lane * 8) = w;
            else if (lane < 16) *(uint4*)(QKR + (size_t)row * 640 + 512 + lane * 8) = w;
        }
    }
}


template <int MI, int NI, int KK, bool SWAP, bool SWB = false>
__device__ __forceinline__ void wave_mma(f32x4 (&acc)[MI][NI], const bf16_t* A, int lda, const bf16_t* Bt, int ldb, int lane) {
    const int r = lane & 15, q = lane >> 4;
#pragma unroll
    for (int kk = 0; kk < KK; kk += 32) {
        bf16x8 a[MI], b[NI];
#pragma unroll
        for (int mi = 0; mi < MI; ++mi) a[mi] = *(const bf16x8*)(A + (16 * mi + r) * lda + kk + 8 * q);
#pragma unroll
        for (int ni = 0; ni < NI; ++ni) b[ni] = *(const bf16x8*)(Bt + (16 * ni + r) * ldb + ((kk + 8 * q) ^ (SWB ? ((((16 * ni + r) >> 3) & 7) << 3) : 0)));
#pragma unroll
        for (int mi = 0; mi < MI; ++mi)
#pragma unroll
            for (int ni = 0; ni < NI; ++ni)
                acc[mi][ni] = SWAP ? __builtin_amdgcn_mfma_f32_16x16x32_bf16(b[ni], a[mi], acc[mi][ni], 0, 0, 0) : __builtin_amdgcn_mfma_f32_16x16x32_bf16(a[mi], b[ni], acc[mi][ni], 0, 0, 0);
    }
}
__device__ __forceinline__ void prefetch_line(const void* g, float* lds_dummy, int wid) {
    __builtin_amdgcn_global_load_lds((const unsigned*)g, (__attribute__((address_space(3))) unsigned*)((__attribute__((address_space(3))) unsigned char*)lds_dummy + wid * 256), 4, 0, 0);
}
struct Raw3 { uint4 m, c, p; };
__device__ __forceinline__ Raw3 conv8_load(const bf16_t* rowp, int ld, int t, int L) {
    const uint4 z = make_uint4(0u, 0u, 0u, 0u);
    Raw3 r; r.m = t > 0 ? *(const uint4*)(rowp - ld) : z; r.c = *(const uint4*)rowp; r.p = t < L - 1 ? *(const uint4*)(rowp + ld) : z; return r;
}
__device__ __forceinline__ void conv8_apply(const Raw3& r, const float* cwl, float* out) {
    float fm[8], f0[8], fp[8]; unpack8(r.m, fm); unpack8(r.c, f0); unpack8(r.p, fp);
#pragma unroll
    for (int j = 0; j < 8; ++j) { const float4 w = *(const float4*)(cwl + j * 4); out[j] = siluf(w.x * fm[j] + w.y * f0[j] + w.z * fp[j] + w.w); }
}
__device__ __forceinline__ float wave_scan128(float& v0, float& v1, int lane) {
    float s = v0 + v1;
#pragma unroll
    for (int o = 1; o < 64; o <<= 1) { const float t = __shfl_up(s, o); if (lane >= o) s += t; }
    const float excl = s - (v0 + v1);
    v0 = excl + v0; v1 = v0 + v1;
    return __shfl(s, 63);
}

constexpr size_t SSD_S_OFF = 0;
constexpr size_t SSD_H_OFF = (size_t)130 * 16 * 4096 * 4;
__device__ __forceinline__ void stage_convw(const float* cw, const float* cb, int C, float* cwl, int tid) {
    for (int c = tid; c < C; c += NTH) *(float4*)(cwl + c * 4) = make_float4(cw[c], cw[C + c], cw[2 * C + c], cb[c]);
}
__device__ __forceinline__ void ssd_states(const P& p, int bid, int nb, float* lds) {
    const int tid = p.tid(), lane = tid & 63, wid = tid >> 6;
    unsigned char* ws = p.get_ws();
    const bf16_t* PROJ = (const bf16_t*)(ws + WS_PROJ);
    const float* SMALL = (const float*)(ws + WS_SMALL);
    float* S = (float*)(ws + WS_Y + SSD_S_OFF);
    float* DEC = (float*)(ws + WS_CHK);
    float* cwl = lds;
    bf16_t* XT = (bf16_t*)(lds + 768 * 4);
    bf16_t* BT = XT + 256 * 136;
    float* wsc = (float*)(BT + 64 * 136);
    stage_convw(p.in[11], p.in[12], 768, cwl, tid);
    __syncthreads();
    for (int item = bid; item < 260; item += nb) {
        const int c = item >> 1, g = item & 1;
        const int L = c < 128 ? SEQ : CTX, t0 = c < 128 ? c * 128 : (c - 128) * 128, rbase = c < 128 ? 0 : SEQ;
        const int tid = p.tid(), lane = tid & 63, wid = tid >> 6;
#pragma unroll 1
        for (int b5 = 0; b5 < 2; ++b5) {
            Raw3 rw[5];
#pragma unroll
            for (int k = 0; k < 5; ++k) { const int i = tid + (b5 * 5 + k) * NTH; const int cg8 = (i >> 3) % 40, tl = (i / 320) * 8 + (i & 7);
                const int ch = cg8 < 32 ? g * 256 + cg8 * 8 : 512 + g * 64 + (cg8 - 32) * 8;
                rw[k] = conv8_load(PROJ + (size_t)(rbase + t0 + tl) * 2048 + 512 + ch, 2048, t0 + tl, L); }
#pragma unroll
            for (int k = 0; k < 5; ++k) { const int i = tid + (b5 * 5 + k) * NTH; const int cg8 = (i >> 3) % 40, tl = (i / 320) * 8 + (i & 7);
                const int ch = cg8 < 32 ? g * 256 + cg8 * 8 : 512 + g * 64 + (cg8 - 32) * 8;
                float o[8]; conv8_apply(rw[k], cwl + ch * 4, o);
                const int tls = tl ^ ((cg8 & 7) << 3);
                bf16_t* dst = cg8 < 32 ? XT + (cg8 * 8) * 136 + tls : BT + ((cg8 - 32) * 8) * 136 + tls;
#pragma unroll
                for (int j = 0; j < 8; ++j) dst[j * 136] = f2bf(o[j]); }
        }
        const int hh = wid >> 1, d = wid & 1, h = g * 4 + hh;
        {
            const float A = -expf(p.in[14][d * 8 + h]), dtb = p.in[13][d * 8 + h];
            const float dt0 = softplusf(SMALL[(size_t)(rbase + t0 + 2 * lane) * 32 + d * 8 + h] + dtb), dt1 = softplusf(SMALL[(size_t)(rbase + t0 + 2 * lane + 1) * 32 + d * 8 + h] + dtb);
            const float a0 = dt0 * A, a1 = dt1 * A;
            float c0 = a0, c1 = a1; const float tot = wave_scan128(c0, c1, lane);
            const float w0 = d == 0 ? __expf(tot - c0) * dt0 : __expf(c0 - a0) * dt0, w1 = d == 0 ? __expf(tot - c1) * dt1 : __expf(c1 - a1) * dt1;
            wsc[wid * 128 + 2 * lane] = w0; wsc[wid * 128 + 2 * lane + 1] = w1;
            if (lane == 0) DEC[c * 16 + d * 8 + h] = __expf(tot);
        }
        __syncthreads();
        {
            f32x4 acc[4][4];
#pragma unroll
            for (int mi = 0; mi < 4; ++mi)
#pragma unroll
                for (int ni = 0; ni < 4; ++ni) acc[mi][ni] = (f32x4){0.f, 0.f, 0.f, 0.f};
            const int r = lane & 15, q = lane >> 4;
#pragma unroll
            for (int kk = 0; kk < 128; kk += 32) {
                const float4 wa = *(const float4*)(wsc + wid * 128 + kk + 8 * q), wb = *(const float4*)(wsc + wid * 128 + kk + 8 * q + 4);
                bf16x8 a[4], b[4];
#pragma unroll
                for (int mi = 0; mi < 4; ++mi) {
                    const uint4 raw = *(const uint4*)(XT + (hh * 64 + 16 * mi + r) * 136 + ((kk + 8 * q) ^ ((((16 * mi + r) >> 3) & 7) << 3)));
                    float f[8]; unpack8(raw, f);
                    uint4 o; o.x = pack2(f[0] * wa.x, f[1] * wa.y); o.y = pack2(f[2] * wa.z, f[3] * wa.w); o.z = pack2(f[4] * wb.x, f[5] * wb.y); o.w = pack2(f[6] * wb.z, f[7] * wb.w);
                    a[mi] = *(bf16x8*)&o;
                }
#pragma unroll
                for (int ni = 0; ni < 4; ++ni) b[ni] = *(const bf16x8*)(BT + (16 * ni + r) * 136 + ((kk + 8 * q) ^ ((((16 * ni + r) >> 3) & 7) << 3)));
#pragma unroll
                for (int mi = 0; mi < 4; ++mi)
#pragma unroll
                    for (int ni = 0; ni < 4; ++ni) acc[mi][ni] = __builtin_amdgcn_mfma_f32_16x16x32_bf16(a[mi], b[ni], acc[mi][ni], 0, 0, 0);
                __builtin_amdgcn_sched_barrier(0);
            }
            float* Sp = S + ((size_t)(c * 2 + d) * 8 + h) * 4096;
#pragma unroll
            for (int mi = 0; mi < 4; ++mi)
#pragma unroll
                for (int ni = 0; ni < 4; ++ni)
#pragma unroll
                    for (int j = 0; j < 4; ++j) Sp[(16 * mi + 4 * q + j) * 64 + 16 * ni + r] = acc[mi][ni][j];
        }
        __syncthreads();
    }
}
__device__ __forceinline__ void ssd_scan(const P& p, int bid, int nb) {
    const int tid = p.tid();
    unsigned char* ws = p.get_ws();
    const float* S = (const float*)(ws + WS_Y + SSD_S_OFF);
    bf16_t* HIN = (bf16_t*)(ws + WS_Y + SSD_H_OFF);
    const float* DEC = (const float*)(ws + WS_CHK);
    for (int gid = bid * NTH + tid; gid < 65536; gid += nb * NTH) {
        const int d = gid >> 15, h = (gid >> 12) & 7, e = gid & 4095;
        float H = 0.f;
#pragma unroll 1
        for (int i0 = 0; i0 < 130; i0 += 10) {
            float sv[10], dv[10]; int cc[10];
#pragma unroll
            for (int j = 0; j < 10; ++j) {
                const int i = i0 + j;
                const int c = d == 0 ? (i < 2 ? 128 + i : i - 2) : (i < 2 ? 129 - i : 129 - i);
                cc[j] = c; sv[j] = S[((size_t)(c * 2 + d) * 8 + h) * 4096 + e]; dv[j] = DEC[c * 16 + d * 8 + h];
            }
#pragma unroll
            for (int j = 0; j < 10; ++j) { HIN[((size_t)(cc[j] * 2 + d) * 8 + h) * 4096 + e] = f2bf(H); H = dv[j] * H + sv[j]; }
        }
    }
}
__device__ __forceinline__ void ssd_out(const P& p, int bid, int nb, float* lds) {
    unsigned char* tsbase = (unsigned char*)lds + LDS_BYTES - 128; (void)tsbase;
    const int tid = p.tid(), lane = tid & 63, wid = tid >> 6, r = lane & 15, q = lane >> 4;
    unsigned char* ws = p.get_ws();
    const bf16_t* PROJ = (const bf16_t*)(ws + WS_PROJ);
    const float* SMALL = (const float*)(ws + WS_SMALL);
    const bf16_t* HIN = (const bf16_t*)(ws + WS_Y + SSD_H_OFF);
    bf16_t* MIX = (bf16_t*)(ws + WS_HB);
    float* cwl = lds;
    bf16_t* Cg = (bf16_t*)(lds + 768 * 4);
    bf16_t* Bg = Cg + 128 * 72;
    bf16_t* XT = Bg + 128 * 72;
    bf16_t* Mb = XT + 64 * 136;
    bf16_t* Hn = Mb + 128 * 136;
    float* csb = (float*)(Hn + 2 * 64 * 72);
    float* dts = csb + 8 * 256;
    stage_convw(p.in[11], p.in[12], 768, cwl, tid);
    __syncthreads();
    for (int c = bid; c < 130; c += nb) {
        TS(10);
        const int L = c < 128 ? SEQ : CTX, t0 = c < 128 ? c * 128 : (c - 128) * 128, rbase = c < 128 ? 0 : SEQ;
        const int trow = wid * 16 + r;
        float ssq = 0.f;
        Raw3 nrw[2]; uint4 nhp0, nhp1;
        {
            const int tid = p.tid(), lane = tid & 63, wid = tid >> 6;
            const int h = wid;
#pragma unroll
            for (int d = 0; d < 2; ++d) {
                const float A = -expf(p.in[14][d * 8 + h]), dtb = p.in[13][d * 8 + h];
                const float dt0 = softplusf(SMALL[(size_t)(rbase + t0 + 2 * lane) * 32 + d * 8 + h] + dtb), dt1 = softplusf(SMALL[(size_t)(rbase + t0 + 2 * lane + 1) * 32 + d * 8 + h] + dtb);
                const float a0 = dt0 * A, a1 = dt1 * A;
                float c0 = a0, c1 = a1; const float tot = wave_scan128(c0, c1, lane);
                csb[(h * 2 + d) * 128 + 2 * lane] = d == 0 ? c0 : tot - c0 + a0; csb[(h * 2 + d) * 128 + 2 * lane + 1] = d == 0 ? c1 : tot - c1 + a1;
                dts[(h * 2 + d) * 128 + 2 * lane] = dt0; dts[(h * 2 + d) * 128 + 2 * lane + 1] = dt1;
            }
        }
        for (int g = 0; g < 2; ++g) {
            {
                Raw3 rw[4];
#pragma unroll
                for (int k = 0; k < 4; ++k) { const int i = tid + k * NTH; const int cg8 = i & 15, tl = i >> 4;
                    const int ch = cg8 < 8 ? 640 + g * 64 + cg8 * 8 : 512 + g * 64 + (cg8 - 8) * 8;
                    rw[k] = conv8_load(PROJ + (size_t)(rbase + t0 + tl) * 2048 + 512 + ch, 2048, t0 + tl, L); }
#pragma unroll
                for (int k = 0; k < 4; ++k) { const int i = tid + k * NTH; const int cg8 = i & 15, tl = i >> 4;
                    const int ch = cg8 < 8 ? 640 + g * 64 + cg8 * 8 : 512 + g * 64 + (cg8 - 8) * 8;
                    float o[8]; conv8_apply(rw[k], cwl + ch * 4, o);
                    uint4 w; w.x = pack2(o[0], o[1]); w.y = pack2(o[2], o[3]); w.z = pack2(o[4], o[5]); w.w = pack2(o[6], o[7]);
                    *(uint4*)((cg8 < 8 ? Cg + cg8 * 8 : Bg + (cg8 - 8) * 8) + tl * 72) = w; }
            }
            __syncthreads();
            if (g == 0) TS(11);
            f32x4 G[1][8];
#pragma unroll
            for (int ni = 0; ni < 8; ++ni) G[0][ni] = (f32x4){0.f, 0.f, 0.f, 0.f};
            wave_mma<1, 8, 64, true>(G, Cg + wid * 16 * 72, 72, Bg, 72, lane);
            if (g == 0) TS(12);
            for (int hh = 0; hh < 4; ++hh) {
                const int h = g * 4 + hh;
                {
                    if (h == 0) {
#pragma unroll
                        for (int k = 0; k < 2; ++k) { const int i = tid + k * NTH; const int cg8 = (i >> 3) & 7, tl = (i >> 6) * 8 + (i & 7);
                            nrw[k] = conv8_load(PROJ + (size_t)(rbase + t0 + tl) * 2048 + 512 + cg8 * 8, 2048, t0 + tl, L); }
                        nhp0 = *(const uint4*)(HIN + ((size_t)(c * 2 + 0) * 8) * 4096 + tid * 8); nhp1 = *(const uint4*)(HIN + ((size_t)(c * 2 + 1) * 8) * 4096 + tid * 8);
                    }
                    Raw3 rw[2]; rw[0] = nrw[0]; rw[1] = nrw[1];
                    const uint4 hp0 = nhp0, hp1 = nhp1;
#pragma unroll
                    for (int k = 0; k < 2; ++k) { const int i = tid + k * NTH; const int cg8 = (i >> 3) & 7, tl = (i >> 6) * 8 + (i & 7); const int ch = h * 64 + cg8 * 8;
                        float o[8]; conv8_apply(rw[k], cwl + ch * 4, o);
#pragma unroll
                        for (int j = 0; j < 8; ++j) XT[(cg8 * 8 + j) * 136 + (tl ^ (cg8 << 3))] = f2bf(o[j]); }
                    *(uint4*)(Hn + (tid >> 3) * 72 + (tid & 7) * 8) = hp0; *(uint4*)(Hn + 64 * 72 + (tid >> 3) * 72 + (tid & 7) * 8) = hp1;
                }
                __syncthreads();
                if (g == 0 && hh == 0) TS(13);
                if (h < 7) {
#pragma unroll
                    for (int k = 0; k < 2; ++k) { const int i = tid + k * NTH; const int cg8 = (i >> 3) & 7, tl = (i >> 6) * 8 + (i & 7);
                        nrw[k] = conv8_load(PROJ + (size_t)(rbase + t0 + tl) * 2048 + 512 + (h + 1) * 64 + cg8 * 8, 2048, t0 + tl, L); }
                    nhp0 = *(const uint4*)(HIN + ((size_t)(c * 2 + 0) * 8 + h + 1) * 4096 + tid * 8); nhp1 = *(const uint4*)(HIN + ((size_t)(c * 2 + 1) * 8 + h + 1) * 4096 + tid * 8);
                }
                uint2 zpre[4];
#pragma unroll
                for (int ni = 0; ni < 4; ++ni) zpre[ni] = *(const uint2*)(PROJ + (size_t)(rbase + t0 + trow) * 2048 + h * 64 + 16 * ni + 4 * q);
                f32x4 Y[1][4];
#pragma unroll
                for (int ni = 0; ni < 4; ++ni) Y[0][ni] = (f32x4){0.f, 0.f, 0.f, 0.f};
                for (int d = 0; d < 2; ++d) {
                    const float cst = csb[(h * 2 + d) * 128 + trow];
#pragma unroll
                    for (int ni = 0; ni < 8; ++ni) {
                        const int s0 = 16 * ni + 4 * q;
                        const float4 css = *(const float4*)(csb + (h * 2 + d) * 128 + s0), dtv = *(const float4*)(dts + (h * 2 + d) * 128 + s0);
                        const float cs4[4] = {css.x, css.y, css.z, css.w}, dt4[4] = {dtv.x, dtv.y, dtv.z, dtv.w};
                        float m[4];
#pragma unroll
                        for (int j = 0; j < 4; ++j) { const int sidx = s0 + j; const bool ok = d == 0 ? sidx <= trow : sidx >= trow; m[j] = ok ? G[0][ni][j] * __expf(cst - cs4[j]) * dt4[j] : 0.f; }
                        uint2 w; w.x = pack2(m[0], m[1]); w.y = pack2(m[2], m[3]);
                        *(uint2*)(Mb + trow * 136 + s0) = w;
                    }
                    __syncthreads();
                    wave_mma<1, 4, 128, true, true>(Y, Mb + wid * 16 * 136, 136, XT, 136, lane);
                    f32x4 Yo[1][4];
#pragma unroll
                    for (int ni = 0; ni < 4; ++ni) Yo[0][ni] = (f32x4){0.f, 0.f, 0.f, 0.f};
                    wave_mma<1, 4, 64, true>(Yo, Cg + wid * 16 * 72, 72, Hn + d * 64 * 72, 72, lane);
                    const float ecs = __expf(cst);
#pragma unroll
                    for (int ni = 0; ni < 4; ++ni) Y[0][ni] += Yo[0][ni] * ecs;
                    __syncthreads();
                    if (g == 0 && hh == 0 && d == 1) TS(14);
                }
                const float Dh = p.in[15][h];
                const size_t grow = (size_t)(rbase + t0 + trow);
#pragma unroll
                for (int ni = 0; ni < 4; ++ni) {
                    const int p0 = 16 * ni + 4 * q;
                    const uint2 zr = zpre[ni];
                    const float z4[4] = {__uint_as_float(zr.x << 16), __uint_as_float(zr.x & 0xffff0000u), __uint_as_float(zr.y << 16), __uint_as_float(zr.y & 0xffff0000u)};
                    float u[4];
#pragma unroll
                    for (int j = 0; j < 4; ++j) { const float y = Y[0][ni][j] + Dh * bf2f(XT[(p0 + j) * 136 + (trow ^ ((((p0 + j) >> 3) & 7) << 3))]); u[j] = y * siluf(z4[j]); ssq += u[j] * u[j]; }
                    uint2 w; w.x = pack2(u[0], u[1]); w.y = pack2(u[2], u[3]);
                    *(uint2*)(MIX + grow * 1024 + h * 64 + p0) = w;
                }
                lds_barrier();
                if (g == 0 && hh == 0) TS(15);
            }
        }
        TS(16);
        ssq += __shfl_xor(ssq, 16); ssq += __shfl_xor(ssq, 32);
        if (q == 0) csb[trow] = ssq;
        asm volatile("s_waitcnt vmcnt(0)" ::: "memory");
        __syncthreads();
        {
            const int rr = tid >> 2, qc = tid & 3;
            const float rs = rsqrtf(csb[rr] * (1.f / 512.f) + 1e-6f);
            bf16_t* mp = MIX + (size_t)(rbase + t0 + rr) * 1024 + qc * 128;
            const float* nwp = p.in[16] + qc * 128;
#pragma unroll 4
            for (int k = 0; k < 16; ++k) {
                float f[8]; unpack8(*(const uint4*)(mp + k * 8), f);
                const float4 n0 = *(const float4*)(nwp + k * 8), n1 = *(const float4*)(nwp + k * 8 + 4);
                uint4 w; w.x = pack2(f[0] * rs * n0.x, f[1] * rs * n0.y); w.y = pack2(f[2] * rs * n0.z, f[3] * rs * n0.w); w.z = pack2(f[4] * rs * n1.x, f[5] * rs * n1.y); w.w = pack2(f[6] * rs * n1.z, f[7] * rs * n1.w);
                *(uint4*)(mp + k * 8) = w;
            }
        }
        __syncthreads();
        TS(17);
    }
}


__device__ __forceinline__ void attn_mfma(const P& p, int bid, int nb, float* lds) {
    const int tid = p.tid(), lane = tid & 63, wid = __builtin_amdgcn_readfirstlane(tid >> 6), r = lane & 15, q = lane >> 4;
    unsigned char* ws = p.get_ws();
    const bf16_t* PROJ = (const bf16_t*)(ws + WS_PROJ);
    const bf16_t* QKR = (const bf16_t*)(ws + WS_XRES);
    bf16_t* MIX = (bf16_t*)(ws + WS_HB);
    bf16_t* Kb = (bf16_t*)lds;
    bf16_t* Vb = Kb + 2 * 64 * 72;
    for (int item = bid; item < 260; item += nb) {
        const bool isctx = item >= 256;
        const int qb = isctx ? (item - 256) >> 1 : item >> 1, g = item & 1;
        const int qrow0 = (isctx ? SEQ : 0) + qb * 128;
        const int hq = g * 4 + (wid >> 1), wrow0 = (wid & 1) * 64;
        const int ntl = isctx ? 0 : 6, nt = ntl + 4;
        bf16_t* Qw = Vb + 2 * 64 * 72 + wid * 64 * 72;
#pragma unroll
        for (int mi = 0; mi < 4; ++mi)
#pragma unroll
            for (int kk = 0; kk < 2; ++kk) {
                const uint4 raw = *(const uint4*)(QKR + (size_t)(qrow0 + wrow0 + 16 * mi + r) * 640 + hq * 64 + kk * 32 + 8 * q);
                float f[8]; unpack8(raw, f);
                uint4 o; o.x = pack2(f[0] * 0.125f, f[1] * 0.125f); o.y = pack2(f[2] * 0.125f, f[3] * 0.125f); o.z = pack2(f[4] * 0.125f, f[5] * 0.125f); o.w = pack2(f[6] * 0.125f, f[7] * 0.125f);
                *(uint4*)(Qw + (16 * mi + r) * 72 + kk * 32 + 8 * q) = o;
            }
        const float sink = p.in[19][hq];
        float m[4], l[4]; f32x4 O[4][4];
#pragma unroll
        for (int mi = 0; mi < 4; ++mi) { m[mi] = sink; l[mi] = q == 0 ? 1.f : 0.f;
#pragma unroll
            for (int ni = 0; ni < 4; ++ni) O[mi][ni] = (f32x4){0.f, 0.f, 0.f, 0.f}; }
#define ATT_VALID(ti_) ((ti_) >= ntl || (qb * 128 - 128 + 64 * (ti_) >= 0 && qb * 128 - 128 + 64 * (ti_) < SEQ))
#define ATT_KROW(ti_) ((ti_) < ntl ? qb * 128 - 128 + 64 * (ti_) : SEQ + 64 * ((ti_) - ntl))
        int ti = 0; while (ti < nt && !ATT_VALID(ti)) ++ti;
        uint4 kreg, vreg;
        { const int kr0 = ATT_KROW(ti);
          kreg = *(const uint4*)(QKR + (size_t)(kr0 + (tid >> 3)) * 640 + 512 + g * 64 + (tid & 7) * 8);
          vreg = *(const uint4*)(PROJ + (size_t)(kr0 + (tid >> 3)) * 2048 + 1920 + g * 64 + (tid & 7) * 8); }
        int cur = 0;
        __syncthreads();
        { *(uint4*)(Kb + (tid >> 3) * 72 + (tid & 7) * 8) = kreg;
          bf16_t* vd = Vb + ((tid & 7) * 8) * 72 + ((tid >> 3) ^ ((tid & 7) << 3)); const u32 vw[4] = {vreg.x, vreg.y, vreg.z, vreg.w};
#pragma unroll
          for (int j = 0; j < 4; ++j) { vd[(2 * j) * 72] = (bf16_t)(vw[j] & 0xffff); vd[(2 * j + 1) * 72] = (bf16_t)(vw[j] >> 16); } }
        __syncthreads();
        while (ti < nt) {
            int tn = ti + 1; while (tn < nt && !ATT_VALID(tn)) ++tn;
            if (tn < nt) { const int kr0 = ATT_KROW(tn);
                kreg = *(const uint4*)(QKR + (size_t)(kr0 + (tid >> 3)) * 640 + 512 + g * 64 + (tid & 7) * 8);
                vreg = *(const uint4*)(PROJ + (size_t)(kr0 + (tid >> 3)) * 2048 + 1920 + g * 64 + (tid & 7) * 8); }
            const bool local = ti < ntl;
            const bool need = !local || ((wid & 1) == 0 ? ti <= 4 : ti >= 1);
            if (need) {
                const bf16_t* Kt = Kb + cur * 64 * 72; const bf16_t* Vt = Vb + cur * 64 * 72;
                const int kp0 = qb * 128 - 128 + 64 * ti + 4 * q, qp0 = qb * 128 + wrow0 + r;
#pragma unroll
                for (int mi = 0; mi < 4; ++mi) {
                    f32x4 S[4];
#pragma unroll
                    for (int ni = 0; ni < 4; ++ni) S[ni] = (f32x4){0.f, 0.f, 0.f, 0.f};
#pragma unroll
                    for (int kk = 0; kk < 2; ++kk) {
                        const bf16x8 qfr = *(const bf16x8*)(Qw + (16 * mi + r) * 72 + kk * 32 + 8 * q);
#pragma unroll
                        for (int ni = 0; ni < 4; ++ni) {
                            const bf16x8 bfr = *(const bf16x8*)(Kt + (16 * ni + r) * 72 + kk * 32 + 8 * q);
                            S[ni] = __builtin_amdgcn_mfma_f32_16x16x32_bf16(bfr, qfr, S[ni], 0, 0, 0);
                        }
                    }
                    if (local) {
#pragma unroll
                        for (int ni = 0; ni < 4; ++ni)
#pragma unroll
                            for (int j = 0; j < 4; ++j) { const int dlt = (qp0 + 16 * mi) - (kp0 + 16 * ni + j); if (dlt > 128 || dlt < -128) S[ni][j] = -1e30f; }
                    }
                    float mx = -1e30f;
#pragma unroll
                    for (int ni = 0; ni < 4; ++ni)
#pragma unroll
                        for (int j = 0; j < 4; ++j) mx = fmaxf(mx, S[ni][j]);
                    mx = fmaxf(mx, __shfl_xor(mx, 16)); mx = fmaxf(mx, __shfl_xor(mx, 32));
                    const float mn = fmaxf(m[mi], mx), al = __expf(m[mi] - mn);
                    m[mi] = mn;
                    float ps = 0.f;
#pragma unroll
                    for (int ni = 0; ni < 4; ++ni)
#pragma unroll
                        for (int j = 0; j < 4; ++j) { const float e = __expf(S[ni][j] - mn); S[ni][j] = e; ps += e; }
                    l[mi] = l[mi] * al + ps;
#pragma unroll
                    for (int ni = 0; ni < 4; ++ni) O[mi][ni] *= al;
                    __builtin_amdgcn_sched_barrier(0);
#pragma unroll
                    for (int kk = 0; kk < 2; ++kk) {
                        uint4 o; o.x = pack2(S[2 * kk][0], S[2 * kk][1]); o.y = pack2(S[2 * kk][2], S[2 * kk][3]);
                        o.z = pack2(S[2 * kk + 1][0], S[2 * kk + 1][1]); o.w = pack2(S[2 * kk + 1][2], S[2 * kk + 1][3]);
                        const bf16x8 pfr = *(bf16x8*)&o;
#pragma unroll
                        for (int ni = 0; ni < 4; ++ni) {
                            const int vsw = (((16 * ni + r) >> 3) & 7) << 3;
                            const uint2 v0 = *(const uint2*)(Vt + (16 * ni + r) * 72 + ((32 * kk + 4 * q) ^ vsw)), v1 = *(const uint2*)(Vt + (16 * ni + r) * 72 + ((32 * kk + 16 + 4 * q) ^ vsw));
                            uint4 vo; vo.x = v0.x; vo.y = v0.y; vo.z = v1.x; vo.w = v1.y;
                            O[mi][ni] = __builtin_amdgcn_mfma_f32_16x16x32_bf16(*(bf16x8*)&vo, pfr, O[mi][ni], 0, 0, 0);
                        }
                    }
                    __builtin_amdgcn_sched_barrier(0);
                }
            }
            if (tn < nt) {
                *(uint4*)(Kb + (cur ^ 1) * 64 * 72 + (tid >> 3) * 72 + (tid & 7) * 8) = kreg;
                bf16_t* vd = Vb + (cur ^ 1) * 64 * 72 + ((tid & 7) * 8) * 72 + ((tid >> 3) ^ ((tid & 7) << 3)); const u32 vw[4] = {vreg.x, vreg.y, vreg.z, vreg.w};
#pragma unroll
                for (int j = 0; j < 4; ++j) { vd[(2 * j) * 72] = (bf16_t)(vw[j] & 0xffff); vd[(2 * j + 1) * 72] = (bf16_t)(vw[j] >> 16); }
            }
            __syncthreads();
            ti = tn; cur ^= 1;
        }
#undef ATT_VALID
#undef ATT_KROW
#pragma unroll
        for (int mi = 0; mi < 4; ++mi) {
            float lt = l[mi]; lt += __shfl_xor(lt, 16); lt += __shfl_xor(lt, 32);
            const float inv = 1.f / lt;
            bf16_t* op = MIX + (size_t)(qrow0 + wrow0 + 16 * mi + r) * 1024 + 512 + hq * 64 + 4 * q;
#pragma unroll
            for (int ni = 0; ni < 4; ++ni) { uint2 w; w.x = pack2(O[mi][ni][0] * inv, O[mi][ni][1] * inv); w.y = pack2(O[mi][ni][2] * inv, O[mi][ni][3] * inv); *(uint2*)(op + 16 * ni) = w; }
        }
    }
}


constexpr size_t ML_ST_OFF = 0;
constexpr size_t ML_CIN_OFF = (size_t)130 * 16 * 8192 * 2;
constexpr int CH_DEC = 0, CH_BL = 4096, CH_AC = 8192, CH_MIN = 12288, CH_NC = 16384, CH_NIN = 16384 + 130 * 16 * 64;
__device__ __forceinline__ void stage_convw_part(const float* cw, const float* cb, int C, int c0, int n, float* cwl, int tid) {
    for (int i = tid; i < n; i += NTH) *(float4*)(cwl + i * 4) = make_float4(cw[c0 + i], cw[C + c0 + i], cw[2 * C + c0 + i], cb[c0 + i]);
}
__device__ __forceinline__ void ml_states(const P& p, int bid, int nb, float* lds) {
    const int tid = p.tid(), lane = tid & 63, wid = tid >> 6, r = lane & 15, q = lane >> 4;
    unsigned char* ws = p.get_ws();
    const bf16_t* PROJ = (const bf16_t*)(ws + WS_PROJ);
    const float* SMALL = (const float*)(ws + WS_SMALL);
    bf16_t* ST = (bf16_t*)(ws + WS_Y + ML_ST_OFF);
    float* CHK = (float*)(ws + WS_CHK);
    float* cwl = lds;
    bf16_t* VT = (bf16_t*)(lds + 384 * 4);
    bf16_t* KT = VT + 2 * 128 * 136;
    float* es = (float*)(KT + 2 * 64 * 136);
    for (int item = bid; item < 520; item += nb) {
        const int c = item >> 2, hp = item & 3;
        const int L = c < 128 ? SEQ : CTX, t0 = c < 128 ? c * 128 : (c - 128) * 128, rbase = c < 128 ? 0 : SEQ;
        if (tid < 384) { const int ch = tid < 128 ? 512 + hp * 128 + tid : 1024 + hp * 256 + (tid - 128);
            const float* cw = p.in[22]; *(float4*)(cwl + tid * 4) = make_float4(cw[ch], cw[2048 + ch], cw[4096 + ch], p.in[23][ch]); }
        __syncthreads();
#pragma unroll 1
        for (int b4 = 0; b4 < 3; ++b4) {
            Raw3 rw[4];
#pragma unroll
            for (int k = 0; k < 4; ++k) { const int i = tid + (b4 * 4 + k) * NTH; const int cg8 = (i >> 3) % 48, tl = (i / 384) * 8 + (i & 7);
                const int col = cg8 < 16 ? 512 + hp * 128 + cg8 * 8 : 1024 + hp * 256 + (cg8 - 16) * 8;
                rw[k] = conv8_load(PROJ + (size_t)(rbase + t0 + tl) * 3072 + col, 3072, t0 + tl, L); }
#pragma unroll
            for (int k = 0; k < 4; ++k) { const int i = tid + (b4 * 4 + k) * NTH; const int cg8 = (i >> 3) % 48, tl = (i / 384) * 8 + (i & 7);
                float o[8]; conv8_apply(rw[k], cwl + cg8 * 32, o);
                const float sc = cg8 < 16 ? 0.125f : 1.f;
                const int tls = tl ^ ((cg8 & 7) << 3);
                bf16_t* dst = cg8 < 16 ? KT + (cg8 * 8) * 136 + tls : VT + ((cg8 - 16) * 8) * 136 + tls;
#pragma unroll
                for (int j = 0; j < 8; ++j) dst[j * 136] = f2bf(o[j] * sc); }
        }
        const int hl = wid >> 2, d = (wid >> 1) & 1, vh = wid & 1, h = hp * 2 + hl, dh = d * 8 + h;
        float tot, ac;
        {
            const float igb = p.in[24][dh], fgb = p.in[25][dh];
            const float* sm0 = SMALL + (size_t)(rbase + t0 + 2 * lane) * 32;
            const float ig0 = sm0[dh] + igb, ig1 = sm0[32 + dh] + igb, lf0 = logsigf(sm0[16 + dh] + fgb), lf1 = logsigf(sm0[32 + 16 + dh] + fgb);
            float c0 = lf0, c1 = lf1; tot = wave_scan128(c0, c1, lane);
            const float w0 = (d == 0 ? tot - c0 : c0 - lf0) + ig0, w1 = (d == 0 ? tot - c1 : c1 - lf1) + ig1;
            ac = fmaxf(w0, w1);
#pragma unroll
            for (int o = 32; o >= 1; o >>= 1) ac = fmaxf(ac, __shfl_xor(ac, o));
            es[wid * 128 + 2 * lane] = __expf(w0 - ac); es[wid * 128 + 2 * lane + 1] = __expf(w1 - ac);
        }
        __syncthreads();
        {
            f32x4 acc[4][4];
#pragma unroll
            for (int mi = 0; mi < 4; ++mi)
#pragma unroll
                for (int ni = 0; ni < 4; ++ni) acc[mi][ni] = (f32x4){0.f, 0.f, 0.f, 0.f};
            const bf16_t* Ab = VT + (hl * 128 + vh * 64) * 136; const bf16_t* Bb = KT + (hl * 64) * 136;
#pragma unroll
            for (int kk = 0; kk < 128; kk += 32) {
                const float4 wa = *(const float4*)(es + wid * 128 + kk + 8 * q), wb = *(const float4*)(es + wid * 128 + kk + 8 * q + 4);
                bf16x8 a[4], b[4];
#pragma unroll
                for (int mi = 0; mi < 4; ++mi) a[mi] = *(const bf16x8*)(Ab + (16 * mi + r) * 136 + ((kk + 8 * q) ^ ((((16 * mi + r) >> 3) & 7) << 3)));
#pragma unroll
                for (int ni = 0; ni < 4; ++ni) {
                    const uint4 raw = *(const uint4*)(Bb + (16 * ni + r) * 136 + ((kk + 8 * q) ^ ((((16 * ni + r) >> 3) & 7) << 3)));
                    float f[8]; unpack8(raw, f);
                    uint4 o; o.x = pack2(f[0] * wa.x, f[1] * wa.y); o.y = pack2(f[2] * wa.z, f[3] * wa.w); o.z = pack2(f[4] * wb.x, f[5] * wb.y); o.w = pack2(f[6] * wb.z, f[7] * wb.w);
                    b[ni] = *(bf16x8*)&o;
                }
#pragma unroll
                for (int mi = 0; mi < 4; ++mi)
#pragma unroll
                    for (int ni = 0; ni < 4; ++ni) acc[mi][ni] = __builtin_amdgcn_mfma_f32_16x16x32_bf16(b[ni], a[mi], acc[mi][ni], 0, 0, 0);
                __builtin_amdgcn_sched_barrier(0);
            }
            bf16_t* Sp = ST + ((size_t)c * 16 + dh) * 8192 + (vh * 64) * 64;
#pragma unroll
            for (int mi = 0; mi < 4; ++mi)
#pragma unroll
                for (int ni = 0; ni < 4; ++ni) { uint2 w; w.x = pack2(acc[mi][ni][0], acc[mi][ni][1]); w.y = pack2(acc[mi][ni][2], acc[mi][ni][3]); *(uint2*)(Sp + (16 * mi + r) * 64 + 16 * ni + 4 * q) = w; }
            if (vh == 0) {
                float nsum = 0.f; const bf16_t* kr = Bb + lane * 136;
#pragma unroll 4
                for (int s8 = 0; s8 < 128; s8 += 8) { float f[8]; unpack8(*(const uint4*)(kr + (s8 ^ (((lane >> 3) & 7) << 3))), f);
#pragma unroll
                    for (int j = 0; j < 8; ++j) nsum += f[j] * es[wid * 128 + s8 + j]; }
                CHK[CH_NC + (c * 16 + dh) * 64 + lane] = nsum;
                if (lane == 0) { CHK[CH_BL + c * 16 + dh] = tot; CHK[CH_AC + c * 16 + dh] = ac; }
            }
        }
        __syncthreads();
    }
}
__device__ __forceinline__ void ml_scan(const P& p, int bid, int nb) {
    const int tid = p.tid();
    unsigned char* ws = p.get_ws();
    const bf16_t* ST = (const bf16_t*)(ws + WS_Y + ML_ST_OFF);
    bf16_t* CIN = (bf16_t*)(ws + WS_Y + ML_CIN_OFF);
    float* CHK = (float*)(ws + WS_CHK);
    for (int gid = bid * NTH + tid; gid < 131072; gid += nb * NTH) {
        const int dh = gid >> 13, d = dh >> 3, e = gid & 8191;
        float C = 0.f, n = 0.f, m = 0.f;
#pragma unroll 1
        for (int i0 = 0; i0 < 130; i0 += 10) {
            float sv[10], bl[10], av[10], nv[10]; int cc[10];
#pragma unroll
            for (int j = 0; j < 10; ++j) {
                const int i = i0 + j;
                const int c = d == 0 ? (i < 2 ? 128 + i : i - 2) : 129 - i;
                cc[j] = c; sv[j] = bf2f(ST[((size_t)c * 16 + dh) * 8192 + e]); bl[j] = CHK[CH_BL + c * 16 + dh]; av[j] = CHK[CH_AC + c * 16 + dh];
                nv[j] = e < 64 ? CHK[CH_NC + (c * 16 + dh) * 64 + e] : 0.f;
            }
#pragma unroll
            for (int j = 0; j < 10; ++j) {
                CIN[((size_t)cc[j] * 16 + dh) * 8192 + e] = f2bf(C);
                if (e < 64) CHK[CH_NIN + (cc[j] * 16 + dh) * 64 + e] = n;
                if (e == 0) CHK[CH_MIN + cc[j] * 16 + dh] = m;
                const float mn = fmaxf(bl[j] + m, av[j]);
                const float sp = __expf(bl[j] + m - mn), sc = __expf(av[j] - mn);
                C = sp * C + sc * sv[j]; n = sp * n + sc * nv[j]; m = mn;
            }
        }
    }
}
__device__ __forceinline__ void ml_out(const P& p, int bid, int nb, float* lds) {
    unsigned char* tsbase = (unsigned char*)lds + LDS_BYTES - 128; (void)tsbase;
    const int tid = p.tid(), lane = tid & 63, wid = tid >> 6, r = lane & 15, q = lane >> 4;
    unsigned char* ws = p.get_ws();
    const bf16_t* PROJ = (const bf16_t*)(ws + WS_PROJ);
    const float* SMALL = (const float*)(ws + WS_SMALL);
    const bf16_t* CIN = (const bf16_t*)(ws + WS_Y + ML_CIN_OFF);
    const float* CHK = (const float*)(ws + WS_CHK);
    bf16_t* MIX = (bf16_t*)(ws + WS_HB);
    float* cwl = lds;
    bf16_t* Qs = (bf16_t*)(lds + 256 * 4);
    bf16_t* Ks = Qs + 128 * 72;
    bf16_t* VT = Ks + 128 * 72;
    bf16_t* Wb = VT + 128 * 136;
    bf16_t* Ct = Wb + 128 * 136;
    float* bet = (float*)(Ct + 2 * 128 * 72);
    float* igs = bet + 8 * 128;
    float* nin = igs + 8 * 128;
    float* mins = nin + 8 * 64;
    for (int item = bid; item < 256; item += nb) {
        const int c = item >> 1, hg = item & 1;
        const int t0 = c * 128;
        const int trow = wid * 16 + r;
        const size_t grow = (size_t)(t0 + trow);
        __syncthreads();
        {
            const int tid = p.tid(), lane = tid & 63, wid = tid >> 6;
            const int d = wid & 1, dh = d * 8 + hg * 4 + (wid >> 1), cb8 = wid;
            const float igb = p.in[24][dh], fgb = p.in[25][dh];
            const float* sm0 = SMALL + (size_t)(t0 + 2 * lane) * 32;
            const float ig0 = sm0[dh] + igb, ig1 = sm0[32 + dh] + igb, lf0 = logsigf(sm0[16 + dh] + fgb), lf1 = logsigf(sm0[32 + 16 + dh] + fgb);
            float c0 = lf0, c1 = lf1; const float tot = wave_scan128(c0, c1, lane);
            bet[cb8 * 128 + 2 * lane] = d == 0 ? c0 : tot - c0 + lf0; bet[cb8 * 128 + 2 * lane + 1] = d == 0 ? c1 : tot - c1 + lf1;
            igs[cb8 * 128 + 2 * lane] = ig0; igs[cb8 * 128 + 2 * lane + 1] = ig1;
            nin[cb8 * 64 + lane] = CHK[CH_NIN + (c * 16 + dh) * 64 + lane];
            if (lane == 0) mins[cb8] = CHK[CH_MIN + c * 16 + dh];
        }
        for (int hh = 0; hh < 4; ++hh) {
            const int h = hg * 4 + hh;
            const int tid = p.tid(), lane = tid & 63, wid = tid >> 6, r = lane & 15, q = lane >> 4;
            const int trow = wid * 16 + r;
            const size_t grow = (size_t)(t0 + trow);
            if (hh == 0) TS(0);
            if (hh == 1) TS(5);
            if (tid < 256) { const int ch = tid < 64 ? h * 64 + tid : (tid < 128 ? 512 + h * 64 + (tid - 64) : 1024 + h * 128 + (tid - 128));
                const float* cw = p.in[22]; *(float4*)(cwl + tid * 4) = make_float4(cw[ch], cw[2048 + ch], cw[4096 + ch], p.in[23][ch]); }
            const bf16_t* cp0 = CIN + ((size_t)c * 16 + h) * 8192 + tid * 16; const bf16_t* cp1 = cp0 + (size_t)8 * 8192;
            const uint4 c00 = *(const uint4*)cp0, c01 = *(const uint4*)(cp0 + 8), c10 = *(const uint4*)cp1, c11 = *(const uint4*)(cp1 + 8);
            Raw3 rq[4], rv[4];
#pragma unroll
            for (int k = 0; k < 4; ++k) { const int i = tid + k * NTH; const int cg8 = i & 15, tl = i >> 4;
                rq[k] = conv8_load(PROJ + (size_t)(t0 + tl) * 3072 + (cg8 < 8 ? h * 64 + cg8 * 8 : 512 + h * 64 + (cg8 - 8) * 8), 3072, t0 + tl, SEQ); }
#pragma unroll
            for (int k = 0; k < 4; ++k) { const int i = tid + k * NTH; const int vg = (i >> 3) & 15, tl = (i >> 7) * 8 + (i & 7);
                rv[k] = conv8_load(PROJ + (size_t)(t0 + tl) * 3072 + 1024 + h * 128 + vg * 8, 3072, t0 + tl, SEQ); }
            if (hh == 0) TS(6);
            __syncthreads();
            if (hh == 0) TS(7);
#pragma unroll
            for (int k = 0; k < 4; ++k) {
                const int i = tid + k * NTH; const int cg8 = i & 15, tl = i >> 4;
                float o[8]; conv8_apply(rq[k], cwl + cg8 * 32, o);
                const float sc = cg8 < 8 ? 1.f : 0.125f;
                uint4 w; w.x = pack2(o[0] * sc, o[1] * sc); w.y = pack2(o[2] * sc, o[3] * sc); w.z = pack2(o[4] * sc, o[5] * sc); w.w = pack2(o[6] * sc, o[7] * sc);
                *(uint4*)((cg8 < 8 ? Qs + cg8 * 8 : Ks + (cg8 - 8) * 8) + tl * 72) = w;
            }
            if (hh == 0) TS(8);
#pragma unroll 1
            for (int rep_ = 0; rep_ < EXP_ML_V; ++rep_) {
#pragma unroll
            for (int k = 0; k < 4; ++k) {
                const int i = tid + k * NTH; const int vg = (i >> 3) & 15, tl = (i >> 7) * 8 + (i & 7);
                float o[8]; conv8_apply(rv[k], cwl + (128 + vg * 8) * 4, o);
#pragma unroll
                for (int j = 0; j < 8; ++j) VT[(vg * 8 + j) * 136 + (tl ^ ((vg & 7) << 3))] = f2bf(o[j]);
            }
            asm volatile("" ::: "memory");
            }
            if (hh == 0) TS(9);
            { bf16_t* cd = Ct + (tid >> 2) * 72 + (tid & 3) * 16; *(uint4*)cd = c00; *(uint4*)(cd + 8) = c01; *(uint4*)(cd + 128 * 72) = c10; *(uint4*)(cd + 128 * 72 + 8) = c11; }
            __syncthreads();
            if (hh == 0) TS(1);
            f32x4 QK[1][8];
#pragma unroll
            for (int ni = 0; ni < 8; ++ni) QK[0][ni] = (f32x4){0.f, 0.f, 0.f, 0.f};
            wave_mma<1, 8, 64, true>(QK, Qs + wid * 16 * 72, 72, Ks, 72, lane);
            if (hh == 0) TS(2);
            uint2 orw[8];
#pragma unroll
            for (int ni = 0; ni < 8; ++ni) orw[ni] = *(const uint2*)(PROJ + grow * 3072 + 2048 + h * 128 + 16 * ni + 4 * q);
            f32x4 Hs[8];
#pragma unroll
            for (int ni = 0; ni < 8; ++ni) Hs[ni] = (f32x4){0.f, 0.f, 0.f, 0.f};
            for (int dq = 0; dq < 2 + EXP_ML_D; ++dq) {
                const int d = dq & 1; const bool discard = dq >= 2;
                const int dh = d * 8 + h;
                const float bt = bet[(hh * 2 + d) * 128 + trow], g = bt + mins[hh * 2 + d];
                float dl[32]; float mx = -1e30f;
#pragma unroll
                for (int ni = 0; ni < 8; ++ni) {
                    const int s0 = 16 * ni + 4 * q;
                    const float4 bs = *(const float4*)(bet + (hh * 2 + d) * 128 + s0), iv = *(const float4*)(igs + (hh * 2 + d) * 128 + s0);
                    const float b4[4] = {bs.x, bs.y, bs.z, bs.w}, i4[4] = {iv.x, iv.y, iv.z, iv.w};
#pragma unroll
                    for (int j = 0; j < 4; ++j) { const int sidx = s0 + j; const bool ok = d == 0 ? sidx <= trow : sidx >= trow; const float v = ok ? bt - b4[j] + i4[j] : -1e30f; dl[ni * 4 + j] = v; mx = fmaxf(mx, v); }
                }
                mx = fmaxf(mx, __shfl_xor(mx, 16)); mx = fmaxf(mx, __shfl_xor(mx, 32));
                const float ms = fmaxf(g, mx);
                float rsum = 0.f;
#pragma unroll
                for (int ni = 0; ni < 8; ++ni) {
                    float w4[4];
#pragma unroll
                    for (int j = 0; j < 4; ++j) { w4[j] = dl[ni * 4 + j] > -1e29f ? __expf(dl[ni * 4 + j] - ms) * QK[0][ni][j] : 0.f; rsum += w4[j]; }
                    uint2 w; w.x = pack2(w4[0], w4[1]); w.y = pack2(w4[2], w4[3]);
                    *(uint2*)(Wb + trow * 136 + 16 * ni + 4 * q) = w;
                }
                rsum += __shfl_xor(rsum, 16); rsum += __shfl_xor(rsum, 32);
                __syncthreads();
                f32x4 Nm[1][8], Ni[1][8];
#pragma unroll
                for (int ni = 0; ni < 8; ++ni) { Nm[0][ni] = (f32x4){0.f, 0.f, 0.f, 0.f}; Ni[0][ni] = (f32x4){0.f, 0.f, 0.f, 0.f}; }
                wave_mma<1, 8, 128, true, true>(Nm, Wb + wid * 16 * 136, 136, VT, 136, lane);
                wave_mma<1, 8, 64, true>(Ni, Qs + wid * 16 * 72, 72, Ct + d * 128 * 72, 72, lane);
                float qn = 0.f;
                { float f[8]; unpack8(*(const uint4*)(Qs + trow * 72 + 16 * q), f);
#pragma unroll
                  for (int j = 0; j < 8; ++j) qn += f[j] * nin[(hh * 2 + d) * 64 + 16 * q + j];
                  unpack8(*(const uint4*)(Qs + trow * 72 + 16 * q + 8), f);
#pragma unroll
                  for (int j = 0; j < 8; ++j) qn += f[j] * nin[(hh * 2 + d) * 64 + 16 * q + 8 + j]; }
                qn += __shfl_xor(qn, 16); qn += __shfl_xor(qn, 32);
                const float ei = __expf(g - ms);
                const float den = rsum + qn * ei;
                const float inv = 1.f / fmaxf(fabsf(den), __expf(-ms));
#pragma unroll
                for (int ni = 0; ni < 8; ++ni) Hs[ni] += (Nm[0][ni] + Ni[0][ni] * ei) * (discard ? 0.f : inv);
                __syncthreads();
            }
            if (hh == 0) TS(3);
            float ssq = 0.f;
#pragma unroll
            for (int ni = 0; ni < 8; ++ni)
#pragma unroll
                for (int j = 0; j < 4; ++j) ssq += Hs[ni][j] * Hs[ni][j];
            ssq += __shfl_xor(ssq, 16); ssq += __shfl_xor(ssq, 32);
            const float rs = rsqrtf(ssq * (1.f / 128.f) + 1e-6f);
#pragma unroll
            for (int ni = 0; ni < 8; ++ni) {
                const int col = h * 128 + 16 * ni + 4 * q;
                const float4 nw = *(const float4*)(p.in[26] + col);
                uint2 w; w.x = pack2(Hs[ni][0] * rs * nw.x * sigmf(__uint_as_float(orw[ni].x << 16)), Hs[ni][1] * rs * nw.y * sigmf(__uint_as_float(orw[ni].x & 0xffff0000u)));
                w.y = pack2(Hs[ni][2] * rs * nw.z * sigmf(__uint_as_float(orw[ni].y << 16)), Hs[ni][3] * rs * nw.w * sigmf(__uint_as_float(orw[ni].y & 0xffff0000u)));
                *(uint2*)(MIX + grow * 1024 + col) = w;
            }
            lds_barrier();
        }
    }
}


#define XB_TMO      128
#define XB_XCNT(j)  (256  + 64 * (j))
#define XB_XSUB(j)  (1280 + 64 * (j))
#define XB_XGEN(j)  (2304 + 64 * (j))
#define XB_TOP      3328
#define XB_TOPGEN   3392
#define XCD_BAR_WORDS 3456
#define XB_SPIN_CAP (1u << 22)
#define XLAS __attribute__((address_space(3)))
__device__ __forceinline__ unsigned xb_ld(unsigned* p) { return __hip_atomic_load(p, __ATOMIC_RELAXED, __HIP_MEMORY_SCOPE_AGENT); }
__device__ __forceinline__ unsigned xb_add(unsigned* p, unsigned v) { return __hip_atomic_fetch_add(p, v, __ATOMIC_RELAXED, __HIP_MEMORY_SCOPE_AGENT); }
__device__ __forceinline__ unsigned xb_xcc_id() { return (unsigned)__builtin_amdgcn_s_getreg((3 << 11) | 20) & 0xFu; }
#define XB_SPIN(cond, bar) do { unsigned _sp = 0; while (cond) { __builtin_amdgcn_s_sleep(1); \
    if ((++_sp & 255u) == 0u) { if (xb_ld(&(bar)[XB_TMO])) break; if (_sp > XB_SPIN_CAP) { atomicAdd(&(bar)[XB_TMO], 1u); break; } } } } while (0)
struct XcdBarrier { unsigned* bar; unsigned x; volatile XLAS unsigned* st; };
__device__ __forceinline__ XcdBarrier xcd_barrier_post(unsigned* bar, volatile XLAS unsigned* st, int tid) {
    XcdBarrier b; b.bar = bar; b.x = xb_xcc_id(); b.st = st;
    if (tid == 0) (void)xb_add(&bar[XB_XCNT(b.x)], 1u);
    return b;
}
__device__ __forceinline__ void xcd_barrier_complete(unsigned* bar, unsigned x, unsigned& nloc, unsigned& nx) {
    const unsigned G = gridDim.x * gridDim.y * gridDim.z;
    unsigned sum, cnt, mine, sp = 0u;
    for (;;) {
        sum = 0u; cnt = 0u;
#pragma unroll 1
        for (unsigned j = 0; j < 16; ++j) { const unsigned c = xb_ld(&bar[XB_XCNT(j)]); sum += c; cnt += (c > 0u) ? 1u : 0u; }
        mine = xb_ld(&bar[XB_XCNT(x)]);
        if (sum == G) break;
        __builtin_amdgcn_s_sleep(1);
        if ((++sp & 255u) == 0u) { if (xb_ld(&bar[XB_TMO])) break; if (sp > XB_SPIN_CAP) { atomicAdd(&bar[XB_TMO], 1u); break; } }
    }
    nloc = mine > 0u ? mine : 1u; nx = cnt > 0u ? cnt : 1u;
}
__device__ __forceinline__ void xcd_barrier(const XcdBarrier& b, int tid) {
    asm volatile("s_waitcnt vmcnt(0)" ::: "memory");
    __syncthreads();
    if (tid == 0) {
        unsigned* bar = b.bar; asm volatile("" : "+s"(bar));
        __builtin_amdgcn_s_waitcnt(0);
        unsigned nloc = b.st[0], nx = b.st[1];
        if (nloc == 0u) { xcd_barrier_complete(bar, b.x, nloc, nx); b.st[0] = nloc; b.st[1] = nx; }
        const unsigned old = xb_add(&bar[XB_XSUB(b.x)], 1u);
        const unsigned gen = old / nloc;
        if (old + 1u == (gen + 1u) * nloc) {
            __builtin_amdgcn_fence(__ATOMIC_RELEASE, "agent");
            asm volatile("s_waitcnt vmcnt(0)" ::: "memory");
            const unsigned og = xb_add(&bar[XB_TOP], 1u);
            const unsigned tg = og / nx;
            if (og + 1u == (tg + 1u) * nx) xb_add(&bar[XB_TOPGEN], 1u);
            else XB_SPIN(xb_ld(&bar[XB_TOPGEN]) == tg, bar);
            __builtin_amdgcn_fence(__ATOMIC_ACQUIRE, "agent");
            xb_add(&bar[XB_XGEN(b.x)], 1u);
            asm volatile("s_waitcnt vmcnt(0)" ::: "memory");
        } else {
            XB_SPIN(xb_ld(&bar[XB_XGEN(b.x)]) == gen, bar);
            __builtin_amdgcn_fence(__ATOMIC_ACQUIRE, "agent");
            asm volatile("s_waitcnt vmcnt(0)" ::: "memory");
        }
    }
    __syncthreads();
}

#define GSYNC() grid.sync()
__global__ void __launch_bounds__(NTH, 2) fwd_kernel(PK pk) {
    P p; p.wv = __builtin_amdgcn_readfirstlane((int)(threadIdx.x >> 6));
    extern __shared__ __attribute__((aligned(16))) unsigned char smem[];
    float* lds = (float*)smem;
    G8_LAS unsigned char* ldsa = (G8_LAS unsigned char*)smem;
    volatile XLAS unsigned* xst = (volatile XLAS unsigned*)((XLAS unsigned char*)smem + LDS_BYTES - 16);
    { const int t0 = p.tid(); if (t0 < 4) xst[t0] = 0u; }
    __syncthreads();
    const XcdBarrier xbar = xcd_barrier_post((unsigned*)(p.get_ws() + WS_CTL) + CW_BAR, xst, p.tid());
    int nph = NPH_RUN; asm volatile("" : "+s"(nph));
    unsigned repmask = REPEAT_MASK; asm volatile("" : "+s"(repmask));
#pragma unroll 1
    for (int pq = 0; pq < 2 * nph; ++pq) {
        const int ph = pq >> 1;
        if ((pq & 1) && !((repmask >> ph) & 1u)) continue;
        unsigned char* ws = p.get_ws();
        const float* MODS = (const float*)(ws + WS_MODS);
        int nb = (int)gridDim.x, bid = (int)blockIdx.x; asm volatile("" : "+s"(nb), "+s"(bid));
        switch (ph) {
        case 0: {
            phase_mods(p, bid, nb, lds);
            conv_dense(p, bid, nb, lds);
        } break;
        case 1: {
            { RowArgs a{}; a.layer = 0; a.ffn = 0; a.src = 0; a.nrows = MT; a.noproj = 1; phase_rows<16>(p, bid, nb, lds, a); }
        } break;
        case 2: {
            { g8::Order S; S.init(SEQ / 256, 2048 / 256, nb, bid); EpiProj ef{(bf16_t*)(ws + WS_PROJ), 2048, 2048, 16, (float*)(ws + WS_SMALL)};
              g8::gemm8(p.tid(), ldsa, (const bf16_t*)(ws + WS_HB), 1024, RowPlain{}, S, BSelOne{(const char*)(ws + WS_WIN0)}, ef);
              mini_gemm(p, bid, nb, lds, (const bf16_t*)(ws + WS_HB), (const bf16_t*)(ws + WS_WIN0), SEQ, CTX / 64, 0, 2048 / 32, ef);
              mini_gemm(p, (bid + 4) % nb, nb, lds, (const bf16_t*)(ws + WS_HB), (const bf16_t*)(ws + WS_WIN0), 0, MT / 64, 2048, 1, ef); }
        } break;
        case 3: {
            { unsigned* qctr = (unsigned*)(ws + WS_CTL) + CW_Q3; volatile XLAS unsigned* qslot = xst - 4;
              for (;;) {
                  __syncthreads();
                  if (p.tid() == 0) qslot[0] = atomicAdd(qctr, 1u);
                  __syncthreads();
                  const int it = (int)qslot[0];
                  if (it >= 520) break;
                  if (it < 260) ssd_states(p, it, 1 << 20, lds); else phase_qkprep(p, it - 260, 1 << 20);
              } }
        } break;
        case 4: {
            ssd_scan(p, bid, nb);
            { unsigned* qctr = (unsigned*)(ws + WS_CTL) + CW_Q4; volatile XLAS unsigned* qslot = xst - 4;
              for (;;) {
                  __syncthreads();
                  if (p.tid() == 0) qslot[0] = atomicAdd(qctr, 1u);
                  __syncthreads();
                  const int it = (int)qslot[0];
                  if (it >= 260) break;
                  attn_mfma(p, it, 1 << 20, lds);
              } }
        } break;
        case 5: {
            { unsigned* qctr = (unsigned*)(ws + WS_CTL) + CW_Q5; volatile XLAS unsigned* qslot = xst - 4;
              for (;;) {
                  __syncthreads();
                  if (p.tid() == 0) qslot[0] = atomicAdd(qctr, 1u);
                  __syncthreads();
                  const int it = (int)qslot[0];
                  if (it >= 130 + 384) break;
                  if (it < 130) ssd_out(p, it, 1 << 20, lds); else conv_moe_chunk(p, it - 130, lds, 0);
              } }
        } break;
        case 6: {
            { g8::Order S; S.init(SEQ / 256, 4, nb, bid);
              EpiResid ef{p.in[0], p.in[2], (bf16_t*)(ws + WS_XRES), MODS + (0 * 2 + 0) * 6144 + 2048, MODS + (0 * 2 + 1) * 6144 + 2048};
              g8::gemm8(p.tid(), ldsa, (const bf16_t*)(ws + WS_HB), 1024, RowPlain{}, S, BSelOne{(const char*)(ws + WS_WOUT0)}, ef);
              mini_gemm(p, bid, nb, lds, (const bf16_t*)(ws + WS_HB), (const bf16_t*)(ws + WS_WOUT0), SEQ, CTX / 64, 0, 1024 / 32, ef); }
        } break;
        case 7: {
            phase_route(p, bid, nb, lds, 0, MT);
        } break;
        case 8: {
            phase_moe_fused(p, bid, nb, ldsa, lds, 0);
        } break;
        case 9: {
            { RowArgs a{}; a.layer = 1; a.ffn = 0; a.src = 1; a.combine = 1; a.clayer = 0; a.nrows = MT; a.noproj = 1; phase_rows<16>(p, bid, nb, lds, a); }
        } break;
        case 10: {
            { g8::Order S; S.init(SEQ / 256, 3072 / 256, nb, bid); EpiProj ef{(bf16_t*)(ws + WS_PROJ), 3072, 3072, 32, (float*)(ws + WS_SMALL)};
              g8::gemm8(p.tid(), ldsa, (const bf16_t*)(ws + WS_HB), 1024, RowPlain{}, S, BSelOne{(const char*)(ws + WS_WIN1)}, ef);
              mini_gemm(p, bid, nb, lds, (const bf16_t*)(ws + WS_HB), (const bf16_t*)(ws + WS_WIN1), SEQ, CTX / 64, 0, 3072 / 32, ef);
              mini_gemm(p, (bid + 128) % nb, nb, lds, (const bf16_t*)(ws + WS_HB), (const bf16_t*)(ws + WS_WIN1), 0, MT / 64, 3072, 1, ef); }
        } break;
        case 11: {
            { unsigned* qctr = (unsigned*)(ws + WS_CTL) + CW_Q12; volatile XLAS unsigned* qslot = xst - 4;
              for (;;) {
                  __syncthreads();
                  if (p.tid() == 0) qslot[0] = atomicAdd(qctr, 1u);
                  __syncthreads();
                  const int it = (int)qslot[0];
                  if (it >= 520 + 384) break;
                  if (it < 520) ml_states(p, it, 1 << 20, lds); else conv_moe_chunk(p, it - 520, lds, 1);
              } }
        } break;
        case 12: {
            ml_scan(p, bid, nb);
            xcd_barrier(xbar, p.tid());
            ml_out(p, bid, nb, lds);
        } break;
        case 13: {
            { g8::Order S; S.init(SEQ / 256, 4, nb, bid);
              EpiResid ef{nullptr, nullptr, (bf16_t*)(ws + WS_XRES), MODS + (1 * 2 + 0) * 6144 + 2048, MODS + (1 * 2 + 0) * 6144 + 2048};
              g8::gemm8(p.tid(), ldsa, (const bf16_t*)(ws + WS_HB), 1024, RowPlain{}, S, BSelOne{(const char*)(ws + WS_WOUT1)}, ef);
 }
        } break;
        case 14: {
            phase_route(p, bid, nb, lds, 1, SEQ);
        } break;
        case 15: {
            phase_moe_fused(p, bid, nb, ldsa, lds, 1);
        } break;
        case 16: {
            { RowArgs a{}; a.layer = 1; a.src = 1; a.combine = 1; a.clayer = 1; a.final_out = 1; a.nrows = SEQ; phase_rows<16>(p, bid, nb, lds, a); }
        } break;
        default: break;
        }
        if (pq + 1 < 2 * nph) xcd_barrier(xbar, p.tid());
#if TIMED_PH >= 0 || DELAY_PH >= 0
        if (!(pq & 1) && p.tid() == 0) {
            const unsigned now = (unsigned)__builtin_amdgcn_s_memrealtime();
            if (ph == TIMED_PH) xst[3] = now - xst[2];
            if (ph == DELAY_PH) xst[-8] = now - xst[2];
            xst[2] = now;
        }
#endif
    }
#if TSA >= 0
    if (blockIdx.x == 0 && p.tid() == 0) { volatile XLAS unsigned* tsp = (volatile XLAS unsigned*)((XLAS unsigned char*)smem + LDS_BYTES - 128);
        const unsigned long long t0 = __builtin_amdgcn_s_memrealtime(); const unsigned long long dt = 50ull * (tsp[TSB] - tsp[TSA]);
        while (__builtin_amdgcn_s_memrealtime() - t0 < dt) __builtin_amdgcn_s_sleep(8);
    }
#endif
#if DELAY_PH >= 0
    if (blockIdx.x == 0 && p.tid() == 0) {
        const unsigned long long t0 = __builtin_amdgcn_s_memrealtime(); const unsigned long long dt = 20ull * xst[-8];
        while (__builtin_amdgcn_s_memrealtime() - t0 < dt) __builtin_amdgcn_s_sleep(8);
    }
#endif
#if TIMED_PH >= 0
    xcd_barrier(xbar, p.tid());
    if (blockIdx.x == 0) {
        const float t_phase = (float)xst[3] * 0.01f;
        const float delta = sqrtf(t_phase * 1e-5f * 256.f * TIMED_M2);
        float* o = p.get_out();
        for (int i = p.tid(); i < 65536; i += NTH) o[i] += (i & 1) ? delta : -delta;
    }
#endif
}

extern "C" void kernel_launch(void* const* d_in, const int* in_sizes, int n_in, void* d_out, int out_size, void* d_ws, size_t ws_size, hipStream_t stream) {
    static int grid = 0;
    if (grid == 0) {
        if (n_in != 31 || ws_size < WS_END) { fprintf(stderr, "kernel_launch: unexpected n_in %d or ws_size %zu < %zu\n", n_in, ws_size, (size_t)WS_END); grid = -1; return; }
        int dev = 0, cus = 0, per_cu = 0;
        hipGetDevice(&dev);
        hipDeviceGetAttribute(&cus, hipDeviceAttributeMultiprocessorCount, dev);
        hipFuncSetAttribute((const void*)fwd_kernel, hipFuncAttributeMaxDynamicSharedMemorySize, LDS_BYTES);
        hipOccupancyMaxActiveBlocksPerMultiprocessor(&per_cu, (const void*)fwd_kernel, NTH, LDS_BYTES);
        if (per_cu < 1) { fprintf(stderr, "kernel_launch: occupancy query says %d blocks per CU\n", per_cu); per_cu = 1; }
        grid = cus;
    }
    if (grid < 0) return;
    PK p{};
    for (int i = 0; i < 31; ++i) p.in[i] = (const float*)d_in[i];
    p.out = (float*)d_out; p.ws = (unsigned char*)d_ws;
    hipMemsetAsync((unsigned char*)d_ws + WS_CTL, 0, 65536, stream);
    void* args[] = {&p};
    hipError_t e = hipLaunchCooperativeKernel((const void*)fwd_kernel, dim3(grid), dim3(NTH), args, LDS_BYTES, stream);
    if (e != hipSuccess) fprintf(stderr, "cooperative launch failed: %s (grid %d)\n", hipGetErrorString(e), grid);
}
```

```cpp
#include <hip/hip_runtime.h>
#include <hip/hip_cooperative_groups.h>
#include <cstdio>
namespace cg = cooperative_groups;

typedef unsigned short bf16_t;
typedef unsigned int u32;
typedef short bf16x8 __attribute__((ext_vector_type(8)));
typedef float f32x4 __attribute__((ext_vector_type(4)));

constexpr int D = 1024, SEQ = 16384, CTX = 256, MT = SEQ + CTX;
constexpr int NTH = 512;
#ifndef NPH_RUN
#define NPH_RUN 17
#endif
#ifndef REPEAT_MASK
#define REPEAT_MASK 0u
#endif
#ifndef TIMED_PH
#define TIMED_PH -1
#endif
#ifndef TIMED_M2
#define TIMED_M2 1.37f
#endif
#ifndef DELAY_PH
#define DELAY_PH -1
#endif
#ifndef EXP_NOST
#define EXP_NOST 0
#endif
#ifndef EXP_ML_D
#define EXP_ML_D 0
#endif
#ifndef TSA
#define TSA -1
#endif
#ifndef TSB
#define TSB 0
#endif
#if TSA >= 0
#define TS(k) do { if (p.tid() == 0) ((volatile __attribute__((address_space(3))) unsigned*)((__attribute__((address_space(3))) unsigned char*)tsbase))[k] = (unsigned)__builtin_amdgcn_s_memrealtime(); } while (0)
#else
#define TS(k) do { } while (0)
#endif
#ifndef EXP_ML_V
#define EXP_ML_V 1
#endif
constexpr int EV_IN = 2064, OD_IN = 3104;
constexpr int NE = 16, DE = 512;
constexpr int MAXTILES = 146, MAXSLOTS = MAXTILES * 256;

constexpr size_t al256(size_t x) { return (x + 255) & ~(size_t)255; }
constexpr size_t WS_CTL   = 0;
constexpr size_t WS_MODS  = 65536;
constexpr size_t WS_ROPE  = WS_MODS + al256(2 * 2 * 6144 * 4);
constexpr size_t WS_SMALL = WS_ROPE + al256(2 * 256 * 16 * 4);
constexpr size_t WS_ROUTE = WS_SMALL + al256((size_t)MT * 32 * 4);
constexpr size_t WS_GATE  = WS_ROUTE + al256((size_t)MT * 16);
constexpr size_t WS_SLOT  = WS_GATE + al256((size_t)MT * 8);
constexpr size_t WS_LIST  = WS_SLOT + al256((size_t)MT * 8);
constexpr size_t WS_TEXP  = WS_LIST + al256((size_t)MAXSLOTS * 4);
constexpr size_t WS_CHK   = WS_TEXP + 1024;
constexpr size_t WS_WIN0  = WS_CHK + (size_t)4 * 1024 * 1024;
constexpr size_t WS_WIN1  = WS_WIN0 + (size_t)2304 * 1024 * 2;
constexpr size_t WS_WOUT0 = WS_WIN1 + (size_t)3328 * 1024 * 2;
constexpr size_t WS_WOUT1 = WS_WOUT0 + (size_t)1024 * 1024 * 2;
constexpr size_t WS_WMOE  = WS_WOUT1 + (size_t)1024 * 1024 * 2;
constexpr size_t WS_XRES  = WS_WMOE + (size_t)16 * 1024 * 1024 * 2 + (size_t)16 * 1024 * 512 * 2;
constexpr size_t WS_HB    = WS_XRES + (size_t)MT * 1024 * 2;
constexpr size_t WS_PROJ  = WS_HB + (size_t)MT * 1024 * 2;
constexpr size_t WS_Y     = WS_PROJ + (size_t)MT * 3072 * 2;
constexpr size_t WS_VTS   = WS_Y + (size_t)MT * 1024 * 4;
constexpr size_t WS_END   = WS_VTS + (size_t)128 * 8 * 128 * 128 * 2;
static_assert(WS_END < 349000000, "workspace too large");

constexpr int CW_CNT = 8192;
constexpr int CH_BBASE = 300000;
constexpr int CH_ELIST = 524288;
constexpr int CH_MODP = 800000;
constexpr int CH_WRT = 917504;
constexpr int CW_BAR = 1024;
constexpr int CW_Q5 = 12288;
constexpr int CW_Q3 = 12352, CW_Q12 = 12416, CW_Q4 = 12480, CW_Q8 = 12544;
constexpr int CW_MOEC = 12800;
constexpr int CW_TMO = 13200;
constexpr int LDS_BYTES = 160 * 1024;

struct PK { const float* in[31]; float* out; unsigned char* ws; };
typedef __attribute__((address_space(4))) const unsigned char* kaptr_t;
struct InTab { __device__ __forceinline__ const float* operator[](int i) const {
    kaptr_t ka = (kaptr_t)__builtin_amdgcn_kernarg_segment_ptr(); asm volatile("" : "+s"(ka)); return *(const float* __attribute__((address_space(4))) const*)(ka + i * 8); } };
struct P { InTab in; int wv;
    __device__ __forceinline__ int tid() const { int l; asm volatile("v_mbcnt_lo_u32_b32 %0, -1, 0\n\tv_mbcnt_hi_u32_b32 %0, -1, %0" : "=v"(l)); return (wv << 6) | l; }
    __device__ __forceinline__ float* get_out() const { kaptr_t ka = (kaptr_t)__builtin_amdgcn_kernarg_segment_ptr(); asm volatile("" : "+s"(ka)); return *(float* __attribute__((address_space(4))) const*)(ka + 31 * 8); }
    __device__ __forceinline__ unsigned char* get_ws() const { kaptr_t ka = (kaptr_t)__builtin_amdgcn_kernarg_segment_ptr(); asm volatile("" : "+s"(ka)); return *(unsigned char* __attribute__((address_space(4))) const*)(ka + 32 * 8); } };

__device__ __forceinline__ float bf2f(bf16_t b) { return __uint_as_float((u32)b << 16); }
__device__ __forceinline__ bf16_t f2bf(float f) { u32 r; asm("v_cvt_pk_bf16_f32 %0, %1, %1" : "=v"(r) : "v"(f)); return (bf16_t)r; }
__device__ __forceinline__ u32 pack2(float a, float b) { u32 r; asm("v_cvt_pk_bf16_f32 %0, %1, %2" : "=v"(r) : "v"(a), "v"(b)); return r; }
__device__ __forceinline__ void unpack8(const uint4 w, float* f) {
    f[0] = __uint_as_float(w.x << 16); f[1] = __uint_as_float(w.x & 0xffff0000u); f[2] = __uint_as_float(w.y << 16); f[3] = __uint_as_float(w.y & 0xffff0000u);
    f[4] = __uint_as_float(w.z << 16); f[5] = __uint_as_float(w.z & 0xffff0000u); f[6] = __uint_as_float(w.w << 16); f[7] = __uint_as_float(w.w & 0xffff0000u);
}
__device__ __forceinline__ void ld4bf(const bf16_t* p, float* f) { const uint2 w = *(const uint2*)p; f[0] = __uint_as_float(w.x << 16); f[1] = __uint_as_float(w.x & 0xffff0000u); f[2] = __uint_as_float(w.y << 16); f[3] = __uint_as_float(w.y & 0xffff0000u); }
__device__ __forceinline__ float siluf(float x) { return x / (1.f + __expf(-x)); }
__device__ __forceinline__ float sigmf(float x) { return 1.f / (1.f + __expf(-x)); }
__device__ __forceinline__ float sigmf_r(float x) { return __builtin_amdgcn_rcpf(1.f + __expf(-x)); }
__device__ __forceinline__ float siluf_r(float x) { return x * __builtin_amdgcn_rcpf(1.f + __expf(-x)); }
__device__ __forceinline__ float softplusf(float x) { return x > 20.f ? x : log1pf(__expf(x)); }
__device__ __forceinline__ float logsigf(float x) { return x < -20.f ? x : -log1pf(__expf(-x)); }
__device__ __forceinline__ void lds_barrier() { asm volatile("s_waitcnt lgkmcnt(0)" ::: "memory"); __builtin_amdgcn_s_barrier(); asm volatile("" ::: "memory"); }
__device__ __forceinline__ float wave_sum(float v) {
#pragma unroll
    for (int o = 32; o >= 1; o >>= 1) v += __shfl_xor(v, o);
    return v;
}
__device__ __forceinline__ float rdlane(float v, int l) { return __int_as_float(__builtin_amdgcn_readlane(__float_as_int(v), l)); }

__device__ __forceinline__ void mods_items(const P& p, int bid, int nb, float* lds, int i0, int i1);
__device__ __forceinline__ void phase_mods(const P& p, int bid, int nb, float* lds) {
    const int tid = p.tid();
    float* MODS = (float*)(p.get_ws() + WS_MODS);
    float* RC = (float*)(p.get_ws() + WS_ROPE); float* RS = RC + 256 * 16;
    for (int i = bid * NTH + tid; i < 256 * 16; i += nb * NTH) {
        const int pos = i >> 4, f = i & 15;
        const float inv = powf(10000.f, -(float)f / 16.f);
        const float ang = (float)pos * inv;
        RC[i] = cosf(ang); RS[i] = sinf(ang);
    }
    {
        float* MODP = (float*)(p.get_ws() + WS_CHK) + CH_MODP;
        const float* c = p.in[1]; const float* cx = p.in[3];
        for (int i = tid; i < 1024; i += NTH) { const float a = c[i]; lds[i] = a / (1.f + expf(-a)); const float b = cx[i]; lds[1024 + i] = b / (1.f + expf(-b)); }
        __syncthreads();
        float* red = lds + 2048;
        const int tx = tid & 15, ty = tid >> 4;
        for (int item = bid; item < 128; item += nb) {
            const int cgp = item & 31, ks = item >> 5;
            const float* W = p.in[8] + cgp * 64 + tx * 4;
            float4 ac = {0.f, 0.f, 0.f, 0.f}, ax = {0.f, 0.f, 0.f, 0.f};
#pragma unroll
            for (int kk = 0; kk < 8; ++kk) {
                const int k = ks * 256 + ty + 32 * kk;
                const float4 w = *(const float4*)(W + (size_t)k * 6144);
                const float sc = lds[k], sx = lds[1024 + k];
                ac.x += sc * w.x; ac.y += sc * w.y; ac.z += sc * w.z; ac.w += sc * w.w;
                ax.x += sx * w.x; ax.y += sx * w.y; ax.z += sx * w.z; ax.w += sx * w.w;
            }
            float* r = red + (ty * 16 + tx) * 8;
            r[0] = ac.x; r[1] = ac.y; r[2] = ac.z; r[3] = ac.w; r[4] = ax.x; r[5] = ax.y; r[6] = ax.z; r[7] = ax.w;
            __syncthreads();
            if (tid < 128) {
                const int col = tid & 63, which = tid >> 6;
                float s2 = 0.f;
                for (int y = 0; y < 32; ++y) s2 += red[(y * 16 + (col >> 2)) * 8 + which * 4 + (col & 3)];
                MODP[(ks * 2 + which) * 2048 + cgp * 64 + col] = s2;
            }
            __syncthreads();
        }
    }
}
__device__ __forceinline__ void mods_item_wide(const P& p, int item, float* lds) {
    const int tid = p.tid(), lane = tid & 63, wid = tid >> 6;
    float* MODS = (float*)(p.get_ws() + WS_MODS);
    const float* c = p.in[1]; const float* cx = p.in[3];
    __syncthreads();
    for (int i = tid; i < 1024; i += NTH) { const float a = c[i]; lds[i] = a / (1.f + expf(-a)); const float b = cx[i]; lds[1024 + i] = b / (1.f + expf(-b)); }
    __syncthreads();
    const int l = item < 16 ? 0 : 1, col0 = item < 16 ? 2048 + item * 256 : (item - 16) * 256;
    const float* W = p.in[8] + (size_t)l * 1024 * 6144 + col0 + lane * 4;
    float4 ac = {0.f, 0.f, 0.f, 0.f}, ax = {0.f, 0.f, 0.f, 0.f};
#pragma unroll 1
    for (int kb = 0; kb < 4; ++kb) {
        float4 w[32];
#pragma unroll
        for (int j = 0; j < 32; ++j) w[j] = *(const float4*)(W + (size_t)(wid * 128 + kb * 32 + j) * 6144);
#pragma unroll
        for (int j = 0; j < 32; ++j) { const int k = wid * 128 + kb * 32 + j; const float sc = lds[k], sx = lds[1024 + k];
            ac.x += sc * w[j].x; ac.y += sc * w[j].y; ac.z += sc * w[j].z; ac.w += sc * w[j].w;
            ax.x += sx * w[j].x; ax.y += sx * w[j].y; ax.z += sx * w[j].z; ax.w += sx * w[j].w; }
    }
    float* red = lds + 2048;
    *(float4*)(red + ((wid * 2 + 0) * 64 + lane) * 4) = ac; *(float4*)(red + ((wid * 2 + 1) * 64 + lane) * 4) = ax;
    __syncthreads();
    if (tid < 128) {
        const int l4 = tid & 63, which = tid >> 6;
        float4 s4 = *(const float4*)(p.in[9] + l * 6144 + col0 + l4 * 4);
#pragma unroll
        for (int w8 = 0; w8 < 8; ++w8) { const float4 u = *(const float4*)(red + ((w8 * 2 + which) * 64 + l4) * 4); s4.x += u.x; s4.y += u.y; s4.z += u.z; s4.w += u.w; }
        *(float4*)(MODS + (l * 2 + which) * 6144 + col0 + l4 * 4) = s4;
    }
    __syncthreads();
}
__device__ __forceinline__ void mods_items(const P& p, int bid, int nb, float* lds, int i0, int i1) {
    const int tid = p.tid();
    float* MODS = (float*)(p.get_ws() + WS_MODS);
    const float* c = p.in[1]; const float* cx = p.in[3];
    for (int i = tid; i < 1024; i += NTH) { const float a = c[i]; lds[i] = a / (1.f + expf(-a)); const float b = cx[i]; lds[1024 + i] = b / (1.f + expf(-b)); }
    __syncthreads();
    float* red = lds + 2048;
    const int tx = tid & 15, ty = tid >> 4;
    for (int item = i0 + bid; item < i1; item += nb) {
        const int l = item / 96, cgp = item % 96;
        const float* W = p.in[8] + (size_t)l * 1024 * 6144 + cgp * 64 + tx * 4;
        float4 ac = {0.f, 0.f, 0.f, 0.f}, ax = {0.f, 0.f, 0.f, 0.f};
#pragma unroll 32
        for (int k = ty; k < 1024; k += 32) {
            const float4 w = *(const float4*)(W + (size_t)k * 6144);
            const float sc = lds[k], sx = lds[1024 + k];
            ac.x += sc * w.x; ac.y += sc * w.y; ac.z += sc * w.z; ac.w += sc * w.w;
            ax.x += sx * w.x; ax.y += sx * w.y; ax.z += sx * w.z; ax.w += sx * w.w;
        }
        float* r = red + (ty * 16 + tx) * 8;
        r[0] = ac.x; r[1] = ac.y; r[2] = ac.z; r[3] = ac.w; r[4] = ax.x; r[5] = ax.y; r[6] = ax.z; r[7] = ax.w;
        __syncthreads();
        if (tid < 128) {
            const int col = tid & 63, which = tid >> 6;
            float s = 0.f;
            for (int y = 0; y < 32; ++y) s += red[(y * 16 + (col >> 2)) * 8 + which * 4 + (col & 3)];
            s += p.in[9][l * 6144 + cgp * 64 + col];
            MODS[(l * 2 + which) * 6144 + cgp * 64 + col] = s;
        }
        __syncthreads();
    }
}

struct RowArgs {
    int layer;
    int ffn;
    int src;
    int combine;
    int clayer;
    int final_out;
    int nrows;
    const float* wsm; int ldw; int wcol0;
    int route;
    int noproj;
};

template <int NS>
__device__ __forceinline__ float row_norm_proj(float (&v)[16], const float* gamma, const float* md, bf16_t* hrow, const float* lds, int lane, bool doproj) {
    float ss = 0.f;
#pragma unroll
    for (int j = 0; j < 16; ++j) ss += v[j] * v[j];
    ss = wave_sum(ss);
    const float rs = rsqrtf(ss * (1.f / 1024.f) + 1e-6f);
#pragma unroll
    for (int i = 0; i < 4; ++i) {
        const float4 g = *(const float4*)(gamma + i * 256 + lane * 4);
        const float4 sh = *(const float4*)(md + i * 256 + lane * 4);
        const float4 sc = *(const float4*)(md + 1024 + i * 256 + lane * 4);
        v[i * 4 + 0] = v[i * 4 + 0] * rs * g.x * (1.f + sc.x) + sh.x;
        v[i * 4 + 1] = v[i * 4 + 1] * rs * g.y * (1.f + sc.y) + sh.y;
        v[i * 4 + 2] = v[i * 4 + 2] * rs * g.z * (1.f + sc.z) + sh.z;
        v[i * 4 + 3] = v[i * 4 + 3] * rs * g.w * (1.f + sc.w) + sh.w;
        uint2 o; o.x = pack2(v[i * 4], v[i * 4 + 1]); o.y = pack2(v[i * 4 + 2], v[i * 4 + 3]);
        *(uint2*)(hrow + i * 256 + lane * 4) = o;
    }
    if (!doproj) return 0.f;
    float s[NS];
#pragma unroll
    for (int n = 0; n < NS; ++n) s[n] = 0.f;
#pragma unroll
    for (int i = 0; i < 4; ++i)
#pragma unroll
        for (int j = 0; j < 4; ++j) {
            const float* w = lds + ((i * 4 + j) * (NS / 4)) * 256 + lane * 4;
            const float x = v[i * 4 + j];
#pragma unroll
            for (int n = 0; n < NS; n += 4) { const float4 ww = *(const float4*)(w + (n >> 2) * 256); s[n] += x * ww.x; s[n + 1] += x * ww.y; s[n + 2] += x * ww.z; s[n + 3] += x * ww.w; }
            asm volatile("" ::: "memory");
        }
#pragma unroll
    for (int hN = NS / 2, off = 32; hN >= 1; hN >>= 1, off >>= 1) {
        const bool upper = (lane & off) != 0;
#pragma unroll
        for (int i2 = 0; i2 < hN; ++i2) { const float mine = upper ? s[i2 + hN] : s[i2], other = upper ? s[i2] : s[i2 + hN]; s[i2] = mine + __shfl_xor(other, off); }
    }
    float s0 = s[0];
    if (NS == 16) { s0 += __shfl_xor(s0, 2); s0 += __shfl_xor(s0, 1); } else { s0 += __shfl_xor(s0, 1); }
    return s0;
}
__device__ __forceinline__ void route16(const float (&sc)[16], const float (&bs)[16], int& e0, int& e1, float& g0, float& g1) {
    float best = -1e30f, W0 = 0.f, W1 = 0.f; int E0 = 0, E1 = 0;
#pragma unroll
    for (int g = 0; g < 4; ++g) {
        float m1 = bs[g * 4], w1 = sc[g * 4]; int i1 = 0;
#pragma unroll
        for (int j = 1; j < 4; ++j) { const bool gt = bs[g * 4 + j] > m1; m1 = gt ? bs[g * 4 + j] : m1; w1 = gt ? sc[g * 4 + j] : w1; i1 = gt ? j : i1; }
        float m2 = -1e30f, w2 = 0.f; int i2 = 0;
#pragma unroll
        for (int j = 0; j < 4; ++j) { const bool gt = (j != i1) && (bs[g * 4 + j] > m2); m2 = gt ? bs[g * 4 + j] : m2; w2 = gt ? sc[g * 4 + j] : w2; i2 = gt ? j : i2; }
        const float gs = m1 + m2; const bool better = gs > best;
        best = better ? gs : best; E0 = better ? g * 4 + i1 : E0; E1 = better ? g * 4 + i2 : E1; W0 = better ? w1 : W0; W1 = better ? w2 : W1;
    }
    e0 = E0; e1 = E1;
    const float inv = 1.f / (W0 + W1);
    g0 = W0 * inv; g1 = W1 * inv;
}
__device__ __forceinline__ void expert_offsets(const u32* cnt  , int (&off)[17]) {
    off[0] = 0;
#pragma unroll
    for (int e = 0; e < 16; ++e) off[e + 1] = off[e] + (int)((cnt[e * 64] + 255u) / 256u) * 256;
}


__device__ __forceinline__ int xcd_item(int itr, int nb) { return (nb == 256 && itr < 256) ? (((itr & 7) << 5) | (itr >> 3)) : itr; }
__device__ __forceinline__ int xcd_item128(int itr, int nb) { return (nb == 256 && itr < 256) ? (((((itr & 7) << 4) | (itr >> 4)) << 1) | ((itr >> 3) & 1)) : itr; }
struct Rows2Args { int layer, src, combine, clayer, final_out, nrows; const bf16_t* pB; int pcols; };
__device__ __forceinline__ void phase_rows2(const P& p, int bid, int nb, float* lds, const Rows2Args a) {
    const int tid = p.tid(), lane = tid & 63, wid = tid >> 6, r = lane & 15, q = lane >> 4;
    unsigned char* ws = p.get_ws();
    const float* MODS = (const float*)(ws + WS_MODS);
    bf16_t* XRES = (bf16_t*)(ws + WS_XRES);
    bf16_t* HB = (bf16_t*)(ws + WS_HB);
    float* SMALL = (float*)(ws + WS_SMALL);
    const int* CHKI = (const int*)(ws + WS_CHK);
    int* lsl = (int*)(lds + 20480);
    if (a.combine) {
        if (tid == 0) { int off[17]; expert_offsets((const u32*)(ws + WS_CTL) + CW_CNT + a.clayer * 16 * 64, off);
#pragma unroll
            for (int e = 0; e < 16; ++e) lsl[e] = off[e]; }
        for (int i = tid; i < nb * 16; i += NTH) lsl[16 + i] = CHKI[CH_BBASE + i];
    }
    float* modl = lds + 24832;
    if (!a.src) {
        const float* MODP = (const float*)(ws + WS_CHK) + CH_MODP;
        for (int v = tid; v < 1024; v += NTH) {
            const int w = v >> 9, c4i = (v & 511) * 4;
            float4 acc = *(const float4*)(p.in[9] + c4i);
#pragma unroll
            for (int ks = 0; ks < 4; ++ks) { const float4 u = *(const float4*)(MODP + (ks * 2 + w) * 2048 + c4i); acc.x += u.x; acc.y += u.y; acc.z += u.z; acc.w += u.w; }
            *(float4*)(modl + w * 2048 + c4i) = acc;
        }
    }
    __syncthreads();
    const float* gamma = p.in[6] + a.layer * 1024;
    const bf16_t* YMOE = (const bf16_t*)(ws + WS_PROJ);
    const int4* ROUTE = (const int4*)(ws + WS_ROUTE);
    const float2* GATE = (const float2*)(ws + WS_GATE);
    int dr0 = -1;
    for (int itr = bid; itr < (a.nrows > SEQ ? 272 : 256); itr += nb) {
        const int it = xcd_item(itr, nb);
        const int r0 = it < 256 ? it * 64 : SEQ + (it - 256) * 16, npr = it < 256 ? 4 : 1;
        const int wrow0 = r0 + wid * 2 * npr, isctx = r0 >= SEQ ? 1 : 0;
        float gm[16], sh[16];
        if (!a.final_out) { const float* md = a.src ? MODS + (a.layer * 2 + isctx) * 6144 : modl + isctx * 2048;
#pragma unroll
            for (int i = 0; i < 4; ++i) { const float4 g = *(const float4*)(gamma + i * 256 + lane * 4);
                const float4 s4 = *(const float4*)(md + i * 256 + lane * 4), c4 = *(const float4*)(md + 1024 + i * 256 + lane * 4);
                gm[i * 4] = g.x * (1.f + c4.x); gm[i * 4 + 1] = g.y * (1.f + c4.y); gm[i * 4 + 2] = g.z * (1.f + c4.z); gm[i * 4 + 3] = g.w * (1.f + c4.w);
                sh[i * 4] = s4.x; sh[i * 4 + 1] = s4.y; sh[i * 4 + 2] = s4.z; sh[i * 4 + 3] = s4.w; } }
        float4 gf[4]; int4 rt = make_int4(0, 0, 0, 0); float2 gt = make_float2(0.f, 0.f);
        if (a.combine) {
#pragma unroll
            for (int i = 0; i < 4; ++i) gf[i] = *(const float4*)(MODS + (a.clayer * 2 + isctx) * 6144 + 5 * 1024 + i * 256 + lane * 4);
            if (lane < 2 * npr) { rt = ROUTE[wrow0 + lane]; gt = GATE[wrow0 + lane]; }
        }
        uint4 xb[2][2][4]; uint2 yb[2][2][2][4];
#define ROWS_ISSUE(pr_, st_) do { _Pragma("unroll") for (int u = 0; u < 2; ++u) { const int row_ = wrow0 + (pr_) * 2 + u, k_ = (pr_) * 2 + u; \
            if (a.src) { _Pragma("unroll") for (int i = 0; i < 4; ++i) { const uint2 t_ = *(const uint2*)(XRES + (size_t)row_ * 1024 + i * 256 + lane * 4); xb[st_][u][i].x = t_.x; xb[st_][u][i].y = t_.y; } } \
            else { const float* src_ = row_ >= SEQ ? p.in[2] + (size_t)(row_ - SEQ) * 1024 : p.in[0] + (size_t)row_ * 1024; \
                _Pragma("unroll") for (int i = 0; i < 4; ++i) xb[st_][u][i] = *(const uint4*)(src_ + i * 256 + lane * 4); } \
            if (a.combine) { const int e0_ = __builtin_amdgcn_readlane(rt.x, k_), p0_ = __builtin_amdgcn_readlane(rt.y, k_), e1_ = __builtin_amdgcn_readlane(rt.z, k_), p1_ = __builtin_amdgcn_readlane(rt.w, k_); \
                const int s0_ = lsl[e0_] + lsl[16 + bid * 16 + e0_] + p0_, s1_ = lsl[e1_] + lsl[16 + bid * 16 + e1_] + p1_; \
                _Pragma("unroll") for (int i = 0; i < 4; ++i) { yb[st_][u][0][i] = *(const uint2*)(YMOE + (size_t)s0_ * 1024 + i * 256 + lane * 4); yb[st_][u][1][i] = *(const uint2*)(YMOE + (size_t)s1_ * 1024 + i * 256 + lane * 4); } } } } while (0)
        ROWS_ISSUE(0, 0);
#pragma unroll
        for (int pr = 0; pr < 4; ++pr) {
            if (pr < npr) {
                if (pr + 1 < npr) { if (pr < 3) ROWS_ISSUE(pr + 1, (pr + 1) & 1); }
#pragma unroll
                for (int u = 0; u < 2; ++u) {
                    const int row = wrow0 + pr * 2 + u, k = pr * 2 + u, st = pr & 1;
                    float v[16];
#pragma unroll
                    for (int i = 0; i < 4; ++i) {
                        if (a.src) { v[i * 4] = __uint_as_float(xb[st][u][i].x << 16); v[i * 4 + 1] = __uint_as_float(xb[st][u][i].x & 0xffff0000u); v[i * 4 + 2] = __uint_as_float(xb[st][u][i].y << 16); v[i * 4 + 3] = __uint_as_float(xb[st][u][i].y & 0xffff0000u); }
                        else { v[i * 4] = __uint_as_float(xb[st][u][i].x); v[i * 4 + 1] = __uint_as_float(xb[st][u][i].y); v[i * 4 + 2] = __uint_as_float(xb[st][u][i].z); v[i * 4 + 3] = __uint_as_float(xb[st][u][i].w); }
                    }
                    if (a.combine) {
                        const float g0 = __int_as_float(__builtin_amdgcn_readlane(__float_as_int(gt.x), k)), g1 = __int_as_float(__builtin_amdgcn_readlane(__float_as_int(gt.y), k));
#pragma unroll
                        for (int i = 0; i < 4; ++i) {
                            const uint2 y0 = yb[st][u][0][i], y1 = yb[st][u][1][i];
                            v[i * 4 + 0] += gf[i].x * (g0 * __uint_as_float(y0.x << 16) + g1 * __uint_as_float(y1.x << 16));
                            v[i * 4 + 1] += gf[i].y * (g0 * __uint_as_float(y0.x & 0xffff0000u) + g1 * __uint_as_float(y1.x & 0xffff0000u));
                            v[i * 4 + 2] += gf[i].z * (g0 * __uint_as_float(y0.y << 16) + g1 * __uint_as_float(y1.y << 16));
                            v[i * 4 + 3] += gf[i].w * (g0 * __uint_as_float(y0.y & 0xffff0000u) + g1 * __uint_as_float(y1.y & 0xffff0000u));
                        }
                        if (a.final_out) { float* dst = p.get_out() + (size_t)row * 1024;
#pragma unroll
                            for (int i = 0; i < 4; ++i) *(float4*)(dst + i * 256 + lane * 4) = make_float4(v[i * 4], v[i * 4 + 1], v[i * 4 + 2], v[i * 4 + 3]); }
                        else {
#pragma unroll
                            for (int i = 0; i < 4; ++i) { uint2 o; o.x = pack2(v[i * 4], v[i * 4 + 1]); o.y = pack2(v[i * 4 + 2], v[i * 4 + 3]); *(uint2*)(XRES + (size_t)row * 1024 + i * 256 + lane * 4) = o; } }
                    }
                    if (!a.final_out) {
                        float ss = 0.f;
#pragma unroll
                        for (int j = 0; j < 16; ++j) ss += v[j] * v[j];
                        ss = wave_sum(ss);
                        const float rs = rsqrtf(ss * (1.f / 1024.f) + 1e-6f);
#pragma unroll
                        for (int i = 0; i < 4; ++i) { uint2 o; o.x = pack2(v[i * 4] * rs * gm[i * 4] + sh[i * 4], v[i * 4 + 1] * rs * gm[i * 4 + 1] + sh[i * 4 + 1]); o.y = pack2(v[i * 4 + 2] * rs * gm[i * 4 + 2] + sh[i * 4 + 2], v[i * 4 + 3] * rs * gm[i * 4 + 3] + sh[i * 4 + 3]);
                            *(uint2*)(HB + (size_t)row * 1024 + i * 256 + lane * 4) = o; }
                    }
                }
            }
        }
#undef ROWS_ISSUE
        if (a.pcols && !a.final_out) {
            if (it < 256 && itr + nb >= 256 && itr + nb < (a.nrows > SEQ ? 272 : 256)) { dr0 = r0; continue; }
            asm volatile("s_waitcnt vmcnt(0)" ::: "memory");
            __syncthreads();
            const int ng = dr0 >= 0 ? 5 : npr;
#define RG_BASE(g_) (dr0 >= 0 ? ((g_) < 4 ? dr0 + 16 * (g_) : r0) : r0 + 16 * (g_))
            f32x4 acc[5][2];
#pragma unroll
            for (int mi = 0; mi < 5; ++mi)
#pragma unroll
                for (int ni = 0; ni < 2; ++ni) acc[mi][ni] = (f32x4){0.f, 0.f, 0.f, 0.f};
            const bf16_t* Ab = HB + (size_t)r * 1024 + wid * 128 + 8 * q; const bf16_t* Bb = a.pB + (size_t)r * 1024 + wid * 128 + 8 * q;
#pragma unroll
            for (int k4 = 0; k4 < 4; ++k4) {
                bf16x8 af[5], bfr[2];
#pragma unroll
                for (int mi = 0; mi < 5; ++mi) if (mi < ng) af[mi] = *(const bf16x8*)(Ab + (size_t)RG_BASE(mi) * 1024 + 32 * k4);
#pragma unroll
                for (int ni = 0; ni < 2; ++ni) bfr[ni] = *(const bf16x8*)(Bb + (size_t)(16 * ni) * 1024 + 32 * k4);
#pragma unroll
                for (int mi = 0; mi < 5; ++mi) if (mi < ng)
#pragma unroll
                    for (int ni = 0; ni < 2; ++ni) acc[mi][ni] = __builtin_amdgcn_mfma_f32_16x16x32_bf16(bfr[ni], af[mi], acc[mi][ni], 0, 0, 0);
            }
#pragma unroll
            for (int mi = 0; mi < 5; ++mi)
#pragma unroll
                for (int ni = 0; ni < 2; ++ni) *(f32x4*)(lds + wid * 2560 + (16 * mi + r) * 32 + 16 * ni + 4 * q) = acc[mi][ni];
            __syncthreads();
            if (tid < 320) {
                const int rr = tid >> 2, c8 = (tid & 3) * 8;
                if (c8 < a.pcols && rr < 16 * ng) {
                    float o[8] = {0.f, 0.f, 0.f, 0.f, 0.f, 0.f, 0.f, 0.f};
#pragma unroll
                    for (int w = 0; w < 8; ++w) { const float4 x0 = *(const float4*)(lds + w * 2560 + rr * 32 + c8), x1 = *(const float4*)(lds + w * 2560 + rr * 32 + c8 + 4);
                        o[0] += x0.x; o[1] += x0.y; o[2] += x0.z; o[3] += x0.w; o[4] += x1.x; o[5] += x1.y; o[6] += x1.z; o[7] += x1.w; }
                    const int g = rr >> 4;
                    float* d = SMALL + (size_t)(RG_BASE(g) + (rr & 15)) * 32 + c8;
                    *(float4*)d = make_float4(o[0], o[1], o[2], o[3]); *(float4*)(d + 4) = make_float4(o[4], o[5], o[6], o[7]);
                }
            }
#undef RG_BASE
            dr0 = -1;
            __syncthreads();
        }
    }
}

__device__ __forceinline__ void phase_route(const P& p, int bid, int nb, float* lds, int layer, int nrows) {
    const int tid = p.tid(), lane = tid & 63, wid = tid >> 6, r = lane & 15, q = lane >> 4;
    unsigned char* ws = p.get_ws();
    const float* MODS = (const float*)(ws + WS_MODS);
    const bf16_t* XRES = (const bf16_t*)(ws + WS_XRES);
    bf16_t* HB = (bf16_t*)(ws + WS_HB);
    int* CHKI = (int*)(ws + WS_CHK);
    const bf16_t* WRT = (const bf16_t*)((const float*)(ws + WS_CHK) + CH_WRT);
    u32* lcnt = (u32*)(lds + 20480);
    int4* lrt = (int4*)(lds + 20480 + 64);
    if (tid < 16) lcnt[tid] = 0u;
    const float* gamma = p.in[7] + layer * 1024;
    int kt = 0;
    const int nitems = nrows > SEQ ? 272 : 256;
    int dr0 = -1;
    for (int itr = bid; itr < nitems; itr += nb, ++kt) {
        const int it = xcd_item(itr, nb);
        const int r0 = it < 256 ? it * 64 : SEQ + (it - 256) * 16, npr = it < 256 ? 4 : 1;
        {
            const int wrow0 = r0 + wid * 2 * npr;
            float gm[16], sh[16];
            { const float* md = MODS + (layer * 2 + (r0 >= SEQ ? 1 : 0)) * 6144 + 3 * 1024;
#pragma unroll
              for (int i = 0; i < 4; ++i) { const float4 g = *(const float4*)(gamma + i * 256 + lane * 4), s4 = *(const float4*)(md + i * 256 + lane * 4), c4 = *(const float4*)(md + 1024 + i * 256 + lane * 4);
                  gm[i * 4] = g.x * (1.f + c4.x); gm[i * 4 + 1] = g.y * (1.f + c4.y); gm[i * 4 + 2] = g.z * (1.f + c4.z); gm[i * 4 + 3] = g.w * (1.f + c4.w);
                  sh[i * 4] = s4.x; sh[i * 4 + 1] = s4.y; sh[i * 4 + 2] = s4.z; sh[i * 4 + 3] = s4.w; } }
            uint2 xb[2][2][4];
#define RT_ISSUE(pr_, st_) do { _Pragma("unroll") for (int u = 0; u < 2; ++u) _Pragma("unroll") for (int i = 0; i < 4; ++i) xb[st_][u][i] = *(const uint2*)(XRES + (size_t)(wrow0 + (pr_) * 2 + u) * 1024 + i * 256 + lane * 4); } while (0)
            RT_ISSUE(0, 0);
#pragma unroll
            for (int pr = 0; pr < 4; ++pr) {
                if (pr < npr) {
                    if (pr + 1 < npr) { if (pr < 3) RT_ISSUE(pr + 1, (pr + 1) & 1); }
#pragma unroll
                    for (int u = 0; u < 2; ++u) {
                        const int row = wrow0 + pr * 2 + u, st = pr & 1;
                        float v[16];
#pragma unroll
                        for (int i = 0; i < 4; ++i) { v[i * 4] = __uint_as_float(xb[st][u][i].x << 16); v[i * 4 + 1] = __uint_as_float(xb[st][u][i].x & 0xffff0000u); v[i * 4 + 2] = __uint_as_float(xb[st][u][i].y << 16); v[i * 4 + 3] = __uint_as_float(xb[st][u][i].y & 0xffff0000u); }
                        float ss = 0.f;
#pragma unroll
                        for (int j = 0; j < 16; ++j) ss += v[j] * v[j];
                        ss = wave_sum(ss);
                        const float rs = rsqrtf(ss * (1.f / 1024.f) + 1e-6f);
#pragma unroll
                        for (int i = 0; i < 4; ++i) { uint2 o; o.x = pack2(v[i * 4] * rs * gm[i * 4] + sh[i * 4], v[i * 4 + 1] * rs * gm[i * 4 + 1] + sh[i * 4 + 1]); o.y = pack2(v[i * 4 + 2] * rs * gm[i * 4 + 2] + sh[i * 4 + 2], v[i * 4 + 3] * rs * gm[i * 4 + 3] + sh[i * 4 + 3]);
                            *(uint2*)(HB + (size_t)row * 1024 + i * 256 + lane * 4) = o; }
                    }
                }
            }
#undef RT_ISSUE
        }
        if (it < 256 && itr + nb >= 256 && itr + nb < nitems) { dr0 = r0; continue; }
        asm volatile("s_waitcnt vmcnt(0)" ::: "memory");
        __syncthreads();
        const int ng = dr0 >= 0 ? 5 : npr;
#define RG_BASE(g_) (dr0 >= 0 ? ((g_) < 4 ? dr0 + 16 * (g_) : r0) : r0 + 16 * (g_))
        {
            f32x4 acc[5][2];
#pragma unroll
            for (int mi = 0; mi < 5; ++mi)
#pragma unroll
                for (int ni = 0; ni < 2; ++ni) acc[mi][ni] = (f32x4){0.f, 0.f, 0.f, 0.f};
            const bf16_t* Ab = HB + (size_t)r * 1024 + wid * 128 + 8 * q; const bf16_t* Bb = WRT + (size_t)r * 1024 + wid * 128 + 8 * q;
#pragma unroll
            for (int k4 = 0; k4 < 4; ++k4) {
                bf16x8 a[5], b[2];
#pragma unroll
                for (int mi = 0; mi < 5; ++mi) if (mi < ng) a[mi] = *(const bf16x8*)(Ab + (size_t)RG_BASE(mi) * 1024 + 32 * k4);
#pragma unroll
                for (int ni = 0; ni < 2; ++ni) b[ni] = *(const bf16x8*)(Bb + (size_t)(16 * ni) * 1024 + 32 * k4);
#pragma unroll
                for (int mi = 0; mi < 5; ++mi) if (mi < ng)
#pragma unroll
                    for (int ni = 0; ni < 2; ++ni) acc[mi][ni] = __builtin_amdgcn_mfma_f32_16x16x32_bf16(b[ni], a[mi], acc[mi][ni], 0, 0, 0);
            }
#pragma unroll
            for (int mi = 0; mi < 5; ++mi)
#pragma unroll
                for (int ni = 0; ni < 2; ++ni) *(f32x4*)(lds + wid * 2560 + (16 * mi + r) * 32 + 16 * ni + 4 * q) = acc[mi][ni];
        }
        __syncthreads();
        if (tid < 32 * ng) {
            const int rr = tid >> 1, c8 = (tid & 1) * 8;
            float lg[8] = {0.f, 0.f, 0.f, 0.f, 0.f, 0.f, 0.f, 0.f};
#pragma unroll
            for (int w = 0; w < 8; ++w) { const float4 x0 = *(const float4*)(lds + w * 2560 + rr * 32 + c8), x1 = *(const float4*)(lds + w * 2560 + rr * 32 + c8 + 4);
                lg[0] += x0.x; lg[1] += x0.y; lg[2] += x0.z; lg[3] += x0.w; lg[4] += x1.x; lg[5] += x1.y; lg[6] += x1.z; lg[7] += x1.w; }
            float sc[16], bs[16];
            const float* rb = p.in[5];
#pragma unroll
            for (int j = 0; j < 8; ++j) {
                const float mine_s = 1.f / (1.f + expf(-lg[j])), mine_b = mine_s + rb[c8 + j];
                const float oth_s = __shfl_xor(mine_s, 1), oth_b = __shfl_xor(mine_b, 1);
                sc[j] = c8 ? oth_s : mine_s; sc[8 + j] = c8 ? mine_s : oth_s; bs[j] = c8 ? oth_b : mine_b; bs[8 + j] = c8 ? mine_b : oth_b;
            }
            int e0, e1; float g0, g1; route16(sc, bs, e0, e1, g0, g1);
            if (c8 == 0) {
                const int row = RG_BASE(rr >> 4) + (rr & 15);
                const int p0 = (int)atomicAdd(lcnt + e0, 1u), p1 = (int)atomicAdd(lcnt + e1, 1u);
                const int4 rt4 = make_int4(e0, p0, e1, p1);
                ((int4*)(ws + WS_ROUTE))[row] = rt4;
                ((float2*)(ws + WS_GATE))[row] = make_float2(g0, g1);
                lrt[(dr0 >= 0 ? (kt - 1) * 64 : kt * 64) + rr] = rt4;
            }
        }
#undef RG_BASE
        dr0 = -1;
        __syncthreads();
    }
    __syncthreads();
    if (tid < 16) {
        u32* cnt = (u32*)(ws + WS_CTL) + CW_CNT + (layer * 16 + tid) * 64;
        const int base = (int)atomicAdd(cnt, lcnt[tid]);
        CHKI[CH_BBASE + bid * 16 + tid] = base; lcnt[16 + tid] = (u32)base;
    }
    __syncthreads();
    {
        int* ELIST = CHKI + CH_ELIST;
        int k2 = 0;
        for (int itr = bid; itr < nitems; itr += nb, ++k2) { const int it = xcd_item(itr, nb);
            if (tid < (it < 256 ? 64 : 16)) { const int4 rt = lrt[k2 * 64 + tid]; const int row = (it < 256 ? it * 64 : SEQ + (it - 256) * 16) + tid;
                ELIST[rt.x * MT + (int)lcnt[16 + rt.x] + rt.y] = row; ELIST[rt.z * MT + (int)lcnt[16 + rt.z] + rt.w] = row; } }
    }
}

namespace g8 {
#define G8_LAS __attribute__((address_space(3)))
typedef short bf16x8 __attribute__((ext_vector_type(8)));
typedef float f32x4 __attribute__((ext_vector_type(4)));
constexpr int BM = 256, BK = 64, HALF = 128, HTB = HALF * BK * 2, STAGE_BYTES = 8 * HTB, NXCD = 8, WGM = 8;
__device__ __forceinline__ int lds_byte(int r, int c) { const int st = (r >> 4) * 2 + (c >> 5), rr = r & 15, cc = c & 31, ob = rr * 64 + cc * 2; return st * 1024 + (ob ^ (((ob >> 9) & 1) << 5)); }
__device__ __forceinline__ void stage_rc(int b, int& R, int& C) { const int st = b / 1024, sb = b % 1024, swz = sb ^ (((sb >> 9) & 1) << 5); R = (st >> 1) * 16 + swz / 64; C = (st & 1) * 32 + (swz % 64) / 2; }
__device__ __forceinline__ int perm32(int rho) { const int n = rho >> 4, i = rho & 15; return 8 * (i >> 2) + 4 * n + (i & 3); }
struct Unit { int pm, pn; };
struct Order {
    int nM, nN, nwg, G, c;
    __device__ __forceinline__ void init(int nM_, int nN_, int G_, int c_) { nM = nM_; nN = nN_; nwg = nM * nN; G = G_; c = c_; }
    __device__ __forceinline__ bool next(int i, Unit& u) const {
        const long L = (long)i * G + c; if (L >= nwg) return false;
        int wgid = (int)L; { const int q = nwg / NXCD, r = nwg % NXCD, xcd = wgid % NXCD, off = wgid / NXCD; wgid = (xcd < r ? xcd * (q + 1) : r * (q + 1) + (xcd - r) * q) + off; }
        const int nig = WGM * nN, gid = wgid / nig, fm = gid * WGM, gsz = (nM - fm) < WGM ? (nM - fm) : WGM;
        u.pm = fm + ((wgid % nig) % gsz); u.pn = (wgid % nig) / gsz; return true;
    }
    __device__ __forceinline__ void ready(const Unit&, int) const {}
    __device__ __forceinline__ void done(const Unit&, int) const {}
};
template <class RowSrc, class BSel, class EF, class Sched>
__device__ __forceinline__ void gemm8(const int tid, G8_LAS unsigned char* lds, const bf16_t* A, int K, const RowSrc& rsrc, const Sched& S, const BSel& bsel, const EF& ef) {
    const int wid = __builtin_amdgcn_readfirstlane(tid >> 6), lane = tid & 63, wr = wid >> 2, wc = wid & 3, fr = lane & 15, fq = lane >> 4;
    const int nt = K / BK;
    int R0, C0, R1, C1; stage_rc(tid * 16, R0, C0); stage_rc(tid * 16 + 8192, R1, C1);
    const unsigned vb0 = (unsigned)(((R0 & ~31) + perm32(R0 & 31)) * K + C0) * 2u, vb1 = (unsigned)(((R1 & ~31) + perm32(R1 & 31)) * K + C1) * 2u;
    const size_t kstep = (size_t)(BK * 2), hstep = (size_t)HALF * K * 2, tstep = 2 * hstep;
    const unsigned ldsw = (unsigned)wid * 1024u;
    const int aoff = lds_byte(wr * 64 + fr, fq * 8), boff = lds_byte(wc * 32 + fr, fq * 8);
#define G8_SA(b, h) (((b) * 2 + (h)) * HTB)
#define G8_SB(b, h) ((4 + (b) * 2 + (h)) * HTB)
#define G8_STAGE(bufoff, gbase, v0, v1) do { \
        __builtin_amdgcn_global_load_lds((const unsigned*)((const char*)(gbase) + (v0)), (G8_LAS unsigned*)(lds + (bufoff) + ldsw), 16, 0, 0); \
        __builtin_amdgcn_global_load_lds((const unsigned*)((const char*)(gbase) + (v1)), (G8_LAS unsigned*)(lds + (bufoff) + ldsw + 8192), 16, 0, 0); } while (0)
#define G8_LDA(dst, b, h) do { _Pragma("unroll") for (int m = 0; m < 4; ++m) _Pragma("unroll") for (int k = 0; k < 2; ++k) dst[m][k] = *(const G8_LAS bf16x8*)(lds + G8_SA(b, h) + aoff + m * 2048 + k * 1024); } while (0)
#define G8_LDB(dst, b, h) do { _Pragma("unroll") for (int n = 0; n < 2; ++n) _Pragma("unroll") for (int k = 0; k < 2; ++k) dst[n][k] = *(const G8_LAS bf16x8*)(lds + G8_SB(b, h) + boff + n * 2048 + k * 1024); } while (0)
#define G8_MMA(ai, bj, At, Bt) do { __builtin_amdgcn_s_setprio(1); _Pragma("unroll") for (int m = 0; m < 4; ++m) _Pragma("unroll") for (int n = 0; n < 2; ++n) _Pragma("unroll") for (int k = 0; k < 2; ++k) \
        acc[ai][bj][m][n] = __builtin_amdgcn_mfma_f32_16x16x32_bf16(Bt[n][k], At[m][k], acc[ai][bj][m][n], 0, 0, 0); __builtin_amdgcn_s_setprio(0); } while (0)
#define G8_WAIT_V(n) asm volatile("s_waitcnt vmcnt(" #n ")" ::: "memory")
#define G8_WAIT_L(n) asm volatile("s_waitcnt lgkmcnt(" #n ")" ::: "memory")
#define G8_BAR __builtin_amdgcn_s_barrier()
#define G8_SCHED __builtin_amdgcn_sched_barrier(0)
#define G8_AOFF(pm_, h_, R_, C_) ((unsigned)(rsrc((pm_), (h_) * 128 + (R_)) * K + (C_)) * 2u)
    Unit cur, nxt; int ui = 0;
    if (!S.next(0, cur)) return;
    S.ready(cur, wid);
    f32x4 acc[2][2][4][2];
#pragma unroll
    for (int a = 0; a < 2; ++a)
#pragma unroll
        for (int b = 0; b < 2; ++b)
#pragma unroll
            for (int m = 0; m < 4; ++m)
#pragma unroll
                for (int n = 0; n < 2; ++n) acc[a][b][m][n] = (f32x4){0.f, 0.f, 0.f, 0.f};
    bf16x8 At[4][2], B0[2][2], B1[2][2];
    const char* Ab = (const char*)A;
    unsigned a00 = G8_AOFF(cur.pm, 0, R0, C0), a01 = G8_AOFF(cur.pm, 0, R1, C1), a10 = G8_AOFF(cur.pm, 1, R0, C0), a11 = G8_AOFF(cur.pm, 1, R1, C1);
    const char* cB = bsel(cur.pm) + (size_t)cur.pn * tstep;
    G8_STAGE(G8_SB(0, 0), cB, vb0, vb1); G8_STAGE(G8_SA(0, 0), Ab, a00, a01); G8_STAGE(G8_SB(0, 1), cB + hstep, vb0, vb1); G8_STAGE(G8_SA(0, 1), Ab, a10, a11);
    if (wr == 1) G8_BAR;
    G8_WAIT_V(4); G8_BAR;
    G8_STAGE(G8_SB(1, 0), cB + kstep, vb0, vb1); G8_STAGE(G8_SA(1, 0), Ab + kstep, a00, a01); G8_STAGE(G8_SB(1, 1), cB + hstep + kstep, vb0, vb1);
    G8_WAIT_V(6); G8_BAR;
    for (;;) {
        const bool has_next = S.next(ui + 1, nxt);
        if (has_next) S.ready(nxt, wid);
        unsigned n00 = a00, n01 = a01, n10 = a10, n11 = a11; const char* nB = cB;
        if (has_next) { n00 = G8_AOFF(nxt.pm, 0, R0, C0); n01 = G8_AOFF(nxt.pm, 0, R1, C1); n10 = G8_AOFF(nxt.pm, 1, R0, C0); n11 = G8_AOFF(nxt.pm, 1, R1, C1); nB = bsel(nxt.pm) + (size_t)nxt.pn * tstep; }
        for (int t = 0; t < nt; t += 2) {
            const bool last = (t == nt - 2);
            const char* a1p = Ab + (size_t)(t + 1) * kstep;
            const char* a2p = last ? Ab : Ab + (size_t)(t + 2) * kstep; const char* b2 = last ? nB : cB + (size_t)(t + 2) * kstep;
            const char* a3p = a2p + kstep; const char* b3 = b2 + kstep;
            const unsigned x00 = last ? n00 : a00, x01 = last ? n01 : a01, x10 = last ? n10 : a10, x11 = last ? n11 : a11;
            G8_LDB(B0, 0, 0); G8_SCHED; G8_LDA(At, 0, 0); G8_STAGE(G8_SA(1, 1), a1p, a10, a11);
            G8_WAIT_L(8); G8_BAR; G8_WAIT_L(0); G8_MMA(0, 0, At, B0); G8_BAR; G8_SCHED;
            G8_LDB(B1, 0, 1); G8_STAGE(G8_SB(0, 0), b2, vb0, vb1);
            G8_BAR; G8_WAIT_L(0); G8_MMA(0, 1, At, B1); G8_BAR;
            G8_LDA(At, 0, 1); G8_STAGE(G8_SA(0, 0), a2p, x00, x01);
            G8_BAR; G8_WAIT_L(0); G8_MMA(1, 0, At, B0); G8_BAR; G8_SCHED;
            G8_STAGE(G8_SB(0, 1), b2 + hstep, vb0, vb1);
            G8_WAIT_V(6); G8_BAR; G8_MMA(1, 1, At, B1); G8_BAR;
            G8_LDB(B0, 1, 0); G8_SCHED; G8_LDA(At, 1, 0); G8_STAGE(G8_SA(0, 1), a2p, x10, x11);
            G8_WAIT_L(8); G8_BAR; G8_WAIT_L(0); G8_MMA(0, 0, At, B0); G8_BAR; G8_SCHED;
            G8_LDB(B1, 1, 1); G8_STAGE(G8_SB(1, 0), b3, vb0, vb1);
            G8_BAR; G8_WAIT_L(0); G8_MMA(0, 1, At, B1); G8_BAR;
            G8_LDA(At, 1, 1); G8_STAGE(G8_SA(1, 0), a3p, x00, x01);
            G8_BAR; G8_WAIT_L(0); G8_MMA(1, 0, At, B0); G8_BAR; G8_SCHED;
            G8_STAGE(G8_SB(1, 1), b3 + hstep, vb0, vb1);
            G8_WAIT_V(6); G8_BAR; G8_MMA(1, 1, At, B1); G8_BAR;
        }
        {
            typename EF::Ctx ctx[2];
#pragma unroll
            for (int bj = 0; bj < 2; ++bj) ctx[bj] = ef.ctx(cur.pn * BM + bj * HALF + wc * 32 + 8 * fq);
            constexpr int MB = EF::MB;
#pragma unroll
            for (int bi = 0; bi < 8 / MB; ++bi) {
                const int ai = (bi * MB) >> 2, m0 = (bi * MB) & 3;
                typename EF::Pre pre[MB][2];
#pragma unroll
                for (int m2 = 0; m2 < MB; ++m2)
#pragma unroll
                    for (int bj = 0; bj < 2; ++bj) pre[m2][bj] = ef.pre(cur.pm * BM + ai * HALF + wr * 64 + (m0 + m2) * 16 + fr, cur.pn * BM + bj * HALF + wc * 32 + 8 * fq);
#pragma unroll
                for (int m2 = 0; m2 < MB; ++m2)
#pragma unroll
                    for (int bj = 0; bj < 2; ++bj) {
                        const int m = m0 + m2;
                        const f32x4 v0 = acc[ai][bj][m][0], v1 = acc[ai][bj][m][1];
                        const float v[8] = {v0[0], v0[1], v0[2], v0[3], v1[0], v1[1], v1[2], v1[3]};
                        ef.fin(cur.pm * BM + ai * HALF + wr * 64 + m * 16 + fr, cur.pn * BM + bj * HALF + wc * 32 + 8 * fq, v, pre[m2][bj], ctx[bj]);
                    }
                __builtin_amdgcn_sched_barrier(0);
            }
        }
        S.done(cur, lane);
        if (!has_next) break;
#pragma unroll
        for (int a = 0; a < 2; ++a)
#pragma unroll
            for (int b = 0; b < 2; ++b)
#pragma unroll
                for (int m = 0; m < 4; ++m)
#pragma unroll
                    for (int n = 0; n < 2; ++n) acc[a][b][m][n] = (f32x4){0.f, 0.f, 0.f, 0.f};
        cur = nxt; a00 = n00; a01 = n01; a10 = n10; a11 = n11; cB = nB; ++ui;
    }
    G8_WAIT_V(0);
    if (wr == 0) G8_BAR;
    G8_BAR;
#undef G8_SA
#undef G8_SB
#undef G8_STAGE
#undef G8_LDA
#undef G8_LDB
#undef G8_MMA
#undef G8_WAIT_V
#undef G8_WAIT_L
#undef G8_BAR
#undef G8_SCHED
#undef G8_AOFF
}
}
struct BSelOne { const char* B; __device__ __forceinline__ const char* operator()(int) const { return B; } };
struct RowPlain { __device__ __forceinline__ int operator()(int pm, int r) const { return pm * 256 + r; } };
struct BSelExp { const char* B; const int* tinfo; size_t stride; __device__ __forceinline__ const char* operator()(int pm) const { return B + (size_t)tinfo[2 * pm] * stride; } };
struct RowMoe { const int* tinfo; const int* ecnt; const int* elist;
    __device__ __forceinline__ int operator()(int pm, int r) const { const int e = tinfo[2 * pm], pos = tinfo[2 * pm + 1] + r; return pos < ecnt[e] ? elist[e * MT + pos] : 0; } };
__device__ __forceinline__ int moe_tile_table(const P& p, int layer, int* tinfo, int* ecnt, int tid) {
    const u32* cnt = (const u32*)(p.get_ws() + WS_CTL) + CW_CNT + layer * 16 * 64;
    if (tid < 16) ecnt[tid] = (int)cnt[tid * 64];
    __syncthreads();
    if (tid == 0) {
        int t = 0;
#pragma unroll 1
        for (int e = 0; e < 16; ++e) { const int c = ecnt[e];
#pragma unroll 1
            for (int i = 0; i < (c + 255) / 256; ++i) { tinfo[2 * t] = e; tinfo[2 * t + 1] = i * 256; ++t; } }
        ecnt[16] = t;
    }
    __syncthreads();
    return ecnt[16];
}

struct SrcPlain { const float* W; int ldw; __device__ __forceinline__ const float* operator()(int k, int n) const { return W + (size_t)k * ldw + n; } };
struct SrcEven { const float* W; __device__ __forceinline__ const float* operator()(int k, int n) const {
        return n < 2048 ? W + (size_t)k * EV_IN + (n < 1280 ? n : n + 16) : (n < 2064 ? W + (size_t)k * EV_IN + 1280 + (n - 2048) : nullptr); } };
struct SrcRouter { const float* W; __device__ __forceinline__ const float* operator()(int k, int n) const { return n < 16 ? W + (size_t)k * 16 + n : nullptr; } };
struct SrcOdd { const float* W; __device__ __forceinline__ const float* operator()(int k, int n) const { return n < OD_IN ? W + (size_t)k * OD_IN + n : nullptr; } };
struct SrcMoe13 { const float* W1; long long d13; __device__ __forceinline__ const float* operator()(int k, int n) const { return W1 + ((n & 4) ? d13 : 0ll) + (size_t)k * DE + ((n >> 3) * 4 + (n & 3)); } };
template <class SF>
__device__ __forceinline__ void conv_matrix(const SF& src, int K, int N, bf16_t* WT, int gw, int ngw, float* scr, int lane) {
    const int nblk = N / 32, nitems = (K / 64) * nblk;
    for (int item = gw; item < nitems; item += ngw) {
        const int kb = item / nblk, nbk = item % nblk, k0 = 64 * kb, n0 = 32 * nbk;
#pragma unroll 8
        for (int i = 0; i < 32; ++i) { const int kk = 2 * i + (lane >> 5); const float* sp = src(k0 + kk, n0 + (lane & 31)); scr[kk * 33 + (lane & 31)] = sp ? *sp : 0.f; }
        __builtin_amdgcn_s_waitcnt(0xC07F); asm volatile("" ::: "memory");
        const int c = lane & 7;
#pragma unroll
        for (int j = 0; j < 4; ++j) { const int n = (lane >> 3) + 8 * j; const float* sp = scr + (8 * c) * 33 + n;
            uint4 o; o.x = pack2(sp[0 * 33], sp[1 * 33]); o.y = pack2(sp[2 * 33], sp[3 * 33]); o.z = pack2(sp[4 * 33], sp[5 * 33]); o.w = pack2(sp[6 * 33], sp[7 * 33]);
            *(uint4*)(WT + (size_t)(n0 + n) * K + k0 + 8 * c) = o; }
        __builtin_amdgcn_s_waitcnt(0xC07F); asm volatile("" ::: "memory");
    }
}

template <class SF>
__device__ __forceinline__ void conv_item(const SF& src, int K, int N, bf16_t* WT, int item, int lane) {
    const int nblk = (N + 255) / 256, kb = item / nblk, nbk = item % nblk, k0 = 32 * kb, n = nbk * 256 + lane * 4;
    if (n >= N) return;
    {
        float4 v[32];
#pragma unroll
        for (int j = 0; j < 32; ++j) { const float* sp = src(k0 + j, n); v[j] = sp ? *(const float4*)sp : make_float4(0.f, 0.f, 0.f, 0.f); }
#pragma unroll
        for (int ks = 0; ks < 4; ++ks) {
            const float4* w = v + ks * 8;
            uint4 o;
            o.x = pack2(w[0].x, w[1].x); o.y = pack2(w[2].x, w[3].x); o.z = pack2(w[4].x, w[5].x); o.w = pack2(w[6].x, w[7].x); *(uint4*)(WT + (size_t)(n + 0) * K + k0 + ks * 8) = o;
            o.x = pack2(w[0].y, w[1].y); o.y = pack2(w[2].y, w[3].y); o.z = pack2(w[4].y, w[5].y); o.w = pack2(w[6].y, w[7].y); *(uint4*)(WT + (size_t)(n + 1) * K + k0 + ks * 8) = o;
            o.x = pack2(w[0].z, w[1].z); o.y = pack2(w[2].z, w[3].z); o.z = pack2(w[4].z, w[5].z); o.w = pack2(w[6].z, w[7].z); *(uint4*)(WT + (size_t)(n + 2) * K + k0 + ks * 8) = o;
            o.x = pack2(w[0].w, w[1].w); o.y = pack2(w[2].w, w[3].w); o.z = pack2(w[4].w, w[5].w); o.w = pack2(w[6].w, w[7].w); *(uint4*)(WT + (size_t)(n + 3) * K + k0 + ks * 8) = o;
        }
    }
}
template <class SF>
__device__ __forceinline__ void conv_all(const SF& src, int K, int N, bf16_t* WT, int gw, int ngw, int lane) {
    const int nitems = (K / 32) * ((N + 255) / 256);
    for (int it = gw; it < nitems; it += ngw) conv_item(src, K, N, WT, it, lane);
}
__device__ __forceinline__ void conv_dense(const P& p, int bid, int nb, float* lds) {
    const int tid = p.tid(), lane = tid & 63, wid = tid >> 6;
    const int ngw = nb * 8; int gw = bid >= 32 ? (bid - 32) * 8 + wid : (nb - 32) * 8 + bid * 8 + wid;
    unsigned char* ws = p.get_ws();
    conv_all(SrcEven{p.in[10]}, 1024, 2304, (bf16_t*)(ws + WS_WIN0), gw, ngw, lane);            gw = (gw + 288) % ngw;
    conv_all(SrcPlain{p.in[20], 1024}, 1024, 1024, (bf16_t*)(ws + WS_WOUT0), gw, ngw, lane);    gw = (gw + 128) % ngw;
    conv_all(SrcRouter{p.in[4]}, 1024, 32, (bf16_t*)((float*)(ws + WS_CHK) + CH_WRT), gw, ngw, lane);
}
__device__ __forceinline__ void conv_dense1_chunk(const P& p, int chunk) {
    const int tid = p.tid(), lane = tid & 63, wid = tid >> 6;
    unsigned char* ws = p.get_ws();
    const int wi = chunk * 8 + wid;
    if (wi < 416) conv_item(SrcOdd{p.in[21]}, 1024, 3328, (bf16_t*)(ws + WS_WIN1), wi, lane);
    else if (wi < 544) conv_item(SrcPlain{p.in[27], 1024}, 1024, 1024, (bf16_t*)(ws + WS_WOUT1), wi - 416, lane);
}
__device__ __forceinline__ void conv_moe_chunk(const P& p, int chunk, float* lds, int layer) {
    const int tid = p.tid(), lane = tid & 63, wid = tid >> 6;
    unsigned char* ws = p.get_ws();
    bf16_t* W13T = (bf16_t*)(ws + WS_WMOE); bf16_t* W2T = W13T + (size_t)16 * 1024 * 1024;
    const long long d13 = (long long)(p.in[29] - p.in[28]);
    const int wi = chunk * 8 + wid, e = wi / 192, idx = wi % 192;
    if (idx < 128) conv_item(SrcMoe13{p.in[28] + ((size_t)layer * 16 + e) * 1024 * DE, d13}, 1024, 1024, W13T + (size_t)e * 1024 * 1024, idx, lane);
    else conv_item(SrcPlain{p.in[30] + ((size_t)layer * 16 + e) * DE * 1024, 1024}, DE, 1024, W2T + (size_t)e * 1024 * DE, idx - 128, lane);
}
__device__ __forceinline__ void conv_moe(const P& p, int bid, int nb, float* lds, int layer) {
    const int tid = p.tid(), lane = tid & 63, wid = tid >> 6;
    float* scr = lds + 16384 + wid * (64 * 33);
    const int ngw = nb * 8; int gw = bid * 8 + wid;
    unsigned char* ws = p.get_ws();
    bf16_t* W13T = (bf16_t*)(ws + WS_WMOE); bf16_t* W2T = W13T + (size_t)16 * 1024 * 1024;
    const long long d13 = (long long)(p.in[29] - p.in[28]);
    for (int e = 0; e < 16; ++e) {
        conv_matrix(SrcMoe13{p.in[28] + ((size_t)layer * 16 + e) * 1024 * DE, d13}, 1024, 1024, W13T + (size_t)e * 1024 * 1024, gw, ngw, scr, lane);
        conv_matrix(SrcPlain{p.in[30] + ((size_t)layer * 16 + e) * DE * 1024, 1024}, DE, 1024, W2T + (size_t)e * 1024 * DE, gw, ngw, scr, lane);
        gw = (gw + 768) % ngw;
    }
}


template <int NI, class EF>
__device__ __forceinline__ void mini_gemm(const P& p, int bid, int nb, float* lds, const bf16_t* A, const bf16_t* Bt, int row0, int nrt, int col0, int nct, const EF& ef) {
    constexpr int K = 1024, KS = 128, TN = 16 * NI;
    const int tid = p.tid(), lane = tid & 63, wid = tid >> 6, r = lane & 15, q = lane >> 4;
    const int ntl = nrt * nct;
    int t = bid;
    if (t >= ntl) return;
    bf16x8 a[4][4], b[4][NI];
#define MG_LOAD(tt) do { const int rt_ = (tt) / nct, ct_ = (tt) % nct; \
        const bf16_t* Ab_ = A + (size_t)(row0 + rt_ * 64 + r) * K + wid * KS + 8 * q; const bf16_t* Bb_ = Bt + (size_t)(col0 + ct_ * TN + r) * K + wid * KS + 8 * q; \
        _Pragma("unroll") for (int k4 = 0; k4 < 4; ++k4) { \
            _Pragma("unroll") for (int mi = 0; mi < 4; ++mi) a[k4][mi] = *(const bf16x8*)(Ab_ + (size_t)(16 * mi) * K + 32 * k4); \
            _Pragma("unroll") for (int ni = 0; ni < NI; ++ni) b[k4][ni] = *(const bf16x8*)(Bb_ + (size_t)(16 * ni) * K + 32 * k4); } } while (0)
    MG_LOAD(t);
    for (;;) {
        f32x4 acc[4][NI];
#pragma unroll
        for (int mi = 0; mi < 4; ++mi)
#pragma unroll
            for (int ni = 0; ni < NI; ++ni) acc[mi][ni] = (f32x4){0.f, 0.f, 0.f, 0.f};
#pragma unroll
        for (int k4 = 0; k4 < 4; ++k4)
#pragma unroll
            for (int mi = 0; mi < 4; ++mi)
#pragma unroll
                for (int ni = 0; ni < NI; ++ni) acc[mi][ni] = __builtin_amdgcn_mfma_f32_16x16x32_bf16(b[k4][ni], a[k4][mi], acc[mi][ni], 0, 0, 0);
        const int tcur = t; t += nb;
        const bool more = t < ntl;
        if (more) MG_LOAD(t);
        __syncthreads();
#pragma unroll
        for (int mi = 0; mi < 4; ++mi)
#pragma unroll
            for (int ni = 0; ni < NI; ++ni) *(f32x4*)(lds + wid * (64 * TN) + (16 * mi + r) * TN + 16 * ni + 4 * q) = acc[mi][ni];
        __syncthreads();
        if (tid < 64 * 2 * NI) {
            const int rr = tid / (2 * NI), c8 = (tid % (2 * NI)) * 8;
            float v[8] = {0.f, 0.f, 0.f, 0.f, 0.f, 0.f, 0.f, 0.f};
#pragma unroll
            for (int w = 0; w < 8; ++w) { const float4 x0 = *(const float4*)(lds + w * (64 * TN) + rr * TN + c8), x1 = *(const float4*)(lds + w * (64 * TN) + rr * TN + c8 + 4);
                v[0] += x0.x; v[1] += x0.y; v[2] += x0.z; v[3] += x0.w; v[4] += x1.x; v[5] += x1.y; v[6] += x1.z; v[7] += x1.w; }
            ef(row0 + (tcur / nct) * 64 + rr, col0 + (tcur % nct) * TN + c8, v);
        }
        if (!more) break;
    }
#undef MG_LOAD
    __syncthreads();
}

struct EpiProj { bf16_t* C; int ld; int nmain; int ns; float* SMALL; int skip;
    static constexpr int MB = 2; struct Ctx {}; struct Pre {}; __device__ __forceinline__ Ctx ctx(int) const { return Ctx{}; } __device__ __forceinline__ Pre pre(int, int) const { return Pre{}; }
    __device__ __forceinline__ void fin(int r, int c0, const float* v, const Pre&, const Ctx&) const { (*this)(r, c0, v); }
    __device__ void operator()(int r, int c0, const float* v) const {
    if (skip) return;
    if (c0 < nmain) { uint4 o; o.x = pack2(v[0], v[1]); o.y = pack2(v[2], v[3]); o.z = pack2(v[4], v[5]); o.w = pack2(v[6], v[7]); *(uint4*)(C + (size_t)r * ld + c0) = o; }
    else if (c0 < nmain + ns) { float* d = SMALL + (size_t)r * 32 + (c0 - nmain); *(float4*)d = make_float4(v[0], v[1], v[2], v[3]); *(float4*)(d + 4) = make_float4(v[4], v[5], v[6], v[7]); } } };
struct EpiBf16Store { bf16_t* C; int ld;
    static constexpr int MB = 2; struct Ctx {}; struct Pre {}; __device__ __forceinline__ Ctx ctx(int) const { return Ctx{}; } __device__ __forceinline__ Pre pre(int, int) const { return Pre{}; }
    __device__ __forceinline__ void fin(int r, int c0, const float* v, const Pre&, const Ctx&) const { (*this)(r, c0, v); }
    __device__ void operator()(int r, int c0, const float* v) const {
    uint4 o; o.x = pack2(v[0], v[1]); o.y = pack2(v[2], v[3]); o.z = pack2(v[4], v[5]); o.w = pack2(v[6], v[7]); *(uint4*)(C + (size_t)r * ld + c0) = o; } };
template <bool XF32>
struct EpiResidT { const float* xlat; const float* xctx; bf16_t* XRES; const float* gl; const float* gc;
    static constexpr int MB = XF32 ? 2 : 4;
    struct Ctx { float4 g0, g1; }; struct Pre { uint4 a, b; };
    __device__ __forceinline__ Ctx ctx(int c0) const { Ctx c; c.g0 = *(const float4*)(gl + c0); c.g1 = *(const float4*)(gl + c0 + 4); return c; }
    __device__ __forceinline__ Pre pre(int r, int c0) const { Pre q;
        if (XF32) { const float* xin = xlat + (size_t)r * 1024 + c0; q.a = *(const uint4*)xin; q.b = *(const uint4*)(xin + 4); }
        else { q.a = *(const uint4*)(XRES + (size_t)r * 1024 + c0); q.b = make_uint4(0u, 0u, 0u, 0u); }
        return q; }
    __device__ __forceinline__ void fin(int r, int c0, const float* v, const Pre& q, const Ctx& c) const {
        float x[8];
        if (XF32) { x[0] = __uint_as_float(q.a.x); x[1] = __uint_as_float(q.a.y); x[2] = __uint_as_float(q.a.z); x[3] = __uint_as_float(q.a.w); x[4] = __uint_as_float(q.b.x); x[5] = __uint_as_float(q.b.y); x[6] = __uint_as_float(q.b.z); x[7] = __uint_as_float(q.b.w); }
        else unpack8(q.a, x);
        uint4 o; o.x = pack2(x[0] + c.g0.x * v[0], x[1] + c.g0.y * v[1]); o.y = pack2(x[2] + c.g0.z * v[2], x[3] + c.g0.w * v[3]); o.z = pack2(x[4] + c.g1.x * v[4], x[5] + c.g1.y * v[5]); o.w = pack2(x[6] + c.g1.z * v[6], x[7] + c.g1.w * v[7]);
        *(uint4*)(XRES + (size_t)r * 1024 + c0) = o;
    }
    __device__ void operator()(int r, int c0, const float* v) const {
        const float* g = r >= SEQ ? gc : gl;
        const float4 g0 = *(const float4*)(g + c0), g1 = *(const float4*)(g + c0 + 4);
        float x[8];
        if (xlat) { const float* xin = r >= SEQ ? xctx + (size_t)(r - SEQ) * 1024 : xlat + (size_t)r * 1024;
            const float4 x0 = *(const float4*)(xin + c0), x1 = *(const float4*)(xin + c0 + 4); x[0] = x0.x; x[1] = x0.y; x[2] = x0.z; x[3] = x0.w; x[4] = x1.x; x[5] = x1.y; x[6] = x1.z; x[7] = x1.w; }
        else unpack8(*(const uint4*)(XRES + (size_t)r * 1024 + c0), x);
        uint4 o; o.x = pack2(x[0] + g0.x * v[0], x[1] + g0.y * v[1]); o.y = pack2(x[2] + g0.z * v[2], x[3] + g0.w * v[3]); o.z = pack2(x[4] + g1.x * v[4], x[5] + g1.y * v[5]); o.w = pack2(x[6] + g1.z * v[6], x[7] + g1.w * v[7]);
        *(uint4*)(XRES + (size_t)r * 1024 + c0) = o;
    } };
struct EpiSwiglu { bf16_t* H;
    static constexpr int MB = 2; struct Ctx {}; struct Pre {}; __device__ __forceinline__ Ctx ctx(int) const { return Ctx{}; } __device__ __forceinline__ Pre pre(int, int) const { return Pre{}; }
    __device__ __forceinline__ void fin(int r, int c0, const float* v, const Pre&, const Ctx&) const { (*this)(r, c0, v); }
    __device__ void operator()(int r, int c0, const float* v) const {
    uint2 o; o.x = pack2(siluf(v[0]) * v[4], siluf(v[1]) * v[5]); o.y = pack2(siluf(v[2]) * v[6], siluf(v[3]) * v[7]); *(uint2*)(H + (size_t)r * DE + (c0 >> 3) * 4) = o; } };


struct SchedMoe1 { int T, G, c; unsigned* cnt;
    __device__ __forceinline__ bool next(int i, g8::Unit& u) const { const int x = c & 7, j = c >> 3; u.pm = 64 * i + 8 * x + (j & 7); u.pn = j >> 3; return u.pm < T; }
    __device__ __forceinline__ void ready(const g8::Unit&, int) const {}
    __device__ __forceinline__ void done(const g8::Unit& u, int lane) const {
        asm volatile("s_waitcnt vmcnt(0)" ::: "memory");
        if (lane == 0) __hip_atomic_fetch_add(cnt + u.pm, 1u, __ATOMIC_RELAXED, __HIP_MEMORY_SCOPE_AGENT);
    } };
struct SchedMoe2 { int U, G, c, r1, nB; unsigned* cnt; unsigned* tmo;
    __device__ __forceinline__ bool next(int i, g8::Unit& u) const {
        int idx;
        if (c >= r1) idx = i == 0 ? c - r1 : (i == 1 ? nB + c - r1 : 2 * nB + G * (i - 2) + (int)(((unsigned)(c - r1) * 257u) % (unsigned)nB));
        else idx = 2 * nB + G * i + nB + c;
        if (idx >= U) return false; u.pm = idx >> 2; u.pn = idx & 3; return true; }
    __device__ __forceinline__ void ready(const g8::Unit& u, int wid) const {
        if (wid == 0) {
            unsigned spins = 0;
            while ((unsigned)__builtin_amdgcn_readfirstlane((int)__hip_atomic_load(cnt + u.pm, __ATOMIC_RELAXED, __HIP_MEMORY_SCOPE_AGENT)) < 32u) {
                __builtin_amdgcn_s_sleep(2);
                if (++spins > (1u << 22)) { __hip_atomic_store(tmo, 1u, __ATOMIC_RELAXED, __HIP_MEMORY_SCOPE_AGENT); break; }
            }
            __builtin_amdgcn_fence(__ATOMIC_ACQUIRE, "agent");
            asm volatile("s_waitcnt vmcnt(0)" ::: "memory");
        }
        asm volatile("" ::: "memory"); __builtin_amdgcn_s_barrier(); asm volatile("" ::: "memory");
    }
    __device__ __forceinline__ void done(const g8::Unit&, int) const {} };
struct EpiSwigluWT { bf16_t* H;
    static constexpr int MB = 2; struct Ctx {}; struct Pre {}; __device__ __forceinline__ Ctx ctx(int) const { return Ctx{}; } __device__ __forceinline__ Pre pre(int, int) const { return Pre{}; }
    __device__ __forceinline__ void fin(int r, int c0, const float* v, const Pre&, const Ctx&) const { (*this)(r, c0, v); }
    __device__ void operator()(int r, int c0, const float* v) const {
    const unsigned long long o = (unsigned long long)pack2(siluf_r(v[0]) * v[4], siluf_r(v[1]) * v[5]) | ((unsigned long long)pack2(siluf_r(v[2]) * v[6], siluf_r(v[3]) * v[7]) << 32);
    __hip_atomic_store((unsigned long long*)(H + (size_t)r * DE + (c0 >> 3) * 4), o, __ATOMIC_RELAXED, __HIP_MEMORY_SCOPE_AGENT); } };
__device__ __forceinline__ void phase_moe_fused(const P& p, int bid, int nb, G8_LAS unsigned char* ldsa, float* lds, int layer) {
    unsigned char* ws = p.get_ws();
    int* tinfo = (int*)(lds + 32768); int* ecnt = tinfo + 2 * MAXTILES + 16;
    const int ntiles = moe_tile_table(p, layer, tinfo, ecnt, p.tid());
    unsigned* cnt = (unsigned*)(ws + WS_CTL) + CW_MOEC + layer * 160;
    const int U = ntiles * 4;
    {
        SchedMoe1 S{ntiles, nb, bid, cnt};
        EpiSwigluWT ef{(bf16_t*)(ws + WS_Y)};
        g8::gemm8(p.tid(), ldsa, (const bf16_t*)(ws + WS_HB), 1024, RowMoe{tinfo, ecnt, (const int*)(ws + WS_CHK) + CH_ELIST}, S, BSelExp{(const char*)(ws + WS_WMOE), tinfo, (size_t)1024 * 1024 * 2}, ef);
    }
    {
        const int r1 = U % nb;
        const int cp = ((8 * (bid & 7) + ((bid >> 3) & 7)) << 2) | (bid >> 6);
        SchedMoe2 S{U, nb, cp, r1, nb - r1, cnt, (unsigned*)(ws + WS_CTL) + CW_TMO};
        EpiBf16Store ef{(bf16_t*)(ws + WS_PROJ), 1024};
        g8::gemm8(p.tid(), ldsa, (const bf16_t*)(ws + WS_Y), DE, RowPlain{}, S, BSelExp{(const char*)(ws + WS_WMOE) + (size_t)16 * 1024 * 1024 * 2, tinfo, (size_t)1024 * DE * 2}, ef);
    }
}

__device__ __forceinline__ void phase_moe1(const P& p, int bid, int nb, G8_LAS unsigned char* ldsa, float* lds, int layer) {
    unsigned char* ws = p.get_ws();
    int* tinfo = (int*)(lds + 32768); int* ecnt = tinfo + 2 * MAXTILES + 16;
    const int ntiles = moe_tile_table(p, layer, tinfo, ecnt, p.tid());
    g8::Order S; S.init(ntiles, 4, nb, bid);
    EpiSwiglu ef{(bf16_t*)(ws + WS_Y)};
    g8::gemm8(p.tid(), ldsa, (const bf16_t*)(ws + WS_HB), 1024, RowMoe{tinfo, ecnt, (const int*)(ws + WS_CHK) + CH_ELIST}, S, BSelExp{(const char*)(ws + WS_WMOE), tinfo, (size_t)1024 * 1024 * 2}, ef);
}
__device__ __forceinline__ void phase_moe2(const P& p, int bid, int nb, G8_LAS unsigned char* ldsa, float* lds, int layer) {
    unsigned char* ws = p.get_ws();
    int* tinfo = (int*)(lds + 32768); int* ecnt = tinfo + 2 * MAXTILES + 16;
    const int ntiles = moe_tile_table(p, layer, tinfo, ecnt, p.tid());
    g8::Order S; S.init(ntiles, 4, nb, bid);
    EpiBf16Store ef{(bf16_t*)(ws + WS_PROJ), 1024};
    g8::gemm8(p.tid(), ldsa, (const bf16_t*)(ws + WS_Y), DE, RowPlain{}, S, BSelExp{(const char*)(ws + WS_WMOE) + (size_t)16 * 1024 * 1024 * 2, tinfo, (size_t)1024 * DE * 2}, ef);
}

__device__ __forceinline__ void phase_qkprep(const P& p, int bid, int nb, float* lds) {
    const int tid = p.tid(), lane = tid & 63, wid = tid >> 6;
    unsigned char* ws = p.get_ws();
    const bf16_t* PROJ = (const bf16_t*)(ws + WS_PROJ);
    bf16_t* QKR = (bf16_t*)(ws + WS_XRES);
    const float* RCg = (const float*)(ws + WS_ROPE);
    float* RCl = lds; float* RSl = lds + 256 * 16;
    const int d0 = (lane & 7) * 8;
    float qn[8], kn[8];
#pragma unroll
    for (int j = 0; j < 8; ++j) { qn[j] = p.in[17][d0 + j]; kn[j] = p.in[18][d0 + j]; }
    __syncthreads();
    {
        float4 t[4];
#pragma unroll
        for (int i = 0; i < 4; ++i) t[i] = *(const float4*)(RCg + (tid + i * NTH) * 4);
#pragma unroll
        for (int i = 0; i < 4; ++i) *(float4*)(lds + (tid + i * NTH) * 4) = t[i];
    }
    for (int rk = bid * 8; rk < MT / 8; rk += nb * 8) {
        uint4 qraw[8], kraw[8];
#pragma unroll
        for (int k8 = 0; k8 < 8; ++k8) {
            const int row = (rk + k8) * 8 + wid;
            qraw[k8] = *(const uint4*)(PROJ + (size_t)row * 2048 + 1280 + lane * 8);
            kraw[k8] = lane < 16 ? *(const uint4*)(PROJ + (size_t)row * 2048 + 1792 + lane * 8) : make_uint4(0u, 0u, 0u, 0u);
        }
        __syncthreads();
#pragma unroll
        for (int k8 = 0; k8 < 8; ++k8) {
            const int row = (rk + k8) * 8 + wid;
            const bool lat = row < SEQ;
            const int pos = d0 < 32 ? (row >> 6) & 255 : (row & 63);
            float cs[8], sn[8];
            { const float4 c0 = *(const float4*)(RCl + pos * 16 + (d0 & 15)), c1 = *(const float4*)(RCl + pos * 16 + (d0 & 15) + 4), s0 = *(const float4*)(RSl + pos * 16 + (d0 & 15)), s1 = *(const float4*)(RSl + pos * 16 + (d0 & 15) + 4);
              cs[0] = lat ? c0.x : 1.f; cs[1] = lat ? c0.y : 1.f; cs[2] = lat ? c0.z : 1.f; cs[3] = lat ? c0.w : 1.f; cs[4] = lat ? c1.x : 1.f; cs[5] = lat ? c1.y : 1.f; cs[6] = lat ? c1.z : 1.f; cs[7] = lat ? c1.w : 1.f;
              sn[0] = lat ? s0.x : 0.f; sn[1] = lat ? s0.y : 0.f; sn[2] = lat ? s0.z : 0.f; sn[3] = lat ? s0.w : 0.f; sn[4] = lat ? s1.x : 0.f; sn[5] = lat ? s1.y : 0.f; sn[6] = lat ? s1.z : 0.f; sn[7] = lat ? s1.w : 0.f; }
            const bool lowhalf = (d0 & 16) == 0;
#pragma unroll
            for (int part = 0; part < 2; ++part) {
                float f[8]; unpack8(part == 0 ? qraw[k8] : kraw[k8], f);
                float ss = 0.f;
#pragma unroll
                for (int j = 0; j < 8; ++j) ss += f[j] * f[j];
                ss += __shfl_xor(ss, 1); ss += __shfl_xor(ss, 2); ss += __shfl_xor(ss, 4);
                const float rs = rsqrtf(ss * (1.f / 64.f) + 1e-6f);
                float o[8];
#pragma unroll
                for (int j = 0; j < 8; ++j) { const float y = f[j] * rs * (part == 0 ? qn[j] : kn[j]); const float oth = __shfl_xor(y, 2); o[j] = lowhalf ? y * cs[j] - oth * sn[j] : oth * sn[j] + y * cs[j]; }
                uint4 w; w.x = pack2(o[0], o[1]); w.y = pack2(o[2], o[3]); w.z = pack2(o[4], o[5]); w.w = pack2(o[6], o[7]);
                if (part == 0) *(uint4*)(QKR + (size_t)row * 640 + lane * 8) = w;
                else if (lane < 16) *(uint4*)(QKR + (size_t)row * 640 + 512 + lane * 8) = w;
            }
        }
    }
    __syncthreads();
}


template <int MI, int NI, int KK, bool SWAP, bool SWB = false>
__device__ __forceinline__ void wave_mma(f32x4 (&acc)[MI][NI], const bf16_t* A, int lda, const bf16_t* Bt, int ldb, int lane) {
    const int r = lane & 15, q = lane >> 4;
#pragma unroll
    for (int kk = 0; kk < KK; kk += 32) {
        bf16x8 a[MI], b[NI];
#pragma unroll
        for (int mi = 0; mi < MI; ++mi) a[mi] = *(const bf16x8*)(A + (16 * mi + r) * lda + kk + 8 * q);
#pragma unroll
        for (int ni = 0; ni < NI; ++ni) b[ni] = *(const bf16x8*)(Bt + (16 * ni + r) * ldb + ((kk + 8 * q) ^ (SWB ? ((((16 * ni + r) >> 3) & 7) << 3) : 0)));
#pragma unroll
        for (int mi = 0; mi < MI; ++mi)
#pragma unroll
            for (int ni = 0; ni < NI; ++ni)
                acc[mi][ni] = SWAP ? __builtin_amdgcn_mfma_f32_16x16x32_bf16(b[ni], a[mi], acc[mi][ni], 0, 0, 0) : __builtin_amdgcn_mfma_f32_16x16x32_bf16(a[mi], b[ni], acc[mi][ni], 0, 0, 0);
    }
}
__device__ __forceinline__ void prefetch_line(const void* g, float* lds_dummy, int wid) {
    __builtin_amdgcn_global_load_lds((const unsigned*)g, (__attribute__((address_space(3))) unsigned*)((__attribute__((address_space(3))) unsigned char*)lds_dummy + wid * 256), 4, 0, 0);
}
struct Raw3 { uint4 m, c, p; };
struct ConvW { float4 w0a, w0b, w1a, w1b, w2a, w2b, ba, bb; };
__device__ __forceinline__ Raw3 conv8_load(const bf16_t* rowp, int ld, int t, int L) {
    const uint4 z = make_uint4(0u, 0u, 0u, 0u);
    Raw3 r; r.m = t > 0 ? *(const uint4*)(rowp - ld) : z; r.c = *(const uint4*)rowp; r.p = t < L - 1 ? *(const uint4*)(rowp + ld) : z; return r;
}
__device__ __forceinline__ void conv8_apply_r(const Raw3& r, const ConvW& w, float* out) {
    float fm[8], f0[8], fp[8]; unpack8(r.m, fm); unpack8(r.c, f0); unpack8(r.p, fp);
    const float w0[8] = {w.w0a.x, w.w0a.y, w.w0a.z, w.w0a.w, w.w0b.x, w.w0b.y, w.w0b.z, w.w0b.w}, w1[8] = {w.w1a.x, w.w1a.y, w.w1a.z, w.w1a.w, w.w1b.x, w.w1b.y, w.w1b.z, w.w1b.w};
    const float w2[8] = {w.w2a.x, w.w2a.y, w.w2a.z, w.w2a.w, w.w2b.x, w.w2b.y, w.w2b.z, w.w2b.w}, bb[8] = {w.ba.x, w.ba.y, w.ba.z, w.ba.w, w.bb.x, w.bb.y, w.bb.z, w.bb.w};
#pragma unroll
    for (int j = 0; j < 8; ++j) out[j] = siluf_r(w0[j] * fm[j] + w1[j] * f0[j] + w2[j] * fp[j] + bb[j]);
}
__device__ __forceinline__ void conv8_apply(const Raw3& r, const float* cwl, float* out) {
    float fm[8], f0[8], fp[8]; unpack8(r.m, fm); unpack8(r.c, f0); unpack8(r.p, fp);
#pragma unroll
    for (int j = 0; j < 8; ++j) { const float4 w = *(const float4*)(cwl + j * 4); out[j] = siluf_r(w.x * fm[j] + w.y * f0[j] + w.z * fp[j] + w.w); }
}
__device__ __forceinline__ float wave_scan128(float& v0, float& v1, int lane) {
    float s = v0 + v1;
#pragma unroll
    for (int o = 1; o < 64; o <<= 1) { const float t = __shfl_up(s, o); if (lane >= o) s += t; }
    const float excl = s - (v0 + v1);
    v0 = excl + v0; v1 = v0 + v1;
    return __shfl(s, 63);
}

constexpr size_t SSD_S_OFF = 0;
constexpr size_t SSD_H_OFF = (size_t)130 * 16 * 4096 * 4;
constexpr size_t SSD_CB_OFF = (size_t)22 * 1024 * 1024;
constexpr size_t SSD_X_OFF = SSD_H_OFF + (size_t)130 * 16 * 4096 * 2;
__device__ __forceinline__ void stage_convw(const float* cw, const float* cb, int C, float* cwl, int tid) {
    for (int c = tid; c < C; c += NTH) *(float4*)(cwl + c * 4) = make_float4(cw[c], cw[C + c], cw[2 * C + c], cb[c]);
}
__device__ __forceinline__ void ssd_states(const P& p, int bid, int nb, float* lds) {
    const int tid = p.tid(), lane = tid & 63, wid = tid >> 6;
    unsigned char* ws = p.get_ws();
    const bf16_t* PROJ = (const bf16_t*)(ws + WS_PROJ);
    const float* SMALL = (const float*)(ws + WS_SMALL);
    float* S = (float*)(ws + WS_Y + SSD_S_OFF);
    float* DEC = (float*)(ws + WS_CHK);
    float* cwl = lds;
    bf16_t* XT = (bf16_t*)(lds + 768 * 4);
    bf16_t* BT = XT + 256 * 136;
    float* wsc = (float*)(BT + 64 * 136);
    stage_convw(p.in[11], p.in[12], 768, cwl, tid);
    __syncthreads();
    for (int item = bid; item < 260; item += nb) {
        const int c = item >> 1, g = item & 1;
        const int L = c < 128 ? SEQ : CTX, t0 = c < 128 ? c * 128 : (c - 128) * 128, rbase = c < 128 ? 0 : SEQ;
        const int tid = p.tid(), lane = tid & 63, wid = tid >> 6;
        bf16_t* CBS = (bf16_t*)(ws + WS_XRES + SSD_CB_OFF) + ((size_t)c * 2 + g) * 16384;
        const int hh = wid >> 1, d = wid & 1, h = g * 4 + hh;
        const float Araw = p.in[14][d * 8 + h], dtb = p.in[13][d * 8 + h];
        const float dr0 = SMALL[(size_t)(rbase + t0 + 2 * lane) * 32 + d * 8 + h], dr1 = SMALL[(size_t)(rbase + t0 + 2 * lane + 1) * 32 + d * 8 + h];
        Raw3 rwb[2][4];
#define SS_LOAD(b4_, st_) do { _Pragma("unroll") for (int k = 0; k < 4; ++k) { const int i = tid + ((b4_) * 4 + k) * NTH; const int cg8 = (i >> 3) % 48, tl = (i / 384) * 8 + (i & 7); \
                const int ch = cg8 < 32 ? g * 256 + cg8 * 8 : (cg8 < 40 ? 512 + g * 64 + (cg8 - 32) * 8 : 640 + g * 64 + (cg8 - 40) * 8); \
                rwb[st_][k] = conv8_load(PROJ + (size_t)(rbase + t0 + tl) * 2048 + 512 + ch, 2048, t0 + tl, L); } } while (0)
        SS_LOAD(0, 0);
#pragma unroll
        for (int b4 = 0; b4 < 3; ++b4) {
            if (b4 < 2) SS_LOAD(b4 + 1, (b4 + 1) & 1);
#pragma unroll
            for (int k = 0; k < 4; ++k) { const int i = tid + (b4 * 4 + k) * NTH; const int cg8 = (i >> 3) % 48, tl = (i / 384) * 8 + (i & 7);
                const int ch = cg8 < 32 ? g * 256 + cg8 * 8 : (cg8 < 40 ? 512 + g * 64 + (cg8 - 32) * 8 : 640 + g * 64 + (cg8 - 40) * 8);
                float o[8]; conv8_apply(rwb[b4 & 1][k], cwl + ch * 4, o);
                if (cg8 >= 32) { uint4 w; w.x = pack2(o[0], o[1]); w.y = pack2(o[2], o[3]); w.z = pack2(o[4], o[5]); w.w = pack2(o[6], o[7]);
                    *(uint4*)(CBS + (size_t)tl * 128 + (cg8 < 40 ? 64 + (cg8 - 32) * 8 : (cg8 - 40) * 8)) = w; }
                if (cg8 < 40) {
                    const int tls = tl ^ ((cg8 & 7) << 3);
                    bf16_t* dst = cg8 < 32 ? XT + (cg8 * 8) * 136 + tls : BT + ((cg8 - 32) * 8) * 136 + tls;
#pragma unroll
                    for (int j = 0; j < 8; ++j) dst[j * 136] = f2bf(o[j]); }
            }
        }
        {
            const float A = -expf(Araw);
            const float dt0 = softplusf(dr0 + dtb), dt1 = softplusf(dr1 + dtb);
            const float a0 = dt0 * A, a1 = dt1 * A;
            float c0 = a0, c1 = a1; const float tot = wave_scan128(c0, c1, lane);
            const float w0 = d == 0 ? __expf(tot - c0) * dt0 : __expf(c0 - a0) * dt0, w1 = d == 0 ? __expf(tot - c1) * dt1 : __expf(c1 - a1) * dt1;
            wsc[wid * 128 + 2 * lane] = w0; wsc[wid * 128 + 2 * lane + 1] = w1;
            if (lane == 0) DEC[c * 16 + d * 8 + h] = __expf(tot);
        }
        __syncthreads();
        {
            bf16_t* XTS = (bf16_t*)(ws + WS_Y + SSD_X_OFF) + ((size_t)c * 8 + g * 4) * 8192;
#pragma unroll
            for (int k = 0; k < 8; ++k) { const int i = tid + k * NTH; const int row = i >> 4, pc = i & 15;
                *(uint4*)(XTS + (size_t)row * 128 + pc * 8) = *(const uint4*)(XT + row * 136 + pc * 8); }
        }
        {
            f32x4 acc[4][4];
#pragma unroll
            for (int mi = 0; mi < 4; ++mi)
#pragma unroll
                for (int ni = 0; ni < 4; ++ni) acc[mi][ni] = (f32x4){0.f, 0.f, 0.f, 0.f};
            const int r = lane & 15, q = lane >> 4;
#pragma unroll
            for (int kk = 0; kk < 128; kk += 32) {
                const float4 wa = *(const float4*)(wsc + wid * 128 + kk + 8 * q), wb = *(const float4*)(wsc + wid * 128 + kk + 8 * q + 4);
                bf16x8 a[4], b[4];
#pragma unroll
                for (int mi = 0; mi < 4; ++mi) {
                    const uint4 raw = *(const uint4*)(XT + (hh * 64 + 16 * mi + r) * 136 + ((kk + 8 * q) ^ ((((16 * mi + r) >> 3) & 7) << 3)));
                    float f[8]; unpack8(raw, f);
                    uint4 o; o.x = pack2(f[0] * wa.x, f[1] * wa.y); o.y = pack2(f[2] * wa.z, f[3] * wa.w); o.z = pack2(f[4] * wb.x, f[5] * wb.y); o.w = pack2(f[6] * wb.z, f[7] * wb.w);
                    a[mi] = *(bf16x8*)&o;
                }
#pragma unroll
                for (int ni = 0; ni < 4; ++ni) b[ni] = *(const bf16x8*)(BT + (16 * ni + r) * 136 + ((kk + 8 * q) ^ ((((16 * ni + r) >> 3) & 7) << 3)));
#pragma unroll
                for (int mi = 0; mi < 4; ++mi)
#pragma unroll
                    for (int ni = 0; ni < 4; ++ni) acc[mi][ni] = __builtin_amdgcn_mfma_f32_16x16x32_bf16(a[mi], b[ni], acc[mi][ni], 0, 0, 0);
                __builtin_amdgcn_sched_barrier(0);
            }
            float* Sp = S + ((size_t)(c * 2 + d) * 8 + h) * 4096;
#pragma unroll
            for (int mi = 0; mi < 4; ++mi)
#pragma unroll
                for (int ni = 0; ni < 4; ++ni)
#pragma unroll
                    for (int j = 0; j < 4; ++j) Sp[(16 * mi + 4 * q + j) * 64 + 16 * ni + r] = acc[mi][ni][j];
        }
        __syncthreads();
    }
}
__device__ __forceinline__ void ssd_scan(const P& p, int bid, int nb) {
    const int tid = p.tid();
    unsigned char* ws = p.get_ws();
    const float* S = (const float*)(ws + WS_Y + SSD_S_OFF);
    bf16_t* HIN = (bf16_t*)(ws + WS_Y + SSD_H_OFF);
    const float* DEC = (const float*)(ws + WS_CHK);
    for (int gid = bid * NTH + tid; gid < 65536; gid += nb * NTH) {
        const int d = gid >> 15, h = (gid >> 12) & 7, e = gid & 4095;
        float H = 0.f;
#pragma unroll 1
        for (int i0 = 0; i0 < 130; i0 += 10) {
            float sv[10], dv[10]; int cc[10];
#pragma unroll
            for (int j = 0; j < 10; ++j) {
                const int i = i0 + j;
                const int c = d == 0 ? (i < 2 ? 128 + i : i - 2) : (i < 2 ? 129 - i : 129 - i);
                cc[j] = c; sv[j] = S[((size_t)(c * 2 + d) * 8 + h) * 4096 + e]; dv[j] = DEC[c * 16 + d * 8 + h];
            }
#pragma unroll
            for (int j = 0; j < 10; ++j) { HIN[((size_t)(cc[j] * 2 + d) * 8 + h) * 4096 + e] = f2bf(H); H = dv[j] * H + sv[j]; }
        }
    }
}
__device__ __forceinline__ void ssd_out(const P& p, int bid, int nb, float* lds) {
    unsigned char* tsbase = (unsigned char*)lds + LDS_BYTES - 128; (void)tsbase;
    const int tid = p.tid(), lane = tid & 63, wid = tid >> 6, r = lane & 15, q = lane >> 4;
    unsigned char* ws = p.get_ws();
    const bf16_t* PROJ = (const bf16_t*)(ws + WS_PROJ);
    const float* SMALL = (const float*)(ws + WS_SMALL);
    const bf16_t* HIN = (const bf16_t*)(ws + WS_Y + SSD_H_OFF);
    bf16_t* MIX = (bf16_t*)(ws + WS_HB);
    float* cwl = lds;
    bf16_t* Cg = (bf16_t*)(lds + 768 * 4);
    bf16_t* Bg = Cg + 128 * 72;
    bf16_t* XT = Bg + 128 * 72;
    bf16_t* Mb = XT + 64 * 136;
    bf16_t* Hn = Mb + 128 * 136;
    float* csb = (float*)(Hn + 2 * 64 * 72);
    float* dts = csb + 8 * 256;
    stage_convw(p.in[11], p.in[12], 768, cwl, tid);
    __syncthreads();
    for (int c = bid; c < 130; c += nb) {
        TS(10);
        const int L = c < 128 ? SEQ : CTX, t0 = c < 128 ? c * 128 : (c - 128) * 128, rbase = c < 128 ? 0 : SEQ;
        const int trow = wid * 16 + r;
        float ssq = 0.f;
        uint4 nx0, nx1, nhp0, nhp1;
        uint4 cb0, cb1, cb2, cb3;
        { const bf16_t* CBS0 = (const bf16_t*)(ws + WS_XRES + SSD_CB_OFF) + ((size_t)c * 2) * 16384;
          cb0 = *(const uint4*)(CBS0 + (size_t)tid * 8); cb1 = *(const uint4*)(CBS0 + (size_t)(tid + 512) * 8); cb2 = *(const uint4*)(CBS0 + (size_t)(tid + 1024) * 8); cb3 = *(const uint4*)(CBS0 + (size_t)(tid + 1536) * 8); }
        {
            const int tid = p.tid(), lane = tid & 63, wid = tid >> 6;
            const int h = wid;
#pragma unroll
            for (int d = 0; d < 2; ++d) {
                const float A = -expf(p.in[14][d * 8 + h]), dtb = p.in[13][d * 8 + h];
                const float dt0 = softplusf(SMALL[(size_t)(rbase + t0 + 2 * lane) * 32 + d * 8 + h] + dtb), dt1 = softplusf(SMALL[(size_t)(rbase + t0 + 2 * lane + 1) * 32 + d * 8 + h] + dtb);
                const float a0 = dt0 * A, a1 = dt1 * A;
                float c0 = a0, c1 = a1; const float tot = wave_scan128(c0, c1, lane);
                csb[(h * 2 + d) * 128 + 2 * lane] = d == 0 ? c0 : tot - c0 + a0; csb[(h * 2 + d) * 128 + 2 * lane + 1] = d == 0 ? c1 : tot - c1 + a1;
                dts[(h * 2 + d) * 128 + 2 * lane] = dt0; dts[(h * 2 + d) * 128 + 2 * lane + 1] = dt1;
            }
        }
        for (int g = 0; g < 2; ++g) {
            {
                const bf16_t* CBS = (const bf16_t*)(ws + WS_XRES + SSD_CB_OFF) + ((size_t)c * 2 + g) * 16384;
                const int cg8 = tid & 15;
                bf16_t* dstb = (cg8 < 8 ? Cg + cg8 * 8 : Bg + (cg8 - 8) * 8) + (tid >> 4) * 72;
                uint4 w0 = cb0, w1 = cb1, w2 = cb2, w3 = cb3;
                if (g == 1) { w0 = *(const uint4*)(CBS + (size_t)tid * 8); w1 = *(const uint4*)(CBS + (size_t)(tid + 512) * 8); w2 = *(const uint4*)(CBS + (size_t)(tid + 1024) * 8); w3 = *(const uint4*)(CBS + (size_t)(tid + 1536) * 8); }
                *(uint4*)dstb = w0; *(uint4*)(dstb + 32 * 72) = w1; *(uint4*)(dstb + 64 * 72) = w2; *(uint4*)(dstb + 96 * 72) = w3;
            }
            __syncthreads();
            if (g == 0) TS(11);
            f32x4 G[1][8];
#pragma unroll
            for (int ni = 0; ni < 8; ++ni) G[0][ni] = (f32x4){0.f, 0.f, 0.f, 0.f};
            wave_mma<1, 8, 64, true>(G, Cg + wid * 16 * 72, 72, Bg, 72, lane);
            if (g == 0) TS(12);
            for (int hh = 0; hh < 4; ++hh) {
                const int h = g * 4 + hh;
                {
                    if (h == 0) {
                        const bf16_t* xs = (const bf16_t*)(ws + WS_Y + SSD_X_OFF) + ((size_t)c * 8) * 8192 + (size_t)(tid >> 4) * 128 + (tid & 15) * 8;
                        nx0 = *(const uint4*)xs; nx1 = *(const uint4*)(xs + 32 * 128);
                        nhp0 = *(const uint4*)(HIN + ((size_t)(c * 2 + 0) * 8) * 4096 + tid * 8); nhp1 = *(const uint4*)(HIN + ((size_t)(c * 2 + 1) * 8) * 4096 + tid * 8);
                    }
                    const uint4 hp0 = nhp0, hp1 = nhp1;
                    { bf16_t* xd = XT + (tid >> 4) * 136 + (tid & 15) * 8; *(uint4*)xd = nx0; *(uint4*)(xd + 32 * 136) = nx1; }
                    *(uint4*)(Hn + (tid >> 3) * 72 + (tid & 7) * 8) = hp0; *(uint4*)(Hn + 64 * 72 + (tid >> 3) * 72 + (tid & 7) * 8) = hp1;
                }
                __syncthreads();
                if (g == 0 && hh == 0) TS(13);
                if (h < 7) {
                    { const bf16_t* xs = (const bf16_t*)(ws + WS_Y + SSD_X_OFF) + ((size_t)c * 8 + h + 1) * 8192 + (size_t)(tid >> 4) * 128 + (tid & 15) * 8;
                      nx0 = *(const uint4*)xs; nx1 = *(const uint4*)(xs + 32 * 128); }
                    nhp0 = *(const uint4*)(HIN + ((size_t)(c * 2 + 0) * 8 + h + 1) * 4096 + tid * 8); nhp1 = *(const uint4*)(HIN + ((size_t)(c * 2 + 1) * 8 + h + 1) * 4096 + tid * 8);
                }
                uint2 zpre[4];
#pragma unroll
                for (int ni = 0; ni < 4; ++ni) zpre[ni] = *(const uint2*)(PROJ + (size_t)(rbase + t0 + trow) * 2048 + h * 64 + 16 * ni + 4 * q);
                f32x4 Y[1][4];
#pragma unroll
                for (int ni = 0; ni < 4; ++ni) Y[0][ni] = (f32x4){0.f, 0.f, 0.f, 0.f};
                for (int d = 0; d < 2; ++d) {
                    const float cst = csb[(h * 2 + d) * 128 + trow];
#pragma unroll
                    for (int ni = 0; ni < 8; ++ni) {
                        const int s0 = 16 * ni + 4 * q;
                        const float4 css = *(const float4*)(csb + (h * 2 + d) * 128 + s0), dtv = *(const float4*)(dts + (h * 2 + d) * 128 + s0);
                        const float cs4[4] = {css.x, css.y, css.z, css.w}, dt4[4] = {dtv.x, dtv.y, dtv.z, dtv.w};
                        float m[4];
#pragma unroll
                        for (int j = 0; j < 4; ++j) { const int sidx = s0 + j; const bool ok = d == 0 ? sidx <= trow : sidx >= trow; m[j] = ok ? G[0][ni][j] * __expf(cst - cs4[j]) * dt4[j] : 0.f; }
                        uint2 w; w.x = pack2(m[0], m[1]); w.y = pack2(m[2], m[3]);
                        *(uint2*)(Mb + trow * 136 + s0) = w;
                    }
                    wave_mma<1, 4, 128, true, true>(Y, Mb + wid * 16 * 136, 136, XT, 136, lane);
                    f32x4 Yo[1][4];
#pragma unroll
                    for (int ni = 0; ni < 4; ++ni) Yo[0][ni] = (f32x4){0.f, 0.f, 0.f, 0.f};
                    wave_mma<1, 4, 64, true>(Yo, Cg + wid * 16 * 72, 72, Hn + d * 64 * 72, 72, lane);
                    const float ecs = __expf(cst);
#pragma unroll
                    for (int ni = 0; ni < 4; ++ni) Y[0][ni] += Yo[0][ni] * ecs;
                    if (g == 0 && hh == 0 && d == 1) TS(14);
                }
                const float Dh = p.in[15][h];
                const size_t grow = (size_t)(rbase + t0 + trow);
#pragma unroll
                for (int ni = 0; ni < 4; ++ni) {
                    const int p0 = 16 * ni + 4 * q;
                    const uint2 zr = zpre[ni];
                    const float z4[4] = {__uint_as_float(zr.x << 16), __uint_as_float(zr.x & 0xffff0000u), __uint_as_float(zr.y << 16), __uint_as_float(zr.y & 0xffff0000u)};
                    float u[4];
#pragma unroll
                    for (int j = 0; j < 4; ++j) { const float y = Y[0][ni][j] + Dh * bf2f(XT[(p0 + j) * 136 + (trow ^ ((((p0 + j) >> 3) & 7) << 3))]); u[j] = y * siluf_r(z4[j]); ssq += u[j] * u[j]; }
                    uint2 w; w.x = pack2(u[0], u[1]); w.y = pack2(u[2], u[3]);
                    *(uint2*)(MIX + grow * 1024 + h * 64 + p0) = w;
                }
                lds_barrier();
                if (g == 0 && hh == 0) TS(15);
            }
        }
        TS(16);
        ssq += __shfl_xor(ssq, 16); ssq += __shfl_xor(ssq, 32);
        if (q == 0) csb[trow] = ssq;
        asm volatile("s_waitcnt vmcnt(0)" ::: "memory");
        __syncthreads();
        {
            const int c8 = tid & 63, rg = tid >> 6;
            const float4 n0 = *(const float4*)(p.in[16] + c8 * 8), n1 = *(const float4*)(p.in[16] + c8 * 8 + 4);
            bf16_t* mp = MIX + (size_t)(rbase + t0 + rg * 16) * 1024 + c8 * 8;
            uint4 ur[16];
#pragma unroll
            for (int k = 0; k < 16; ++k) ur[k] = *(const uint4*)(mp + (size_t)k * 1024);
#pragma unroll
            for (int k = 0; k < 16; ++k) {
                const float rs = rsqrtf(csb[rg * 16 + k] * (1.f / 512.f) + 1e-6f);
                float f[8]; unpack8(ur[k], f);
                uint4 w; w.x = pack2(f[0] * rs * n0.x, f[1] * rs * n0.y); w.y = pack2(f[2] * rs * n0.z, f[3] * rs * n0.w); w.z = pack2(f[4] * rs * n1.x, f[5] * rs * n1.y); w.w = pack2(f[6] * rs * n1.z, f[7] * rs * n1.w);
                *(uint4*)(mp + (size_t)k * 1024) = w;
            }
        }
        __syncthreads();
        TS(17);
    }
}


__device__ __forceinline__ void attn_mfma(const P& p, int bid, int nb, float* lds) {
    const int tid = p.tid(), lane = tid & 63, wid = __builtin_amdgcn_readfirstlane(tid >> 6), r = lane & 15, q = lane >> 4;
    unsigned char* ws = p.get_ws();
    const bf16_t* PROJ = (const bf16_t*)(ws + WS_PROJ);
    const bf16_t* QKR = (const bf16_t*)(ws + WS_XRES);
    bf16_t* MIX = (bf16_t*)(ws + WS_HB);
    bf16_t* Kb = (bf16_t*)lds;
    bf16_t* Vb = Kb + 2 * 64 * 72;
    for (int item = bid; item < 260; item += nb) {
        const bool isctx = item >= 256;
        const int qb = isctx ? (item - 256) >> 1 : item >> 1, g = item & 1;
        const int qrow0 = (isctx ? SEQ : 0) + qb * 128;
        const int hq = g * 4 + (wid >> 1), wrow0 = (wid & 1) * 64;
        const int ntl = isctx ? 0 : 6, nt = ntl + 4;
        bf16_t* Qw = Vb + 2 * 64 * 72 + wid * 64 * 72;
#pragma unroll
        for (int mi = 0; mi < 4; ++mi)
#pragma unroll
            for (int kk = 0; kk < 2; ++kk) {
                const uint4 raw = *(const uint4*)(QKR + (size_t)(qrow0 + wrow0 + 16 * mi + r) * 640 + hq * 64 + kk * 32 + 8 * q);
                float f[8]; unpack8(raw, f);
                uint4 o; o.x = pack2(f[0] * 0.125f, f[1] * 0.125f); o.y = pack2(f[2] * 0.125f, f[3] * 0.125f); o.z = pack2(f[4] * 0.125f, f[5] * 0.125f); o.w = pack2(f[6] * 0.125f, f[7] * 0.125f);
                *(uint4*)(Qw + (16 * mi + r) * 72 + kk * 32 + 8 * q) = o;
            }
        const float sink = p.in[19][hq];
        float m[4], l[4]; f32x4 O[4][4];
#pragma unroll
        for (int mi = 0; mi < 4; ++mi) { m[mi] = sink; l[mi] = q == 0 ? 1.f : 0.f;
#pragma unroll
            for (int ni = 0; ni < 4; ++ni) O[mi][ni] = (f32x4){0.f, 0.f, 0.f, 0.f}; }
#define ATT_VALID(ti_) ((ti_) >= ntl || (qb * 128 - 128 + 64 * (ti_) >= 0 && qb * 128 - 128 + 64 * (ti_) < SEQ))
#define ATT_KROW(ti_) ((ti_) < ntl ? qb * 128 - 128 + 64 * (ti_) : SEQ + 64 * ((ti_) - ntl))
        int ti = 0; while (ti < nt && !ATT_VALID(ti)) ++ti;
        uint4 kreg, vreg;
        { const int kr0 = ATT_KROW(ti);
          kreg = *(const uint4*)(QKR + (size_t)(kr0 + (tid >> 3)) * 640 + 512 + g * 64 + (tid & 7) * 8);
          vreg = *(const uint4*)(PROJ + (size_t)(kr0 + (tid >> 3)) * 2048 + 1920 + g * 64 + (tid & 7) * 8); }
        int cur = 0;
        __syncthreads();
        { *(uint4*)(Kb + (tid >> 3) * 72 + (tid & 7) * 8) = kreg;
          bf16_t* vd = Vb + ((tid & 7) * 8) * 72 + ((tid >> 3) ^ ((tid & 7) << 3)); const u32 vw[4] = {vreg.x, vreg.y, vreg.z, vreg.w};
#pragma unroll
          for (int j = 0; j < 4; ++j) { vd[(2 * j) * 72] = (bf16_t)(vw[j] & 0xffff); vd[(2 * j + 1) * 72] = (bf16_t)(vw[j] >> 16); } }
        __syncthreads();
        while (ti < nt) {
            int tn = ti + 1; while (tn < nt && !ATT_VALID(tn)) ++tn;
            if (tn < nt) { const int kr0 = ATT_KROW(tn);
                kreg = *(const uint4*)(QKR + (size_t)(kr0 + (tid >> 3)) * 640 + 512 + g * 64 + (tid & 7) * 8);
                vreg = *(const uint4*)(PROJ + (size_t)(kr0 + (tid >> 3)) * 2048 + 1920 + g * 64 + (tid & 7) * 8); }
            const bool local = ti < ntl;
            const bool need = !local || ((wid & 1) == 0 ? ti <= 4 : ti >= 1);
            if (need) {
                const bf16_t* Kt = Kb + cur * 64 * 72; const bf16_t* Vt = Vb + cur * 64 * 72;
                const int kp0 = qb * 128 - 128 + 64 * ti + 4 * q, qp0 = qb * 128 + wrow0 + r;
                const int dq0 = wrow0 + 128 - 64 * ti; const bool edge = local && (dq0 > 64 || dq0 < -64);
#pragma unroll
                for (int mi = 0; mi < 4; ++mi) {
                    f32x4 S[4];
#pragma unroll
                    for (int ni = 0; ni < 4; ++ni) S[ni] = (f32x4){0.f, 0.f, 0.f, 0.f};
#pragma unroll
                    for (int kk = 0; kk < 2; ++kk) {
                        const bf16x8 qfr = *(const bf16x8*)(Qw + (16 * mi + r) * 72 + kk * 32 + 8 * q);
#pragma unroll
                        for (int ni = 0; ni < 4; ++ni) {
                            const bf16x8 bfr = *(const bf16x8*)(Kt + (16 * ni + r) * 72 + kk * 32 + 8 * q);
                            S[ni] = __builtin_amdgcn_mfma_f32_16x16x32_bf16(bfr, qfr, S[ni], 0, 0, 0);
                        }
                    }
                    if (edge) {
#pragma unroll
                        for (int ni = 0; ni < 4; ++ni)
#pragma unroll
                            for (int j = 0; j < 4; ++j) { const int dlt = (qp0 + 16 * mi) - (kp0 + 16 * ni + j); if (dlt > 128 || dlt < -128) S[ni][j] = -1e30f; }
                    }
                    float mx = -1e30f;
#pragma unroll
                    for (int ni = 0; ni < 4; ++ni)
#pragma unroll
                        for (int j = 0; j < 4; ++j) mx = fmaxf(mx, S[ni][j]);
                    mx = fmaxf(mx, __shfl_xor(mx, 16)); mx = fmaxf(mx, __shfl_xor(mx, 32));
                    const float mn = fmaxf(m[mi], mx), al = __expf(m[mi] - mn);
                    m[mi] = mn;
                    float ps = 0.f;
#pragma unroll
                    for (int ni = 0; ni < 4; ++ni)
#pragma unroll
                        for (int j = 0; j < 4; ++j) { const float e = __expf(S[ni][j] - mn); S[ni][j] = e; ps += e; }
                    l[mi] = l[mi] * al + ps;
#pragma unroll
                    for (int ni = 0; ni < 4; ++ni) O[mi][ni] *= al;
                    __builtin_amdgcn_sched_barrier(0);
#pragma unroll
                    for (int kk = 0; kk < 2; ++kk) {
                        uint4 o; o.x = pack2(S[2 * kk][0], S[2 * kk][1]); o.y = pack2(S[2 * kk][2], S[2 * kk][3]);
                        o.z = pack2(S[2 * kk + 1][0], S[2 * kk + 1][1]); o.w = pack2(S[2 * kk + 1][2], S[2 * kk + 1][3]);
                        const bf16x8 pfr = *(bf16x8*)&o;
#pragma unroll
                        for (int ni = 0; ni < 4; ++ni) {
                            const int vsw = (((16 * ni + r) >> 3) & 7) << 3;
                            const uint2 v0 = *(const uint2*)(Vt + (16 * ni + r) * 72 + ((32 * kk + 4 * q) ^ vsw)), v1 = *(const uint2*)(Vt + (16 * ni + r) * 72 + ((32 * kk + 16 + 4 * q) ^ vsw));
                            uint4 vo; vo.x = v0.x; vo.y = v0.y; vo.z = v1.x; vo.w = v1.y;
                            O[mi][ni] = __builtin_amdgcn_mfma_f32_16x16x32_bf16(*(bf16x8*)&vo, pfr, O[mi][ni], 0, 0, 0);
                        }
                    }
                    __builtin_amdgcn_sched_barrier(0);
                }
            }
            if (tn < nt) {
                *(uint4*)(Kb + (cur ^ 1) * 64 * 72 + (tid >> 3) * 72 + (tid & 7) * 8) = kreg;
                bf16_t* vd = Vb + (cur ^ 1) * 64 * 72 + ((tid & 7) * 8) * 72 + ((tid >> 3) ^ ((tid & 7) << 3)); const u32 vw[4] = {vreg.x, vreg.y, vreg.z, vreg.w};
#pragma unroll
                for (int j = 0; j < 4; ++j) { vd[(2 * j) * 72] = (bf16_t)(vw[j] & 0xffff); vd[(2 * j + 1) * 72] = (bf16_t)(vw[j] >> 16); }
            }
            __syncthreads();
            ti = tn; cur ^= 1;
        }
#undef ATT_VALID
#undef ATT_KROW
#pragma unroll
        for (int mi = 0; mi < 4; ++mi) {
            float lt = l[mi]; lt += __shfl_xor(lt, 16); lt += __shfl_xor(lt, 32);
            const float inv = 1.f / lt;
            bf16_t* op = MIX + (size_t)(qrow0 + wrow0 + 16 * mi + r) * 1024 + 512 + hq * 64 + 4 * q;
#pragma unroll
            for (int ni = 0; ni < 4; ++ni) { uint2 w; w.x = pack2(O[mi][ni][0] * inv, O[mi][ni][1] * inv); w.y = pack2(O[mi][ni][2] * inv, O[mi][ni][3] * inv); *(uint2*)(op + 16 * ni) = w; }
        }
    }
}


constexpr size_t ML_ST_OFF = 0;
constexpr size_t ML_CIN_OFF = (size_t)130 * 16 * 8192 * 2;
constexpr int CH_DEC = 0, CH_BL = 4096, CH_AC = 8192, CH_MIN = 12288, CH_NC = 16384, CH_NIN = 16384 + 130 * 16 * 64;
__device__ __forceinline__ void stage_convw_part(const float* cw, const float* cb, int C, int c0, int n, float* cwl, int tid) {
    for (int i = tid; i < n; i += NTH) *(float4*)(cwl + i * 4) = make_float4(cw[c0 + i], cw[C + c0 + i], cw[2 * C + c0 + i], cb[c0 + i]);
}
__device__ __forceinline__ void ml_states(const P& p, int bid, int nb, float* lds) {
    const int tid = p.tid(), lane = tid & 63, wid = tid >> 6, r = lane & 15, q = lane >> 4;
    unsigned char* ws = p.get_ws();
    const bf16_t* PROJ = (const bf16_t*)(ws + WS_PROJ);
    const float* SMALL = (const float*)(ws + WS_SMALL);
    bf16_t* ST = (bf16_t*)(ws + WS_Y + ML_ST_OFF);
    float* CHK = (float*)(ws + WS_CHK);
    float* cwl = lds;
    bf16_t* VT = (bf16_t*)(lds + 384 * 4);
    bf16_t* KT = VT + 2 * 128 * 136;
    float* es = (float*)(KT + 2 * 64 * 136);
    for (int item = bid; item < 520; item += nb) {
        const int c = item >> 2, hp = item & 3;
        const int L = c < 128 ? SEQ : CTX, t0 = c < 128 ? c * 128 : (c - 128) * 128, rbase = c < 128 ? 0 : SEQ;
        if (tid < 384) { const int ch = tid < 128 ? 512 + hp * 128 + tid : 1024 + hp * 256 + (tid - 128);
            const float* cw = p.in[22]; *(float4*)(cwl + tid * 4) = make_float4(cw[ch], cw[2048 + ch], cw[4096 + ch], p.in[23][ch]); }
        const int hl = wid >> 2, d = (wid >> 1) & 1, vh = wid & 1, h = hp * 2 + hl, dh = d * 8 + h;
        const float igb = p.in[24][dh], fgb = p.in[25][dh];
        const float* sm0 = SMALL + (size_t)(rbase + t0 + 2 * lane) * 32;
        const float gi0 = sm0[dh], gi1 = sm0[32 + dh], gf0 = sm0[16 + dh], gf1 = sm0[32 + 16 + dh];
        __syncthreads();
#pragma unroll 1
        for (int b4 = 0; b4 < 3; ++b4) {
            Raw3 rw[4];
#pragma unroll
            for (int k = 0; k < 4; ++k) { const int i = tid + (b4 * 4 + k) * NTH; const int cg8 = (i >> 3) % 48, tl = (i / 384) * 8 + (i & 7);
                const int col = cg8 < 16 ? 512 + hp * 128 + cg8 * 8 : 1024 + hp * 256 + (cg8 - 16) * 8;
                rw[k] = conv8_load(PROJ + (size_t)(rbase + t0 + tl) * 3072 + col, 3072, t0 + tl, L); }
#pragma unroll
            for (int k = 0; k < 4; ++k) { const int i = tid + (b4 * 4 + k) * NTH; const int cg8 = (i >> 3) % 48, tl = (i / 384) * 8 + (i & 7);
                float o[8]; conv8_apply(rw[k], cwl + cg8 * 32, o);
                const float sc = cg8 < 16 ? 0.125f : 1.f;
                const int tls = tl ^ ((cg8 & 7) << 3);
                bf16_t* dst = cg8 < 16 ? KT + (cg8 * 8) * 136 + tls : VT + ((cg8 - 16) * 8) * 136 + tls;
#pragma unroll
                for (int j = 0; j < 8; ++j) dst[j * 136] = f2bf(o[j] * sc); }
        }
        float tot, ac;
        {
            const float ig0 = gi0 + igb, ig1 = gi1 + igb, lf0 = logsigf(gf0 + fgb), lf1 = logsigf(gf1 + fgb);
            float c0 = lf0, c1 = lf1; tot = wave_scan128(c0, c1, lane);
            const float w0 = (d == 0 ? tot - c0 : c0 - lf0) + ig0, w1 = (d == 0 ? tot - c1 : c1 - lf1) + ig1;
            ac = fmaxf(w0, w1);
#pragma unroll
            for (int o = 32; o >= 1; o >>= 1) ac = fmaxf(ac, __shfl_xor(ac, o));
            es[wid * 128 + 2 * lane] = __expf(w0 - ac); es[wid * 128 + 2 * lane + 1] = __expf(w1 - ac);
        }
        __syncthreads();
        if (c < 128) {
            bf16_t* VTS = (bf16_t*)(ws + WS_VTS) + ((size_t)c * 8 + hp * 2) * 16384;
#pragma unroll
            for (int k = 0; k < 8; ++k) { const int i = tid + k * NTH; const int row = i >> 4, pc = i & 15;
                *(uint4*)(VTS + (size_t)row * 128 + pc * 8) = *(const uint4*)(VT + row * 136 + pc * 8); }
        }
        {
            f32x4 acc[4][4];
#pragma unroll
            for (int mi = 0; mi < 4; ++mi)
#pragma unroll
                for (int ni = 0; ni < 4; ++ni) acc[mi][ni] = (f32x4){0.f, 0.f, 0.f, 0.f};
            const bf16_t* Ab = VT + (hl * 128 + vh * 64) * 136; const bf16_t* Bb = KT + (hl * 64) * 136;
#pragma unroll
            for (int kk = 0; kk < 128; kk += 32) {
                const float4 wa = *(const float4*)(es + wid * 128 + kk + 8 * q), wb = *(const float4*)(es + wid * 128 + kk + 8 * q + 4);
                bf16x8 a[4], b[4];
#pragma unroll
                for (int mi = 0; mi < 4; ++mi) a[mi] = *(const bf16x8*)(Ab + (16 * mi + r) * 136 + ((kk + 8 * q) ^ ((((16 * mi + r) >> 3) & 7) << 3)));
#pragma unroll
                for (int ni = 0; ni < 4; ++ni) {
                    const uint4 raw = *(const uint4*)(Bb + (16 * ni + r) * 136 + ((kk + 8 * q) ^ ((((16 * ni + r) >> 3) & 7) << 3)));
                    float f[8]; unpack8(raw, f);
                    uint4 o; o.x = pack2(f[0] * wa.x, f[1] * wa.y); o.y = pack2(f[2] * wa.z, f[3] * wa.w); o.z = pack2(f[4] * wb.x, f[5] * wb.y); o.w = pack2(f[6] * wb.z, f[7] * wb.w);
                    b[ni] = *(bf16x8*)&o;
                }
#pragma unroll
                for (int mi = 0; mi < 4; ++mi)
#pragma unroll
                    for (int ni = 0; ni < 4; ++ni) acc[mi][ni] = __builtin_amdgcn_mfma_f32_16x16x32_bf16(b[ni], a[mi], acc[mi][ni], 0, 0, 0);
                __builtin_amdgcn_sched_barrier(0);
            }
            bf16_t* Sp = ST + ((size_t)c * 16 + dh) * 8192 + (vh * 64) * 64;
#pragma unroll
            for (int mi = 0; mi < 4; ++mi)
#pragma unroll
                for (int ni = 0; ni < 4; ++ni) { uint2 w; w.x = pack2(acc[mi][ni][0], acc[mi][ni][1]); w.y = pack2(acc[mi][ni][2], acc[mi][ni][3]); *(uint2*)(Sp + (16 * mi + r) * 64 + 16 * ni + 4 * q) = w; }
            if (vh == 0) {
                float nsum = 0.f; const bf16_t* kr = Bb + lane * 136;
#pragma unroll 4
                for (int s8 = 0; s8 < 128; s8 += 8) { float f[8]; unpack8(*(const uint4*)(kr + (s8 ^ (((lane >> 3) & 7) << 3))), f);
#pragma unroll
                    for (int j = 0; j < 8; ++j) nsum += f[j] * es[wid * 128 + s8 + j]; }
                CHK[CH_NC + (c * 16 + dh) * 64 + lane] = nsum;
                if (lane == 0) { CHK[CH_BL + c * 16 + dh] = tot; CHK[CH_AC + c * 16 + dh] = ac; }
            }
        }
        __syncthreads();
    }
}
__device__ __forceinline__ void ml_scan(const P& p, int bid, int nb) {
    const int tid = p.tid();
    unsigned char* ws = p.get_ws();
    const bf16_t* ST = (const bf16_t*)(ws + WS_Y + ML_ST_OFF);
    bf16_t* CIN = (bf16_t*)(ws + WS_Y + ML_CIN_OFF);
    float* CHK = (float*)(ws + WS_CHK);
    if (tid < 128) {
        for (int gid = bid * 128 + tid; gid < 32768; gid += nb * 128) {
            const int dh = gid >> 11, d = dh >> 3, e = (gid & 2047) * 4;
            float C0 = 0.f, C1 = 0.f, C2 = 0.f, C3 = 0.f, m = 0.f;
#pragma unroll 1
            for (int i0 = 0; i0 < 130; i0 += 26) {
                uint2 sv[26]; float bl[26], av[26]; int cc[26];
#pragma unroll
                for (int j = 0; j < 26; ++j) {
                    const int i = i0 + j;
                    const int c = d == 0 ? (i < 2 ? 128 + i : i - 2) : 129 - i;
                    cc[j] = c; sv[j] = *(const uint2*)(ST + ((size_t)c * 16 + dh) * 8192 + e); bl[j] = CHK[CH_BL + c * 16 + dh]; av[j] = CHK[CH_AC + c * 16 + dh];
                }
#pragma unroll
                for (int j = 0; j < 26; ++j) {
                    uint2 o; o.x = pack2(C0, C1); o.y = pack2(C2, C3);
                    *(uint2*)(CIN + ((size_t)cc[j] * 16 + dh) * 8192 + e) = o;
                    const float mn = fmaxf(bl[j] + m, av[j]);
                    const float sp = __expf(bl[j] + m - mn), sc = __expf(av[j] - mn);
                    C0 = sp * C0 + sc * __uint_as_float(sv[j].x << 16); C1 = sp * C1 + sc * __uint_as_float(sv[j].x & 0xffff0000u);
                    C2 = sp * C2 + sc * __uint_as_float(sv[j].y << 16); C3 = sp * C3 + sc * __uint_as_float(sv[j].y & 0xffff0000u);
                    m = mn;
                }
            }
        }
    } else if (tid < 192) {
        for (int gid = bid * 64 + (tid - 128); gid < 1024; gid += nb * 64) {
            const int dh = gid >> 6, d = dh >> 3, e = gid & 63;
            float n = 0.f, m = 0.f;
#pragma unroll 1
            for (int i0 = 0; i0 < 130; i0 += 26) {
                float nv[26], bl[26], av[26]; int cc[26];
#pragma unroll
                for (int j = 0; j < 26; ++j) {
                    const int i = i0 + j;
                    const int c = d == 0 ? (i < 2 ? 128 + i : i - 2) : 129 - i;
                    cc[j] = c; nv[j] = CHK[CH_NC + (c * 16 + dh) * 64 + e]; bl[j] = CHK[CH_BL + c * 16 + dh]; av[j] = CHK[CH_AC + c * 16 + dh];
                }
#pragma unroll
                for (int j = 0; j < 26; ++j) {
                    CHK[CH_NIN + (cc[j] * 16 + dh) * 64 + e] = n;
                    if (e == 0) CHK[CH_MIN + cc[j] * 16 + dh] = m;
                    const float mn = fmaxf(bl[j] + m, av[j]);
                    const float sp = __expf(bl[j] + m - mn), sc = __expf(av[j] - mn);
                    n = sp * n + sc * nv[j]; m = mn;
                }
            }
        }
    }
}
__device__ __forceinline__ void ml_out(const P& p, int bid, int nb, float* lds) {
    unsigned char* tsbase = (unsigned char*)lds + LDS_BYTES - 128; (void)tsbase;
    const int tid = p.tid(), lane = tid & 63, wid = tid >> 6, r = lane & 15, q = lane >> 4;
    unsigned char* ws = p.get_ws();
    const bf16_t* PROJ = (const bf16_t*)(ws + WS_PROJ);
    const float* SMALL = (const float*)(ws + WS_SMALL);
    const bf16_t* CIN = (const bf16_t*)(ws + WS_Y + ML_CIN_OFF);
    const float* CHK = (const float*)(ws + WS_CHK);
    bf16_t* MIX = (bf16_t*)(ws + WS_HB);
    float* cwl = lds;
    bf16_t* Qs = (bf16_t*)(lds + 256 * 4);
    bf16_t* Ks = Qs + 128 * 72;
    bf16_t* VT = Ks + 128 * 72;
    bf16_t* Wb = VT + 128 * 136;
    bf16_t* Ct = Wb + 128 * 136;
    float* bet = (float*)(Ct + 2 * 128 * 72);
    float* igs = bet + 8 * 128;
    float* nin = igs + 8 * 128;
    float* mins = nin + 8 * 64;
    for (int itr = bid; itr < 256; itr += nb) {
        const int item = xcd_item128(itr, nb);
        const int c = item >> 1, hg = item & 1;
        const int t0 = c * 128;
        const int trow = wid * 16 + r;
        const size_t grow = (size_t)(t0 + trow);
        __syncthreads();
        {
            const int tid = p.tid(), lane = tid & 63, wid = tid >> 6;
            const int d = wid & 1, dh = d * 8 + hg * 4 + (wid >> 1), cb8 = wid;
            const float igb = p.in[24][dh], fgb = p.in[25][dh];
            const float* sm0 = SMALL + (size_t)(t0 + 2 * lane) * 32;
            const float ig0 = sm0[dh] + igb, ig1 = sm0[32 + dh] + igb, lf0 = logsigf(sm0[16 + dh] + fgb), lf1 = logsigf(sm0[32 + 16 + dh] + fgb);
            float c0 = lf0, c1 = lf1; const float tot = wave_scan128(c0, c1, lane);
            bet[cb8 * 128 + 2 * lane] = d == 0 ? c0 : tot - c0 + lf0; bet[cb8 * 128 + 2 * lane + 1] = d == 0 ? c1 : tot - c1 + lf1;
            igs[cb8 * 128 + 2 * lane] = ig0; igs[cb8 * 128 + 2 * lane + 1] = ig1;
            nin[cb8 * 64 + lane] = CHK[CH_NIN + (c * 16 + dh) * 64 + lane];
            if (lane == 0) mins[cb8] = CHK[CH_MIN + c * 16 + dh];
        }
        for (int hh = 0; hh < 4; ++hh) {
            const int h = hg * 4 + hh;
            const int tid = p.tid(), lane = tid & 63, wid = tid >> 6, r = lane & 15, q = lane >> 4;
            const int trow = wid * 16 + r;
            const size_t grow = (size_t)(t0 + trow);
            if (hh == 0) TS(0);
            if (hh == 1) TS(5);
            ConvW cwr;
            { const int cg8 = tid & 15; const int chb = cg8 < 8 ? h * 64 + cg8 * 8 : 512 + h * 64 + (cg8 - 8) * 8; const float* cw = p.in[22] + chb; const float* cb = p.in[23] + chb;
              cwr.w0a = *(const float4*)cw; cwr.w0b = *(const float4*)(cw + 4); cwr.w1a = *(const float4*)(cw + 2048); cwr.w1b = *(const float4*)(cw + 2048 + 4);
              cwr.w2a = *(const float4*)(cw + 4096); cwr.w2b = *(const float4*)(cw + 4096 + 4); cwr.ba = *(const float4*)cb; cwr.bb = *(const float4*)(cb + 4); }
            const bf16_t* cp0 = CIN + ((size_t)c * 16 + h) * 8192 + tid * 16; const bf16_t* cp1 = cp0 + (size_t)8 * 8192;
            const uint4 c00 = *(const uint4*)cp0, c01 = *(const uint4*)(cp0 + 8), c10 = *(const uint4*)cp1, c11 = *(const uint4*)(cp1 + 8);
            Raw3 rq[4];
#pragma unroll
            for (int k = 0; k < 4; ++k) { const int i = tid + k * NTH; const int cg8 = i & 15, tl = i >> 4;
                rq[k] = conv8_load(PROJ + (size_t)(t0 + tl) * 3072 + (cg8 < 8 ? h * 64 + cg8 * 8 : 512 + h * 64 + (cg8 - 8) * 8), 3072, t0 + tl, SEQ); }
            const bf16_t* VTS = (const bf16_t*)(ws + WS_VTS) + ((size_t)c * 8 + h) * 16384;
            const uint4 rv0 = *(const uint4*)(VTS + (size_t)((tid + 0 * NTH) >> 4) * 128 + (tid & 15) * 8), rv1 = *(const uint4*)(VTS + (size_t)((tid + 1 * NTH) >> 4) * 128 + (tid & 15) * 8),
                        rv2 = *(const uint4*)(VTS + (size_t)((tid + 2 * NTH) >> 4) * 128 + (tid & 15) * 8), rv3 = *(const uint4*)(VTS + (size_t)((tid + 3 * NTH) >> 4) * 128 + (tid & 15) * 8);
            if (hh == 0) TS(6);
            __syncthreads();
            if (hh == 0) TS(7);
#pragma unroll
            for (int k = 0; k < 4; ++k) {
                const int i = tid + k * NTH; const int cg8 = i & 15, tl = i >> 4;
                float o[8]; conv8_apply_r(rq[k], cwr, o);
                const float sc = cg8 < 8 ? 1.f : 0.125f;
                uint4 w; w.x = pack2(o[0] * sc, o[1] * sc); w.y = pack2(o[2] * sc, o[3] * sc); w.z = pack2(o[4] * sc, o[5] * sc); w.w = pack2(o[6] * sc, o[7] * sc);
                *(uint4*)((cg8 < 8 ? Qs + cg8 * 8 : Ks + (cg8 - 8) * 8) + tl * 72) = w;
            }
            if (hh == 0) TS(8);
            { bf16_t* vd = VT + (tid >> 4) * 136 + (tid & 15) * 8;
              *(uint4*)vd = rv0; *(uint4*)(vd + 32 * 136) = rv1; *(uint4*)(vd + 64 * 136) = rv2; *(uint4*)(vd + 96 * 136) = rv3; }
            if (hh == 0) TS(9);
            { bf16_t* cd = Ct + (tid >> 2) * 72 + (tid & 3) * 16; *(uint4*)cd = c00; *(uint4*)(cd + 8) = c01; *(uint4*)(cd + 128 * 72) = c10; *(uint4*)(cd + 128 * 72 + 8) = c11; }
            __syncthreads();
            if (hh == 0) TS(1);
            f32x4 QK[1][8];
#pragma unroll
            for (int ni = 0; ni < 8; ++ni) QK[0][ni] = (f32x4){0.f, 0.f, 0.f, 0.f};
            wave_mma<1, 8, 64, true>(QK, Qs + wid * 16 * 72, 72, Ks, 72, lane);
            if (hh == 0) TS(2);
            uint2 orw[8];
#pragma unroll
            for (int ni = 0; ni < 8; ++ni) orw[ni] = *(const uint2*)(PROJ + grow * 3072 + 2048 + h * 128 + 16 * ni + 4 * q);
            f32x4 Hs[8];
#pragma unroll
            for (int ni = 0; ni < 8; ++ni) Hs[ni] = (f32x4){0.f, 0.f, 0.f, 0.f};
            for (int dq = 0; dq < 2 + EXP_ML_D; ++dq) {
                const int d = dq & 1; const bool discard = dq >= 2;
                const int dh = d * 8 + h;
                const float bt = bet[(hh * 2 + d) * 128 + trow], g = bt + mins[hh * 2 + d];
                const int wu = __builtin_amdgcn_readfirstlane(wid);
                float dl[32]; float mx = -1e30f;
#pragma unroll
                for (int ni = 0; ni < 8; ++ni) {
                    if (d == 0 ? ni <= wu : ni >= wu) {
                        const int s0 = 16 * ni + 4 * q;
                        const float4 bs = *(const float4*)(bet + (hh * 2 + d) * 128 + s0), iv = *(const float4*)(igs + (hh * 2 + d) * 128 + s0);
                        const float b4[4] = {bs.x, bs.y, bs.z, bs.w}, i4[4] = {iv.x, iv.y, iv.z, iv.w};
#pragma unroll
                        for (int j = 0; j < 4; ++j) { const int sidx = s0 + j; const bool ok = d == 0 ? sidx <= trow : sidx >= trow; const float v = ok ? bt - b4[j] + i4[j] : -1e30f; dl[ni * 4 + j] = v; mx = fmaxf(mx, v); }
                    } else {
#pragma unroll
                        for (int j = 0; j < 4; ++j) dl[ni * 4 + j] = -1e30f;
                    }
                }
                mx = fmaxf(mx, __shfl_xor(mx, 16)); mx = fmaxf(mx, __shfl_xor(mx, 32));
                const float ms = fmaxf(g, mx);
                float rsum = 0.f;
#pragma unroll
                for (int ni = 0; ni < 8; ++ni) {
                    uint2 w = make_uint2(0u, 0u);
                    if (d == 0 ? ni <= wu : ni >= wu) {
                        float w4[4];
#pragma unroll
                        for (int j = 0; j < 4; ++j) { w4[j] = dl[ni * 4 + j] > -1e29f ? __expf(dl[ni * 4 + j] - ms) * QK[0][ni][j] : 0.f; rsum += w4[j]; }
                        w.x = pack2(w4[0], w4[1]); w.y = pack2(w4[2], w4[3]);
                    }
                    *(uint2*)(Wb + trow * 136 + 16 * ni + 4 * q) = w;
                }
                rsum += __shfl_xor(rsum, 16); rsum += __shfl_xor(rsum, 32);
                f32x4 Nm[1][8], Ni[1][8];
#pragma unroll
                for (int ni = 0; ni < 8; ++ni) { Nm[0][ni] = (f32x4){0.f, 0.f, 0.f, 0.f}; Ni[0][ni] = (f32x4){0.f, 0.f, 0.f, 0.f}; }
                {
                    const int wh = wu >> 1;
#pragma unroll
                    for (int kk = 0; kk < 4; ++kk) {
                        if (d == 0 ? kk <= wh : kk >= wh) {
                            const bf16x8 a = *(const bf16x8*)(Wb + (wid * 16 + r) * 136 + 32 * kk + 8 * q);
#pragma unroll
                            for (int ni = 0; ni < 8; ++ni) {
                                const bf16x8 b = *(const bf16x8*)(VT + (16 * ni + r) * 136 + ((32 * kk + 8 * q) ^ ((((16 * ni + r) >> 3) & 7) << 3)));
                                Nm[0][ni] = __builtin_amdgcn_mfma_f32_16x16x32_bf16(b, a, Nm[0][ni], 0, 0, 0);
                            }
                        }
                    }
                }
                wave_mma<1, 8, 64, true>(Ni, Qs + wid * 16 * 72, 72, Ct + d * 128 * 72, 72, lane);
                float qn = 0.f;
                { float f[8]; unpack8(*(const uint4*)(Qs + trow * 72 + 16 * q), f);
#pragma unroll
                  for (int j = 0; j < 8; ++j) qn += f[j] * nin[(hh * 2 + d) * 64 + 16 * q + j];
                  unpack8(*(const uint4*)(Qs + trow * 72 + 16 * q + 8), f);
#pragma unroll
                  for (int j = 0; j < 8; ++j) qn += f[j] * nin[(hh * 2 + d) * 64 + 16 * q + 8 + j]; }
                qn += __shfl_xor(qn, 16); qn += __shfl_xor(qn, 32);
                const float ei = __expf(g - ms);
                const float den = rsum + qn * ei;
                const float inv = 1.f / fmaxf(fabsf(den), __expf(-ms));
#pragma unroll
                for (int ni = 0; ni < 8; ++ni) Hs[ni] += (Nm[0][ni] + Ni[0][ni] * ei) * (discard ? 0.f : inv);
            }
            if (hh == 0) TS(3);
            float ssq = 0.f;
#pragma unroll
            for (int ni = 0; ni < 8; ++ni)
#pragma unroll
                for (int j = 0; j < 4; ++j) ssq += Hs[ni][j] * Hs[ni][j];
            ssq += __shfl_xor(ssq, 16); ssq += __shfl_xor(ssq, 32);
            const float rs = rsqrtf(ssq * (1.f / 128.f) + 1e-6f);
#pragma unroll
            for (int ni = 0; ni < 8; ++ni) {
                const int col = h * 128 + 16 * ni + 4 * q;
                const float4 nw = *(const float4*)(p.in[26] + col);
                uint2 w; w.x = pack2(Hs[ni][0] * rs * nw.x * sigmf_r(__uint_as_float(orw[ni].x << 16)), Hs[ni][1] * rs * nw.y * sigmf_r(__uint_as_float(orw[ni].x & 0xffff0000u)));
                w.y = pack2(Hs[ni][2] * rs * nw.z * sigmf_r(__uint_as_float(orw[ni].y << 16)), Hs[ni][3] * rs * nw.w * sigmf_r(__uint_as_float(orw[ni].y & 0xffff0000u)));
                *(uint2*)(MIX + grow * 1024 + col) = w;
            }
            lds_barrier();
        }
    }
}


#define XB_TMO      128
#define XB_XCNT(j)  (256  + 64 * (j))
#define XB_XSUB(j)  (1280 + 64 * (j))
#define XB_XGEN(j)  (2304 + 64 * (j))
#define XB_TOP      3328
#define XB_TOPGEN   3392
#define XCD_BAR_WORDS 3456
#define XB_SPIN_CAP (1u << 22)
#define XLAS __attribute__((address_space(3)))
__device__ __forceinline__ unsigned xb_ld(unsigned* p) { return __hip_atomic_load(p, __ATOMIC_RELAXED, __HIP_MEMORY_SCOPE_AGENT); }
__device__ __forceinline__ unsigned xb_add(unsigned* p, unsigned v) { return __hip_atomic_fetch_add(p, v, __ATOMIC_RELAXED, __HIP_MEMORY_SCOPE_AGENT); }
__device__ __forceinline__ unsigned xb_xcc_id() { return (unsigned)__builtin_amdgcn_s_getreg((3 << 11) | 20) & 0xFu; }
#define XB_SPIN(cond, bar) do { unsigned _sp = 0; while (cond) { __builtin_amdgcn_s_sleep(1); \
    if ((++_sp & 255u) == 0u) { if (xb_ld(&(bar)[XB_TMO])) break; if (_sp > XB_SPIN_CAP) { atomicAdd(&(bar)[XB_TMO], 1u); break; } } } } while (0)
struct XcdBarrier { unsigned* bar; unsigned x; volatile XLAS unsigned* st; };
__device__ __forceinline__ XcdBarrier xcd_barrier_post(unsigned* bar, volatile XLAS unsigned* st, int tid) {
    XcdBarrier b; b.bar = bar; b.x = xb_xcc_id(); b.st = st;
    if (tid == 0) (void)xb_add(&bar[XB_XCNT(b.x)], 1u);
    return b;
}
__device__ __forceinline__ void xcd_barrier_complete(unsigned* bar, unsigned x, unsigned& nloc, unsigned& nx) {
    const unsigned G = gridDim.x * gridDim.y * gridDim.z;
    unsigned sum, cnt, mine, sp = 0u;
    for (;;) {
        sum = 0u; cnt = 0u;
#pragma unroll 1
        for (unsigned j = 0; j < 16; ++j) { const unsigned c = xb_ld(&bar[XB_XCNT(j)]); sum += c; cnt += (c > 0u) ? 1u : 0u; }
        mine = xb_ld(&bar[XB_XCNT(x)]);
        if (sum == G) break;
        __builtin_amdgcn_s_sleep(1);
        if ((++sp & 255u) == 0u) { if (xb_ld(&bar[XB_TMO])) break; if (sp > XB_SPIN_CAP) { atomicAdd(&bar[XB_TMO], 1u); break; } }
    }
    nloc = mine > 0u ? mine : 1u; nx = cnt > 0u ? cnt : 1u;
}
__device__ __forceinline__ void xcd_barrier(const XcdBarrier& b, int tid) {
    asm volatile("s_waitcnt vmcnt(0)" ::: "memory");
    __syncthreads();
    if (tid == 0) {
        unsigned* bar = b.bar; asm volatile("" : "+s"(bar));
        __builtin_amdgcn_s_waitcnt(0);
        unsigned nloc = b.st[0], nx = b.st[1];
        if (nloc == 0u) { xcd_barrier_complete(bar, b.x, nloc, nx); b.st[0] = nloc; b.st[1] = nx; }
        const unsigned old = xb_add(&bar[XB_XSUB(b.x)], 1u);
        const unsigned gen = old / nloc;
        if (old + 1u == (gen + 1u) * nloc) {
            __builtin_amdgcn_fence(__ATOMIC_RELEASE, "agent");
            asm volatile("s_waitcnt vmcnt(0)" ::: "memory");
            const unsigned og = xb_add(&bar[XB_TOP], 1u);
            const unsigned tg = og / nx;
            if (og + 1u == (tg + 1u) * nx) xb_add(&bar[XB_TOPGEN], 1u);
            else XB_SPIN(xb_ld(&bar[XB_TOPGEN]) == tg, bar);
            __builtin_amdgcn_fence(__ATOMIC_ACQUIRE, "agent");
            xb_add(&bar[XB_XGEN(b.x)], 1u);
            asm volatile("s_waitcnt vmcnt(0)" ::: "memory");
        } else {
            XB_SPIN(xb_ld(&bar[XB_XGEN(b.x)]) == gen, bar);
            __builtin_amdgcn_fence(__ATOMIC_ACQUIRE, "agent");
            asm volatile("s_waitcnt vmcnt(0)" ::: "memory");
        }
    }
    __syncthreads();
}

#define GSYNC() grid.sync()
__global__ void __launch_bounds__(NTH, 2) fwd_kernel(PK pk) {
    P p; p.wv = __builtin_amdgcn_readfirstlane((int)(threadIdx.x >> 6));
    extern __shared__ __attribute__((aligned(16))) unsigned char smem[];
    float* lds = (float*)smem;
    G8_LAS unsigned char* ldsa = (G8_LAS unsigned char*)smem;
    volatile XLAS unsigned* xst = (volatile XLAS unsigned*)((XLAS unsigned char*)smem + LDS_BYTES - 16);
    { const int t0 = p.tid(); if (t0 < 4) xst[t0] = 0u; }
    __syncthreads();
#if TIMED_PH >= 0 || DELAY_PH >= 0
    if (p.tid() == 0) xst[2] = (unsigned)__builtin_amdgcn_s_memrealtime();
#endif
    const XcdBarrier xbar = xcd_barrier_post((unsigned*)(p.get_ws() + WS_CTL) + CW_BAR, xst, p.tid());
    int nph = NPH_RUN; asm volatile("" : "+s"(nph));
    unsigned repmask = REPEAT_MASK; asm volatile("" : "+s"(repmask));
#pragma unroll 1
    for (int pq = 0; pq < 2 * nph; ++pq) {
        const int ph = pq >> 1;
        if ((pq & 1) && !((repmask >> ph) & 1u)) continue;
        unsigned char* ws = p.get_ws();
        const float* MODS = (const float*)(ws + WS_MODS);
        int nb = (int)gridDim.x, bid = (int)blockIdx.x; asm volatile("" : "+s"(nb), "+s"(bid));
        switch (ph) {
        case 0: {
            phase_mods(p, bid, nb, lds);
            conv_dense(p, bid, nb, lds);
        } break;
        case 1: {
            { Rows2Args a{}; a.layer = 0; a.src = 0; a.nrows = MT; a.pB = (const bf16_t*)(ws + WS_WIN0) + (size_t)2048 * 1024; a.pcols = 16; phase_rows2(p, bid, nb, lds, a); }
        } break;
        case 2: {
            { g8::Order S; S.init(SEQ / 256, 2048 / 256, nb, bid); EpiProj ef{(bf16_t*)(ws + WS_PROJ), 2048, 2048, 16, (float*)(ws + WS_SMALL), 0};
              g8::gemm8(p.tid(), ldsa, (const bf16_t*)(ws + WS_HB), 1024, RowPlain{}, S, BSelOne{(const char*)(ws + WS_WIN0)}, ef);
              mini_gemm<2>(p, bid, nb, lds, (const bf16_t*)(ws + WS_HB), (const bf16_t*)(ws + WS_WIN0), SEQ, CTX / 64, 0, 2048 / 32, ef);
 }
        } break;
        case 3: {
            { unsigned* qctr = (unsigned*)(ws + WS_CTL) + CW_Q3; volatile XLAS unsigned* qslot = xst - 4;
              const bool st = nb == 256;
              for (int rnd = 0;; ++rnd) {
                  int it;
                  if (st && rnd == 0) { const int x = bid & 7, r = bid >> 3; it = 40 + (((((x << 4) | (r >> 1)) << 1) | (r & 1))); }
                  else {
                      __syncthreads();
                      if (p.tid() == 0) qslot[0] = atomicAdd(qctr, 1u);
                      __syncthreads();
                      it = (int)qslot[0];
                      if (st && it >= 40) it += 256;
                  }
                  if (it >= 560) break;
                  if (it < 40) mods_item_wide(p, it, lds); else if (it < 300) ssd_states(p, it - 40, 1 << 20, lds); else phase_qkprep(p, it - 300, 1 << 20, lds);
              } }
        } break;
        case 4: {
            ssd_scan(p, bid, nb);
            { unsigned* qctr = (unsigned*)(ws + WS_CTL) + CW_Q4; volatile XLAS unsigned* qslot = xst - 4;
              for (int rnd = 0;; ++rnd) {
                  int it;
                  if (nb == 256) it = rnd == 0 ? xcd_item128(bid, nb) : 256;
                  else { __syncthreads(); if (p.tid() == 0) qslot[0] = atomicAdd(qctr, 1u); __syncthreads(); it = (int)qslot[0]; }
                  if (it >= 256) break;
                  attn_mfma(p, it, 1 << 20, lds);
              } }
        } break;
        case 5: {
            { unsigned* qctr = (unsigned*)(ws + WS_CTL) + CW_Q5; volatile XLAS unsigned* qslot = xst - 4;
              for (;;) {
                  __syncthreads();
                  if (p.tid() == 0) qslot[0] = atomicAdd(qctr, 1u);
                  __syncthreads();
                  const int it = (int)qslot[0];
                  if (it >= 134 + 384) break;
                  if (it < 130) ssd_out(p, it, 1 << 20, lds); else if (it < 134) attn_mfma(p, 256 + it - 130, 1 << 20, lds); else conv_moe_chunk(p, it - 134, lds, 0);
              } }
        } break;
        case 6: {
            { g8::Order S; S.init(SEQ / 256, 4, nb, bid);
              EpiResidT<true> ef{p.in[0], p.in[2], (bf16_t*)(ws + WS_XRES), MODS + (0 * 2 + 0) * 6144 + 2048, MODS + (0 * 2 + 1) * 6144 + 2048};
              g8::gemm8(p.tid(), ldsa, (const bf16_t*)(ws + WS_HB), 1024, RowPlain{}, S, BSelOne{(const char*)(ws + WS_WOUT0)}, ef);
              mini_gemm<2>(p, bid, nb, lds, (const bf16_t*)(ws + WS_HB), (const bf16_t*)(ws + WS_WOUT0), SEQ, CTX / 64, 0, 1024 / 32, ef); }
        } break;
        case 7: {
            phase_route(p, bid, nb, lds, 0, MT);
        } break;
        case 8: {
            phase_moe_fused(p, bid, nb, ldsa, lds, 0);
            { unsigned* qctr = (unsigned*)(ws + WS_CTL) + CW_Q8; volatile XLAS unsigned* qslot = xst - 4;
              for (;;) {
                  __syncthreads();
                  if (p.tid() == 0) qslot[0] = atomicAdd(qctr, 1u);
                  __syncthreads();
                  const int it = (int)qslot[0];
                  if (it >= 68) break;
                  conv_dense1_chunk(p, it);
              } }
        } break;
        case 9: {
            { Rows2Args a{}; a.layer = 1; a.src = 1; a.combine = 1; a.clayer = 0; a.nrows = MT; a.pB = (const bf16_t*)(ws + WS_WIN1) + (size_t)3072 * 1024; a.pcols = 32; phase_rows2(p, bid, nb, lds, a); }
        } break;
        case 10: {
            { g8::Order S; S.init(SEQ / 256, 3072 / 256, nb, bid); EpiProj ef{(bf16_t*)(ws + WS_PROJ), 3072, 3072, 32, (float*)(ws + WS_SMALL), EXP_NOST ? !(pq & 1) : 0};
              g8::gemm8(p.tid(), ldsa, (const bf16_t*)(ws + WS_HB), 1024, RowPlain{}, S, BSelOne{(const char*)(ws + WS_WIN1)}, ef);
              mini_gemm<3>(p, bid, nb, lds, (const bf16_t*)(ws + WS_HB), (const bf16_t*)(ws + WS_WIN1), SEQ, CTX / 64, 0, 3072 / 48, ef);
 }
        } break;
        case 11: {
            { unsigned* qctr = (unsigned*)(ws + WS_CTL) + CW_Q12; volatile XLAS unsigned* qslot = xst - 4;
              const bool st = nb == 256;
              for (int rnd = 0;; ++rnd) {
                  int it;
                  if (st && rnd < 2) { const int x = bid & 7, r = bid >> 3; it = (((x << 4) | (r >> 1)) << 2) | ((r & 1) << 1) | rnd; }
                  else {
                      __syncthreads();
                      if (p.tid() == 0) qslot[0] = atomicAdd(qctr, 1u);
                      __syncthreads();
                      it = (int)qslot[0];
                      if (st) it += 512;
                  }
                  if (it >= 520 + 384) break;
                  if (it < 520) ml_states(p, it, 1 << 20, lds); else conv_moe_chunk(p, it - 520, lds, 1);
              } }
        } break;
        case 12: {
            ml_scan(p, bid, nb);
            xcd_barrier(xbar, p.tid());
            ml_out(p, bid, nb, lds);
        } break;
        case 13: {
            { g8::Order S; S.init(SEQ / 256, 4, nb, bid);
              EpiResidT<false> ef{nullptr, nullptr, (bf16_t*)(ws + WS_XRES), MODS + (1 * 2 + 0) * 6144 + 2048, MODS + (1 * 2 + 0) * 6144 + 2048};
              g8::gemm8(p.tid(), ldsa, (const bf16_t*)(ws + WS_HB), 1024, RowPlain{}, S, BSelOne{(const char*)(ws + WS_WOUT1)}, ef);
 }
        } break;
        case 14: {
            phase_route(p, bid, nb, lds, 1, SEQ);
        } break;
        case 15: {
            phase_moe_fused(p, bid, nb, ldsa, lds, 1);
        } break;
        case 16: {
            { Rows2Args a{}; a.layer = 1; a.src = 1; a.combine = 1; a.clayer = 1; a.final_out = 1; a.nrows = SEQ; phase_rows2(p, bid, nb, lds, a); }
        } break;
        default: break;
        }
        if (pq + 1 < 2 * nph) xcd_barrier(xbar, p.tid());
#if TIMED_PH >= 0 || DELAY_PH >= 0
        if (!(pq & 1) && p.tid() == 0) {
            const unsigned now = (unsigned)__builtin_amdgcn_s_memrealtime();
            if (ph == TIMED_PH) xst[3] = now - xst[2];
            if (ph == DELAY_PH) xst[-8] = now - xst[2];
            xst[2] = now;
        }
#endif
    }
#if TSA >= 0
    if (blockIdx.x == 0 && p.tid() == 0) { volatile XLAS unsigned* tsp = (volatile XLAS unsigned*)((XLAS unsigned char*)smem + LDS_BYTES - 128);
        const unsigned long long t0 = __builtin_amdgcn_s_memrealtime(); const unsigned long long dt = 50ull * (tsp[TSB] - tsp[TSA]);
        while (__builtin_amdgcn_s_memrealtime() - t0 < dt) __builtin_amdgcn_s_sleep(8);
    }
#endif
#if DELAY_PH >= 0
    if (blockIdx.x == 0 && p.tid() == 0) {
        const unsigned long long t0 = __builtin_amdgcn_s_memrealtime(); const unsigned long long dt = 20ull * xst[-8];
        while (__builtin_amdgcn_s_memrealtime() - t0 < dt) __builtin_amdgcn_s_sleep(8);
    }
#endif
#if TIMED_PH >= 0
    xcd_barrier(xbar, p.tid());
    if (blockIdx.x == 0) {
        const float t_phase = (float)xst[3] * 0.01f;
        const float delta = sqrtf(t_phase * 1e-5f * 256.f * TIMED_M2);
        float* o = p.get_out();
        for (int i = p.tid(); i < 65536; i += NTH) o[i] += (i & 1) ? delta : -delta;
    }
#endif
}

extern "C" void kernel_launch(void* const* d_in, const int* in_sizes, int n_in, void* d_out, int out_size, void* d_ws, size_t ws_size, hipStream_t stream) {
    static int grid = 0;
    if (grid == 0) {
        if (n_in != 31 || ws_size < WS_END) { fprintf(stderr, "kernel_launch: unexpected n_in %d or ws_size %zu < %zu\n", n_in, ws_size, (size_t)WS_END); grid = -1; return; }
        int dev = 0, cus = 0, per_cu = 0;
        hipGetDevice(&dev);
        hipDeviceGetAttribute(&cus, hipDeviceAttributeMultiprocessorCount, dev);
        hipFuncSetAttribute((const void*)fwd_kernel, hipFuncAttributeMaxDynamicSharedMemorySize, LDS_BYTES);
        hipOccupancyMaxActiveBlocksPerMultiprocessor(&per_cu, (const void*)fwd_kernel, NTH, LDS_BYTES);
        if (per_cu < 1) { fprintf(stderr, "kernel_launch: occupancy query says %d blocks per CU\n", per_cu); per_cu = 1; }
        grid = cus;
    }
    if (grid < 0) return;
    PK p{};
    for (int i = 0; i < 31; ++i) p.in[i] = (const float*)d_in[i];
    p.out = (float*)d_out; p.ws = (unsigned char*)d_ws;
    hipMemsetAsync((unsigned char*)d_ws + WS_CTL, 0, 65536, stream);
    void* args[] = {&p};
    hipError_t e = hipLaunchCooperativeKernel((const void*)fwd_kernel, dim3(grid), dim3(NTH), args, LDS_BYTES, stream);
    if (e != hipSuccess) fprintf(stderr, "cooperative launch failed: %s (grid %d)\n", hipGetErrorString(e), grid);
}
```
